# Optimizing an MI355X kernel written in HIP

```python
import jax, jax.numpy as jnp
from jax import lax
import numpy as np

D_MODEL = 1024
BATCH = 2
SEQ = 8192
DEPTH = 2

CHUNK = 64
LOOKBACK_CHUNKS = 8
BAND = (LOOKBACK_CHUNKS + 1) * CHUNK
N_MIXERS = 2
N_HEADS = 16
HEAD_DIM = D_MODEL // N_HEADS
MAX_REL = 128
N_REL = 2 * MAX_REL + 1
SSM_GROUP = 16
SSM_GROUPS = D_MODEL // SSM_GROUP
SSM_STATE = 64
DT_MIN = 1e-3
DT_MAX = 1e-1
N_EXPERT_GROUPS = 4
EXPERTS_PER_GROUP = 8
N_EXPERTS = N_EXPERT_GROUPS * EXPERTS_PER_GROUP
TOP_K = 2
D_EXPERT = D_MODEL // 4
RMS_EPS = 1e-6
NEG_BIG = -1e30

kernel_name = "interleaved_chunkattn_s5_hiermoe"


def rms_norm(x, g):
    x32 = x.astype(jnp.float32)
    y = x32 * lax.rsqrt(jnp.mean(x32 * x32, axis=-1, keepdims=True) + RMS_EPS)
    return (y * g.astype(jnp.float32)).astype(x.dtype)


def chunked_rel_attention(h, w_qkv, w_o, rel_bias):
    b, s, _ = h.shape
    nc = s // CHUNK
    q, k, v = jnp.split(h @ w_qkv, 3, axis=-1)
    q = q.reshape(b, nc, CHUNK, N_HEADS, HEAD_DIM)
    pad = ((0, 0), (LOOKBACK_CHUNKS * CHUNK, 0), (0, 0))

    def gather_band(t):
        t = jnp.pad(t, pad).reshape(b, nc + LOOKBACK_CHUNKS, CHUNK, N_HEADS, HEAD_DIM)
        return jnp.concatenate([t[:, j:j + nc] for j in range(LOOKBACK_CHUNKS + 1)], axis=2)

    kb, vb = gather_band(k), gather_band(v)
    scores = jnp.einsum('bcqhd,bckhd->bhcqk', q, kb).astype(jnp.float32) * (HEAD_DIM ** -0.5)
    q_pos = LOOKBACK_CHUNKS * CHUNK + jnp.arange(CHUNK)
    dist = q_pos[:, None] - jnp.arange(BAND)[None, :]
    rel_idx = jnp.clip(dist, -MAX_REL, MAX_REL) + MAX_REL
    bias = rel_bias[:, rel_idx].astype(jnp.float32)
    key_chunk = jnp.arange(nc)[:, None] - LOOKBACK_CHUNKS + jnp.arange(BAND)[None, :] // CHUNK
    valid = key_chunk >= 0
    scores = jnp.where(valid[None, None, :, None, :], scores + bias[None, :, None], NEG_BIG)
    p = jax.nn.softmax(scores, axis=-1).astype(vb.dtype)
    o = jnp.einsum('bhcqk,bckhd->bcqhd', p, vb).reshape(b, s, D_MODEL)
    return o @ w_o


def _complex_affine_combine(e1, e2):
    a1r, a1i, b1r, b1i = e1
    a2r, a2i, b2r, b2i = e2
    ar = a2r * a1r - a2i * a1i
    ai = a2r * a1i + a2i * a1r
    br = a2r * b1r - a2i * b1i + b2r
    bi = a2r * b1i + a2i * b1r + b2i
    return (ar, ai, br, bi)


def s5_mixer(h, lambda_re, lambda_im, log_step, b_re, b_im, c_re, c_im, d_skip, w_out):
    bsz, s, _ = h.shape
    h32 = h.astype(jnp.float32)
    u = h32.reshape(bsz, s, SSM_GROUPS, SSM_GROUP)
    lam_re = jnp.minimum(lambda_re.astype(jnp.float32), -1e-4)
    lam_im = lambda_im.astype(jnp.float32)
    step = jnp.exp(log_step.astype(jnp.float32))[:, None]
    decay = jnp.exp(lam_re * step)
    ang = lam_im * step
    abar_re = decay * jnp.cos(ang)
    abar_im = decay * jnp.sin(ang)
    denom = lam_re * lam_re + lam_im * lam_im
    num_re = abar_re - 1.0
    f_re = ((num_re * lam_re + abar_im * lam_im) / denom)[..., None]
    f_im = ((abar_im * lam_re - num_re * lam_im) / denom)[..., None]
    br = b_re.astype(jnp.float32)
    bi = b_im.astype(jnp.float32)
    bbar_re = f_re * br - f_im * bi
    bbar_im = f_re * bi + f_im * br
    bu_re = jnp.einsum('blgc,gpc->blgp', u, bbar_re)
    bu_im = jnp.einsum('blgc,gpc->blgp', u, bbar_im)
    a_re = jnp.broadcast_to(abar_re, bu_re.shape)
    a_im = jnp.broadcast_to(abar_im, bu_im.shape)
    _, _, x_re, x_im = lax.associative_scan(_complex_affine_combine, (a_re, a_im, bu_re, bu_im), axis=1)
    y = (jnp.einsum('blgp,gcp->blgc', x_re, c_re.astype(jnp.float32))
         - jnp.einsum('blgp,gcp->blgc', x_im, c_im.astype(jnp.float32)))
    y = y.reshape(bsz, s, D_MODEL) + d_skip.astype(jnp.float32) * h32
    y = jax.nn.gelu(y).astype(h.dtype)
    a, g = jnp.split(y @ w_out, 2, axis=-1)
    return a * jax.nn.sigmoid(g)


def hierarchical_moe(h, w_group_router, b_group_router, w_expert_router, b_expert_router,
                     w_gate, w_up, w_down):
    bsz, s, d = h.shape
    t = h.reshape(-1, d)
    group_logits = (t @ w_group_router).astype(jnp.float32) + b_group_router.astype(jnp.float32)
    group_prob = jax.nn.softmax(group_logits, axis=-1)
    g_prob, g_idx = lax.top_k(group_prob, 1)
    exp_logits = (jnp.einsum('td,gde->tge', t, w_expert_router).astype(jnp.float32)
                  + b_expert_router.astype(jnp.float32))
    sel_logits = jnp.take_along_axis(exp_logits, g_idx[:, :, None], axis=1)[:, 0]
    top_logits, e_idx = lax.top_k(sel_logits, TOP_K)
    e_w = jax.nn.softmax(top_logits, axis=-1) * g_prob
    global_idx = g_idx * EXPERTS_PER_GROUP + e_idx
    gates = jnp.sum(jax.nn.one_hot(global_idx, N_EXPERTS, dtype=jnp.float32) * e_w[..., None], axis=1)
    out = jnp.zeros(t.shape, jnp.float32)
    for e in range(N_EXPERTS):
        hid = jax.nn.silu(t @ w_gate[e]) * (t @ w_up[e])
        out = out + gates[:, e:e + 1] * (hid @ w_down[e]).astype(jnp.float32)
    return out.astype(h.dtype).reshape(bsz, s, d)


def setup_inputs(seed: int = 0) -> dict:
    key = jax.random.key(seed)
    ks = jax.random.split(key, 24)
    n_attn = (DEPTH + 1) // 2
    n_ssm = DEPTH // 2
    D, F = D_MODEL, D_EXPERT
    nrm = jax.random.normal
    f32 = jnp.float32
    log_step = jax.random.uniform(ks[5], (n_ssm, SSM_GROUPS), f32,
                                  float(np.log(DT_MIN)), float(np.log(DT_MAX)))
    lam_im_base = jnp.pi * jnp.arange(SSM_STATE, dtype=f32)
    return {
        "x": nrm(ks[0], (BATCH, SEQ, D), f32),
        "norm_mix": 1.0 + 0.02 * nrm(ks[1], (DEPTH, D), f32),
        "norm_ffn": 1.0 + 0.02 * nrm(ks[2], (DEPTH, D), f32),
        "norm_final": 1.0 + 0.02 * nrm(ks[3], (D,), f32),
        "attn_w_qkv": nrm(ks[4], (n_attn, D, 3 * D), f32) * D ** -0.5,
        "attn_w_o": nrm(ks[6], (n_attn, D, D), f32) * D ** -0.5,
        "attn_rel_bias": 0.1 * nrm(ks[7], (n_attn, N_HEADS, N_REL), f32),
        "ssm_lambda_re": -0.5 + 0.01 * nrm(ks[8], (n_ssm, SSM_GROUPS, SSM_STATE), f32),
        "ssm_lambda_im": lam_im_base + 0.01 * nrm(ks[9], (n_ssm, SSM_GROUPS, SSM_STATE), f32),
        "ssm_log_step": log_step,
        "ssm_b_re": nrm(ks[10], (n_ssm, SSM_GROUPS, SSM_STATE, SSM_GROUP), f32) * (2 * SSM_GROUP) ** -0.5,
        "ssm_b_im": nrm(ks[11], (n_ssm, SSM_GROUPS, SSM_STATE, SSM_GROUP), f32) * (2 * SSM_GROUP) ** -0.5,
        "ssm_c_re": nrm(ks[12], (n_ssm, SSM_GROUPS, SSM_GROUP, SSM_STATE), f32) * SSM_STATE ** -0.5,
        "ssm_c_im": nrm(ks[13], (n_ssm, SSM_GROUPS, SSM_GROUP, SSM_STATE), f32) * SSM_STATE ** -0.5,
        "ssm_d": nrm(ks[14], (n_ssm, D), f32),
        "ssm_w_out": nrm(ks[15], (n_ssm, D, 2 * D), f32) * D ** -0.5,
        "moe_w_group_router": nrm(ks[16], (DEPTH, D, N_EXPERT_GROUPS), f32) * D ** -0.5,
        "moe_b_group_router": 0.01 * nrm(ks[17], (DEPTH, N_EXPERT_GROUPS), f32),
        "moe_w_expert_router": nrm(ks[18], (DEPTH, N_EXPERT_GROUPS, D, EXPERTS_PER_GROUP), f32) * D ** -0.5,
        "moe_b_expert_router": 0.01 * nrm(ks[19], (DEPTH, N_EXPERT_GROUPS, EXPERTS_PER_GROUP), f32),
        "moe_w_gate": nrm(ks[20], (DEPTH, N_EXPERTS, D, F), f32) * D ** -0.5,
        "moe_w_up": nrm(ks[21], (DEPTH, N_EXPERTS, D, F), f32) * D ** -0.5,
        "moe_w_down": nrm(ks[22], (DEPTH, N_EXPERTS, F, D), f32) * F ** -0.5,
    }


def reference(x, norm_mix, norm_ffn, norm_final, attn_w_qkv, attn_w_o, attn_rel_bias,
              ssm_lambda_re, ssm_lambda_im, ssm_log_step, ssm_b_re, ssm_b_im, ssm_c_re, ssm_c_im,
              ssm_d, ssm_w_out, moe_w_group_router, moe_b_group_router, moe_w_expert_router,
              moe_b_expert_router, moe_w_gate, moe_w_up, moe_w_down):
    h = x
    for i in range(DEPTH):
        j = i // N_MIXERS
        hn = rms_norm(h, norm_mix[i])
        if i % N_MIXERS == 0:
            mix = chunked_rel_attention(hn, attn_w_qkv[j], attn_w_o[j], attn_rel_bias[j])
        else:
            mix = s5_mixer(hn, ssm_lambda_re[j], ssm_lambda_im[j], ssm_log_step[j],
                           ssm_b_re[j], ssm_b_im[j], ssm_c_re[j], ssm_c_im[j],
                           ssm_d[j], ssm_w_out[j])
        h = h + mix
        hn = rms_norm(h, norm_ffn[i])
        h = h + hierarchical_moe(hn, moe_w_group_router[i], moe_b_group_router[i],
                                 moe_w_expert_router[i], moe_b_expert_router[i],
                                 moe_w_gate[i], moe_w_up[i], moe_w_down[i])
    return rms_norm(h, norm_final)
```

```cpp
#include <hip/hip_runtime.h>
#include <cstdio>
#include <cstdint>

typedef unsigned short bf16;
constexpr int BATCH = 2, SEQ = 8192, D = 1024, M = BATCH * SEQ, NH = 16, HD = 64;
constexpr int NEXP = 32, EPG = 8, FE = 256;
constexpr int NREL = 257;
constexpr float RMS_EPS = 1e-6f;
constexpr float LOG2E = 1.4426950408889634f;
constexpr float C2 = 0.125f * LOG2E;

constexpr size_t MiB = 1u << 20;
constexpr size_t WS_CTL = 0;
constexpr size_t WS_XN = 86 * MiB;
constexpr size_t WS_BIG = 134 * MiB;
constexpr size_t WS_Q = WS_BIG, WS_K = WS_BIG + 32 * MiB, WS_V = WS_BIG + 64 * MiB;
constexpr size_t WS_Y2 = WS_BIG, WS_H = WS_BIG + 64 * MiB;
constexpr size_t WS_SLOC = WS_BIG, WS_G = WS_BIG + 32 * MiB;

__device__ __forceinline__ bf16 f2bf(float f) { unsigned u = __float_as_uint(f); return (bf16)((u + 0x7fffu + ((u >> 16) & 1u)) >> 16); }
__device__ __forceinline__ float bf2f(bf16 h) { return __uint_as_float(((unsigned)h) << 16); }
__device__ __forceinline__ float wave_sum(float v) {
#pragma unroll
    for (int o = 1; o < 64; o <<= 1) v += __shfl_xor(v, o);
    return v;
}
__device__ __forceinline__ float gelu_tanh(float x) { const float u = 0.7978845608028654f * (x + 0.044715f * x * x * x); return 0.5f * x * (1.f + tanhf(u)); }

__device__ __forceinline__ size_t xng_off(int t, int col) { const int b = t >> 13, tt = t & 8191, s = tt >> 4, j = tt & 15, g = col >> 4, c = col & 15; return ((size_t)(g * 1024 + b * 512 + s)) * 384 + j * 16 + c; }

__global__ void __launch_bounds__(256) n_rmsnorm_bf16(const float* __restrict__ x, const float* __restrict__ g, bf16* __restrict__ out) {
    const int row = blockIdx.x * 4 + (threadIdx.x >> 6), lane = threadIdx.x & 63;
    const float4* xr = (const float4*)(x + (size_t)row * D);
    float4 v[4]; float ss = 0.f;
#pragma unroll
    for (int j = 0; j < 4; ++j) { v[j] = xr[lane + 64 * j]; ss += v[j].x * v[j].x + v[j].y * v[j].y + v[j].z * v[j].z + v[j].w * v[j].w; }
    ss = wave_sum(ss); const float s = rsqrtf(ss * (1.f / D) + RMS_EPS);
#pragma unroll
    for (int j = 0; j < 4; ++j) { const int c = 4 * (lane + 64 * j); const float4 gg = *(const float4*)(g + c);
        bf16* o = out + (size_t)row * D + c; o[0] = f2bf(v[j].x * s * gg.x); o[1] = f2bf(v[j].y * s * gg.y); o[2] = f2bf(v[j].z * s * gg.z); o[3] = f2bf(v[j].w * s * gg.w); }
}

template <int MODE> __global__ void __launch_bounds__(256) n_gemm(const bf16* __restrict__ A, const float* __restrict__ B, int ldb, const float* resid, float* outf, bf16* __restrict__ ob0, bf16* __restrict__ ob1, bf16* __restrict__ ob2) {
    __shared__ float As[16][65]; __shared__ float Bs[16][64]; __shared__ float Bs2[16][64];
    const int tid = threadIdx.x, tx = tid & 15, ty = tid >> 4, bm = blockIdx.y * 64, bn = blockIdx.x * 64;
    float acc[4][4], acc2[4][4];
#pragma unroll
    for (int i = 0; i < 4; ++i)
#pragma unroll
        for (int j = 0; j < 4; ++j) { acc[i][j] = 0.f; acc2[i][j] = 0.f; }
    for (int k0 = 0; k0 < 1024; k0 += 16) {
        { const int r = tid >> 2, kq = (tid & 3) * 4; const bf16* ap = A + (size_t)(bm + r) * 1024 + k0 + kq;
#pragma unroll
          for (int i = 0; i < 4; ++i) As[kq + i][r] = bf2f(ap[i]); }
        { const int k = tid >> 4, n = (tid & 15) * 4; const float4 b = *(const float4*)(B + (size_t)(k0 + k) * ldb + bn + n);
          Bs[k][n] = b.x; Bs[k][n + 1] = b.y; Bs[k][n + 2] = b.z; Bs[k][n + 3] = b.w;
          if (MODE == 2) { const float4 b2 = *(const float4*)(B + (size_t)(k0 + k) * ldb + 1024 + bn + n); Bs2[k][n] = b2.x; Bs2[k][n + 1] = b2.y; Bs2[k][n + 2] = b2.z; Bs2[k][n + 3] = b2.w; } }
        __syncthreads();
#pragma unroll
        for (int k = 0; k < 16; ++k) { float a[4], b[4], b2[4];
#pragma unroll
            for (int i = 0; i < 4; ++i) a[i] = As[k][ty * 4 + i];
#pragma unroll
            for (int j = 0; j < 4; ++j) { b[j] = Bs[k][tx * 4 + j]; b2[j] = (MODE == 2) ? Bs2[k][tx * 4 + j] : 0.f; }
#pragma unroll
            for (int i = 0; i < 4; ++i)
#pragma unroll
                for (int j = 0; j < 4; ++j) { acc[i][j] += a[i] * b[j]; if (MODE == 2) acc2[i][j] += a[i] * b2[j]; } }
        __syncthreads();
    }
#pragma unroll
    for (int i = 0; i < 4; ++i)
#pragma unroll
        for (int j = 0; j < 4; ++j) { const int row = bm + ty * 4 + i, col = bn + tx * 4 + j;
            if (MODE == 0) { const int which = col >> 10, c = col & 1023; bf16* o = which == 0 ? ob0 : (which == 1 ? ob1 : ob2); o[(size_t)row * 1024 + c] = f2bf(acc[i][j] * (which == 0 ? C2 : 1.f)); }
            else { float h = resid[(size_t)row * 1024 + col]; if (MODE == 1) h += acc[i][j]; else h += acc[i][j] / (1.f + __expf(-acc2[i][j])); outf[(size_t)row * 1024 + col] = h; ob0[(size_t)row * 1024 + col] = f2bf(h); } }
}

__global__ void __launch_bounds__(64) n_attn(const bf16* Q, const bf16* __restrict__ K, const bf16* __restrict__ V, const float* __restrict__ relb, bf16* O) {
    const int c = blockIdx.x, h = blockIdx.y, b = blockIdx.z, qi = threadIdx.x;
    const size_t qrow = (size_t)b * SEQ + c * 64 + qi;
    float q[64], o[64];
#pragma unroll
    for (int d = 0; d < 64; ++d) { q[d] = bf2f(Q[qrow * D + h * 64 + d]); o[d] = 0.f; }
    float m = -1e30f, l = 0.f; const float* rb = relb + h * NREL;
    const int kc0 = c - 8 < 0 ? 0 : c - 8;
    for (int kc = kc0; kc <= c; ++kc)
        for (int kj = 0; kj < 64; ++kj) {
            const size_t krow = (size_t)b * SEQ + kc * 64 + kj; const bf16* kp = K + krow * D + h * 64; const bf16* vp = V + krow * D + h * 64;
            float s = 0.f;
#pragma unroll
            for (int d = 0; d < 64; ++d) s += q[d] * bf2f(kp[d]);
            int dist = (c - kc) * 64 + qi - kj; dist = dist < -128 ? -128 : (dist > 128 ? 128 : dist);
            s += rb[dist + 128] * LOG2E;
            const float mn = fmaxf(m, s), a = exp2f(m - mn), p = exp2f(s - mn); l = l * a + p; m = mn;
#pragma unroll
            for (int d = 0; d < 64; ++d) o[d] = o[d] * a + p * bf2f(vp[d]);
        }
    const float il = 1.f / l;
#pragma unroll
    for (int d = 0; d < 64; ++d) O[qrow * D + h * 64 + d] = f2bf(o[d] * il);
}

__global__ void __launch_bounds__(256) n_moe(const float* __restrict__ h, const float* __restrict__ gn, const float* __restrict__ wgr, const float* __restrict__ bgr, const float* __restrict__ wer, const float* __restrict__ ber,
                                             const float* __restrict__ wg, const float* __restrict__ wu, const float* __restrict__ wd, bf16* __restrict__ Y2) {
    __shared__ float hn[1024]; __shared__ float red[4]; __shared__ float logit[36]; __shared__ float hid[256]; __shared__ int se[2]; __shared__ float sw[2];
    const int t = blockIdx.x, tid = threadIdx.x;
    const float4 v = ((const float4*)(h + (size_t)t * D))[tid];
    float ss = wave_sum(v.x * v.x + v.y * v.y + v.z * v.z + v.w * v.w);
    if ((tid & 63) == 0) red[tid >> 6] = ss;
    __syncthreads();
    const float s = rsqrtf((red[0] + red[1] + red[2] + red[3]) * (1.f / D) + RMS_EPS);
    { const float4 gg = ((const float4*)gn)[tid]; hn[4 * tid] = v.x * s * gg.x; hn[4 * tid + 1] = v.y * s * gg.y; hn[4 * tid + 2] = v.z * s * gg.z; hn[4 * tid + 3] = v.w * s * gg.w; }
    __syncthreads();
    if (tid < 36) { float acc = 0.f;
        if (tid < 4) { for (int k = 0; k < 1024; ++k) acc += hn[k] * wgr[k * 4 + tid]; acc += bgr[tid]; }
        else { const int o = tid - 4, gi = o >> 3, ei = o & 7; for (int k = 0; k < 1024; ++k) acc += hn[k] * wer[((size_t)gi * 1024 + k) * 8 + ei]; acc += ber[o]; }
        logit[tid] = acc; }
    __syncthreads();
    if (tid == 0) {
        int gi = 0; float gm = logit[0];
        for (int i = 1; i < 4; ++i) if (logit[i] > gm) { gm = logit[i]; gi = i; }
        float den = 0.f; for (int i = 0; i < 4; ++i) den += __expf(logit[i] - gm);
        const float gp = 1.f / den;
        const float* sl = logit + 4 + 8 * gi;
        int i1 = 0; float l1 = sl[0]; for (int i = 1; i < 8; ++i) if (sl[i] > l1) { l1 = sl[i]; i1 = i; }
        int i2 = -1; float l2 = -3.4e38f; for (int i = 0; i < 8; ++i) if (i != i1 && sl[i] > l2) { l2 = sl[i]; i2 = i; }
        const float e2 = __expf(l2 - l1), w1 = 1.f / (1.f + e2), w2 = e2 / (1.f + e2);
        se[0] = gi * 8 + i1; se[1] = gi * 8 + i2; sw[0] = w1 * gp; sw[1] = w2 * gp;
    }
    __syncthreads();
    for (int kk = 0; kk < 2; ++kk) {
        const int e = se[kk]; const float w = sw[kk];
        const float* pg = wg + (size_t)e * 1024 * 256 + tid; const float* pu = wu + (size_t)e * 1024 * 256 + tid;
        float ag = 0.f, au = 0.f;
        for (int k = 0; k < 1024; ++k) { ag += hn[k] * pg[(size_t)k * 256]; au += hn[k] * pu[(size_t)k * 256]; }
        hid[tid] = ag / (1.f + __expf(-ag)) * au;
        __syncthreads();
        const float* pd = wd + (size_t)e * 256 * 1024;
#pragma unroll
        for (int i = 0; i < 4; ++i) { const int c = tid + 256 * i; float acc = 0.f; for (int j = 0; j < 256; ++j) acc += hid[j] * pd[(size_t)j * 1024 + c]; Y2[((size_t)2 * t + kk) * D + c] = f2bf(w * acc); }
        __syncthreads();
    }
}

__global__ void __launch_bounds__(256) n_combine_norm(float* hio, const bf16* __restrict__ Y2, const float* __restrict__ g, bf16* __restrict__ xng) {
    const int row = blockIdx.x * 4 + (threadIdx.x >> 6), lane = threadIdx.x & 63;
    float4* hr = (float4*)(hio + (size_t)row * D);
    float4 v[4]; float ss = 0.f;
#pragma unroll
    for (int j = 0; j < 4; ++j) { v[j] = hr[lane + 64 * j]; const int c = 4 * (lane + 64 * j);
        const bf16* ya = Y2 + ((size_t)2 * row) * D + c; const bf16* yb = ya + D;
        v[j].x += bf2f(ya[0]) + bf2f(yb[0]); v[j].y += bf2f(ya[1]) + bf2f(yb[1]); v[j].z += bf2f(ya[2]) + bf2f(yb[2]); v[j].w += bf2f(ya[3]) + bf2f(yb[3]);
        ss += v[j].x * v[j].x + v[j].y * v[j].y + v[j].z * v[j].z + v[j].w * v[j].w; hr[lane + 64 * j] = v[j]; }
    ss = wave_sum(ss); const float s = rsqrtf(ss * (1.f / D) + RMS_EPS);
#pragma unroll
    for (int j = 0; j < 4; ++j) { const int c = 4 * (lane + 64 * j); const float4 gg = *(const float4*)(g + c); bf16* o = xng + xng_off(row, c);
        o[0] = f2bf(v[j].x * s * gg.x); o[1] = f2bf(v[j].y * s * gg.y); o[2] = f2bf(v[j].z * s * gg.z); o[3] = f2bf(v[j].w * s * gg.w); }
}

__global__ void __launch_bounds__(64) n_ssm(const bf16* __restrict__ xng, const float* __restrict__ lre, const float* __restrict__ lim, const float* __restrict__ lstep, const float* __restrict__ bre, const float* __restrict__ bim,
                                            const float* __restrict__ cre, const float* __restrict__ cim, const float* __restrict__ dsk, bf16* __restrict__ G) {
    const int g = blockIdx.x, b = blockIdx.y, p = threadIdx.x;
    const float lr = fminf(lre[g * 64 + p], -1e-4f), li = lim[g * 64 + p], step = expf(lstep[g]);
    const float decay = expf(lr * step), ang = li * step, ar = decay * cosf(ang), ai = decay * sinf(ang);
    const float den = lr * lr + li * li, nr = ar - 1.f, fr = (nr * lr + ai * li) / den, fi = (ai * lr - nr * li) / den;
    float bbr[16], bbi[16], ccr[16], cci[16];
#pragma unroll
    for (int c = 0; c < 16; ++c) { const float br = bre[(g * 64 + p) * 16 + c], bi = bim[(g * 64 + p) * 16 + c]; bbr[c] = fr * br - fi * bi; bbi[c] = fr * bi + fi * br;
        ccr[c] = cre[(g * 16 + c) * 64 + p]; cci[c] = cim[(g * 16 + c) * 64 + p]; }
    const float dd = dsk[g * 16 + (p & 15)];
    float xr = 0.f, xi = 0.f;
    for (int t = 0; t < SEQ; ++t) {
        const bf16* up = xng + ((size_t)(g * 1024 + b * 512 + (t >> 4))) * 384 + (t & 15) * 16;
        float u[16]; float bur = 0.f, bui = 0.f;
#pragma unroll
        for (int c = 0; c < 16; ++c) { u[c] = bf2f(up[c]); bur += bbr[c] * u[c]; bui += bbi[c] * u[c]; }
        const float nxr = ar * xr - ai * xi + bur, nxi = ar * xi + ai * xr + bui; xr = nxr; xi = nxi;
        float mine = 0.f, myu = 0.f;
#pragma unroll
        for (int c = 0; c < 16; ++c) { const float y = wave_sum(ccr[c] * xr - cci[c] * xi); if ((p & 15) == c) { mine = y; myu = u[c]; } }
        if (p < 16) G[((size_t)b * SEQ + t) * D + g * 16 + p] = f2bf(gelu_tanh(mine + dd * myu));
    }
}

__global__ void __launch_bounds__(256) n_final(float* hio, const bf16* __restrict__ Y2, const float* __restrict__ g) {
    const int row = blockIdx.x * 4 + (threadIdx.x >> 6), lane = threadIdx.x & 63;
    float4* hr = (float4*)(hio + (size_t)row * D);
    float4 v[4]; float ss = 0.f;
#pragma unroll
    for (int j = 0; j < 4; ++j) { v[j] = hr[lane + 64 * j]; const int c = 4 * (lane + 64 * j);
        const bf16* ya = Y2 + ((size_t)2 * row) * D + c; const bf16* yb = ya + D;
        v[j].x += bf2f(ya[0]) + bf2f(yb[0]); v[j].y += bf2f(ya[1]) + bf2f(yb[1]); v[j].z += bf2f(ya[2]) + bf2f(yb[2]); v[j].w += bf2f(ya[3]) + bf2f(yb[3]);
        ss += v[j].x * v[j].x + v[j].y * v[j].y + v[j].z * v[j].z + v[j].w * v[j].w; }
    ss = wave_sum(ss); const float s = rsqrtf(ss * (1.f / D) + RMS_EPS);
#pragma unroll
    for (int j = 0; j < 4; ++j) { const int c = 4 * (lane + 64 * j); const float4 gg = *(const float4*)(g + c);
        float4 o; o.x = v[j].x * s * gg.x; o.y = v[j].y * s * gg.y; o.z = v[j].z * s * gg.z; o.w = v[j].w * s * gg.w; hr[lane + 64 * j] = o; }
}


#define LAS __attribute__((address_space(3)))
typedef short bf16x8 __attribute__((ext_vector_type(8)));
typedef short s16x4 __attribute__((ext_vector_type(4)));
typedef float f32x4 __attribute__((ext_vector_type(4)));
typedef float f32x16 __attribute__((ext_vector_type(16)));
typedef unsigned u32x4 __attribute__((ext_vector_type(4)));
typedef unsigned u32x2 __attribute__((ext_vector_type(2)));

constexpr int NWAVES = 8, NTHR = 512;
constexpr int CAP = 16384;
constexpr size_t CTL_ZERO_BYTES = 1 * MiB;
constexpr size_t WS_PDST = 1 * MiB, WS_PW = 3 * MiB, WS_PS = 5 * MiB, WS_SROW = 7 * MiB, WS_A16 = 7 * MiB + 65536;
constexpr size_t WS_RWT = 8 * MiB;
constexpr size_t WS_WQKV = 9 * MiB, WS_WO = 15 * MiB, WS_WOUT = 17 * MiB, WS_SSM = 21 * MiB;
constexpr size_t WS_WGU = 38 * MiB, WS_WD = 70 * MiB;
constexpr size_t WS_END = 230 * MiB;
constexpr int RW_PITCH = 1028, RW_LAYER = 36 * RW_PITCH;
constexpr int SSM_G_BYTES = 262144, SSM_A2_OFF = 65536;
constexpr int CW_BAR = 4096;
constexpr int CW_CNT = 65536;
constexpr int LDS_BYTES = 160 * 1024, MISC_OFF = LDS_BYTES - 512, AUX_OFF = 128 * 1024, RSCR_OFF = 36 * 1028 * 4;
constexpr int N_PHASES = 16;

__device__ __forceinline__ unsigned cvt_pk_bf16(float lo, float hi) { unsigned r; asm volatile("v_cvt_pk_bf16_f32 %0, %1, %2" : "=v"(r) : "v"(lo), "v"(hi)); return r; }
__device__ __forceinline__ unsigned pk2(float lo, float hi) { return (unsigned)f2bf(lo) | ((unsigned)f2bf(hi) << 16); }
#define LDS_WAIT() asm volatile("s_waitcnt lgkmcnt(0)" ::: "memory")
#define VM_WAIT() asm volatile("s_waitcnt vmcnt(0)" ::: "memory")
#define RLX_AGENT __ATOMIC_RELAXED, __HIP_MEMORY_SCOPE_AGENT

#define XB_TMO      128
#define XB_XCNT(j)  (256  + 64 * (j))
#define XB_XSUB(j)  (1280 + 64 * (j))
#define XB_XGEN(j)  (2304 + 64 * (j))
#define XB_TOP      3328
#define XB_TOPGEN   3392
#define XCD_BAR_WORDS 3456
#define XB_SPIN_CAP (1u << 18)
__device__ __forceinline__ unsigned xb_ld(unsigned* p)              { return __hip_atomic_load(p, __ATOMIC_RELAXED, __HIP_MEMORY_SCOPE_AGENT); }
__device__ __forceinline__ unsigned xb_add(unsigned* p, unsigned v) { return __hip_atomic_fetch_add(p, v, __ATOMIC_RELAXED, __HIP_MEMORY_SCOPE_AGENT); }
__device__ __forceinline__ unsigned xb_xcc_id() { return (unsigned)__builtin_amdgcn_s_getreg((3 << 11) | 20) & 0xFu; }
#define XB_SPIN(cond, bar) do { unsigned _sp = 0; while (cond) { __builtin_amdgcn_s_sleep(1); \
    if ((++_sp & 255u) == 0u) { if (xb_ld(&(bar)[XB_TMO])) break; if (_sp > XB_SPIN_CAP) { atomicAdd(&(bar)[XB_TMO], 1u); break; } } } } while (0)
struct XcdBarrier { unsigned* bar; unsigned x; volatile LAS unsigned* st; };
__device__ __forceinline__ XcdBarrier xcd_barrier_post(unsigned* bar, volatile LAS unsigned* st) {
    XcdBarrier b; b.bar = bar; b.x = xb_xcc_id(); b.st = st;
    if (threadIdx.x == 0) (void)xb_add(&bar[XB_XCNT(b.x)], 1u);
    return b;
}
__device__ __forceinline__ void xcd_barrier_complete(unsigned* bar, unsigned x, unsigned& nloc, unsigned& nx) {
    const unsigned G = gridDim.x * gridDim.y * gridDim.z;
    unsigned sum, cnt, mine, sp = 0u;
    for (;;) {
        sum = 0u; cnt = 0u; mine = 0u;
#pragma unroll
        for (unsigned j = 0; j < 16; ++j) { const unsigned c = xb_ld(&bar[XB_XCNT(j)]); sum += c; cnt += (c > 0u) ? 1u : 0u; mine = (j == x) ? c : mine; }
        if (sum == G) break;
        __builtin_amdgcn_s_sleep(1);
        if ((++sp & 255u) == 0u) { if (xb_ld(&bar[XB_TMO])) break; if (sp > XB_SPIN_CAP) { atomicAdd(&bar[XB_TMO], 1u); break; } }
    }
    nloc = mine > 0u ? mine : 1u; nx = cnt > 0u ? cnt : 1u;
}
__device__ __forceinline__ void xcd_barrier(const XcdBarrier& b) {
    asm volatile("s_waitcnt vmcnt(0)" ::: "memory");
    __syncthreads();
    if (threadIdx.x == 0) {
        unsigned* bar = b.bar;
        __builtin_amdgcn_s_waitcnt(0);
        unsigned nloc = b.st[0], nx = b.st[1];
        if (nloc == 0u) { xcd_barrier_complete(bar, b.x, nloc, nx); b.st[0] = nloc; b.st[1] = nx; }
        const unsigned old = xb_add(&bar[XB_XSUB(b.x)], 1u);
        const unsigned gen = old / nloc;
        if (old + 1u == (gen + 1u) * nloc) {
            __builtin_amdgcn_fence(__ATOMIC_RELEASE, "agent");
            asm volatile("s_waitcnt vmcnt(0)" ::: "memory");
            const unsigned og = xb_add(&bar[XB_TOP], 1u);
            const unsigned tg = og / nx;
            if (og + 1u == (tg + 1u) * nx) xb_add(&bar[XB_TOPGEN], 1u);
            else XB_SPIN(xb_ld(&bar[XB_TOPGEN]) == tg, bar);
            __builtin_amdgcn_fence(__ATOMIC_ACQUIRE, "agent");
            xb_add(&bar[XB_XGEN(b.x)], 1u);
            asm volatile("s_waitcnt vmcnt(0)" ::: "memory");
        } else {
            XB_SPIN(xb_ld(&bar[XB_XGEN(b.x)]) == gen, bar);
            __builtin_amdgcn_fence(__ATOMIC_ACQUIRE, "agent");
            asm volatile("s_waitcnt vmcnt(0)" ::: "memory");
        }
    }
    __syncthreads();
}

namespace gm {
constexpr int HTB = 16384;
__device__ __forceinline__ int lds_byte(int r, int c) { const int st = (r >> 4) * 2 + (c >> 5), rr = r & 15, cc = c & 31, ob = rr * 64 + cc * 2; return st * 1024 + (ob ^ (((ob >> 9) & 1) << 5)); }
__device__ __forceinline__ void stage_rc(int b, int& R, int& C) { const int st = b / 1024, sb = b % 1024, swz = sb ^ (((sb >> 9) & 1) << 5); R = (st >> 1) * 16 + swz / 64; C = (st & 1) * 32 + (swz % 64) / 2; }
__device__ __forceinline__ int perm32(int rho) { const int n = rho >> 4, i = rho & 15; return 8 * (i >> 2) + 4 * n + (i & 3); }
struct Unit { int pm, pn, e, gt, cnt; };
__device__ __forceinline__ bool static_unit(int i, int G, int c, int nM, int nN, Unit& u) {
    const int nwg = nM * nN; const long L = (long)i * G + c; if (L >= nwg) return false;
    int wgid = (int)L; { const int q = nwg / 8, r = nwg % 8, xcd = wgid % 8, off = wgid / 8; wgid = (xcd < r ? xcd * (q + 1) : r * (q + 1) + (xcd - r) * q) + off; }
    const int nig = 8 * nN, gid = wgid / nig, fm = gid * 8, gsz = (nM - fm) < 8 ? (nM - fm) : 8;
    u.pm = fm + ((wgid % nig) % gsz); u.pn = (wgid % nig) / gsz; u.e = 0; u.gt = 0; u.cnt = 0; return true;
}
template <class P> __device__ __forceinline__ void gemm_phase(LAS unsigned char* lds, const P& ph) {
    const int tid = threadIdx.x, wid = __builtin_amdgcn_readfirstlane(tid >> 6), lane = tid & 63, wr = wid >> 2, wc = wid & 3, fr = lane & 15, fq = lane >> 4;
    constexpr int nt = P::K / 64;
    static_assert(nt >= 2 && (nt % 2) == 0, "K must be a multiple of 128");
    unsigned voffA[2], voffB[2];
#pragma unroll
    for (int i = 0; i < 2; ++i) { int R, C; stage_rc(tid * 16 + i * 8192, R, C); const int Rb = (R & ~31) + perm32(R & 31); voffB[i] = (unsigned)(Rb * P::LDB + C) * 2u; voffA[i] = (unsigned)(R * P::LDA + C) * 2u; }
    const unsigned ldsw = (unsigned)wid * 1024u;
    const int aoff = lds_byte(wr * 64 + fr, fq * 8), boff = lds_byte(wc * 32 + fr, fq * 8);
    constexpr int hB = P::HSTEPB, hA = 128 * P::LDA * 2;
#define G_SA(b, h) (((b) * 2 + (h)) * gm::HTB)
#define G_SB(b, h) ((4 + (b) * 2 + (h)) * gm::HTB)
#define G_GLDS(src, bufoff, i) __builtin_amdgcn_global_load_lds((const unsigned*)(src), (LAS unsigned*)(lds + (bufoff) + ldsw + (i) * 8192), 16, 0, 0)
#define G_STA(bufoff, ptr, kb, offs, h) do { if constexpr (P::GATHER) { _Pragma("unroll") for (int _i = 0; _i < 2; ++_i) G_GLDS(Ab + (kb) + (offs)[h][_i], bufoff, _i); } \
        else { _Pragma("unroll") for (int _i = 0; _i < 2; ++_i) G_GLDS((ptr) + (h) * hA + voffA[_i], bufoff, _i); } } while (0)
#define G_STB(bufoff, ptr) do { _Pragma("unroll") for (int _i = 0; _i < 2; ++_i) G_GLDS((ptr) + voffB[_i], bufoff, _i); } while (0)
#define G_LDA(dst, b, h) do { _Pragma("unroll") for (int m = 0; m < 4; ++m) _Pragma("unroll") for (int k = 0; k < 2; ++k) dst[m][k] = *(const LAS bf16x8*)(lds + G_SA(b, h) + aoff + m * 2048 + k * 1024); } while (0)
#define G_LDB(dst, b, h) do { _Pragma("unroll") for (int n = 0; n < 2; ++n) _Pragma("unroll") for (int k = 0; k < 2; ++k) dst[n][k] = *(const LAS bf16x8*)(lds + G_SB(b, h) + boff + n * 2048 + k * 1024); } while (0)
#define G_MMA(ai, bj, At, Bt) do { __builtin_amdgcn_s_setprio(1); _Pragma("unroll") for (int m = 0; m < 4; ++m) _Pragma("unroll") for (int n = 0; n < 2; ++n) _Pragma("unroll") for (int k = 0; k < 2; ++k) \
        acc[ai][bj][m][n] = __builtin_amdgcn_mfma_f32_16x16x32_bf16(Bt[n][k], At[m][k], acc[ai][bj][m][n], 0, 0, 0); __builtin_amdgcn_s_setprio(0); } while (0)
#define G_WAIT_V(n) asm volatile("s_waitcnt vmcnt(" #n ")" ::: "memory")
#define G_WAIT_L(n) asm volatile("s_waitcnt lgkmcnt(" #n ")" ::: "memory")
#define G_BAR __builtin_amdgcn_s_barrier()
#define G_SCHED __builtin_amdgcn_sched_barrier(0)
    Unit cur, nxt; int ui = 0;
    if (!ph.next(0, cur)) return;
    f32x4 acc[2][2][4][2];
#pragma unroll
    for (int a = 0; a < 2; ++a)
#pragma unroll
        for (int b = 0; b < 2; ++b)
#pragma unroll
            for (int m = 0; m < 4; ++m)
#pragma unroll
                for (int n = 0; n < 2; ++n) acc[a][b][m][n] = (f32x4){0.f, 0.f, 0.f, 0.f};
    bf16x8 At[4][2], B0[2][2], B1[2][2];
    unsigned co[2][2] = {{0u, 0u}, {0u, 0u}};
    const char* Ab = ph.Abase;
    const char* cA = Ab; const char* cB = ph.b_tile(cur);
    if constexpr (P::GATHER) { ph.a_offs(cur, tid, co); asm volatile("s_waitcnt vmcnt(0)" ::: "memory"); } else cA = ph.a_tile(cur);
    G_STB(G_SB(0, 0), cB); G_STB(G_SB(0, 1), cB + hB); G_STA(G_SA(0, 0), cA, 0, co, 0); G_STA(G_SA(0, 1), cA, 0, co, 1);
    if (wr == 1) G_BAR;
    G_WAIT_V(2); G_BAR;
    G_STB(G_SB(1, 0), cB + 128); G_STA(G_SA(1, 0), cA + 128, 128, co, 0); G_STB(G_SB(1, 1), cB + hB + 128);
    G_WAIT_V(6); G_BAR;
    for (;;) {
        const bool has_next = ph.next(ui + 1, nxt);
        const char* nA = cA; const char* nB = cB;
        if (has_next) { nB = ph.b_tile(nxt); if constexpr (!P::GATHER) nA = ph.a_tile(nxt); }
        for (int t = 0; t < nt; t += 2) {
            const bool last = (t == nt - 2);
            const int kb1 = (t + 1) * 128, kb2 = last ? 0 : (t + 2) * 128, kb3 = kb2 + 128;
            const char* a1 = cA + kb1; const char* a2 = last ? nA : cA + kb2; const char* a3 = a2 + 128;
            const char* b2 = last ? nB : cB + (t + 2) * 128; const char* b3 = b2 + 128;
            G_LDB(B0, 0, 0); G_LDB(B1, 0, 1); G_SCHED; G_LDA(At, 0, 0); G_STA(G_SA(1, 1), a1, kb1, co, 1);
            G_WAIT_V(8); G_WAIT_L(0); G_BAR; G_MMA(0, 0, At, B0); G_MMA(0, 1, At, B1); G_BAR; G_SCHED;
            if constexpr (P::GATHER) { if (last && has_next) ph.a_offs(nxt, tid, co); }
            G_LDA(At, 0, 1); G_STB(G_SB(0, 0), b2); G_STB(G_SB(0, 1), b2 + hB); G_STA(G_SA(0, 0), a2, kb2, co, 0);
            G_WAIT_V(8); G_WAIT_L(0); G_BAR; G_MMA(1, 0, At, B0); G_MMA(1, 1, At, B1); G_BAR; G_SCHED;
            G_LDB(B0, 1, 0); G_LDB(B1, 1, 1); G_SCHED; G_LDA(At, 1, 0); G_STA(G_SA(0, 1), a2, kb2, co, 1);
            G_WAIT_V(8); G_WAIT_L(0); G_BAR; G_MMA(0, 0, At, B0); G_MMA(0, 1, At, B1); G_BAR; G_SCHED;
            G_LDA(At, 1, 1); G_STB(G_SB(1, 0), b3); G_STB(G_SB(1, 1), b3 + hB); G_STA(G_SA(1, 0), a3, kb3, co, 0);
            G_WAIT_V(8); G_WAIT_L(0); G_BAR; G_MMA(1, 0, At, B0); G_MMA(1, 1, At, B1); G_BAR; G_SCHED;
        }
        if (wr == 0) G_BAR;
        ph.epi(acc, cur, wr, wc, fr, fq);
        if (!has_next) break;
#pragma unroll
        for (int a = 0; a < 2; ++a)
#pragma unroll
            for (int b = 0; b < 2; ++b)
#pragma unroll
                for (int m = 0; m < 4; ++m)
#pragma unroll
                    for (int n = 0; n < 2; ++n) acc[a][b][m][n] = (f32x4){0.f, 0.f, 0.f, 0.f};
        cur = nxt; cA = nA; cB = nB; ++ui;
        if (wr == 1) G_BAR;
    }
    G_WAIT_V(0);
    G_BAR;
}
}

using gm::Unit;
#define EPI_ARGS const f32x4 (&acc)[2][2][4][2], const Unit& u, int wr, int wc, int fr_in, int fq_in
#define EPI_OPAQUE int fr = fr_in, fq = fq_in; asm volatile("" : "+v"(fr), "+v"(fq));
#define NO_GATHER __device__ __forceinline__ void a_offs(const Unit&, int, unsigned (&)[2][2]) const {}
#define EPI_FENCE() asm volatile("" ::: "memory")
__device__ __forceinline__ u32x4 pack8(const f32x4& v0, const f32x4& v1) { u32x4 w; w.x = cvt_pk_bf16(v0[0], v0[1]); w.y = cvt_pk_bf16(v0[2], v0[3]); w.z = cvt_pk_bf16(v1[0], v1[1]); w.w = cvt_pk_bf16(v1[2], v1[3]); return w; }
__device__ __forceinline__ float fast_sigmoid(float v) { return __builtin_amdgcn_rcpf(1.f + __builtin_amdgcn_exp2f(-LOG2E * v)); }
__device__ __forceinline__ float fast_gelu(float v) { const float u2 = 1.5957691216057308f * (v + 0.044715f * v * v * v); return v * fast_sigmoid(u2); }

struct PhQKV {
    static constexpr bool GATHER = false; static constexpr int LDA = 1024, K = 1024, LDB = 1024, HSTEPB = 128 * 1024 * 2;
    unsigned char* ws; const char* Abase; int G, c;
    __device__ __forceinline__ bool next(int i, Unit& u) const { return gm::static_unit(i, G, c, M / 256, 12, u); }
    NO_GATHER __device__ __forceinline__ const char* a_tile(const Unit& u) const { return Abase + (size_t)(u.pm * 256) * 1024 * 2; }
    __device__ __forceinline__ const char* b_tile(const Unit& u) const { return (const char*)(ws + WS_WQKV) + (size_t)u.pn * 256 * 1024 * 2; }
    __device__ __forceinline__ void epi(EPI_ARGS) const { EPI_OPAQUE
        const int row0 = u.pm * 256 + wr * 64 + fr; const int t = u.pn >> 2; const int colt = (u.pn & 3) * 256;
        bf16* base = (bf16*)(ws + WS_Q) + (size_t)t * (16u * 1024u * 1024u); const float sc = (t == 0) ? C2 : 1.f;
        const int col0 = colt + wc * 32 + 8 * fq;
#pragma unroll
        for (int ai = 0; ai < 2; ++ai)
#pragma unroll
            for (int m = 0; m < 4; ++m) { bf16* rowp = base + (size_t)(row0 + ai * 128 + m * 16) * 1024 + col0;
#pragma unroll
                for (int bj = 0; bj < 2; ++bj) *(u32x4*)(rowp + bj * 128) = pack8(acc[ai][bj][m][0] * sc, acc[ai][bj][m][1] * sc); }
    }
};
struct PhWo {
    static constexpr bool GATHER = false; static constexpr int LDA = 1024, K = 1024, LDB = 1024, HSTEPB = 128 * 1024 * 2;
    unsigned char* ws; const char* Abase; const float* resid; float* out; int G, c;
    __device__ __forceinline__ bool next(int i, Unit& u) const { return gm::static_unit(i, G, c, M / 256, 4, u); }
    NO_GATHER __device__ __forceinline__ const char* a_tile(const Unit& u) const { return Abase + (size_t)(u.pm * 256) * 1024 * 2; }
    __device__ __forceinline__ const char* b_tile(const Unit& u) const { return (const char*)(ws + WS_WO) + (size_t)u.pn * 256 * 1024 * 2; }
    __device__ __forceinline__ void epi(EPI_ARGS) const { EPI_OPAQUE
        const int row0 = u.pm * 256 + wr * 64 + fr, col0 = u.pn * 256 + wc * 32 + 8 * fq; bf16* hb = (bf16*)(ws + WS_XN);
#pragma unroll
        for (int ai = 0; ai < 2; ++ai)
#pragma unroll
            for (int m = 0; m < 4; ++m) { const size_t off = (size_t)(row0 + ai * 128 + m * 16) * 1024 + col0;
#pragma unroll
                for (int bj = 0; bj < 2; ++bj) { const f32x4 r0 = *(const f32x4*)(resid + off + bj * 128), r1 = *(const f32x4*)(resid + off + bj * 128 + 4);
                    const f32x4 v0 = acc[ai][bj][m][0] + r0, v1 = acc[ai][bj][m][1] + r1;
                    *(f32x4*)(out + off + bj * 128) = v0; *(f32x4*)(out + off + bj * 128 + 4) = v1; *(u32x4*)(hb + off + bj * 128) = pack8(v0, v1); }
                EPI_FENCE(); }
    }
};
struct PhWout {
    static constexpr bool GATHER = false; static constexpr int LDA = 1024, K = 1024, LDB = 1024, HSTEPB = 128 * 1024 * 2;
    unsigned char* ws; const char* Abase; float* out; int G, c;
    __device__ __forceinline__ bool next(int i, Unit& u) const { return gm::static_unit(i, G, c, M / 256, 8, u); }
    NO_GATHER __device__ __forceinline__ const char* a_tile(const Unit& u) const { return Abase + (size_t)(u.pm * 256) * 1024 * 2; }
    __device__ __forceinline__ const char* b_tile(const Unit& u) const { return (const char*)(ws + WS_WOUT) + (size_t)u.pn * 256 * 1024 * 2; }
    __device__ __forceinline__ void epi(EPI_ARGS) const { EPI_OPAQUE
        const size_t off0 = (size_t)(u.pm * 256 + wr * 64 + fr) * 1024 + u.pn * 128 + wc * 32 + 8 * fq;
        float* po = out + off0; bf16* ph = (bf16*)(ws + WS_XN) + off0;
#pragma unroll
        for (int ai = 0; ai < 2; ++ai)
#pragma unroll
            for (int m = 0; m < 4; ++m) {
                const f32x4 r0 = *(const f32x4*)(po), r1 = *(const f32x4*)(po + 4);
                f32x4 v0, v1;
#pragma unroll
                for (int j = 0; j < 4; ++j) { v0[j] = r0[j] + acc[ai][0][m][0][j] * fast_sigmoid(acc[ai][1][m][0][j]); v1[j] = r1[j] + acc[ai][0][m][1][j] * fast_sigmoid(acc[ai][1][m][1][j]); }
                *(f32x4*)(po) = v0; *(f32x4*)(po + 4) = v1; *(u32x4*)(ph) = pack8(v0, v1);
                po += (m == 3 ? (128 - 48) : 16) * 1024; ph += (m == 3 ? (128 - 48) : 16) * 1024; asm volatile("" : "+v"(po), "+v"(ph) :: "memory"); }
    }
};
__device__ __forceinline__ void moe_locate(LAS unsigned char* lds, int tile, Unit& u) { const LAS int* cn = (const LAS int*)(lds + AUX_OFF); const LAS int* tb = cn + 32;
    int e = 0; while (e < 31 && tb[e + 1] <= tile) ++e; u.e = e; u.pm = tile - tb[e]; u.gt = tile; u.cnt = cn[e]; }
struct PhGateUp {
    static constexpr bool GATHER = true; static constexpr int LDA = 1024, K = 1024, LDB = 1024, HSTEPB = 128 * 1024 * 2;
    unsigned char* ws; const char* Abase; LAS unsigned char* lds; int G, c;
    __device__ __forceinline__ bool next(int i, Unit& u) const { const int idx = i * G + c; const int nt = ((const LAS int*)(lds + AUX_OFF))[64]; if (idx >= 2 * nt) return false; u.pn = idx & 1; moe_locate(lds, idx >> 1, u); return true; }
    __device__ __forceinline__ void a_offs(const Unit& u, int tid, unsigned (&o)[2][2]) const { const int* pdst = (const int*)(ws + WS_PDST);
#pragma unroll
        for (int i = 0; i < 2; ++i) { int R, C; gm::stage_rc(tid * 16 + i * 8192, R, C);
#pragma unroll
            for (int h = 0; h < 2; ++h) { int slot = u.pm * 256 + 128 * h + R; slot = slot < u.cnt ? slot : u.cnt - 1; const int tok = pdst[u.e * CAP + slot] >> 1; o[h][i] = (unsigned)(tok * 1024 + C) * 2u; } }
    }
    __device__ __forceinline__ const char* a_tile(const Unit&) const { return Abase; }
    __device__ __forceinline__ const char* b_tile(const Unit& u) const { return (const char*)(ws + WS_WGU) + ((size_t)u.e * 512 + u.pn * 256) * 1024 * 2; }
    __device__ __forceinline__ void epi(EPI_ARGS) const { EPI_OPAQUE
        const int r0 = wr * 64 + fr, col0 = u.pn * 128 + wc * 32 + 8 * fq; const float* ps = (const float*)(ws + WS_PS); bf16* H = (bf16*)(ws + WS_H);
#pragma unroll
        for (int ai = 0; ai < 2; ++ai)
#pragma unroll
            for (int m = 0; m < 4; ++m) { const int r = r0 + ai * 128 + m * 16; int slot = u.pm * 256 + r; slot = slot < u.cnt ? slot : u.cnt - 1; const float s = ps[u.e * CAP + slot];
                f32x4 v0, v1;
#pragma unroll
                for (int j = 0; j < 4; ++j) { const float g0 = acc[ai][0][m][0][j] * s, u0 = acc[ai][1][m][0][j] * s, g1 = acc[ai][0][m][1][j] * s, u1 = acc[ai][1][m][1][j] * s;
                    v0[j] = g0 * fast_sigmoid(g0) * u0; v1[j] = g1 * fast_sigmoid(g1) * u1; }
                *(u32x4*)(H + ((size_t)u.gt * 256 + r) * 256 + col0) = pack8(v0, v1);
                EPI_FENCE(); }
    }
};
struct PhDown {
    static constexpr bool GATHER = false; static constexpr int LDA = 256, K = 256, LDB = 256, HSTEPB = 128 * 256 * 2;
    unsigned char* ws; const char* Abase; LAS unsigned char* lds; int G, c;
    __device__ __forceinline__ bool next(int i, Unit& u) const { const int idx = i * G + c; const int nt = ((const LAS int*)(lds + AUX_OFF))[64]; if (idx >= 4 * nt) return false; u.pn = idx & 3; moe_locate(lds, idx >> 2, u); return true; }
    NO_GATHER __device__ __forceinline__ const char* a_tile(const Unit& u) const { return Abase + (size_t)(u.gt * 256) * 256 * 2; }
    __device__ __forceinline__ const char* b_tile(const Unit& u) const { return (const char*)(ws + WS_WD) + ((size_t)u.e * 1024 + u.pn * 256) * 256 * 2; }
    __device__ __forceinline__ void epi(EPI_ARGS) const { EPI_OPAQUE
        const int r0 = wr * 64 + fr, col0 = u.pn * 256 + wc * 32 + 8 * fq; const int* pdst = (const int*)(ws + WS_PDST); const float* pw = (const float*)(ws + WS_PW); bf16* Y2 = (bf16*)(ws + WS_Y2);
#pragma unroll
        for (int ai = 0; ai < 2; ++ai)
#pragma unroll
            for (int m = 0; m < 4; ++m) { const int r = r0 + ai * 128 + m * 16; const int slot = u.pm * 256 + r;
                if (slot < u.cnt) { const int dst = pdst[u.e * CAP + slot]; const float w8 = pw[u.e * CAP + slot];
#pragma unroll
                    for (int bj = 0; bj < 2; ++bj) *(u32x4*)(Y2 + (size_t)dst * 1024 + col0 + bj * 128) = pack8(acc[ai][bj][m][0] * w8, acc[ai][bj][m][1] * w8); }
                EPI_FENCE(); }
    }
};
struct PhSloc {
    static constexpr bool GATHER = false; static constexpr int LDA = 384, K = 256, LDB = 256, HSTEPB = 0;
    unsigned char* ws; const char* Abase; int G, c;
    __device__ __forceinline__ bool next(int i, Unit& u) const { const int idx = i * G + c; if (idx >= 256) return false; u.e = idx >> 2; u.pm = idx & 3; u.pn = 0; u.gt = 0; u.cnt = 0; return true; }
    NO_GATHER __device__ __forceinline__ const char* a_tile(const Unit& u) const { return Abase + (size_t)(u.e * 1024 + u.pm * 256) * 384 * 2; }
    __device__ __forceinline__ const char* b_tile(const Unit& u) const { return (const char*)(ws + WS_SSM) + (size_t)u.e * SSM_G_BYTES; }
    __device__ __forceinline__ void epi(EPI_ARGS) const { EPI_OPAQUE
        const int r0 = u.e * 1024 + u.pm * 256 + wr * 64 + fr, col0 = wc * 32 + 8 * fq; float* Sloc = (float*)(ws + WS_SLOC);
#pragma unroll
        for (int ai = 0; ai < 2; ++ai)
#pragma unroll
            for (int m = 0; m < 4; ++m) { float* p = Sloc + (size_t)(r0 + ai * 128 + m * 16) * 128 + col0; *(f32x4*)p = acc[ai][0][m][0]; *(f32x4*)(p + 4) = acc[ai][0][m][1]; }
    }
};
struct PhY {
    static constexpr bool GATHER = false; static constexpr int LDA = 384, K = 384, LDB = 384, HSTEPB = 128 * 384 * 2;
    unsigned char* ws; const char* Abase; int G, c;
    __device__ __forceinline__ bool next(int i, Unit& u) const { const int idx = i * G + c; if (idx >= 256) return false; u.e = idx >> 2; u.pm = idx & 3; u.pn = 0; u.gt = 0; u.cnt = 0; return true; }
    NO_GATHER __device__ __forceinline__ const char* a_tile(const Unit& u) const { return Abase + (size_t)(u.e * 1024 + u.pm * 256) * 384 * 2; }
    __device__ __forceinline__ const char* b_tile(const Unit& u) const { return (const char*)(ws + WS_SSM) + (size_t)u.e * SSM_G_BYTES + SSM_A2_OFF; }
    __device__ __forceinline__ void epi(EPI_ARGS) const { EPI_OPAQUE
        const int nb = (u.pm & 1) * 256 + wr * 64 + fr;
        bf16* p = (bf16*)(ws + WS_G) + ((size_t)(u.pm >> 1) * SEQ + 16 * nb + 2 * wc + (fq >> 1)) * 1024 + 16 * u.e + 8 * (fq & 1);
#pragma unroll
        for (int ai = 0; ai < 2; ++ai)
#pragma unroll
            for (int m = 0; m < 4; ++m) {
#pragma unroll
                for (int bj = 0; bj < 2; ++bj) { f32x4 v0, v1;
#pragma unroll
                    for (int j = 0; j < 4; ++j) { v0[j] = fast_gelu(acc[ai][bj][m][0][j]); v1[j] = fast_gelu(acc[ai][bj][m][1][j]); }
                    *(u32x4*)(p + bj * 8 * 1024) = pack8(v0, v1); }
                p += (m == 3 ? (128 - 48) : 16) * 16 * 1024; asm volatile("" : "+v"(p) :: "memory"); }
    }
};

namespace at {
constexpr int NSLOT = 3, SLOTB = 8192;
constexpr int LDS_K = 0, LDS_V = NSLOT * SLOTB, LDS_WS = 2 * NSLOT * SLOTB, LDS_TBL = LDS_WS + 2048, LDS_OST = LDS_TBL + 2048, LDS_TOTAL = LDS_OST + 8 * 4096;
typedef short v4i16_t __attribute__((ext_vector_type(4)));
__device__ __forceinline__ int crow(int r, int hi) { return (r & 3) + 8 * (r >> 2) + 4 * hi; }
__device__ __forceinline__ void glds16(const void* gsrc, unsigned lds_dst) { unsigned keep;
    asm volatile("s_mov_b32 %0, m0\n\ts_mov_b32 m0, %2\n\ts_nop 0\n\tglobal_load_lds_dwordx4 %1, off\n\ts_mov_b32 m0, %0" : "=&s"(keep) : "v"(gsrc), "s"(lds_dst) : "memory"); }
__device__ __forceinline__ s16x4 vtr(const LAS unsigned char* p) { return __builtin_bit_cast(s16x4, __builtin_amdgcn_ds_read_tr16_b64_v4i16((LAS v4i16_t*)p)); }
#define AT_WAIT_BAR(N) asm volatile("s_waitcnt vmcnt(" #N ") lgkmcnt(0)\n\ts_barrier" ::: "memory")
template <int THR> __device__ __forceinline__ void attn_unit(int b, int h, int qb, const bf16* Q, const bf16* __restrict__ K, const bf16* __restrict__ V, bf16* O, const float* __restrict__ relb, LAS unsigned char* shm) {
    const int tid = threadIdx.x, lane = tid & 63, r32 = lane & 31, hi = lane >> 5; const int wid = __builtin_amdgcn_readfirstlane(tid >> 6);
    const long rowbase = (long)b * SEQ; const int q0 = qb * 256; const int cq = 4 * qb + (wid >> 1);
    const bf16* Qw = Q + (rowbase + q0 + wid * 32) * D + h * 64;
    const unsigned lds0 = (unsigned)(uintptr_t)shm;
    LAS float* wsf = (LAS float*)(shm + LDS_WS) + wid * 64; LAS float* tbl = (LAS float*)(shm + LDS_TBL);
    const int kc_lo = (4 * qb - 8) < 0 ? 0 : (4 * qb - 8); const int NT = 4 * qb + 3 - kc_lo + 1;
    if (tid < 320) tbl[tid] = relb[h * NREL + (tid < 256 ? tid : 256)] * LOG2E;
    const bf16* ksrc = K + (rowbase + kc_lo * 64 + lane) * D + h * 64 + wid * 8;
    const bf16* vsrc = V + (rowbase + kc_lo * 64 + 16 * (wid & 3) + (lane >> 2)) * D + h * 64 + (wid >> 2) * 32 + (lane & 3) * 8;
    const unsigned kdst = lds0 + LDS_K + wid * 1024, vdst = lds0 + LDS_V + wid * 1024;
#define AT_DMA(t, slotoff) do { glds16(ksrc + (long)(t) * 64 * D, (unsigned)__builtin_amdgcn_readfirstlane(kdst + (slotoff))); glds16(vsrc + (long)(t) * 64 * D, (unsigned)__builtin_amdgcn_readfirstlane(vdst + (slotoff))); } while (0)
    bf16x8 qr[4];
#pragma unroll
    for (int d0 = 0; d0 < 4; ++d0) qr[d0] = *reinterpret_cast<const bf16x8*>(&Qw[(long)r32 * D + d0 * 16 + hi * 8]);
    asm volatile("s_waitcnt vmcnt(0)" ::: "memory");
    AT_DMA(0, 0); if (NT > 1) AT_DMA(1, SLOTB);
    float mrow = -1e30f, lsum = 0.f; f32x16 o[2]; o[0] = f32x16{}; o[1] = f32x16{};
    int sl_cur = 0, sl_nn = 2 * SLOTB;
    for (int t = 0; t < NT; ++t) {
        const int kc = kc_lo + t;
        if (t + 1 < NT) { AT_WAIT_BAR(2); } else { AT_WAIT_BAR(0); }
        if (t + 2 < NT) AT_DMA(t + 2, sl_nn);
        if (kc >= cq - 8 && kc <= cq) {
            const LAS unsigned char* kp = shm + LDS_K + sl_cur + hi * 1024 + r32 * 16;
            f32x16 p0 = f32x16{}, p1 = f32x16{};
#pragma unroll
            for (int d0 = 0; d0 < 4; ++d0) { const bf16x8 b0 = *(const LAS bf16x8*)(kp + d0 * 2048), b1 = *(const LAS bf16x8*)(kp + d0 * 2048 + 512);
                p0 = __builtin_amdgcn_mfma_f32_32x32x16_bf16(b0, qr[d0], p0, 0, 0, 0); p1 = __builtin_amdgcn_mfma_f32_32x32x16_bf16(b1, qr[d0], p1, 0, 0, 0); }
            const int delta = cq - kc;
            if (delta >= 3) { const float bf = tbl[256];
#pragma unroll
                for (int r = 0; r < 16; ++r) { p0[r] += bf; p1[r] += bf; } }
            else { const LAS float* tb = tbl + (64 * delta + 32 * (wid & 1) + r32 + 128 - 4 * hi);
#pragma unroll
                for (int r = 0; r < 16; ++r) { const int kj = (r & 3) + 8 * (r >> 2); p0[r] += tb[-kj]; p1[r] += tb[-kj - 32]; } }
            float rm = fmaxf(p0[0], p1[0]);
#pragma unroll
            for (int r = 1; r < 16; ++r) rm = fmaxf(rm, fmaxf(p0[r], p1[r]));
            { auto rr = __builtin_amdgcn_permlane32_swap(__float_as_uint(rm), __float_as_uint(rm), false, false); rm = fmaxf(__uint_as_float(rr[0]), __uint_as_float(rr[1])); }
            if (__any(rm > mrow + (float)THR)) {
                const float mn = fmaxf(mrow, rm), f = __builtin_amdgcn_exp2f(mrow - mn); mrow = mn; lsum *= f;
                if (hi == 0) wsf[r32] = f;
                LDS_WAIT();
#pragma unroll
                for (int r = 0; r < 16; ++r) { const float fr_ = wsf[crow(r, hi)]; o[0][r] *= fr_; o[1][r] *= fr_; }
            }
            float sacc = 0.f;
#pragma unroll
            for (int r = 0; r < 16; ++r) { p0[r] = __builtin_amdgcn_exp2f(p0[r] - mrow); p1[r] = __builtin_amdgcn_exp2f(p1[r] - mrow); sacc += p0[r] + p1[r]; }
            lsum += sacc;
            u32x4 pw0, pw1, pw2, pw3;
            pw0 = (u32x4){cvt_pk_bf16(p0[0], p0[1]), cvt_pk_bf16(p0[2], p0[3]), cvt_pk_bf16(p0[4], p0[5]), cvt_pk_bf16(p0[6], p0[7])};
            pw1 = (u32x4){cvt_pk_bf16(p0[8], p0[9]), cvt_pk_bf16(p0[10], p0[11]), cvt_pk_bf16(p0[12], p0[13]), cvt_pk_bf16(p0[14], p0[15])};
            pw2 = (u32x4){cvt_pk_bf16(p1[0], p1[1]), cvt_pk_bf16(p1[2], p1[3]), cvt_pk_bf16(p1[4], p1[5]), cvt_pk_bf16(p1[6], p1[7])};
            pw3 = (u32x4){cvt_pk_bf16(p1[8], p1[9]), cvt_pk_bf16(p1[10], p1[11]), cvt_pk_bf16(p1[12], p1[13]), cvt_pk_bf16(p1[14], p1[15])};
            const bf16x8 pa[4] = {__builtin_bit_cast(bf16x8, pw0), __builtin_bit_cast(bf16x8, pw1), __builtin_bit_cast(bf16x8, pw2), __builtin_bit_cast(bf16x8, pw3)};
            const LAS unsigned char* vp = shm + LDS_V + sl_cur + ((lane >> 4) & 1) * 32 + (lane & 3) * 8 + (4 * hi + ((lane & 15) >> 2)) * 64;
#pragma unroll
            for (int d0 = 0; d0 < 2; ++d0)
#pragma unroll
                for (int ks = 0; ks < 4; ++ks) { const s16x4 lo = vtr(vp + d0 * 4096 + ks * 1024), hh = vtr(vp + d0 * 4096 + ks * 1024 + 512);
                    const bf16x8 vf = (bf16x8){lo[0], lo[1], lo[2], lo[3], hh[0], hh[1], hh[2], hh[3]};
                    o[d0] = __builtin_amdgcn_mfma_f32_32x32x16_bf16(pa[ks], vf, o[d0], 0, 0, 0); }
        }
        sl_cur = (sl_cur == 2 * SLOTB) ? 0 : sl_cur + SLOTB; sl_nn = (sl_nn == 2 * SLOTB) ? 0 : sl_nn + SLOTB;
    }
    { auto rr = __builtin_amdgcn_permlane32_swap(__float_as_uint(lsum), __float_as_uint(lsum), false, false); lsum = __uint_as_float(rr[0]) + __uint_as_float(rr[1]); }
    if (hi == 0) wsf[32 + r32] = lsum;
    LDS_WAIT();
    float rli[16];
#pragma unroll
    for (int r = 0; r < 16; ++r) rli[r] = __builtin_amdgcn_rcpf(wsf[32 + crow(r, hi)]);
    bf16* Ow = O + (rowbase + q0 + wid * 32) * D + h * 64;
    { LAS bf16* stg = (LAS bf16*)(shm + LDS_OST) + wid * 2048;
#pragma unroll
      for (int r = 0; r < 16; ++r) { const int orow = crow(r, hi);
#pragma unroll
          for (int d0 = 0; d0 < 2; ++d0) stg[orow * 64 + d0 * 32 + r32] = f2bf(o[d0][r] * rli[r]); }
      LDS_WAIT();
#pragma unroll
      for (int i = 0; i < 4; ++i) { const int row = i * 8 + (lane >> 3), ch = lane & 7; const u32x4 v = *(const LAS u32x4*)(stg + row * 64 + ch * 8); *(u32x4*)(Ow + (long)row * D + ch * 8) = v; } }
    asm volatile("s_waitcnt lgkmcnt(0)\n\ts_barrier" ::: "memory");
#undef AT_DMA
}
}

struct Args { const float* in[23]; float* out; unsigned char* ws; int ph_lo, ph_hi, li, pad; };

__device__ __forceinline__ void tr_item(const float* __restrict__ W, int ldw, int k0, int n0, bf16* __restrict__ WT, int ldt, int drow0, const float* __restrict__ ks, LAS float* scr, int lane) {
#pragma unroll 8
    for (int i = 0; i < 32; ++i) { const int kk = 2 * i + (lane >> 5); float v = W[(size_t)(k0 + kk) * ldw + n0 + (lane & 31)]; if (ks) v *= ks[k0 + kk]; scr[kk * 33 + (lane & 31)] = v; }
    LDS_WAIT(); asm volatile("" ::: "memory");
    const int c = lane & 7;
#pragma unroll
    for (int j = 0; j < 4; ++j) { const int n = (lane >> 3) + 8 * j; const LAS float* s = scr + (8 * c) * 33 + n;
        u32x4 o; o.x = pk2(s[0 * 33], s[1 * 33]); o.y = pk2(s[2 * 33], s[3 * 33]); o.z = pk2(s[4 * 33], s[5 * 33]); o.w = pk2(s[6 * 33], s[7 * 33]);
        *(u32x4*)(WT + (size_t)(drow0 + n) * ldt + k0 + 8 * c) = o; }
    LDS_WAIT(); asm volatile("" ::: "memory");
}
__device__ __forceinline__ void moe_convert(const float* wg, const float* wu, const float* wd, const float* gn, bf16* WGU, bf16* WD, LAS float* scr, int gw, int NGW, int lane) {
    for (int it = gw; it < 12288; it += NGW) {
        if (it < 8192) { const int which = it >> 12, r = it & 4095, e = r >> 7, kb = (r >> 3) & 15, nb = r & 7, n0 = nb * 32;
            tr_item((which ? wu : wg) + (size_t)e * 1024 * 256, 256, kb * 64, n0, WGU, 1024, e * 512 + 256 * (n0 >> 7) + 128 * which + (n0 & 127), gn, scr, lane); }
        else { const int r = it - 8192, e = r >> 7, kb = (r >> 5) & 3, nb = r & 31;
            tr_item(wd + (size_t)e * 256 * 1024, 1024, kb * 64, nb * 32, WD, 256, e * 1024 + nb * 32, nullptr, scr, lane); }
    }
}
__device__ __forceinline__ void ssm_mats(int g, const float* lre, const float* lim, const float* lstep, const float* bre, const float* bim, const float* cre, const float* cim, const float* dsk,
                                         unsigned char* ssm_ws, float* a16g, LAS float* L, int tid) {
    LAS float* pwr = L; LAS float* pwi = L + 64 * 17; LAS float* bbr = L + 2 * 64 * 17; LAS float* bbi = bbr + 1024; LAS float* ccr = bbi + 1024; LAS float* cci = ccr + 1024; LAS float* Kt = cci + 1024;
    if (tid < 64) { const int p = tid;
        const float lr = fminf(lre[g * 64 + p], -1e-4f), li = lim[g * 64 + p], step = expf(lstep[g]);
        const float decay = expf(lr * step), ang = li * step, ar = decay * cosf(ang), ai = decay * sinf(ang);
        const float den = lr * lr + li * li, nr = ar - 1.f, fr = (nr * lr + ai * li) / den, fi = (ai * lr - nr * li) / den;
        for (int c = 0; c < 16; ++c) { const float br = bre[(g * 64 + p) * 16 + c], bi = bim[(g * 64 + p) * 16 + c]; bbr[p * 16 + c] = fr * br - fi * bi; bbi[p * 16 + c] = fr * bi + fi * br;
            ccr[c * 64 + p] = cre[(g * 16 + c) * 64 + p]; cci[c * 64 + p] = cim[(g * 16 + c) * 64 + p]; }
        for (int n = 0; n <= 16; ++n) { const float dn = expf((float)n * lr * step), an = (float)n * ang; pwr[p * 17 + n] = dn * cosf(an); pwi[p * 17 + n] = dn * sinf(an); }
        a16g[(g * 64 + p) * 2] = pwr[p * 17 + 16]; a16g[(g * 64 + p) * 2 + 1] = pwi[p * 17 + 16];
    }
    __syncthreads();
    for (int o = tid; o < 4096; o += NTHR) { const int tau = o >> 8, c = (o >> 4) & 15, c2 = o & 15; float s = 0.f;
        for (int p = 0; p < 64; ++p) { const float cr = ccr[c * 64 + p], ci = cci[c * 64 + p], ar = pwr[p * 17 + tau], ai = pwi[p * 17 + tau], br = bbr[p * 16 + c2], bi = bbi[p * 16 + c2];
            const float tr = cr * ar - ci * ai, ti = cr * ai + ci * ar; s += tr * br - ti * bi; }
        if (tau == 0 && c == c2) s += dsk[g * 16 + c];
        Kt[o] = s; }
    __syncthreads();
    bf16* Bend = (bf16*)(ssm_ws + (size_t)g * SSM_G_BYTES); bf16* A2 = (bf16*)(ssm_ws + (size_t)g * SSM_G_BYTES + SSM_A2_OFF);
    for (int o = tid; o < 256 * 48; o += NTHR) { const int n = o / 48, k8 = (o % 48) * 8, i = n >> 4, c = n & 15; float v[8];
#pragma unroll
        for (int q = 0; q < 8; ++q) { const int k = k8 + q;
            if (k < 256) { const int j = k >> 4, c2 = k & 15; v[q] = (j <= i) ? Kt[(i - j) * 256 + c * 16 + c2] : 0.f; }
            else { const int p = (k - 256) >> 1, ri = k & 1; const float cr = ccr[c * 64 + p], ci = cci[c * 64 + p], ar = pwr[p * 17 + i + 1], ai = pwi[p * 17 + i + 1];
                v[q] = ri ? -(cr * ai + ci * ar) : (cr * ar - ci * ai); } }
        u32x4 w; w.x = pk2(v[0], v[1]); w.y = pk2(v[2], v[3]); w.z = pk2(v[4], v[5]); w.w = pk2(v[6], v[7]); *(u32x4*)(A2 + (size_t)n * 384 + k8) = w; }
    for (int o = tid; o < 128 * 32; o += NTHR) { const int n = o >> 5, k8 = (o & 31) * 8, p = n >> 1, ri = n & 1; float v[8];
#pragma unroll
        for (int q = 0; q < 8; ++q) { const int k = k8 + q, j = k >> 4, c2 = k & 15; const float ar = pwr[p * 17 + 15 - j], ai = pwi[p * 17 + 15 - j], br = bbr[p * 16 + c2], bi = bbi[p * 16 + c2];
            v[q] = ri ? (ar * bi + ai * br) : (ar * br - ai * bi); }
        u32x4 w; w.x = pk2(v[0], v[1]); w.y = pk2(v[2], v[3]); w.z = pk2(v[4], v[5]); w.w = pk2(v[6], v[7]); *(u32x4*)(Bend + (size_t)n * 256 + k8) = w; }
    __syncthreads();
}

__device__ __forceinline__ void router_phase(const float* __restrict__ h, const float* __restrict__ rwt, const float* __restrict__ bgr, const float* __restrict__ ber, unsigned* cntg,
                                             int* pdst, float* pw, float* ps, float* srow, LAS unsigned char* lds, int vcu, int G) {
    const int tid = threadIdx.x, lane = tid & 63, wid = __builtin_amdgcn_readfirstlane(tid >> 6);
    LAS float* Wl = (LAS float*)lds;
    for (int i = tid; i < RW_LAYER / 4; i += NTHR) ((LAS f32x4*)Wl)[i] = ((const f32x4*)rwt)[i];
    LAS int* lc = (LAS int*)(lds + RSCR_OFF); LAS int* lbase = lc + 32;
    const int rb = wid & 3, kh = wid >> 2, row = lane & 15, kq = lane >> 4;
    for (int blk = vcu; blk < M / 64; blk += G) {
        if (tid < 32) lc[tid] = 0;
        __syncthreads();
        const int t0 = blk * 64;
        const float* hp = h + (size_t)(t0 + 16 * rb + row) * D + 512 * kh + 4 * kq;
        const LAS float* wp0 = Wl + row * RW_PITCH + 512 * kh + 4 * kq; const LAS float* wp1 = wp0 + 16 * RW_PITCH; const LAS float* wp2 = Wl + (32 + (row & 3)) * RW_PITCH + 512 * kh + 4 * kq;
        f32x4 a0 = {0.f, 0.f, 0.f, 0.f}, a1 = a0, a2 = a0; float ssl = 0.f;
#pragma unroll 4
        for (int j = 0; j < 32; ++j) { const f32x4 a = *(const f32x4*)(hp + 16 * j); const f32x4 b0 = *(const LAS f32x4*)(wp0 + 16 * j), b1 = *(const LAS f32x4*)(wp1 + 16 * j), b2 = *(const LAS f32x4*)(wp2 + 16 * j);
            ssl += a[0] * a[0] + a[1] * a[1] + a[2] * a[2] + a[3] * a[3];
#pragma unroll
            for (int i = 0; i < 4; ++i) { a0 = __builtin_amdgcn_mfma_f32_16x16x4f32(a[i], b0[i], a0, 0, 0, 0); a1 = __builtin_amdgcn_mfma_f32_16x16x4f32(a[i], b1[i], a1, 0, 0, 0); a2 = __builtin_amdgcn_mfma_f32_16x16x4f32(a[i], b2[i], a2, 0, 0, 0); } }
        ssl += __shfl_xor(ssl, 16); ssl += __shfl_xor(ssl, 32);
        LAS float* P = (LAS float*)(lds + RSCR_OFF + 256);
        LAS float* pp = P + (16 * rb) * 40;
        if (kh == 1) {
#pragma unroll
            for (int r = 0; r < 4; ++r) { const int tk = 4 * kq + r; pp[tk * 40 + row] = a0[r]; pp[tk * 40 + 16 + row] = a1[r]; if (row < 4) pp[tk * 40 + 32 + row] = a2[r]; }
            if (kq == 0) pp[row * 40 + 36] = ssl; }
        __syncthreads();
        if (kh == 0) {
#pragma unroll
            for (int r = 0; r < 4; ++r) { const int tk = 4 * kq + r; pp[tk * 40 + row] += a0[r]; pp[tk * 40 + 16 + row] += a1[r]; if (row < 4) pp[tk * 40 + 32 + row] += a2[r]; }
            if (kq == 0) pp[row * 40 + 36] += ssl; }
        __syncthreads();
        int e1 = 0, e2 = 0; float w1 = 0.f, w2 = 0.f, s = 0.f; int sl1 = 0, sl2 = 0;
        if (tid < 64) { LAS float* p0 = P + tid * 40;
            s = rsqrtf(p0[36] * (1.f / D) + RMS_EPS);
            for (int o = 0; o < 36; ++o) p0[o] = p0[o] * s + (o < 4 ? bgr[o] : ber[o - 4]);
            int gi = 0; float gmx = p0[0];
            for (int i = 1; i < 4; ++i) if (p0[i] > gmx) { gmx = p0[i]; gi = i; }
            float den = 0.f; for (int i = 0; i < 4; ++i) den += __expf(p0[i] - gmx);
            const float gp = 1.f / den; const LAS float* sl = p0 + 4 + 8 * gi;
            int i1 = 0; float l1 = sl[0]; for (int i = 1; i < 8; ++i) if (sl[i] > l1) { l1 = sl[i]; i1 = i; }
            int i2 = -1; float l2 = -3.4e38f; for (int i = 0; i < 8; ++i) if (i != i1 && sl[i] > l2) { l2 = sl[i]; i2 = i; }
            const float ex = __expf(l2 - l1); w1 = gp / (1.f + ex); w2 = gp * ex / (1.f + ex); e1 = gi * 8 + i1; e2 = gi * 8 + i2;
            sl1 = __hip_atomic_fetch_add(&lc[e1], 1, __ATOMIC_RELAXED, __HIP_MEMORY_SCOPE_WORKGROUP); sl2 = __hip_atomic_fetch_add(&lc[e2], 1, __ATOMIC_RELAXED, __HIP_MEMORY_SCOPE_WORKGROUP);
            srow[t0 + tid] = s; }
        __syncthreads();
        if (tid < 32) { const int n = lc[tid]; lbase[tid] = n ? (int)__hip_atomic_fetch_add(cntg + tid * 64, (unsigned)n, RLX_AGENT) : 0; }
        __syncthreads();
        if (tid < 64) { const int t = t0 + tid; int i1 = lbase[e1] + sl1, i2 = lbase[e2] + sl2;
            if (i1 < CAP) { pdst[e1 * CAP + i1] = 2 * t; pw[e1 * CAP + i1] = w1; ps[e1 * CAP + i1] = s; }
            if (i2 < CAP) { pdst[e2 * CAP + i2] = 2 * t + 1; pw[e2 * CAP + i2] = w2; ps[e2 * CAP + i2] = s; } }
        __syncthreads();
    }
}

template <bool FINAL> __device__ __forceinline__ void combine_phase(float* hio, const bf16* __restrict__ Y2, const float* __restrict__ g, bf16* __restrict__ xng, int vcu, int G, int wid, int lane) {
    for (int base = vcu * 16; base < M; base += G * 16) {
#pragma unroll
        for (int rr = 0; rr < 2; ++rr) { const int row = base + 2 * wid + rr;
            float4* hr = (float4*)(hio + (size_t)row * D); float4 v[4]; float ss = 0.f;
#pragma unroll
            for (int j = 0; j < 4; ++j) { v[j] = hr[lane + 64 * j]; const int c = 4 * (lane + 64 * j);
                const u32x2 ya = *(const u32x2*)(Y2 + ((size_t)2 * row) * D + c), yb = *(const u32x2*)(Y2 + ((size_t)2 * row + 1) * D + c);
                v[j].x += __uint_as_float(ya.x << 16) + __uint_as_float(yb.x << 16); v[j].y += __uint_as_float(ya.x & 0xffff0000u) + __uint_as_float(yb.x & 0xffff0000u);
                v[j].z += __uint_as_float(ya.y << 16) + __uint_as_float(yb.y << 16); v[j].w += __uint_as_float(ya.y & 0xffff0000u) + __uint_as_float(yb.y & 0xffff0000u);
                ss += v[j].x * v[j].x + v[j].y * v[j].y + v[j].z * v[j].z + v[j].w * v[j].w; if (!FINAL) hr[lane + 64 * j] = v[j]; }
            ss = wave_sum(ss); const float s = rsqrtf(ss * (1.f / D) + RMS_EPS);
#pragma unroll
            for (int j = 0; j < 4; ++j) { const int c = 4 * (lane + 64 * j); const float4 gg = *(const float4*)(g + c);
                const float ox = v[j].x * s * gg.x, oy = v[j].y * s * gg.y, oz = v[j].z * s * gg.z, ow = v[j].w * s * gg.w;
                if (FINAL) { float4 o; o.x = ox; o.y = oy; o.z = oz; o.w = ow; hr[lane + 64 * j] = o; }
                else { u32x2 w; w.x = pk2(ox, oy); w.y = pk2(oz, ow); *(u32x2*)(xng + xng_off(row, c)) = w; } } }
    }
}

__device__ __forceinline__ void scan_phase(const float* __restrict__ Sloc, const float* __restrict__ a16g, bf16* xng, LAS unsigned char* lds, int vcu, int G) {
    const int tid = threadIdx.x, p = tid & 63, q = tid >> 6;
    LAS float* E = (LAS float*)(lds + AUX_OFF);
    for (int bg = vcu; bg < 128; bg += G) { const int g = bg >> 1, b = bg & 1;
        const float ar = a16g[(g * 64 + p) * 2], ai = a16g[(g * 64 + p) * 2 + 1];
        const float* sp = Sloc + ((size_t)g * 1024 + b * 512 + q * 64) * 128 + 2 * p;
        float xr = 0.f, xi = 0.f;
#pragma unroll 8
        for (int s = 0; s < 64; ++s) { const float2 v = *(const float2*)(sp + (size_t)s * 128); const float nr = ar * xr - ai * xi + v.x, ni = ar * xi + ai * xr + v.y; xr = nr; xi = ni; }
        E[(q * 64 + p) * 2] = xr; E[(q * 64 + p) * 2 + 1] = xi;
        __syncthreads();
        float pr = ar, pi = ai;
#pragma unroll
        for (int k = 0; k < 6; ++k) { const float nr = pr * pr - pi * pi, ni = 2.f * pr * pi; pr = nr; pi = ni; }
        xr = 0.f; xi = 0.f;
        for (int qq = 0; qq < q; ++qq) { const float er = E[(qq * 64 + p) * 2], ei = E[(qq * 64 + p) * 2 + 1]; const float nr = pr * xr - pi * xi + er, ni = pr * xi + pi * xr + ei; xr = nr; xi = ni; }
        bf16* xp = xng + ((size_t)g * 1024 + b * 512 + q * 64) * 384 + 256 + 2 * p;
#pragma unroll 8
        for (int s = 0; s < 64; ++s) { *(unsigned*)(xp + (size_t)s * 384) = pk2(xr, xi); const float2 v = *(const float2*)(sp + (size_t)s * 128); const float nr = ar * xr - ai * xi + v.x, ni = ar * xi + ai * xr + v.y; xr = nr; xi = ni; }
        __syncthreads();
    }
}

__global__ void __launch_bounds__(NTHR, 2) mk_fwd(Args args) {
    extern __shared__ __attribute__((aligned(16))) unsigned char lds_[];
    LAS unsigned char* lds = (LAS unsigned char*)lds_;
    volatile LAS unsigned* MISC = (volatile LAS unsigned*)(lds + MISC_OFF);
    const int tid = threadIdx.x, lane = tid & 63, wid = __builtin_amdgcn_readfirstlane(tid >> 6);
    const int G = gridDim.x; const int bx = blockIdx.x; const int vcu = (G % 8 == 0) ? (bx % 8) * (G / 8) + bx / 8 : bx;
    unsigned char* const ws = args.ws;
    constexpr size_t EW = (size_t)NEXP * 1024 * 256;
    for (int u = tid; u < (LDS_BYTES - MISC_OFF) / 4; u += NTHR) ((LAS unsigned*)(lds + MISC_OFF))[u] = 0u;
    __syncthreads();
    const int lo = args.ph_lo, hi = args.ph_hi;
    XcdBarrier bar; bar.bar = (unsigned*)ws + CW_BAR + args.li * XCD_BAR_WORDS; bar.x = 0; bar.st = nullptr;
    if (hi - lo > 1) bar = xcd_barrier_post((unsigned*)ws + CW_BAR + args.li * XCD_BAR_WORDS, MISC + 8);
    const int gw = vcu * NWAVES + wid, NGW = G * NWAVES;
#ifndef PH_ONLY
#define PH_ONLY -1
#endif
#define IN(k) ((PH_ONLY < 0 || PH_ONLY == ((k) >= 12 && (k) <= 14 ? (k) - 8 : (k))) && lo <= (k) && (k) < hi)
#define SEAM(k) do { if ((k) + 1 < hi) xcd_barrier(bar); } while (0)
#define SCR ((LAS float*)(lds + wid * 16384))
    if (IN(0)) {
        const float* w_qkv = args.in[4]; const float* w_o = args.in[5]; const float* w_out = args.in[15];
        for (int it = gw; it < 3072; it += NGW) {
            if (it < 1536) { const int kb = it / 96, nb = it % 96; tr_item(w_qkv, 3072, kb * 64, nb * 32, (bf16*)(ws + WS_WQKV), 1024, nb * 32, nullptr, SCR, lane); }
            else if (it < 2048) { const int r = it - 1536, kb = r >> 5, nb = r & 31; tr_item(w_o, 1024, kb * 64, nb * 32, (bf16*)(ws + WS_WO), 1024, nb * 32, nullptr, SCR, lane); }
            else { const int r = it - 2048, kb = r >> 6, nb = r & 63, n0 = nb * 32, ag = n0 >> 10, cc = n0 & 1023; tr_item(w_out, 2048, kb * 64, n0, (bf16*)(ws + WS_WOUT), 1024, 256 * (cc >> 7) + 128 * ag + (cc & 127), nullptr, SCR, lane); }
        }
        moe_convert(args.in[20], args.in[21], args.in[22], args.in[2], (bf16*)(ws + WS_WGU), (bf16*)(ws + WS_WD), SCR, gw, NGW, lane);
        { float* rwt = (float*)(ws + WS_RWT); const float* norm_ffn = args.in[2];
          for (int o = bx * NTHR + tid; o < 2 * 36 * 1024; o += G * NTHR) { const int layer = o / (36 * 1024), r = o % (36 * 1024), col = r >> 10, k = r & 1023;
            const float gnk = norm_ffn[layer * D + k];
            const float w = col < 4 ? args.in[16][(size_t)layer * 4096 + k * 4 + col] : args.in[18][(size_t)layer * 32768 + ((size_t)((col - 4) >> 3) * 1024 + k) * 8 + ((col - 4) & 7)];
            rwt[layer * RW_LAYER + col * RW_PITCH + k] = w * gnk; } }
        __syncthreads();
        for (int g = vcu; g < 64; g += G) ssm_mats(g, args.in[7], args.in[8], args.in[9], args.in[10], args.in[11], args.in[12], args.in[13], args.in[14], ws + WS_SSM, (float*)(ws + WS_A16), (LAS float*)lds, tid);
        { const float* x = args.in[0]; const float* norm_mix = args.in[1]; bf16* XN = (bf16*)(ws + WS_XN);
          for (int m = gw; m < M; m += NGW) { const float4* xr = (const float4*)(x + (size_t)m * D); float4 v[4]; float ss = 0.f;
#pragma unroll
            for (int j = 0; j < 4; ++j) { v[j] = xr[lane + 64 * j]; ss += v[j].x * v[j].x + v[j].y * v[j].y + v[j].z * v[j].z + v[j].w * v[j].w; }
            ss = wave_sum(ss); const float s = rsqrtf(ss * (1.f / D) + RMS_EPS);
#pragma unroll
            for (int j = 0; j < 4; ++j) { const int c = 4 * (lane + 64 * j); const float4 gg = *(const float4*)(norm_mix + c); u32x2 w; w.x = pk2(v[j].x * s * gg.x, v[j].y * s * gg.y); w.y = pk2(v[j].z * s * gg.z, v[j].w * s * gg.w);
                *(u32x2*)(XN + (size_t)m * D + c) = w; } } }
        SEAM(0);
    }
    if (IN(1)) { PhQKV P{ws, (const char*)(ws + WS_XN), G, bx}; gm::gemm_phase(lds, P); SEAM(1); }
    if (IN(2)) {
        const int per = 1024 / G;
        for (int i = 0; i < per; ++i) { const int uid = vcu * per + i; const int bh = uid >> 5, qb = uid & 31;
            at::attn_unit<8>(bh >> 4, bh & 15, qb, (const bf16*)(ws + WS_Q), (const bf16*)(ws + WS_K), (const bf16*)(ws + WS_V), (bf16*)(ws + WS_Q), args.in[6], lds); }
        SEAM(2);
    }
    if (IN(3)) { PhWo P{ws, (const char*)(ws + WS_Q), args.in[0], args.out, G, bx}; gm::gemm_phase(lds, P); SEAM(3); }
#define MOE_LAYER(layer, pr) \
    if (IN(pr)) { router_phase(args.out, (const float*)(ws + WS_RWT) + (layer) * RW_LAYER, args.in[17] + (layer) * 4, args.in[19] + (layer) * 32, (unsigned*)ws + CW_CNT + (layer) * 32 * 64, \
                               (int*)(ws + WS_PDST), (float*)(ws + WS_PW), (float*)(ws + WS_PS), (float*)(ws + WS_SROW), lds, vcu, G); SEAM(pr); } \
    if (IN((pr) + 1) || IN((pr) + 2)) { \
        LAS int* cn = (LAS int*)(lds + AUX_OFF); LAS int* tb = cn + 32; \
        if (tid < 32) { const unsigned c = __hip_atomic_load((unsigned*)ws + CW_CNT + ((layer) * 32 + tid) * 64, RLX_AGENT); cn[tid] = c < (unsigned)CAP ? (int)c : CAP; } \
        __syncthreads(); \
        if (tid == 0) { int a = 0; for (int e = 0; e < 32; ++e) { tb[e] = a; a += (cn[e] + 255) >> 8; } tb[32] = a; } \
        __syncthreads(); \
        if (IN((pr) + 1)) { PhGateUp P{ws, (const char*)(ws + WS_XN), lds, G, vcu}; gm::gemm_phase(lds, P); SEAM((pr) + 1); } \
        if (IN((pr) + 2)) { PhDown P{ws, (const char*)(ws + WS_H), lds, G, vcu}; gm::gemm_phase(lds, P); SEAM((pr) + 2); } \
    }
    MOE_LAYER(0, 4)
    if (IN(7)) {
        moe_convert(args.in[20] + EW, args.in[21] + EW, args.in[22] + EW, args.in[2] + D, (bf16*)(ws + WS_WGU), (bf16*)(ws + WS_WD), SCR, gw, NGW, lane);
        combine_phase<false>(args.out, (const bf16*)(ws + WS_Y2), args.in[1] + D, (bf16*)(ws + WS_XN), vcu, G, wid, lane);
        SEAM(7); }
    if (IN(8)) { PhSloc P{ws, (const char*)(ws + WS_XN), G, vcu}; gm::gemm_phase(lds, P); SEAM(8); }
    if (IN(9)) { scan_phase((const float*)(ws + WS_SLOC), (const float*)(ws + WS_A16), (bf16*)(ws + WS_XN), lds, vcu, G); SEAM(9); }
    if (IN(10)) { PhY P{ws, (const char*)(ws + WS_XN), G, vcu}; gm::gemm_phase(lds, P); SEAM(10); }
    if (IN(11)) { PhWout P{ws, (const char*)(ws + WS_G), args.out, G, bx}; gm::gemm_phase(lds, P); SEAM(11); }
    MOE_LAYER(1, 12)
#undef MOE_LAYER
    if (IN(15)) combine_phase<true>(args.out, (const bf16*)(ws + WS_Y2), args.in[3], nullptr, vcu, G, wid, lane);
    if (IN(16)) moe_convert(args.in[20] + EW, args.in[21] + EW, args.in[22] + EW, args.in[2] + D, (bf16*)(ws + WS_WGU), (bf16*)(ws + WS_WD), SCR, gw, NGW, lane);
#undef IN
#undef SEAM
#undef SCR
}

#ifndef FAST_MASK
#define FAST_MASK 0x3ff
#endif
#ifndef FUSED
#define FUSED 1
#endif
extern "C" void kernel_launch(void* const* d_in, const int* in_sizes, int n_in, void* d_out, int out_size, void* d_ws, size_t ws_size, hipStream_t stream) {
    static int grid = 0;
    if (grid == 0) {
        if (n_in != 23 || out_size != M * D || ws_size < WS_END) { fprintf(stderr, "kernel_launch: unexpected shapes (n_in %d out %d ws %zu)\n", n_in, out_size, ws_size); grid = -1; return; }
        int dev = 0, cus = 0;
        if (hipGetDevice(&dev) != hipSuccess || hipDeviceGetAttribute(&cus, hipDeviceAttributeMultiprocessorCount, dev) != hipSuccess) { grid = -1; return; }
        if (hipFuncSetAttribute((const void*)mk_fwd, hipFuncAttributeMaxDynamicSharedMemorySize, LDS_BYTES) != hipSuccess) { fprintf(stderr, "kernel_launch: hipFuncSetAttribute failed\n"); grid = -1; return; }
        (void)hipGetLastError();
        grid = cus;
        if (grid != 256) fprintf(stderr, "kernel_launch: %d CUs (built for 256)\n", grid);
    }
    if (grid < 0) return;
    const float* x = (const float*)d_in[0]; const float* norm_mix = (const float*)d_in[1]; const float* norm_ffn = (const float*)d_in[2]; const float* norm_final = (const float*)d_in[3];
    const float* w_qkv = (const float*)d_in[4]; const float* w_o = (const float*)d_in[5]; const float* relb = (const float*)d_in[6];
    const float* lre = (const float*)d_in[7]; const float* lim = (const float*)d_in[8]; const float* lstep = (const float*)d_in[9];
    const float* bre = (const float*)d_in[10]; const float* bim = (const float*)d_in[11]; const float* cre = (const float*)d_in[12]; const float* cim = (const float*)d_in[13];
    const float* dsk = (const float*)d_in[14]; const float* w_out = (const float*)d_in[15];
    const float* wgr = (const float*)d_in[16]; const float* bgr = (const float*)d_in[17]; const float* wer = (const float*)d_in[18]; const float* ber = (const float*)d_in[19];
    const float* wg = (const float*)d_in[20]; const float* wu = (const float*)d_in[21]; const float* wd = (const float*)d_in[22];
    float* out = (float*)d_out; unsigned char* ws = (unsigned char*)d_ws;
    bf16* XN = (bf16*)(ws + WS_XN); bf16* Qb = (bf16*)(ws + WS_Q); bf16* Kb = (bf16*)(ws + WS_K); bf16* Vb = (bf16*)(ws + WS_V);
    bf16* Y2 = (bf16*)(ws + WS_Y2); bf16* Gb = (bf16*)(ws + WS_G);
    const size_t EW = (size_t)NEXP * 1024 * 256;
    (void)hipMemsetAsync(ws + WS_CTL, 0, CTL_ZERO_BYTES, stream);
    Args a{}; for (int i = 0; i < 23; ++i) a.in[i] = (const float*)d_in[i];
    a.out = out; a.ws = ws;
    int li = 0;
    auto run = [&](int lo, int hi) { a.ph_lo = lo; a.ph_hi = hi; a.li = li++; hipLaunchKernelGGL(mk_fwd, dim3(grid), dim3(NTHR), LDS_BYTES, stream, a); };
    constexpr unsigned FM = FAST_MASK;
    if (FUSED) { run(0, N_PHASES); return; }
    if (FM != 0) run(0, 1);
    if (!(FM & 1)) n_rmsnorm_bf16<<<M / 4, 256, 0, stream>>>(x, norm_mix, XN);
    if (FM & 2) run(1, 2); else n_gemm<0><<<dim3(3072 / 64, M / 64), 256, 0, stream>>>(XN, w_qkv, 3072, nullptr, nullptr, Qb, Kb, Vb);
    if (FM & 4) run(2, 3); else n_attn<<<dim3(SEQ / 64, NH, BATCH), 64, 0, stream>>>(Qb, Kb, Vb, relb, Qb);
    if (FM & 8) run(3, 4); else n_gemm<1><<<dim3(1024 / 64, M / 64), 256, 0, stream>>>(Qb, w_o, 1024, x, out, XN, nullptr, nullptr);
    if (FM & 16) { run(4, 5); run(5, 6); run(6, 7); } else n_moe<<<M, 256, 0, stream>>>(out, norm_ffn, wgr, bgr, wer, ber, wg, wu, wd, Y2);
    if (FM & 32) run(7, 8); else { if (FM & 256) run(16, 17); n_combine_norm<<<M / 4, 256, 0, stream>>>(out, Y2, norm_mix + D, XN); }
    if (FM & 64) { run(8, 9); run(9, 10); run(10, 11); } else n_ssm<<<dim3(64, BATCH), 64, 0, stream>>>(XN, lre, lim, lstep, bre, bim, cre, cim, dsk, Gb);
    if (FM & 128) run(11, 12); else n_gemm<2><<<dim3(1024 / 64, M / 64), 256, 0, stream>>>(Gb, w_out, 2048, out, out, XN, nullptr, nullptr);
    if (FM & 256) { run(12, 13); run(13, 14); run(14, 15); } else n_moe<<<M, 256, 0, stream>>>(out, norm_ffn + D, wgr + 1024 * 4, bgr + 4, wer + 4 * 1024 * 8, ber + 32, wg + EW, wu + EW, wd + EW, Y2);
    if (FM & 512) run(15, 16); else n_final<<<M / 4, 256, 0, stream>>>(out, Y2, norm_final);
}
```

```cpp
#include <hip/hip_runtime.h>
#include <cstdio>
#include <cstdint>

typedef unsigned short bf16;
constexpr int BATCH = 2, SEQ = 8192, D = 1024, M = BATCH * SEQ, NH = 16, HD = 64;
constexpr int NEXP = 32, EPG = 8, FE = 256;
constexpr int NREL = 257;
constexpr float RMS_EPS = 1e-6f;
constexpr float LOG2E = 1.4426950408889634f;
constexpr float C2 = 0.125f * LOG2E;

constexpr size_t MiB = 1u << 20;
constexpr size_t WS_CTL = 0;
constexpr size_t WS_XN = 86 * MiB;
constexpr size_t WS_BIG = 134 * MiB;
constexpr size_t WS_Q = WS_BIG, WS_K = WS_BIG + 32 * MiB, WS_V = WS_BIG + 64 * MiB;
constexpr size_t WS_Y2 = WS_BIG, WS_H = WS_BIG + 64 * MiB;
constexpr size_t WS_SLOC = WS_BIG, WS_G = WS_BIG + 32 * MiB;

__device__ __forceinline__ bf16 f2bf(float f) { unsigned u = __float_as_uint(f); return (bf16)((u + 0x7fffu + ((u >> 16) & 1u)) >> 16); }
__device__ __forceinline__ float bf2f(bf16 h) { return __uint_as_float(((unsigned)h) << 16); }
__device__ __forceinline__ float wave_sum(float v) {
#pragma unroll
    for (int o = 1; o < 64; o <<= 1) v += __shfl_xor(v, o);
    return v;
}
__device__ __forceinline__ float gelu_tanh(float x) { const float u = 0.7978845608028654f * (x + 0.044715f * x * x * x); return 0.5f * x * (1.f + tanhf(u)); }

__device__ __forceinline__ size_t xng_off(int t, int col) { const int b = t >> 13, tt = t & 8191, s = tt >> 4, j = tt & 15, g = col >> 4, c = col & 15; return ((size_t)(g * 1024 + b * 512 + s)) * 384 + j * 16 + c; }

__global__ void __launch_bounds__(256) n_rmsnorm_bf16(const float* __restrict__ x, const float* __restrict__ g, bf16* __restrict__ out) {
    const int row = blockIdx.x * 4 + (threadIdx.x >> 6), lane = threadIdx.x & 63;
    const float4* xr = (const float4*)(x + (size_t)row * D);
    float4 v[4]; float ss = 0.f;
#pragma unroll
    for (int j = 0; j < 4; ++j) { v[j] = xr[lane + 64 * j]; ss += v[j].x * v[j].x + v[j].y * v[j].y + v[j].z * v[j].z + v[j].w * v[j].w; }
    ss = wave_sum(ss); const float s = rsqrtf(ss * (1.f / D) + RMS_EPS);
#pragma unroll
    for (int j = 0; j < 4; ++j) { const int c = 4 * (lane + 64 * j); const float4 gg = *(const float4*)(g + c);
        bf16* o = out + (size_t)row * D + c; o[0] = f2bf(v[j].x * s * gg.x); o[1] = f2bf(v[j].y * s * gg.y); o[2] = f2bf(v[j].z * s * gg.z); o[3] = f2bf(v[j].w * s * gg.w); }
}

template <int MODE> __global__ void __launch_bounds__(256) n_gemm(const bf16* __restrict__ A, const float* __restrict__ B, int ldb, const float* resid, float* outf, bf16* __restrict__ ob0, bf16* __restrict__ ob1, bf16* __restrict__ ob2) {
    __shared__ float As[16][65]; __shared__ float Bs[16][64]; __shared__ float Bs2[16][64];
    const int tid = threadIdx.x, tx = tid & 15, ty = tid >> 4, bm = blockIdx.y * 64, bn = blockIdx.x * 64;
    float acc[4][4], acc2[4][4];
#pragma unroll
    for (int i = 0; i < 4; ++i)
#pragma unroll
        for (int j = 0; j < 4; ++j) { acc[i][j] = 0.f; acc2[i][j] = 0.f; }
    for (int k0 = 0; k0 < 1024; k0 += 16) {
        { const int r = tid >> 2, kq = (tid & 3) * 4; const bf16* ap = A + (size_t)(bm + r) * 1024 + k0 + kq;
#pragma unroll
          for (int i = 0; i < 4; ++i) As[kq + i][r] = bf2f(ap[i]); }
        { const int k = tid >> 4, n = (tid & 15) * 4; const float4 b = *(const float4*)(B + (size_t)(k0 + k) * ldb + bn + n);
          Bs[k][n] = b.x; Bs[k][n + 1] = b.y; Bs[k][n + 2] = b.z; Bs[k][n + 3] = b.w;
          if (MODE == 2) { const float4 b2 = *(const float4*)(B + (size_t)(k0 + k) * ldb + 1024 + bn + n); Bs2[k][n] = b2.x; Bs2[k][n + 1] = b2.y; Bs2[k][n + 2] = b2.z; Bs2[k][n + 3] = b2.w; } }
        __syncthreads();
#pragma unroll
        for (int k = 0; k < 16; ++k) { float a[4], b[4], b2[4];
#pragma unroll
            for (int i = 0; i < 4; ++i) a[i] = As[k][ty * 4 + i];
#pragma unroll
            for (int j = 0; j < 4; ++j) { b[j] = Bs[k][tx * 4 + j]; b2[j] = (MODE == 2) ? Bs2[k][tx * 4 + j] : 0.f; }
#pragma unroll
            for (int i = 0; i < 4; ++i)
#pragma unroll
                for (int j = 0; j < 4; ++j) { acc[i][j] += a[i] * b[j]; if (MODE == 2) acc2[i][j] += a[i] * b2[j]; } }
        __syncthreads();
    }
#pragma unroll
    for (int i = 0; i < 4; ++i)
#pragma unroll
        for (int j = 0; j < 4; ++j) { const int row = bm + ty * 4 + i, col = bn + tx * 4 + j;
            if (MODE == 0) { const int which = col >> 10, c = col & 1023; bf16* o = which == 0 ? ob0 : (which == 1 ? ob1 : ob2); o[(size_t)row * 1024 + c] = f2bf(acc[i][j] * (which == 0 ? C2 : 1.f)); }
            else { float h = resid[(size_t)row * 1024 + col]; if (MODE == 1) h += acc[i][j]; else h += acc[i][j] / (1.f + __expf(-acc2[i][j])); outf[(size_t)row * 1024 + col] = h; ob0[(size_t)row * 1024 + col] = f2bf(h); } }
}

__global__ void __launch_bounds__(64) n_attn(const bf16* Q, const bf16* __restrict__ K, const bf16* __restrict__ V, const float* __restrict__ relb, bf16* O) {
    const int c = blockIdx.x, h = blockIdx.y, b = blockIdx.z, qi = threadIdx.x;
    const size_t qrow = (size_t)b * SEQ + c * 64 + qi;
    float q[64], o[64];
#pragma unroll
    for (int d = 0; d < 64; ++d) { q[d] = bf2f(Q[qrow * D + h * 64 + d]); o[d] = 0.f; }
    float m = -1e30f, l = 0.f; const float* rb = relb + h * NREL;
    const int kc0 = c - 8 < 0 ? 0 : c - 8;
    for (int kc = kc0; kc <= c; ++kc)
        for (int kj = 0; kj < 64; ++kj) {
            const size_t krow = (size_t)b * SEQ + kc * 64 + kj; const bf16* kp = K + krow * D + h * 64; const bf16* vp = V + krow * D + h * 64;
            float s = 0.f;
#pragma unroll
            for (int d = 0; d < 64; ++d) s += q[d] * bf2f(kp[d]);
            int dist = (c - kc) * 64 + qi - kj; dist = dist < -128 ? -128 : (dist > 128 ? 128 : dist);
            s += rb[dist + 128] * LOG2E;
            const float mn = fmaxf(m, s), a = exp2f(m - mn), p = exp2f(s - mn); l = l * a + p; m = mn;
#pragma unroll
            for (int d = 0; d < 64; ++d) o[d] = o[d] * a + p * bf2f(vp[d]);
        }
    const float il = 1.f / l;
#pragma unroll
    for (int d = 0; d < 64; ++d) O[qrow * D + h * 64 + d] = f2bf(o[d] * il);
}

__global__ void __launch_bounds__(256) n_moe(const float* __restrict__ h, const float* __restrict__ gn, const float* __restrict__ wgr, const float* __restrict__ bgr, const float* __restrict__ wer, const float* __restrict__ ber,
                                             const float* __restrict__ wg, const float* __restrict__ wu, const float* __restrict__ wd, bf16* __restrict__ Y2) {
    __shared__ float hn[1024]; __shared__ float red[4]; __shared__ float logit[36]; __shared__ float hid[256]; __shared__ int se[2]; __shared__ float sw[2];
    const int t = blockIdx.x, tid = threadIdx.x;
    const float4 v = ((const float4*)(h + (size_t)t * D))[tid];
    float ss = wave_sum(v.x * v.x + v.y * v.y + v.z * v.z + v.w * v.w);
    if ((tid & 63) == 0) red[tid >> 6] = ss;
    __syncthreads();
    const float s = rsqrtf((red[0] + red[1] + red[2] + red[3]) * (1.f / D) + RMS_EPS);
    { const float4 gg = ((const float4*)gn)[tid]; hn[4 * tid] = v.x * s * gg.x; hn[4 * tid + 1] = v.y * s * gg.y; hn[4 * tid + 2] = v.z * s * gg.z; hn[4 * tid + 3] = v.w * s * gg.w; }
    __syncthreads();
    if (tid < 36) { float acc = 0.f;
        if (tid < 4) { for (int k = 0; k < 1024; ++k) acc += hn[k] * wgr[k * 4 + tid]; acc += bgr[tid]; }
        else { const int o = tid - 4, gi = o >> 3, ei = o & 7; for (int k = 0; k < 1024; ++k) acc += hn[k] * wer[((size_t)gi * 1024 + k) * 8 + ei]; acc += ber[o]; }
        logit[tid] = acc; }
    __syncthreads();
    if (tid == 0) {
        int gi = 0; float gm = logit[0];
        for (int i = 1; i < 4; ++i) if (logit[i] > gm) { gm = logit[i]; gi = i; }
        float den = 0.f; for (int i = 0; i < 4; ++i) den += __expf(logit[i] - gm);
        const float gp = 1.f / den;
        const float* sl = logit + 4 + 8 * gi;
        int i1 = 0; float l1 = sl[0]; for (int i = 1; i < 8; ++i) if (sl[i] > l1) { l1 = sl[i]; i1 = i; }
        int i2 = -1; float l2 = -3.4e38f; for (int i = 0; i < 8; ++i) if (i != i1 && sl[i] > l2) { l2 = sl[i]; i2 = i; }
        const float e2 = __expf(l2 - l1), w1 = 1.f / (1.f + e2), w2 = e2 / (1.f + e2);
        se[0] = gi * 8 + i1; se[1] = gi * 8 + i2; sw[0] = w1 * gp; sw[1] = w2 * gp;
    }
    __syncthreads();
    for (int kk = 0; kk < 2; ++kk) {
        const int e = se[kk]; const float w = sw[kk];
        const float* pg = wg + (size_t)e * 1024 * 256 + tid; const float* pu = wu + (size_t)e * 1024 * 256 + tid;
        float ag = 0.f, au = 0.f;
        for (int k = 0; k < 1024; ++k) { ag += hn[k] * pg[(size_t)k * 256]; au += hn[k] * pu[(size_t)k * 256]; }
        hid[tid] = ag / (1.f + __expf(-ag)) * au;
        __syncthreads();
        const float* pd = wd + (size_t)e * 256 * 1024;
#pragma unroll
        for (int i = 0; i < 4; ++i) { const int c = tid + 256 * i; float acc = 0.f; for (int j = 0; j < 256; ++j) acc += hid[j] * pd[(size_t)j * 1024 + c]; Y2[((size_t)2 * t + kk) * D + c] = f2bf(w * acc); }
        __syncthreads();
    }
}

__global__ void __launch_bounds__(256) n_combine_norm(float* hio, const bf16* __restrict__ Y2, const float* __restrict__ g, bf16* __restrict__ xng) {
    const int row = blockIdx.x * 4 + (threadIdx.x >> 6), lane = threadIdx.x & 63;
    float4* hr = (float4*)(hio + (size_t)row * D);
    float4 v[4]; float ss = 0.f;
#pragma unroll
    for (int j = 0; j < 4; ++j) { v[j] = hr[lane + 64 * j]; const int c = 4 * (lane + 64 * j);
        const bf16* ya = Y2 + ((size_t)2 * row) * D + c; const bf16* yb = ya + D;
        v[j].x += bf2f(ya[0]) + bf2f(yb[0]); v[j].y += bf2f(ya[1]) + bf2f(yb[1]); v[j].z += bf2f(ya[2]) + bf2f(yb[2]); v[j].w += bf2f(ya[3]) + bf2f(yb[3]);
        ss += v[j].x * v[j].x + v[j].y * v[j].y + v[j].z * v[j].z + v[j].w * v[j].w; hr[lane + 64 * j] = v[j]; }
    ss = wave_sum(ss); const float s = rsqrtf(ss * (1.f / D) + RMS_EPS);
#pragma unroll
    for (int j = 0; j < 4; ++j) { const int c = 4 * (lane + 64 * j); const float4 gg = *(const float4*)(g + c); bf16* o = xng + xng_off(row, c);
        o[0] = f2bf(v[j].x * s * gg.x); o[1] = f2bf(v[j].y * s * gg.y); o[2] = f2bf(v[j].z * s * gg.z); o[3] = f2bf(v[j].w * s * gg.w); }
}

__global__ void __launch_bounds__(64) n_ssm(const bf16* __restrict__ xng, const float* __restrict__ lre, const float* __restrict__ lim, const float* __restrict__ lstep, const float* __restrict__ bre, const float* __restrict__ bim,
                                            const float* __restrict__ cre, const float* __restrict__ cim, const float* __restrict__ dsk, bf16* __restrict__ G) {
    const int g = blockIdx.x, b = blockIdx.y, p = threadIdx.x;
    const float lr = fminf(lre[g * 64 + p], -1e-4f), li = lim[g * 64 + p], step = expf(lstep[g]);
    const float decay = expf(lr * step), ang = li * step, ar = decay * cosf(ang), ai = decay * sinf(ang);
    const float den = lr * lr + li * li, nr = ar - 1.f, fr = (nr * lr + ai * li) / den, fi = (ai * lr - nr * li) / den;
    float bbr[16], bbi[16], ccr[16], cci[16];
#pragma unroll
    for (int c = 0; c < 16; ++c) { const float br = bre[(g * 64 + p) * 16 + c], bi = bim[(g * 64 + p) * 16 + c]; bbr[c] = fr * br - fi * bi; bbi[c] = fr * bi + fi * br;
        ccr[c] = cre[(g * 16 + c) * 64 + p]; cci[c] = cim[(g * 16 + c) * 64 + p]; }
    const float dd = dsk[g * 16 + (p & 15)];
    float xr = 0.f, xi = 0.f;
    for (int t = 0; t < SEQ; ++t) {
        const bf16* up = xng + ((size_t)(g * 1024 + b * 512 + (t >> 4))) * 384 + (t & 15) * 16;
        float u[16]; float bur = 0.f, bui = 0.f;
#pragma unroll
        for (int c = 0; c < 16; ++c) { u[c] = bf2f(up[c]); bur += bbr[c] * u[c]; bui += bbi[c] * u[c]; }
        const float nxr = ar * xr - ai * xi + bur, nxi = ar * xi + ai * xr + bui; xr = nxr; xi = nxi;
        float mine = 0.f, myu = 0.f;
#pragma unroll
        for (int c = 0; c < 16; ++c) { const float y = wave_sum(ccr[c] * xr - cci[c] * xi); if ((p & 15) == c) { mine = y; myu = u[c]; } }
        if (p < 16) G[((size_t)b * SEQ + t) * D + g * 16 + p] = f2bf(gelu_tanh(mine + dd * myu));
    }
}

__global__ void __launch_bounds__(256) n_final(float* hio, const bf16* __restrict__ Y2, const float* __restrict__ g) {
    const int row = blockIdx.x * 4 + (threadIdx.x >> 6), lane = threadIdx.x & 63;
    float4* hr = (float4*)(hio + (size_t)row * D);
    float4 v[4]; float ss = 0.f;
#pragma unroll
    for (int j = 0; j < 4; ++j) { v[j] = hr[lane + 64 * j]; const int c = 4 * (lane + 64 * j);
        const bf16* ya = Y2 + ((size_t)2 * row) * D + c; const bf16* yb = ya + D;
        v[j].x += bf2f(ya[0]) + bf2f(yb[0]); v[j].y += bf2f(ya[1]) + bf2f(yb[1]); v[j].z += bf2f(ya[2]) + bf2f(yb[2]); v[j].w += bf2f(ya[3]) + bf2f(yb[3]);
        ss += v[j].x * v[j].x + v[j].y * v[j].y + v[j].z * v[j].z + v[j].w * v[j].w; }
    ss = wave_sum(ss); const float s = rsqrtf(ss * (1.f / D) + RMS_EPS);
#pragma unroll
    for (int j = 0; j < 4; ++j) { const int c = 4 * (lane + 64 * j); const float4 gg = *(const float4*)(g + c);
        float4 o; o.x = v[j].x * s * gg.x; o.y = v[j].y * s * gg.y; o.z = v[j].z * s * gg.z; o.w = v[j].w * s * gg.w; hr[lane + 64 * j] = o; }
}


#define LAS __attribute__((address_space(3)))
typedef short bf16x8 __attribute__((ext_vector_type(8)));
typedef short s16x4 __attribute__((ext_vector_type(4)));
typedef float f32x4 __attribute__((ext_vector_type(4)));
typedef float f32x16 __attribute__((ext_vector_type(16)));
typedef unsigned u32x4 __attribute__((ext_vector_type(4)));
typedef unsigned u32x2 __attribute__((ext_vector_type(2)));

constexpr int NWAVES = 8, NTHR = 512;
constexpr int CAP = 16384;
constexpr size_t CTL_ZERO_BYTES = 1 * MiB;
constexpr size_t WS_PDST = 1 * MiB, WS_PW = 3 * MiB, WS_PS = 5 * MiB, WS_SROW = 7 * MiB, WS_A16 = 7 * MiB + 65536;
constexpr size_t WS_TS = 7 * MiB + 131072;
constexpr size_t WS_RWT = 8 * MiB;
constexpr size_t WS_WQKV = 9 * MiB, WS_WO = 15 * MiB, WS_WOUT = 17 * MiB, WS_SSM = 21 * MiB;
constexpr size_t WS_WGU = 38 * MiB, WS_WD = 70 * MiB;
constexpr size_t WS_END = 230 * MiB;
constexpr int RW_PITCH = 1028, RW_LAYER = 36 * RW_PITCH;
constexpr int SSM_G_BYTES = 262144, SSM_A2_OFF = 65536;
constexpr int CW_BAR = 4096;
constexpr int CW_CNT = 65536;
constexpr int LDS_BYTES = 160 * 1024, MISC_OFF = LDS_BYTES - 512, AUX_OFF = 128 * 1024, RSCR_OFF = 36 * 1028 * 4;
constexpr int N_PHASES = 16;

__device__ __forceinline__ unsigned cvt_pk_bf16(float lo, float hi) { unsigned r; asm volatile("v_cvt_pk_bf16_f32 %0, %1, %2" : "=v"(r) : "v"(lo), "v"(hi)); return r; }
__device__ __forceinline__ unsigned pk2(float lo, float hi) { return (unsigned)f2bf(lo) | ((unsigned)f2bf(hi) << 16); }
#define LDS_WAIT() asm volatile("s_waitcnt lgkmcnt(0)" ::: "memory")
#define VM_WAIT() asm volatile("s_waitcnt vmcnt(0)" ::: "memory")
#define RLX_AGENT __ATOMIC_RELAXED, __HIP_MEMORY_SCOPE_AGENT

#define XB_TMO      128
#define XB_XCNT(j)  (256  + 64 * (j))
#define XB_XSUB(j)  (1280 + 64 * (j))
#define XB_XGEN(j)  (2304 + 64 * (j))
#define XB_TOP      3328
#define XB_TOPGEN   3392
#define XCD_BAR_WORDS 3456
#define XB_SPIN_CAP (1u << 18)
__device__ __forceinline__ unsigned xb_ld(unsigned* p)              { return __hip_atomic_load(p, __ATOMIC_RELAXED, __HIP_MEMORY_SCOPE_AGENT); }
__device__ __forceinline__ unsigned xb_add(unsigned* p, unsigned v) { return __hip_atomic_fetch_add(p, v, __ATOMIC_RELAXED, __HIP_MEMORY_SCOPE_AGENT); }
__device__ __forceinline__ unsigned xb_xcc_id() { return (unsigned)__builtin_amdgcn_s_getreg((3 << 11) | 20) & 0xFu; }
#define XB_SPIN(cond, bar) do { unsigned _sp = 0; while (cond) { __builtin_amdgcn_s_sleep(1); \
    if ((++_sp & 255u) == 0u) { if (xb_ld(&(bar)[XB_TMO])) break; if (_sp > XB_SPIN_CAP) { atomicAdd(&(bar)[XB_TMO], 1u); break; } } } } while (0)
struct XcdBarrier { unsigned* bar; unsigned x; volatile LAS unsigned* st; };
__device__ __forceinline__ XcdBarrier xcd_barrier_post(unsigned* bar, volatile LAS unsigned* st) {
    XcdBarrier b; b.bar = bar; b.x = xb_xcc_id(); b.st = st;
    if (threadIdx.x == 0) (void)xb_add(&bar[XB_XCNT(b.x)], 1u);
    return b;
}
__device__ __forceinline__ void xcd_barrier_complete(unsigned* bar, unsigned x, unsigned& nloc, unsigned& nx) {
    const unsigned G = gridDim.x * gridDim.y * gridDim.z;
    unsigned sum, cnt, mine, sp = 0u;
    for (;;) {
        sum = 0u; cnt = 0u; mine = 0u;
#pragma unroll
        for (unsigned j = 0; j < 16; ++j) { const unsigned c = xb_ld(&bar[XB_XCNT(j)]); sum += c; cnt += (c > 0u) ? 1u : 0u; mine = (j == x) ? c : mine; }
        if (sum == G) break;
        __builtin_amdgcn_s_sleep(1);
        if ((++sp & 255u) == 0u) { if (xb_ld(&bar[XB_TMO])) break; if (sp > XB_SPIN_CAP) { atomicAdd(&bar[XB_TMO], 1u); break; } }
    }
    nloc = mine > 0u ? mine : 1u; nx = cnt > 0u ? cnt : 1u;
}
__device__ __forceinline__ void xcd_barrier(const XcdBarrier& b) {
    asm volatile("s_waitcnt vmcnt(0)" ::: "memory");
    __syncthreads();
    if (threadIdx.x == 0) {
        unsigned* bar = b.bar;
        __builtin_amdgcn_s_waitcnt(0);
        unsigned nloc = b.st[0], nx = b.st[1];
        if (nloc == 0u) { xcd_barrier_complete(bar, b.x, nloc, nx); b.st[0] = nloc; b.st[1] = nx; }
        const unsigned old = xb_add(&bar[XB_XSUB(b.x)], 1u);
        const unsigned gen = old / nloc;
        if (old + 1u == (gen + 1u) * nloc) {
            __builtin_amdgcn_fence(__ATOMIC_RELEASE, "agent");
            asm volatile("s_waitcnt vmcnt(0)" ::: "memory");
            const unsigned og = xb_add(&bar[XB_TOP], 1u);
            const unsigned tg = og / nx;
            if (og + 1u == (tg + 1u) * nx) xb_add(&bar[XB_TOPGEN], 1u);
            else XB_SPIN(xb_ld(&bar[XB_TOPGEN]) == tg, bar);
            __builtin_amdgcn_fence(__ATOMIC_ACQUIRE, "agent");
            xb_add(&bar[XB_XGEN(b.x)], 1u);
            asm volatile("s_waitcnt vmcnt(0)" ::: "memory");
        } else {
            XB_SPIN(xb_ld(&bar[XB_XGEN(b.x)]) == gen, bar);
            __builtin_amdgcn_fence(__ATOMIC_ACQUIRE, "agent");
            asm volatile("s_waitcnt vmcnt(0)" ::: "memory");
        }
    }
    __syncthreads();
}

namespace gm {
constexpr int HTB = 16384;
__device__ __forceinline__ int lds_byte(int r, int c) { const int st = (r >> 4) * 2 + (c >> 5), rr = r & 15, cc = c & 31, ob = rr * 64 + cc * 2; return st * 1024 + (ob ^ (((ob >> 9) & 1) << 5)); }
__device__ __forceinline__ void stage_rc(int b, int& R, int& C) { const int st = b / 1024, sb = b % 1024, swz = sb ^ (((sb >> 9) & 1) << 5); R = (st >> 1) * 16 + swz / 64; C = (st & 1) * 32 + (swz % 64) / 2; }
__device__ __forceinline__ int perm32(int rho) { const int n = rho >> 4, i = rho & 15; return 8 * (i >> 2) + 4 * n + (i & 3); }
struct Unit { int pm, pn, e, gt, cnt; };
__device__ __forceinline__ bool static_unit(int i, int G, int c, int nM, int nN, Unit& u) {
    const int nwg = nM * nN; const long L = (long)i * G + c; if (L >= nwg) return false;
    int wgid = (int)L; { const int q = nwg / 8, r = nwg % 8, xcd = wgid % 8, off = wgid / 8; wgid = (xcd < r ? xcd * (q + 1) : r * (q + 1) + (xcd - r) * q) + off; }
    const int nig = 8 * nN, gid = wgid / nig, fm = gid * 8, gsz = (nM - fm) < 8 ? (nM - fm) : 8;
    u.pm = fm + ((wgid % nig) % gsz); u.pn = (wgid % nig) / gsz; u.e = 0; u.gt = 0; u.cnt = 0; return true;
}
template <class P> __device__ __forceinline__ void gemm_phase(LAS unsigned char* lds, const P& ph) {
    const int tid = threadIdx.x, wid = __builtin_amdgcn_readfirstlane(tid >> 6), lane = tid & 63, wr = wid >> 2, wc = wid & 3, fr = lane & 15, fq = lane >> 4;
    constexpr int nt = P::K / 64;
    static_assert(nt >= 2 && (nt % 2) == 0, "K must be a multiple of 128");
    unsigned voffA[2], voffB[2];
#pragma unroll
    for (int i = 0; i < 2; ++i) { int R, C; stage_rc(tid * 16 + i * 8192, R, C); const int Rb = (R & ~31) + perm32(R & 31); voffB[i] = (unsigned)(Rb * P::LDB + C) * 2u; voffA[i] = (unsigned)(R * P::LDA + C) * 2u; }
    const unsigned ldsw = (unsigned)wid * 1024u;
    const int aoff = lds_byte(wr * 64 + fr, fq * 8), boff = lds_byte(wc * 32 + fr, fq * 8);
    constexpr int hB = P::HSTEPB, hA = 128 * P::LDA * 2;
#define G_SA(b, h) (((b) * 2 + (h)) * gm::HTB)
#define G_SB(b, h) ((4 + (b) * 2 + (h)) * gm::HTB)
#define G_GLDS(src, bufoff, i) __builtin_amdgcn_global_load_lds((const unsigned*)(src), (LAS unsigned*)(lds + (bufoff) + ldsw + (i) * 8192), 16, 0, 0)
#define G_STA(bufoff, ptr, kb, offs, h) do { if constexpr (P::GATHER) { _Pragma("unroll") for (int _i = 0; _i < 2; ++_i) G_GLDS(Ab + (kb) + (offs)[h][_i], bufoff, _i); } \
        else { _Pragma("unroll") for (int _i = 0; _i < 2; ++_i) G_GLDS((ptr) + (h) * hA + voffA[_i], bufoff, _i); } } while (0)
#define G_STB(bufoff, ptr) do { _Pragma("unroll") for (int _i = 0; _i < 2; ++_i) G_GLDS((ptr) + voffB[_i], bufoff, _i); } while (0)
#define G_LDA(dst, b, h) do { _Pragma("unroll") for (int m = 0; m < 4; ++m) _Pragma("unroll") for (int k = 0; k < 2; ++k) dst[m][k] = *(const LAS bf16x8*)(lds + G_SA(b, h) + aoff + m * 2048 + k * 1024); } while (0)
#define G_LDB(dst, b, h) do { _Pragma("unroll") for (int n = 0; n < 2; ++n) _Pragma("unroll") for (int k = 0; k < 2; ++k) dst[n][k] = *(const LAS bf16x8*)(lds + G_SB(b, h) + boff + n * 2048 + k * 1024); } while (0)
#define G_MMA(ai, bj, At, Bt) do { __builtin_amdgcn_s_setprio(1); _Pragma("unroll") for (int m = 0; m < 4; ++m) _Pragma("unroll") for (int n = 0; n < 2; ++n) _Pragma("unroll") for (int k = 0; k < 2; ++k) \
        acc[ai][bj][m][n] = __builtin_amdgcn_mfma_f32_16x16x32_bf16(Bt[n][k], At[m][k], acc[ai][bj][m][n], 0, 0, 0); __builtin_amdgcn_s_setprio(0); } while (0)
#define G_WAIT_V(n) asm volatile("s_waitcnt vmcnt(" #n ")" ::: "memory")
#define G_WAIT_L(n) asm volatile("s_waitcnt lgkmcnt(" #n ")" ::: "memory")
#define G_BAR __builtin_amdgcn_s_barrier()
#define G_SCHED __builtin_amdgcn_sched_barrier(0)
    Unit cur, nxt; int ui = 0;
    if (!ph.next(0, cur)) return;
    f32x4 acc[2][2][4][2];
#pragma unroll
    for (int a = 0; a < 2; ++a)
#pragma unroll
        for (int b = 0; b < 2; ++b)
#pragma unroll
            for (int m = 0; m < 4; ++m)
#pragma unroll
                for (int n = 0; n < 2; ++n) acc[a][b][m][n] = (f32x4){0.f, 0.f, 0.f, 0.f};
    bf16x8 At[4][2], B0[2][2], B1[2][2];
    unsigned co[2][2] = {{0u, 0u}, {0u, 0u}};
    const char* Ab = ph.Abase;
    const char* cA = Ab; const char* cB = ph.b_tile(cur);
    if constexpr (P::GATHER) { ph.a_offs(cur, tid, co); asm volatile("s_waitcnt vmcnt(0)" ::: "memory"); } else cA = ph.a_tile(cur);
    G_STB(G_SB(0, 0), cB); G_STB(G_SB(0, 1), cB + hB); G_STA(G_SA(0, 0), cA, 0, co, 0); G_STA(G_SA(0, 1), cA, 0, co, 1);
    if (wr == 1) G_BAR;
    G_WAIT_V(2); G_BAR;
    G_STB(G_SB(1, 0), cB + 128); G_STA(G_SA(1, 0), cA + 128, 128, co, 0); G_STB(G_SB(1, 1), cB + hB + 128);
    G_WAIT_V(6); G_BAR;
    for (;;) {
        const bool has_next = ph.next(ui + 1, nxt);
        const char* nA = cA; const char* nB = cB;
        if (has_next) { nB = ph.b_tile(nxt); if constexpr (!P::GATHER) nA = ph.a_tile(nxt); }
        for (int t = 0; t < nt; t += 2) {
            const bool last = (t == nt - 2);
            const int kb1 = (t + 1) * 128, kb2 = last ? 0 : (t + 2) * 128, kb3 = kb2 + 128;
            const char* a1 = cA + kb1; const char* a2 = last ? nA : cA + kb2; const char* a3 = a2 + 128;
            const char* b2 = last ? nB : cB + (t + 2) * 128; const char* b3 = b2 + 128;
            G_LDB(B0, 0, 0); G_LDB(B1, 0, 1); G_SCHED; G_LDA(At, 0, 0); G_STA(G_SA(1, 1), a1, kb1, co, 1);
            G_WAIT_V(8); G_WAIT_L(0); G_BAR; G_MMA(0, 0, At, B0); G_MMA(0, 1, At, B1); G_BAR; G_SCHED;
            if constexpr (P::GATHER) { if (last && has_next) ph.a_offs(nxt, tid, co); }
            G_LDA(At, 0, 1); G_STB(G_SB(0, 0), b2); G_STB(G_SB(0, 1), b2 + hB); G_STA(G_SA(0, 0), a2, kb2, co, 0);
            G_WAIT_V(8); G_WAIT_L(0); G_BAR; G_MMA(1, 0, At, B0); G_MMA(1, 1, At, B1); G_BAR; G_SCHED;
            G_LDB(B0, 1, 0); G_LDB(B1, 1, 1); G_SCHED; G_LDA(At, 1, 0); G_STA(G_SA(0, 1), a2, kb2, co, 1);
            G_WAIT_V(8); G_WAIT_L(0); G_BAR; G_MMA(0, 0, At, B0); G_MMA(0, 1, At, B1); G_BAR; G_SCHED;
            G_LDA(At, 1, 1); G_STB(G_SB(1, 0), b3); G_STB(G_SB(1, 1), b3 + hB); G_STA(G_SA(1, 0), a3, kb3, co, 0);
            G_WAIT_V(8); G_WAIT_L(0); G_BAR; G_MMA(1, 0, At, B0); G_MMA(1, 1, At, B1); G_BAR; G_SCHED;
        }
        if (wr == 0) G_BAR;
        ph.epi(acc, cur, wr, wc, fr, fq);
        if (!has_next) break;
#pragma unroll
        for (int a = 0; a < 2; ++a)
#pragma unroll
            for (int b = 0; b < 2; ++b)
#pragma unroll
                for (int m = 0; m < 4; ++m)
#pragma unroll
                    for (int n = 0; n < 2; ++n) acc[a][b][m][n] = (f32x4){0.f, 0.f, 0.f, 0.f};
        cur = nxt; cA = nA; cB = nB; ++ui;
        if (wr == 1) G_BAR;
    }
    G_WAIT_V(0);
    G_BAR;
}
}

using gm::Unit;
#define EPI_ARGS const f32x4 (&acc)[2][2][4][2], const Unit& u, int wr, int wc, int fr_in, int fq_in
#define EPI_OPAQUE int fr = fr_in, fq = fq_in; asm volatile("" : "+v"(fr), "+v"(fq));
#define NO_GATHER __device__ __forceinline__ void a_offs(const Unit&, int, unsigned (&)[2][2]) const {}
#define EPI_FENCE() asm volatile("" ::: "memory")
__device__ __forceinline__ u32x4 pack8(const f32x4& v0, const f32x4& v1) { u32x4 w; w.x = cvt_pk_bf16(v0[0], v0[1]); w.y = cvt_pk_bf16(v0[2], v0[3]); w.z = cvt_pk_bf16(v1[0], v1[1]); w.w = cvt_pk_bf16(v1[2], v1[3]); return w; }
__device__ __forceinline__ float fast_sigmoid(float v) { return __builtin_amdgcn_rcpf(1.f + __builtin_amdgcn_exp2f(-LOG2E * v)); }
__device__ __forceinline__ float fast_gelu(float v) { const float u2 = 1.5957691216057308f * (v + 0.044715f * v * v * v); return v * fast_sigmoid(u2); }

struct PhQKV {
    static constexpr bool GATHER = false; static constexpr int LDA = 1024, K = 1024, LDB = 1024, HSTEPB = 128 * 1024 * 2;
    unsigned char* ws; const char* Abase; int G, c;
    __device__ __forceinline__ bool next(int i, Unit& u) const { return gm::static_unit(i, G, c, M / 256, 12, u); }
    NO_GATHER __device__ __forceinline__ const char* a_tile(const Unit& u) const { return Abase + (size_t)(u.pm * 256) * 1024 * 2; }
    __device__ __forceinline__ const char* b_tile(const Unit& u) const { return (const char*)(ws + WS_WQKV) + (size_t)u.pn * 256 * 1024 * 2; }
    __device__ __forceinline__ void epi(EPI_ARGS) const { EPI_OPAQUE
        const int row0 = u.pm * 256 + wr * 64 + fr; const int t = u.pn >> 2; const int colt = (u.pn & 3) * 256;
        bf16* base = (bf16*)(ws + WS_Q) + (size_t)t * (16u * 1024u * 1024u); const float sc = (t == 0) ? C2 : 1.f;
        const int col0 = colt + wc * 32 + 8 * fq;
#pragma unroll
        for (int ai = 0; ai < 2; ++ai)
#pragma unroll
            for (int m = 0; m < 4; ++m) { bf16* rowp = base + (size_t)(row0 + ai * 128 + m * 16) * 1024 + col0;
#pragma unroll
                for (int bj = 0; bj < 2; ++bj) *(u32x4*)(rowp + bj * 128) = pack8(acc[ai][bj][m][0] * sc, acc[ai][bj][m][1] * sc); }
    }
};
struct PhWo {
    static constexpr bool GATHER = false; static constexpr int LDA = 1024, K = 1024, LDB = 1024, HSTEPB = 128 * 1024 * 2;
    unsigned char* ws; const char* Abase; const float* resid; float* out; int G, c;
    __device__ __forceinline__ bool next(int i, Unit& u) const { return gm::static_unit(i, G, c, M / 256, 4, u); }
    NO_GATHER __device__ __forceinline__ const char* a_tile(const Unit& u) const { return Abase + (size_t)(u.pm * 256) * 1024 * 2; }
    __device__ __forceinline__ const char* b_tile(const Unit& u) const { return (const char*)(ws + WS_WO) + (size_t)u.pn * 256 * 1024 * 2; }
    __device__ __forceinline__ void epi(EPI_ARGS) const { EPI_OPAQUE
        const int row0 = u.pm * 256 + wr * 64 + fr, col0 = u.pn * 256 + wc * 32 + 8 * fq; bf16* hb = (bf16*)(ws + WS_XN);
#pragma unroll
        for (int ai = 0; ai < 2; ++ai)
#pragma unroll
            for (int m = 0; m < 4; ++m) { const size_t off = (size_t)(row0 + ai * 128 + m * 16) * 1024 + col0;
#pragma unroll
                for (int bj = 0; bj < 2; ++bj) { const f32x4 r0 = *(const f32x4*)(resid + off + bj * 128), r1 = *(const f32x4*)(resid + off + bj * 128 + 4);
                    const f32x4 v0 = acc[ai][bj][m][0] + r0, v1 = acc[ai][bj][m][1] + r1;
                    *(f32x4*)(out + off + bj * 128) = v0; *(f32x4*)(out + off + bj * 128 + 4) = v1; *(u32x4*)(hb + off + bj * 128) = pack8(v0, v1); }
                EPI_FENCE(); }
    }
};
struct PhWout {
    static constexpr bool GATHER = false; static constexpr int LDA = 1024, K = 1024, LDB = 1024, HSTEPB = 128 * 1024 * 2;
    unsigned char* ws; const char* Abase; float* out; int G, c;
    __device__ __forceinline__ bool next(int i, Unit& u) const { return gm::static_unit(i, G, c, M / 256, 8, u); }
    NO_GATHER __device__ __forceinline__ const char* a_tile(const Unit& u) const { return Abase + (size_t)(u.pm * 256) * 1024 * 2; }
    __device__ __forceinline__ const char* b_tile(const Unit& u) const { return (const char*)(ws + WS_WOUT) + (size_t)u.pn * 256 * 1024 * 2; }
    __device__ __forceinline__ void epi(EPI_ARGS) const { EPI_OPAQUE
        const size_t off0 = (size_t)(u.pm * 256 + wr * 64 + fr) * 1024 + u.pn * 128 + wc * 32 + 8 * fq;
        float* po = out + off0; bf16* ph = (bf16*)(ws + WS_XN) + off0;
#pragma unroll
        for (int ai = 0; ai < 2; ++ai)
#pragma unroll
            for (int m = 0; m < 4; ++m) {
                const f32x4 r0 = *(const f32x4*)(po), r1 = *(const f32x4*)(po + 4);
                f32x4 v0, v1;
#pragma unroll
                for (int j = 0; j < 4; ++j) { v0[j] = r0[j] + acc[ai][0][m][0][j] * fast_sigmoid(acc[ai][1][m][0][j]); v1[j] = r1[j] + acc[ai][0][m][1][j] * fast_sigmoid(acc[ai][1][m][1][j]); }
                *(f32x4*)(po) = v0; *(f32x4*)(po + 4) = v1; *(u32x4*)(ph) = pack8(v0, v1);
                po += (m == 3 ? (128 - 48) : 16) * 1024; ph += (m == 3 ? (128 - 48) : 16) * 1024; asm volatile("" : "+v"(po), "+v"(ph) :: "memory"); }
    }
};
__device__ __forceinline__ void moe_locate(LAS unsigned char* lds, int tile, Unit& u) { const LAS int* cn = (const LAS int*)(lds + AUX_OFF); const LAS int* tb = cn + 32;
    int e = 0; while (e < 31 && tb[e + 1] <= tile) ++e; u.e = e; u.pm = tile - tb[e]; u.gt = tile; u.cnt = cn[e]; }
struct PhGateUp {
    static constexpr bool GATHER = true; static constexpr int LDA = 1024, K = 1024, LDB = 1024, HSTEPB = 128 * 1024 * 2;
    unsigned char* ws; const char* Abase; LAS unsigned char* lds; int G, c;
    __device__ __forceinline__ bool next(int i, Unit& u) const { const int idx = i * G + c; const int nt = ((const LAS int*)(lds + AUX_OFF))[64]; if (idx >= 2 * nt) return false; u.pn = idx & 1; moe_locate(lds, idx >> 1, u); return true; }
    __device__ __forceinline__ void a_offs(const Unit& u, int tid, unsigned (&o)[2][2]) const { const int* pdst = (const int*)(ws + WS_PDST);
#pragma unroll
        for (int i = 0; i < 2; ++i) { int R, C; gm::stage_rc(tid * 16 + i * 8192, R, C);
#pragma unroll
            for (int h = 0; h < 2; ++h) { int slot = u.pm * 256 + 128 * h + R; slot = slot < u.cnt ? slot : u.cnt - 1; const int tok = pdst[u.e * CAP + slot] >> 1; o[h][i] = (unsigned)(tok * 1024 + C) * 2u; } }
    }
    __device__ __forceinline__ const char* a_tile(const Unit&) const { return Abase; }
    __device__ __forceinline__ const char* b_tile(const Unit& u) const { return (const char*)(ws + WS_WGU) + ((size_t)u.e * 512 + u.pn * 256) * 1024 * 2; }
    __device__ __forceinline__ void epi(EPI_ARGS) const { EPI_OPAQUE
        const int r0 = wr * 64 + fr, col0 = u.pn * 128 + wc * 32 + 8 * fq; const float* ps = (const float*)(ws + WS_PS); bf16* H = (bf16*)(ws + WS_H);
#pragma unroll
        for (int ai = 0; ai < 2; ++ai)
#pragma unroll
            for (int m = 0; m < 4; ++m) { const int r = r0 + ai * 128 + m * 16; int slot = u.pm * 256 + r; slot = slot < u.cnt ? slot : u.cnt - 1; const float s = ps[u.e * CAP + slot];
                f32x4 v0, v1;
#pragma unroll
                for (int j = 0; j < 4; ++j) { const float g0 = acc[ai][0][m][0][j] * s, u0 = acc[ai][1][m][0][j] * s, g1 = acc[ai][0][m][1][j] * s, u1 = acc[ai][1][m][1][j] * s;
                    v0[j] = g0 * fast_sigmoid(g0) * u0; v1[j] = g1 * fast_sigmoid(g1) * u1; }
                *(u32x4*)(H + ((size_t)u.gt * 256 + r) * 256 + col0) = pack8(v0, v1);
                EPI_FENCE(); }
    }
};
struct PhDown {
    static constexpr bool GATHER = false; static constexpr int LDA = 256, K = 256, LDB = 256, HSTEPB = 128 * 256 * 2;
    unsigned char* ws; const char* Abase; LAS unsigned char* lds; int G, c;
    __device__ __forceinline__ bool next(int i, Unit& u) const { const int idx = i * G + c; const int nt = ((const LAS int*)(lds + AUX_OFF))[64]; if (idx >= 4 * nt) return false; u.pn = idx & 3; moe_locate(lds, idx >> 2, u); return true; }
    NO_GATHER __device__ __forceinline__ const char* a_tile(const Unit& u) const { return Abase + (size_t)(u.gt * 256) * 256 * 2; }
    __device__ __forceinline__ const char* b_tile(const Unit& u) const { return (const char*)(ws + WS_WD) + ((size_t)u.e * 1024 + u.pn * 256) * 256 * 2; }
    __device__ __forceinline__ void epi(EPI_ARGS) const { EPI_OPAQUE
        const int r0 = wr * 64 + fr, col0 = u.pn * 256 + wc * 32 + 8 * fq; const int* pdst = (const int*)(ws + WS_PDST); const float* pw = (const float*)(ws + WS_PW); bf16* Y2 = (bf16*)(ws + WS_Y2);
#pragma unroll
        for (int ai = 0; ai < 2; ++ai)
#pragma unroll
            for (int m = 0; m < 4; ++m) { const int r = r0 + ai * 128 + m * 16; const int slot = u.pm * 256 + r;
                if (slot < u.cnt) { const int dst = pdst[u.e * CAP + slot]; const float w8 = pw[u.e * CAP + slot];
#pragma unroll
                    for (int bj = 0; bj < 2; ++bj) *(u32x4*)(Y2 + (size_t)dst * 1024 + col0 + bj * 128) = pack8(acc[ai][bj][m][0] * w8, acc[ai][bj][m][1] * w8); }
                EPI_FENCE(); }
    }
};
struct PhSloc {
    static constexpr bool GATHER = false; static constexpr int LDA = 384, K = 256, LDB = 256, HSTEPB = 0;
    unsigned char* ws; const char* Abase; int G, c;
    __device__ __forceinline__ bool next(int i, Unit& u) const { const int idx = i * G + c; if (idx >= 256) return false; u.e = idx >> 2; u.pm = idx & 3; u.pn = 0; u.gt = 0; u.cnt = 0; return true; }
    NO_GATHER __device__ __forceinline__ const char* a_tile(const Unit& u) const { return Abase + (size_t)(u.e * 1024 + u.pm * 256) * 384 * 2; }
    __device__ __forceinline__ const char* b_tile(const Unit& u) const { return (const char*)(ws + WS_SSM) + (size_t)u.e * SSM_G_BYTES; }
    __device__ __forceinline__ void epi(EPI_ARGS) const { EPI_OPAQUE
        const int r0 = u.e * 1024 + u.pm * 256 + wr * 64 + fr, col0 = wc * 32 + 8 * fq; float* Sloc = (float*)(ws + WS_SLOC);
#pragma unroll
        for (int ai = 0; ai < 2; ++ai)
#pragma unroll
            for (int m = 0; m < 4; ++m) { float* p = Sloc + (size_t)(r0 + ai * 128 + m * 16) * 128 + col0; *(f32x4*)p = acc[ai][0][m][0]; *(f32x4*)(p + 4) = acc[ai][0][m][1]; }
    }
};
struct PhY {
    static constexpr bool GATHER = false; static constexpr int LDA = 384, K = 384, LDB = 384, HSTEPB = 128 * 384 * 2;
    unsigned char* ws; const char* Abase; int G, c;
    __device__ __forceinline__ bool next(int i, Unit& u) const { const int idx = i * G + c; if (idx >= 256) return false; u.e = idx >> 2; u.pm = idx & 3; u.pn = 0; u.gt = 0; u.cnt = 0; return true; }
    NO_GATHER __device__ __forceinline__ const char* a_tile(const Unit& u) const { return Abase + (size_t)(u.e * 1024 + u.pm * 256) * 384 * 2; }
    __device__ __forceinline__ const char* b_tile(const Unit& u) const { return (const char*)(ws + WS_SSM) + (size_t)u.e * SSM_G_BYTES + SSM_A2_OFF; }
    __device__ __forceinline__ void epi(EPI_ARGS) const { EPI_OPAQUE
        const int nb = (u.pm & 1) * 256 + wr * 64 + fr;
        bf16* p = (bf16*)(ws + WS_G) + ((size_t)(u.pm >> 1) * SEQ + 16 * nb + 2 * wc + (fq >> 1)) * 1024 + 16 * u.e + 8 * (fq & 1);
#pragma unroll
        for (int ai = 0; ai < 2; ++ai)
#pragma unroll
            for (int m = 0; m < 4; ++m) {
#pragma unroll
                for (int bj = 0; bj < 2; ++bj) { f32x4 v0, v1;
#pragma unroll
                    for (int j = 0; j < 4; ++j) { v0[j] = fast_gelu(acc[ai][bj][m][0][j]); v1[j] = fast_gelu(acc[ai][bj][m][1][j]); }
                    *(u32x4*)(p + bj * 8 * 1024) = pack8(v0, v1); }
                p += (m == 3 ? (128 - 48) : 16) * 16 * 1024; asm volatile("" : "+v"(p) :: "memory"); }
    }
};

namespace at {
constexpr int NSLOT = 3, SLOTB = 8192;
constexpr int LDS_K = 0, LDS_V = NSLOT * SLOTB, LDS_WS = 2 * NSLOT * SLOTB, LDS_TBL = LDS_WS + 2048, LDS_OST = LDS_TBL + 2048, LDS_TOTAL = LDS_OST + 8 * 4096;
typedef short v4i16_t __attribute__((ext_vector_type(4)));
__device__ __forceinline__ int crow(int r, int hi) { return (r & 3) + 8 * (r >> 2) + 4 * hi; }
__device__ __forceinline__ void glds16(const void* gsrc, unsigned lds_dst) { unsigned keep;
    asm volatile("s_mov_b32 %0, m0\n\ts_mov_b32 m0, %2\n\ts_nop 0\n\tglobal_load_lds_dwordx4 %1, off\n\ts_mov_b32 m0, %0" : "=&s"(keep) : "v"(gsrc), "s"(lds_dst) : "memory"); }
__device__ __forceinline__ s16x4 vtr(const LAS unsigned char* p) { return __builtin_bit_cast(s16x4, __builtin_amdgcn_ds_read_tr16_b64_v4i16((LAS v4i16_t*)p)); }
#define AT_WAIT_BAR(N) asm volatile("s_waitcnt vmcnt(" #N ") lgkmcnt(0)\n\ts_barrier" ::: "memory")
template <int THR> __device__ __forceinline__ void attn_unit(int b, int h, int qb, const bf16* Q, const bf16* __restrict__ K, const bf16* __restrict__ V, bf16* O, const float* __restrict__ relb, LAS unsigned char* shm) {
    const int tid = threadIdx.x, lane = tid & 63, r32 = lane & 31, hi = lane >> 5; const int wid = __builtin_amdgcn_readfirstlane(tid >> 6);
    const long rowbase = (long)b * SEQ; const int q0 = qb * 256; const int cq = 4 * qb + (wid >> 1);
    const bf16* Qw = Q + (rowbase + q0 + wid * 32) * D + h * 64;
    const unsigned lds0 = (unsigned)(uintptr_t)shm;
    LAS float* wsf = (LAS float*)(shm + LDS_WS) + wid * 64; LAS float* tbl = (LAS float*)(shm + LDS_TBL);
    const int kc_lo = (4 * qb - 8) < 0 ? 0 : (4 * qb - 8); const int NT = 4 * qb + 3 - kc_lo + 1;
    if (tid < 320) tbl[tid] = relb[h * NREL + (tid < 256 ? tid : 256)] * LOG2E;
    const bf16* ksrc = K + (rowbase + kc_lo * 64 + lane) * D + h * 64 + wid * 8;
    const bf16* vsrc = V + (rowbase + kc_lo * 64 + 16 * (wid & 3) + (lane >> 2)) * D + h * 64 + (wid >> 2) * 32 + (lane & 3) * 8;
    const unsigned kdst = lds0 + LDS_K + wid * 1024, vdst = lds0 + LDS_V + wid * 1024;
#define AT_DMA(t, slotoff) do { glds16(ksrc + (long)(t) * 64 * D, (unsigned)__builtin_amdgcn_readfirstlane(kdst + (slotoff))); glds16(vsrc + (long)(t) * 64 * D, (unsigned)__builtin_amdgcn_readfirstlane(vdst + (slotoff))); } while (0)
    bf16x8 qr[4];
#pragma unroll
    for (int d0 = 0; d0 < 4; ++d0) qr[d0] = *reinterpret_cast<const bf16x8*>(&Qw[(long)r32 * D + d0 * 16 + hi * 8]);
    asm volatile("s_waitcnt vmcnt(0)" ::: "memory");
    AT_DMA(0, 0); if (NT > 1) AT_DMA(1, SLOTB);
    float mrow = -1e30f, lsum = 0.f; f32x16 o[2]; o[0] = f32x16{}; o[1] = f32x16{};
    int sl_cur = 0, sl_nn = 2 * SLOTB;
    for (int t = 0; t < NT; ++t) {
        const int kc = kc_lo + t;
        if (t + 1 < NT) { AT_WAIT_BAR(2); } else { AT_WAIT_BAR(0); }
        if (t + 2 < NT) AT_DMA(t + 2, sl_nn);
        if (kc >= cq - 8 && kc <= cq) {
            const LAS unsigned char* kp = shm + LDS_K + sl_cur + hi * 1024 + r32 * 16;
            f32x16 p0 = f32x16{}, p1 = f32x16{};
#pragma unroll
            for (int d0 = 0; d0 < 4; ++d0) { const bf16x8 b0 = *(const LAS bf16x8*)(kp + d0 * 2048), b1 = *(const LAS bf16x8*)(kp + d0 * 2048 + 512);
                p0 = __builtin_amdgcn_mfma_f32_32x32x16_bf16(b0, qr[d0], p0, 0, 0, 0); p1 = __builtin_amdgcn_mfma_f32_32x32x16_bf16(b1, qr[d0], p1, 0, 0, 0); }
            const int delta = cq - kc;
            if (delta >= 3) { const float bf = tbl[256];
#pragma unroll
                for (int r = 0; r < 16; ++r) { p0[r] += bf; p1[r] += bf; } }
            else { const LAS float* tb = tbl + (64 * delta + 32 * (wid & 1) + r32 + 128 - 4 * hi);
#pragma unroll
                for (int r = 0; r < 16; ++r) { const int kj = (r & 3) + 8 * (r >> 2); p0[r] += tb[-kj]; p1[r] += tb[-kj - 32]; } }
            float rm = fmaxf(p0[0], p1[0]);
#pragma unroll
            for (int r = 1; r < 16; ++r) rm = fmaxf(rm, fmaxf(p0[r], p1[r]));
            { auto rr = __builtin_amdgcn_permlane32_swap(__float_as_uint(rm), __float_as_uint(rm), false, false); rm = fmaxf(__uint_as_float(rr[0]), __uint_as_float(rr[1])); }
            if (__any(rm > mrow + (float)THR)) {
                const float mn = fmaxf(mrow, rm), f = __builtin_amdgcn_exp2f(mrow - mn); mrow = mn; lsum *= f;
                if (hi == 0) wsf[r32] = f;
                LDS_WAIT();
#pragma unroll
                for (int r = 0; r < 16; ++r) { const float fr_ = wsf[crow(r, hi)]; o[0][r] *= fr_; o[1][r] *= fr_; }
            }
            float sacc = 0.f;
#pragma unroll
            for (int r = 0; r < 16; ++r) { p0[r] = __builtin_amdgcn_exp2f(p0[r] - mrow); p1[r] = __builtin_amdgcn_exp2f(p1[r] - mrow); sacc += p0[r] + p1[r]; }
            lsum += sacc;
            u32x4 pw0, pw1, pw2, pw3;
            pw0 = (u32x4){cvt_pk_bf16(p0[0], p0[1]), cvt_pk_bf16(p0[2], p0[3]), cvt_pk_bf16(p0[4], p0[5]), cvt_pk_bf16(p0[6], p0[7])};
            pw1 = (u32x4){cvt_pk_bf16(p0[8], p0[9]), cvt_pk_bf16(p0[10], p0[11]), cvt_pk_bf16(p0[12], p0[13]), cvt_pk_bf16(p0[14], p0[15])};
            pw2 = (u32x4){cvt_pk_bf16(p1[0], p1[1]), cvt_pk_bf16(p1[2], p1[3]), cvt_pk_bf16(p1[4], p1[5]), cvt_pk_bf16(p1[6], p1[7])};
            pw3 = (u32x4){cvt_pk_bf16(p1[8], p1[9]), cvt_pk_bf16(p1[10], p1[11]), cvt_pk_bf16(p1[12], p1[13]), cvt_pk_bf16(p1[14], p1[15])};
            const bf16x8 pa[4] = {__builtin_bit_cast(bf16x8, pw0), __builtin_bit_cast(bf16x8, pw1), __builtin_bit_cast(bf16x8, pw2), __builtin_bit_cast(bf16x8, pw3)};
            const LAS unsigned char* vp = shm + LDS_V + sl_cur + ((lane >> 4) & 1) * 32 + (lane & 3) * 8 + (4 * hi + ((lane & 15) >> 2)) * 64;
#pragma unroll
            for (int d0 = 0; d0 < 2; ++d0)
#pragma unroll
                for (int ks = 0; ks < 4; ++ks) { const s16x4 lo = vtr(vp + d0 * 4096 + ks * 1024), hh = vtr(vp + d0 * 4096 + ks * 1024 + 512);
                    const bf16x8 vf = (bf16x8){lo[0], lo[1], lo[2], lo[3], hh[0], hh[1], hh[2], hh[3]};
                    o[d0] = __builtin_amdgcn_mfma_f32_32x32x16_bf16(pa[ks], vf, o[d0], 0, 0, 0); }
        }
        sl_cur = (sl_cur == 2 * SLOTB) ? 0 : sl_cur + SLOTB; sl_nn = (sl_nn == 2 * SLOTB) ? 0 : sl_nn + SLOTB;
    }
    { auto rr = __builtin_amdgcn_permlane32_swap(__float_as_uint(lsum), __float_as_uint(lsum), false, false); lsum = __uint_as_float(rr[0]) + __uint_as_float(rr[1]); }
    if (hi == 0) wsf[32 + r32] = lsum;
    LDS_WAIT();
    float rli[16];
#pragma unroll
    for (int r = 0; r < 16; ++r) rli[r] = __builtin_amdgcn_rcpf(wsf[32 + crow(r, hi)]);
    bf16* Ow = O + (rowbase + q0 + wid * 32) * D + h * 64;
    { LAS bf16* stg = (LAS bf16*)(shm + LDS_OST) + wid * 2048;
#pragma unroll
      for (int r = 0; r < 16; ++r) { const int orow = crow(r, hi);
#pragma unroll
          for (int d0 = 0; d0 < 2; ++d0) stg[orow * 64 + d0 * 32 + r32] = f2bf(o[d0][r] * rli[r]); }
      LDS_WAIT();
#pragma unroll
      for (int i = 0; i < 4; ++i) { const int row = i * 8 + (lane >> 3), ch = lane & 7; const u32x4 v = *(const LAS u32x4*)(stg + row * 64 + ch * 8); *(u32x4*)(Ow + (long)row * D + ch * 8) = v; } }
    asm volatile("s_waitcnt lgkmcnt(0)\n\ts_barrier" ::: "memory");
#undef AT_DMA
}
}

struct Args { const float* in[23]; float* out; unsigned char* ws; int ph_lo, ph_hi, li, pad; };

__device__ __forceinline__ void tr_item(const float* __restrict__ W, int ldw, int k0, int n0, bf16* __restrict__ WT, int ldt, int drow0, const float* __restrict__ ks, LAS float* scr, int lane) {
    float v[32];
    const float* wp = W + (size_t)(k0 + (lane >> 5)) * ldw + n0 + (lane & 31);
#pragma unroll
    for (int i = 0; i < 32; ++i) v[i] = wp[(size_t)(2 * i) * ldw];
    if (ks) {
#pragma unroll
        for (int i = 0; i < 32; ++i) v[i] *= ks[k0 + 2 * i + (lane >> 5)]; }
#pragma unroll
    for (int i = 0; i < 32; ++i) scr[(2 * i + (lane >> 5)) * 33 + (lane & 31)] = v[i];
    LDS_WAIT(); asm volatile("" ::: "memory");
    const int c = lane & 7;
#pragma unroll
    for (int j = 0; j < 4; ++j) { const int n = (lane >> 3) + 8 * j; const LAS float* s = scr + (8 * c) * 33 + n;
        u32x4 o; o.x = pk2(s[0 * 33], s[1 * 33]); o.y = pk2(s[2 * 33], s[3 * 33]); o.z = pk2(s[4 * 33], s[5 * 33]); o.w = pk2(s[6 * 33], s[7 * 33]);
        *(u32x4*)(WT + (size_t)(drow0 + n) * ldt + k0 + 8 * c) = o; }
    LDS_WAIT(); asm volatile("" ::: "memory");
}
__device__ __forceinline__ void moe_convert(const float* wg, const float* wu, const float* wd, const float* gn, bf16* WGU, bf16* WD, LAS float* scr, int gw, int NGW, int lane) {
    for (int it = gw; it < 12288; it += NGW) {
        if (it < 8192) { const int which = it >> 12, r = it & 4095, e = r >> 7, kb = (r >> 3) & 15, nb = r & 7, n0 = nb * 32;
            tr_item((which ? wu : wg) + (size_t)e * 1024 * 256, 256, kb * 64, n0, WGU, 1024, e * 512 + 256 * (n0 >> 7) + 128 * which + (n0 & 127), gn, scr, lane); }
        else { const int r = it - 8192, e = r >> 7, kb = (r >> 5) & 3, nb = r & 31;
            tr_item(wd + (size_t)e * 256 * 1024, 1024, kb * 64, nb * 32, WD, 256, e * 1024 + nb * 32, nullptr, scr, lane); }
    }
}
__device__ __forceinline__ void ssm_mats(int g, int q, const float* lre, const float* lim, const float* lstep, const float* bre, const float* bim, const float* cre, const float* cim, const float* dsk,
                                         unsigned char* ssm_ws, float* a16g, LAS float* L, int tid) {
    LAS float* pwr = L; LAS float* pwi = L + 64 * 17; LAS float* bbr = L + 2 * 64 * 17; LAS float* bbi = bbr + 1024; LAS float* ccr = bbi + 1024; LAS float* cci = ccr + 1024; LAS float* Kt = cci + 1024;
    if (tid < 64) { const int p = tid;
        const float lr = fminf(lre[g * 64 + p], -1e-4f), li = lim[g * 64 + p], step = expf(lstep[g]);
        const float decay = expf(lr * step), ang = li * step, ar = decay * cosf(ang), ai = decay * sinf(ang);
        const float den = lr * lr + li * li, nr = ar - 1.f, fr = (nr * lr + ai * li) / den, fi = (ai * lr - nr * li) / den;
        for (int c = 0; c < 16; ++c) { const float br = bre[(g * 64 + p) * 16 + c], bi = bim[(g * 64 + p) * 16 + c]; bbr[p * 16 + c] = fr * br - fi * bi; bbi[p * 16 + c] = fr * bi + fi * br;
            ccr[c * 64 + p] = cre[(g * 16 + c) * 64 + p]; cci[c * 64 + p] = cim[(g * 16 + c) * 64 + p]; }
        float xr = 1.f, xi = 0.f;
        for (int n = 0; n <= 16; ++n) { pwr[p * 17 + n] = xr; pwi[p * 17 + n] = xi; const float t = xr * ar - xi * ai; xi = xr * ai + xi * ar; xr = t; }
        if (q == 0) { a16g[(g * 64 + p) * 2] = pwr[p * 17 + 16]; a16g[(g * 64 + p) * 2 + 1] = pwi[p * 17 + 16]; }
    }
    __syncthreads();
    if (tid < 256) { const int tl = tid >> 6, c = (tid >> 2) & 15, cq = tid & 3, tau = 4 * q + tl;
        float s0 = 0.f, s1 = 0.f, s2 = 0.f, s3 = 0.f;
        for (int p = 0; p < 64; ++p) { const float cr = ccr[c * 64 + p], ci = cci[c * 64 + p], ar = pwr[p * 17 + tau], ai = pwi[p * 17 + tau]; const float tr = cr * ar - ci * ai, ti = cr * ai + ci * ar;
            const f32x4 br = *(const LAS f32x4*)(bbr + p * 16 + 4 * cq), bi = *(const LAS f32x4*)(bbi + p * 16 + 4 * cq);
            s0 += tr * br[0] - ti * bi[0]; s1 += tr * br[1] - ti * bi[1]; s2 += tr * br[2] - ti * bi[2]; s3 += tr * br[3] - ti * bi[3]; }
        if (tau == 0) { const float dd = dsk[g * 16 + c]; if (4 * cq == (c & ~3)) { if ((c & 3) == 0) s0 += dd; else if ((c & 3) == 1) s1 += dd; else if ((c & 3) == 2) s2 += dd; else s3 += dd; } }
        LAS float* kp = Kt + tl * 256 + c * 16 + 4 * cq; kp[0] = s0; kp[1] = s1; kp[2] = s2; kp[3] = s3; }
    __syncthreads();
    bf16* Bend = (bf16*)(ssm_ws + (size_t)g * SSM_G_BYTES); bf16* A2 = (bf16*)(ssm_ws + (size_t)g * SSM_G_BYTES + SSM_A2_OFF);
    for (int o = tid; o < 2048; o += NTHR) { const int tl = o >> 9, i = (o >> 5) & 15, c = (o >> 1) & 15, hf = o & 1, tau = 4 * q + tl, j = i - tau;
        if (j >= 0) { const LAS float* kp = Kt + tl * 256 + c * 16 + 8 * hf; u32x4 w; w.x = pk2(kp[0], kp[1]); w.y = pk2(kp[2], kp[3]); w.z = pk2(kp[4], kp[5]); w.w = pk2(kp[6], kp[7]);
            *(u32x4*)(A2 + (size_t)(i * 16 + c) * 384 + j * 16 + 8 * hf) = w; } }
    for (int o = tid; o < 2048; o += NTHR) { const int il = o >> 9, c = (o >> 5) & 15, j = (o >> 1) & 15, hf = o & 1, i = 4 * q + il;
        if (j > i) *(u32x4*)(A2 + (size_t)(i * 16 + c) * 384 + j * 16 + 8 * hf) = (u32x4){0u, 0u, 0u, 0u}; }
    for (int o = tid; o < 1024; o += NTHR) { const int il = o >> 8, c = (o >> 4) & 15, k8 = (o & 15) * 8, i = 4 * q + il; float v[8];
#pragma unroll
        for (int qq = 0; qq < 4; ++qq) { const int p = (k8 >> 1) + qq; const float cr = ccr[c * 64 + p], ci = cci[c * 64 + p], ar = pwr[p * 17 + i + 1], ai = pwi[p * 17 + i + 1];
            v[2 * qq] = cr * ar - ci * ai; v[2 * qq + 1] = -(cr * ai + ci * ar); }
        u32x4 w; w.x = pk2(v[0], v[1]); w.y = pk2(v[2], v[3]); w.z = pk2(v[4], v[5]); w.w = pk2(v[6], v[7]); *(u32x4*)(A2 + (size_t)(i * 16 + c) * 384 + 256 + k8) = w; }
    for (int o = tid; o < 1024; o += NTHR) { const int n = 32 * q + (o >> 5), k8 = (o & 31) * 8, p = n >> 1, ri = n & 1, j = k8 >> 4; float v[8];
        const float ar = pwr[p * 17 + 15 - j], ai = pwi[p * 17 + 15 - j];
#pragma unroll
        for (int qq = 0; qq < 8; ++qq) { const int c2 = (k8 & 15) + qq; const float br = bbr[p * 16 + c2], bi = bbi[p * 16 + c2]; v[qq] = ri ? (ar * bi + ai * br) : (ar * br - ai * bi); }
        u32x4 w; w.x = pk2(v[0], v[1]); w.y = pk2(v[2], v[3]); w.z = pk2(v[4], v[5]); w.w = pk2(v[6], v[7]); *(u32x4*)(Bend + (size_t)n * 256 + k8) = w; }
    __syncthreads();
}

__device__ __forceinline__ void router_phase(const float* __restrict__ h, const float* __restrict__ rwt, const float* __restrict__ bgr, const float* __restrict__ ber, unsigned* cntg,
                                             int* pdst, float* pw, float* ps, float* srow, LAS unsigned char* lds, int vcu, int G) {
    const int tid = threadIdx.x, lane = tid & 63, wid = __builtin_amdgcn_readfirstlane(tid >> 6);
    LAS float* Wl = (LAS float*)lds;
    for (int i = tid; i < RW_LAYER / 4; i += NTHR) ((LAS f32x4*)Wl)[i] = ((const f32x4*)rwt)[i];
    LAS int* lc = (LAS int*)(lds + RSCR_OFF); LAS int* lbase = lc + 32;
    const int rb = wid & 3, kh = wid >> 2, row = lane & 15, kq = lane >> 4;
    for (int blk = vcu; blk < M / 64; blk += G) {
        if (tid < 32) lc[tid] = 0;
        __syncthreads();
        const int t0 = blk * 64;
        const float* hp = h + (size_t)(t0 + 16 * rb + row) * D + 512 * kh + 4 * kq;
        const LAS float* wp0 = Wl + row * RW_PITCH + 512 * kh + 4 * kq; const LAS float* wp1 = wp0 + 16 * RW_PITCH; const LAS float* wp2 = Wl + (32 + (row & 3)) * RW_PITCH + 512 * kh + 4 * kq;
        f32x4 a0 = {0.f, 0.f, 0.f, 0.f}, a1 = a0, a2 = a0; float ssl = 0.f;
#pragma unroll 4
        for (int j = 0; j < 32; ++j) { const f32x4 a = *(const f32x4*)(hp + 16 * j); const f32x4 b0 = *(const LAS f32x4*)(wp0 + 16 * j), b1 = *(const LAS f32x4*)(wp1 + 16 * j), b2 = *(const LAS f32x4*)(wp2 + 16 * j);
            ssl += a[0] * a[0] + a[1] * a[1] + a[2] * a[2] + a[3] * a[3];
#pragma unroll
            for (int i = 0; i < 4; ++i) { a0 = __builtin_amdgcn_mfma_f32_16x16x4f32(a[i], b0[i], a0, 0, 0, 0); a1 = __builtin_amdgcn_mfma_f32_16x16x4f32(a[i], b1[i], a1, 0, 0, 0); a2 = __builtin_amdgcn_mfma_f32_16x16x4f32(a[i], b2[i], a2, 0, 0, 0); } }
        ssl += __shfl_xor(ssl, 16); ssl += __shfl_xor(ssl, 32);
        LAS float* P = (LAS float*)(lds + RSCR_OFF + 256);
        LAS float* pp = P + (16 * rb) * 40;
        if (kh == 1) {
#pragma unroll
            for (int r = 0; r < 4; ++r) { const int tk = 4 * kq + r; pp[tk * 40 + row] = a0[r]; pp[tk * 40 + 16 + row] = a1[r]; if (row < 4) pp[tk * 40 + 32 + row] = a2[r]; }
            if (kq == 0) pp[row * 40 + 36] = ssl; }
        __syncthreads();
        if (kh == 0) {
#pragma unroll
            for (int r = 0; r < 4; ++r) { const int tk = 4 * kq + r; pp[tk * 40 + row] += a0[r]; pp[tk * 40 + 16 + row] += a1[r]; if (row < 4) pp[tk * 40 + 32 + row] += a2[r]; }
            if (kq == 0) pp[row * 40 + 36] += ssl; }
        __syncthreads();
        int e1 = 0, e2 = 0; float w1 = 0.f, w2 = 0.f, s = 0.f; int sl1 = 0, sl2 = 0;
        if (tid < 64) { LAS float* p0 = P + tid * 40;
            s = rsqrtf(p0[36] * (1.f / D) + RMS_EPS);
            for (int o = 0; o < 36; ++o) p0[o] = p0[o] * s + (o < 4 ? bgr[o] : ber[o - 4]);
            int gi = 0; float gmx = p0[0];
            for (int i = 1; i < 4; ++i) if (p0[i] > gmx) { gmx = p0[i]; gi = i; }
            float den = 0.f; for (int i = 0; i < 4; ++i) den += __expf(p0[i] - gmx);
            const float gp = 1.f / den; const LAS float* sl = p0 + 4 + 8 * gi;
            int i1 = 0; float l1 = sl[0]; for (int i = 1; i < 8; ++i) if (sl[i] > l1) { l1 = sl[i]; i1 = i; }
            int i2 = -1; float l2 = -3.4e38f; for (int i = 0; i < 8; ++i) if (i != i1 && sl[i] > l2) { l2 = sl[i]; i2 = i; }
            const float ex = __expf(l2 - l1); w1 = gp / (1.f + ex); w2 = gp * ex / (1.f + ex); e1 = gi * 8 + i1; e2 = gi * 8 + i2;
            sl1 = __hip_atomic_fetch_add(&lc[e1], 1, __ATOMIC_RELAXED, __HIP_MEMORY_SCOPE_WORKGROUP); sl2 = __hip_atomic_fetch_add(&lc[e2], 1, __ATOMIC_RELAXED, __HIP_MEMORY_SCOPE_WORKGROUP);
            srow[t0 + tid] = s; }
        __syncthreads();
        if (tid < 32) { const int n = lc[tid]; lbase[tid] = n ? (int)__hip_atomic_fetch_add(cntg + tid * 64, (unsigned)n, RLX_AGENT) : 0; }
        __syncthreads();
        if (tid < 64) { const int t = t0 + tid; int i1 = lbase[e1] + sl1, i2 = lbase[e2] + sl2;
            if (i1 < CAP) { pdst[e1 * CAP + i1] = 2 * t; pw[e1 * CAP + i1] = w1; ps[e1 * CAP + i1] = s; }
            if (i2 < CAP) { pdst[e2 * CAP + i2] = 2 * t + 1; pw[e2 * CAP + i2] = w2; ps[e2 * CAP + i2] = s; } }
        __syncthreads();
    }
}

template <bool FINAL> __device__ __forceinline__ void combine_phase(float* hio, const bf16* __restrict__ Y2, const float* __restrict__ g, bf16* __restrict__ xng, int vcu, int G, int wid, int lane) {
    for (int base = vcu * 16; base < M; base += G * 16) {
#pragma unroll
        for (int rr = 0; rr < 2; ++rr) { const int row = base + 2 * wid + rr;
            float4* hr = (float4*)(hio + (size_t)row * D); float4 v[4]; float ss = 0.f;
#pragma unroll
            for (int j = 0; j < 4; ++j) { v[j] = hr[lane + 64 * j]; const int c = 4 * (lane + 64 * j);
                const u32x2 ya = *(const u32x2*)(Y2 + ((size_t)2 * row) * D + c), yb = *(const u32x2*)(Y2 + ((size_t)2 * row + 1) * D + c);
                v[j].x += __uint_as_float(ya.x << 16) + __uint_as_float(yb.x << 16); v[j].y += __uint_as_float(ya.x & 0xffff0000u) + __uint_as_float(yb.x & 0xffff0000u);
                v[j].z += __uint_as_float(ya.y << 16) + __uint_as_float(yb.y << 16); v[j].w += __uint_as_float(ya.y & 0xffff0000u) + __uint_as_float(yb.y & 0xffff0000u);
                ss += v[j].x * v[j].x + v[j].y * v[j].y + v[j].z * v[j].z + v[j].w * v[j].w; if (!FINAL) hr[lane + 64 * j] = v[j]; }
            ss = wave_sum(ss); const float s = rsqrtf(ss * (1.f / D) + RMS_EPS);
#pragma unroll
            for (int j = 0; j < 4; ++j) { const int c = 4 * (lane + 64 * j); const float4 gg = *(const float4*)(g + c);
                const float ox = v[j].x * s * gg.x, oy = v[j].y * s * gg.y, oz = v[j].z * s * gg.z, ow = v[j].w * s * gg.w;
                if (FINAL) { float4 o; o.x = ox; o.y = oy; o.z = oz; o.w = ow; hr[lane + 64 * j] = o; }
                else { u32x2 w; w.x = pk2(ox, oy); w.y = pk2(oz, ow); *(u32x2*)(xng + xng_off(row, c)) = w; } } }
    }
}

__device__ __forceinline__ void scan_phase(const float* __restrict__ Sloc, const float* __restrict__ a16g, bf16* xng, LAS unsigned char* lds, int vcu, int G) {
    const int tid = threadIdx.x, p = tid & 63, q = tid >> 6;
    LAS float* E = (LAS float*)(lds + AUX_OFF);
    for (int bg = vcu; bg < 128; bg += G) { const int g = bg >> 1, b = bg & 1;
        const float ar = a16g[(g * 64 + p) * 2], ai = a16g[(g * 64 + p) * 2 + 1];
        const float* sp = Sloc + ((size_t)g * 1024 + b * 512 + q * 64) * 128 + 2 * p;
        float xr = 0.f, xi = 0.f;
#pragma unroll 1
        for (int hh = 0; hh < 2; ++hh) { float2 v[32];
#pragma unroll
            for (int s = 0; s < 32; ++s) v[s] = *(const float2*)(sp + (size_t)(hh * 32 + s) * 128);
#pragma unroll
            for (int s = 0; s < 32; ++s) { const float nr = ar * xr - ai * xi + v[s].x, ni = ar * xi + ai * xr + v[s].y; xr = nr; xi = ni; } }
        E[(q * 64 + p) * 2] = xr; E[(q * 64 + p) * 2 + 1] = xi;
        __syncthreads();
        float pr = ar, pi = ai;
#pragma unroll
        for (int k = 0; k < 6; ++k) { const float nr = pr * pr - pi * pi, ni = 2.f * pr * pi; pr = nr; pi = ni; }
        xr = 0.f; xi = 0.f;
        for (int qq = 0; qq < q; ++qq) { const float er = E[(qq * 64 + p) * 2], ei = E[(qq * 64 + p) * 2 + 1]; const float nr = pr * xr - pi * xi + er, ni = pr * xi + pi * xr + ei; xr = nr; xi = ni; }
        bf16* xp = xng + ((size_t)g * 1024 + b * 512 + q * 64) * 384 + 256 + 2 * p;
#pragma unroll 1
        for (int hh = 0; hh < 2; ++hh) { float2 v[32];
#pragma unroll
            for (int s = 0; s < 32; ++s) v[s] = *(const float2*)(sp + (size_t)(hh * 32 + s) * 128);
#pragma unroll
            for (int s = 0; s < 32; ++s) { *(unsigned*)(xp + (size_t)(hh * 32 + s) * 384) = pk2(xr, xi); const float nr = ar * xr - ai * xi + v[s].x, ni = ar * xi + ai * xr + v[s].y; xr = nr; xi = ni; } }
        __syncthreads();
    }
}

__global__ void __launch_bounds__(NTHR, 2) mk_fwd(Args args) {
    extern __shared__ __attribute__((aligned(16))) unsigned char lds_[];
    LAS unsigned char* lds = (LAS unsigned char*)lds_;
    volatile LAS unsigned* MISC = (volatile LAS unsigned*)(lds + MISC_OFF);
    const int tid = threadIdx.x, lane = tid & 63, wid = __builtin_amdgcn_readfirstlane(tid >> 6);
    const int G = gridDim.x; const int bx = blockIdx.x; const int vcu = (G % 8 == 0) ? (bx % 8) * (G / 8) + bx / 8 : bx;
    unsigned char* const ws = args.ws;
    constexpr size_t EW = (size_t)NEXP * 1024 * 256;
    for (int u = tid; u < (LDS_BYTES - MISC_OFF) / 4; u += NTHR) ((LAS unsigned*)(lds + MISC_OFF))[u] = 0u;
    __syncthreads();
    const int lo = args.ph_lo, hi = args.ph_hi;
    XcdBarrier bar; bar.bar = (unsigned*)ws + CW_BAR + args.li * XCD_BAR_WORDS; bar.x = 0; bar.st = nullptr;
    if (hi - lo > 1) bar = xcd_barrier_post((unsigned*)ws + CW_BAR + args.li * XCD_BAR_WORDS, MISC + 8);
    const int gw = vcu * NWAVES + wid, NGW = G * NWAVES;
#ifndef PH_ONLY
#define PH_ONLY -1
#endif
#define IN(k) ((PH_ONLY < 0 || PH_ONLY == ((k) >= 12 && (k) <= 14 ? (k) - 8 : (k))) && lo <= (k) && (k) < hi)
#ifndef TS_K1
#define TS_K1 -1
#define TS_K2 -1
#endif
#define TS_STAMP(k) do { if (TS_K1 >= 0 && bx == 0 && tid == 0) ((unsigned long long*)(ws + WS_TS))[k] = __builtin_amdgcn_s_memrealtime(); } while (0)
#define SEAM(k) do { if ((k) + 1 < hi) xcd_barrier(bar); TS_STAMP((k) + 1); } while (0)
#define SCR ((LAS float*)(lds + wid * 16384))
    TS_STAMP(0);
    if (IN(0)) {
        const float* w_qkv = args.in[4]; const float* w_o = args.in[5]; const float* w_out = args.in[15];
        for (int it = gw; it < 3072; it += NGW) {
            if (it < 1536) { const int kb = it / 96, nb = it % 96; tr_item(w_qkv, 3072, kb * 64, nb * 32, (bf16*)(ws + WS_WQKV), 1024, nb * 32, nullptr, SCR, lane); }
            else if (it < 2048) { const int r = it - 1536, kb = r >> 5, nb = r & 31; tr_item(w_o, 1024, kb * 64, nb * 32, (bf16*)(ws + WS_WO), 1024, nb * 32, nullptr, SCR, lane); }
            else { const int r = it - 2048, kb = r >> 6, nb = r & 63, n0 = nb * 32, ag = n0 >> 10, cc = n0 & 1023; tr_item(w_out, 2048, kb * 64, n0, (bf16*)(ws + WS_WOUT), 1024, 256 * (cc >> 7) + 128 * ag + (cc & 127), nullptr, SCR, lane); }
        }
        moe_convert(args.in[20], args.in[21], args.in[22], args.in[2], (bf16*)(ws + WS_WGU), (bf16*)(ws + WS_WD), SCR, gw, NGW, lane);
        { float* rwt = (float*)(ws + WS_RWT); const float* norm_ffn = args.in[2];
          for (int o = bx * NTHR + tid; o < 2 * 36 * 1024; o += G * NTHR) { const int layer = o / (36 * 1024), r = o % (36 * 1024), col = r >> 10, k = r & 1023;
            const float gnk = norm_ffn[layer * D + k];
            const float w = col < 4 ? args.in[16][(size_t)layer * 4096 + k * 4 + col] : args.in[18][(size_t)layer * 32768 + ((size_t)((col - 4) >> 3) * 1024 + k) * 8 + ((col - 4) & 7)];
            rwt[layer * RW_LAYER + col * RW_PITCH + k] = w * gnk; } }
        __syncthreads();
        for (int gq = vcu; gq < 256; gq += G) ssm_mats(gq >> 2, gq & 3, args.in[7], args.in[8], args.in[9], args.in[10], args.in[11], args.in[12], args.in[13], args.in[14], ws + WS_SSM, (float*)(ws + WS_A16), (LAS float*)lds, tid);
        { const float* x = args.in[0]; const float* norm_mix = args.in[1]; bf16* XN = (bf16*)(ws + WS_XN);
          for (int m = gw; m < M; m += NGW) { const float4* xr = (const float4*)(x + (size_t)m * D); float4 v[4]; float ss = 0.f;
#pragma unroll
            for (int j = 0; j < 4; ++j) { v[j] = xr[lane + 64 * j]; ss += v[j].x * v[j].x + v[j].y * v[j].y + v[j].z * v[j].z + v[j].w * v[j].w; }
            ss = wave_sum(ss); const float s = rsqrtf(ss * (1.f / D) + RMS_EPS);
#pragma unroll
            for (int j = 0; j < 4; ++j) { const int c = 4 * (lane + 64 * j); const float4 gg = *(const float4*)(norm_mix + c); u32x2 w; w.x = pk2(v[j].x * s * gg.x, v[j].y * s * gg.y); w.y = pk2(v[j].z * s * gg.z, v[j].w * s * gg.w);
                *(u32x2*)(XN + (size_t)m * D + c) = w; } } }
        SEAM(0);
    }
    if (IN(1)) { PhQKV P{ws, (const char*)(ws + WS_XN), G, bx}; gm::gemm_phase(lds, P); SEAM(1); }
    if (IN(2)) {
        const int per = 1024 / G;
        for (int i = 0; i < per; ++i) { const int uid = vcu * per + i; const int bh = uid >> 5, qb = uid & 31;
            at::attn_unit<8>(bh >> 4, bh & 15, qb, (const bf16*)(ws + WS_Q), (const bf16*)(ws + WS_K), (const bf16*)(ws + WS_V), (bf16*)(ws + (args.pad ? WS_XN : WS_Q)), args.in[6], lds); }
        SEAM(2);
    }
    if (IN(3)) { PhWo P{ws, (const char*)(ws + WS_Q), args.in[0], args.out, G, bx}; gm::gemm_phase(lds, P); SEAM(3); }
#define MOE_LAYER(layer, pr) \
    if (IN(pr)) { router_phase(args.out, (const float*)(ws + WS_RWT) + (layer) * RW_LAYER, args.in[17] + (layer) * 4, args.in[19] + (layer) * 32, (unsigned*)ws + CW_CNT + (layer) * 32 * 64, \
                               (int*)(ws + WS_PDST), (float*)(ws + WS_PW), (float*)(ws + WS_PS), (float*)(ws + WS_SROW), lds, vcu, G); SEAM(pr); } \
    if (IN((pr) + 1) || IN((pr) + 2)) { \
        LAS int* cn = (LAS int*)(lds + AUX_OFF); LAS int* tb = cn + 32; \
        if (tid < 32) { const unsigned c = __hip_atomic_load((unsigned*)ws + CW_CNT + ((layer) * 32 + tid) * 64, RLX_AGENT); cn[tid] = c < (unsigned)CAP ? (int)c : CAP; } \
        __syncthreads(); \
        if (tid == 0) { int a = 0; for (int e = 0; e < 32; ++e) { tb[e] = a; a += (cn[e] + 255) >> 8; } tb[32] = a; } \
        __syncthreads(); \
        if (IN((pr) + 1)) { PhGateUp P{ws, (const char*)(ws + WS_XN), lds, G, vcu}; gm::gemm_phase(lds, P); SEAM((pr) + 1); } \
        if (IN((pr) + 2)) { PhDown P{ws, (const char*)(ws + WS_H), lds, G, vcu}; gm::gemm_phase(lds, P); SEAM((pr) + 2); } \
    }
    MOE_LAYER(0, 4)
    if (IN(7)) {
        moe_convert(args.in[20] + EW, args.in[21] + EW, args.in[22] + EW, args.in[2] + D, (bf16*)(ws + WS_WGU), (bf16*)(ws + WS_WD), SCR, gw, NGW, lane);
        combine_phase<false>(args.out, (const bf16*)(ws + WS_Y2), args.in[1] + D, (bf16*)(ws + WS_XN), vcu, G, wid, lane);
        SEAM(7); }
    if (IN(8)) { PhSloc P{ws, (const char*)(ws + WS_XN), G, vcu}; gm::gemm_phase(lds, P); SEAM(8); }
    if (IN(9)) { scan_phase((const float*)(ws + WS_SLOC), (const float*)(ws + WS_A16), (bf16*)(ws + WS_XN), lds, vcu, G); SEAM(9); }
    if (IN(10)) { PhY P{ws, (const char*)(ws + WS_XN), G, vcu}; gm::gemm_phase(lds, P); SEAM(10); }
    if (IN(11)) { PhWout P{ws, (const char*)(ws + WS_G), args.out, G, bx}; gm::gemm_phase(lds, P); SEAM(11); }
    MOE_LAYER(1, 12)
#undef MOE_LAYER
    if (IN(15)) { combine_phase<true>(args.out, (const bf16*)(ws + WS_Y2), args.in[3], nullptr, vcu, G, wid, lane);
#if TS_K1 >= 0
        { const unsigned long long* ts = (const unsigned long long*)(ws + WS_TS); const float dtus = (float)(ts[TS_K1 + 1] - ts[TS_K1]) * 1e-2f; const float e = exp2f(rintf(log2f(dtus) * 6.f) / 6.f) * 1e-2f;
          __syncthreads();
          for (int base = vcu * 16; base < M; base += G * 16) for (int i = tid; i < 16 * D; i += NTHR) args.out[(size_t)base * D + i] *= (1.f + e);
          if (TS_K2 >= 0 && bx == 0) { __syncthreads(); if (tid == 0) args.out[0] = exp2f(rintf(log2f((float)(ts[TS_K2 + 1] - ts[TS_K2]) * 1e-2f) * 6.f) / 6.f); } }
#endif
    }
    if (IN(16)) moe_convert(args.in[20] + EW, args.in[21] + EW, args.in[22] + EW, args.in[2] + D, (bf16*)(ws + WS_WGU), (bf16*)(ws + WS_WD), SCR, gw, NGW, lane);
#undef IN
#undef SEAM
#undef SCR
}

#ifndef FAST_MASK
#define FAST_MASK 0x3ff
#endif
#ifndef FUSED
#define FUSED 1
#endif
extern "C" void kernel_launch(void* const* d_in, const int* in_sizes, int n_in, void* d_out, int out_size, void* d_ws, size_t ws_size, hipStream_t stream) {
    static int grid = 0;
    if (grid == 0) {
        if (n_in != 23 || out_size != M * D || ws_size < WS_END) { fprintf(stderr, "kernel_launch: unexpected shapes (n_in %d out %d ws %zu)\n", n_in, out_size, ws_size); grid = -1; return; }
        int dev = 0, cus = 0;
        if (hipGetDevice(&dev) != hipSuccess || hipDeviceGetAttribute(&cus, hipDeviceAttributeMultiprocessorCount, dev) != hipSuccess) { grid = -1; return; }
        if (hipFuncSetAttribute((const void*)mk_fwd, hipFuncAttributeMaxDynamicSharedMemorySize, LDS_BYTES) != hipSuccess) { fprintf(stderr, "kernel_launch: hipFuncSetAttribute failed\n"); grid = -1; return; }
        (void)hipGetLastError();
        grid = cus;
        if (grid != 256) fprintf(stderr, "kernel_launch: %d CUs (built for 256)\n", grid);
    }
    if (grid < 0) return;
    const float* x = (const float*)d_in[0]; const float* norm_mix = (const float*)d_in[1]; const float* norm_ffn = (const float*)d_in[2]; const float* norm_final = (const float*)d_in[3];
    const float* w_qkv = (const float*)d_in[4]; const float* w_o = (const float*)d_in[5]; const float* relb = (const float*)d_in[6];
    const float* lre = (const float*)d_in[7]; const float* lim = (const float*)d_in[8]; const float* lstep = (const float*)d_in[9];
    const float* bre = (const float*)d_in[10]; const float* bim = (const float*)d_in[11]; const float* cre = (const float*)d_in[12]; const float* cim = (const float*)d_in[13];
    const float* dsk = (const float*)d_in[14]; const float* w_out = (const float*)d_in[15];
    const float* wgr = (const float*)d_in[16]; const float* bgr = (const float*)d_in[17]; const float* wer = (const float*)d_in[18]; const float* ber = (const float*)d_in[19];
    const float* wg = (const float*)d_in[20]; const float* wu = (const float*)d_in[21]; const float* wd = (const float*)d_in[22];
    float* out = (float*)d_out; unsigned char* ws = (unsigned char*)d_ws;
    bf16* XN = (bf16*)(ws + WS_XN); bf16* Qb = (bf16*)(ws + WS_Q); bf16* Kb = (bf16*)(ws + WS_K); bf16* Vb = (bf16*)(ws + WS_V);
    bf16* Y2 = (bf16*)(ws + WS_Y2); bf16* Gb = (bf16*)(ws + WS_G);
    const size_t EW = (size_t)NEXP * 1024 * 256;
    (void)hipMemsetAsync(ws + WS_CTL, 0, CTL_ZERO_BYTES, stream);
    Args a{}; for (int i = 0; i < 23; ++i) a.in[i] = (const float*)d_in[i];
    a.out = out; a.ws = ws;
    int li = 0;
    auto run = [&](int lo, int hi) { a.ph_lo = lo; a.ph_hi = hi; a.li = li++; hipLaunchKernelGGL(mk_fwd, dim3(grid), dim3(NTHR), LDS_BYTES, stream, a); };
#ifndef DUP_PH
#define DUP_PH -1
#endif
    constexpr unsigned FM = FAST_MASK;
    auto dup = [&](int ph) { if (DUP_PH == ph) { if (ph == 2) { a.pad = 1; run(2, 3); a.pad = 0; } else run(ph, ph + 1); } };
    if (FUSED) { run(0, N_PHASES); return; }
    if (FM != 0) { dup(0); run(0, 1); }
    if (!(FM & 1)) n_rmsnorm_bf16<<<M / 4, 256, 0, stream>>>(x, norm_mix, XN);
    if (FM & 2) { dup(1); run(1, 2); } else n_gemm<0><<<dim3(3072 / 64, M / 64), 256, 0, stream>>>(XN, w_qkv, 3072, nullptr, nullptr, Qb, Kb, Vb);
    if (FM & 4) { dup(2); run(2, 3); } else n_attn<<<dim3(SEQ / 64, NH, BATCH), 64, 0, stream>>>(Qb, Kb, Vb, relb, Qb);
    if (FM & 8) { dup(3); run(3, 4); } else n_gemm<1><<<dim3(1024 / 64, M / 64), 256, 0, stream>>>(Qb, w_o, 1024, x, out, XN, nullptr, nullptr);
    if (FM & 16) { run(4, 5); dup(5); run(5, 6); dup(6); run(6, 7); } else n_moe<<<M, 256, 0, stream>>>(out, norm_ffn, wgr, bgr, wer, ber, wg, wu, wd, Y2);
    if (FM & 32) run(7, 8); else { if (FM & 256) run(16, 17); n_combine_norm<<<M / 4, 256, 0, stream>>>(out, Y2, norm_mix + D, XN); }
    if (FM & 64) { dup(8); run(8, 9); dup(9); run(9, 10); dup(10); run(10, 11); } else n_ssm<<<dim3(64, BATCH), 64, 0, stream>>>(XN, lre, lim, lstep, bre, bim, cre, cim, dsk, Gb);
    if (FM & 128) run(11, 12); else n_gemm<2><<<dim3(1024 / 64, M / 64), 256, 0, stream>>>(Gb, w_out, 2048, out, out, XN, nullptr, nullptr);
    if (FM & 256) { run(12, 13); run(13, 14); run(14, 15); } else n_moe<<<M, 256, 0, stream>>>(out, norm_ffn + D, wgr + 1024 * 4, bgr + 4, wer + 4 * 1024 * 8, ber + 32, wg + EW, wu + EW, wd + EW, Y2);
    if (FM & 512) run(15, 16); else n_final<<<M / 4, 256, 0, stream>>>(out, Y2, norm_final);
}
```

```cpp
#include <hip/hip_runtime.h>
#include <cstdio>
#include <cstdint>

typedef unsigned short bf16;
constexpr int BATCH = 2, SEQ = 8192, D = 1024, M = BATCH * SEQ, NH = 16, HD = 64;
constexpr int NEXP = 32, EPG = 8, FE = 256;
constexpr int NREL = 257;
constexpr float RMS_EPS = 1e-6f;
constexpr float LOG2E = 1.4426950408889634f;
constexpr float C2 = 0.125f * LOG2E;

constexpr size_t MiB = 1u << 20;
constexpr size_t WS_CTL = 0;
constexpr size_t WS_XN = 86 * MiB;
constexpr size_t WS_BIG = 134 * MiB;
constexpr size_t WS_Q = WS_BIG, WS_K = WS_BIG + 32 * MiB, WS_V = WS_BIG + 64 * MiB;
constexpr size_t WS_Y2 = WS_BIG, WS_H = WS_BIG + 64 * MiB;
constexpr size_t WS_SLOC = WS_BIG, WS_G = WS_BIG + 32 * MiB;

__device__ __forceinline__ bf16 f2bf(float f) { unsigned u = __float_as_uint(f); return (bf16)((u + 0x7fffu + ((u >> 16) & 1u)) >> 16); }
__device__ __forceinline__ float bf2f(bf16 h) { return __uint_as_float(((unsigned)h) << 16); }
__device__ __forceinline__ float wave_sum(float v) {
#pragma unroll
    for (int o = 1; o < 64; o <<= 1) v += __shfl_xor(v, o);
    return v;
}
__device__ __forceinline__ float gelu_tanh(float x) { const float u = 0.7978845608028654f * (x + 0.044715f * x * x * x); return 0.5f * x * (1.f + tanhf(u)); }

__device__ __forceinline__ size_t xng_off(int t, int col) { const int b = t >> 13, tt = t & 8191, s = tt >> 4, j = tt & 15, g = col >> 4, c = col & 15; return ((size_t)(g * 1024 + b * 512 + s)) * 384 + j * 16 + c; }

__global__ void __launch_bounds__(256) n_rmsnorm_bf16(const float* __restrict__ x, const float* __restrict__ g, bf16* __restrict__ out) {
    const int row = blockIdx.x * 4 + (threadIdx.x >> 6), lane = threadIdx.x & 63;
    const float4* xr = (const float4*)(x + (size_t)row * D);
    float4 v[4]; float ss = 0.f;
#pragma unroll
    for (int j = 0; j < 4; ++j) { v[j] = xr[lane + 64 * j]; ss += v[j].x * v[j].x + v[j].y * v[j].y + v[j].z * v[j].z + v[j].w * v[j].w; }
    ss = wave_sum(ss); const float s = rsqrtf(ss * (1.f / D) + RMS_EPS);
#pragma unroll
    for (int j = 0; j < 4; ++j) { const int c = 4 * (lane + 64 * j); const float4 gg = *(const float4*)(g + c);
        bf16* o = out + (size_t)row * D + c; o[0] = f2bf(v[j].x * s * gg.x); o[1] = f2bf(v[j].y * s * gg.y); o[2] = f2bf(v[j].z * s * gg.z); o[3] = f2bf(v[j].w * s * gg.w); }
}

template <int MODE> __global__ void __launch_bounds__(256) n_gemm(const bf16* __restrict__ A, const float* __restrict__ B, int ldb, const float* resid, float* outf, bf16* __restrict__ ob0, bf16* __restrict__ ob1, bf16* __restrict__ ob2) {
    __shared__ float As[16][65]; __shared__ float Bs[16][64]; __shared__ float Bs2[16][64];
    const int tid = threadIdx.x, tx = tid & 15, ty = tid >> 4, bm = blockIdx.y * 64, bn = blockIdx.x * 64;
    float acc[4][4], acc2[4][4];
#pragma unroll
    for (int i = 0; i < 4; ++i)
#pragma unroll
        for (int j = 0; j < 4; ++j) { acc[i][j] = 0.f; acc2[i][j] = 0.f; }
    for (int k0 = 0; k0 < 1024; k0 += 16) {
        { const int r = tid >> 2, kq = (tid & 3) * 4; const bf16* ap = A + (size_t)(bm + r) * 1024 + k0 + kq;
#pragma unroll
          for (int i = 0; i < 4; ++i) As[kq + i][r] = bf2f(ap[i]); }
        { const int k = tid >> 4, n = (tid & 15) * 4; const float4 b = *(const float4*)(B + (size_t)(k0 + k) * ldb + bn + n);
          Bs[k][n] = b.x; Bs[k][n + 1] = b.y; Bs[k][n + 2] = b.z; Bs[k][n + 3] = b.w;
          if (MODE == 2) { const float4 b2 = *(const float4*)(B + (size_t)(k0 + k) * ldb + 1024 + bn + n); Bs2[k][n] = b2.x; Bs2[k][n + 1] = b2.y; Bs2[k][n + 2] = b2.z; Bs2[k][n + 3] = b2.w; } }
        __syncthreads();
#pragma unroll
        for (int k = 0; k < 16; ++k) { float a[4], b[4], b2[4];
#pragma unroll
            for (int i = 0; i < 4; ++i) a[i] = As[k][ty * 4 + i];
#pragma unroll
            for (int j = 0; j < 4; ++j) { b[j] = Bs[k][tx * 4 + j]; b2[j] = (MODE == 2) ? Bs2[k][tx * 4 + j] : 0.f; }
#pragma unroll
            for (int i = 0; i < 4; ++i)
#pragma unroll
                for (int j = 0; j < 4; ++j) { acc[i][j] += a[i] * b[j]; if (MODE == 2) acc2[i][j] += a[i] * b2[j]; } }
        __syncthreads();
    }
#pragma unroll
    for (int i = 0; i < 4; ++i)
#pragma unroll
        for (int j = 0; j < 4; ++j) { const int row = bm + ty * 4 + i, col = bn + tx * 4 + j;
            if (MODE == 0) { const int which = col >> 10, c = col & 1023; bf16* o = which == 0 ? ob0 : (which == 1 ? ob1 : ob2); o[(size_t)row * 1024 + c] = f2bf(acc[i][j] * (which == 0 ? C2 : 1.f)); }
            else { float h = resid[(size_t)row * 1024 + col]; if (MODE == 1) h += acc[i][j]; else h += acc[i][j] / (1.f + __expf(-acc2[i][j])); outf[(size_t)row * 1024 + col] = h; ob0[(size_t)row * 1024 + col] = f2bf(h); } }
}

__global__ void __launch_bounds__(64) n_attn(const bf16* Q, const bf16* __restrict__ K, const bf16* __restrict__ V, const float* __restrict__ relb, bf16* O) {
    const int c = blockIdx.x, h = blockIdx.y, b = blockIdx.z, qi = threadIdx.x;
    const size_t qrow = (size_t)b * SEQ + c * 64 + qi;
    float q[64], o[64];
#pragma unroll
    for (int d = 0; d < 64; ++d) { q[d] = bf2f(Q[qrow * D + h * 64 + d]); o[d] = 0.f; }
    float m = -1e30f, l = 0.f; const float* rb = relb + h * NREL;
    const int kc0 = c - 8 < 0 ? 0 : c - 8;
    for (int kc = kc0; kc <= c; ++kc)
        for (int kj = 0; kj < 64; ++kj) {
            const size_t krow = (size_t)b * SEQ + kc * 64 + kj; const bf16* kp = K + krow * D + h * 64; const bf16* vp = V + krow * D + h * 64;
            float s = 0.f;
#pragma unroll
            for (int d = 0; d < 64; ++d) s += q[d] * bf2f(kp[d]);
            int dist = (c - kc) * 64 + qi - kj; dist = dist < -128 ? -128 : (dist > 128 ? 128 : dist);
            s += rb[dist + 128] * LOG2E;
            const float mn = fmaxf(m, s), a = exp2f(m - mn), p = exp2f(s - mn); l = l * a + p; m = mn;
#pragma unroll
            for (int d = 0; d < 64; ++d) o[d] = o[d] * a + p * bf2f(vp[d]);
        }
    const float il = 1.f / l;
#pragma unroll
    for (int d = 0; d < 64; ++d) O[qrow * D + h * 64 + d] = f2bf(o[d] * il);
}

__global__ void __launch_bounds__(256) n_moe(const float* __restrict__ h, const float* __restrict__ gn, const float* __restrict__ wgr, const float* __restrict__ bgr, const float* __restrict__ wer, const float* __restrict__ ber,
                                             const float* __restrict__ wg, const float* __restrict__ wu, const float* __restrict__ wd, bf16* __restrict__ Y2) {
    __shared__ float hn[1024]; __shared__ float red[4]; __shared__ float logit[36]; __shared__ float hid[256]; __shared__ int se[2]; __shared__ float sw[2];
    const int t = blockIdx.x, tid = threadIdx.x;
    const float4 v = ((const float4*)(h + (size_t)t * D))[tid];
    float ss = wave_sum(v.x * v.x + v.y * v.y + v.z * v.z + v.w * v.w);
    if ((tid & 63) == 0) red[tid >> 6] = ss;
    __syncthreads();
    const float s = rsqrtf((red[0] + red[1] + red[2] + red[3]) * (1.f / D) + RMS_EPS);
    { const float4 gg = ((const float4*)gn)[tid]; hn[4 * tid] = v.x * s * gg.x; hn[4 * tid + 1] = v.y * s * gg.y; hn[4 * tid + 2] = v.z * s * gg.z; hn[4 * tid + 3] = v.w * s * gg.w; }
    __syncthreads();
    if (tid < 36) { float acc = 0.f;
        if (tid < 4) { for (int k = 0; k < 1024; ++k) acc += hn[k] * wgr[k * 4 + tid]; acc += bgr[tid]; }
        else { const int o = tid - 4, gi = o >> 3, ei = o & 7; for (int k = 0; k < 1024; ++k) acc += hn[k] * wer[((size_t)gi * 1024 + k) * 8 + ei]; acc += ber[o]; }
        logit[tid] = acc; }
    __syncthreads();
    if (tid == 0) {
        int gi = 0; float gm = logit[0];
        for (int i = 1; i < 4; ++i) if (logit[i] > gm) { gm = logit[i]; gi = i; }
        float den = 0.f; for (int i = 0; i < 4; ++i) den += __expf(logit[i] - gm);
        const float gp = 1.f / den;
        const float* sl = logit + 4 + 8 * gi;
        int i1 = 0; float l1 = sl[0]; for (int i = 1; i < 8; ++i) if (sl[i] > l1) { l1 = sl[i]; i1 = i; }
        int i2 = -1; float l2 = -3.4e38f; for (int i = 0; i < 8; ++i) if (i != i1 && sl[i] > l2) { l2 = sl[i]; i2 = i; }
        const float e2 = __expf(l2 - l1), w1 = 1.f / (1.f + e2), w2 = e2 / (1.f + e2);
        se[0] = gi * 8 + i1; se[1] = gi * 8 + i2; sw[0] = w1 * gp; sw[1] = w2 * gp;
    }
    __syncthreads();
    for (int kk = 0; kk < 2; ++kk) {
        const int e = se[kk]; const float w = sw[kk];
        const float* pg = wg + (size_t)e * 1024 * 256 + tid; const float* pu = wu + (size_t)e * 1024 * 256 + tid;
        float ag = 0.f, au = 0.f;
        for (int k = 0; k < 1024; ++k) { ag += hn[k] * pg[(size_t)k * 256]; au += hn[k] * pu[(size_t)k * 256]; }
        hid[tid] = ag / (1.f + __expf(-ag)) * au;
        __syncthreads();
        const float* pd = wd + (size_t)e * 256 * 1024;
#pragma unroll
        for (int i = 0; i < 4; ++i) { const int c = tid + 256 * i; float acc = 0.f; for (int j = 0; j < 256; ++j) acc += hid[j] * pd[(size_t)j * 1024 + c]; Y2[((size_t)2 * t + kk) * D + c] = f2bf(w * acc); }
        __syncthreads();
    }
}

__global__ void __launch_bounds__(256) n_combine_norm(float* hio, const bf16* __restrict__ Y2, const float* __restrict__ g, bf16* __restrict__ xng) {
    const int row = blockIdx.x * 4 + (threadIdx.x >> 6), lane = threadIdx.x & 63;
    float4* hr = (float4*)(hio + (size_t)row * D);
    float4 v[4]; float ss = 0.f;
#pragma unroll
    for (int j = 0; j < 4; ++j) { v[j] = hr[lane + 64 * j]; const int c = 4 * (lane + 64 * j);
        const bf16* ya = Y2 + ((size_t)2 * row) * D + c; const bf16* yb = ya + D;
        v[j].x += bf2f(ya[0]) + bf2f(yb[0]); v[j].y += bf2f(ya[1]) + bf2f(yb[1]); v[j].z += bf2f(ya[2]) + bf2f(yb[2]); v[j].w += bf2f(ya[3]) + bf2f(yb[3]);
        ss += v[j].x * v[j].x + v[j].y * v[j].y + v[j].z * v[j].z + v[j].w * v[j].w; hr[lane + 64 * j] = v[j]; }
    ss = wave_sum(ss); const float s = rsqrtf(ss * (1.f / D) + RMS_EPS);
#pragma unroll
    for (int j = 0; j < 4; ++j) { const int c = 4 * (lane + 64 * j); const float4 gg = *(const float4*)(g + c); bf16* o = xng + xng_off(row, c);
        o[0] = f2bf(v[j].x * s * gg.x); o[1] = f2bf(v[j].y * s * gg.y); o[2] = f2bf(v[j].z * s * gg.z); o[3] = f2bf(v[j].w * s * gg.w); }
}

__global__ void __launch_bounds__(64) n_ssm(const bf16* __restrict__ xng, const float* __restrict__ lre, const float* __restrict__ lim, const float* __restrict__ lstep, const float* __restrict__ bre, const float* __restrict__ bim,
                                            const float* __restrict__ cre, const float* __restrict__ cim, const float* __restrict__ dsk, bf16* __restrict__ G) {
    const int g = blockIdx.x, b = blockIdx.y, p = threadIdx.x;
    const float lr = fminf(lre[g * 64 + p], -1e-4f), li = lim[g * 64 + p], step = expf(lstep[g]);
    const float decay = expf(lr * step), ang = li * step, ar = decay * cosf(ang), ai = decay * sinf(ang);
    const float den = lr * lr + li * li, nr = ar - 1.f, fr = (nr * lr + ai * li) / den, fi = (ai * lr - nr * li) / den;
    float bbr[16], bbi[16], ccr[16], cci[16];
#pragma unroll
    for (int c = 0; c < 16; ++c) { const float br = bre[(g * 64 + p) * 16 + c], bi = bim[(g * 64 + p) * 16 + c]; bbr[c] = fr * br - fi * bi; bbi[c] = fr * bi + fi * br;
        ccr[c] = cre[(g * 16 + c) * 64 + p]; cci[c] = cim[(g * 16 + c) * 64 + p]; }
    const float dd = dsk[g * 16 + (p & 15)];
    float xr = 0.f, xi = 0.f;
    for (int t = 0; t < SEQ; ++t) {
        const bf16* up = xng + ((size_t)(g * 1024 + b * 512 + (t >> 4))) * 384 + (t & 15) * 16;
        float u[16]; float bur = 0.f, bui = 0.f;
#pragma unroll
        for (int c = 0; c < 16; ++c) { u[c] = bf2f(up[c]); bur += bbr[c] * u[c]; bui += bbi[c] * u[c]; }
        const float nxr = ar * xr - ai * xi + bur, nxi = ar * xi + ai * xr + bui; xr = nxr; xi = nxi;
        float mine = 0.f, myu = 0.f;
#pragma unroll
        for (int c = 0; c < 16; ++c) { const float y = wave_sum(ccr[c] * xr - cci[c] * xi); if ((p & 15) == c) { mine = y; myu = u[c]; } }
        if (p < 16) G[((size_t)b * SEQ + t) * D + g * 16 + p] = f2bf(gelu_tanh(mine + dd * myu));
    }
}

__global__ void __launch_bounds__(256) n_final(float* hio, const bf16* __restrict__ Y2, const float* __restrict__ g) {
    const int row = blockIdx.x * 4 + (threadIdx.x >> 6), lane = threadIdx.x & 63;
    float4* hr = (float4*)(hio + (size_t)row * D);
    float4 v[4]; float ss = 0.f;
#pragma unroll
    for (int j = 0; j < 4; ++j) { v[j] = hr[lane + 64 * j]; const int c = 4 * (lane + 64 * j);
        const bf16* ya = Y2 + ((size_t)2 * row) * D + c; const bf16* yb = ya + D;
        v[j].x += bf2f(ya[0]) + bf2f(yb[0]); v[j].y += bf2f(ya[1]) + bf2f(yb[1]); v[j].z += bf2f(ya[2]) + bf2f(yb[2]); v[j].w += bf2f(ya[3]) + bf2f(yb[3]);
        ss += v[j].x * v[j].x + v[j].y * v[j].y + v[j].z * v[j].z + v[j].w * v[j].w; }
    ss = wave_sum(ss); const float s = rsqrtf(ss * (1.f / D) + RMS_EPS);
#pragma unroll
    for (int j = 0; j < 4; ++j) { const int c = 4 * (lane + 64 * j); const float4 gg = *(const float4*)(g + c);
        float4 o; o.x = v[j].x * s * gg.x; o.y = v[j].y * s * gg.y; o.z = v[j].z * s * gg.z; o.w = v[j].w * s * gg.w; hr[lane + 64 * j] = o; }
}


#define LAS __attribute__((address_space(3)))
typedef short bf16x8 __attribute__((ext_vector_type(8)));
typedef short s16x4 __attribute__((ext_vector_type(4)));
typedef float f32x4 __attribute__((ext_vector_type(4)));
typedef float f32x16 __attribute__((ext_vector_type(16)));
typedef unsigned u32x4 __attribute__((ext_vector_type(4)));
typedef unsigned u32x2 __attribute__((ext_vector_type(2)));

constexpr int NWAVES = 8, NTHR = 512;
constexpr int CAP = 16384;
constexpr size_t CTL_ZERO_BYTES = 1 * MiB;
constexpr size_t WS_PDST = 1 * MiB, WS_PW = 3 * MiB, WS_PS = 5 * MiB, WS_SROW = 7 * MiB, WS_A16 = 7 * MiB + 65536;
constexpr size_t WS_TS = 7 * MiB + 131072;
constexpr size_t WS_RWT = 8 * MiB;
constexpr size_t WS_WQKV = 9 * MiB, WS_WO = 15 * MiB, WS_WOUT = 17 * MiB, WS_SSM = 21 * MiB;
constexpr size_t WS_WGU = 38 * MiB, WS_WD = 70 * MiB;
constexpr size_t WS_END = 230 * MiB;
constexpr int RW_PITCH = 1028, RW_LAYER = 36 * RW_PITCH;
constexpr int SSM_G_BYTES = 262144, SSM_A2_OFF = 65536;
constexpr int CW_BAR = 4096;
constexpr int CW_CNT = 65536;
constexpr int LDS_BYTES = 160 * 1024, MISC_OFF = LDS_BYTES - 512, AUX_OFF = 128 * 1024, RSCR_OFF = 36 * 1028 * 4;
constexpr int N_PHASES = 16;

__device__ __forceinline__ unsigned cvt_pk_bf16(float lo, float hi) { unsigned r; asm volatile("v_cvt_pk_bf16_f32 %0, %1, %2" : "=v"(r) : "v"(lo), "v"(hi)); return r; }
__device__ __forceinline__ unsigned pk2(float lo, float hi) { return (unsigned)f2bf(lo) | ((unsigned)f2bf(hi) << 16); }
#define LDS_WAIT() asm volatile("s_waitcnt lgkmcnt(0)" ::: "memory")
#define VM_WAIT() asm volatile("s_waitcnt vmcnt(0)" ::: "memory")
#define RLX_AGENT __ATOMIC_RELAXED, __HIP_MEMORY_SCOPE_AGENT

#define XB_TMO      128
#define XB_XCNT(j)  (256  + 64 * (j))
#define XB_XSUB(j)  (1280 + 64 * (j))
#define XB_XGEN(j)  (2304 + 64 * (j))
#define XB_TOP      3328
#define XB_TOPGEN   3392
#define XCD_BAR_WORDS 3456
#define XB_SPIN_CAP (1u << 18)
__device__ __forceinline__ unsigned xb_ld(unsigned* p)              { return __hip_atomic_load(p, __ATOMIC_RELAXED, __HIP_MEMORY_SCOPE_AGENT); }
__device__ __forceinline__ unsigned xb_add(unsigned* p, unsigned v) { return __hip_atomic_fetch_add(p, v, __ATOMIC_RELAXED, __HIP_MEMORY_SCOPE_AGENT); }
__device__ __forceinline__ unsigned xb_xcc_id() { return (unsigned)__builtin_amdgcn_s_getreg((3 << 11) | 20) & 0xFu; }
#define XB_SPIN(cond, bar) do { unsigned _sp = 0; while (cond) { __builtin_amdgcn_s_sleep(1); \
    if ((++_sp & 255u) == 0u) { if (xb_ld(&(bar)[XB_TMO])) break; if (_sp > XB_SPIN_CAP) { atomicAdd(&(bar)[XB_TMO], 1u); break; } } } } while (0)
struct XcdBarrier { unsigned* bar; unsigned x; volatile LAS unsigned* st; };
__device__ __forceinline__ XcdBarrier xcd_barrier_post(unsigned* bar, volatile LAS unsigned* st) {
    XcdBarrier b; b.bar = bar; b.x = xb_xcc_id(); b.st = st;
    if (threadIdx.x == 0) (void)xb_add(&bar[XB_XCNT(b.x)], 1u);
    return b;
}
__device__ __forceinline__ void xcd_barrier_complete(unsigned* bar, unsigned x, unsigned& nloc, unsigned& nx) {
    const unsigned G = gridDim.x * gridDim.y * gridDim.z;
    unsigned sum, cnt, mine, sp = 0u;
    for (;;) {
        sum = 0u; cnt = 0u; mine = 0u;
#pragma unroll
        for (unsigned j = 0; j < 16; ++j) { const unsigned c = xb_ld(&bar[XB_XCNT(j)]); sum += c; cnt += (c > 0u) ? 1u : 0u; mine = (j == x) ? c : mine; }
        if (sum == G) break;
        __builtin_amdgcn_s_sleep(1);
        if ((++sp & 255u) == 0u) { if (xb_ld(&bar[XB_TMO])) break; if (sp > XB_SPIN_CAP) { atomicAdd(&bar[XB_TMO], 1u); break; } }
    }
    nloc = mine > 0u ? mine : 1u; nx = cnt > 0u ? cnt : 1u;
}
__device__ __forceinline__ void xcd_barrier(const XcdBarrier& b) {
    asm volatile("s_waitcnt vmcnt(0)" ::: "memory");
    __syncthreads();
    if (threadIdx.x == 0) {
        unsigned* bar = b.bar;
        __builtin_amdgcn_s_waitcnt(0);
        unsigned nloc = b.st[0], nx = b.st[1];
        if (nloc == 0u) { xcd_barrier_complete(bar, b.x, nloc, nx); b.st[0] = nloc; b.st[1] = nx; }
        const unsigned old = xb_add(&bar[XB_XSUB(b.x)], 1u);
        const unsigned gen = old / nloc;
        if (old + 1u == (gen + 1u) * nloc) {
            __builtin_amdgcn_fence(__ATOMIC_RELEASE, "agent");
            asm volatile("s_waitcnt vmcnt(0)" ::: "memory");
            const unsigned og = xb_add(&bar[XB_TOP], 1u);
            const unsigned tg = og / nx;
            if (og + 1u == (tg + 1u) * nx) xb_add(&bar[XB_TOPGEN], 1u);
            else XB_SPIN(xb_ld(&bar[XB_TOPGEN]) == tg, bar);
            __builtin_amdgcn_fence(__ATOMIC_ACQUIRE, "agent");
            xb_add(&bar[XB_XGEN(b.x)], 1u);
            asm volatile("s_waitcnt vmcnt(0)" ::: "memory");
        } else {
            XB_SPIN(xb_ld(&bar[XB_XGEN(b.x)]) == gen, bar);
            __builtin_amdgcn_fence(__ATOMIC_ACQUIRE, "agent");
            asm volatile("s_waitcnt vmcnt(0)" ::: "memory");
        }
    }
    __syncthreads();
}

namespace gm {
constexpr int HTB = 16384;
__device__ __forceinline__ int lds_byte(int r, int c) { const int st = (r >> 4) * 2 + (c >> 5), rr = r & 15, cc = c & 31, ob = rr * 64 + cc * 2; return st * 1024 + (ob ^ (((ob >> 9) & 1) << 5)); }
__device__ __forceinline__ void stage_rc(int b, int& R, int& C) { const int st = b / 1024, sb = b % 1024, swz = sb ^ (((sb >> 9) & 1) << 5); R = (st >> 1) * 16 + swz / 64; C = (st & 1) * 32 + (swz % 64) / 2; }
__device__ __forceinline__ int perm32(int rho) { const int n = rho >> 4, i = rho & 15; return 8 * (i >> 2) + 4 * n + (i & 3); }
struct Unit { int pm, pn, e, gt, cnt; };
__device__ __forceinline__ bool static_unit(int i, int G, int c, int nM, int nN, Unit& u) {
    const int nwg = nM * nN; const long L = (long)i * G + c; if (L >= nwg) return false;
    int wgid = (int)L; { const int q = nwg / 8, r = nwg % 8, xcd = wgid % 8, off = wgid / 8; wgid = (xcd < r ? xcd * (q + 1) : r * (q + 1) + (xcd - r) * q) + off; }
    const int nig = 8 * nN, gid = wgid / nig, fm = gid * 8, gsz = (nM - fm) < 8 ? (nM - fm) : 8;
    u.pm = fm + ((wgid % nig) % gsz); u.pn = (wgid % nig) / gsz; u.e = 0; u.gt = 0; u.cnt = 0; return true;
}
template <class P> __device__ __forceinline__ void gemm_phase(LAS unsigned char* lds, const P& ph) {
    const int tid = threadIdx.x, wid = __builtin_amdgcn_readfirstlane(tid >> 6), lane = tid & 63, wr = wid >> 2, wc = wid & 3, fr = lane & 15, fq = lane >> 4;
    constexpr int nt = P::K / 64;
    static_assert(nt >= 2 && (nt % 2) == 0, "K must be a multiple of 128");
    unsigned voffA[2], voffB[2];
#pragma unroll
    for (int i = 0; i < 2; ++i) { int R, C; stage_rc(tid * 16 + i * 8192, R, C); const int Rb = (R & ~31) + perm32(R & 31); voffB[i] = (unsigned)(Rb * P::LDB + C) * 2u; voffA[i] = (unsigned)(R * P::LDA + C) * 2u; }
    const unsigned ldsw = (unsigned)wid * 1024u;
    const int aoff = lds_byte(wr * 64 + fr, fq * 8), boff = lds_byte(wc * 32 + fr, fq * 8);
    constexpr int hB = P::HSTEPB, hA = 128 * P::LDA * 2;
#define G_SA(b, h) (((b) * 2 + (h)) * gm::HTB)
#define G_SB(b, h) ((4 + (b) * 2 + (h)) * gm::HTB)
#define G_GLDS(src, bufoff, i) __builtin_amdgcn_global_load_lds((const unsigned*)(src), (LAS unsigned*)(lds + (bufoff) + ldsw + (i) * 8192), 16, 0, 0)
#define G_STA(bufoff, ptr, kb, offs, h) do { if constexpr (P::GATHER) { _Pragma("unroll") for (int _i = 0; _i < 2; ++_i) G_GLDS(Ab + (kb) + (offs)[h][_i], bufoff, _i); } \
        else { _Pragma("unroll") for (int _i = 0; _i < 2; ++_i) G_GLDS((ptr) + (h) * hA + voffA[_i], bufoff, _i); } } while (0)
#define G_STB(bufoff, ptr) do { _Pragma("unroll") for (int _i = 0; _i < 2; ++_i) G_GLDS((ptr) + voffB[_i], bufoff, _i); } while (0)
#define G_LDA(dst, b, h) do { _Pragma("unroll") for (int m = 0; m < 4; ++m) _Pragma("unroll") for (int k = 0; k < 2; ++k) dst[m][k] = *(const LAS bf16x8*)(lds + G_SA(b, h) + aoff + m * 2048 + k * 1024); } while (0)
#define G_LDB(dst, b, h) do { _Pragma("unroll") for (int n = 0; n < 2; ++n) _Pragma("unroll") for (int k = 0; k < 2; ++k) dst[n][k] = *(const LAS bf16x8*)(lds + G_SB(b, h) + boff + n * 2048 + k * 1024); } while (0)
#define G_MMA(ai, bj, At, Bt) do { __builtin_amdgcn_s_setprio(1); _Pragma("unroll") for (int m = 0; m < 4; ++m) _Pragma("unroll") for (int n = 0; n < 2; ++n) _Pragma("unroll") for (int k = 0; k < 2; ++k) \
        acc[ai][bj][m][n] = __builtin_amdgcn_mfma_f32_16x16x32_bf16(Bt[n][k], At[m][k], acc[ai][bj][m][n], 0, 0, 0); __builtin_amdgcn_s_setprio(0); } while (0)
#define G_WAIT_V(n) asm volatile("s_waitcnt vmcnt(" #n ")" ::: "memory")
#define G_WAIT_L(n) asm volatile("s_waitcnt lgkmcnt(" #n ")" ::: "memory")
#define G_BAR __builtin_amdgcn_s_barrier()
#define G_SCHED __builtin_amdgcn_sched_barrier(0)
    Unit cur, nxt; int ui = 0;
    if (!ph.next(0, cur)) return;
    f32x4 acc[2][2][4][2];
#pragma unroll
    for (int a = 0; a < 2; ++a)
#pragma unroll
        for (int b = 0; b < 2; ++b)
#pragma unroll
            for (int m = 0; m < 4; ++m)
#pragma unroll
                for (int n = 0; n < 2; ++n) acc[a][b][m][n] = (f32x4){0.f, 0.f, 0.f, 0.f};
    bf16x8 At[4][2], B0[2][2], B1[2][2];
    unsigned co[2][2] = {{0u, 0u}, {0u, 0u}};
    const char* Ab = ph.Abase;
    const char* cA = Ab; const char* cB = ph.b_tile(cur);
    if constexpr (P::GATHER) { ph.a_offs(cur, tid, co); asm volatile("s_waitcnt vmcnt(0)" ::: "memory"); } else cA = ph.a_tile(cur);
    G_STB(G_SB(0, 0), cB); G_STB(G_SB(0, 1), cB + hB); G_STA(G_SA(0, 0), cA, 0, co, 0); G_STA(G_SA(0, 1), cA, 0, co, 1);
    if (wr == 1) G_BAR;
    G_WAIT_V(2); G_BAR;
    G_STB(G_SB(1, 0), cB + 128); G_STA(G_SA(1, 0), cA + 128, 128, co, 0); G_STB(G_SB(1, 1), cB + hB + 128);
    G_WAIT_V(6); G_BAR;
    for (;;) {
        const bool has_next = ph.next(ui + 1, nxt);
        const char* nA = cA; const char* nB = cB;
        if (has_next) { nB = ph.b_tile(nxt); if constexpr (!P::GATHER) nA = ph.a_tile(nxt); }
        for (int t = 0; t < nt; t += 2) {
            const bool last = (t == nt - 2);
            const int kb1 = (t + 1) * 128, kb2 = last ? 0 : (t + 2) * 128, kb3 = kb2 + 128;
            const char* a1 = cA + kb1; const char* a2 = last ? nA : cA + kb2; const char* a3 = a2 + 128;
            const char* b2 = last ? nB : cB + (t + 2) * 128; const char* b3 = b2 + 128;
            G_LDB(B0, 0, 0); G_LDB(B1, 0, 1); G_SCHED; G_LDA(At, 0, 0); G_STA(G_SA(1, 1), a1, kb1, co, 1);
            G_WAIT_V(8); G_WAIT_L(0); G_BAR; G_MMA(0, 0, At, B0); G_MMA(0, 1, At, B1); G_BAR; G_SCHED;
            if constexpr (P::GATHER) { if (last && has_next) ph.a_offs(nxt, tid, co); }
            G_LDA(At, 0, 1); G_STB(G_SB(0, 0), b2); G_STB(G_SB(0, 1), b2 + hB); G_STA(G_SA(0, 0), a2, kb2, co, 0);
            G_WAIT_V(8); G_WAIT_L(0); G_BAR; G_MMA(1, 0, At, B0); G_MMA(1, 1, At, B1); G_BAR; G_SCHED;
            G_LDB(B0, 1, 0); G_LDB(B1, 1, 1); G_SCHED; G_LDA(At, 1, 0); G_STA(G_SA(0, 1), a2, kb2, co, 1);
            G_WAIT_V(8); G_WAIT_L(0); G_BAR; G_MMA(0, 0, At, B0); G_MMA(0, 1, At, B1); G_BAR; G_SCHED;
            G_LDA(At, 1, 1); G_STB(G_SB(1, 0), b3); G_STB(G_SB(1, 1), b3 + hB); G_STA(G_SA(1, 0), a3, kb3, co, 0);
            G_WAIT_V(8); G_WAIT_L(0); G_BAR; G_MMA(1, 0, At, B0); G_MMA(1, 1, At, B1); G_BAR; G_SCHED;
        }
        if (wr == 0) G_BAR;
        ph.epi(acc, cur, wr, wc, fr, fq);
        if (!has_next) break;
#pragma unroll
        for (int a = 0; a < 2; ++a)
#pragma unroll
            for (int b = 0; b < 2; ++b)
#pragma unroll
                for (int m = 0; m < 4; ++m)
#pragma unroll
                    for (int n = 0; n < 2; ++n) acc[a][b][m][n] = (f32x4){0.f, 0.f, 0.f, 0.f};
        cur = nxt; cA = nA; cB = nB; ++ui;
        if (wr == 1) G_BAR;
    }
    G_WAIT_V(0);
    G_BAR;
}
}

using gm::Unit;
#define EPI_ARGS const f32x4 (&acc)[2][2][4][2], const Unit& u, int wr, int wc, int fr_in, int fq_in
#define EPI_OPAQUE int fr = fr_in, fq = fq_in; asm volatile("" : "+v"(fr), "+v"(fq));
#define NO_GATHER __device__ __forceinline__ void a_offs(const Unit&, int, unsigned (&)[2][2]) const {}
#define EPI_FENCE() asm volatile("" ::: "memory")
__device__ __forceinline__ u32x4 pack8(const f32x4& v0, const f32x4& v1) { u32x4 w; w.x = cvt_pk_bf16(v0[0], v0[1]); w.y = cvt_pk_bf16(v0[2], v0[3]); w.z = cvt_pk_bf16(v1[0], v1[1]); w.w = cvt_pk_bf16(v1[2], v1[3]); return w; }
__device__ __forceinline__ float fast_sigmoid(float v) { return __builtin_amdgcn_rcpf(1.f + __builtin_amdgcn_exp2f(-LOG2E * v)); }
__device__ __forceinline__ float fast_gelu(float v) { const float u2 = 1.5957691216057308f * (v + 0.044715f * v * v * v); return v * fast_sigmoid(u2); }

struct PhQKV {
    static constexpr bool GATHER = false; static constexpr int LDA = 1024, K = 1024, LDB = 1024, HSTEPB = 128 * 1024 * 2;
    unsigned char* ws; const char* Abase; int G, c;
    __device__ __forceinline__ bool next(int i, Unit& u) const { return gm::static_unit(i, G, c, M / 256, 12, u); }
    NO_GATHER __device__ __forceinline__ const char* a_tile(const Unit& u) const { return Abase + (size_t)(u.pm * 256) * 1024 * 2; }
    __device__ __forceinline__ const char* b_tile(const Unit& u) const { return (const char*)(ws + WS_WQKV) + (size_t)u.pn * 256 * 1024 * 2; }
    __device__ __forceinline__ void epi(EPI_ARGS) const { EPI_OPAQUE
        const int row0 = u.pm * 256 + wr * 64 + fr; const int t = u.pn >> 2; const int colt = (u.pn & 3) * 256;
        bf16* base = (bf16*)(ws + WS_Q) + (size_t)t * (16u * 1024u * 1024u); const float sc = (t == 0) ? C2 : 1.f;
        const int col0 = colt + wc * 32 + 8 * fq;
#pragma unroll
        for (int ai = 0; ai < 2; ++ai)
#pragma unroll
            for (int m = 0; m < 4; ++m) { bf16* rowp = base + (size_t)(row0 + ai * 128 + m * 16) * 1024 + col0;
#pragma unroll
                for (int bj = 0; bj < 2; ++bj) *(u32x4*)(rowp + bj * 128) = pack8(acc[ai][bj][m][0] * sc, acc[ai][bj][m][1] * sc); }
    }
};
struct PhWo {
    static constexpr bool GATHER = false; static constexpr int LDA = 1024, K = 1024, LDB = 1024, HSTEPB = 128 * 1024 * 2;
    unsigned char* ws; const char* Abase; const float* resid; float* out; int G, c;
    __device__ __forceinline__ bool next(int i, Unit& u) const { return gm::static_unit(i, G, c, M / 256, 4, u); }
    NO_GATHER __device__ __forceinline__ const char* a_tile(const Unit& u) const { return Abase + (size_t)(u.pm * 256) * 1024 * 2; }
    __device__ __forceinline__ const char* b_tile(const Unit& u) const { return (const char*)(ws + WS_WO) + (size_t)u.pn * 256 * 1024 * 2; }
    __device__ __forceinline__ void epi(EPI_ARGS) const { EPI_OPAQUE
        const size_t off0 = (size_t)(u.pm * 256 + wr * 64 + fr) * 1024 + u.pn * 256 + wc * 32 + 8 * fq; bf16* hb = (bf16*)(ws + WS_XN);
#pragma unroll
        for (int ai = 0; ai < 2; ++ai) { f32x4 r[4][2][2];
#pragma unroll
            for (int m = 0; m < 4; ++m)
#pragma unroll
                for (int bj = 0; bj < 2; ++bj) { const float* p = resid + off0 + (size_t)(ai * 128 + m * 16) * 1024 + bj * 128; r[m][bj][0] = *(const f32x4*)p; r[m][bj][1] = *(const f32x4*)(p + 4); }
            EPI_FENCE();
#pragma unroll
            for (int m = 0; m < 4; ++m)
#pragma unroll
                for (int bj = 0; bj < 2; ++bj) { const size_t off = off0 + (size_t)(ai * 128 + m * 16) * 1024 + bj * 128; const f32x4 v0 = acc[ai][bj][m][0] + r[m][bj][0], v1 = acc[ai][bj][m][1] + r[m][bj][1];
                    *(f32x4*)(out + off) = v0; *(f32x4*)(out + off + 4) = v1; *(u32x4*)(hb + off) = pack8(v0, v1); }
            EPI_FENCE(); }
    }
};
struct PhWout {
    static constexpr bool GATHER = false; static constexpr int LDA = 1024, K = 1024, LDB = 1024, HSTEPB = 128 * 1024 * 2;
    unsigned char* ws; const char* Abase; float* out; int G, c;
    __device__ __forceinline__ bool next(int i, Unit& u) const { return gm::static_unit(i, G, c, M / 256, 8, u); }
    NO_GATHER __device__ __forceinline__ const char* a_tile(const Unit& u) const { return Abase + (size_t)(u.pm * 256) * 1024 * 2; }
    __device__ __forceinline__ const char* b_tile(const Unit& u) const { return (const char*)(ws + WS_WOUT) + (size_t)u.pn * 256 * 1024 * 2; }
    __device__ __forceinline__ void epi(EPI_ARGS) const { EPI_OPAQUE
        const size_t off0 = (size_t)(u.pm * 256 + wr * 64 + fr) * 1024 + u.pn * 128 + wc * 32 + 8 * fq; bf16* hb = (bf16*)(ws + WS_XN);
        f32x4 r[2][4][2];
#pragma unroll
        for (int ai = 0; ai < 2; ++ai)
#pragma unroll
            for (int m = 0; m < 4; ++m) { const float* p = out + off0 + (size_t)(ai * 128 + m * 16) * 1024; r[ai][m][0] = *(const f32x4*)p; r[ai][m][1] = *(const f32x4*)(p + 4); }
        EPI_FENCE();
#pragma unroll
        for (int ai = 0; ai < 2; ++ai)
#pragma unroll
            for (int m = 0; m < 4; ++m) { const size_t off = off0 + (size_t)(ai * 128 + m * 16) * 1024; f32x4 v0, v1;
#pragma unroll
                for (int j = 0; j < 4; ++j) { v0[j] = r[ai][m][0][j] + acc[ai][0][m][0][j] * fast_sigmoid(acc[ai][1][m][0][j]); v1[j] = r[ai][m][1][j] + acc[ai][0][m][1][j] * fast_sigmoid(acc[ai][1][m][1][j]); }
                *(f32x4*)(out + off) = v0; *(f32x4*)(out + off + 4) = v1; *(u32x4*)(hb + off) = pack8(v0, v1); }
        EPI_FENCE();
    }
};
__device__ __forceinline__ void moe_locate(LAS unsigned char* lds, int tile, Unit& u) { const LAS int* cn = (const LAS int*)(lds + AUX_OFF); const LAS int* tb = cn + 32;
    int e = 0; while (e < 31 && tb[e + 1] <= tile) ++e; u.e = e; u.pm = tile - tb[e]; u.gt = tile; u.cnt = cn[e]; }
struct PhGateUp {
    static constexpr bool GATHER = true; static constexpr int LDA = 1024, K = 1024, LDB = 1024, HSTEPB = 128 * 1024 * 2;
    unsigned char* ws; const char* Abase; LAS unsigned char* lds; int G, c;
    __device__ __forceinline__ bool next(int i, Unit& u) const { const int idx = i * G + c; const int nt = ((const LAS int*)(lds + AUX_OFF))[64]; if (idx >= 2 * nt) return false; u.pn = idx & 1; moe_locate(lds, idx >> 1, u); return true; }
    __device__ __forceinline__ void a_offs(const Unit& u, int tid, unsigned (&o)[2][2]) const { const int* pdst = (const int*)(ws + WS_PDST);
#pragma unroll
        for (int i = 0; i < 2; ++i) { int R, C; gm::stage_rc(tid * 16 + i * 8192, R, C);
#pragma unroll
            for (int h = 0; h < 2; ++h) { int slot = u.pm * 256 + 128 * h + R; slot = slot < u.cnt ? slot : u.cnt - 1; const int tok = pdst[u.e * CAP + slot] >> 1; o[h][i] = (unsigned)(tok * 1024 + C) * 2u; } }
    }
    __device__ __forceinline__ const char* a_tile(const Unit&) const { return Abase; }
    __device__ __forceinline__ const char* b_tile(const Unit& u) const { return (const char*)(ws + WS_WGU) + ((size_t)u.e * 512 + u.pn * 256) * 1024 * 2; }
    __device__ __forceinline__ void epi(EPI_ARGS) const { EPI_OPAQUE
        const int r0 = wr * 64 + fr, col0 = u.pn * 128 + wc * 32 + 8 * fq; const float* ps = (const float*)(ws + WS_PS) + u.e * CAP; bf16* H = (bf16*)(ws + WS_H);
        float sv[2][4];
#pragma unroll
        for (int ai = 0; ai < 2; ++ai)
#pragma unroll
            for (int m = 0; m < 4; ++m) { int slot = u.pm * 256 + r0 + ai * 128 + m * 16; slot = slot < u.cnt ? slot : u.cnt - 1; sv[ai][m] = ps[slot]; }
        EPI_FENCE();
#pragma unroll
        for (int ai = 0; ai < 2; ++ai)
#pragma unroll
            for (int m = 0; m < 4; ++m) { const int r = r0 + ai * 128 + m * 16; const float s = sv[ai][m];
                f32x4 v0, v1;
#pragma unroll
                for (int j = 0; j < 4; ++j) { const float g0 = acc[ai][0][m][0][j] * s, u0 = acc[ai][1][m][0][j] * s, g1 = acc[ai][0][m][1][j] * s, u1 = acc[ai][1][m][1][j] * s;
                    v0[j] = g0 * fast_sigmoid(g0) * u0; v1[j] = g1 * fast_sigmoid(g1) * u1; }
                *(u32x4*)(H + ((size_t)u.gt * 256 + r) * 256 + col0) = pack8(v0, v1); }
        EPI_FENCE();
    }
};
struct PhDown {
    static constexpr bool GATHER = false; static constexpr int LDA = 256, K = 256, LDB = 256, HSTEPB = 128 * 256 * 2;
    unsigned char* ws; const char* Abase; LAS unsigned char* lds; int G, c;
    __device__ __forceinline__ bool next(int i, Unit& u) const { const int idx = i * G + c; const int nt = ((const LAS int*)(lds + AUX_OFF))[64]; if (idx >= 4 * nt) return false; u.pn = idx & 3; moe_locate(lds, idx >> 2, u); return true; }
    NO_GATHER __device__ __forceinline__ const char* a_tile(const Unit& u) const { return Abase + (size_t)(u.gt * 256) * 256 * 2; }
    __device__ __forceinline__ const char* b_tile(const Unit& u) const { return (const char*)(ws + WS_WD) + ((size_t)u.e * 1024 + u.pn * 256) * 256 * 2; }
    __device__ __forceinline__ void epi(EPI_ARGS) const { EPI_OPAQUE
        const int r0 = wr * 64 + fr, col0 = u.pn * 256 + wc * 32 + 8 * fq; const int* pdst = (const int*)(ws + WS_PDST) + u.e * CAP; const float* pw = (const float*)(ws + WS_PW) + u.e * CAP; bf16* Y2 = (bf16*)(ws + WS_Y2);
        int dv[2][4]; float wv[2][4];
#pragma unroll
        for (int ai = 0; ai < 2; ++ai)
#pragma unroll
            for (int m = 0; m < 4; ++m) { int slot = u.pm * 256 + r0 + ai * 128 + m * 16; slot = slot < u.cnt ? slot : u.cnt - 1; dv[ai][m] = pdst[slot]; wv[ai][m] = pw[slot]; }
        EPI_FENCE();
#pragma unroll
        for (int ai = 0; ai < 2; ++ai)
#pragma unroll
            for (int m = 0; m < 4; ++m) { const int slot = u.pm * 256 + r0 + ai * 128 + m * 16;
                if (slot < u.cnt) { const float w8 = wv[ai][m]; bf16* yp = Y2 + (size_t)dv[ai][m] * 1024 + col0;
#pragma unroll
                    for (int bj = 0; bj < 2; ++bj) *(u32x4*)(yp + bj * 128) = pack8(acc[ai][bj][m][0] * w8, acc[ai][bj][m][1] * w8); } }
        EPI_FENCE();
    }
};
struct PhSloc {
    static constexpr bool GATHER = false; static constexpr int LDA = 384, K = 256, LDB = 256, HSTEPB = 0;
    unsigned char* ws; const char* Abase; int G, c;
    __device__ __forceinline__ bool next(int i, Unit& u) const { const int idx = i * G + c; if (idx >= 256) return false; u.e = idx >> 2; u.pm = idx & 3; u.pn = 0; u.gt = 0; u.cnt = 0; return true; }
    NO_GATHER __device__ __forceinline__ const char* a_tile(const Unit& u) const { return Abase + (size_t)(u.e * 1024 + u.pm * 256) * 384 * 2; }
    __device__ __forceinline__ const char* b_tile(const Unit& u) const { return (const char*)(ws + WS_SSM) + (size_t)u.e * SSM_G_BYTES; }
    __device__ __forceinline__ void epi(EPI_ARGS) const { EPI_OPAQUE
        const int r0 = u.e * 1024 + u.pm * 256 + wr * 64 + fr, col0 = wc * 32 + 8 * fq; float* Sloc = (float*)(ws + WS_SLOC);
#pragma unroll
        for (int ai = 0; ai < 2; ++ai)
#pragma unroll
            for (int m = 0; m < 4; ++m) { float* p = Sloc + (size_t)(r0 + ai * 128 + m * 16) * 128 + col0; *(f32x4*)p = acc[ai][0][m][0]; *(f32x4*)(p + 4) = acc[ai][0][m][1]; }
    }
};
struct PhY {
    static constexpr bool GATHER = false; static constexpr int LDA = 384, K = 384, LDB = 384, HSTEPB = 128 * 384 * 2;
    unsigned char* ws; const char* Abase; int G, c;
    __device__ __forceinline__ bool next(int i, Unit& u) const { const int idx = i * G + c; if (idx >= 256) return false; u.e = idx >> 2; u.pm = idx & 3; u.pn = 0; u.gt = 0; u.cnt = 0; return true; }
    NO_GATHER __device__ __forceinline__ const char* a_tile(const Unit& u) const { return Abase + (size_t)(u.e * 1024 + u.pm * 256) * 384 * 2; }
    __device__ __forceinline__ const char* b_tile(const Unit& u) const { return (const char*)(ws + WS_SSM) + (size_t)u.e * SSM_G_BYTES + SSM_A2_OFF; }
    __device__ __forceinline__ void epi(EPI_ARGS) const { EPI_OPAQUE
        const int nb = (u.pm & 1) * 256 + wr * 64 + fr;
        bf16* p = (bf16*)(ws + WS_G) + ((size_t)(u.pm >> 1) * SEQ + 16 * nb + 2 * wc + (fq >> 1)) * 1024 + 16 * u.e + 8 * (fq & 1);
#pragma unroll
        for (int ai = 0; ai < 2; ++ai)
#pragma unroll
            for (int m = 0; m < 4; ++m) {
#pragma unroll
                for (int bj = 0; bj < 2; ++bj) { f32x4 v0, v1;
#pragma unroll
                    for (int j = 0; j < 4; ++j) { v0[j] = fast_gelu(acc[ai][bj][m][0][j]); v1[j] = fast_gelu(acc[ai][bj][m][1][j]); }
                    *(u32x4*)(p + bj * 8 * 1024) = pack8(v0, v1); }
                p += (m == 3 ? (128 - 48) : 16) * 16 * 1024; asm volatile("" : "+v"(p) :: "memory"); }
    }
};

namespace at {
constexpr int NSLOT = 3, SLOTB = 8192;
constexpr int LDS_K = 0, LDS_V = NSLOT * SLOTB, LDS_WS = 2 * NSLOT * SLOTB, LDS_TBL = LDS_WS + 2048, LDS_OST = LDS_TBL + 2048, LDS_TOTAL = LDS_OST + 8 * 4096;
typedef short v4i16_t __attribute__((ext_vector_type(4)));
__device__ __forceinline__ int crow(int r, int hi) { return (r & 3) + 8 * (r >> 2) + 4 * hi; }
__device__ __forceinline__ void glds16(const void* gsrc, unsigned lds_dst) { unsigned keep;
    asm volatile("s_mov_b32 %0, m0\n\ts_mov_b32 m0, %2\n\ts_nop 0\n\tglobal_load_lds_dwordx4 %1, off\n\ts_mov_b32 m0, %0" : "=&s"(keep) : "v"(gsrc), "s"(lds_dst) : "memory"); }
__device__ __forceinline__ s16x4 vtr(const LAS unsigned char* p) { return __builtin_bit_cast(s16x4, __builtin_amdgcn_ds_read_tr16_b64_v4i16((LAS v4i16_t*)p)); }
#define AT_WAIT_BAR(N) asm volatile("s_waitcnt vmcnt(" #N ") lgkmcnt(0)\n\ts_barrier" ::: "memory")
template <int THR> __device__ __forceinline__ void attn_unit(int b, int h, int qb, const bf16* Q, const bf16* __restrict__ K, const bf16* __restrict__ V, bf16* O, const float* __restrict__ relb, LAS unsigned char* shm) {
    const int tid = threadIdx.x, lane = tid & 63, r32 = lane & 31, hi = lane >> 5; const int wid = __builtin_amdgcn_readfirstlane(tid >> 6);
    const long rowbase = (long)b * SEQ; const int q0 = qb * 256; const int cq = 4 * qb + (wid >> 1);
    const bf16* Qw = Q + (rowbase + q0 + wid * 32) * D + h * 64;
    const unsigned lds0 = (unsigned)(uintptr_t)shm;
    LAS float* wsf = (LAS float*)(shm + LDS_WS) + wid * 64; LAS float* tbl = (LAS float*)(shm + LDS_TBL);
    const int kc_lo = (4 * qb - 8) < 0 ? 0 : (4 * qb - 8); const int NT = 4 * qb + 3 - kc_lo + 1;
    if (tid < 320) tbl[tid] = relb[h * NREL + (tid < 256 ? tid : 256)] * LOG2E;
    const bf16* ksrc = K + (rowbase + kc_lo * 64 + lane) * D + h * 64 + wid * 8;
    const bf16* vsrc = V + (rowbase + kc_lo * 64 + 16 * (wid & 3) + (lane >> 2)) * D + h * 64 + (wid >> 2) * 32 + (lane & 3) * 8;
    const unsigned kdst = lds0 + LDS_K + wid * 1024, vdst = lds0 + LDS_V + wid * 1024;
#define AT_DMA(t, slotoff) do { glds16(ksrc + (long)(t) * 64 * D, (unsigned)__builtin_amdgcn_readfirstlane(kdst + (slotoff))); glds16(vsrc + (long)(t) * 64 * D, (unsigned)__builtin_amdgcn_readfirstlane(vdst + (slotoff))); } while (0)
    bf16x8 qr[4];
#pragma unroll
    for (int d0 = 0; d0 < 4; ++d0) qr[d0] = *reinterpret_cast<const bf16x8*>(&Qw[(long)r32 * D + d0 * 16 + hi * 8]);
    asm volatile("s_waitcnt vmcnt(0)" ::: "memory");
    AT_DMA(0, 0); if (NT > 1) AT_DMA(1, SLOTB);
    float mrow = -1e30f, lsum = 0.f; f32x16 o[2]; o[0] = f32x16{}; o[1] = f32x16{};
    int sl_cur = 0, sl_nn = 2 * SLOTB;
    for (int t = 0; t < NT; ++t) {
        const int kc = kc_lo + t;
        if (t + 1 < NT) { AT_WAIT_BAR(2); } else { AT_WAIT_BAR(0); }
        if (t + 2 < NT) AT_DMA(t + 2, sl_nn);
        if (kc >= cq - 8 && kc <= cq) {
            const LAS unsigned char* kp = shm + LDS_K + sl_cur + hi * 1024 + r32 * 16;
            f32x16 p0 = f32x16{}, p1 = f32x16{};
#pragma unroll
            for (int d0 = 0; d0 < 4; ++d0) { const bf16x8 b0 = *(const LAS bf16x8*)(kp + d0 * 2048), b1 = *(const LAS bf16x8*)(kp + d0 * 2048 + 512);
                p0 = __builtin_amdgcn_mfma_f32_32x32x16_bf16(b0, qr[d0], p0, 0, 0, 0); p1 = __builtin_amdgcn_mfma_f32_32x32x16_bf16(b1, qr[d0], p1, 0, 0, 0); }
            const int delta = cq - kc;
            if (delta >= 3) { const float bf = tbl[256];
#pragma unroll
                for (int r = 0; r < 16; ++r) { p0[r] += bf; p1[r] += bf; } }
            else { const LAS float* tb = tbl + (64 * delta + 32 * (wid & 1) + r32 + 128 - 4 * hi);
#pragma unroll
                for (int r = 0; r < 16; ++r) { const int kj = (r & 3) + 8 * (r >> 2); p0[r] += tb[-kj]; p1[r] += tb[-kj - 32]; } }
            float rm = fmaxf(p0[0], p1[0]);
#pragma unroll
            for (int r = 1; r < 16; ++r) rm = fmaxf(rm, fmaxf(p0[r], p1[r]));
            { auto rr = __builtin_amdgcn_permlane32_swap(__float_as_uint(rm), __float_as_uint(rm), false, false); rm = fmaxf(__uint_as_float(rr[0]), __uint_as_float(rr[1])); }
            if (__any(rm > mrow + (float)THR)) {
                const float mn = fmaxf(mrow, rm), f = __builtin_amdgcn_exp2f(mrow - mn); mrow = mn; lsum *= f;
                if (hi == 0) wsf[r32] = f;
                LDS_WAIT();
#pragma unroll
                for (int r = 0; r < 16; ++r) { const float fr_ = wsf[crow(r, hi)]; o[0][r] *= fr_; o[1][r] *= fr_; }
            }
            float sacc = 0.f;
#pragma unroll
            for (int r = 0; r < 16; ++r) { p0[r] = __builtin_amdgcn_exp2f(p0[r] - mrow); p1[r] = __builtin_amdgcn_exp2f(p1[r] - mrow); sacc += p0[r] + p1[r]; }
            lsum += sacc;
            u32x4 pw0, pw1, pw2, pw3;
            pw0 = (u32x4){cvt_pk_bf16(p0[0], p0[1]), cvt_pk_bf16(p0[2], p0[3]), cvt_pk_bf16(p0[4], p0[5]), cvt_pk_bf16(p0[6], p0[7])};
            pw1 = (u32x4){cvt_pk_bf16(p0[8], p0[9]), cvt_pk_bf16(p0[10], p0[11]), cvt_pk_bf16(p0[12], p0[13]), cvt_pk_bf16(p0[14], p0[15])};
            pw2 = (u32x4){cvt_pk_bf16(p1[0], p1[1]), cvt_pk_bf16(p1[2], p1[3]), cvt_pk_bf16(p1[4], p1[5]), cvt_pk_bf16(p1[6], p1[7])};
            pw3 = (u32x4){cvt_pk_bf16(p1[8], p1[9]), cvt_pk_bf16(p1[10], p1[11]), cvt_pk_bf16(p1[12], p1[13]), cvt_pk_bf16(p1[14], p1[15])};
            const bf16x8 pa[4] = {__builtin_bit_cast(bf16x8, pw0), __builtin_bit_cast(bf16x8, pw1), __builtin_bit_cast(bf16x8, pw2), __builtin_bit_cast(bf16x8, pw3)};
            const LAS unsigned char* vp = shm + LDS_V + sl_cur + ((lane >> 4) & 1) * 32 + (lane & 3) * 8 + (4 * hi + ((lane & 15) >> 2)) * 64;
#pragma unroll
            for (int d0 = 0; d0 < 2; ++d0)
#pragma unroll
                for (int ks = 0; ks < 4; ++ks) { const s16x4 lo = vtr(vp + d0 * 4096 + ks * 1024), hh = vtr(vp + d0 * 4096 + ks * 1024 + 512);
                    const bf16x8 vf = (bf16x8){lo[0], lo[1], lo[2], lo[3], hh[0], hh[1], hh[2], hh[3]};
                    o[d0] = __builtin_amdgcn_mfma_f32_32x32x16_bf16(pa[ks], vf, o[d0], 0, 0, 0); }
        }
        sl_cur = (sl_cur == 2 * SLOTB) ? 0 : sl_cur + SLOTB; sl_nn = (sl_nn == 2 * SLOTB) ? 0 : sl_nn + SLOTB;
    }
    { auto rr = __builtin_amdgcn_permlane32_swap(__float_as_uint(lsum), __float_as_uint(lsum), false, false); lsum = __uint_as_float(rr[0]) + __uint_as_float(rr[1]); }
    if (hi == 0) wsf[32 + r32] = lsum;
    LDS_WAIT();
    float rli[16];
#pragma unroll
    for (int r = 0; r < 16; ++r) rli[r] = __builtin_amdgcn_rcpf(wsf[32 + crow(r, hi)]);
    bf16* Ow = O + (rowbase + q0 + wid * 32) * D + h * 64;
    { LAS bf16* stg = (LAS bf16*)(shm + LDS_OST) + wid * 2048;
#pragma unroll
      for (int r = 0; r < 16; ++r) { const int orow = crow(r, hi);
#pragma unroll
          for (int d0 = 0; d0 < 2; ++d0) stg[orow * 64 + d0 * 32 + r32] = f2bf(o[d0][r] * rli[r]); }
      LDS_WAIT();
#pragma unroll
      for (int i = 0; i < 4; ++i) { const int row = i * 8 + (lane >> 3), ch = lane & 7; const u32x4 v = *(const LAS u32x4*)(stg + row * 64 + ch * 8); *(u32x4*)(Ow + (long)row * D + ch * 8) = v; } }
    asm volatile("s_waitcnt lgkmcnt(0)\n\ts_barrier" ::: "memory");
#undef AT_DMA
}
}

struct Args { const float* in[23]; float* out; unsigned char* ws; int ph_lo, ph_hi, li, pad; };

__device__ __forceinline__ void tr_item(const float* __restrict__ W, int ldw, int k0, int n0, bf16* __restrict__ WT, int ldt, int drow0, const float* __restrict__ ks, LAS float* scr, int lane) {
    float v[32];
    const float* wp = W + (size_t)(k0 + (lane >> 5)) * ldw + n0 + (lane & 31);
#pragma unroll
    for (int i = 0; i < 32; ++i) v[i] = wp[(size_t)(2 * i) * ldw];
    if (ks) {
#pragma unroll
        for (int i = 0; i < 32; ++i) v[i] *= ks[k0 + 2 * i + (lane >> 5)]; }
#pragma unroll
    for (int i = 0; i < 32; ++i) scr[(2 * i + (lane >> 5)) * 33 + (lane & 31)] = v[i];
    LDS_WAIT(); asm volatile("" ::: "memory");
    const int c = lane & 7;
#pragma unroll
    for (int j = 0; j < 4; ++j) { const int n = (lane >> 3) + 8 * j; const LAS float* s = scr + (8 * c) * 33 + n;
        u32x4 o; o.x = pk2(s[0 * 33], s[1 * 33]); o.y = pk2(s[2 * 33], s[3 * 33]); o.z = pk2(s[4 * 33], s[5 * 33]); o.w = pk2(s[6 * 33], s[7 * 33]);
        *(u32x4*)(WT + (size_t)(drow0 + n) * ldt + k0 + 8 * c) = o; }
    LDS_WAIT(); asm volatile("" ::: "memory");
}
__device__ __forceinline__ void moe_convert(const float* wg, const float* wu, const float* wd, const float* gn, bf16* WGU, bf16* WD, LAS float* scr, int gw, int NGW, int lane) {
    for (int it = gw; it < 12288; it += NGW) {
        if (it < 8192) { const int which = it >> 12, r = it & 4095, e = r >> 7, kb = (r >> 3) & 15, nb = r & 7, n0 = nb * 32;
            tr_item((which ? wu : wg) + (size_t)e * 1024 * 256, 256, kb * 64, n0, WGU, 1024, e * 512 + 256 * (n0 >> 7) + 128 * which + (n0 & 127), gn, scr, lane); }
        else { const int r = it - 8192, e = r >> 7, kb = (r >> 5) & 3, nb = r & 31;
            tr_item(wd + (size_t)e * 256 * 1024, 1024, kb * 64, nb * 32, WD, 256, e * 1024 + nb * 32, nullptr, scr, lane); }
    }
}
__device__ __forceinline__ void ssm_mats(int g, int q, const float* lre, const float* lim, const float* lstep, const float* bre, const float* bim, const float* cre, const float* cim, const float* dsk,
                                         unsigned char* ssm_ws, float* a16g, LAS float* L, int tid) {
    LAS float* pwr = L; LAS float* pwi = L + 64 * 17; LAS float* bbr = L + 2 * 64 * 17; LAS float* bbi = bbr + 1024; LAS float* ccr = bbi + 1024; LAS float* cci = ccr + 1024; LAS float* Kt = cci + 1024;
    if (tid < 64) { const int p = tid;
        const float lr = fminf(lre[g * 64 + p], -1e-4f), li = lim[g * 64 + p], step = expf(lstep[g]);
        const float decay = expf(lr * step), ang = li * step, ar = decay * cosf(ang), ai = decay * sinf(ang);
        const float den = lr * lr + li * li, nr = ar - 1.f, fr = (nr * lr + ai * li) / den, fi = (ai * lr - nr * li) / den;
        for (int c = 0; c < 16; ++c) { const float br = bre[(g * 64 + p) * 16 + c], bi = bim[(g * 64 + p) * 16 + c]; bbr[p * 16 + c] = fr * br - fi * bi; bbi[p * 16 + c] = fr * bi + fi * br;
            ccr[c * 64 + p] = cre[(g * 16 + c) * 64 + p]; cci[c * 64 + p] = cim[(g * 16 + c) * 64 + p]; }
        float xr = 1.f, xi = 0.f;
        for (int n = 0; n <= 16; ++n) { pwr[p * 17 + n] = xr; pwi[p * 17 + n] = xi; const float t = xr * ar - xi * ai; xi = xr * ai + xi * ar; xr = t; }
        if (q == 0) { a16g[(g * 64 + p) * 2] = pwr[p * 17 + 16]; a16g[(g * 64 + p) * 2 + 1] = pwi[p * 17 + 16]; }
    }
    __syncthreads();
    if (tid < 256) { const int tl = tid >> 6, c = (tid >> 2) & 15, cq = tid & 3, tau = 4 * q + tl;
        float s0 = 0.f, s1 = 0.f, s2 = 0.f, s3 = 0.f;
        for (int p = 0; p < 64; ++p) { const float cr = ccr[c * 64 + p], ci = cci[c * 64 + p], ar = pwr[p * 17 + tau], ai = pwi[p * 17 + tau]; const float tr = cr * ar - ci * ai, ti = cr * ai + ci * ar;
            const f32x4 br = *(const LAS f32x4*)(bbr + p * 16 + 4 * cq), bi = *(const LAS f32x4*)(bbi + p * 16 + 4 * cq);
            s0 += tr * br[0] - ti * bi[0]; s1 += tr * br[1] - ti * bi[1]; s2 += tr * br[2] - ti * bi[2]; s3 += tr * br[3] - ti * bi[3]; }
        if (tau == 0) { const float dd = dsk[g * 16 + c]; if (4 * cq == (c & ~3)) { if ((c & 3) == 0) s0 += dd; else if ((c & 3) == 1) s1 += dd; else if ((c & 3) == 2) s2 += dd; else s3 += dd; } }
        LAS float* kp = Kt + tl * 256 + c * 16 + 4 * cq; kp[0] = s0; kp[1] = s1; kp[2] = s2; kp[3] = s3; }
    __syncthreads();
    bf16* Bend = (bf16*)(ssm_ws + (size_t)g * SSM_G_BYTES); bf16* A2 = (bf16*)(ssm_ws + (size_t)g * SSM_G_BYTES + SSM_A2_OFF);
    for (int o = tid; o < 2048; o += NTHR) { const int tl = o >> 9, i = (o >> 5) & 15, c = (o >> 1) & 15, hf = o & 1, tau = 4 * q + tl, j = i - tau;
        if (j >= 0) { const LAS float* kp = Kt + tl * 256 + c * 16 + 8 * hf; u32x4 w; w.x = pk2(kp[0], kp[1]); w.y = pk2(kp[2], kp[3]); w.z = pk2(kp[4], kp[5]); w.w = pk2(kp[6], kp[7]);
            *(u32x4*)(A2 + (size_t)(i * 16 + c) * 384 + j * 16 + 8 * hf) = w; } }
    for (int o = tid; o < 2048; o += NTHR) { const int il = o >> 9, c = (o >> 5) & 15, j = (o >> 1) & 15, hf = o & 1, i = 4 * q + il;
        if (j > i) *(u32x4*)(A2 + (size_t)(i * 16 + c) * 384 + j * 16 + 8 * hf) = (u32x4){0u, 0u, 0u, 0u}; }
    for (int o = tid; o < 1024; o += NTHR) { const int il = o >> 8, c = (o >> 4) & 15, k8 = (o & 15) * 8, i = 4 * q + il; float v[8];
#pragma unroll
        for (int qq = 0; qq < 4; ++qq) { const int p = (k8 >> 1) + qq; const float cr = ccr[c * 64 + p], ci = cci[c * 64 + p], ar = pwr[p * 17 + i + 1], ai = pwi[p * 17 + i + 1];
            v[2 * qq] = cr * ar - ci * ai; v[2 * qq + 1] = -(cr * ai + ci * ar); }
        u32x4 w; w.x = pk2(v[0], v[1]); w.y = pk2(v[2], v[3]); w.z = pk2(v[4], v[5]); w.w = pk2(v[6], v[7]); *(u32x4*)(A2 + (size_t)(i * 16 + c) * 384 + 256 + k8) = w; }
    for (int o = tid; o < 1024; o += NTHR) { const int n = 32 * q + (o >> 5), k8 = (o & 31) * 8, p = n >> 1, ri = n & 1, j = k8 >> 4; float v[8];
        const float ar = pwr[p * 17 + 15 - j], ai = pwi[p * 17 + 15 - j];
#pragma unroll
        for (int qq = 0; qq < 8; ++qq) { const int c2 = (k8 & 15) + qq; const float br = bbr[p * 16 + c2], bi = bbi[p * 16 + c2]; v[qq] = ri ? (ar * bi + ai * br) : (ar * br - ai * bi); }
        u32x4 w; w.x = pk2(v[0], v[1]); w.y = pk2(v[2], v[3]); w.z = pk2(v[4], v[5]); w.w = pk2(v[6], v[7]); *(u32x4*)(Bend + (size_t)n * 256 + k8) = w; }
    __syncthreads();
}

__device__ __forceinline__ void router_phase(const float* __restrict__ h, const float* __restrict__ rwt, const float* __restrict__ bgr, const float* __restrict__ ber, unsigned* cntg,
                                             int* pdst, float* pw, float* ps, float* srow, LAS unsigned char* lds, int vcu, int G) {
    const int tid = threadIdx.x, lane = tid & 63, wid = __builtin_amdgcn_readfirstlane(tid >> 6);
    LAS float* Wl = (LAS float*)lds;
    for (int i = tid; i < RW_LAYER / 4; i += NTHR) ((LAS f32x4*)Wl)[i] = ((const f32x4*)rwt)[i];
    LAS int* lc = (LAS int*)(lds + RSCR_OFF); LAS int* lbase = lc + 32;
    const int rb = wid & 3, kh = wid >> 2, row = lane & 15, kq = lane >> 4;
    for (int blk = vcu; blk < M / 64; blk += G) {
        if (tid < 32) lc[tid] = 0;
        __syncthreads();
        const int t0 = blk * 64;
        const float* hp = h + (size_t)(t0 + 16 * rb + row) * D + 512 * kh + 4 * kq;
        const LAS float* wp0 = Wl + row * RW_PITCH + 512 * kh + 4 * kq; const LAS float* wp1 = wp0 + 16 * RW_PITCH; const LAS float* wp2 = Wl + (32 + (row & 3)) * RW_PITCH + 512 * kh + 4 * kq;
        f32x4 a0 = {0.f, 0.f, 0.f, 0.f}, a1 = a0, a2 = a0; float ssl = 0.f;
#pragma unroll 4
        for (int j = 0; j < 32; ++j) { const f32x4 a = *(const f32x4*)(hp + 16 * j); const f32x4 b0 = *(const LAS f32x4*)(wp0 + 16 * j), b1 = *(const LAS f32x4*)(wp1 + 16 * j), b2 = *(const LAS f32x4*)(wp2 + 16 * j);
            ssl += a[0] * a[0] + a[1] * a[1] + a[2] * a[2] + a[3] * a[3];
#pragma unroll
            for (int i = 0; i < 4; ++i) { a0 = __builtin_amdgcn_mfma_f32_16x16x4f32(a[i], b0[i], a0, 0, 0, 0); a1 = __builtin_amdgcn_mfma_f32_16x16x4f32(a[i], b1[i], a1, 0, 0, 0); a2 = __builtin_amdgcn_mfma_f32_16x16x4f32(a[i], b2[i], a2, 0, 0, 0); } }
        ssl += __shfl_xor(ssl, 16); ssl += __shfl_xor(ssl, 32);
        LAS float* P = (LAS float*)(lds + RSCR_OFF + 256);
        LAS float* pp = P + (16 * rb) * 40;
        if (kh == 1) {
#pragma unroll
            for (int r = 0; r < 4; ++r) { const int tk = 4 * kq + r; pp[tk * 40 + row] = a0[r]; pp[tk * 40 + 16 + row] = a1[r]; if (row < 4) pp[tk * 40 + 32 + row] = a2[r]; }
            if (kq == 0) pp[row * 40 + 36] = ssl; }
        __syncthreads();
        if (kh == 0) {
#pragma unroll
            for (int r = 0; r < 4; ++r) { const int tk = 4 * kq + r; pp[tk * 40 + row] += a0[r]; pp[tk * 40 + 16 + row] += a1[r]; if (row < 4) pp[tk * 40 + 32 + row] += a2[r]; }
            if (kq == 0) pp[row * 40 + 36] += ssl; }
        __syncthreads();
        int e1 = 0, e2 = 0; float w1 = 0.f, w2 = 0.f, s = 0.f; int sl1 = 0, sl2 = 0;
        if (tid < 64) { LAS float* p0 = P + tid * 40;
            s = rsqrtf(p0[36] * (1.f / D) + RMS_EPS);
            for (int o = 0; o < 36; ++o) p0[o] = p0[o] * s + (o < 4 ? bgr[o] : ber[o - 4]);
            int gi = 0; float gmx = p0[0];
            for (int i = 1; i < 4; ++i) if (p0[i] > gmx) { gmx = p0[i]; gi = i; }
            float den = 0.f; for (int i = 0; i < 4; ++i) den += __expf(p0[i] - gmx);
            const float gp = 1.f / den; const LAS float* sl = p0 + 4 + 8 * gi;
            int i1 = 0; float l1 = sl[0]; for (int i = 1; i < 8; ++i) if (sl[i] > l1) { l1 = sl[i]; i1 = i; }
            int i2 = -1; float l2 = -3.4e38f; for (int i = 0; i < 8; ++i) if (i != i1 && sl[i] > l2) { l2 = sl[i]; i2 = i; }
            const float ex = __expf(l2 - l1); w1 = gp / (1.f + ex); w2 = gp * ex / (1.f + ex); e1 = gi * 8 + i1; e2 = gi * 8 + i2;
            sl1 = __hip_atomic_fetch_add(&lc[e1], 1, __ATOMIC_RELAXED, __HIP_MEMORY_SCOPE_WORKGROUP); sl2 = __hip_atomic_fetch_add(&lc[e2], 1, __ATOMIC_RELAXED, __HIP_MEMORY_SCOPE_WORKGROUP);
            srow[t0 + tid] = s; }
        __syncthreads();
        if (tid < 32) { const int n = lc[tid]; lbase[tid] = n ? (int)__hip_atomic_fetch_add(cntg + tid * 64, (unsigned)n, RLX_AGENT) : 0; }
        __syncthreads();
        if (tid < 64) { const int t = t0 + tid; int i1 = lbase[e1] + sl1, i2 = lbase[e2] + sl2;
            if (i1 < CAP) { pdst[e1 * CAP + i1] = 2 * t; pw[e1 * CAP + i1] = w1; ps[e1 * CAP + i1] = s; }
            if (i2 < CAP) { pdst[e2 * CAP + i2] = 2 * t + 1; pw[e2 * CAP + i2] = w2; ps[e2 * CAP + i2] = s; } }
        __syncthreads();
    }
}

template <bool FINAL> __device__ __forceinline__ void combine_phase(float* hio, const bf16* __restrict__ Y2, const float* __restrict__ g, bf16* __restrict__ xng, int vcu, int G, int wid, int lane) {
    for (int base = vcu * 16; base < M; base += G * 16) {
#pragma unroll
        for (int rr = 0; rr < 2; ++rr) { const int row = base + 2 * wid + rr;
            float4* hr = (float4*)(hio + (size_t)row * D); float4 v[4]; float ss = 0.f;
#pragma unroll
            for (int j = 0; j < 4; ++j) { v[j] = hr[lane + 64 * j]; const int c = 4 * (lane + 64 * j);
                const u32x2 ya = *(const u32x2*)(Y2 + ((size_t)2 * row) * D + c), yb = *(const u32x2*)(Y2 + ((size_t)2 * row + 1) * D + c);
                v[j].x += __uint_as_float(ya.x << 16) + __uint_as_float(yb.x << 16); v[j].y += __uint_as_float(ya.x & 0xffff0000u) + __uint_as_float(yb.x & 0xffff0000u);
                v[j].z += __uint_as_float(ya.y << 16) + __uint_as_float(yb.y << 16); v[j].w += __uint_as_float(ya.y & 0xffff0000u) + __uint_as_float(yb.y & 0xffff0000u);
                ss += v[j].x * v[j].x + v[j].y * v[j].y + v[j].z * v[j].z + v[j].w * v[j].w; if (!FINAL) hr[lane + 64 * j] = v[j]; }
            ss = wave_sum(ss); const float s = rsqrtf(ss * (1.f / D) + RMS_EPS);
#pragma unroll
            for (int j = 0; j < 4; ++j) { const int c = 4 * (lane + 64 * j); const float4 gg = *(const float4*)(g + c);
                const float ox = v[j].x * s * gg.x, oy = v[j].y * s * gg.y, oz = v[j].z * s * gg.z, ow = v[j].w * s * gg.w;
                if (FINAL) { float4 o; o.x = ox; o.y = oy; o.z = oz; o.w = ow; hr[lane + 64 * j] = o; }
                else { u32x2 w; w.x = pk2(ox, oy); w.y = pk2(oz, ow); *(u32x2*)(xng + xng_off(row, c)) = w; } } }
    }
}

__device__ __forceinline__ void scan_phase(const float* __restrict__ Sloc, const float* __restrict__ a16g, bf16* xng, LAS unsigned char* lds, int vcu, int G) {
    const int tid = threadIdx.x, p = tid & 63, q = tid >> 6;
    LAS float* E = (LAS float*)(lds + AUX_OFF);
    for (int bg = vcu; bg < 128; bg += G) { const int g = bg >> 1, b = bg & 1;
        const float ar = a16g[(g * 64 + p) * 2], ai = a16g[(g * 64 + p) * 2 + 1];
        const float* sp = Sloc + ((size_t)g * 1024 + b * 512 + q * 64) * 128 + 2 * p;
        float xr = 0.f, xi = 0.f;
#pragma unroll 1
        for (int hh = 0; hh < 2; ++hh) { float2 v[32];
#pragma unroll
            for (int s = 0; s < 32; ++s) v[s] = *(const float2*)(sp + (size_t)(hh * 32 + s) * 128);
#pragma unroll
            for (int s = 0; s < 32; ++s) { const float nr = ar * xr - ai * xi + v[s].x, ni = ar * xi + ai * xr + v[s].y; xr = nr; xi = ni; } }
        E[(q * 64 + p) * 2] = xr; E[(q * 64 + p) * 2 + 1] = xi;
        __syncthreads();
        float pr = ar, pi = ai;
#pragma unroll
        for (int k = 0; k < 6; ++k) { const float nr = pr * pr - pi * pi, ni = 2.f * pr * pi; pr = nr; pi = ni; }
        xr = 0.f; xi = 0.f;
        for (int qq = 0; qq < q; ++qq) { const float er = E[(qq * 64 + p) * 2], ei = E[(qq * 64 + p) * 2 + 1]; const float nr = pr * xr - pi * xi + er, ni = pr * xi + pi * xr + ei; xr = nr; xi = ni; }
        bf16* xp = xng + ((size_t)g * 1024 + b * 512 + q * 64) * 384 + 256 + 2 * p;
#pragma unroll 1
        for (int hh = 0; hh < 2; ++hh) { float2 v[32];
#pragma unroll
            for (int s = 0; s < 32; ++s) v[s] = *(const float2*)(sp + (size_t)(hh * 32 + s) * 128);
#pragma unroll
            for (int s = 0; s < 32; ++s) { *(unsigned*)(xp + (size_t)(hh * 32 + s) * 384) = pk2(xr, xi); const float nr = ar * xr - ai * xi + v[s].x, ni = ar * xi + ai * xr + v[s].y; xr = nr; xi = ni; } }
        __syncthreads();
    }
}

__global__ void __launch_bounds__(NTHR, 2) mk_fwd(Args args) {
    extern __shared__ __attribute__((aligned(16))) unsigned char lds_[];
    LAS unsigned char* lds = (LAS unsigned char*)lds_;
    volatile LAS unsigned* MISC = (volatile LAS unsigned*)(lds + MISC_OFF);
    const int tid = threadIdx.x, lane = tid & 63, wid = __builtin_amdgcn_readfirstlane(tid >> 6);
    const int G = gridDim.x; const int bx = blockIdx.x; const int vcu = (G % 8 == 0) ? (bx % 8) * (G / 8) + bx / 8 : bx;
    unsigned char* const ws = args.ws;
    constexpr size_t EW = (size_t)NEXP * 1024 * 256;
    for (int u = tid; u < (LDS_BYTES - MISC_OFF) / 4; u += NTHR) ((LAS unsigned*)(lds + MISC_OFF))[u] = 0u;
    __syncthreads();
    const int lo = args.ph_lo, hi = args.ph_hi;
    XcdBarrier bar; bar.bar = (unsigned*)ws + CW_BAR + args.li * XCD_BAR_WORDS; bar.x = 0; bar.st = nullptr;
    if (hi - lo > 1) bar = xcd_barrier_post((unsigned*)ws + CW_BAR + args.li * XCD_BAR_WORDS, MISC + 8);
    const int gw = vcu * NWAVES + wid, NGW = G * NWAVES;
#ifndef PH_ONLY
#define PH_ONLY -1
#endif
#define IN(k) ((PH_ONLY < 0 || PH_ONLY == ((k) >= 12 && (k) <= 14 ? (k) - 8 : (k))) && lo <= (k) && (k) < hi)
#ifndef TS_K1
#define TS_K1 -1
#define TS_K2 -1
#endif
#define TS_STAMP(k) do { if (TS_K1 >= 0 && bx == 0 && tid == 0) ((unsigned long long*)(ws + WS_TS))[k] = __builtin_amdgcn_s_memrealtime(); } while (0)
#define SEAM(k) do { if ((k) + 1 < hi) xcd_barrier(bar); TS_STAMP((k) + 1); } while (0)
#define SCR ((LAS float*)(lds + wid * 16384))
    TS_STAMP(0);
    if (IN(0)) {
        const float* w_qkv = args.in[4]; const float* w_o = args.in[5]; const float* w_out = args.in[15];
        for (int it = gw; it < 3072; it += NGW) {
            if (it < 1536) { const int kb = it / 96, nb = it % 96; tr_item(w_qkv, 3072, kb * 64, nb * 32, (bf16*)(ws + WS_WQKV), 1024, nb * 32, nullptr, SCR, lane); }
            else if (it < 2048) { const int r = it - 1536, kb = r >> 5, nb = r & 31; tr_item(w_o, 1024, kb * 64, nb * 32, (bf16*)(ws + WS_WO), 1024, nb * 32, nullptr, SCR, lane); }
            else { const int r = it - 2048, kb = r >> 6, nb = r & 63, n0 = nb * 32, ag = n0 >> 10, cc = n0 & 1023; tr_item(w_out, 2048, kb * 64, n0, (bf16*)(ws + WS_WOUT), 1024, 256 * (cc >> 7) + 128 * ag + (cc & 127), nullptr, SCR, lane); }
        }
        moe_convert(args.in[20], args.in[21], args.in[22], args.in[2], (bf16*)(ws + WS_WGU), (bf16*)(ws + WS_WD), SCR, gw, NGW, lane);
        { float* rwt = (float*)(ws + WS_RWT); const float* norm_ffn = args.in[2];
          for (int o = bx * NTHR + tid; o < 2 * 36 * 1024; o += G * NTHR) { const int layer = o / (36 * 1024), r = o % (36 * 1024), col = r >> 10, k = r & 1023;
            const float gnk = norm_ffn[layer * D + k];
            const float w = col < 4 ? args.in[16][(size_t)layer * 4096 + k * 4 + col] : args.in[18][(size_t)layer * 32768 + ((size_t)((col - 4) >> 3) * 1024 + k) * 8 + ((col - 4) & 7)];
            rwt[layer * RW_LAYER + col * RW_PITCH + k] = w * gnk; } }
        __syncthreads();
        for (int gq = vcu; gq < 256; gq += G) ssm_mats(gq >> 2, gq & 3, args.in[7], args.in[8], args.in[9], args.in[10], args.in[11], args.in[12], args.in[13], args.in[14], ws + WS_SSM, (float*)(ws + WS_A16), (LAS float*)lds, tid);
        { const float* x = args.in[0]; const float* norm_mix = args.in[1]; bf16* XN = (bf16*)(ws + WS_XN);
          for (int m = gw; m < M; m += NGW) { const float4* xr = (const float4*)(x + (size_t)m * D); float4 v[4]; float ss = 0.f;
#pragma unroll
            for (int j = 0; j < 4; ++j) { v[j] = xr[lane + 64 * j]; ss += v[j].x * v[j].x + v[j].y * v[j].y + v[j].z * v[j].z + v[j].w * v[j].w; }
            ss = wave_sum(ss); const float s = rsqrtf(ss * (1.f / D) + RMS_EPS);
#pragma unroll
            for (int j = 0; j < 4; ++j) { const int c = 4 * (lane + 64 * j); const float4 gg = *(const float4*)(norm_mix + c); u32x2 w; w.x = pk2(v[j].x * s * gg.x, v[j].y * s * gg.y); w.y = pk2(v[j].z * s * gg.z, v[j].w * s * gg.w);
                *(u32x2*)(XN + (size_t)m * D + c) = w; } } }
        SEAM(0);
    }
    if (IN(1)) { PhQKV P{ws, (const char*)(ws + WS_XN), G, bx}; gm::gemm_phase(lds, P); SEAM(1); }
    if (IN(2)) {
        const int per = 1024 / G;
        for (int i = 0; i < per; ++i) { const int uid = vcu * per + i; const int bh = uid >> 5, qb = uid & 31;
            at::attn_unit<8>(bh >> 4, bh & 15, qb, (const bf16*)(ws + WS_Q), (const bf16*)(ws + WS_K), (const bf16*)(ws + WS_V), (bf16*)(ws + (args.pad ? WS_XN : WS_Q)), args.in[6], lds); }
        SEAM(2);
    }
    if (IN(3)) { PhWo P{ws, (const char*)(ws + WS_Q), args.in[0], args.out, G, bx}; gm::gemm_phase(lds, P); SEAM(3); }
#define MOE_LAYER(layer, pr) \
    if (IN(pr)) { router_phase(args.out, (const float*)(ws + WS_RWT) + (layer) * RW_LAYER, args.in[17] + (layer) * 4, args.in[19] + (layer) * 32, (unsigned*)ws + CW_CNT + (layer) * 32 * 64, \
                               (int*)(ws + WS_PDST), (float*)(ws + WS_PW), (float*)(ws + WS_PS), (float*)(ws + WS_SROW), lds, vcu, G); SEAM(pr); } \
    if (IN((pr) + 1) || IN((pr) + 2)) { \
        LAS int* cn = (LAS int*)(lds + AUX_OFF); LAS int* tb = cn + 32; \
        if (tid < 32) { const unsigned c = __hip_atomic_load((unsigned*)ws + CW_CNT + ((layer) * 32 + tid) * 64, RLX_AGENT); cn[tid] = c < (unsigned)CAP ? (int)c : CAP; } \
        __syncthreads(); \
        if (tid == 0) { int a = 0; for (int e = 0; e < 32; ++e) { tb[e] = a; a += (cn[e] + 255) >> 8; } tb[32] = a; } \
        __syncthreads(); \
        if (IN((pr) + 1)) { PhGateUp P{ws, (const char*)(ws + WS_XN), lds, G, vcu}; gm::gemm_phase(lds, P); SEAM((pr) + 1); } \
        if (IN((pr) + 2)) { PhDown P{ws, (const char*)(ws + WS_H), lds, G, vcu}; gm::gemm_phase(lds, P); SEAM((pr) + 2); } \
    }
    MOE_LAYER(0, 4)
    if (IN(7)) {
        moe_convert(args.in[20] + EW, args.in[21] + EW, args.in[22] + EW, args.in[2] + D, (bf16*)(ws + WS_WGU), (bf16*)(ws + WS_WD), SCR, gw, NGW, lane);
        combine_phase<false>(args.out, (const bf16*)(ws + WS_Y2), args.in[1] + D, (bf16*)(ws + WS_XN), vcu, G, wid, lane);
        SEAM(7); }
    if (IN(8)) { PhSloc P{ws, (const char*)(ws + WS_XN), G, vcu}; gm::gemm_phase(lds, P); SEAM(8); }
    if (IN(9)) { scan_phase((const float*)(ws + WS_SLOC), (const float*)(ws + WS_A16), (bf16*)(ws + WS_XN), lds, vcu, G); SEAM(9); }
    if (IN(10)) { PhY P{ws, (const char*)(ws + WS_XN), G, vcu}; gm::gemm_phase(lds, P); SEAM(10); }
    if (IN(11)) { PhWout P{ws, (const char*)(ws + WS_G), args.out, G, bx}; gm::gemm_phase(lds, P); SEAM(11); }
    MOE_LAYER(1, 12)
#undef MOE_LAYER
    if (IN(15)) { combine_phase<true>(args.out, (const bf16*)(ws + WS_Y2), args.in[3], nullptr, vcu, G, wid, lane);
#if TS_K1 >= 0
        { const unsigned long long* ts = (const unsigned long long*)(ws + WS_TS); const float dtus = (float)(ts[TS_K1 + 1] - ts[TS_K1]) * 1e-2f; const float e = exp2f(rintf(log2f(dtus) * 6.f) / 6.f) * 1e-2f;
          __syncthreads();
          for (int base = vcu * 16; base < M; base += G * 16) for (int i = tid; i < 16 * D; i += NTHR) args.out[(size_t)base * D + i] *= (1.f + e);
          if (TS_K2 >= 0 && bx == 0) { __syncthreads(); if (tid == 0) args.out[0] = exp2f(rintf(log2f((float)(ts[TS_K2 + 1] - ts[TS_K2]) * 1e-2f) * 6.f) / 6.f); } }
#endif
    }
    if (IN(16)) moe_convert(args.in[20] + EW, args.in[21] + EW, args.in[22] + EW, args.in[2] + D, (bf16*)(ws + WS_WGU), (bf16*)(ws + WS_WD), SCR, gw, NGW, lane);
#undef IN
#undef SEAM
#undef SCR
}

#ifndef FAST_MASK
#define FAST_MASK 0x3ff
#endif
#ifndef FUSED
#define FUSED 1
#endif
extern "C" void kernel_launch(void* const* d_in, const int* in_sizes, int n_in, void* d_out, int out_size, void* d_ws, size_t ws_size, hipStream_t stream) {
    static int grid = 0;
    if (grid == 0) {
        if (n_in != 23 || out_size != M * D || ws_size < WS_END) { fprintf(stderr, "kernel_launch: unexpected shapes (n_in %d out %d ws %zu)\n", n_in, out_size, ws_size); grid = -1; return; }
        int dev = 0, cus = 0;
        if (hipGetDevice(&dev) != hipSuccess || hipDeviceGetAttribute(&cus, hipDeviceAttributeMultiprocessorCount, dev) != hipSuccess) { grid = -1; return; }
        if (hipFuncSetAttribute((const void*)mk_fwd, hipFuncAttributeMaxDynamicSharedMemorySize, LDS_BYTES) != hipSuccess) { fprintf(stderr, "kernel_launch: hipFuncSetAttribute failed\n"); grid = -1; return; }
        (void)hipGetLastError();
        grid = cus;
        if (grid != 256) fprintf(stderr, "kernel_launch: %d CUs (built for 256)\n", grid);
    }
    if (grid < 0) return;
    const float* x = (const float*)d_in[0]; const float* norm_mix = (const float*)d_in[1]; const float* norm_ffn = (const float*)d_in[2]; const float* norm_final = (const float*)d_in[3];
    const float* w_qkv = (const float*)d_in[4]; const float* w_o = (const float*)d_in[5]; const float* relb = (const float*)d_in[6];
    const float* lre = (const float*)d_in[7]; const float* lim = (const float*)d_in[8]; const float* lstep = (const float*)d_in[9];
    const float* bre = (const float*)d_in[10]; const float* bim = (const float*)d_in[11]; const float* cre = (const float*)d_in[12]; const float* cim = (const float*)d_in[13];
    const float* dsk = (const float*)d_in[14]; const float* w_out = (const float*)d_in[15];
    const float* wgr = (const float*)d_in[16]; const float* bgr = (const float*)d_in[17]; const float* wer = (const float*)d_in[18]; const float* ber = (const float*)d_in[19];
    const float* wg = (const float*)d_in[20]; const float* wu = (const float*)d_in[21]; const float* wd = (const float*)d_in[22];
    float* out = (float*)d_out; unsigned char* ws = (unsigned char*)d_ws;
    bf16* XN = (bf16*)(ws + WS_XN); bf16* Qb = (bf16*)(ws + WS_Q); bf16* Kb = (bf16*)(ws + WS_K); bf16* Vb = (bf16*)(ws + WS_V);
    bf16* Y2 = (bf16*)(ws + WS_Y2); bf16* Gb = (bf16*)(ws + WS_G);
    const size_t EW = (size_t)NEXP * 1024 * 256;
    (void)hipMemsetAsync(ws + WS_CTL, 0, CTL_ZERO_BYTES, stream);
    Args a{}; for (int i = 0; i < 23; ++i) a.in[i] = (const float*)d_in[i];
    a.out = out; a.ws = ws;
    int li = 0;
    auto run = [&](int lo, int hi) { a.ph_lo = lo; a.ph_hi = hi; a.li = li++; hipLaunchKernelGGL(mk_fwd, dim3(grid), dim3(NTHR), LDS_BYTES, stream, a); };
#ifndef DUP_PH
#define DUP_PH -1
#endif
    constexpr unsigned FM = FAST_MASK;
    auto dup = [&](int ph) { if (DUP_PH == ph) { if (ph == 2) { a.pad = 1; run(2, 3); a.pad = 0; } else run(ph, ph + 1); } };
    if (FUSED) { run(0, N_PHASES); return; }
    if (FM != 0) { dup(0); run(0, 1); }
    if (!(FM & 1)) n_rmsnorm_bf16<<<M / 4, 256, 0, stream>>>(x, norm_mix, XN);
    if (FM & 2) { dup(1); run(1, 2); } else n_gemm<0><<<dim3(3072 / 64, M / 64), 256, 0, stream>>>(XN, w_qkv, 3072, nullptr, nullptr, Qb, Kb, Vb);
    if (FM & 4) { dup(2); run(2, 3); } else n_attn<<<dim3(SEQ / 64, NH, BATCH), 64, 0, stream>>>(Qb, Kb, Vb, relb, Qb);
    if (FM & 8) { dup(3); run(3, 4); } else n_gemm<1><<<dim3(1024 / 64, M / 64), 256, 0, stream>>>(Qb, w_o, 1024, x, out, XN, nullptr, nullptr);
    if (FM & 16) { run(4, 5); dup(5); run(5, 6); dup(6); run(6, 7); } else n_moe<<<M, 256, 0, stream>>>(out, norm_ffn, wgr, bgr, wer, ber, wg, wu, wd, Y2);
    if (FM & 32) run(7, 8); else { if (FM & 256) run(16, 17); n_combine_norm<<<M / 4, 256, 0, stream>>>(out, Y2, norm_mix + D, XN); }
    if (FM & 64) { dup(8); run(8, 9); dup(9); run(9, 10); dup(10); run(10, 11); } else n_ssm<<<dim3(64, BATCH), 64, 0, stream>>>(XN, lre, lim, lstep, bre, bim, cre, cim, dsk, Gb);
    if (FM & 128) run(11, 12); else n_gemm<2><<<dim3(1024 / 64, M / 64), 256, 0, stream>>>(Gb, w_out, 2048, out, out, XN, nullptr, nullptr);
    if (FM & 256) { run(12, 13); run(13, 14); run(14, 15); } else n_moe<<<M, 256, 0, stream>>>(out, norm_ffn + D, wgr + 1024 * 4, bgr + 4, wer + 4 * 1024 * 8, ber + 32, wg + EW, wu + EW, wd + EW, Y2);
    if (FM & 512) run(15, 16); else n_final<<<M / 4, 256, 0, stream>>>(out, Y2, norm_final);
}
```

```cpp
#include <hip/hip_runtime.h>
#include <cstdio>
#include <cstdint>

typedef unsigned short bf16;
constexpr int BATCH = 2, SEQ = 8192, D = 1024, M = BATCH * SEQ, NH = 16, HD = 64;
constexpr int NEXP = 32, EPG = 8, FE = 256;
constexpr int NREL = 257;
constexpr float RMS_EPS = 1e-6f;
constexpr float LOG2E = 1.4426950408889634f;
constexpr float C2 = 0.125f * LOG2E;

constexpr size_t MiB = 1u << 20;
constexpr size_t WS_CTL = 0;
constexpr size_t WS_XN = 86 * MiB;
constexpr size_t WS_BIG = 134 * MiB;
constexpr size_t WS_Q = WS_BIG, WS_K = WS_BIG + 32 * MiB, WS_V = WS_BIG + 64 * MiB;
constexpr size_t WS_Y2 = WS_BIG, WS_H = WS_BIG + 64 * MiB;
constexpr size_t WS_SLOC = WS_BIG, WS_G = WS_BIG + 32 * MiB;

__device__ __forceinline__ bf16 f2bf(float f) { unsigned u = __float_as_uint(f); return (bf16)((u + 0x7fffu + ((u >> 16) & 1u)) >> 16); }
__device__ __forceinline__ float bf2f(bf16 h) { return __uint_as_float(((unsigned)h) << 16); }
__device__ __forceinline__ float wave_sum(float v) {
#pragma unroll
    for (int o = 1; o < 64; o <<= 1) v += __shfl_xor(v, o);
    return v;
}
__device__ __forceinline__ float gelu_tanh(float x) { const float u = 0.7978845608028654f * (x + 0.044715f * x * x * x); return 0.5f * x * (1.f + tanhf(u)); }

__device__ __forceinline__ size_t xng_off(int t, int col) { const int b = t >> 13, tt = t & 8191, s = tt >> 4, j = tt & 15, g = col >> 4, c = col & 15; return ((size_t)(g * 1024 + b * 512 + s)) * 384 + j * 16 + c; }


#define LAS __attribute__((address_space(3)))
typedef short bf16x8 __attribute__((ext_vector_type(8)));
typedef short s16x4 __attribute__((ext_vector_type(4)));
typedef float f32x4 __attribute__((ext_vector_type(4)));
typedef float f32x16 __attribute__((ext_vector_type(16)));
typedef unsigned u32x4 __attribute__((ext_vector_type(4)));
typedef unsigned u32x2 __attribute__((ext_vector_type(2)));

constexpr int NWAVES = 8, NTHR = 512;
constexpr int CAP = 16384;
constexpr size_t CTL_ZERO_BYTES = 1 * MiB;
constexpr size_t WS_PDST = 1 * MiB, WS_PW = 3 * MiB, WS_PS = 5 * MiB, WS_SROW = 7 * MiB, WS_A16 = 7 * MiB + 65536;
constexpr size_t WS_TS = 7 * MiB + 131072;
constexpr size_t WS_RWT = 8 * MiB;
constexpr size_t WS_WQKV = 9 * MiB, WS_WO = 15 * MiB, WS_WOUT = 17 * MiB, WS_SSM = 21 * MiB;
constexpr size_t WS_WGU = 38 * MiB, WS_WD = 70 * MiB;
constexpr size_t WS_END = 230 * MiB;
constexpr int RW_PITCH = 1028, RW_LAYER = 36 * RW_PITCH;
constexpr int SSM_G_BYTES = 262144, SSM_A2_OFF = 65536;
constexpr int CW_BAR = 4096;
constexpr int CW_CNT = 65536;
constexpr int LDS_BYTES = 160 * 1024, MISC_OFF = LDS_BYTES - 512, AUX_OFF = 128 * 1024, RSCR_OFF = 36 * 1028 * 4;
constexpr int N_PHASES = 16;

__device__ __forceinline__ unsigned cvt_pk_bf16(float lo, float hi) { unsigned r; asm volatile("v_cvt_pk_bf16_f32 %0, %1, %2" : "=v"(r) : "v"(lo), "v"(hi)); return r; }
typedef float f32x2_t __attribute__((ext_vector_type(2))); typedef __bf16 bf16x2_t __attribute__((ext_vector_type(2)));
__device__ __forceinline__ unsigned cvtpk_s(float lo, float hi) { f32x2_t v = {lo, hi}; bf16x2_t b = __builtin_convertvector(v, bf16x2_t); return __builtin_bit_cast(unsigned, b); }
__device__ __forceinline__ unsigned pk2(float lo, float hi) { return (unsigned)f2bf(lo) | ((unsigned)f2bf(hi) << 16); }
#define LDS_WAIT() asm volatile("s_waitcnt lgkmcnt(0)" ::: "memory")
#define VM_WAIT() asm volatile("s_waitcnt vmcnt(0)" ::: "memory")
#define RLX_AGENT __ATOMIC_RELAXED, __HIP_MEMORY_SCOPE_AGENT

#define XB_TMO      128
#define XB_XCNT(j)  (256  + 64 * (j))
#define XB_XSUB(j)  (1280 + 64 * (j))
#define XB_XGEN(j)  (2304 + 64 * (j))
#define XB_TOP      3328
#define XB_TOPGEN   3392
#define XCD_BAR_WORDS 3456
#define XB_SPIN_CAP (1u << 18)
__device__ __forceinline__ unsigned xb_ld(unsigned* p)              { return __hip_atomic_load(p, __ATOMIC_RELAXED, __HIP_MEMORY_SCOPE_AGENT); }
__device__ __forceinline__ unsigned xb_add(unsigned* p, unsigned v) { return __hip_atomic_fetch_add(p, v, __ATOMIC_RELAXED, __HIP_MEMORY_SCOPE_AGENT); }
__device__ __forceinline__ unsigned xb_xcc_id() { return (unsigned)__builtin_amdgcn_s_getreg((3 << 11) | 20) & 0xFu; }
#define XB_SPIN(cond, bar) do { unsigned _sp = 0; while (cond) { __builtin_amdgcn_s_sleep(1); \
    if ((++_sp & 255u) == 0u) { if (xb_ld(&(bar)[XB_TMO])) break; if (_sp > XB_SPIN_CAP) { atomicAdd(&(bar)[XB_TMO], 1u); break; } } } } while (0)
struct XcdBarrier { unsigned* bar; unsigned x; volatile LAS unsigned* st; };
__device__ __forceinline__ XcdBarrier xcd_barrier_post(unsigned* bar, volatile LAS unsigned* st) {
    XcdBarrier b; b.bar = bar; b.x = xb_xcc_id(); b.st = st;
    if (threadIdx.x == 0) (void)xb_add(&bar[XB_XCNT(b.x)], 1u);
    return b;
}
__device__ __forceinline__ void xcd_barrier_complete(unsigned* bar, unsigned x, unsigned& nloc, unsigned& nx) {
    const unsigned G = gridDim.x * gridDim.y * gridDim.z;
    unsigned sum, cnt, mine, sp = 0u;
    for (;;) {
        sum = 0u; cnt = 0u; mine = 0u;
#pragma unroll
        for (unsigned j = 0; j < 16; ++j) { const unsigned c = xb_ld(&bar[XB_XCNT(j)]); sum += c; cnt += (c > 0u) ? 1u : 0u; mine = (j == x) ? c : mine; }
        if (sum == G) break;
        __builtin_amdgcn_s_sleep(1);
        if ((++sp & 255u) == 0u) { if (xb_ld(&bar[XB_TMO])) break; if (sp > XB_SPIN_CAP) { atomicAdd(&bar[XB_TMO], 1u); break; } }
    }
    nloc = mine > 0u ? mine : 1u; nx = cnt > 0u ? cnt : 1u;
}
__device__ __forceinline__ void xcd_barrier(const XcdBarrier& b) {
    asm volatile("s_waitcnt vmcnt(0)" ::: "memory");
    __syncthreads();
    if (threadIdx.x == 0) {
        unsigned* bar = b.bar;
        __builtin_amdgcn_s_waitcnt(0);
        unsigned nloc = b.st[0], nx = b.st[1];
        if (nloc == 0u) { xcd_barrier_complete(bar, b.x, nloc, nx); b.st[0] = nloc; b.st[1] = nx; }
        const unsigned old = xb_add(&bar[XB_XSUB(b.x)], 1u);
        const unsigned gen = old / nloc;
        if (old + 1u == (gen + 1u) * nloc) {
            __builtin_amdgcn_fence(__ATOMIC_RELEASE, "agent");
            asm volatile("s_waitcnt vmcnt(0)" ::: "memory");
            const unsigned og = xb_add(&bar[XB_TOP], 1u);
            const unsigned tg = og / nx;
            if (og + 1u == (tg + 1u) * nx) xb_add(&bar[XB_TOPGEN], 1u);
            else XB_SPIN(xb_ld(&bar[XB_TOPGEN]) == tg, bar);
            __builtin_amdgcn_fence(__ATOMIC_ACQUIRE, "agent");
            xb_add(&bar[XB_XGEN(b.x)], 1u);
            asm volatile("s_waitcnt vmcnt(0)" ::: "memory");
        } else {
            XB_SPIN(xb_ld(&bar[XB_XGEN(b.x)]) == gen, bar);
            __builtin_amdgcn_fence(__ATOMIC_ACQUIRE, "agent");
            asm volatile("s_waitcnt vmcnt(0)" ::: "memory");
        }
    }
    __syncthreads();
}

namespace gm {
constexpr int HTB = 16384;
__device__ __forceinline__ int lds_byte(int r, int c) { const int st = (r >> 4) * 2 + (c >> 5), rr = r & 15, cc = c & 31, ob = rr * 64 + cc * 2; return st * 1024 + (ob ^ (((ob >> 9) & 1) << 5)); }
__device__ __forceinline__ void stage_rc(int b, int& R, int& C) { const int st = b / 1024, sb = b % 1024, swz = sb ^ (((sb >> 9) & 1) << 5); R = (st >> 1) * 16 + swz / 64; C = (st & 1) * 32 + (swz % 64) / 2; }
__device__ __forceinline__ int perm32(int rho) { const int n = rho >> 4, i = rho & 15; return 8 * (i >> 2) + 4 * n + (i & 3); }
struct Unit { int pm, pn, e, gt, cnt; };
__device__ __forceinline__ bool static_unit(int i, int G, int c, int nM, int nN, Unit& u) {
    const int nwg = nM * nN; const long L = (long)i * G + c; if (L >= nwg) return false;
    int wgid = (int)L; { const int q = nwg / 8, r = nwg % 8, xcd = wgid % 8, off = wgid / 8; wgid = (xcd < r ? xcd * (q + 1) : r * (q + 1) + (xcd - r) * q) + off; }
    const int nig = 8 * nN, gid = wgid / nig, fm = gid * 8, gsz = (nM - fm) < 8 ? (nM - fm) : 8;
    u.pm = fm + ((wgid % nig) % gsz); u.pn = (wgid % nig) / gsz; u.e = 0; u.gt = 0; u.cnt = 0; return true;
}
template <class P> __device__ __forceinline__ void gemm_phase(LAS unsigned char* lds, const P& ph) {
    const int tid = threadIdx.x, wid = __builtin_amdgcn_readfirstlane(tid >> 6), lane = tid & 63, wr = wid >> 2, wc = wid & 3, fr = lane & 15, fq = lane >> 4;
    constexpr int nt = P::K / 64;
    static_assert(nt >= 2 && (nt % 2) == 0, "K must be a multiple of 128");
    unsigned voffA[2], voffB[2];
#pragma unroll
    for (int i = 0; i < 2; ++i) { int R, C; stage_rc(tid * 16 + i * 8192, R, C); const int Rb = (R & ~31) + perm32(R & 31); voffB[i] = (unsigned)(Rb * P::LDB + C) * 2u; voffA[i] = (unsigned)(R * P::LDA + C) * 2u; }
    const unsigned ldsw = (unsigned)wid * 1024u;
    const int aoff = lds_byte(wr * 64 + fr, fq * 8), boff = lds_byte(wc * 32 + fr, fq * 8);
    constexpr int hB = P::HSTEPB, hA = 128 * P::LDA * 2;
#define G_SA(b, h) (((b) * 2 + (h)) * gm::HTB)
#define G_SB(b, h) ((4 + (b) * 2 + (h)) * gm::HTB)
#define G_GLDS(src, bufoff, i) __builtin_amdgcn_global_load_lds((const unsigned*)(src), (LAS unsigned*)(lds + (bufoff) + ldsw + (i) * 8192), 16, 0, 0)
#define G_STA(bufoff, ptr, kb, offs, h) do { if constexpr (P::GATHER) { _Pragma("unroll") for (int _i = 0; _i < 2; ++_i) G_GLDS(Ab + (kb) + (offs)[h][_i], bufoff, _i); } \
        else { _Pragma("unroll") for (int _i = 0; _i < 2; ++_i) G_GLDS((ptr) + (h) * hA + voffA[_i], bufoff, _i); } } while (0)
#define G_STB(bufoff, ptr) do { _Pragma("unroll") for (int _i = 0; _i < 2; ++_i) G_GLDS((ptr) + voffB[_i], bufoff, _i); } while (0)
#define G_LDA(dst, b, h) do { _Pragma("unroll") for (int m = 0; m < 4; ++m) _Pragma("unroll") for (int k = 0; k < 2; ++k) dst[m][k] = *(const LAS bf16x8*)(lds + G_SA(b, h) + aoff + m * 2048 + k * 1024); } while (0)
#define G_LDB(dst, b, h) do { _Pragma("unroll") for (int n = 0; n < 2; ++n) _Pragma("unroll") for (int k = 0; k < 2; ++k) dst[n][k] = *(const LAS bf16x8*)(lds + G_SB(b, h) + boff + n * 2048 + k * 1024); } while (0)
#define G_MMA(ai, bj, At, Bt) do { __builtin_amdgcn_s_setprio(1); _Pragma("unroll") for (int m = 0; m < 4; ++m) _Pragma("unroll") for (int n = 0; n < 2; ++n) _Pragma("unroll") for (int k = 0; k < 2; ++k) \
        acc[ai][bj][m][n] = __builtin_amdgcn_mfma_f32_16x16x32_bf16(Bt[n][k], At[m][k], acc[ai][bj][m][n], 0, 0, 0); __builtin_amdgcn_s_setprio(0); } while (0)
#define G_WAIT_V(n) asm volatile("s_waitcnt vmcnt(" #n ")" ::: "memory")
#define G_WAIT_L(n) asm volatile("s_waitcnt lgkmcnt(" #n ")" ::: "memory")
#define G_BAR __builtin_amdgcn_s_barrier()
#define G_SCHED __builtin_amdgcn_sched_barrier(0)
    Unit cur, nxt; int ui = 0;
    if (!ph.next(0, cur)) return;
    f32x4 acc[2][2][4][2];
#pragma unroll
    for (int a = 0; a < 2; ++a)
#pragma unroll
        for (int b = 0; b < 2; ++b)
#pragma unroll
            for (int m = 0; m < 4; ++m)
#pragma unroll
                for (int n = 0; n < 2; ++n) acc[a][b][m][n] = (f32x4){0.f, 0.f, 0.f, 0.f};
    bf16x8 At[4][2], B0[2][2], B1[2][2];
    unsigned co[2][2] = {{0u, 0u}, {0u, 0u}};
    const char* Ab = ph.Abase;
    const char* cA = Ab; const char* cB = ph.b_tile(cur);
    if constexpr (P::GATHER) { ph.a_offs(cur, tid, co); asm volatile("s_waitcnt vmcnt(0)" ::: "memory"); } else cA = ph.a_tile(cur);
    G_STB(G_SB(0, 0), cB); G_STB(G_SB(0, 1), cB + hB); G_STA(G_SA(0, 0), cA, 0, co, 0); G_STA(G_SA(0, 1), cA, 0, co, 1);
    if (wr == 1) G_BAR;
    G_WAIT_V(2); G_BAR;
    G_STB(G_SB(1, 0), cB + 128); G_STA(G_SA(1, 0), cA + 128, 128, co, 0); G_STB(G_SB(1, 1), cB + hB + 128);
    G_WAIT_V(6); G_BAR;
    for (;;) {
        const bool has_next = ph.next(ui + 1, nxt);
        const char* nA = cA; const char* nB = cB;
        if (has_next) { nB = ph.b_tile(nxt); if constexpr (!P::GATHER) nA = ph.a_tile(nxt); }
        for (int t = 0; t < nt; t += 2) {
            const bool last = (t == nt - 2);
            const int kb1 = (t + 1) * 128, kb2 = last ? 0 : (t + 2) * 128, kb3 = kb2 + 128;
            const char* a1 = cA + kb1; const char* a2 = last ? nA : cA + kb2; const char* a3 = a2 + 128;
            const char* b2 = last ? nB : cB + (t + 2) * 128; const char* b3 = b2 + 128;
            G_LDB(B0, 0, 0); G_LDB(B1, 0, 1); G_SCHED; G_LDA(At, 0, 0); G_STA(G_SA(1, 1), a1, kb1, co, 1);
            G_WAIT_V(8); G_WAIT_L(0); G_BAR; G_MMA(0, 0, At, B0); G_MMA(0, 1, At, B1); G_BAR; G_SCHED;
            if constexpr (P::GATHER) { if (last && has_next) ph.a_offs(nxt, tid, co); }
            G_LDA(At, 0, 1); G_STB(G_SB(0, 0), b2); G_STB(G_SB(0, 1), b2 + hB); G_STA(G_SA(0, 0), a2, kb2, co, 0);
            G_WAIT_V(8); G_WAIT_L(0); G_BAR; G_MMA(1, 0, At, B0); G_MMA(1, 1, At, B1); G_BAR; G_SCHED;
            G_LDB(B0, 1, 0); G_LDB(B1, 1, 1); G_SCHED; G_LDA(At, 1, 0); G_STA(G_SA(0, 1), a2, kb2, co, 1);
            G_WAIT_V(8); G_WAIT_L(0); G_BAR; G_MMA(0, 0, At, B0); G_MMA(0, 1, At, B1); G_BAR; G_SCHED;
            G_LDA(At, 1, 1); G_STB(G_SB(1, 0), b3); G_STB(G_SB(1, 1), b3 + hB); G_STA(G_SA(1, 0), a3, kb3, co, 0);
            G_WAIT_V(8); G_WAIT_L(0); G_BAR; G_MMA(1, 0, At, B0); G_MMA(1, 1, At, B1); G_BAR; G_SCHED;
        }
        if (wr == 0) G_BAR;
        ph.epi(acc, cur, wr, wc, fr, fq);
        if (!has_next) break;
#pragma unroll
        for (int a = 0; a < 2; ++a)
#pragma unroll
            for (int b = 0; b < 2; ++b)
#pragma unroll
                for (int m = 0; m < 4; ++m)
#pragma unroll
                    for (int n = 0; n < 2; ++n) acc[a][b][m][n] = (f32x4){0.f, 0.f, 0.f, 0.f};
        cur = nxt; cA = nA; cB = nB; ++ui;
        if (wr == 1) G_BAR;
    }
    G_WAIT_V(0);
    G_BAR;
}
}

using gm::Unit;
#define EPI_ARGS const f32x4 (&acc)[2][2][4][2], const Unit& u, int wr, int wc, int fr_in, int fq_in
#define EPI_OPAQUE int fr = fr_in, fq = fq_in; asm volatile("" : "+v"(fr), "+v"(fq));
#define NO_GATHER __device__ __forceinline__ void a_offs(const Unit&, int, unsigned (&)[2][2]) const {}
#define EPI_FENCE() asm volatile("" ::: "memory")
__device__ __forceinline__ u32x4 pack8(const f32x4& v0, const f32x4& v1) { u32x4 w; w.x = cvt_pk_bf16(v0[0], v0[1]); w.y = cvt_pk_bf16(v0[2], v0[3]); w.z = cvt_pk_bf16(v1[0], v1[1]); w.w = cvt_pk_bf16(v1[2], v1[3]); return w; }
__device__ __forceinline__ float fast_sigmoid(float v) { return __builtin_amdgcn_rcpf(1.f + __builtin_amdgcn_exp2f(-LOG2E * v)); }
__device__ __forceinline__ float fast_gelu(float v) { const float u2 = 1.5957691216057308f * (v + 0.044715f * v * v * v); return v * fast_sigmoid(u2); }

struct PhQKV {
    static constexpr bool GATHER = false; static constexpr int LDA = 1024, K = 1024, LDB = 1024, HSTEPB = 128 * 1024 * 2;
    unsigned char* ws; const char* Abase; int G, c;
    __device__ __forceinline__ bool next(int i, Unit& u) const { return gm::static_unit(i, G, c, M / 256, 12, u); }
    NO_GATHER __device__ __forceinline__ const char* a_tile(const Unit& u) const { return Abase + (size_t)(u.pm * 256) * 1024 * 2; }
    __device__ __forceinline__ const char* b_tile(const Unit& u) const { return (const char*)(ws + WS_WQKV) + (size_t)u.pn * 256 * 1024 * 2; }
    __device__ __forceinline__ void epi(EPI_ARGS) const { EPI_OPAQUE
        const int row0 = u.pm * 256 + wr * 64 + fr; const int t = u.pn >> 2; const int colt = (u.pn & 3) * 256;
        bf16* base = (bf16*)(ws + WS_Q) + (size_t)t * (16u * 1024u * 1024u); const float sc = (t == 0) ? C2 : 1.f;
        const int col0 = colt + wc * 32 + 8 * fq;
#pragma unroll
        for (int ai = 0; ai < 2; ++ai)
#pragma unroll
            for (int m = 0; m < 4; ++m) { bf16* rowp = base + (size_t)(row0 + ai * 128 + m * 16) * 1024 + col0;
#pragma unroll
                for (int bj = 0; bj < 2; ++bj) *(u32x4*)(rowp + bj * 128) = pack8(acc[ai][bj][m][0] * sc, acc[ai][bj][m][1] * sc); }
    }
};
struct PhWo {
    static constexpr bool GATHER = false; static constexpr int LDA = 1024, K = 1024, LDB = 1024, HSTEPB = 128 * 1024 * 2;
    unsigned char* ws; const char* Abase; const float* resid; float* out; int G, c;
    __device__ __forceinline__ bool next(int i, Unit& u) const { return gm::static_unit(i, G, c, M / 256, 4, u); }
    NO_GATHER __device__ __forceinline__ const char* a_tile(const Unit& u) const { return Abase + (size_t)(u.pm * 256) * 1024 * 2; }
    __device__ __forceinline__ const char* b_tile(const Unit& u) const { return (const char*)(ws + WS_WO) + (size_t)u.pn * 256 * 1024 * 2; }
    __device__ __forceinline__ void epi(EPI_ARGS) const { EPI_OPAQUE
        const size_t off0 = (size_t)(u.pm * 256 + wr * 64 + fr) * 1024 + u.pn * 256 + wc * 32 + 8 * fq; bf16* hb = (bf16*)out;
#pragma unroll
        for (int ai = 0; ai < 2; ++ai) { f32x4 r[4][2][2];
#pragma unroll
            for (int m = 0; m < 4; ++m)
#pragma unroll
                for (int bj = 0; bj < 2; ++bj) { const float* p = resid + off0 + (size_t)(ai * 128 + m * 16) * 1024 + bj * 128; r[m][bj][0] = *(const f32x4*)p; r[m][bj][1] = *(const f32x4*)(p + 4); }
            EPI_FENCE();
#pragma unroll
            for (int m = 0; m < 4; ++m)
#pragma unroll
                for (int bj = 0; bj < 2; ++bj) { const size_t off = off0 + (size_t)(ai * 128 + m * 16) * 1024 + bj * 128; const f32x4 v0 = acc[ai][bj][m][0] + r[m][bj][0], v1 = acc[ai][bj][m][1] + r[m][bj][1];
                    *(u32x4*)(hb + off) = pack8(v0, v1); }
            EPI_FENCE(); }
    }
};
struct PhWout {
    static constexpr bool GATHER = false; static constexpr int LDA = 1024, K = 1024, LDB = 1024, HSTEPB = 128 * 1024 * 2;
    unsigned char* ws; const char* Abase; float* out; int G, c;
    __device__ __forceinline__ bool next(int i, Unit& u) const { return gm::static_unit(i, G, c, M / 256, 8, u); }
    NO_GATHER __device__ __forceinline__ const char* a_tile(const Unit& u) const { return Abase + (size_t)(u.pm * 256) * 1024 * 2; }
    __device__ __forceinline__ const char* b_tile(const Unit& u) const { return (const char*)(ws + WS_WOUT) + (size_t)u.pn * 256 * 1024 * 2; }
    __device__ __forceinline__ void epi(EPI_ARGS) const { EPI_OPAQUE
        const size_t off0 = (size_t)(u.pm * 256 + wr * 64 + fr) * 1024 + u.pn * 128 + wc * 32 + 8 * fq; bf16* hb = (bf16*)(ws + WS_XN); const bf16* rs = (const bf16*)out + (size_t)M * D;
        u32x4 r[2][4];
#pragma unroll
        for (int ai = 0; ai < 2; ++ai)
#pragma unroll
            for (int m = 0; m < 4; ++m) r[ai][m] = *(const u32x4*)(rs + off0 + (size_t)(ai * 128 + m * 16) * 1024);
        EPI_FENCE();
#pragma unroll
        for (int ai = 0; ai < 2; ++ai)
#pragma unroll
            for (int m = 0; m < 4; ++m) { const size_t off = off0 + (size_t)(ai * 128 + m * 16) * 1024; f32x4 v0, v1;
#pragma unroll
                for (int j = 0; j < 4; ++j) { const unsigned w0 = r[ai][m][j >> 1], w1 = r[ai][m][2 + (j >> 1)];
                    const float r0 = __uint_as_float((j & 1) ? (w0 & 0xffff0000u) : (w0 << 16)), r1 = __uint_as_float((j & 1) ? (w1 & 0xffff0000u) : (w1 << 16));
                    v0[j] = r0 + acc[ai][0][m][0][j] * fast_sigmoid(acc[ai][1][m][0][j]); v1[j] = r1 + acc[ai][0][m][1][j] * fast_sigmoid(acc[ai][1][m][1][j]); }
                *(u32x4*)(hb + off) = pack8(v0, v1); }
        EPI_FENCE();
    }
};
__device__ __forceinline__ void moe_locate(LAS unsigned char* lds, int tile, Unit& u) { const LAS int* cn = (const LAS int*)(lds + AUX_OFF); const LAS int* tb = cn + 32;
    int e = 0; while (e < 31 && tb[e + 1] <= tile) ++e; u.e = e; u.pm = tile - tb[e]; u.gt = tile; u.cnt = cn[e]; }
struct PhGateUp {
    static constexpr bool GATHER = true; static constexpr int LDA = 1024, K = 1024, LDB = 1024, HSTEPB = 128 * 1024 * 2;
    unsigned char* ws; const char* Abase; LAS unsigned char* lds; int G, c;
    __device__ __forceinline__ bool next(int i, Unit& u) const { const int idx = i * G + c; const int nt = ((const LAS int*)(lds + AUX_OFF))[64]; if (idx >= 2 * nt) return false; u.pn = idx & 1; moe_locate(lds, idx >> 1, u); return true; }
    __device__ __forceinline__ void a_offs(const Unit& u, int tid, unsigned (&o)[2][2]) const { const int* pdst = (const int*)(ws + WS_PDST);
#pragma unroll
        for (int i = 0; i < 2; ++i) { int R, C; gm::stage_rc(tid * 16 + i * 8192, R, C);
#pragma unroll
            for (int h = 0; h < 2; ++h) { int slot = u.pm * 256 + 128 * h + R; slot = slot < u.cnt ? slot : u.cnt - 1; const int tok = pdst[u.e * CAP + slot] >> 1; o[h][i] = (unsigned)(tok * 1024 + C) * 2u; } }
    }
    __device__ __forceinline__ const char* a_tile(const Unit&) const { return Abase; }
    __device__ __forceinline__ const char* b_tile(const Unit& u) const { return (const char*)(ws + WS_WGU) + ((size_t)u.e * 512 + u.pn * 256) * 1024 * 2; }
    __device__ __forceinline__ void epi(EPI_ARGS) const { EPI_OPAQUE
        const int r0 = wr * 64 + fr, col0 = u.pn * 128 + wc * 32 + 8 * fq; const float* ps = (const float*)(ws + WS_PS) + u.e * CAP; bf16* H = (bf16*)(ws + WS_H);
        float sv[2][4];
#pragma unroll
        for (int ai = 0; ai < 2; ++ai)
#pragma unroll
            for (int m = 0; m < 4; ++m) { int slot = u.pm * 256 + r0 + ai * 128 + m * 16; slot = slot < u.cnt ? slot : u.cnt - 1; sv[ai][m] = ps[slot]; }
        EPI_FENCE();
#pragma unroll
        for (int ai = 0; ai < 2; ++ai)
#pragma unroll
            for (int m = 0; m < 4; ++m) { const int r = r0 + ai * 128 + m * 16; const float s = sv[ai][m];
                f32x4 v0, v1;
#pragma unroll
                for (int j = 0; j < 4; ++j) { const float g0 = acc[ai][0][m][0][j] * s, u0 = acc[ai][1][m][0][j] * s, g1 = acc[ai][0][m][1][j] * s, u1 = acc[ai][1][m][1][j] * s;
                    v0[j] = g0 * fast_sigmoid(g0) * u0; v1[j] = g1 * fast_sigmoid(g1) * u1; }
                *(u32x4*)(H + ((size_t)u.gt * 256 + r) * 256 + col0) = pack8(v0, v1); }
        EPI_FENCE();
    }
};
struct PhDown {
    static constexpr bool GATHER = false; static constexpr int LDA = 256, K = 256, LDB = 256, HSTEPB = 128 * 256 * 2;
    unsigned char* ws; const char* Abase; LAS unsigned char* lds; int G, c;
    __device__ __forceinline__ bool next(int i, Unit& u) const { const int idx = i * G + c; const int nt = ((const LAS int*)(lds + AUX_OFF))[64]; if (idx >= 4 * nt) return false; u.pn = idx & 3; moe_locate(lds, idx >> 2, u); return true; }
    NO_GATHER __device__ __forceinline__ const char* a_tile(const Unit& u) const { return Abase + (size_t)(u.gt * 256) * 256 * 2; }
    __device__ __forceinline__ const char* b_tile(const Unit& u) const { return (const char*)(ws + WS_WD) + ((size_t)u.e * 1024 + u.pn * 256) * 256 * 2; }
    __device__ __forceinline__ void epi(EPI_ARGS) const { EPI_OPAQUE
        const int r0 = wr * 64 + fr, col0 = u.pn * 256 + wc * 32 + 8 * fq; const int* pdst = (const int*)(ws + WS_PDST) + u.e * CAP; const float* pw = (const float*)(ws + WS_PW) + u.e * CAP; bf16* Y2 = (bf16*)(ws + WS_Y2);
        int dv[2][4]; float wv[2][4];
#pragma unroll
        for (int ai = 0; ai < 2; ++ai)
#pragma unroll
            for (int m = 0; m < 4; ++m) { int slot = u.pm * 256 + r0 + ai * 128 + m * 16; slot = slot < u.cnt ? slot : u.cnt - 1; dv[ai][m] = pdst[slot]; wv[ai][m] = pw[slot]; }
        EPI_FENCE();
#pragma unroll
        for (int ai = 0; ai < 2; ++ai)
#pragma unroll
            for (int m = 0; m < 4; ++m) { const int slot = u.pm * 256 + r0 + ai * 128 + m * 16;
                if (slot < u.cnt) { const float w8 = wv[ai][m]; bf16* yp = Y2 + (size_t)dv[ai][m] * 1024 + col0;
#pragma unroll
                    for (int bj = 0; bj < 2; ++bj) *(u32x4*)(yp + bj * 128) = pack8(acc[ai][bj][m][0] * w8, acc[ai][bj][m][1] * w8); } }
        EPI_FENCE();
    }
};
struct PhSloc {
    static constexpr bool GATHER = false; static constexpr int LDA = 384, K = 256, LDB = 256, HSTEPB = 0;
    unsigned char* ws; const char* Abase; int G, c;
    __device__ __forceinline__ bool next(int i, Unit& u) const { const int idx = i * G + c; if (idx >= 256) return false; u.e = idx >> 2; u.pm = idx & 3; u.pn = 0; u.gt = 0; u.cnt = 0; return true; }
    NO_GATHER __device__ __forceinline__ const char* a_tile(const Unit& u) const { return Abase + (size_t)(u.e * 1024 + u.pm * 256) * 384 * 2; }
    __device__ __forceinline__ const char* b_tile(const Unit& u) const { return (const char*)(ws + WS_SSM) + (size_t)u.e * SSM_G_BYTES; }
    __device__ __forceinline__ void epi(EPI_ARGS) const { EPI_OPAQUE
        const int r0 = u.e * 1024 + u.pm * 256 + wr * 64 + fr, col0 = wc * 32 + 8 * fq; float* Sloc = (float*)(ws + WS_SLOC);
#pragma unroll
        for (int ai = 0; ai < 2; ++ai)
#pragma unroll
            for (int m = 0; m < 4; ++m) { float* p = Sloc + (size_t)(r0 + ai * 128 + m * 16) * 128 + col0; *(f32x4*)p = acc[ai][0][m][0]; *(f32x4*)(p + 4) = acc[ai][0][m][1]; }
    }
};
struct PhY {
    static constexpr bool GATHER = false; static constexpr int LDA = 384, K = 384, LDB = 384, HSTEPB = 128 * 384 * 2;
    unsigned char* ws; const char* Abase; int G, c;
    __device__ __forceinline__ bool next(int i, Unit& u) const { const int idx = i * G + c; if (idx >= 256) return false; u.e = idx >> 2; u.pm = idx & 3; u.pn = 0; u.gt = 0; u.cnt = 0; return true; }
    NO_GATHER __device__ __forceinline__ const char* a_tile(const Unit& u) const { return Abase + (size_t)(u.e * 1024 + u.pm * 256) * 384 * 2; }
    __device__ __forceinline__ const char* b_tile(const Unit& u) const { return (const char*)(ws + WS_SSM) + (size_t)u.e * SSM_G_BYTES + SSM_A2_OFF; }
    __device__ __forceinline__ void epi(EPI_ARGS) const { EPI_OPAQUE
        const int nb = (u.pm & 1) * 256 + wr * 64 + fr;
        bf16* p = (bf16*)(ws + WS_G) + ((size_t)(u.pm >> 1) * SEQ + 16 * nb + 2 * wc + (fq >> 1)) * 1024 + 16 * u.e + 8 * (fq & 1);
#pragma unroll
        for (int ai = 0; ai < 2; ++ai)
#pragma unroll
            for (int m = 0; m < 4; ++m) {
#pragma unroll
                for (int bj = 0; bj < 2; ++bj) { f32x4 v0, v1;
#pragma unroll
                    for (int j = 0; j < 4; ++j) { v0[j] = fast_gelu(acc[ai][bj][m][0][j]); v1[j] = fast_gelu(acc[ai][bj][m][1][j]); }
                    *(u32x4*)(p + bj * 8 * 1024) = pack8(v0, v1); }
                p += (m == 3 ? (128 - 48) : 16) * 16 * 1024; asm volatile("" : "+v"(p) :: "memory"); }
    }
};

namespace at {
constexpr int NSLOT = 3, SLOTB = 8192;
constexpr int LDS_K = 0, LDS_V = NSLOT * SLOTB, LDS_WS = 2 * NSLOT * SLOTB, LDS_TBL = LDS_WS + 2048, LDS_OST = LDS_TBL + 2048, LDS_TOTAL = LDS_OST + 8 * 4096;
typedef short v4i16_t __attribute__((ext_vector_type(4)));
__device__ __forceinline__ int crow(int r, int hi) { return (r & 3) + 8 * (r >> 2) + 4 * hi; }
__device__ __forceinline__ void glds16(const void* gsrc, unsigned lds_dst) { unsigned keep;
    asm volatile("s_mov_b32 %0, m0\n\ts_mov_b32 m0, %2\n\ts_nop 0\n\tglobal_load_lds_dwordx4 %1, off\n\ts_mov_b32 m0, %0" : "=&s"(keep) : "v"(gsrc), "s"(lds_dst) : "memory"); }
__device__ __forceinline__ s16x4 vtr(const LAS unsigned char* p) { return __builtin_bit_cast(s16x4, __builtin_amdgcn_ds_read_tr16_b64_v4i16((LAS v4i16_t*)p)); }
#define AT_WAIT_BAR(N) asm volatile("s_waitcnt vmcnt(" #N ") lgkmcnt(0)\n\ts_barrier" ::: "memory")
template <int THR> __device__ __forceinline__ void attn_unit(int b, int h, int qb, const bf16* Q, const bf16* __restrict__ K, const bf16* __restrict__ V, bf16* O, const float* __restrict__ relb, LAS unsigned char* shm) {
    const int tid = threadIdx.x, lane = tid & 63, r32 = lane & 31, hi = lane >> 5; const int wid = __builtin_amdgcn_readfirstlane(tid >> 6);
    const long rowbase = (long)b * SEQ; const int q0 = qb * 256; const int cq = 4 * qb + (wid >> 1);
    const bf16* Qw = Q + (rowbase + q0 + wid * 32) * D + h * 64;
    const unsigned lds0 = (unsigned)(uintptr_t)shm;
    LAS float* wsf = (LAS float*)(shm + LDS_WS) + wid * 64; LAS float* tbl = (LAS float*)(shm + LDS_TBL);
    const int kc_lo = (4 * qb - 8) < 0 ? 0 : (4 * qb - 8); const int NT = 4 * qb + 3 - kc_lo + 1;
    if (tid < 320) tbl[tid] = relb[h * NREL + (tid < 256 ? tid : 256)] * LOG2E;
    const bf16* ksrc = K + (rowbase + kc_lo * 64 + lane) * D + h * 64 + wid * 8;
    const bf16* vsrc = V + (rowbase + kc_lo * 64 + 16 * (wid & 3) + (lane >> 2)) * D + h * 64 + (wid >> 2) * 32 + (lane & 3) * 8;
    const unsigned kdst = lds0 + LDS_K + wid * 1024, vdst = lds0 + LDS_V + wid * 1024;
#define AT_DMA(t, slotoff) do { glds16(ksrc + (long)(t) * 64 * D, (unsigned)__builtin_amdgcn_readfirstlane(kdst + (slotoff))); glds16(vsrc + (long)(t) * 64 * D, (unsigned)__builtin_amdgcn_readfirstlane(vdst + (slotoff))); } while (0)
    bf16x8 qr[4];
#pragma unroll
    for (int d0 = 0; d0 < 4; ++d0) qr[d0] = *reinterpret_cast<const bf16x8*>(&Qw[(long)r32 * D + d0 * 16 + hi * 8]);
    asm volatile("s_waitcnt vmcnt(0)" ::: "memory");
    AT_DMA(0, 0); if (NT > 1) AT_DMA(1, SLOTB);
    float mrow = -1e30f, lsum = 0.f; f32x16 o[2]; o[0] = f32x16{}; o[1] = f32x16{};
    int sl_cur = 0, sl_nn = 2 * SLOTB;
    for (int t = 0; t < NT; ++t) {
        const int kc = kc_lo + t;
        if (t + 1 < NT) { AT_WAIT_BAR(2); } else { AT_WAIT_BAR(0); }
        if (t + 2 < NT) AT_DMA(t + 2, sl_nn);
        if (kc >= cq - 8 && kc <= cq) {
            const LAS unsigned char* kp = shm + LDS_K + sl_cur + hi * 1024 + r32 * 16;
            const int delta = cq - kc; const bool first = (mrow < -1e29f);
            const float msub = first ? 0.f : mrow;
            f32x16 p0, p1;
            if (delta >= 3) { const float c0 = tbl[256] - msub;
#pragma unroll
                for (int r = 0; r < 16; ++r) { p0[r] = c0; p1[r] = c0; } }
            else { const LAS float* tb = tbl + (64 * delta + 32 * (wid & 1) + r32 + 128 - 4 * hi);
#pragma unroll
                for (int r = 0; r < 16; ++r) { const int kj = (r & 3) + 8 * (r >> 2); p0[r] = tb[-kj] - msub; p1[r] = tb[-kj - 32] - msub; } }
#pragma unroll
            for (int d0 = 0; d0 < 4; ++d0) { const bf16x8 b0 = *(const LAS bf16x8*)(kp + d0 * 2048), b1 = *(const LAS bf16x8*)(kp + d0 * 2048 + 512);
                p0 = __builtin_amdgcn_mfma_f32_32x32x16_bf16(b0, qr[d0], p0, 0, 0, 0); p1 = __builtin_amdgcn_mfma_f32_32x32x16_bf16(b1, qr[d0], p1, 0, 0, 0); }
            float ra = fmaxf(fmaxf(p0[0], p0[1]), p1[0]), rb2 = fmaxf(fmaxf(p0[2], p0[3]), p1[1]); ra = fmaxf(fmaxf(ra, p1[2]), p1[3]);
#pragma unroll
            for (int r = 4; r < 16; r += 4) { ra = fmaxf(fmaxf(ra, p0[r]), p0[r + 1]); rb2 = fmaxf(fmaxf(rb2, p0[r + 2]), p0[r + 3]); ra = fmaxf(fmaxf(ra, p1[r]), p1[r + 1]); rb2 = fmaxf(fmaxf(rb2, p1[r + 2]), p1[r + 3]); }
            float rm = fmaxf(ra, rb2);
            { auto rr = __builtin_amdgcn_permlane32_swap(__float_as_uint(rm), __float_as_uint(rm), false, false); rm = fmaxf(__uint_as_float(rr[0]), __uint_as_float(rr[1])); }
            if (first) { mrow = rm;
#pragma unroll
                for (int r = 0; r < 16; ++r) { p0[r] -= rm; p1[r] -= rm; } }
            else if (__any(rm > (float)THR)) {
                const float dl = fmaxf(rm, 0.f), f = __builtin_amdgcn_exp2f(-dl); mrow += dl; lsum *= f;
                if (hi == 0) wsf[r32] = f;
                LDS_WAIT();
#pragma unroll
                for (int r = 0; r < 16; ++r) { const float fr_ = wsf[crow(r, hi)]; o[0][r] *= fr_; o[1][r] *= fr_; p0[r] -= dl; p1[r] -= dl; }
            }
            float sacc = 0.f, sacc2 = 0.f;
#pragma unroll
            for (int r = 0; r < 16; ++r) { p0[r] = __builtin_amdgcn_exp2f(p0[r]); p1[r] = __builtin_amdgcn_exp2f(p1[r]); sacc += p0[r]; sacc2 += p1[r]; }
            lsum += sacc + sacc2;
            u32x4 pw0, pw1, pw2, pw3;
            pw0 = (u32x4){cvtpk_s(p0[0], p0[1]), cvtpk_s(p0[2], p0[3]), cvtpk_s(p0[4], p0[5]), cvtpk_s(p0[6], p0[7])};
            pw1 = (u32x4){cvtpk_s(p0[8], p0[9]), cvtpk_s(p0[10], p0[11]), cvtpk_s(p0[12], p0[13]), cvtpk_s(p0[14], p0[15])};
            pw2 = (u32x4){cvtpk_s(p1[0], p1[1]), cvtpk_s(p1[2], p1[3]), cvtpk_s(p1[4], p1[5]), cvtpk_s(p1[6], p1[7])};
            pw3 = (u32x4){cvtpk_s(p1[8], p1[9]), cvtpk_s(p1[10], p1[11]), cvtpk_s(p1[12], p1[13]), cvtpk_s(p1[14], p1[15])};
            const bf16x8 pa[4] = {__builtin_bit_cast(bf16x8, pw0), __builtin_bit_cast(bf16x8, pw1), __builtin_bit_cast(bf16x8, pw2), __builtin_bit_cast(bf16x8, pw3)};
            const LAS unsigned char* vp = shm + LDS_V + sl_cur + ((lane >> 4) & 1) * 32 + (lane & 3) * 8 + (4 * hi + ((lane & 15) >> 2)) * 64;
#pragma unroll
            for (int d0 = 0; d0 < 2; ++d0)
#pragma unroll
                for (int ks = 0; ks < 4; ++ks) { const s16x4 lo = vtr(vp + d0 * 4096 + ks * 1024), hh = vtr(vp + d0 * 4096 + ks * 1024 + 512);
                    const bf16x8 vf = (bf16x8){lo[0], lo[1], lo[2], lo[3], hh[0], hh[1], hh[2], hh[3]};
                    o[d0] = __builtin_amdgcn_mfma_f32_32x32x16_bf16(pa[ks], vf, o[d0], 0, 0, 0); }
        }
        sl_cur = (sl_cur == 2 * SLOTB) ? 0 : sl_cur + SLOTB; sl_nn = (sl_nn == 2 * SLOTB) ? 0 : sl_nn + SLOTB;
    }
    { auto rr = __builtin_amdgcn_permlane32_swap(__float_as_uint(lsum), __float_as_uint(lsum), false, false); lsum = __uint_as_float(rr[0]) + __uint_as_float(rr[1]); }
    if (hi == 0) wsf[32 + r32] = lsum;
    LDS_WAIT();
    float rli[16];
#pragma unroll
    for (int r = 0; r < 16; ++r) rli[r] = __builtin_amdgcn_rcpf(wsf[32 + crow(r, hi)]);
    bf16* Ow = O + (rowbase + q0 + wid * 32) * D + h * 64;
    { LAS bf16* stg = (LAS bf16*)(shm + LDS_OST) + wid * 2048;
#pragma unroll
      for (int r = 0; r < 16; ++r) { const int orow = crow(r, hi);
#pragma unroll
          for (int d0 = 0; d0 < 2; ++d0) stg[orow * 64 + d0 * 32 + r32] = f2bf(o[d0][r] * rli[r]); }
      LDS_WAIT();
#pragma unroll
      for (int i = 0; i < 4; ++i) { const int row = i * 8 + (lane >> 3), ch = lane & 7; const u32x4 v = *(const LAS u32x4*)(stg + row * 64 + ch * 8); *(u32x4*)(Ow + (long)row * D + ch * 8) = v; } }
    asm volatile("s_waitcnt lgkmcnt(0)\n\ts_barrier" ::: "memory");
#undef AT_DMA
}
}

struct Args { const float* in[23]; float* out; unsigned char* ws; int ph_lo, ph_hi, li, pad; };

__device__ __forceinline__ void tr_item(const float* __restrict__ W, int ldw, int k0, int n0, bf16* __restrict__ WT, int ldt, int drow0, const float* __restrict__ ks, LAS float* scr, int lane) {
    float v[32];
    const float* wp = W + (size_t)(k0 + (lane >> 5)) * ldw + n0 + (lane & 31);
#pragma unroll
    for (int i = 0; i < 32; ++i) v[i] = wp[(size_t)(2 * i) * ldw];
    if (ks) {
#pragma unroll
        for (int i = 0; i < 32; ++i) v[i] *= ks[k0 + 2 * i + (lane >> 5)]; }
#pragma unroll
    for (int i = 0; i < 32; ++i) scr[(2 * i + (lane >> 5)) * 33 + (lane & 31)] = v[i];
    LDS_WAIT(); asm volatile("" ::: "memory");
    const int c = lane & 7;
#pragma unroll
    for (int j = 0; j < 4; ++j) { const int n = (lane >> 3) + 8 * j; const LAS float* s = scr + (8 * c) * 33 + n;
        u32x4 o; o.x = pk2(s[0 * 33], s[1 * 33]); o.y = pk2(s[2 * 33], s[3 * 33]); o.z = pk2(s[4 * 33], s[5 * 33]); o.w = pk2(s[6 * 33], s[7 * 33]);
        *(u32x4*)(WT + (size_t)(drow0 + n) * ldt + k0 + 8 * c) = o; }
    LDS_WAIT(); asm volatile("" ::: "memory");
}
__device__ __forceinline__ void moe_convert(const float* wg, const float* wu, const float* wd, const float* gn, bf16* WGU, bf16* WD, LAS float* scr, int gw, int NGW, int lane) {
    for (int it = gw; it < 12288; it += NGW) {
        if (it < 8192) { const int which = it >> 12, r = it & 4095, e = r >> 7, kb = (r >> 3) & 15, nb = r & 7, n0 = nb * 32;
            tr_item((which ? wu : wg) + (size_t)e * 1024 * 256, 256, kb * 64, n0, WGU, 1024, e * 512 + 256 * (n0 >> 7) + 128 * which + (n0 & 127), gn, scr, lane); }
        else { const int r = it - 8192, e = r >> 7, kb = (r >> 5) & 3, nb = r & 31;
            tr_item(wd + (size_t)e * 256 * 1024, 1024, kb * 64, nb * 32, WD, 256, e * 1024 + nb * 32, nullptr, scr, lane); }
    }
}
__device__ __forceinline__ void ssm_mats(int g, int q, const float* lre, const float* lim, const float* lstep, const float* bre, const float* bim, const float* cre, const float* cim, const float* dsk,
                                         unsigned char* ssm_ws, float* a16g, LAS float* L, int tid) {
    LAS float* pwr = L; LAS float* pwi = L + 64 * 17; LAS float* bbr = L + 2 * 64 * 17; LAS float* bbi = bbr + 1024; LAS float* ccr = bbi + 1024; LAS float* cci = ccr + 1024; LAS float* Kt = cci + 1024;
    if (tid < 64) { const int p = tid;
        const float lr = fminf(lre[g * 64 + p], -1e-4f), li = lim[g * 64 + p], step = expf(lstep[g]);
        const float decay = expf(lr * step), ang = li * step, ar = decay * cosf(ang), ai = decay * sinf(ang);
        const float den = lr * lr + li * li, nr = ar - 1.f, fr = (nr * lr + ai * li) / den, fi = (ai * lr - nr * li) / den;
        for (int c = 0; c < 16; ++c) { const float br = bre[(g * 64 + p) * 16 + c], bi = bim[(g * 64 + p) * 16 + c]; bbr[p * 16 + c] = fr * br - fi * bi; bbi[p * 16 + c] = fr * bi + fi * br;
            ccr[c * 64 + p] = cre[(g * 16 + c) * 64 + p]; cci[c * 64 + p] = cim[(g * 16 + c) * 64 + p]; }
        float xr = 1.f, xi = 0.f;
        for (int n = 0; n <= 16; ++n) { pwr[p * 17 + n] = xr; pwi[p * 17 + n] = xi; const float t = xr * ar - xi * ai; xi = xr * ai + xi * ar; xr = t; }
        if (q == 0) { a16g[(g * 64 + p) * 2] = pwr[p * 17 + 16]; a16g[(g * 64 + p) * 2 + 1] = pwi[p * 17 + 16]; }
    }
    __syncthreads();
    if (tid < 256) { const int tl = tid >> 6, c = (tid >> 2) & 15, cq = tid & 3, tau = 4 * q + tl;
        float s0 = 0.f, s1 = 0.f, s2 = 0.f, s3 = 0.f;
        for (int p = 0; p < 64; ++p) { const float cr = ccr[c * 64 + p], ci = cci[c * 64 + p], ar = pwr[p * 17 + tau], ai = pwi[p * 17 + tau]; const float tr = cr * ar - ci * ai, ti = cr * ai + ci * ar;
            const f32x4 br = *(const LAS f32x4*)(bbr + p * 16 + 4 * cq), bi = *(const LAS f32x4*)(bbi + p * 16 + 4 * cq);
            s0 += tr * br[0] - ti * bi[0]; s1 += tr * br[1] - ti * bi[1]; s2 += tr * br[2] - ti * bi[2]; s3 += tr * br[3] - ti * bi[3]; }
        if (tau == 0) { const float dd = dsk[g * 16 + c]; if (4 * cq == (c & ~3)) { if ((c & 3) == 0) s0 += dd; else if ((c & 3) == 1) s1 += dd; else if ((c & 3) == 2) s2 += dd; else s3 += dd; } }
        LAS float* kp = Kt + tl * 256 + c * 16 + 4 * cq; kp[0] = s0; kp[1] = s1; kp[2] = s2; kp[3] = s3; }
    __syncthreads();
    bf16* Bend = (bf16*)(ssm_ws + (size_t)g * SSM_G_BYTES); bf16* A2 = (bf16*)(ssm_ws + (size_t)g * SSM_G_BYTES + SSM_A2_OFF);
    for (int o = tid; o < 2048; o += NTHR) { const int tl = o >> 9, i = (o >> 5) & 15, c = (o >> 1) & 15, hf = o & 1, tau = 4 * q + tl, j = i - tau;
        if (j >= 0) { const LAS float* kp = Kt + tl * 256 + c * 16 + 8 * hf; u32x4 w; w.x = pk2(kp[0], kp[1]); w.y = pk2(kp[2], kp[3]); w.z = pk2(kp[4], kp[5]); w.w = pk2(kp[6], kp[7]);
            *(u32x4*)(A2 + (size_t)(i * 16 + c) * 384 + j * 16 + 8 * hf) = w; } }
    for (int o = tid; o < 2048; o += NTHR) { const int il = o >> 9, c = (o >> 5) & 15, j = (o >> 1) & 15, hf = o & 1, i = 4 * q + il;
        if (j > i) *(u32x4*)(A2 + (size_t)(i * 16 + c) * 384 + j * 16 + 8 * hf) = (u32x4){0u, 0u, 0u, 0u}; }
    for (int o = tid; o < 1024; o += NTHR) { const int il = o >> 8, c = (o >> 4) & 15, k8 = (o & 15) * 8, i = 4 * q + il; float v[8];
#pragma unroll
        for (int qq = 0; qq < 4; ++qq) { const int p = (k8 >> 1) + qq; const float cr = ccr[c * 64 + p], ci = cci[c * 64 + p], ar = pwr[p * 17 + i + 1], ai = pwi[p * 17 + i + 1];
            v[2 * qq] = cr * ar - ci * ai; v[2 * qq + 1] = -(cr * ai + ci * ar); }
        u32x4 w; w.x = pk2(v[0], v[1]); w.y = pk2(v[2], v[3]); w.z = pk2(v[4], v[5]); w.w = pk2(v[6], v[7]); *(u32x4*)(A2 + (size_t)(i * 16 + c) * 384 + 256 + k8) = w; }
    for (int o = tid; o < 1024; o += NTHR) { const int n = 32 * q + (o >> 5), k8 = (o & 31) * 8, p = n >> 1, ri = n & 1, j = k8 >> 4; float v[8];
        const float ar = pwr[p * 17 + 15 - j], ai = pwi[p * 17 + 15 - j];
#pragma unroll
        for (int qq = 0; qq < 8; ++qq) { const int c2 = (k8 & 15) + qq; const float br = bbr[p * 16 + c2], bi = bbi[p * 16 + c2]; v[qq] = ri ? (ar * bi + ai * br) : (ar * br - ai * bi); }
        u32x4 w; w.x = pk2(v[0], v[1]); w.y = pk2(v[2], v[3]); w.z = pk2(v[4], v[5]); w.w = pk2(v[6], v[7]); *(u32x4*)(Bend + (size_t)n * 256 + k8) = w; }
    __syncthreads();
}

__device__ __forceinline__ void router_phase(const bf16* __restrict__ h, const float* __restrict__ rwt, const float* __restrict__ bgr, const float* __restrict__ ber, unsigned* cntg,
                                             int* pdst, float* pw, float* ps, float* srow, LAS unsigned char* lds, int vcu, int G) {
    const int tid = threadIdx.x, lane = tid & 63, wid = __builtin_amdgcn_readfirstlane(tid >> 6);
    LAS float* Wl = (LAS float*)lds;
    for (int i = tid; i < RW_LAYER / 4; i += NTHR) ((LAS f32x4*)Wl)[i] = ((const f32x4*)rwt)[i];
    LAS int* lc = (LAS int*)(lds + RSCR_OFF); LAS int* lbase = lc + 32;
    const int rb = wid & 3, kh = wid >> 2, row = lane & 15, kq = lane >> 4;
    for (int blk = vcu; blk < M / 64; blk += G) {
        if (tid < 32) lc[tid] = 0;
        __syncthreads();
        const int t0 = blk * 64;
        const bf16* hp = h + (size_t)(t0 + 16 * rb + row) * D + 512 * kh + 8 * kq;
        const LAS float* wp0 = Wl + row * RW_PITCH + 512 * kh + 8 * kq; const LAS float* wp1 = wp0 + 16 * RW_PITCH; const LAS float* wp2 = Wl + (32 + (row & 3)) * RW_PITCH + 512 * kh + 8 * kq;
        f32x4 a0 = {0.f, 0.f, 0.f, 0.f}, a1 = a0, a2 = a0; float ssl = 0.f;
#pragma unroll 4
        for (int j = 0; j < 16; ++j) { const u32x4 hw = *(const u32x4*)(hp + 32 * j); float a[8];
#pragma unroll
            for (int i = 0; i < 4; ++i) { a[2 * i] = __uint_as_float(hw[i] << 16); a[2 * i + 1] = __uint_as_float(hw[i] & 0xffff0000u); }
#pragma unroll
            for (int hf = 0; hf < 2; ++hf) { const f32x4 b0 = *(const LAS f32x4*)(wp0 + 32 * j + 4 * hf), b1 = *(const LAS f32x4*)(wp1 + 32 * j + 4 * hf), b2 = *(const LAS f32x4*)(wp2 + 32 * j + 4 * hf);
#pragma unroll
                for (int i = 0; i < 4; ++i) { const float av = a[4 * hf + i]; ssl += av * av;
                    a0 = __builtin_amdgcn_mfma_f32_16x16x4f32(av, b0[i], a0, 0, 0, 0); a1 = __builtin_amdgcn_mfma_f32_16x16x4f32(av, b1[i], a1, 0, 0, 0); a2 = __builtin_amdgcn_mfma_f32_16x16x4f32(av, b2[i], a2, 0, 0, 0); } } }
        ssl += __shfl_xor(ssl, 16); ssl += __shfl_xor(ssl, 32);
        LAS float* P = (LAS float*)(lds + RSCR_OFF + 256);
        LAS float* pp = P + (16 * rb) * 40;
        if (kh == 1) {
#pragma unroll
            for (int r = 0; r < 4; ++r) { const int tk = 4 * kq + r; pp[tk * 40 + row] = a0[r]; pp[tk * 40 + 16 + row] = a1[r]; if (row < 4) pp[tk * 40 + 32 + row] = a2[r]; }
            if (kq == 0) pp[row * 40 + 36] = ssl; }
        __syncthreads();
        if (kh == 0) {
#pragma unroll
            for (int r = 0; r < 4; ++r) { const int tk = 4 * kq + r; pp[tk * 40 + row] += a0[r]; pp[tk * 40 + 16 + row] += a1[r]; if (row < 4) pp[tk * 40 + 32 + row] += a2[r]; }
            if (kq == 0) pp[row * 40 + 36] += ssl; }
        __syncthreads();
        int e1 = 0, e2 = 0; float w1 = 0.f, w2 = 0.f, s = 0.f; int sl1 = 0, sl2 = 0;
        if (tid < 64) { LAS float* p0 = P + tid * 40;
            s = rsqrtf(p0[36] * (1.f / D) + RMS_EPS);
            for (int o = 0; o < 36; ++o) p0[o] = p0[o] * s + (o < 4 ? bgr[o] : ber[o - 4]);
            int gi = 0; float gmx = p0[0];
            for (int i = 1; i < 4; ++i) if (p0[i] > gmx) { gmx = p0[i]; gi = i; }
            float den = 0.f; for (int i = 0; i < 4; ++i) den += __expf(p0[i] - gmx);
            const float gp = 1.f / den; const LAS float* sl = p0 + 4 + 8 * gi;
            int i1 = 0; float l1 = sl[0]; for (int i = 1; i < 8; ++i) if (sl[i] > l1) { l1 = sl[i]; i1 = i; }
            int i2 = -1; float l2 = -3.4e38f; for (int i = 0; i < 8; ++i) if (i != i1 && sl[i] > l2) { l2 = sl[i]; i2 = i; }
            const float ex = __expf(l2 - l1); w1 = gp / (1.f + ex); w2 = gp * ex / (1.f + ex); e1 = gi * 8 + i1; e2 = gi * 8 + i2;
            sl1 = __hip_atomic_fetch_add(&lc[e1], 1, __ATOMIC_RELAXED, __HIP_MEMORY_SCOPE_WORKGROUP); sl2 = __hip_atomic_fetch_add(&lc[e2], 1, __ATOMIC_RELAXED, __HIP_MEMORY_SCOPE_WORKGROUP);
            srow[t0 + tid] = s; }
        __syncthreads();
        if (tid < 32) { const int n = lc[tid]; lbase[tid] = n ? (int)__hip_atomic_fetch_add(cntg + tid * 64, (unsigned)n, RLX_AGENT) : 0; }
        __syncthreads();
        if (tid < 64) { const int t = t0 + tid; int i1 = lbase[e1] + sl1, i2 = lbase[e2] + sl2;
            if (i1 < CAP) { pdst[e1 * CAP + i1] = 2 * t; pw[e1 * CAP + i1] = w1; ps[e1 * CAP + i1] = s; }
            if (i2 < CAP) { pdst[e2 * CAP + i2] = 2 * t + 1; pw[e2 * CAP + i2] = w2; ps[e2 * CAP + i2] = s; } }
        __syncthreads();
    }
}

template <bool FINAL> __device__ __forceinline__ void combine_phase(const bf16* __restrict__ hin, const bf16* __restrict__ Y2, const float* __restrict__ g, bf16* __restrict__ hout, bf16* __restrict__ xng, float* __restrict__ outf, int vcu, int G, int wid, int lane) {
    for (int base = vcu * 16; base < M; base += G * 16) {
#pragma unroll
        for (int rr = 0; rr < 2; ++rr) { const int row = base + 2 * wid + rr;
            float4 v[4]; float ss = 0.f;
#pragma unroll
            for (int j = 0; j < 4; ++j) { const int c = 4 * (lane + 64 * j);
                const u32x2 hh = *(const u32x2*)(hin + (size_t)row * D + c), ya = *(const u32x2*)(Y2 + ((size_t)2 * row) * D + c), yb = *(const u32x2*)(Y2 + ((size_t)2 * row + 1) * D + c);
                v[j].x = __uint_as_float(hh.x << 16) + __uint_as_float(ya.x << 16) + __uint_as_float(yb.x << 16); v[j].y = __uint_as_float(hh.x & 0xffff0000u) + __uint_as_float(ya.x & 0xffff0000u) + __uint_as_float(yb.x & 0xffff0000u);
                v[j].z = __uint_as_float(hh.y << 16) + __uint_as_float(ya.y << 16) + __uint_as_float(yb.y << 16); v[j].w = __uint_as_float(hh.y & 0xffff0000u) + __uint_as_float(ya.y & 0xffff0000u) + __uint_as_float(yb.y & 0xffff0000u);
                ss += v[j].x * v[j].x + v[j].y * v[j].y + v[j].z * v[j].z + v[j].w * v[j].w;
                if (!FINAL) { u32x2 w; w.x = pk2(v[j].x, v[j].y); w.y = pk2(v[j].z, v[j].w); *(u32x2*)(hout + (size_t)row * D + c) = w; } }
            ss = wave_sum(ss); const float s = rsqrtf(ss * (1.f / D) + RMS_EPS);
#pragma unroll
            for (int j = 0; j < 4; ++j) { const int c = 4 * (lane + 64 * j); const float4 gg = *(const float4*)(g + c);
                const float ox = v[j].x * s * gg.x, oy = v[j].y * s * gg.y, oz = v[j].z * s * gg.z, ow = v[j].w * s * gg.w;
                if (FINAL) { float4 o; o.x = ox; o.y = oy; o.z = oz; o.w = ow; *(float4*)(outf + (size_t)row * D + c) = o; }
                else { u32x2 w; w.x = pk2(ox, oy); w.y = pk2(oz, ow); *(u32x2*)(xng + xng_off(row, c)) = w; } } }
    }
}

__device__ __forceinline__ void scan_unit(int g, int pm, const float* __restrict__ Sloc, const float* __restrict__ a16g, bf16* xng, LAS unsigned char* lds) {
    const int tid = threadIdx.x, p = tid & 63, q = tid >> 6, b = pm >> 1, half = pm & 1;
    LAS float* E = (LAS float*)(lds + AUX_OFF);
    const float ar = a16g[(g * 64 + p) * 2], ai = a16g[(g * 64 + p) * 2 + 1];
    float pr = ar, pi = ai;
#pragma unroll
    for (int k = 0; k < 5; ++k) { const float nr = pr * pr - pi * pi, ni = 2.f * pr * pi; pr = nr; pi = ni; }
    float cr = 0.f, ci = 0.f;
    for (int rnd = 0; rnd <= half; ++rnd) {
        const size_t row0 = (size_t)g * 1024 + b * 512 + rnd * 256 + q * 32;
        const float* sp = Sloc + row0 * 128 + 2 * p;
        float2 v[32];
#pragma unroll
        for (int s = 0; s < 32; ++s) v[s] = *(const float2*)(sp + (size_t)s * 128);
        float xr = 0.f, xi = 0.f;
#pragma unroll
        for (int s = 0; s < 32; ++s) { const float nr = ar * xr - ai * xi + v[s].x, ni = ar * xi + ai * xr + v[s].y; xr = nr; xi = ni; }
        E[(q * 64 + p) * 2] = xr; E[(q * 64 + p) * 2 + 1] = xi;
        __syncthreads();
        float ir = cr, ii = ci, mr = 0.f, mi = 0.f;
#pragma unroll
        for (int qq = 0; qq < 8; ++qq) { if (qq == q) { mr = ir; mi = ii; } const float er = E[(qq * 64 + p) * 2], ei = E[(qq * 64 + p) * 2 + 1]; const float nr = pr * ir - pi * ii + er, ni = pr * ii + pi * ir + ei; ir = nr; ii = ni; }
        cr = ir; ci = ii;
        if (rnd == half) { bf16* xp = xng + row0 * 384 + 256 + 2 * p; xr = mr; xi = mi;
#pragma unroll
            for (int s = 0; s < 32; ++s) { *(unsigned*)(xp + (size_t)s * 384) = pk2(xr, xi); const float nr = ar * xr - ai * xi + v[s].x, ni = ar * xi + ai * xr + v[s].y; xr = nr; xi = ni; } }
        __syncthreads();
    }
}

__global__ void __launch_bounds__(NTHR, 2) mk_fwd(Args args) {
    extern __shared__ __attribute__((aligned(16))) unsigned char lds_[];
    LAS unsigned char* lds = (LAS unsigned char*)lds_;
    volatile LAS unsigned* MISC = (volatile LAS unsigned*)(lds + MISC_OFF);
    const int tid = threadIdx.x, lane = tid & 63, wid = __builtin_amdgcn_readfirstlane(tid >> 6);
    const int G = gridDim.x; const int bx = blockIdx.x; const int vcu = (G % 8 == 0) ? (bx % 8) * (G / 8) + bx / 8 : bx;
    unsigned char* const ws = args.ws;
    constexpr size_t EW = (size_t)NEXP * 1024 * 256;
    for (int u = tid; u < (LDS_BYTES - MISC_OFF) / 4; u += NTHR) ((LAS unsigned*)(lds + MISC_OFF))[u] = 0u;
    __syncthreads();
    const int lo = args.ph_lo, hi = args.ph_hi;
    XcdBarrier bar; bar.bar = (unsigned*)ws + CW_BAR + args.li * XCD_BAR_WORDS; bar.x = 0; bar.st = nullptr;
    if (hi - lo > 1) bar = xcd_barrier_post((unsigned*)ws + CW_BAR + args.li * XCD_BAR_WORDS, MISC + 8);
    const int gw = vcu * NWAVES + wid, NGW = G * NWAVES;
#ifndef PH_ONLY
#define PH_ONLY -1
#endif
#define IN(k) ((PH_ONLY < 0 || PH_ONLY == ((k) >= 12 && (k) <= 14 ? (k) - 8 : (k))) && lo <= (k) && (k) < hi)
#ifndef TS_K1
#define TS_K1 -1
#define TS_K2 -1
#endif
#define TS_STAMP(k) do { if (TS_K1 >= 0 && bx == 0 && tid == 0) ((unsigned long long*)(ws + WS_TS))[k] = __builtin_amdgcn_s_memrealtime(); } while (0)
#define SEAM(k) do { if ((k) + 1 < hi) xcd_barrier(bar); TS_STAMP((k) + 1); } while (0)
#define SCR ((LAS float*)(lds + wid * 16384))
    TS_STAMP(0);
    if (IN(0)) {
        const float* w_qkv = args.in[4]; const float* w_o = args.in[5]; const float* w_out = args.in[15];
        for (int it = gw; it < 3072; it += NGW) {
            if (it < 1536) { const int kb = it / 96, nb = it % 96; tr_item(w_qkv, 3072, kb * 64, nb * 32, (bf16*)(ws + WS_WQKV), 1024, nb * 32, nullptr, SCR, lane); }
            else if (it < 2048) { const int r = it - 1536, kb = r >> 5, nb = r & 31; tr_item(w_o, 1024, kb * 64, nb * 32, (bf16*)(ws + WS_WO), 1024, nb * 32, nullptr, SCR, lane); }
            else { const int r = it - 2048, kb = r >> 6, nb = r & 63, n0 = nb * 32, ag = n0 >> 10, cc = n0 & 1023; tr_item(w_out, 2048, kb * 64, n0, (bf16*)(ws + WS_WOUT), 1024, 256 * (cc >> 7) + 128 * ag + (cc & 127), nullptr, SCR, lane); }
        }
        moe_convert(args.in[20], args.in[21], args.in[22], args.in[2], (bf16*)(ws + WS_WGU), (bf16*)(ws + WS_WD), SCR, gw, NGW, lane);
        { float* rwt = (float*)(ws + WS_RWT); const float* norm_ffn = args.in[2];
          for (int o = bx * NTHR + tid; o < 2 * 36 * 1024; o += G * NTHR) { const int layer = o / (36 * 1024), r = o % (36 * 1024), col = r >> 10, k = r & 1023;
            const float gnk = norm_ffn[layer * D + k];
            const float w = col < 4 ? args.in[16][(size_t)layer * 4096 + k * 4 + col] : args.in[18][(size_t)layer * 32768 + ((size_t)((col - 4) >> 3) * 1024 + k) * 8 + ((col - 4) & 7)];
            rwt[layer * RW_LAYER + col * RW_PITCH + k] = w * gnk; } }
        __syncthreads();
        for (int gq = vcu; gq < 256; gq += G) ssm_mats(gq >> 2, gq & 3, args.in[7], args.in[8], args.in[9], args.in[10], args.in[11], args.in[12], args.in[13], args.in[14], ws + WS_SSM, (float*)(ws + WS_A16), (LAS float*)lds, tid);
        { const float* x = args.in[0]; const float* norm_mix = args.in[1]; bf16* XN = (bf16*)(ws + WS_XN);
          for (int m = gw; m < M; m += NGW) { const float4* xr = (const float4*)(x + (size_t)m * D); float4 v[4]; float ss = 0.f;
#pragma unroll
            for (int j = 0; j < 4; ++j) { v[j] = xr[lane + 64 * j]; ss += v[j].x * v[j].x + v[j].y * v[j].y + v[j].z * v[j].z + v[j].w * v[j].w; }
            ss = wave_sum(ss); const float s = rsqrtf(ss * (1.f / D) + RMS_EPS);
#pragma unroll
            for (int j = 0; j < 4; ++j) { const int c = 4 * (lane + 64 * j); const float4 gg = *(const float4*)(norm_mix + c); u32x2 w; w.x = pk2(v[j].x * s * gg.x, v[j].y * s * gg.y); w.y = pk2(v[j].z * s * gg.z, v[j].w * s * gg.w);
                *(u32x2*)(XN + (size_t)m * D + c) = w; } } }
        SEAM(0);
    }
    if (IN(1)) { PhQKV P{ws, (const char*)(ws + WS_XN), G, bx}; gm::gemm_phase(lds, P); SEAM(1); }
    if (IN(2)) {
        const int per = 1024 / G;
        for (int i = 0; i < per; ++i) { const int uid = vcu * per + i; const int bh = uid >> 5, qb = uid & 31;
            at::attn_unit<8>(bh >> 4, bh & 15, qb, (const bf16*)(ws + WS_Q), (const bf16*)(ws + WS_K), (const bf16*)(ws + WS_V), (bf16*)(ws + (args.pad ? WS_XN : WS_Q)), args.in[6], lds); }
        SEAM(2);
    }
    if (IN(3)) { PhWo P{ws, (const char*)(ws + WS_Q), args.in[0], args.out, G, bx}; gm::gemm_phase(lds, P); SEAM(3); }
#define MOE_LAYER(layer, pr) \
    if (IN(pr)) { router_phase((layer) ? (const bf16*)(ws + WS_XN) : (const bf16*)args.out, (const float*)(ws + WS_RWT) + (layer) * RW_LAYER, args.in[17] + (layer) * 4, args.in[19] + (layer) * 32, (unsigned*)ws + CW_CNT + (layer) * 32 * 64, \
                               (int*)(ws + WS_PDST), (float*)(ws + WS_PW), (float*)(ws + WS_PS), (float*)(ws + WS_SROW), lds, vcu, G); SEAM(pr); } \
    if (IN((pr) + 1) || IN((pr) + 2)) { \
        LAS int* cn = (LAS int*)(lds + AUX_OFF); LAS int* tb = cn + 32; \
        if (tid < 32) { const unsigned c = __hip_atomic_load((unsigned*)ws + CW_CNT + ((layer) * 32 + tid) * 64, RLX_AGENT); cn[tid] = c < (unsigned)CAP ? (int)c : CAP; } \
        __syncthreads(); \
        if (tid == 0) { int a = 0; for (int e = 0; e < 32; ++e) { tb[e] = a; a += (cn[e] + 255) >> 8; } tb[32] = a; } \
        __syncthreads(); \
        if (IN((pr) + 1)) { PhGateUp P{ws, (layer) ? (const char*)(ws + WS_XN) : (const char*)args.out, lds, G, vcu}; gm::gemm_phase(lds, P); SEAM((pr) + 1); } \
        if (IN((pr) + 2)) { PhDown P{ws, (const char*)(ws + WS_H), lds, G, vcu}; gm::gemm_phase(lds, P); SEAM((pr) + 2); } \
    }
    MOE_LAYER(0, 4)
    if (IN(7)) {
        moe_convert(args.in[20] + EW, args.in[21] + EW, args.in[22] + EW, args.in[2] + D, (bf16*)(ws + WS_WGU), (bf16*)(ws + WS_WD), SCR, gw, NGW, lane);
        combine_phase<false>((const bf16*)args.out, (const bf16*)(ws + WS_Y2), args.in[1] + D, (bf16*)args.out + (size_t)M * D, (bf16*)(ws + WS_XN), nullptr, vcu, G, wid, lane);
        SEAM(7); }
    if (IN(8)) { PhSloc P{ws, (const char*)(ws + WS_XN), G, vcu}; gm::gemm_phase(lds, P); if (10 < hi) xcd_barrier(bar); }
    if (IN(10)) {
        for (int idx = vcu; idx < 256; idx += G) scan_unit(idx >> 2, idx & 3, (const float*)(ws + WS_SLOC), (const float*)(ws + WS_A16), (bf16*)(ws + WS_XN), lds);
        asm volatile("s_waitcnt vmcnt(0)" ::: "memory"); __syncthreads();
        PhY P{ws, (const char*)(ws + WS_XN), G, vcu}; gm::gemm_phase(lds, P); SEAM(10); }
    if (IN(11)) { PhWout P{ws, (const char*)(ws + WS_G), args.out, G, bx}; gm::gemm_phase(lds, P); SEAM(11); }
    MOE_LAYER(1, 12)
#undef MOE_LAYER
    if (IN(15)) { combine_phase<true>((const bf16*)(ws + WS_XN), (const bf16*)(ws + WS_Y2), args.in[3], nullptr, nullptr, args.out, vcu, G, wid, lane);
#if TS_K1 >= 0
        { const unsigned long long* ts = (const unsigned long long*)(ws + WS_TS); const float dtus = (float)(ts[TS_K1 + 1] - ts[TS_K1]) * 1e-2f; const float e = exp2f(rintf(log2f(dtus) * 6.f) / 6.f) * 1e-2f;
          __syncthreads();
          for (int base = vcu * 16; base < M; base += G * 16) for (int i = tid; i < 16 * D; i += NTHR) args.out[(size_t)base * D + i] *= (1.f + e);
          if (TS_K2 >= 0 && bx == 0) { __syncthreads(); if (tid == 0) args.out[0] = exp2f(rintf(log2f((float)(ts[TS_K2 + 1] - ts[TS_K2]) * 1e-2f) * 6.f) / 6.f); } }
#endif
    }
    if (IN(16)) moe_convert(args.in[20] + EW, args.in[21] + EW, args.in[22] + EW, args.in[2] + D, (bf16*)(ws + WS_WGU), (bf16*)(ws + WS_WD), SCR, gw, NGW, lane);
#undef IN
#undef SEAM
#undef SCR
}

#ifndef FUSED
#define FUSED 1
#endif
#ifndef DUP_PH
#define DUP_PH -1
#endif
extern "C" void kernel_launch(void* const* d_in, const int* in_sizes, int n_in, void* d_out, int out_size, void* d_ws, size_t ws_size, hipStream_t stream) {
    static int grid = 0;
    if (grid == 0) {
        if (n_in != 23 || out_size != M * D || ws_size < WS_END) { fprintf(stderr, "kernel_launch: unexpected shapes (n_in %d out %d ws %zu)\n", n_in, out_size, ws_size); grid = -1; return; }
        int dev = 0, cus = 0;
        if (hipGetDevice(&dev) != hipSuccess || hipDeviceGetAttribute(&cus, hipDeviceAttributeMultiprocessorCount, dev) != hipSuccess) { grid = -1; return; }
        if (hipFuncSetAttribute((const void*)mk_fwd, hipFuncAttributeMaxDynamicSharedMemorySize, LDS_BYTES) != hipSuccess) { fprintf(stderr, "kernel_launch: hipFuncSetAttribute failed\n"); grid = -1; return; }
        (void)hipGetLastError();
        grid = cus;
        if (grid != 256) fprintf(stderr, "kernel_launch: %d CUs (built for 256)\n", grid);
    }
    if (grid < 0) return;
    unsigned char* ws = (unsigned char*)d_ws;
    (void)hipMemsetAsync(ws + WS_CTL, 0, CTL_ZERO_BYTES, stream);
    Args a{}; for (int i = 0; i < 23; ++i) a.in[i] = (const float*)d_in[i];
    a.out = (float*)d_out; a.ws = ws;
    int li = 0;
    auto run = [&](int lo, int hi) { a.ph_lo = lo; a.ph_hi = hi; a.li = li++; hipLaunchKernelGGL(mk_fwd, dim3(grid), dim3(NTHR), LDS_BYTES, stream, a); };
    if (FUSED) { run(0, N_PHASES); return; }
    for (int ph = 0; ph < N_PHASES; ++ph) { if (ph == 9) continue;
        if (DUP_PH == ph) { if (ph == 2) { a.pad = 1; run(2, 3); a.pad = 0; } else run(ph, ph + 1); }
        run(ph, ph + 1); }
}
```

```cpp
#include <hip/hip_runtime.h>
#include <cstdio>
#include <cstdint>

typedef unsigned short bf16;
constexpr int BATCH = 2, SEQ = 8192, D = 1024, M = BATCH * SEQ, NH = 16, HD = 64;
constexpr int NEXP = 32, EPG = 8, FE = 256;
constexpr int NREL = 257;
constexpr float RMS_EPS = 1e-6f;
constexpr float LOG2E = 1.4426950408889634f;
constexpr float C2 = 0.125f * LOG2E;

constexpr size_t MiB = 1u << 20;
constexpr size_t WS_CTL = 0;
constexpr size_t WS_XN = 86 * MiB;
constexpr size_t WS_BIG = 134 * MiB;
constexpr size_t WS_Q = WS_BIG, WS_K = WS_BIG + 32 * MiB, WS_V = WS_BIG + 64 * MiB;
constexpr size_t WS_Y2 = WS_BIG, WS_H = WS_BIG + 64 * MiB;
constexpr size_t WS_SLOC = WS_BIG, WS_G = WS_BIG + 32 * MiB;

__device__ __forceinline__ bf16 f2bf(float f) { unsigned u = __float_as_uint(f); return (bf16)((u + 0x7fffu + ((u >> 16) & 1u)) >> 16); }
__device__ __forceinline__ float bf2f(bf16 h) { return __uint_as_float(((unsigned)h) << 16); }
__device__ __forceinline__ float wave_sum(float v) {
#pragma unroll
    for (int o = 1; o < 64; o <<= 1) v += __shfl_xor(v, o);
    return v;
}
__device__ __forceinline__ float gelu_tanh(float x) { const float u = 0.7978845608028654f * (x + 0.044715f * x * x * x); return 0.5f * x * (1.f + tanhf(u)); }

__device__ __forceinline__ size_t xng_off(int t, int col) { const int b = t >> 13, tt = t & 8191, s = tt >> 4, j = tt & 15, g = col >> 4, c = col & 15; return ((size_t)(g * 1024 + b * 512 + s)) * 384 + j * 16 + c; }


#define LAS __attribute__((address_space(3)))
typedef short bf16x8 __attribute__((ext_vector_type(8)));
typedef short s16x4 __attribute__((ext_vector_type(4)));
typedef float f32x4 __attribute__((ext_vector_type(4)));
typedef float f32x16 __attribute__((ext_vector_type(16)));
typedef unsigned u32x4 __attribute__((ext_vector_type(4)));
typedef unsigned u32x2 __attribute__((ext_vector_type(2)));

constexpr int NWAVES = 8, NTHR = 512;
constexpr int CAP = 16384;
constexpr size_t CTL_ZERO_BYTES = 1 * MiB;
constexpr size_t WS_PDST = 1 * MiB, WS_PW = 3 * MiB, WS_PS = 5 * MiB, WS_SROW = 7 * MiB, WS_A16 = 7 * MiB + 65536;
constexpr size_t WS_TS = 7 * MiB + 131072;
constexpr size_t WS_RWT = 8 * MiB;
constexpr size_t WS_WQKV = 9 * MiB, WS_WO = 15 * MiB, WS_WOUT = 17 * MiB, WS_SSM = 21 * MiB;
constexpr size_t WS_WGU = 38 * MiB, WS_WD = 70 * MiB;
constexpr size_t WS_END = 230 * MiB;
constexpr int RW_PITCH = 1028, RW_LAYER = 36 * RW_PITCH;
constexpr int SSM_G_BYTES = 262144, SSM_A2_OFF = 65536;
constexpr int CW_BAR = 4096;
constexpr int CW_CNT = 65536;
constexpr int LDS_BYTES = 160 * 1024, MISC_OFF = LDS_BYTES - 512, AUX_OFF = 128 * 1024, RSCR_OFF = 36 * 1028 * 4;
constexpr int N_PHASES = 16;

__device__ __forceinline__ int lane_now() { int l; asm volatile("v_mbcnt_lo_u32_b32 %0, -1, 0\n\tv_mbcnt_hi_u32_b32 %0, -1, %0" : "=v"(l)); return l; }
__device__ __forceinline__ unsigned cvt_pk_bf16(float lo, float hi) { unsigned r; asm volatile("v_cvt_pk_bf16_f32 %0, %1, %2" : "=v"(r) : "v"(lo), "v"(hi)); return r; }
typedef float f32x2_t __attribute__((ext_vector_type(2))); typedef __bf16 bf16x2_t __attribute__((ext_vector_type(2)));
__device__ __forceinline__ unsigned cvtpk_s(float lo, float hi) { f32x2_t v = {lo, hi}; bf16x2_t b = __builtin_convertvector(v, bf16x2_t); return __builtin_bit_cast(unsigned, b); }
__device__ __forceinline__ unsigned pk2(float lo, float hi) { return (unsigned)f2bf(lo) | ((unsigned)f2bf(hi) << 16); }
#define LDS_WAIT() asm volatile("s_waitcnt lgkmcnt(0)" ::: "memory")
#define VM_WAIT() asm volatile("s_waitcnt vmcnt(0)" ::: "memory")
#define RLX_AGENT __ATOMIC_RELAXED, __HIP_MEMORY_SCOPE_AGENT

#define XB_TMO      128
#define XB_XCNT(j)  (256  + 64 * (j))
#define XB_XSUB(j)  (1280 + 64 * (j))
#define XB_XGEN(j)  (2304 + 64 * (j))
#define XB_TOP      3328
#define XB_TOPGEN   3392
#define XCD_BAR_WORDS 3456
#define XB_SPIN_CAP (1u << 18)
__device__ __forceinline__ unsigned xb_ld(unsigned* p)              { return __hip_atomic_load(p, __ATOMIC_RELAXED, __HIP_MEMORY_SCOPE_AGENT); }
__device__ __forceinline__ unsigned xb_add(unsigned* p, unsigned v) { return __hip_atomic_fetch_add(p, v, __ATOMIC_RELAXED, __HIP_MEMORY_SCOPE_AGENT); }
__device__ __forceinline__ unsigned xb_xcc_id() { return (unsigned)__builtin_amdgcn_s_getreg((3 << 11) | 20) & 0xFu; }
#define XB_SPIN(cond, bar) do { unsigned _sp = 0; while (cond) { __builtin_amdgcn_s_sleep(1); \
    if ((++_sp & 255u) == 0u) { if (xb_ld(&(bar)[XB_TMO])) break; if (_sp > XB_SPIN_CAP) { atomicAdd(&(bar)[XB_TMO], 1u); break; } } } } while (0)
struct XcdBarrier { unsigned* bar; unsigned x; volatile LAS unsigned* st; };
__device__ __forceinline__ XcdBarrier xcd_barrier_post(unsigned* bar, volatile LAS unsigned* st, int wid) {
    XcdBarrier b; b.bar = bar; b.x = xb_xcc_id(); b.st = st;
    if (wid == 0 && lane_now() == 0) (void)xb_add(&bar[XB_XCNT(b.x)], 1u);
    return b;
}
__device__ __forceinline__ void xcd_barrier_complete(unsigned* bar, unsigned x, unsigned& nloc, unsigned& nx) {
    const unsigned G = gridDim.x * gridDim.y * gridDim.z;
    unsigned sum, cnt, mine, sp = 0u;
    for (;;) {
        sum = 0u; cnt = 0u; mine = 0u;
#pragma unroll
        for (unsigned j = 0; j < 16; ++j) { const unsigned c = xb_ld(&bar[XB_XCNT(j)]); sum += c; cnt += (c > 0u) ? 1u : 0u; mine = (j == x) ? c : mine; }
        if (sum == G) break;
        __builtin_amdgcn_s_sleep(1);
        if ((++sp & 255u) == 0u) { if (xb_ld(&bar[XB_TMO])) break; if (sp > XB_SPIN_CAP) { atomicAdd(&bar[XB_TMO], 1u); break; } }
    }
    nloc = mine > 0u ? mine : 1u; nx = cnt > 0u ? cnt : 1u;
}
__device__ __forceinline__ void xcd_barrier(const XcdBarrier& b, int wid) {
    asm volatile("s_waitcnt vmcnt(0)" ::: "memory");
    __syncthreads();
    if (wid == 0 && lane_now() == 0) {
        unsigned* bar = b.bar;
        __builtin_amdgcn_s_waitcnt(0);
        unsigned nloc = b.st[0], nx = b.st[1];
        if (nloc == 0u) { xcd_barrier_complete(bar, b.x, nloc, nx); b.st[0] = nloc; b.st[1] = nx; }
        const unsigned old = xb_add(&bar[XB_XSUB(b.x)], 1u);
        const unsigned gen = old / nloc;
        if (old + 1u == (gen + 1u) * nloc) {
            __builtin_amdgcn_fence(__ATOMIC_RELEASE, "agent");
            asm volatile("s_waitcnt vmcnt(0)" ::: "memory");
            const unsigned og = xb_add(&bar[XB_TOP], 1u);
            const unsigned tg = og / nx;
            if (og + 1u == (tg + 1u) * nx) xb_add(&bar[XB_TOPGEN], 1u);
            else XB_SPIN(xb_ld(&bar[XB_TOPGEN]) == tg, bar);
            __builtin_amdgcn_fence(__ATOMIC_ACQUIRE, "agent");
            xb_add(&bar[XB_XGEN(b.x)], 1u);
            asm volatile("s_waitcnt vmcnt(0)" ::: "memory");
        } else {
            XB_SPIN(xb_ld(&bar[XB_XGEN(b.x)]) == gen, bar);
            __builtin_amdgcn_fence(__ATOMIC_ACQUIRE, "agent");
            asm volatile("s_waitcnt vmcnt(0)" ::: "memory");
        }
    }
    __syncthreads();
}

namespace gm {
constexpr int HTB = 16384;
__device__ __forceinline__ int lds_byte(int r, int c) { const int st = (r >> 4) * 2 + (c >> 5), rr = r & 15, cc = c & 31, ob = rr * 64 + cc * 2; return st * 1024 + (ob ^ (((ob >> 9) & 1) << 5)); }
__device__ __forceinline__ void stage_rc(int b, int& R, int& C) { const int st = b / 1024, sb = b % 1024, swz = sb ^ (((sb >> 9) & 1) << 5); R = (st >> 1) * 16 + swz / 64; C = (st & 1) * 32 + (swz % 64) / 2; }
__device__ __forceinline__ int perm32(int rho) { const int n = rho >> 4, i = rho & 15; return 8 * (i >> 2) + 4 * n + (i & 3); }
struct Unit { int pm, pn, e, gt, cnt; };
__device__ __forceinline__ bool static_unit(int i, int G, int c, int nM, int nN, Unit& u) {
    const int nwg = nM * nN; const long L = (long)i * G + c; if (L >= nwg) return false;
    int wgid = (int)L; { const int q = nwg / 8, r = nwg % 8, xcd = wgid % 8, off = wgid / 8; wgid = (xcd < r ? xcd * (q + 1) : r * (q + 1) + (xcd - r) * q) + off; }
    const int nig = 8 * nN, gid = wgid / nig, fm = gid * 8, gsz = (nM - fm) < 8 ? (nM - fm) : 8;
    u.pm = fm + ((wgid % nig) % gsz); u.pn = (wgid % nig) / gsz; u.e = 0; u.gt = 0; u.cnt = 0; return true;
}
template <class P> __device__ __forceinline__ void gemm_phase(LAS unsigned char* lds, const P& ph, int wid) {
    const int lane = lane_now(), tid = wid * 64 + lane, wr = wid >> 2, wc = wid & 3, fr = lane & 15, fq = lane >> 4;
    constexpr int nt = P::K / 64;
    static_assert(nt >= 2 && (nt % 2) == 0, "K must be a multiple of 128");
    unsigned voffA[2], voffB[2];
#pragma unroll
    for (int i = 0; i < 2; ++i) { int R, C; stage_rc(tid * 16 + i * 8192, R, C); const int Rb = (R & ~31) + perm32(R & 31); voffB[i] = (unsigned)(Rb * P::LDB + C) * 2u; voffA[i] = (unsigned)(R * P::LDA + C) * 2u; }
    const unsigned ldsw = (unsigned)wid * 1024u;
    const int aoff = lds_byte(wr * 64 + fr, fq * 8), boff = lds_byte(wc * 32 + fr, fq * 8);
    constexpr int hB = P::HSTEPB, hA = 128 * P::LDA * 2;
#define G_SA(b, h) (((b) * 2 + (h)) * gm::HTB)
#define G_SB(b, h) ((4 + (b) * 2 + (h)) * gm::HTB)
#define G_GLDS(src, bufoff, i) __builtin_amdgcn_global_load_lds((const unsigned*)(src), (LAS unsigned*)(lds + (bufoff) + ldsw + (i) * 8192), 16, 0, 0)
#define G_STA(bufoff, ptr, kb, offs, h) do { if constexpr (P::GATHER) { _Pragma("unroll") for (int _i = 0; _i < 2; ++_i) G_GLDS(Ab + (kb) + (offs)[h][_i], bufoff, _i); } \
        else { _Pragma("unroll") for (int _i = 0; _i < 2; ++_i) G_GLDS((ptr) + (h) * hA + voffA[_i], bufoff, _i); } } while (0)
#define G_STB(bufoff, ptr) do { _Pragma("unroll") for (int _i = 0; _i < 2; ++_i) G_GLDS((ptr) + voffB[_i], bufoff, _i); } while (0)
#define G_LDA(dst, b, h) do { _Pragma("unroll") for (int m = 0; m < 4; ++m) _Pragma("unroll") for (int k = 0; k < 2; ++k) dst[m][k] = *(const LAS bf16x8*)(lds + G_SA(b, h) + aoff + m * 2048 + k * 1024); } while (0)
#define G_LDB(dst, b, h) do { _Pragma("unroll") for (int n = 0; n < 2; ++n) _Pragma("unroll") for (int k = 0; k < 2; ++k) dst[n][k] = *(const LAS bf16x8*)(lds + G_SB(b, h) + boff + n * 2048 + k * 1024); } while (0)
#define G_MMA(ai, bj, At, Bt) do { __builtin_amdgcn_s_setprio(1); _Pragma("unroll") for (int m = 0; m < 4; ++m) _Pragma("unroll") for (int n = 0; n < 2; ++n) _Pragma("unroll") for (int k = 0; k < 2; ++k) \
        acc[ai][bj][m][n] = __builtin_amdgcn_mfma_f32_16x16x32_bf16(Bt[n][k], At[m][k], acc[ai][bj][m][n], 0, 0, 0); __builtin_amdgcn_s_setprio(0); } while (0)
#define G_WAIT_V(n) asm volatile("s_waitcnt vmcnt(" #n ")" ::: "memory")
#define G_WAIT_L(n) asm volatile("s_waitcnt lgkmcnt(" #n ")" ::: "memory")
#define G_BAR __builtin_amdgcn_s_barrier()
#define G_SCHED __builtin_amdgcn_sched_barrier(0)
    Unit cur, nxt; int ui = 0;
    if (!ph.next(0, cur)) return;
    f32x4 acc[2][2][4][2];
#pragma unroll
    for (int a = 0; a < 2; ++a)
#pragma unroll
        for (int b = 0; b < 2; ++b)
#pragma unroll
            for (int m = 0; m < 4; ++m)
#pragma unroll
                for (int n = 0; n < 2; ++n) acc[a][b][m][n] = (f32x4){0.f, 0.f, 0.f, 0.f};
    bf16x8 At[4][2], B0[2][2], B1[2][2];
    unsigned co[2][2] = {{0u, 0u}, {0u, 0u}};
    const char* Ab = ph.Abase;
    const char* cA = Ab; const char* cB = ph.b_tile(cur);
    if constexpr (P::GATHER) { ph.a_offs(cur, tid, co); asm volatile("s_waitcnt vmcnt(0)" ::: "memory"); } else cA = ph.a_tile(cur);
    G_STB(G_SB(0, 0), cB); G_STB(G_SB(0, 1), cB + hB); G_STA(G_SA(0, 0), cA, 0, co, 0); G_STA(G_SA(0, 1), cA, 0, co, 1);
    if (wr == 1) G_BAR;
    G_WAIT_V(2); G_BAR;
    G_STB(G_SB(1, 0), cB + 128); G_STA(G_SA(1, 0), cA + 128, 128, co, 0); G_STB(G_SB(1, 1), cB + hB + 128);
    G_WAIT_V(6); G_BAR;
    for (;;) {
        const bool has_next = ph.next(ui + 1, nxt);
        const char* nA = cA; const char* nB = cB;
        if (has_next) { nB = ph.b_tile(nxt); if constexpr (!P::GATHER) nA = ph.a_tile(nxt); }
        for (int t = 0; t < nt; t += 2) {
            const bool last = (t == nt - 2);
            const int kb1 = (t + 1) * 128, kb2 = last ? 0 : (t + 2) * 128, kb3 = kb2 + 128;
            const char* a1 = cA + kb1; const char* a2 = last ? nA : cA + kb2; const char* a3 = a2 + 128;
            const char* b2 = last ? nB : cB + (t + 2) * 128; const char* b3 = b2 + 128;
            G_LDB(B0, 0, 0); G_LDB(B1, 0, 1); G_SCHED; G_LDA(At, 0, 0); G_STA(G_SA(1, 1), a1, kb1, co, 1);
            G_WAIT_V(8); G_WAIT_L(0); G_BAR; G_MMA(0, 0, At, B0); G_MMA(0, 1, At, B1); G_BAR; G_SCHED;
            if constexpr (P::GATHER) { if (last && has_next) ph.a_offs(nxt, tid, co); }
            G_LDA(At, 0, 1); G_STB(G_SB(0, 0), b2); G_STB(G_SB(0, 1), b2 + hB); G_STA(G_SA(0, 0), a2, kb2, co, 0);
            G_WAIT_V(8); G_WAIT_L(0); G_BAR; G_MMA(1, 0, At, B0); G_MMA(1, 1, At, B1); G_BAR; G_SCHED;
            G_LDB(B0, 1, 0); G_LDB(B1, 1, 1); G_SCHED; G_LDA(At, 1, 0); G_STA(G_SA(0, 1), a2, kb2, co, 1);
            G_WAIT_V(8); G_WAIT_L(0); G_BAR; G_MMA(0, 0, At, B0); G_MMA(0, 1, At, B1); G_BAR; G_SCHED;
            G_LDA(At, 1, 1); G_STB(G_SB(1, 0), b3); G_STB(G_SB(1, 1), b3 + hB); G_STA(G_SA(1, 0), a3, kb3, co, 0);
            G_WAIT_V(8); G_WAIT_L(0); G_BAR; G_MMA(1, 0, At, B0); G_MMA(1, 1, At, B1); G_BAR; G_SCHED;
        }
        if (wr == 0) G_BAR;
        ph.epi(acc, cur, wr, wc, fr, fq);
        if (!has_next) break;
#pragma unroll
        for (int a = 0; a < 2; ++a)
#pragma unroll
            for (int b = 0; b < 2; ++b)
#pragma unroll
                for (int m = 0; m < 4; ++m)
#pragma unroll
                    for (int n = 0; n < 2; ++n) acc[a][b][m][n] = (f32x4){0.f, 0.f, 0.f, 0.f};
        cur = nxt; cA = nA; cB = nB; ++ui;
        if (wr == 1) G_BAR;
    }
    G_WAIT_V(0);
    G_BAR;
}
}

using gm::Unit;
#define EPI_ARGS const f32x4 (&acc)[2][2][4][2], const Unit& u, int wr, int wc, int fr_in, int fq_in
#define EPI_OPAQUE int fr = fr_in, fq = fq_in; asm volatile("" : "+v"(fr), "+v"(fq));
#define NO_GATHER __device__ __forceinline__ void a_offs(const Unit&, int, unsigned (&)[2][2]) const {}
#define EPI_FENCE() asm volatile("" ::: "memory")
__device__ __forceinline__ u32x4 pack8(const f32x4& v0, const f32x4& v1) { u32x4 w; w.x = cvt_pk_bf16(v0[0], v0[1]); w.y = cvt_pk_bf16(v0[2], v0[3]); w.z = cvt_pk_bf16(v1[0], v1[1]); w.w = cvt_pk_bf16(v1[2], v1[3]); return w; }
__device__ __forceinline__ float fast_sigmoid(float v) { return __builtin_amdgcn_rcpf(1.f + __builtin_amdgcn_exp2f(-LOG2E * v)); }
__device__ __forceinline__ float fast_gelu(float v) { const float u2 = 1.5957691216057308f * (v + 0.044715f * v * v * v); return v * fast_sigmoid(u2); }

struct PhQKV {
    static constexpr bool GATHER = false; static constexpr int LDA = 1024, K = 1024, LDB = 1024, HSTEPB = 128 * 1024 * 2;
    unsigned char* ws; const char* Abase; int G, c;
    __device__ __forceinline__ bool next(int i, Unit& u) const { return gm::static_unit(i, G, c, M / 256, 12, u); }
    NO_GATHER __device__ __forceinline__ const char* a_tile(const Unit& u) const { return Abase + (size_t)(u.pm * 256) * 1024 * 2; }
    __device__ __forceinline__ const char* b_tile(const Unit& u) const { return (const char*)(ws + WS_WQKV) + (size_t)u.pn * 256 * 1024 * 2; }
    __device__ __forceinline__ void epi(EPI_ARGS) const { EPI_OPAQUE
        const int row0 = u.pm * 256 + wr * 64 + fr; const int t = u.pn >> 2; const int colt = (u.pn & 3) * 256;
        bf16* base = (bf16*)(ws + WS_Q) + (size_t)t * (16u * 1024u * 1024u); const float sc = (t == 0) ? C2 : 1.f;
        const int col0 = colt + wc * 32 + 8 * fq;
#pragma unroll
        for (int ai = 0; ai < 2; ++ai)
#pragma unroll
            for (int m = 0; m < 4; ++m) { bf16* rowp = base + (size_t)(row0 + ai * 128 + m * 16) * 1024 + col0;
#pragma unroll
                for (int bj = 0; bj < 2; ++bj) *(u32x4*)(rowp + bj * 128) = pack8(acc[ai][bj][m][0] * sc, acc[ai][bj][m][1] * sc); }
    }
};
struct PhWo {
    static constexpr bool GATHER = false; static constexpr int LDA = 1024, K = 1024, LDB = 1024, HSTEPB = 128 * 1024 * 2;
    unsigned char* ws; const char* Abase; const float* resid; float* out; int G, c;
    __device__ __forceinline__ bool next(int i, Unit& u) const { return gm::static_unit(i, G, c, M / 256, 4, u); }
    NO_GATHER __device__ __forceinline__ const char* a_tile(const Unit& u) const { return Abase + (size_t)(u.pm * 256) * 1024 * 2; }
    __device__ __forceinline__ const char* b_tile(const Unit& u) const { return (const char*)(ws + WS_WO) + (size_t)u.pn * 256 * 1024 * 2; }
    __device__ __forceinline__ void epi(EPI_ARGS) const { EPI_OPAQUE
        const size_t off0 = (size_t)(u.pm * 256 + wr * 64 + fr) * 1024 + u.pn * 256 + wc * 32 + 8 * fq; bf16* hb = (bf16*)out;
#pragma unroll
        for (int ai = 0; ai < 2; ++ai) { f32x4 r[4][2][2];
#pragma unroll
            for (int m = 0; m < 4; ++m)
#pragma unroll
                for (int bj = 0; bj < 2; ++bj) { const float* p = resid + off0 + (size_t)(ai * 128 + m * 16) * 1024 + bj * 128; r[m][bj][0] = *(const f32x4*)p; r[m][bj][1] = *(const f32x4*)(p + 4); }
            EPI_FENCE();
#pragma unroll
            for (int m = 0; m < 4; ++m)
#pragma unroll
                for (int bj = 0; bj < 2; ++bj) { const size_t off = off0 + (size_t)(ai * 128 + m * 16) * 1024 + bj * 128; const f32x4 v0 = acc[ai][bj][m][0] + r[m][bj][0], v1 = acc[ai][bj][m][1] + r[m][bj][1];
                    *(u32x4*)(hb + off) = pack8(v0, v1); }
            EPI_FENCE(); }
    }
};
struct PhWout {
    static constexpr bool GATHER = false; static constexpr int LDA = 1024, K = 1024, LDB = 1024, HSTEPB = 128 * 1024 * 2;
    unsigned char* ws; const char* Abase; float* out; int G, c;
    __device__ __forceinline__ bool next(int i, Unit& u) const { return gm::static_unit(i, G, c, M / 256, 8, u); }
    NO_GATHER __device__ __forceinline__ const char* a_tile(const Unit& u) const { return Abase + (size_t)(u.pm * 256) * 1024 * 2; }
    __device__ __forceinline__ const char* b_tile(const Unit& u) const { return (const char*)(ws + WS_WOUT) + (size_t)u.pn * 256 * 1024 * 2; }
    __device__ __forceinline__ void epi(EPI_ARGS) const { EPI_OPAQUE
        const size_t off0 = (size_t)(u.pm * 256 + wr * 64 + fr) * 1024 + u.pn * 128 + wc * 32 + 8 * fq; bf16* hb = (bf16*)(ws + WS_XN); const bf16* rs = (const bf16*)out + (size_t)M * D;
        u32x4 r[2][4];
#pragma unroll
        for (int ai = 0; ai < 2; ++ai)
#pragma unroll
            for (int m = 0; m < 4; ++m) r[ai][m] = *(const u32x4*)(rs + off0 + (size_t)(ai * 128 + m * 16) * 1024);
        EPI_FENCE();
#pragma unroll
        for (int ai = 0; ai < 2; ++ai)
#pragma unroll
            for (int m = 0; m < 4; ++m) { const size_t off = off0 + (size_t)(ai * 128 + m * 16) * 1024; f32x4 v0, v1;
#pragma unroll
                for (int j = 0; j < 4; ++j) { const unsigned w0 = r[ai][m][j >> 1], w1 = r[ai][m][2 + (j >> 1)];
                    const float r0 = __uint_as_float((j & 1) ? (w0 & 0xffff0000u) : (w0 << 16)), r1 = __uint_as_float((j & 1) ? (w1 & 0xffff0000u) : (w1 << 16));
                    v0[j] = r0 + acc[ai][0][m][0][j] * fast_sigmoid(acc[ai][1][m][0][j]); v1[j] = r1 + acc[ai][0][m][1][j] * fast_sigmoid(acc[ai][1][m][1][j]); }
                *(u32x4*)(hb + off) = pack8(v0, v1); }
        EPI_FENCE();
    }
};
constexpr int MT_NN = 65, MT_NS = 66, MT_NLIST = 128, MT_SLIST = 384, SMALL_ROWS = 128;
__device__ __forceinline__ void moe_decode(LAS unsigned char* lds, int code, Unit& u) { const LAS int* cn = (const LAS int*)(lds + AUX_OFF); u.e = code >> 8; u.pm = code & 255; u.gt = cn[32 + u.e] + u.pm; u.cnt = cn[u.e]; }
__device__ __forceinline__ void moe_tables(LAS unsigned char* lds, const unsigned* cntg, int tid) {
    LAS int* cn = (LAS int*)(lds + AUX_OFF); LAS int* tb = cn + 32;
    if (tid < 64) {
        const int e = tid & 31; const unsigned cu = __hip_atomic_load(cntg + e * 64, RLX_AGENT); const int c = cu < (unsigned)CAP ? (int)cu : CAP;
        const int n = (c + 255) >> 8; const int lastrows = c - 256 * (n - 1); const int small = (n > 0 && lastrows <= SMALL_ROWS) ? 1 : 0; const int nnorm = n - small;
        int pt = n, pn_ = nnorm, ps_ = small;
#pragma unroll
        for (int o = 1; o < 32; o <<= 1) { const int a = __shfl_up(pt, o, 32), b = __shfl_up(pn_, o, 32), d = __shfl_up(ps_, o, 32); if (e >= o) { pt += a; pn_ += b; ps_ += d; } }
        if (tid < 32) { cn[e] = c; tb[e] = pt - n;
            for (int pm = 0; pm < nnorm; ++pm) cn[MT_NLIST + (pn_ - nnorm) + pm] = (e << 8) | pm;
            if (small) cn[MT_SLIST + ps_ - 1] = (e << 8) | (n - 1);
            if (e == 31) { tb[32] = pt; cn[MT_NN] = pn_; cn[MT_NS] = ps_; } }
    }
    __syncthreads();
}
template <bool GU> __device__ __forceinline__ void tail_job(unsigned char* ws, const bf16* __restrict__ Xbase, const Unit& u, int ns, int wid) {
    const int lane = lane_now(), fr = lane & 15, fq = lane >> 4, w = wid;
    constexpr int K = GU ? 1024 : 256, NG = GU ? 2 : 4;
    const int slot0 = u.pm * 256, rows = u.cnt - slot0;
    if (16 * w >= rows) return;
    const int* pdst = (const int*)(ws + WS_PDST) + u.e * CAP + slot0;
    int r = 16 * w + fr; const bool valid = r < rows; r = valid ? r : rows - 1;
    const int dst = pdst[r];
    const bf16* xp = (GU ? Xbase + (size_t)(dst >> 1) * 1024 : Xbase + ((size_t)u.gt * 256 + r) * 256) + 8 * fq;
    const bf16* wp[NG];
#pragma unroll
    for (int n = 0; n < NG; ++n) wp[n] = GU ? (const bf16*)(ws + WS_WGU) + ((size_t)u.e * 512 + 256 * (ns >> 3) + 128 * n + 16 * (ns & 7) + fr) * 1024 + 8 * fq
                                             : (const bf16*)(ws + WS_WD) + ((size_t)u.e * 1024 + 64 * ns + 16 * n + fr) * 256 + 8 * fq;
    f32x4 acc[NG];
#pragma unroll
    for (int n = 0; n < NG; ++n) acc[n] = (f32x4){0.f, 0.f, 0.f, 0.f};
#pragma unroll 8
    for (int ks = 0; ks < K / 32; ++ks) { const bf16x8 xf = *(const bf16x8*)(xp + 32 * ks); bf16x8 wf[NG];
#pragma unroll
        for (int n = 0; n < NG; ++n) wf[n] = *(const bf16x8*)(wp[n] + 32 * ks);
#pragma unroll
        for (int n = 0; n < NG; ++n) acc[n] = __builtin_amdgcn_mfma_f32_16x16x32_bf16(wf[n], xf, acc[n], 0, 0, 0); }
    if (valid) {
        if (GU) { const float sc = ((const float*)(ws + WS_PS))[u.e * CAP + slot0 + r]; float v[4];
#pragma unroll
            for (int j = 0; j < 4; ++j) { const float gg = acc[0][j] * sc, uu = acc[NG - 1][j] * sc; v[j] = gg * fast_sigmoid(gg) * uu; }
            u32x2 o; o.x = cvt_pk_bf16(v[0], v[1]); o.y = cvt_pk_bf16(v[2], v[3]);
            *(u32x2*)((bf16*)(ws + WS_H) + ((size_t)u.gt * 256 + r) * 256 + 16 * ns + 4 * fq) = o; }
        else { const float wt = ((const float*)(ws + WS_PW))[u.e * CAP + slot0 + r];
#pragma unroll
            for (int n = 0; n < NG; ++n) { u32x2 o; o.x = cvt_pk_bf16(acc[n][0] * wt, acc[n][1] * wt); o.y = cvt_pk_bf16(acc[n][2] * wt, acc[n][3] * wt);
                *(u32x2*)((bf16*)(ws + WS_Y2) + (size_t)dst * 1024 + 64 * ns + 16 * n + 4 * fq) = o; } } }
}
struct PhGateUp {
    static constexpr bool GATHER = true; static constexpr int LDA = 1024, K = 1024, LDB = 1024, HSTEPB = 128 * 1024 * 2;
    unsigned char* ws; const char* Abase; LAS unsigned char* lds; int G, c, nn;
    __device__ __forceinline__ bool next(int i, Unit& u) const { const int idx = i * G + c; if (idx >= 2 * nn) return false; u.pn = idx & 1; moe_decode(lds, ((const LAS int*)(lds + AUX_OFF))[MT_NLIST + (idx >> 1)], u); return true; }
    __device__ __forceinline__ void a_offs(const Unit& u, int tid, unsigned (&o)[2][2]) const { const int* pdst = (const int*)(ws + WS_PDST);
#pragma unroll
        for (int i = 0; i < 2; ++i) { int R, C; gm::stage_rc(tid * 16 + i * 8192, R, C);
#pragma unroll
            for (int h = 0; h < 2; ++h) { int slot = u.pm * 256 + 128 * h + R; slot = slot < u.cnt ? slot : u.cnt - 1; const int tok = pdst[u.e * CAP + slot] >> 1; o[h][i] = (unsigned)(tok * 1024 + C) * 2u; } }
    }
    __device__ __forceinline__ const char* a_tile(const Unit&) const { return Abase; }
    __device__ __forceinline__ const char* b_tile(const Unit& u) const { return (const char*)(ws + WS_WGU) + ((size_t)u.e * 512 + u.pn * 256) * 1024 * 2; }
    __device__ __forceinline__ void epi(EPI_ARGS) const { EPI_OPAQUE
        const int r0 = wr * 64 + fr, col0 = u.pn * 128 + wc * 32 + 8 * fq; const float* ps = (const float*)(ws + WS_PS) + u.e * CAP; bf16* H = (bf16*)(ws + WS_H);
        float sv[2][4];
#pragma unroll
        for (int ai = 0; ai < 2; ++ai)
#pragma unroll
            for (int m = 0; m < 4; ++m) { int slot = u.pm * 256 + r0 + ai * 128 + m * 16; slot = slot < u.cnt ? slot : u.cnt - 1; sv[ai][m] = ps[slot]; }
        EPI_FENCE();
#pragma unroll
        for (int ai = 0; ai < 2; ++ai)
#pragma unroll
            for (int m = 0; m < 4; ++m) { const int r = r0 + ai * 128 + m * 16; const float s = sv[ai][m];
                f32x4 v0, v1;
#pragma unroll
                for (int j = 0; j < 4; ++j) { const float g0 = acc[ai][0][m][0][j] * s, u0 = acc[ai][1][m][0][j] * s, g1 = acc[ai][0][m][1][j] * s, u1 = acc[ai][1][m][1][j] * s;
                    v0[j] = g0 * fast_sigmoid(g0) * u0; v1[j] = g1 * fast_sigmoid(g1) * u1; }
                *(u32x4*)(H + ((size_t)u.gt * 256 + r) * 256 + col0) = pack8(v0, v1); }
        EPI_FENCE();
    }
};
struct PhDown {
    static constexpr bool GATHER = false; static constexpr int LDA = 256, K = 256, LDB = 256, HSTEPB = 128 * 256 * 2;
    unsigned char* ws; const char* Abase; LAS unsigned char* lds; int G, c, nn;
    __device__ __forceinline__ bool next(int i, Unit& u) const { const int idx = i * G + c; if (idx >= 4 * nn) return false; u.pn = idx & 3; moe_decode(lds, ((const LAS int*)(lds + AUX_OFF))[MT_NLIST + (idx >> 2)], u); return true; }
    NO_GATHER __device__ __forceinline__ const char* a_tile(const Unit& u) const { return Abase + (size_t)(u.gt * 256) * 256 * 2; }
    __device__ __forceinline__ const char* b_tile(const Unit& u) const { return (const char*)(ws + WS_WD) + ((size_t)u.e * 1024 + u.pn * 256) * 256 * 2; }
    __device__ __forceinline__ void epi(EPI_ARGS) const { EPI_OPAQUE
        const int r0 = u.pm * 256 + wr * 64 + fr, col0 = u.pn * 256 + wc * 32 + 8 * fq; const int* pdst = (const int*)(ws + WS_PDST) + u.e * CAP; const float* pw = (const float*)(ws + WS_PW) + u.e * CAP; bf16* Y2 = (bf16*)(ws + WS_Y2);
        int slot = r0 < u.cnt ? r0 : u.cnt - 1; int dn = pdst[slot]; float wn = pw[slot];
#pragma unroll
        for (int g = 0; g < 8; ++g) { const int ai = g >> 2, m = g & 3; const int dcur = dn; const float wcur = wn;
            if (g < 7) { int s2 = r0 + ((g + 1) >> 2) * 128 + ((g + 1) & 3) * 16; s2 = s2 < u.cnt ? s2 : u.cnt - 1; dn = pdst[s2]; wn = pw[s2]; }
            if (r0 + ai * 128 + m * 16 < u.cnt) { bf16* yp = Y2 + (size_t)dcur * 1024 + col0;
#pragma unroll
                for (int bj = 0; bj < 2; ++bj) *(u32x4*)(yp + bj * 128) = pack8(acc[ai][bj][m][0] * wcur, acc[ai][bj][m][1] * wcur); }
            EPI_FENCE(); }
    }
};
struct PhSloc {
    static constexpr bool GATHER = false; static constexpr int LDA = 384, K = 256, LDB = 256, HSTEPB = 0;
    unsigned char* ws; const char* Abase; int G, c;
    __device__ __forceinline__ bool next(int i, Unit& u) const { const int idx = i * G + c; if (idx >= 256) return false; u.e = idx >> 2; u.pm = idx & 3; u.pn = 0; u.gt = 0; u.cnt = 0; return true; }
    NO_GATHER __device__ __forceinline__ const char* a_tile(const Unit& u) const { return Abase + (size_t)(u.e * 1024 + u.pm * 256) * 384 * 2; }
    __device__ __forceinline__ const char* b_tile(const Unit& u) const { return (const char*)(ws + WS_SSM) + (size_t)u.e * SSM_G_BYTES; }
    __device__ __forceinline__ void epi(EPI_ARGS) const { EPI_OPAQUE
        const int r0 = u.e * 1024 + u.pm * 256 + wr * 64 + fr, col0 = wc * 32 + 8 * fq; float* Sloc = (float*)(ws + WS_SLOC);
#pragma unroll
        for (int ai = 0; ai < 2; ++ai)
#pragma unroll
            for (int m = 0; m < 4; ++m) { float* p = Sloc + (size_t)(r0 + ai * 128 + m * 16) * 128 + col0; *(f32x4*)p = acc[ai][0][m][0]; *(f32x4*)(p + 4) = acc[ai][0][m][1]; }
    }
};
struct PhY {
    static constexpr bool GATHER = false; static constexpr int LDA = 384, K = 384, LDB = 384, HSTEPB = 128 * 384 * 2;
    unsigned char* ws; const char* Abase; int G, c;
    __device__ __forceinline__ bool next(int i, Unit& u) const { const int idx = i * G + c; if (idx >= 256) return false; u.e = idx >> 2; u.pm = idx & 3; u.pn = 0; u.gt = 0; u.cnt = 0; return true; }
    NO_GATHER __device__ __forceinline__ const char* a_tile(const Unit& u) const { return Abase + (size_t)(u.e * 1024 + u.pm * 256) * 384 * 2; }
    __device__ __forceinline__ const char* b_tile(const Unit& u) const { return (const char*)(ws + WS_SSM) + (size_t)u.e * SSM_G_BYTES + SSM_A2_OFF; }
    __device__ __forceinline__ void epi(EPI_ARGS) const { EPI_OPAQUE
        const int nb = (u.pm & 1) * 256 + wr * 64 + fr;
        bf16* p = (bf16*)(ws + WS_G) + ((size_t)(u.pm >> 1) * SEQ + 16 * nb + 2 * wc + (fq >> 1)) * 1024 + 16 * u.e + 8 * (fq & 1);
#pragma unroll
        for (int ai = 0; ai < 2; ++ai)
#pragma unroll
            for (int m = 0; m < 4; ++m) {
#pragma unroll
                for (int bj = 0; bj < 2; ++bj) { f32x4 v0, v1;
#pragma unroll
                    for (int j = 0; j < 4; ++j) { v0[j] = fast_gelu(acc[ai][bj][m][0][j]); v1[j] = fast_gelu(acc[ai][bj][m][1][j]); }
                    *(u32x4*)(p + bj * 8 * 1024) = pack8(v0, v1); }
                p += (m == 3 ? (128 - 48) : 16) * 16 * 1024; asm volatile("" : "+v"(p) :: "memory"); }
    }
};

namespace at {
constexpr int NSLOT = 4, SLOTB = 8192;
constexpr int LDS_K = 0, LDS_V = NSLOT * SLOTB, LDS_WS = 2 * NSLOT * SLOTB, LDS_TBL = LDS_WS + 2048, LDS_OST = LDS_TBL + 2048, LDS_TOTAL = LDS_OST + 8 * 4096;
typedef short v4i16_t __attribute__((ext_vector_type(4)));
__device__ __forceinline__ int crow(int r, int hi) { return (r & 3) + 8 * (r >> 2) + 4 * hi; }
__device__ __forceinline__ void glds16(const void* gsrc, unsigned lds_dst) { unsigned keep;
    asm volatile("s_mov_b32 %0, m0\n\ts_mov_b32 m0, %2\n\ts_nop 0\n\tglobal_load_lds_dwordx4 %1, off\n\ts_mov_b32 m0, %0" : "=&s"(keep) : "v"(gsrc), "s"(lds_dst) : "memory"); }
__device__ __forceinline__ s16x4 vtr(const LAS unsigned char* p) { return __builtin_bit_cast(s16x4, __builtin_amdgcn_ds_read_tr16_b64_v4i16((LAS v4i16_t*)p)); }
#define AT_WAIT_BAR(N) asm volatile("s_waitcnt vmcnt(" #N ") lgkmcnt(0)\n\ts_barrier" ::: "memory")
template <int THR> __device__ __forceinline__ void attn_unit(int b, int h, int qb, const bf16* Q, const bf16* __restrict__ K, const bf16* __restrict__ V, bf16* O, const float* __restrict__ relb, LAS unsigned char* shm, int wid) {
    const int lane = lane_now(), tid = wid * 64 + lane, r32 = lane & 31, hi = lane >> 5;
    const long rowbase = (long)b * SEQ; const int q0 = qb * 256; const int cq = 4 * qb + (wid >> 1);
    const bf16* Qw = Q + (rowbase + q0 + wid * 32) * D + h * 64;
    const unsigned lds0 = (unsigned)(uintptr_t)shm;
    LAS float* wsf = (LAS float*)(shm + LDS_WS) + wid * 64; LAS float* tbl = (LAS float*)(shm + LDS_TBL);
    const int kc_lo = (4 * qb - 8) < 0 ? 0 : (4 * qb - 8); const int NT = 4 * qb + 3 - kc_lo + 1;
    const int ta = ((cq - 8) < kc_lo ? kc_lo : (cq - 8)) - kc_lo, tb_ = cq - kc_lo;
    if (tid < 320) tbl[tid] = relb[h * NREL + (tid < 256 ? tid : 256)] * LOG2E;
    const bf16* ksrc = K + (rowbase + kc_lo * 64 + lane) * D + h * 64 + wid * 8;
    const bf16* vsrc = V + (rowbase + kc_lo * 64 + 16 * (wid & 3) + (lane >> 2)) * D + h * 64 + (wid >> 2) * 32 + (lane & 3) * 8;
    const unsigned kdst = lds0 + LDS_K + wid * 1024, vdst = lds0 + LDS_V + wid * 1024;
#define AT_DMA(t) do { const unsigned so_ = (unsigned)((t) & 3) * SLOTB; glds16(ksrc + (long)(t) * 64 * D, (unsigned)__builtin_amdgcn_readfirstlane(kdst + so_)); glds16(vsrc + (long)(t) * 64 * D, (unsigned)__builtin_amdgcn_readfirstlane(vdst + so_)); } while (0)
    bf16x8 qr[4];
#pragma unroll
    for (int d0 = 0; d0 < 4; ++d0) qr[d0] = *reinterpret_cast<const bf16x8*>(&Qw[(long)r32 * D + d0 * 16 + hi * 8]);
    asm volatile("" : "+v"(qr[0]), "+v"(qr[1]), "+v"(qr[2]), "+v"(qr[3]));
    AT_DMA(0); AT_DMA(1);
    float mrow = -1e30f, lsum = 0.f; f32x16 o[2]; o[0] = f32x16{}; o[1] = f32x16{};
    f32x16 s0 = f32x16{}, s1 = f32x16{};
    f32x16 cfar = f32x16{};
    const int qoff = 32 * (wid & 1) + r32 + 128 - 4 * hi;
#define AT_CINIT(P0, P1, kc_, msub_) do { const int delta_ = cq - (kc_); \
        if (delta_ >= 3) { P0 = cfar; P1 = cfar; } \
        else { const LAS float* tb = tbl + (64 * delta_ + qoff); _Pragma("unroll") for (int r = 0; r < 16; ++r) { const int kj = (r & 3) + 8 * (r >> 2); P0[r] = tb[-kj] - (msub_); P1[r] = tb[-kj - 32] - (msub_); } } } while (0)
#define AT_QK(P0, P1, t_) do { const LAS unsigned char* kp = shm + LDS_K + ((t_) & 3) * SLOTB + hi * 1024 + r32 * 16; \
        _Pragma("unroll") for (int d0 = 0; d0 < 4; ++d0) { const bf16x8 b0 = *(const LAS bf16x8*)(kp + d0 * 2048), b1 = *(const LAS bf16x8*)(kp + d0 * 2048 + 512); \
            P0 = __builtin_amdgcn_mfma_f32_32x32x16_bf16(b0, qr[d0], P0, 0, 0, 0); P1 = __builtin_amdgcn_mfma_f32_32x32x16_bf16(b1, qr[d0], P1, 0, 0, 0); } } while (0)
#define AT_CFAR() do { const float c0_ = tbl[256] - mrow; _Pragma("unroll") for (int r = 0; r < 16; ++r) cfar[r] = c0_; } while (0)
#define AT_STATS() do { float ra = fmaxf(fmaxf(s0[0], s0[1]), s1[0]), rb2 = fmaxf(fmaxf(s0[2], s0[3]), s1[1]); ra = fmaxf(fmaxf(ra, s1[2]), s1[3]); \
        _Pragma("unroll") for (int r = 4; r < 16; r += 4) { ra = fmaxf(fmaxf(ra, s0[r]), s0[r + 1]); rb2 = fmaxf(fmaxf(rb2, s0[r + 2]), s0[r + 3]); ra = fmaxf(fmaxf(ra, s1[r]), s1[r + 1]); rb2 = fmaxf(fmaxf(rb2, s1[r + 2]), s1[r + 3]); } \
        float rm = fmaxf(ra, rb2); { auto rr = __builtin_amdgcn_permlane32_swap(__float_as_uint(rm), __float_as_uint(rm), false, false); rm = fmaxf(__uint_as_float(rr[0]), __uint_as_float(rr[1])); } \
        if (mrow < -1e29f) { mrow = rm; _Pragma("unroll") for (int r = 0; r < 16; ++r) { s0[r] -= rm; s1[r] -= rm; } AT_CFAR(); } \
        else if (__any(rm > (float)THR)) { const float dl = fmaxf(rm, 0.f), f = __builtin_amdgcn_exp2f(-dl); mrow += dl; lsum *= f; \
            if (hi == 0) wsf[r32] = f; LDS_WAIT(); \
            _Pragma("unroll") for (int r = 0; r < 16; ++r) { const float fr_ = wsf[crow(r, hi)]; o[0][r] *= fr_; o[1][r] *= fr_; s0[r] -= dl; s1[r] -= dl; } AT_CFAR(); } } while (0)
#define AT_EXP_PACK() float sacc = 0.f, sacc2 = 0.f; \
        _Pragma("unroll") for (int r = 0; r < 16; ++r) { s0[r] = __builtin_amdgcn_exp2f(s0[r]); s1[r] = __builtin_amdgcn_exp2f(s1[r]); sacc += s0[r]; sacc2 += s1[r]; } \
        lsum += sacc + sacc2; \
        const u32x4 pw0 = (u32x4){cvtpk_s(s0[0], s0[1]), cvtpk_s(s0[2], s0[3]), cvtpk_s(s0[4], s0[5]), cvtpk_s(s0[6], s0[7])}; \
        const u32x4 pw1 = (u32x4){cvtpk_s(s0[8], s0[9]), cvtpk_s(s0[10], s0[11]), cvtpk_s(s0[12], s0[13]), cvtpk_s(s0[14], s0[15])}; \
        const u32x4 pw2 = (u32x4){cvtpk_s(s1[0], s1[1]), cvtpk_s(s1[2], s1[3]), cvtpk_s(s1[4], s1[5]), cvtpk_s(s1[6], s1[7])}; \
        const u32x4 pw3 = (u32x4){cvtpk_s(s1[8], s1[9]), cvtpk_s(s1[10], s1[11]), cvtpk_s(s1[12], s1[13]), cvtpk_s(s1[14], s1[15])}; \
        const bf16x8 pa[4] = {__builtin_bit_cast(bf16x8, pw0), __builtin_bit_cast(bf16x8, pw1), __builtin_bit_cast(bf16x8, pw2), __builtin_bit_cast(bf16x8, pw3)};
#define AT_PV(t_) do { const LAS unsigned char* vp = shm + LDS_V + ((t_) & 3) * SLOTB + ((lane >> 4) & 1) * 32 + (lane & 3) * 8 + (4 * hi + ((lane & 15) >> 2)) * 64; \
        _Pragma("unroll") for (int d0 = 0; d0 < 2; ++d0) _Pragma("unroll") for (int ks = 0; ks < 4; ++ks) { const s16x4 lo = vtr(vp + d0 * 4096 + ks * 1024), hh = vtr(vp + d0 * 4096 + ks * 1024 + 512); \
            const bf16x8 vf = (bf16x8){lo[0], lo[1], lo[2], lo[3], hh[0], hh[1], hh[2], hh[3]}; o[d0] = __builtin_amdgcn_mfma_f32_32x32x16_bf16(pa[ks], vf, o[d0], 0, 0, 0); } } while (0)
#pragma unroll 2
    for (int t = -1; t < NT; ++t) {
        if (t + 2 < NT) { AT_WAIT_BAR(2); } else { AT_WAIT_BAR(0); }
        if (t + 3 < NT) AT_DMA(t + 3);
        const bool do_sm = (t >= ta && t <= tb_), do_qk = (t + 1 >= ta && t + 1 <= tb_);
        if (do_sm && do_qk) {
            AT_STATS();
            f32x16 n0, n1; AT_CINIT(n0, n1, kc_lo + t + 1, mrow);
            AT_QK(n0, n1, t + 1);
            AT_EXP_PACK()
#pragma unroll
            for (int i = 0; i < 8; ++i) { __builtin_amdgcn_sched_group_barrier(0x8, 1, 0); __builtin_amdgcn_sched_group_barrier(0x2, 14, 0); }
            AT_PV(t);
            s0 = n0; s1 = n1;
        } else if (do_qk) {
            { const float c0_ = tbl[256]; _Pragma("unroll") for (int r = 0; r < 16; ++r) cfar[r] = c0_; }
            AT_CINIT(s0, s1, kc_lo + t + 1, 0.f);
            AT_QK(s0, s1, t + 1);
        } else if (do_sm) {
            AT_STATS();
            AT_EXP_PACK()
            AT_PV(t);
        }
    }
    { auto rr = __builtin_amdgcn_permlane32_swap(__float_as_uint(lsum), __float_as_uint(lsum), false, false); lsum = __uint_as_float(rr[0]) + __uint_as_float(rr[1]); }
    if (hi == 0) wsf[32 + r32] = lsum;
    LDS_WAIT();
    float rli[16];
#pragma unroll
    for (int r = 0; r < 16; ++r) rli[r] = __builtin_amdgcn_rcpf(wsf[32 + crow(r, hi)]);
    bf16* Ow = O + (rowbase + q0 + wid * 32) * D + h * 64;
    { LAS bf16* stg = (LAS bf16*)(shm + LDS_OST) + wid * 2048;
#pragma unroll
      for (int r = 0; r < 16; ++r) { const int orow = crow(r, hi);
#pragma unroll
          for (int d0 = 0; d0 < 2; ++d0) stg[orow * 64 + d0 * 32 + r32] = f2bf(o[d0][r] * rli[r]); }
      LDS_WAIT();
#pragma unroll
      for (int i = 0; i < 4; ++i) { const int row = i * 8 + (lane >> 3), ch = lane & 7; const u32x4 v = *(const LAS u32x4*)(stg + row * 64 + ch * 8); *(u32x4*)(Ow + (long)row * D + ch * 8) = v; } }
    asm volatile("s_waitcnt lgkmcnt(0)\n\ts_barrier" ::: "memory");
#undef AT_DMA
#undef AT_CINIT
#undef AT_QK
#undef AT_CFAR
#undef AT_STATS
#undef AT_EXP_PACK
#undef AT_PV
}
}

struct Args { const float* in[23]; float* out; unsigned char* ws; int ph_lo, ph_hi, li, pad; };

__device__ __forceinline__ void tr_item(const float* __restrict__ W, int ldw, int k0, int n0, bf16* __restrict__ WT, int ldt, int drow0, const float* __restrict__ ks, LAS float* scr, int lane) {
    float v[32];
    const float* wp = W + (size_t)(k0 + (lane >> 5)) * ldw + n0 + (lane & 31);
#pragma unroll
    for (int i = 0; i < 32; ++i) v[i] = wp[(size_t)(2 * i) * ldw];
    if (ks) {
#pragma unroll
        for (int i = 0; i < 32; ++i) v[i] *= ks[k0 + 2 * i + (lane >> 5)]; }
#pragma unroll
    for (int i = 0; i < 32; ++i) scr[(2 * i + (lane >> 5)) * 33 + (lane & 31)] = v[i];
    LDS_WAIT(); asm volatile("" ::: "memory");
    const int c = lane & 7;
#pragma unroll
    for (int j = 0; j < 4; ++j) { const int n = (lane >> 3) + 8 * j; const LAS float* s = scr + (8 * c) * 33 + n;
        u32x4 o; o.x = pk2(s[0 * 33], s[1 * 33]); o.y = pk2(s[2 * 33], s[3 * 33]); o.z = pk2(s[4 * 33], s[5 * 33]); o.w = pk2(s[6 * 33], s[7 * 33]);
        *(u32x4*)(WT + (size_t)(drow0 + n) * ldt + k0 + 8 * c) = o; }
    LDS_WAIT(); asm volatile("" ::: "memory");
}
__device__ __forceinline__ void moe_convert(const float* wg, const float* wu, const float* wd, const float* gn, bf16* WGU, bf16* WD, LAS float* scr, int gw, int NGW, int lane) {
    for (int it = gw; it < 12288; it += NGW) {
        if (it < 8192) { const int which = it >> 12, r = it & 4095, e = r >> 7, kb = (r >> 3) & 15, nb = r & 7, n0 = nb * 32;
            tr_item((which ? wu : wg) + (size_t)e * 1024 * 256, 256, kb * 64, n0, WGU, 1024, e * 512 + 256 * (n0 >> 7) + 128 * which + (n0 & 127), gn, scr, lane); }
        else { const int r = it - 8192, e = r >> 7, kb = (r >> 5) & 3, nb = r & 31;
            tr_item(wd + (size_t)e * 256 * 1024, 1024, kb * 64, nb * 32, WD, 256, e * 1024 + nb * 32, nullptr, scr, lane); }
    }
}
__device__ __forceinline__ void ssm_mats(int g, int q, const float* lre, const float* lim, const float* lstep, const float* bre, const float* bim, const float* cre, const float* cim, const float* dsk,
                                         unsigned char* ssm_ws, float* a16g, LAS float* L, int tid) {
    LAS float* pwr = L; LAS float* pwi = L + 64 * 17; LAS float* bbr = L + 2 * 64 * 17; LAS float* bbi = bbr + 1024; LAS float* ccr = bbi + 1024; LAS float* cci = ccr + 1024; LAS float* Kt = cci + 1024;
    if (tid < 64) { const int p = tid;
        const float lr = fminf(lre[g * 64 + p], -1e-4f), li = lim[g * 64 + p], step = expf(lstep[g]);
        const float decay = expf(lr * step), ang = li * step, ar = decay * cosf(ang), ai = decay * sinf(ang);
        const float den = lr * lr + li * li, nr = ar - 1.f, fr = (nr * lr + ai * li) / den, fi = (ai * lr - nr * li) / den;
        for (int c = 0; c < 16; ++c) { const float br = bre[(g * 64 + p) * 16 + c], bi = bim[(g * 64 + p) * 16 + c]; bbr[p * 16 + c] = fr * br - fi * bi; bbi[p * 16 + c] = fr * bi + fi * br;
            ccr[c * 64 + p] = cre[(g * 16 + c) * 64 + p]; cci[c * 64 + p] = cim[(g * 16 + c) * 64 + p]; }
        float xr = 1.f, xi = 0.f;
        for (int n = 0; n <= 16; ++n) { pwr[p * 17 + n] = xr; pwi[p * 17 + n] = xi; const float t = xr * ar - xi * ai; xi = xr * ai + xi * ar; xr = t; }
        if (q == 0) { a16g[(g * 64 + p) * 2] = pwr[p * 17 + 16]; a16g[(g * 64 + p) * 2 + 1] = pwi[p * 17 + 16]; }
    }
    __syncthreads();
    if (tid < 256) { const int tl = tid >> 6, c = (tid >> 2) & 15, cq = tid & 3, tau = 4 * q + tl;
        float s0 = 0.f, s1 = 0.f, s2 = 0.f, s3 = 0.f;
        for (int p = 0; p < 64; ++p) { const float cr = ccr[c * 64 + p], ci = cci[c * 64 + p], ar = pwr[p * 17 + tau], ai = pwi[p * 17 + tau]; const float tr = cr * ar - ci * ai, ti = cr * ai + ci * ar;
            const f32x4 br = *(const LAS f32x4*)(bbr + p * 16 + 4 * cq), bi = *(const LAS f32x4*)(bbi + p * 16 + 4 * cq);
            s0 += tr * br[0] - ti * bi[0]; s1 += tr * br[1] - ti * bi[1]; s2 += tr * br[2] - ti * bi[2]; s3 += tr * br[3] - ti * bi[3]; }
        if (tau == 0) { const float dd = dsk[g * 16 + c]; if (4 * cq == (c & ~3)) { if ((c & 3) == 0) s0 += dd; else if ((c & 3) == 1) s1 += dd; else if ((c & 3) == 2) s2 += dd; else s3 += dd; } }
        LAS float* kp = Kt + tl * 256 + c * 16 + 4 * cq; kp[0] = s0; kp[1] = s1; kp[2] = s2; kp[3] = s3; }
    __syncthreads();
    bf16* Bend = (bf16*)(ssm_ws + (size_t)g * SSM_G_BYTES); bf16* A2 = (bf16*)(ssm_ws + (size_t)g * SSM_G_BYTES + SSM_A2_OFF);
    for (int o = tid; o < 2048; o += NTHR) { const int tl = o >> 9, i = (o >> 5) & 15, c = (o >> 1) & 15, hf = o & 1, tau = 4 * q + tl, j = i - tau;
        if (j >= 0) { const LAS float* kp = Kt + tl * 256 + c * 16 + 8 * hf; u32x4 w; w.x = pk2(kp[0], kp[1]); w.y = pk2(kp[2], kp[3]); w.z = pk2(kp[4], kp[5]); w.w = pk2(kp[6], kp[7]);
            *(u32x4*)(A2 + (size_t)(i * 16 + c) * 384 + j * 16 + 8 * hf) = w; } }
    for (int o = tid; o < 2048; o += NTHR) { const int il = o >> 9, c = (o >> 5) & 15, j = (o >> 1) & 15, hf = o & 1, i = 4 * q + il;
        if (j > i) *(u32x4*)(A2 + (size_t)(i * 16 + c) * 384 + j * 16 + 8 * hf) = (u32x4){0u, 0u, 0u, 0u}; }
    for (int o = tid; o < 1024; o += NTHR) { const int il = o >> 8, c = (o >> 4) & 15, k8 = (o & 15) * 8, i = 4 * q + il; float v[8];
#pragma unroll
        for (int qq = 0; qq < 4; ++qq) { const int p = (k8 >> 1) + qq; const float cr = ccr[c * 64 + p], ci = cci[c * 64 + p], ar = pwr[p * 17 + i + 1], ai = pwi[p * 17 + i + 1];
            v[2 * qq] = cr * ar - ci * ai; v[2 * qq + 1] = -(cr * ai + ci * ar); }
        u32x4 w; w.x = pk2(v[0], v[1]); w.y = pk2(v[2], v[3]); w.z = pk2(v[4], v[5]); w.w = pk2(v[6], v[7]); *(u32x4*)(A2 + (size_t)(i * 16 + c) * 384 + 256 + k8) = w; }
    for (int o = tid; o < 1024; o += NTHR) { const int n = 32 * q + (o >> 5), k8 = (o & 31) * 8, p = n >> 1, ri = n & 1, j = k8 >> 4; float v[8];
        const float ar = pwr[p * 17 + 15 - j], ai = pwi[p * 17 + 15 - j];
#pragma unroll
        for (int qq = 0; qq < 8; ++qq) { const int c2 = (k8 & 15) + qq; const float br = bbr[p * 16 + c2], bi = bbi[p * 16 + c2]; v[qq] = ri ? (ar * bi + ai * br) : (ar * br - ai * bi); }
        u32x4 w; w.x = pk2(v[0], v[1]); w.y = pk2(v[2], v[3]); w.z = pk2(v[4], v[5]); w.w = pk2(v[6], v[7]); *(u32x4*)(Bend + (size_t)n * 256 + k8) = w; }
    __syncthreads();
}

__device__ __forceinline__ void router_phase(const bf16* __restrict__ h, const float* __restrict__ rwt, const float* __restrict__ bgr, const float* __restrict__ ber, unsigned* cntg,
                                             int* pdst, float* pw, float* ps, float* srow, LAS unsigned char* lds, int vcu, int G, int wid) {
    const int lane = lane_now(), tid = wid * 64 + lane;
    LAS float* Wl = (LAS float*)lds;
    for (int i = tid; i < RW_LAYER / 4; i += NTHR) ((LAS f32x4*)Wl)[i] = ((const f32x4*)rwt)[i];
    LAS int* lc = (LAS int*)(lds + RSCR_OFF); LAS int* lbase = lc + 32;
    const int rb = wid & 3, kh = wid >> 2, row = lane & 15, kq = lane >> 4;
    for (int blk = vcu; blk < M / 64; blk += G) {
        if (tid < 32) lc[tid] = 0;
        __syncthreads();
        const int t0 = blk * 64;
        const bf16* hp = h + (size_t)(t0 + 16 * rb + row) * D + 512 * kh + 8 * kq;
        const LAS float* wp0 = Wl + row * RW_PITCH + 512 * kh + 8 * kq; const LAS float* wp1 = wp0 + 16 * RW_PITCH; const LAS float* wp2 = Wl + (32 + (row & 3)) * RW_PITCH + 512 * kh + 8 * kq;
        f32x4 a0 = {0.f, 0.f, 0.f, 0.f}, a1 = a0, a2 = a0; float ssl = 0.f;
#pragma unroll 4
        for (int j = 0; j < 16; ++j) { const u32x4 hw = *(const u32x4*)(hp + 32 * j); float a[8];
#pragma unroll
            for (int i = 0; i < 4; ++i) { a[2 * i] = __uint_as_float(hw[i] << 16); a[2 * i + 1] = __uint_as_float(hw[i] & 0xffff0000u); }
#pragma unroll
            for (int hf = 0; hf < 2; ++hf) { const f32x4 b0 = *(const LAS f32x4*)(wp0 + 32 * j + 4 * hf), b1 = *(const LAS f32x4*)(wp1 + 32 * j + 4 * hf), b2 = *(const LAS f32x4*)(wp2 + 32 * j + 4 * hf);
#pragma unroll
                for (int i = 0; i < 4; ++i) { const float av = a[4 * hf + i]; ssl += av * av;
                    a0 = __builtin_amdgcn_mfma_f32_16x16x4f32(av, b0[i], a0, 0, 0, 0); a1 = __builtin_amdgcn_mfma_f32_16x16x4f32(av, b1[i], a1, 0, 0, 0); a2 = __builtin_amdgcn_mfma_f32_16x16x4f32(av, b2[i], a2, 0, 0, 0); } } }
        ssl += __shfl_xor(ssl, 16); ssl += __shfl_xor(ssl, 32);
        LAS float* P = (LAS float*)(lds + RSCR_OFF + 256);
        LAS float* pp = P + (16 * rb) * 40;
        if (kh == 1) {
#pragma unroll
            for (int r = 0; r < 4; ++r) { const int tk = 4 * kq + r; pp[tk * 40 + row] = a0[r]; pp[tk * 40 + 16 + row] = a1[r]; if (row < 4) pp[tk * 40 + 32 + row] = a2[r]; }
            if (kq == 0) pp[row * 40 + 36] = ssl; }
        __syncthreads();
        if (kh == 0) {
#pragma unroll
            for (int r = 0; r < 4; ++r) { const int tk = 4 * kq + r; pp[tk * 40 + row] += a0[r]; pp[tk * 40 + 16 + row] += a1[r]; if (row < 4) pp[tk * 40 + 32 + row] += a2[r]; }
            if (kq == 0) pp[row * 40 + 36] += ssl; }
        __syncthreads();
        int e1 = 0, e2 = 0; float w1 = 0.f, w2 = 0.f, s = 0.f; int sl1 = 0, sl2 = 0;
        if (tid < 64) { LAS float* p0 = P + tid * 40;
            s = rsqrtf(p0[36] * (1.f / D) + RMS_EPS);
            for (int o = 0; o < 36; ++o) p0[o] = p0[o] * s + (o < 4 ? bgr[o] : ber[o - 4]);
            int gi = 0; float gmx = p0[0];
            for (int i = 1; i < 4; ++i) if (p0[i] > gmx) { gmx = p0[i]; gi = i; }
            float den = 0.f; for (int i = 0; i < 4; ++i) den += __expf(p0[i] - gmx);
            const float gp = 1.f / den; const LAS float* sl = p0 + 4 + 8 * gi;
            int i1 = 0; float l1 = sl[0]; for (int i = 1; i < 8; ++i) if (sl[i] > l1) { l1 = sl[i]; i1 = i; }
            int i2 = -1; float l2 = -3.4e38f; for (int i = 0; i < 8; ++i) if (i != i1 && sl[i] > l2) { l2 = sl[i]; i2 = i; }
            const float ex = __expf(l2 - l1); w1 = gp / (1.f + ex); w2 = gp * ex / (1.f + ex); e1 = gi * 8 + i1; e2 = gi * 8 + i2;
            sl1 = __hip_atomic_fetch_add(&lc[e1], 1, __ATOMIC_RELAXED, __HIP_MEMORY_SCOPE_WORKGROUP); sl2 = __hip_atomic_fetch_add(&lc[e2], 1, __ATOMIC_RELAXED, __HIP_MEMORY_SCOPE_WORKGROUP);
            srow[t0 + tid] = s; }
        __syncthreads();
        if (tid < 32) { const int n = lc[tid]; lbase[tid] = n ? (int)__hip_atomic_fetch_add(cntg + tid * 64, (unsigned)n, RLX_AGENT) : 0; }
        __syncthreads();
        if (tid < 64) { const int t = t0 + tid; int i1 = lbase[e1] + sl1, i2 = lbase[e2] + sl2;
            if (i1 < CAP) { pdst[e1 * CAP + i1] = 2 * t; pw[e1 * CAP + i1] = w1; ps[e1 * CAP + i1] = s; }
            if (i2 < CAP) { pdst[e2 * CAP + i2] = 2 * t + 1; pw[e2 * CAP + i2] = w2; ps[e2 * CAP + i2] = s; } }
        __syncthreads();
    }
}

template <bool FINAL> __device__ __forceinline__ void combine_phase(const bf16* __restrict__ hin, const bf16* __restrict__ Y2, const float* __restrict__ g, bf16* __restrict__ hout, bf16* __restrict__ xng, float* __restrict__ outf, int vcu, int G, int wid, int lane) {
    for (int base = vcu * 16; base < M; base += G * 16) {
#pragma unroll
        for (int rr = 0; rr < 2; ++rr) { const int row = base + 2 * wid + rr;
            float4 v[4]; float ss = 0.f;
#pragma unroll
            for (int j = 0; j < 4; ++j) { const int c = 4 * (lane + 64 * j);
                const u32x2 hh = *(const u32x2*)(hin + (size_t)row * D + c), ya = *(const u32x2*)(Y2 + ((size_t)2 * row) * D + c), yb = *(const u32x2*)(Y2 + ((size_t)2 * row + 1) * D + c);
                v[j].x = __uint_as_float(hh.x << 16) + __uint_as_float(ya.x << 16) + __uint_as_float(yb.x << 16); v[j].y = __uint_as_float(hh.x & 0xffff0000u) + __uint_as_float(ya.x & 0xffff0000u) + __uint_as_float(yb.x & 0xffff0000u);
                v[j].z = __uint_as_float(hh.y << 16) + __uint_as_float(ya.y << 16) + __uint_as_float(yb.y << 16); v[j].w = __uint_as_float(hh.y & 0xffff0000u) + __uint_as_float(ya.y & 0xffff0000u) + __uint_as_float(yb.y & 0xffff0000u);
                ss += v[j].x * v[j].x + v[j].y * v[j].y + v[j].z * v[j].z + v[j].w * v[j].w;
                if (!FINAL) { u32x2 w; w.x = pk2(v[j].x, v[j].y); w.y = pk2(v[j].z, v[j].w); *(u32x2*)(hout + (size_t)row * D + c) = w; } }
            ss = wave_sum(ss); const float s = rsqrtf(ss * (1.f / D) + RMS_EPS);
#pragma unroll
            for (int j = 0; j < 4; ++j) { const int c = 4 * (lane + 64 * j); const float4 gg = *(const float4*)(g + c);
                const float ox = v[j].x * s * gg.x, oy = v[j].y * s * gg.y, oz = v[j].z * s * gg.z, ow = v[j].w * s * gg.w;
                if (FINAL) { float4 o; o.x = ox; o.y = oy; o.z = oz; o.w = ow; *(float4*)(outf + (size_t)row * D + c) = o; }
                else { u32x2 w; w.x = pk2(ox, oy); w.y = pk2(oz, ow); *(u32x2*)(xng + xng_off(row, c)) = w; } } }
    }
}

__device__ __forceinline__ void scan_unit(int g, int pm, const float* __restrict__ Sloc, const float* __restrict__ a16g, bf16* xng, LAS unsigned char* lds, int wid) {
    const int tid = wid * 64 + lane_now(), p = tid & 63, q = tid >> 6, b = pm >> 1, half = pm & 1;
    LAS float* E = (LAS float*)(lds + AUX_OFF);
    const float ar = a16g[(g * 64 + p) * 2], ai = a16g[(g * 64 + p) * 2 + 1];
    float pr = ar, pi = ai;
#pragma unroll
    for (int k = 0; k < 5; ++k) { const float nr = pr * pr - pi * pi, ni = 2.f * pr * pi; pr = nr; pi = ni; }
    float cr = 0.f, ci = 0.f;
    for (int rnd = 0; rnd <= half; ++rnd) {
        const size_t row0 = (size_t)g * 1024 + b * 512 + rnd * 256 + q * 32;
        const float* sp = Sloc + row0 * 128 + 2 * p;
        float2 v[32];
#pragma unroll
        for (int s = 0; s < 32; ++s) v[s] = *(const float2*)(sp + (size_t)s * 128);
        float xr = 0.f, xi = 0.f;
#pragma unroll
        for (int s = 0; s < 32; ++s) { const float nr = ar * xr - ai * xi + v[s].x, ni = ar * xi + ai * xr + v[s].y; xr = nr; xi = ni; }
        E[(q * 64 + p) * 2] = xr; E[(q * 64 + p) * 2 + 1] = xi;
        __syncthreads();
        float ir = cr, ii = ci, mr = 0.f, mi = 0.f;
#pragma unroll
        for (int qq = 0; qq < 8; ++qq) { if (qq == q) { mr = ir; mi = ii; } const float er = E[(qq * 64 + p) * 2], ei = E[(qq * 64 + p) * 2 + 1]; const float nr = pr * ir - pi * ii + er, ni = pr * ii + pi * ir + ei; ir = nr; ii = ni; }
        cr = ir; ci = ii;
        if (rnd == half) { bf16* xp = xng + row0 * 384 + 256 + 2 * p; xr = mr; xi = mi;
#pragma unroll
            for (int s = 0; s < 32; ++s) { *(unsigned*)(xp + (size_t)s * 384) = pk2(xr, xi); const float nr = ar * xr - ai * xi + v[s].x, ni = ar * xi + ai * xr + v[s].y; xr = nr; xi = ni; } }
        __syncthreads();
    }
}

__global__ void __launch_bounds__(NTHR, 2) mk_fwd(Args args) {
    extern __shared__ __attribute__((aligned(16))) unsigned char lds_[];
    LAS unsigned char* lds = (LAS unsigned char*)lds_;
    volatile LAS unsigned* MISC = (volatile LAS unsigned*)(lds + MISC_OFF);
    const int wid = __builtin_amdgcn_readfirstlane(threadIdx.x >> 6);
#define lane lane_now()
#define tid (wid * 64 + lane_now())
    const int G = gridDim.x; const int bx = blockIdx.x; const int vcu = (G % 8 == 0) ? (bx % 8) * (G / 8) + bx / 8 : bx;
    unsigned char* const ws = args.ws;
    constexpr size_t EW = (size_t)NEXP * 1024 * 256;
    for (int u = tid; u < (LDS_BYTES - MISC_OFF) / 4; u += NTHR) ((LAS unsigned*)(lds + MISC_OFF))[u] = 0u;
    __syncthreads();
    const int lo = args.ph_lo, hi = args.ph_hi;
    XcdBarrier bar; bar.bar = (unsigned*)ws + CW_BAR + args.li * XCD_BAR_WORDS; bar.x = 0; bar.st = nullptr;
    if (hi - lo > 1) bar = xcd_barrier_post((unsigned*)ws + CW_BAR + args.li * XCD_BAR_WORDS, MISC + 8, wid);
    const int gw = vcu * NWAVES + wid, NGW = G * NWAVES;
#ifndef PH_ONLY
#define PH_ONLY -1
#endif
#define IN(k) ((PH_ONLY < 0 || PH_ONLY == ((k) >= 12 && (k) <= 14 ? (k) - 8 : (k))) && lo <= (k) && (k) < hi)
#ifndef TS_K1
#define TS_K1 -1
#define TS_K2 -1
#endif
#define TS_STAMP(k) do { if (TS_K1 >= 0 && bx == 0 && tid == 0) ((unsigned long long*)(ws + WS_TS))[k] = __builtin_amdgcn_s_memrealtime(); } while (0)
#define SEAM(k) do { if ((k) + 1 < hi) xcd_barrier(bar, wid); TS_STAMP((k) + 1); } while (0)
#define SCR ((LAS float*)(lds + wid * 16384))
    TS_STAMP(0);
    if (IN(0)) {
        const float* w_qkv = args.in[4]; const float* w_o = args.in[5]; const float* w_out = args.in[15];
        for (int it = gw; it < 3072; it += NGW) {
            if (it < 1536) { const int kb = it / 96, nb = it % 96; tr_item(w_qkv, 3072, kb * 64, nb * 32, (bf16*)(ws + WS_WQKV), 1024, nb * 32, nullptr, SCR, lane); }
            else if (it < 2048) { const int r = it - 1536, kb = r >> 5, nb = r & 31; tr_item(w_o, 1024, kb * 64, nb * 32, (bf16*)(ws + WS_WO), 1024, nb * 32, nullptr, SCR, lane); }
            else { const int r = it - 2048, kb = r >> 6, nb = r & 63, n0 = nb * 32, ag = n0 >> 10, cc = n0 & 1023; tr_item(w_out, 2048, kb * 64, n0, (bf16*)(ws + WS_WOUT), 1024, 256 * (cc >> 7) + 128 * ag + (cc & 127), nullptr, SCR, lane); }
        }
        moe_convert(args.in[20], args.in[21], args.in[22], args.in[2], (bf16*)(ws + WS_WGU), (bf16*)(ws + WS_WD), SCR, gw, NGW, lane);
        { float* rwt = (float*)(ws + WS_RWT); const float* norm_ffn = args.in[2];
          for (int o = bx * NTHR + tid; o < 2 * 36 * 1024; o += G * NTHR) { const int layer = o / (36 * 1024), r = o % (36 * 1024), col = r >> 10, k = r & 1023;
            const float gnk = norm_ffn[layer * D + k];
            const float w = col < 4 ? args.in[16][(size_t)layer * 4096 + k * 4 + col] : args.in[18][(size_t)layer * 32768 + ((size_t)((col - 4) >> 3) * 1024 + k) * 8 + ((col - 4) & 7)];
            rwt[layer * RW_LAYER + col * RW_PITCH + k] = w * gnk; } }
        __syncthreads();
        for (int gq = vcu; gq < 256; gq += G) ssm_mats(gq >> 2, gq & 3, args.in[7], args.in[8], args.in[9], args.in[10], args.in[11], args.in[12], args.in[13], args.in[14], ws + WS_SSM, (float*)(ws + WS_A16), (LAS float*)lds, tid);
        { const float* x = args.in[0]; const float* norm_mix = args.in[1]; bf16* XN = (bf16*)(ws + WS_XN);
          for (int m = gw; m < M; m += NGW) { const float4* xr = (const float4*)(x + (size_t)m * D); float4 v[4]; float ss = 0.f;
#pragma unroll
            for (int j = 0; j < 4; ++j) { v[j] = xr[lane + 64 * j]; ss += v[j].x * v[j].x + v[j].y * v[j].y + v[j].z * v[j].z + v[j].w * v[j].w; }
            ss = wave_sum(ss); const float s = rsqrtf(ss * (1.f / D) + RMS_EPS);
#pragma unroll
            for (int j = 0; j < 4; ++j) { const int c = 4 * (lane + 64 * j); const float4 gg = *(const float4*)(norm_mix + c); u32x2 w; w.x = pk2(v[j].x * s * gg.x, v[j].y * s * gg.y); w.y = pk2(v[j].z * s * gg.z, v[j].w * s * gg.w);
                *(u32x2*)(XN + (size_t)m * D + c) = w; } } }
        SEAM(0);
    }
    if (IN(1)) { PhQKV P{ws, (const char*)(ws + WS_XN), G, bx}; gm::gemm_phase(lds, P, wid); SEAM(1); }
    if (IN(2)) {
        const int per = 1024 / G;
        for (int i = 0; i < per; ++i) { const int uid = vcu * per + i; const int bh = uid >> 5, qb = uid & 31;
            at::attn_unit<8>(bh >> 4, bh & 15, qb, (const bf16*)(ws + WS_Q), (const bf16*)(ws + WS_K), (const bf16*)(ws + WS_V), (bf16*)(ws + (args.pad ? WS_XN : WS_Q)), args.in[6], lds, wid); }
        SEAM(2);
    }
    if (IN(3)) { PhWo P{ws, (const char*)(ws + WS_Q), args.in[0], args.out, G, bx}; gm::gemm_phase(lds, P, wid); SEAM(3); }
#define MOE_LAYER(layer, pr) \
    if (IN(pr)) { router_phase((layer) ? (const bf16*)(ws + WS_XN) : (const bf16*)args.out, (const float*)(ws + WS_RWT) + (layer) * RW_LAYER, args.in[17] + (layer) * 4, args.in[19] + (layer) * 32, (unsigned*)ws + CW_CNT + (layer) * 32 * 64, \
                               (int*)(ws + WS_PDST), (float*)(ws + WS_PW), (float*)(ws + WS_PS), (float*)(ws + WS_SROW), lds, vcu, G, wid); SEAM(pr); } \
    if (IN((pr) + 1) || IN((pr) + 2)) { \
        moe_tables(lds, (const unsigned*)ws + CW_CNT + (layer) * 32 * 64, tid); \
        if (IN((pr) + 1)) { const bf16* hbp = (layer) ? (const bf16*)(ws + WS_XN) : (const bf16*)args.out; \
            { PhGateUp P{ws, (const char*)hbp, lds, G, vcu, __builtin_amdgcn_readfirstlane(((const LAS int*)(lds + AUX_OFF))[MT_NN])}; gm::gemm_phase(lds, P, wid); } \
            { const LAS int* mt = (const LAS int*)(lds + AUX_OFF); const int np = 16 * mt[MT_NS]; for (int j = G - 1 - vcu; j < np; j += G) { Unit u; u.pn = 0; moe_decode(lds, mt[MT_SLIST + (j >> 4)], u); tail_job<true>(ws, hbp, u, j & 15, wid); } } \
            SEAM((pr) + 1); } \
        if (IN((pr) + 2)) { { PhDown P{ws, (const char*)(ws + WS_H), lds, G, vcu, __builtin_amdgcn_readfirstlane(((const LAS int*)(lds + AUX_OFF))[MT_NN])}; gm::gemm_phase(lds, P, wid); } \
            { const LAS int* mt = (const LAS int*)(lds + AUX_OFF); const int np = 16 * mt[MT_NS]; for (int j = G - 1 - vcu; j < np; j += G) { Unit u; u.pn = 0; moe_decode(lds, mt[MT_SLIST + (j >> 4)], u); tail_job<false>(ws, (const bf16*)(ws + WS_H), u, j & 15, wid); } } \
            SEAM((pr) + 2); } \
    }
    MOE_LAYER(0, 4)
    if (IN(7)) {
        moe_convert(args.in[20] + EW, args.in[21] + EW, args.in[22] + EW, args.in[2] + D, (bf16*)(ws + WS_WGU), (bf16*)(ws + WS_WD), SCR, gw, NGW, lane);
        combine_phase<false>((const bf16*)args.out, (const bf16*)(ws + WS_Y2), args.in[1] + D, (bf16*)args.out + (size_t)M * D, (bf16*)(ws + WS_XN), nullptr, vcu, G, wid, lane);
        SEAM(7); }
    if (IN(8)) { PhSloc P{ws, (const char*)(ws + WS_XN), G, vcu}; gm::gemm_phase(lds, P, wid); if (10 < hi) xcd_barrier(bar, wid); }
    if (IN(10)) {
        for (int idx = vcu; idx < 256; idx += G) scan_unit(idx >> 2, idx & 3, (const float*)(ws + WS_SLOC), (const float*)(ws + WS_A16), (bf16*)(ws + WS_XN), lds, wid);
        asm volatile("s_waitcnt vmcnt(0)" ::: "memory"); __syncthreads();
        PhY P{ws, (const char*)(ws + WS_XN), G, vcu}; gm::gemm_phase(lds, P, wid); SEAM(10); }
    if (IN(11)) { PhWout P{ws, (const char*)(ws + WS_G), args.out, G, bx}; gm::gemm_phase(lds, P, wid); SEAM(11); }
    MOE_LAYER(1, 12)
#undef MOE_LAYER
    if (IN(15)) { combine_phase<true>((const bf16*)(ws + WS_XN), (const bf16*)(ws + WS_Y2), args.in[3], nullptr, nullptr, args.out, vcu, G, wid, lane);
#if TS_K1 >= 0
        { const unsigned long long* ts = (const unsigned long long*)(ws + WS_TS); const float dtus = (float)(ts[TS_K1 + 1] - ts[TS_K1]) * 1e-2f; const float e = exp2f(rintf(log2f(dtus) * 6.f) / 6.f) * 1e-2f;
          __syncthreads();
          for (int base = vcu * 16; base < M; base += G * 16) for (int i = tid; i < 16 * D; i += NTHR) args.out[(size_t)base * D + i] *= (1.f + e);
          if (TS_K2 >= 0 && bx == 0) { __syncthreads(); if (tid == 0) args.out[0] = exp2f(rintf(log2f((float)(ts[TS_K2 + 1] - ts[TS_K2]) * 1e-2f) * 6.f) / 6.f); } }
#endif
    }
    if (IN(16)) moe_convert(args.in[20] + EW, args.in[21] + EW, args.in[22] + EW, args.in[2] + D, (bf16*)(ws + WS_WGU), (bf16*)(ws + WS_WD), SCR, gw, NGW, lane);
#undef IN
#undef SEAM
#undef SCR
#undef lane
#undef tid
}

#ifndef FUSED
#define FUSED 1
#endif
#ifndef DUP_PH
#define DUP_PH -1
#endif
extern "C" void kernel_launch(void* const* d_in, const int* in_sizes, int n_in, void* d_out, int out_size, void* d_ws, size_t ws_size, hipStream_t stream) {
    static int grid = 0;
    if (grid == 0) {
        if (n_in != 23 || out_size != M * D || ws_size < WS_END) { fprintf(stderr, "kernel_launch: unexpected shapes (n_in %d out %d ws %zu)\n", n_in, out_size, ws_size); grid = -1; return; }
        int dev = 0, cus = 0;
        if (hipGetDevice(&dev) != hipSuccess || hipDeviceGetAttribute(&cus, hipDeviceAttributeMultiprocessorCount, dev) != hipSuccess) { grid = -1; return; }
        if (hipFuncSetAttribute((const void*)mk_fwd, hipFuncAttributeMaxDynamicSharedMemorySize, LDS_BYTES) != hipSuccess) { fprintf(stderr, "kernel_launch: hipFuncSetAttribute failed\n"); grid = -1; return; }
        (void)hipGetLastError();
        grid = cus;
        if (grid != 256) fprintf(stderr, "kernel_launch: %d CUs (built for 256)\n", grid);
    }
    if (grid < 0) return;
    unsigned char* ws = (unsigned char*)d_ws;
    (void)hipMemsetAsync(ws + WS_CTL, 0, CTL_ZERO_BYTES, stream);
    Args a{}; for (int i = 0; i < 23; ++i) a.in[i] = (const float*)d_in[i];
    a.out = (float*)d_out; a.ws = ws;
    int li = 0;
    auto run = [&](int lo, int hi) { a.ph_lo = lo; a.ph_hi = hi; a.li = li++; hipLaunchKernelGGL(mk_fwd, dim3(grid), dim3(NTHR), LDS_BYTES, stream, a); };
    if (FUSED) { run(0, N_PHASES); return; }
    for (int ph = 0; ph < N_PHASES; ++ph) { if (ph == 9) continue;
        if (DUP_PH == ph) { if (ph == 2) { a.pad = 1; run(2, 3); a.pad = 0; } else run(ph, ph + 1); }
        run(ph, ph + 1); }
}
```

```cpp
#include <hip/hip_runtime.h>
#include <cstdio>
#include <cstdint>

typedef unsigned short bf16;
constexpr int BATCH = 2, SEQ = 8192, D = 1024, M = BATCH * SEQ, NH = 16, HD = 64;
constexpr int NEXP = 32, EPG = 8, FE = 256;
constexpr int NREL = 257;
constexpr float RMS_EPS = 1e-6f;
constexpr float LOG2E = 1.4426950408889634f;
constexpr float C2 = 0.125f * LOG2E;

constexpr size_t MiB = 1u << 20;
constexpr size_t WS_CTL = 0;
constexpr size_t WS_XN = 86 * MiB;
constexpr size_t WS_BIG = 134 * MiB;
constexpr size_t WS_Q = WS_BIG, WS_K = WS_BIG + 32 * MiB, WS_V = WS_BIG + 64 * MiB;
constexpr size_t WS_Y2 = WS_BIG, WS_H = WS_BIG + 64 * MiB;
constexpr size_t WS_SLOC = WS_BIG, WS_G = WS_BIG + 32 * MiB;

__device__ __forceinline__ bf16 f2bf(float f) { unsigned u = __float_as_uint(f); return (bf16)((u + 0x7fffu + ((u >> 16) & 1u)) >> 16); }
__device__ __forceinline__ float bf2f(bf16 h) { return __uint_as_float(((unsigned)h) << 16); }
__device__ __forceinline__ float wave_sum(float v) {
#pragma unroll
    for (int o = 1; o < 64; o <<= 1) v += __shfl_xor(v, o);
    return v;
}
__device__ __forceinline__ float gelu_tanh(float x) { const float u = 0.7978845608028654f * (x + 0.044715f * x * x * x); return 0.5f * x * (1.f + tanhf(u)); }

__device__ __forceinline__ size_t xng_off(int t, int col) { const int b = t >> 13, tt = t & 8191, s = tt >> 4, j = tt & 15, g = col >> 4, c = col & 15; return ((size_t)(g * 1024 + b * 512 + s)) * 384 + j * 16 + c; }


#define LAS __attribute__((address_space(3)))
typedef short bf16x8 __attribute__((ext_vector_type(8)));
typedef short s16x4 __attribute__((ext_vector_type(4)));
typedef float f32x4 __attribute__((ext_vector_type(4)));
typedef float f32x16 __attribute__((ext_vector_type(16)));
typedef unsigned u32x4 __attribute__((ext_vector_type(4)));
typedef unsigned u32x2 __attribute__((ext_vector_type(2)));

constexpr int NWAVES = 8, NTHR = 512;
constexpr int CAP = 16384;
constexpr size_t CTL_ZERO_BYTES = 1 * MiB;
constexpr size_t WS_PDST = 1 * MiB, WS_PW = 3 * MiB, WS_PS = 5 * MiB, WS_SROW = 7 * MiB, WS_A16 = 7 * MiB + 65536;
constexpr size_t WS_TS = 7 * MiB + 131072;
constexpr size_t WS_RWT = 8 * MiB;
constexpr size_t WS_WQKV = 9 * MiB, WS_WO = 15 * MiB, WS_WOUT = 17 * MiB, WS_SSM = 21 * MiB;
constexpr size_t WS_WGU = 38 * MiB, WS_WD = 70 * MiB;
constexpr size_t WS_END = 230 * MiB;
constexpr int RW_PITCH = 1028, RW_LAYER = 36 * RW_PITCH;
constexpr int SSM_G_BYTES = 262144, SSM_A2_OFF = 65536;
constexpr int CW_BAR = 4096;
constexpr int CW_CNT = 65536;
constexpr int LDS_BYTES = 160 * 1024, MISC_OFF = LDS_BYTES - 512, AUX_OFF = 128 * 1024, RSCR_OFF = 36 * 1028 * 4;
constexpr int N_PHASES = 16;

__device__ __forceinline__ int lane_now() { int l; asm volatile("v_mbcnt_lo_u32_b32 %0, -1, 0\n\tv_mbcnt_hi_u32_b32 %0, -1, %0" : "=v"(l)); return l; }
__device__ __forceinline__ unsigned cvt_pk_bf16(float lo, float hi) { unsigned r; asm volatile("v_cvt_pk_bf16_f32 %0, %1, %2" : "=v"(r) : "v"(lo), "v"(hi)); return r; }
typedef float f32x2_t __attribute__((ext_vector_type(2))); typedef __bf16 bf16x2_t __attribute__((ext_vector_type(2)));
__device__ __forceinline__ unsigned cvtpk_s(float lo, float hi) { f32x2_t v = {lo, hi}; bf16x2_t b = __builtin_convertvector(v, bf16x2_t); return __builtin_bit_cast(unsigned, b); }
__device__ __forceinline__ unsigned pk2(float lo, float hi) { return (unsigned)f2bf(lo) | ((unsigned)f2bf(hi) << 16); }
#define LDS_WAIT() asm volatile("s_waitcnt lgkmcnt(0)" ::: "memory")
#define VM_WAIT() asm volatile("s_waitcnt vmcnt(0)" ::: "memory")
#define RLX_AGENT __ATOMIC_RELAXED, __HIP_MEMORY_SCOPE_AGENT

#define XB_TMO      128
#define XB_XCNT(j)  (256  + 64 * (j))
#define XB_XSUB(j)  (1280 + 64 * (j))
#define XB_XGEN(j)  (2304 + 64 * (j))
#define XB_TOP      3328
#define XB_TOPGEN   3392
#define XCD_BAR_WORDS 3456
#define XB_SPIN_CAP (1u << 18)
__device__ __forceinline__ unsigned xb_ld(unsigned* p)              { return __hip_atomic_load(p, __ATOMIC_RELAXED, __HIP_MEMORY_SCOPE_AGENT); }
__device__ __forceinline__ unsigned xb_add(unsigned* p, unsigned v) { return __hip_atomic_fetch_add(p, v, __ATOMIC_RELAXED, __HIP_MEMORY_SCOPE_AGENT); }
__device__ __forceinline__ unsigned xb_xcc_id() { return (unsigned)__builtin_amdgcn_s_getreg((3 << 11) | 20) & 0xFu; }
#define XB_SPIN(cond, bar) do { unsigned _sp = 0; while (cond) { __builtin_amdgcn_s_sleep(1); \
    if ((++_sp & 255u) == 0u) { if (xb_ld(&(bar)[XB_TMO])) break; if (_sp > XB_SPIN_CAP) { atomicAdd(&(bar)[XB_TMO], 1u); break; } } } } while (0)
struct XcdBarrier { unsigned* bar; unsigned x; volatile LAS unsigned* st; };
__device__ __forceinline__ XcdBarrier xcd_barrier_post(unsigned* bar, volatile LAS unsigned* st, int wid) {
    XcdBarrier b; b.bar = bar; b.x = xb_xcc_id(); b.st = st;
    if (wid == 0 && lane_now() == 0) (void)xb_add(&bar[XB_XCNT(b.x)], 1u);
    return b;
}
__device__ __forceinline__ void xcd_barrier_complete(unsigned* bar, unsigned x, unsigned& nloc, unsigned& nx) {
    const unsigned G = gridDim.x * gridDim.y * gridDim.z;
    unsigned sum, cnt, mine, sp = 0u;
    for (;;) {
        sum = 0u; cnt = 0u; mine = 0u;
#pragma unroll
        for (unsigned j = 0; j < 16; ++j) { const unsigned c = xb_ld(&bar[XB_XCNT(j)]); sum += c; cnt += (c > 0u) ? 1u : 0u; mine = (j == x) ? c : mine; }
        if (sum == G) break;
        __builtin_amdgcn_s_sleep(1);
        if ((++sp & 255u) == 0u) { if (xb_ld(&bar[XB_TMO])) break; if (sp > XB_SPIN_CAP) { atomicAdd(&bar[XB_TMO], 1u); break; } }
    }
    nloc = mine > 0u ? mine : 1u; nx = cnt > 0u ? cnt : 1u;
}
__device__ __forceinline__ void xcd_barrier(const XcdBarrier& b, int wid) {
    asm volatile("s_waitcnt vmcnt(0)" ::: "memory");
    __syncthreads();
    if (wid == 0 && lane_now() == 0) {
        unsigned* bar = b.bar;
        __builtin_amdgcn_s_waitcnt(0);
        unsigned nloc = b.st[0], nx = b.st[1];
        if (nloc == 0u) { xcd_barrier_complete(bar, b.x, nloc, nx); b.st[0] = nloc; b.st[1] = nx; }
        const unsigned old = xb_add(&bar[XB_XSUB(b.x)], 1u);
        const unsigned gen = old / nloc;
        if (old + 1u == (gen + 1u) * nloc) {
            __builtin_amdgcn_fence(__ATOMIC_RELEASE, "agent");
            asm volatile("s_waitcnt vmcnt(0)" ::: "memory");
            const unsigned og = xb_add(&bar[XB_TOP], 1u);
            const unsigned tg = og / nx;
            if (og + 1u == (tg + 1u) * nx) xb_add(&bar[XB_TOPGEN], 1u);
            else XB_SPIN(xb_ld(&bar[XB_TOPGEN]) == tg, bar);
            __builtin_amdgcn_fence(__ATOMIC_ACQUIRE, "agent");
            xb_add(&bar[XB_XGEN(b.x)], 1u);
            asm volatile("s_waitcnt vmcnt(0)" ::: "memory");
        } else {
            XB_SPIN(xb_ld(&bar[XB_XGEN(b.x)]) == gen, bar);
            __builtin_amdgcn_fence(__ATOMIC_ACQUIRE, "agent");
            asm volatile("s_waitcnt vmcnt(0)" ::: "memory");
        }
    }
    __syncthreads();
}

namespace gm {
constexpr int HTB = 16384;
__device__ __forceinline__ int lds_byte(int r, int c) { const int st = (r >> 4) * 2 + (c >> 5), rr = r & 15, cc = c & 31, ob = rr * 64 + cc * 2; return st * 1024 + (ob ^ (((ob >> 9) & 1) << 5)); }
__device__ __forceinline__ void stage_rc(int b, int& R, int& C) { const int st = b / 1024, sb = b % 1024, swz = sb ^ (((sb >> 9) & 1) << 5); R = (st >> 1) * 16 + swz / 64; C = (st & 1) * 32 + (swz % 64) / 2; }
__device__ __forceinline__ int perm32(int rho) { const int n = rho >> 4, i = rho & 15; return 8 * (i >> 2) + 4 * n + (i & 3); }
struct Unit { int pm, pn, e, gt, cnt; };
__device__ __forceinline__ bool static_unit(int i, int G, int c, int nM, int nN, Unit& u) {
    const int nwg = nM * nN; const long L = (long)i * G + c; if (L >= nwg) return false;
    int wgid = (int)L; { const int q = nwg / 8, r = nwg % 8, xcd = wgid % 8, off = wgid / 8; wgid = (xcd < r ? xcd * (q + 1) : r * (q + 1) + (xcd - r) * q) + off; }
    const int nig = 8 * nN, gid = wgid / nig, fm = gid * 8, gsz = (nM - fm) < 8 ? (nM - fm) : 8;
    u.pm = fm + ((wgid % nig) % gsz); u.pn = (wgid % nig) / gsz; u.e = 0; u.gt = 0; u.cnt = 0; return true;
}
template <class P> __device__ __forceinline__ void gemm_phase(LAS unsigned char* lds, const P& ph, int wid) {
    const int lane = lane_now(), tid = wid * 64 + lane, wr = wid >> 2, wc = wid & 3, fr = lane & 15, fq = lane >> 4;
    constexpr int nt = P::K / 64;
    static_assert(nt >= 2 && (nt % 2) == 0, "K must be a multiple of 128");
    unsigned voffA[2], voffB[2];
#pragma unroll
    for (int i = 0; i < 2; ++i) { int R, C; stage_rc(tid * 16 + i * 8192, R, C); const int Rb = (R & ~31) + perm32(R & 31); voffB[i] = (unsigned)(Rb * P::LDB + C) * 2u; voffA[i] = (unsigned)(R * P::LDA + C) * 2u; }
    const unsigned ldsw = (unsigned)wid * 1024u;
    const int aoff = lds_byte(wr * 64 + fr, fq * 8), boff = lds_byte(wc * 32 + fr, fq * 8);
    constexpr int hB = P::HSTEPB, hA = 128 * P::LDA * 2;
#define G_SA(b, h) (((b) * 2 + (h)) * gm::HTB)
#define G_SB(b, h) ((4 + (b) * 2 + (h)) * gm::HTB)
#define G_GLDS(src, bufoff, i) __builtin_amdgcn_global_load_lds((const unsigned*)(src), (LAS unsigned*)(lds + (bufoff) + ldsw + (i) * 8192), 16, 0, 0)
#define G_STA(bufoff, ptr, kb, offs, h) do { if constexpr (P::GATHER) { _Pragma("unroll") for (int _i = 0; _i < 2; ++_i) G_GLDS(Ab + (kb) + (offs)[h][_i], bufoff, _i); } \
        else { _Pragma("unroll") for (int _i = 0; _i < 2; ++_i) G_GLDS((ptr) + (h) * hA + voffA[_i], bufoff, _i); } } while (0)
#define G_STB(bufoff, ptr) do { _Pragma("unroll") for (int _i = 0; _i < 2; ++_i) G_GLDS((ptr) + voffB[_i], bufoff, _i); } while (0)
#define G_LDA(dst, b, h) do { _Pragma("unroll") for (int m = 0; m < 4; ++m) _Pragma("unroll") for (int k = 0; k < 2; ++k) dst[m][k] = *(const LAS bf16x8*)(lds + G_SA(b, h) + aoff + m * 2048 + k * 1024); } while (0)
#define G_LDB(dst, b, h) do { _Pragma("unroll") for (int n = 0; n < 2; ++n) _Pragma("unroll") for (int k = 0; k < 2; ++k) dst[n][k] = *(const LAS bf16x8*)(lds + G_SB(b, h) + boff + n * 2048 + k * 1024); } while (0)
#define G_MMA(ai, bj, At, Bt) do { __builtin_amdgcn_s_setprio(1); _Pragma("unroll") for (int m = 0; m < 4; ++m) _Pragma("unroll") for (int n = 0; n < 2; ++n) _Pragma("unroll") for (int k = 0; k < 2; ++k) \
        acc[ai][bj][m][n] = __builtin_amdgcn_mfma_f32_16x16x32_bf16(Bt[n][k], At[m][k], acc[ai][bj][m][n], 0, 0, 0); __builtin_amdgcn_s_setprio(0); } while (0)
#define G_WAIT_V(n) asm volatile("s_waitcnt vmcnt(" #n ")" ::: "memory")
#define G_WAIT_L(n) asm volatile("s_waitcnt lgkmcnt(" #n ")" ::: "memory")
#define G_BAR __builtin_amdgcn_s_barrier()
#define G_SCHED __builtin_amdgcn_sched_barrier(0)
    Unit cur, nxt; int ui = 0;
    if (!ph.next(0, cur)) return;
    f32x4 acc[2][2][4][2];
#pragma unroll
    for (int a = 0; a < 2; ++a)
#pragma unroll
        for (int b = 0; b < 2; ++b)
#pragma unroll
            for (int m = 0; m < 4; ++m)
#pragma unroll
                for (int n = 0; n < 2; ++n) acc[a][b][m][n] = (f32x4){0.f, 0.f, 0.f, 0.f};
    bf16x8 At[4][2], B0[2][2], B1[2][2];
    unsigned co[2][2] = {{0u, 0u}, {0u, 0u}};
    const char* Ab = ph.Abase;
    const char* cA = Ab; const char* cB = ph.b_tile(cur);
    if constexpr (P::GATHER) { ph.a_offs(cur, tid, co); asm volatile("s_waitcnt vmcnt(0)" ::: "memory"); } else cA = ph.a_tile(cur);
    G_STB(G_SB(0, 0), cB); G_STB(G_SB(0, 1), cB + hB); G_STA(G_SA(0, 0), cA, 0, co, 0); G_STA(G_SA(0, 1), cA, 0, co, 1);
    if (wr == 1) G_BAR;
    G_WAIT_V(2); G_BAR;
    G_STB(G_SB(1, 0), cB + 128); G_STA(G_SA(1, 0), cA + 128, 128, co, 0); G_STB(G_SB(1, 1), cB + hB + 128);
    G_WAIT_V(6); G_BAR;
    for (;;) {
        const bool has_next = ph.next(ui + 1, nxt);
        const char* nA = cA; const char* nB = cB;
        if (has_next) { nB = ph.b_tile(nxt); if constexpr (!P::GATHER) nA = ph.a_tile(nxt); }
        for (int t = 0; t < nt; t += 2) {
            const bool last = (t == nt - 2);
            const int kb1 = (t + 1) * 128, kb2 = last ? 0 : (t + 2) * 128, kb3 = kb2 + 128;
            const char* a1 = cA + kb1; const char* a2 = last ? nA : cA + kb2; const char* a3 = a2 + 128;
            const char* b2 = last ? nB : cB + (t + 2) * 128; const char* b3 = b2 + 128;
            G_LDB(B0, 0, 0); G_LDB(B1, 0, 1); G_SCHED; G_LDA(At, 0, 0); G_STA(G_SA(1, 1), a1, kb1, co, 1);
            G_WAIT_V(8); G_WAIT_L(0); G_BAR; G_MMA(0, 0, At, B0); G_MMA(0, 1, At, B1); G_BAR; G_SCHED;
            if constexpr (P::GATHER) { if (last && has_next) ph.a_offs(nxt, tid, co); }
            G_LDA(At, 0, 1); G_STB(G_SB(0, 0), b2); G_STB(G_SB(0, 1), b2 + hB); G_STA(G_SA(0, 0), a2, kb2, co, 0);
            G_WAIT_V(8); G_WAIT_L(0); G_BAR; G_MMA(1, 0, At, B0); G_MMA(1, 1, At, B1); G_BAR; G_SCHED;
            G_LDB(B0, 1, 0); G_LDB(B1, 1, 1); G_SCHED; G_LDA(At, 1, 0); G_STA(G_SA(0, 1), a2, kb2, co, 1);
            G_WAIT_V(8); G_WAIT_L(0); G_BAR; G_MMA(0, 0, At, B0); G_MMA(0, 1, At, B1); G_BAR; G_SCHED;
            G_LDA(At, 1, 1); G_STB(G_SB(1, 0), b3); G_STB(G_SB(1, 1), b3 + hB); G_STA(G_SA(1, 0), a3, kb3, co, 0);
            G_WAIT_V(8); G_WAIT_L(0); G_BAR; G_MMA(1, 0, At, B0); G_MMA(1, 1, At, B1); G_BAR; G_SCHED;
        }
        if (wr == 0) G_BAR;
        ph.epi(acc, cur, wr, wc, fr, fq);
        if (!has_next) break;
#pragma unroll
        for (int a = 0; a < 2; ++a)
#pragma unroll
            for (int b = 0; b < 2; ++b)
#pragma unroll
                for (int m = 0; m < 4; ++m)
#pragma unroll
                    for (int n = 0; n < 2; ++n) acc[a][b][m][n] = (f32x4){0.f, 0.f, 0.f, 0.f};
        cur = nxt; cA = nA; cB = nB; ++ui;
        if (wr == 1) G_BAR;
    }
    G_WAIT_V(0);
    G_BAR;
}
}

using gm::Unit;
#define EPI_ARGS const f32x4 (&acc)[2][2][4][2], const Unit& u, int wr, int wc, int fr_in, int fq_in
#define EPI_OPAQUE int fr = fr_in, fq = fq_in; asm volatile("" : "+v"(fr), "+v"(fq));
#define NO_GATHER __device__ __forceinline__ void a_offs(const Unit&, int, unsigned (&)[2][2]) const {}
#define EPI_FENCE() asm volatile("" ::: "memory")
__device__ __forceinline__ u32x4 pack8(const f32x4& v0, const f32x4& v1) { u32x4 w; w.x = cvt_pk_bf16(v0[0], v0[1]); w.y = cvt_pk_bf16(v0[2], v0[3]); w.z = cvt_pk_bf16(v1[0], v1[1]); w.w = cvt_pk_bf16(v1[2], v1[3]); return w; }
__device__ __forceinline__ float fast_sigmoid(float v) { return __builtin_amdgcn_rcpf(1.f + __builtin_amdgcn_exp2f(-LOG2E * v)); }
__device__ __forceinline__ float fast_gelu(float v) { const float u2 = 1.5957691216057308f * (v + 0.044715f * v * v * v); return v * fast_sigmoid(u2); }

struct PhQKV {
    static constexpr bool GATHER = false; static constexpr int LDA = 1024, K = 1024, LDB = 1024, HSTEPB = 128 * 1024 * 2;
    unsigned char* ws; const char* Abase; int G, c;
    __device__ __forceinline__ bool next(int i, Unit& u) const { return gm::static_unit(i, G, c, M / 256, 12, u); }
    NO_GATHER __device__ __forceinline__ const char* a_tile(const Unit& u) const { return Abase + (size_t)(u.pm * 256) * 1024 * 2; }
    __device__ __forceinline__ const char* b_tile(const Unit& u) const { return (const char*)(ws + WS_WQKV) + (size_t)u.pn * 256 * 1024 * 2; }
    __device__ __forceinline__ void epi(EPI_ARGS) const { EPI_OPAQUE
        const int row0 = u.pm * 256 + wr * 64 + fr; const int t = u.pn >> 2; const int colt = (u.pn & 3) * 256;
        bf16* base = (bf16*)(ws + WS_Q) + (size_t)t * (16u * 1024u * 1024u); const float sc = (t == 0) ? C2 : 1.f;
        const int col0 = colt + wc * 32 + 8 * fq;
#pragma unroll
        for (int ai = 0; ai < 2; ++ai)
#pragma unroll
            for (int m = 0; m < 4; ++m) { bf16* rowp = base + (size_t)(row0 + ai * 128 + m * 16) * 1024 + col0;
#pragma unroll
                for (int bj = 0; bj < 2; ++bj) *(u32x4*)(rowp + bj * 128) = pack8(acc[ai][bj][m][0] * sc, acc[ai][bj][m][1] * sc); }
    }
};
struct PhWo {
    static constexpr bool GATHER = false; static constexpr int LDA = 1024, K = 1024, LDB = 1024, HSTEPB = 128 * 1024 * 2;
    unsigned char* ws; const char* Abase; const float* resid; float* out; int G, c;
    __device__ __forceinline__ bool next(int i, Unit& u) const { return gm::static_unit(i, G, c, M / 256, 4, u); }
    NO_GATHER __device__ __forceinline__ const char* a_tile(const Unit& u) const { return Abase + (size_t)(u.pm * 256) * 1024 * 2; }
    __device__ __forceinline__ const char* b_tile(const Unit& u) const { return (const char*)(ws + WS_WO) + (size_t)u.pn * 256 * 1024 * 2; }
    __device__ __forceinline__ void epi(EPI_ARGS) const { EPI_OPAQUE
        const size_t off0 = (size_t)(u.pm * 256 + wr * 64 + fr) * 1024 + u.pn * 256 + wc * 32 + 8 * fq; bf16* hb = (bf16*)out;
#pragma unroll
        for (int ai = 0; ai < 2; ++ai) { f32x4 r[4][2][2];
#pragma unroll
            for (int m = 0; m < 4; ++m)
#pragma unroll
                for (int bj = 0; bj < 2; ++bj) { const float* p = resid + off0 + (size_t)(ai * 128 + m * 16) * 1024 + bj * 128; r[m][bj][0] = *(const f32x4*)p; r[m][bj][1] = *(const f32x4*)(p + 4); }
            EPI_FENCE();
#pragma unroll
            for (int m = 0; m < 4; ++m)
#pragma unroll
                for (int bj = 0; bj < 2; ++bj) { const size_t off = off0 + (size_t)(ai * 128 + m * 16) * 1024 + bj * 128; const f32x4 v0 = acc[ai][bj][m][0] + r[m][bj][0], v1 = acc[ai][bj][m][1] + r[m][bj][1];
                    *(u32x4*)(hb + off) = pack8(v0, v1); }
            EPI_FENCE(); }
    }
};
struct PhWout {
    static constexpr bool GATHER = false; static constexpr int LDA = 1024, K = 1024, LDB = 1024, HSTEPB = 128 * 1024 * 2;
    unsigned char* ws; const char* Abase; float* out; int G, c;
    __device__ __forceinline__ bool next(int i, Unit& u) const { return gm::static_unit(i, G, c, M / 256, 8, u); }
    NO_GATHER __device__ __forceinline__ const char* a_tile(const Unit& u) const { return Abase + (size_t)(u.pm * 256) * 1024 * 2; }
    __device__ __forceinline__ const char* b_tile(const Unit& u) const { return (const char*)(ws + WS_WOUT) + (size_t)u.pn * 256 * 1024 * 2; }
    __device__ __forceinline__ void epi(EPI_ARGS) const { EPI_OPAQUE
        const size_t off0 = (size_t)(u.pm * 256 + wr * 64 + fr) * 1024 + u.pn * 128 + wc * 32 + 8 * fq; bf16* hb = (bf16*)(ws + WS_XN); const bf16* rs = (const bf16*)out + (size_t)M * D;
        u32x4 r[2][4];
#pragma unroll
        for (int ai = 0; ai < 2; ++ai)
#pragma unroll
            for (int m = 0; m < 4; ++m) r[ai][m] = *(const u32x4*)(rs + off0 + (size_t)(ai * 128 + m * 16) * 1024);
        EPI_FENCE();
#pragma unroll
        for (int ai = 0; ai < 2; ++ai)
#pragma unroll
            for (int m = 0; m < 4; ++m) { const size_t off = off0 + (size_t)(ai * 128 + m * 16) * 1024; f32x4 v0, v1;
#pragma unroll
                for (int j = 0; j < 4; ++j) { const unsigned w0 = r[ai][m][j >> 1], w1 = r[ai][m][2 + (j >> 1)];
                    const float r0 = __uint_as_float((j & 1) ? (w0 & 0xffff0000u) : (w0 << 16)), r1 = __uint_as_float((j & 1) ? (w1 & 0xffff0000u) : (w1 << 16));
                    v0[j] = r0 + acc[ai][0][m][0][j] * fast_sigmoid(acc[ai][1][m][0][j]); v1[j] = r1 + acc[ai][0][m][1][j] * fast_sigmoid(acc[ai][1][m][1][j]); }
                *(u32x4*)(hb + off) = pack8(v0, v1); }
        EPI_FENCE();
    }
};
constexpr int MT_NN = 65, MT_NS = 66, MT_NLIST = 128, MT_SLIST = 384, SMALL_ROWS = 128;
__device__ __forceinline__ void moe_decode(LAS unsigned char* lds, int code, Unit& u) { const LAS int* cn = (const LAS int*)(lds + AUX_OFF); u.e = code >> 8; u.pm = code & 255; u.gt = cn[32 + u.e] + u.pm; u.cnt = cn[u.e]; }
__device__ __forceinline__ void moe_tables(LAS unsigned char* lds, const unsigned* cntg, int tid) {
    LAS int* cn = (LAS int*)(lds + AUX_OFF); LAS int* tb = cn + 32;
    if (tid < 64) {
        const int e = tid & 31; const unsigned cu = __hip_atomic_load(cntg + e * 64, RLX_AGENT); const int c = cu < (unsigned)CAP ? (int)cu : CAP;
        const int n = (c + 255) >> 8; const int lastrows = c - 256 * (n - 1); const int small = (n > 0 && lastrows <= SMALL_ROWS) ? 1 : 0; const int nnorm = n - small;
        int pt = n, pn_ = nnorm, ps_ = small;
#pragma unroll
        for (int o = 1; o < 32; o <<= 1) { const int a = __shfl_up(pt, o, 32), b = __shfl_up(pn_, o, 32), d = __shfl_up(ps_, o, 32); if (e >= o) { pt += a; pn_ += b; ps_ += d; } }
        if (tid < 32) { cn[e] = c; tb[e] = pt - n;
            for (int pm = 0; pm < nnorm; ++pm) cn[MT_NLIST + (pn_ - nnorm) + pm] = (e << 8) | pm;
            if (small) cn[MT_SLIST + ps_ - 1] = (e << 8) | (n - 1);
            if (e == 31) { tb[32] = pt; cn[MT_NN] = pn_; cn[MT_NS] = ps_; } }
    }
    __syncthreads();
}
template <bool GU> __device__ __forceinline__ void tail_job(unsigned char* ws, const bf16* __restrict__ Xbase, const Unit& u, int ns, int wid) {
    const int lane = lane_now(), fr = lane & 15, fq = lane >> 4, w = wid;
    constexpr int K = GU ? 1024 : 256, NG = GU ? 2 : 4;
    const int slot0 = u.pm * 256, rows = u.cnt - slot0;
    if (16 * w >= rows) return;
    const int* pdst = (const int*)(ws + WS_PDST) + u.e * CAP + slot0;
    int r = 16 * w + fr; const bool valid = r < rows; r = valid ? r : rows - 1;
    const int dst = pdst[r];
    const bf16* xp = (GU ? Xbase + (size_t)(dst >> 1) * 1024 : Xbase + ((size_t)u.gt * 256 + r) * 256) + 8 * fq;
    const bf16* wp[NG];
#pragma unroll
    for (int n = 0; n < NG; ++n) wp[n] = GU ? (const bf16*)(ws + WS_WGU) + ((size_t)u.e * 512 + 256 * (ns >> 3) + 128 * n + 16 * (ns & 7) + fr) * 1024 + 8 * fq
                                             : (const bf16*)(ws + WS_WD) + ((size_t)u.e * 1024 + 64 * ns + 16 * n + fr) * 256 + 8 * fq;
    f32x4 acc[NG];
#pragma unroll
    for (int n = 0; n < NG; ++n) acc[n] = (f32x4){0.f, 0.f, 0.f, 0.f};
#pragma unroll 8
    for (int ks = 0; ks < K / 32; ++ks) { const bf16x8 xf = *(const bf16x8*)(xp + 32 * ks); bf16x8 wf[NG];
#pragma unroll
        for (int n = 0; n < NG; ++n) wf[n] = *(const bf16x8*)(wp[n] + 32 * ks);
#pragma unroll
        for (int n = 0; n < NG; ++n) acc[n] = __builtin_amdgcn_mfma_f32_16x16x32_bf16(wf[n], xf, acc[n], 0, 0, 0); }
    if (valid) {
        if (GU) { const float sc = ((const float*)(ws + WS_PS))[u.e * CAP + slot0 + r]; float v[4];
#pragma unroll
            for (int j = 0; j < 4; ++j) { const float gg = acc[0][j] * sc, uu = acc[NG - 1][j] * sc; v[j] = gg * fast_sigmoid(gg) * uu; }
            u32x2 o; o.x = cvt_pk_bf16(v[0], v[1]); o.y = cvt_pk_bf16(v[2], v[3]);
            *(u32x2*)((bf16*)(ws + WS_H) + ((size_t)u.gt * 256 + r) * 256 + 16 * ns + 4 * fq) = o; }
        else { const float wt = ((const float*)(ws + WS_PW))[u.e * CAP + slot0 + r];
#pragma unroll
            for (int n = 0; n < NG; ++n) { u32x2 o; o.x = cvt_pk_bf16(acc[n][0] * wt, acc[n][1] * wt); o.y = cvt_pk_bf16(acc[n][2] * wt, acc[n][3] * wt);
                *(u32x2*)((bf16*)(ws + WS_Y2) + (size_t)dst * 1024 + 64 * ns + 16 * n + 4 * fq) = o; } } }
}
struct PhGateUp {
    static constexpr bool GATHER = true; static constexpr int LDA = 1024, K = 1024, LDB = 1024, HSTEPB = 128 * 1024 * 2;
    unsigned char* ws; const char* Abase; LAS unsigned char* lds; int G, c, nn;
    __device__ __forceinline__ bool next(int i, Unit& u) const { const int idx = i * G + c; if (idx >= 2 * nn) return false; u.pn = idx & 1; moe_decode(lds, ((const LAS int*)(lds + AUX_OFF))[MT_NLIST + (idx >> 1)], u); return true; }
    __device__ __forceinline__ void a_offs(const Unit& u, int tid, unsigned (&o)[2][2]) const { const int* pdst = (const int*)(ws + WS_PDST);
#pragma unroll
        for (int i = 0; i < 2; ++i) { int R, C; gm::stage_rc(tid * 16 + i * 8192, R, C);
#pragma unroll
            for (int h = 0; h < 2; ++h) { int slot = u.pm * 256 + 128 * h + R; slot = slot < u.cnt ? slot : u.cnt - 1; const int tok = pdst[u.e * CAP + slot] >> 1; o[h][i] = (unsigned)(tok * 1024 + C) * 2u; } }
    }
    __device__ __forceinline__ const char* a_tile(const Unit&) const { return Abase; }
    __device__ __forceinline__ const char* b_tile(const Unit& u) const { return (const char*)(ws + WS_WGU) + ((size_t)u.e * 512 + u.pn * 256) * 1024 * 2; }
    __device__ __forceinline__ void epi(EPI_ARGS) const { EPI_OPAQUE
        const int r0 = wr * 64 + fr, col0 = u.pn * 128 + wc * 32 + 8 * fq; const float* ps = (const float*)(ws + WS_PS) + u.e * CAP; bf16* H = (bf16*)(ws + WS_H);
        float sv[2][4];
#pragma unroll
        for (int ai = 0; ai < 2; ++ai)
#pragma unroll
            for (int m = 0; m < 4; ++m) { int slot = u.pm * 256 + r0 + ai * 128 + m * 16; slot = slot < u.cnt ? slot : u.cnt - 1; sv[ai][m] = ps[slot]; }
        EPI_FENCE();
#pragma unroll
        for (int ai = 0; ai < 2; ++ai)
#pragma unroll
            for (int m = 0; m < 4; ++m) { const int r = r0 + ai * 128 + m * 16; const float s = sv[ai][m];
                f32x4 v0, v1;
#pragma unroll
                for (int j = 0; j < 4; ++j) { const float g0 = acc[ai][0][m][0][j] * s, u0 = acc[ai][1][m][0][j] * s, g1 = acc[ai][0][m][1][j] * s, u1 = acc[ai][1][m][1][j] * s;
                    v0[j] = g0 * fast_sigmoid(g0) * u0; v1[j] = g1 * fast_sigmoid(g1) * u1; }
                *(u32x4*)(H + ((size_t)u.gt * 256 + r) * 256 + col0) = pack8(v0, v1); }
        EPI_FENCE();
    }
};
struct PhDown {
    static constexpr bool GATHER = false; static constexpr int LDA = 256, K = 256, LDB = 256, HSTEPB = 128 * 256 * 2;
    unsigned char* ws; const char* Abase; LAS unsigned char* lds; int G, c, nn;
    __device__ __forceinline__ bool next(int i, Unit& u) const { const int idx = i * G + c; if (idx >= 4 * nn) return false; u.pn = idx & 3; moe_decode(lds, ((const LAS int*)(lds + AUX_OFF))[MT_NLIST + (idx >> 2)], u); return true; }
    NO_GATHER __device__ __forceinline__ const char* a_tile(const Unit& u) const { return Abase + (size_t)(u.gt * 256) * 256 * 2; }
    __device__ __forceinline__ const char* b_tile(const Unit& u) const { return (const char*)(ws + WS_WD) + ((size_t)u.e * 1024 + u.pn * 256) * 256 * 2; }
    __device__ __forceinline__ void epi(EPI_ARGS) const { EPI_OPAQUE
        const int r0 = u.pm * 256 + wr * 64 + fr, col0 = u.pn * 256 + wc * 32 + 8 * fq; const int* pdst = (const int*)(ws + WS_PDST) + u.e * CAP; const float* pw = (const float*)(ws + WS_PW) + u.e * CAP; bf16* Y2 = (bf16*)(ws + WS_Y2);
        int slot = r0 < u.cnt ? r0 : u.cnt - 1; int dn = pdst[slot]; float wn = pw[slot];
#pragma unroll
        for (int g = 0; g < 8; ++g) { const int ai = g >> 2, m = g & 3; const int dcur = dn; const float wcur = wn;
            if (g < 7) { int s2 = r0 + ((g + 1) >> 2) * 128 + ((g + 1) & 3) * 16; s2 = s2 < u.cnt ? s2 : u.cnt - 1; dn = pdst[s2]; wn = pw[s2]; }
            if (r0 + ai * 128 + m * 16 < u.cnt) { bf16* yp = Y2 + (size_t)dcur * 1024 + col0;
#pragma unroll
                for (int bj = 0; bj < 2; ++bj) *(u32x4*)(yp + bj * 128) = pack8(acc[ai][bj][m][0] * wcur, acc[ai][bj][m][1] * wcur); }
            EPI_FENCE(); }
    }
};
struct PhSloc {
    static constexpr bool GATHER = false; static constexpr int LDA = 384, K = 256, LDB = 256, HSTEPB = 0;
    unsigned char* ws; const char* Abase; int G, c;
    __device__ __forceinline__ bool next(int i, Unit& u) const { const int idx = i * G + c; if (idx >= 256) return false; u.e = idx >> 2; u.pm = idx & 3; u.pn = 0; u.gt = 0; u.cnt = 0; return true; }
    NO_GATHER __device__ __forceinline__ const char* a_tile(const Unit& u) const { return Abase + (size_t)(u.e * 1024 + u.pm * 256) * 384 * 2; }
    __device__ __forceinline__ const char* b_tile(const Unit& u) const { return (const char*)(ws + WS_SSM) + (size_t)u.e * SSM_G_BYTES; }
    __device__ __forceinline__ void epi(EPI_ARGS) const { EPI_OPAQUE
        const int r0 = u.e * 1024 + u.pm * 256 + wr * 64 + fr, col0 = wc * 32 + 8 * fq; float* Sloc = (float*)(ws + WS_SLOC);
#pragma unroll
        for (int ai = 0; ai < 2; ++ai)
#pragma unroll
            for (int m = 0; m < 4; ++m) { float* p = Sloc + (size_t)(r0 + ai * 128 + m * 16) * 128 + col0; *(f32x4*)p = acc[ai][0][m][0]; *(f32x4*)(p + 4) = acc[ai][0][m][1]; }
    }
};
struct PhY {
    static constexpr bool GATHER = false; static constexpr int LDA = 384, K = 384, LDB = 384, HSTEPB = 128 * 384 * 2;
    unsigned char* ws; const char* Abase; int G, c;
    __device__ __forceinline__ bool next(int i, Unit& u) const { const int idx = i * G + c; if (idx >= 256) return false; u.e = idx >> 2; u.pm = idx & 3; u.pn = 0; u.gt = 0; u.cnt = 0; return true; }
    NO_GATHER __device__ __forceinline__ const char* a_tile(const Unit& u) const { return Abase + (size_t)(u.e * 1024 + u.pm * 256) * 384 * 2; }
    __device__ __forceinline__ const char* b_tile(const Unit& u) const { return (const char*)(ws + WS_SSM) + (size_t)u.e * SSM_G_BYTES + SSM_A2_OFF; }
    __device__ __forceinline__ void epi(EPI_ARGS) const { EPI_OPAQUE
        const int nb = (u.pm & 1) * 256 + wr * 64 + fr;
        bf16* p = (bf16*)(ws + WS_G) + ((size_t)(u.pm >> 1) * SEQ + 16 * nb + 2 * wc + (fq >> 1)) * 1024 + 16 * u.e + 8 * (fq & 1);
#pragma unroll
        for (int ai = 0; ai < 2; ++ai)
#pragma unroll
            for (int m = 0; m < 4; ++m) {
#pragma unroll
                for (int bj = 0; bj < 2; ++bj) { f32x4 v0, v1;
#pragma unroll
                    for (int j = 0; j < 4; ++j) { v0[j] = fast_gelu(acc[ai][bj][m][0][j]); v1[j] = fast_gelu(acc[ai][bj][m][1][j]); }
                    *(u32x4*)(p + bj * 8 * 1024) = pack8(v0, v1); }
                p += (m == 3 ? (128 - 48) : 16) * 16 * 1024; asm volatile("" : "+v"(p) :: "memory"); }
    }
};

namespace at {
constexpr int NSLOT = 4, SLOTB = 8192;
constexpr int LDS_K = 0, LDS_V = NSLOT * SLOTB, LDS_WS = 2 * NSLOT * SLOTB, LDS_TBL = LDS_WS + 2048, LDS_OST = LDS_TBL + 2048, LDS_TOTAL = LDS_OST + 8 * 4096;
typedef short v4i16_t __attribute__((ext_vector_type(4)));
__device__ __forceinline__ int crow(int r, int hi) { return (r & 3) + 8 * (r >> 2) + 4 * hi; }
__device__ __forceinline__ void glds16(const void* gsrc, unsigned lds_dst) { unsigned keep;
    asm volatile("s_mov_b32 %0, m0\n\ts_mov_b32 m0, %2\n\ts_nop 0\n\tglobal_load_lds_dwordx4 %1, off\n\ts_mov_b32 m0, %0" : "=&s"(keep) : "v"(gsrc), "s"(lds_dst) : "memory"); }
__device__ __forceinline__ s16x4 vtr(const LAS unsigned char* p) { return __builtin_bit_cast(s16x4, __builtin_amdgcn_ds_read_tr16_b64_v4i16((LAS v4i16_t*)p)); }
#define AT_WAIT_BAR(N) asm volatile("s_waitcnt vmcnt(" #N ") lgkmcnt(0)\n\ts_barrier" ::: "memory")
template <int THR> __device__ __forceinline__ void attn_unit(int b, int h, int qb, const bf16* Q, const bf16* __restrict__ K, const bf16* __restrict__ V, bf16* O, const float* __restrict__ relb, LAS unsigned char* shm, int wid) {
    const int lane = lane_now(), tid = wid * 64 + lane, r32 = lane & 31, hi = lane >> 5;
    const long rowbase = (long)b * SEQ; const int q0 = qb * 256; const int cq = 4 * qb + (wid >> 1);
    const bf16* Qw = Q + (rowbase + q0 + wid * 32) * D + h * 64;
    const unsigned lds0 = (unsigned)(uintptr_t)shm;
    LAS float* wsf = (LAS float*)(shm + LDS_WS) + wid * 64; LAS float* tbl = (LAS float*)(shm + LDS_TBL);
    const int kc_lo = (4 * qb - 8) < 0 ? 0 : (4 * qb - 8); const int NT = 4 * qb + 3 - kc_lo + 1;
    const int ta = ((cq - 8) < kc_lo ? kc_lo : (cq - 8)) - kc_lo, tb_ = cq - kc_lo;
    if (tid < 320) tbl[tid] = relb[h * NREL + (tid < 256 ? tid : 256)] * LOG2E;
    const bf16* ksrc = K + (rowbase + kc_lo * 64 + lane) * D + h * 64 + wid * 8;
    const bf16* vsrc = V + (rowbase + kc_lo * 64 + 16 * (wid & 3) + (lane >> 2)) * D + h * 64 + (wid >> 2) * 32 + (lane & 3) * 8;
    const unsigned kdst = lds0 + LDS_K + wid * 1024, vdst = lds0 + LDS_V + wid * 1024;
#define AT_DMA(t) do { const unsigned so_ = (unsigned)((t) & 3) * SLOTB; glds16(ksrc + (long)(t) * 64 * D, (unsigned)__builtin_amdgcn_readfirstlane(kdst + so_)); glds16(vsrc + (long)(t) * 64 * D, (unsigned)__builtin_amdgcn_readfirstlane(vdst + so_)); } while (0)
    bf16x8 qr[4];
#pragma unroll
    for (int d0 = 0; d0 < 4; ++d0) qr[d0] = *reinterpret_cast<const bf16x8*>(&Qw[(long)r32 * D + d0 * 16 + hi * 8]);
    AT_DMA(0); AT_DMA(1); AT_DMA(2);
    asm volatile("" : "+v"(qr[0]), "+v"(qr[1]), "+v"(qr[2]), "+v"(qr[3]));
    float mrow = -1e30f, lsum = 0.f; f32x16 o[2]; o[0] = f32x16{}; o[1] = f32x16{};
    f32x16 s0 = f32x16{}, s1 = f32x16{};
    f32x16 cfar = f32x16{};
    const int qoff = 32 * (wid & 1) + r32 + 128 - 4 * hi;
#define AT_CINIT(P0, P1, kc_, msub_) do { const int delta_ = cq - (kc_); \
        if (delta_ >= 3) { P0 = cfar; P1 = cfar; } \
        else { const LAS float* tb = tbl + (64 * delta_ + qoff); _Pragma("unroll") for (int r = 0; r < 16; ++r) { const int kj = (r & 3) + 8 * (r >> 2); P0[r] = tb[-kj] - (msub_); P1[r] = tb[-kj - 32] - (msub_); } } } while (0)
#define AT_KLOAD(t_) do { const LAS unsigned char* kp = shm + LDS_K + ((t_) & 3) * SLOTB + hi * 1024 + r32 * 16; \
        _Pragma("unroll") for (int d0 = 0; d0 < 4; ++d0) { kf[2 * d0] = *(const LAS bf16x8*)(kp + d0 * 2048); kf[2 * d0 + 1] = *(const LAS bf16x8*)(kp + d0 * 2048 + 512); } } while (0)
#define AT_QK(P0, P1) do { _Pragma("unroll") for (int d0 = 0; d0 < 4; ++d0) { \
            P0 = __builtin_amdgcn_mfma_f32_32x32x16_bf16(kf[2 * d0], qr[d0], P0, 0, 0, 0); P1 = __builtin_amdgcn_mfma_f32_32x32x16_bf16(kf[2 * d0 + 1], qr[d0], P1, 0, 0, 0); } } while (0)
#define AT_CFAR() do { const float c0_ = tbl[256] - mrow; _Pragma("unroll") for (int r = 0; r < 16; ++r) cfar[r] = c0_; } while (0)
#define AT_STATS() do { float ra = fmaxf(fmaxf(s0[0], s0[1]), s1[0]), rb2 = fmaxf(fmaxf(s0[2], s0[3]), s1[1]); ra = fmaxf(fmaxf(ra, s1[2]), s1[3]); \
        _Pragma("unroll") for (int r = 4; r < 16; r += 4) { ra = fmaxf(fmaxf(ra, s0[r]), s0[r + 1]); rb2 = fmaxf(fmaxf(rb2, s0[r + 2]), s0[r + 3]); ra = fmaxf(fmaxf(ra, s1[r]), s1[r + 1]); rb2 = fmaxf(fmaxf(rb2, s1[r + 2]), s1[r + 3]); } \
        float rm = fmaxf(ra, rb2); { auto rr = __builtin_amdgcn_permlane32_swap(__float_as_uint(rm), __float_as_uint(rm), false, false); rm = fmaxf(__uint_as_float(rr[0]), __uint_as_float(rr[1])); } \
        if (mrow < -1e29f) { mrow = rm; _Pragma("unroll") for (int r = 0; r < 16; ++r) { s0[r] -= rm; s1[r] -= rm; } AT_CFAR(); } \
        else if (__any(rm > (float)THR)) { const float dl = fmaxf(rm, 0.f), f = __builtin_amdgcn_exp2f(-dl); mrow += dl; lsum *= f; \
            if (hi == 0) wsf[r32] = f; LDS_WAIT(); \
            _Pragma("unroll") for (int r = 0; r < 16; ++r) { const float fr_ = wsf[crow(r, hi)]; o[0][r] *= fr_; o[1][r] *= fr_; s0[r] -= dl; s1[r] -= dl; } AT_CFAR(); } } while (0)
#define AT_EXP_PACK() float sacc = 0.f, sacc2 = 0.f; \
        _Pragma("unroll") for (int r = 0; r < 16; ++r) { s0[r] = __builtin_amdgcn_exp2f(s0[r]); s1[r] = __builtin_amdgcn_exp2f(s1[r]); sacc += s0[r]; sacc2 += s1[r]; } \
        lsum += sacc + sacc2; \
        const u32x4 pw0 = (u32x4){cvtpk_s(s0[0], s0[1]), cvtpk_s(s0[2], s0[3]), cvtpk_s(s0[4], s0[5]), cvtpk_s(s0[6], s0[7])}; \
        const u32x4 pw1 = (u32x4){cvtpk_s(s0[8], s0[9]), cvtpk_s(s0[10], s0[11]), cvtpk_s(s0[12], s0[13]), cvtpk_s(s0[14], s0[15])}; \
        const u32x4 pw2 = (u32x4){cvtpk_s(s1[0], s1[1]), cvtpk_s(s1[2], s1[3]), cvtpk_s(s1[4], s1[5]), cvtpk_s(s1[6], s1[7])}; \
        const u32x4 pw3 = (u32x4){cvtpk_s(s1[8], s1[9]), cvtpk_s(s1[10], s1[11]), cvtpk_s(s1[12], s1[13]), cvtpk_s(s1[14], s1[15])}; \
        const bf16x8 pa[4] = {__builtin_bit_cast(bf16x8, pw0), __builtin_bit_cast(bf16x8, pw1), __builtin_bit_cast(bf16x8, pw2), __builtin_bit_cast(bf16x8, pw3)};
#define AT_VLOAD(t_) do { const LAS unsigned char* vp = shm + LDS_V + ((t_) & 3) * SLOTB + ((lane >> 4) & 1) * 32 + (lane & 3) * 8 + (4 * hi + ((lane & 15) >> 2)) * 64; \
        _Pragma("unroll") for (int d0 = 0; d0 < 2; ++d0) _Pragma("unroll") for (int ks = 0; ks < 4; ++ks) { vlo[d0 * 4 + ks] = vtr(vp + d0 * 4096 + ks * 1024); vhi[d0 * 4 + ks] = vtr(vp + d0 * 4096 + ks * 1024 + 512); } } while (0)
#define AT_PV() do { _Pragma("unroll") for (int d0 = 0; d0 < 2; ++d0) _Pragma("unroll") for (int ks = 0; ks < 4; ++ks) { const s16x4 lo = vlo[d0 * 4 + ks], hh = vhi[d0 * 4 + ks]; \
            const bf16x8 vf = (bf16x8){lo[0], lo[1], lo[2], lo[3], hh[0], hh[1], hh[2], hh[3]}; o[d0] = __builtin_amdgcn_mfma_f32_32x32x16_bf16(pa[ks], vf, o[d0], 0, 0, 0); } } while (0)
    bf16x8 kf[8]; s16x4 vlo[8], vhi[8];
    for (int t = 0; t < NT; ++t) {
        if (t + 2 < NT) { AT_WAIT_BAR(4); } else if (t + 1 < NT) { AT_WAIT_BAR(2); } else { AT_WAIT_BAR(0); }
        if (t + 3 < NT) AT_DMA(t + 3);
        if (t >= ta && t <= tb_) {
            AT_KLOAD(t); AT_VLOAD(t);
            __builtin_amdgcn_sched_barrier(0);
            if (mrow < -1e29f) { const float c0_ = tbl[256]; _Pragma("unroll") for (int r = 0; r < 16; ++r) cfar[r] = c0_; }
            AT_CINIT(s0, s1, kc_lo + t, (mrow < -1e29f ? 0.f : mrow));
            AT_QK(s0, s1);
            AT_STATS();
            AT_EXP_PACK()
            AT_PV();
        }
    }
    { auto rr = __builtin_amdgcn_permlane32_swap(__float_as_uint(lsum), __float_as_uint(lsum), false, false); lsum = __uint_as_float(rr[0]) + __uint_as_float(rr[1]); }
    if (hi == 0) wsf[32 + r32] = lsum;
    LDS_WAIT();
    float rli[16];
#pragma unroll
    for (int r = 0; r < 16; ++r) rli[r] = __builtin_amdgcn_rcpf(wsf[32 + crow(r, hi)]);
    bf16* Ow = O + (rowbase + q0 + wid * 32) * D + h * 64;
    { LAS bf16* stg = (LAS bf16*)(shm + LDS_OST) + wid * 2048;
#pragma unroll
      for (int r = 0; r < 16; ++r) { const int orow = crow(r, hi);
#pragma unroll
          for (int d0 = 0; d0 < 2; ++d0) stg[orow * 64 + d0 * 32 + r32] = f2bf(o[d0][r] * rli[r]); }
      LDS_WAIT();
#pragma unroll
      for (int i = 0; i < 4; ++i) { const int row = i * 8 + (lane >> 3), ch = lane & 7; const u32x4 v = *(const LAS u32x4*)(stg + row * 64 + ch * 8); *(u32x4*)(Ow + (long)row * D + ch * 8) = v; } }
    asm volatile("s_waitcnt lgkmcnt(0)\n\ts_barrier" ::: "memory");
#undef AT_DMA
#undef AT_CINIT
#undef AT_QK
#undef AT_KLOAD
#undef AT_VLOAD
#undef AT_CFAR
#undef AT_STATS
#undef AT_EXP_PACK
#undef AT_PV
}
}

struct Args { const float* in[23]; float* out; unsigned char* ws; int ph_lo, ph_hi, li, pad; };

__device__ __forceinline__ void tr_item(const float* __restrict__ W, int ldw, int k0, int n0, bf16* __restrict__ WT, int ldt, int drow0, const float* __restrict__ ks, LAS float* scr, int lane) {
    float v[32];
    const float* wp = W + (size_t)(k0 + (lane >> 5)) * ldw + n0 + (lane & 31);
#pragma unroll
    for (int i = 0; i < 32; ++i) v[i] = wp[(size_t)(2 * i) * ldw];
    if (ks) {
#pragma unroll
        for (int i = 0; i < 32; ++i) v[i] *= ks[k0 + 2 * i + (lane >> 5)]; }
#pragma unroll
    for (int i = 0; i < 32; ++i) scr[(2 * i + (lane >> 5)) * 33 + (lane & 31)] = v[i];
    LDS_WAIT(); asm volatile("" ::: "memory");
    const int c = lane & 7;
#pragma unroll
    for (int j = 0; j < 4; ++j) { const int n = (lane >> 3) + 8 * j; const LAS float* s = scr + (8 * c) * 33 + n;
        u32x4 o; o.x = pk2(s[0 * 33], s[1 * 33]); o.y = pk2(s[2 * 33], s[3 * 33]); o.z = pk2(s[4 * 33], s[5 * 33]); o.w = pk2(s[6 * 33], s[7 * 33]);
        *(u32x4*)(WT + (size_t)(drow0 + n) * ldt + k0 + 8 * c) = o; }
    LDS_WAIT(); asm volatile("" ::: "memory");
}
__device__ __forceinline__ void moe_convert(const float* wg, const float* wu, const float* wd, const float* gn, bf16* WGU, bf16* WD, LAS float* scr, int gw, int NGW, int lane) {
    for (int it = gw; it < 12288; it += NGW) {
        if (it < 8192) { const int which = it >> 12, r = it & 4095, e = r >> 7, kb = (r >> 3) & 15, nb = r & 7, n0 = nb * 32;
            tr_item((which ? wu : wg) + (size_t)e * 1024 * 256, 256, kb * 64, n0, WGU, 1024, e * 512 + 256 * (n0 >> 7) + 128 * which + (n0 & 127), gn, scr, lane); }
        else { const int r = it - 8192, e = r >> 7, kb = (r >> 5) & 3, nb = r & 31;
            tr_item(wd + (size_t)e * 256 * 1024, 1024, kb * 64, nb * 32, WD, 256, e * 1024 + nb * 32, nullptr, scr, lane); }
    }
}
__device__ __forceinline__ void ssm_mats(int g, int q, const float* lre, const float* lim, const float* lstep, const float* bre, const float* bim, const float* cre, const float* cim, const float* dsk,
                                         unsigned char* ssm_ws, float* a16g, LAS float* L, int tid) {
    LAS float* pwr = L; LAS float* pwi = L + 64 * 17; LAS float* bbr = L + 2 * 64 * 17; LAS float* bbi = bbr + 1024; LAS float* ccr = bbi + 1024; LAS float* cci = ccr + 1024; LAS float* Kt = cci + 1024;
    if (tid < 64) { const int p = tid;
        const float lr = fminf(lre[g * 64 + p], -1e-4f), li = lim[g * 64 + p], step = expf(lstep[g]);
        const float decay = expf(lr * step), ang = li * step, ar = decay * cosf(ang), ai = decay * sinf(ang);
        const float den = lr * lr + li * li, nr = ar - 1.f, fr = (nr * lr + ai * li) / den, fi = (ai * lr - nr * li) / den;
        for (int c = 0; c < 16; ++c) { const float br = bre[(g * 64 + p) * 16 + c], bi = bim[(g * 64 + p) * 16 + c]; bbr[p * 16 + c] = fr * br - fi * bi; bbi[p * 16 + c] = fr * bi + fi * br;
            ccr[c * 64 + p] = cre[(g * 16 + c) * 64 + p]; cci[c * 64 + p] = cim[(g * 16 + c) * 64 + p]; }
        float xr = 1.f, xi = 0.f;
        for (int n = 0; n <= 16; ++n) { pwr[p * 17 + n] = xr; pwi[p * 17 + n] = xi; const float t = xr * ar - xi * ai; xi = xr * ai + xi * ar; xr = t; }
        if (q == 0) { a16g[(g * 64 + p) * 2] = pwr[p * 17 + 16]; a16g[(g * 64 + p) * 2 + 1] = pwi[p * 17 + 16]; }
    }
    __syncthreads();
    if (tid < 256) { const int tl = tid >> 6, c = (tid >> 2) & 15, cq = tid & 3, tau = 4 * q + tl;
        float s0 = 0.f, s1 = 0.f, s2 = 0.f, s3 = 0.f;
        for (int p = 0; p < 64; ++p) { const float cr = ccr[c * 64 + p], ci = cci[c * 64 + p], ar = pwr[p * 17 + tau], ai = pwi[p * 17 + tau]; const float tr = cr * ar - ci * ai, ti = cr * ai + ci * ar;
            const f32x4 br = *(const LAS f32x4*)(bbr + p * 16 + 4 * cq), bi = *(const LAS f32x4*)(bbi + p * 16 + 4 * cq);
            s0 += tr * br[0] - ti * bi[0]; s1 += tr * br[1] - ti * bi[1]; s2 += tr * br[2] - ti * bi[2]; s3 += tr * br[3] - ti * bi[3]; }
        if (tau == 0) { const float dd = dsk[g * 16 + c]; if (4 * cq == (c & ~3)) { if ((c & 3) == 0) s0 += dd; else if ((c & 3) == 1) s1 += dd; else if ((c & 3) == 2) s2 += dd; else s3 += dd; } }
        LAS float* kp = Kt + tl * 256 + c * 16 + 4 * cq; kp[0] = s0; kp[1] = s1; kp[2] = s2; kp[3] = s3; }
    __syncthreads();
    bf16* Bend = (bf16*)(ssm_ws + (size_t)g * SSM_G_BYTES); bf16* A2 = (bf16*)(ssm_ws + (size_t)g * SSM_G_BYTES + SSM_A2_OFF);
    for (int o = tid; o < 2048; o += NTHR) { const int tl = o >> 9, i = (o >> 5) & 15, c = (o >> 1) & 15, hf = o & 1, tau = 4 * q + tl, j = i - tau;
        if (j >= 0) { const LAS float* kp = Kt + tl * 256 + c * 16 + 8 * hf; u32x4 w; w.x = pk2(kp[0], kp[1]); w.y = pk2(kp[2], kp[3]); w.z = pk2(kp[4], kp[5]); w.w = pk2(kp[6], kp[7]);
            *(u32x4*)(A2 + (size_t)(i * 16 + c) * 384 + j * 16 + 8 * hf) = w; } }
    for (int o = tid; o < 2048; o += NTHR) { const int il = o >> 9, c = (o >> 5) & 15, j = (o >> 1) & 15, hf = o & 1, i = 4 * q + il;
        if (j > i) *(u32x4*)(A2 + (size_t)(i * 16 + c) * 384 + j * 16 + 8 * hf) = (u32x4){0u, 0u, 0u, 0u}; }
    for (int o = tid; o < 1024; o += NTHR) { const int il = o >> 8, c = (o >> 4) & 15, k8 = (o & 15) * 8, i = 4 * q + il; float v[8];
#pragma unroll
        for (int qq = 0; qq < 4; ++qq) { const int p = (k8 >> 1) + qq; const float cr = ccr[c * 64 + p], ci = cci[c * 64 + p], ar = pwr[p * 17 + i + 1], ai = pwi[p * 17 + i + 1];
            v[2 * qq] = cr * ar - ci * ai; v[2 * qq + 1] = -(cr * ai + ci * ar); }
        u32x4 w; w.x = pk2(v[0], v[1]); w.y = pk2(v[2], v[3]); w.z = pk2(v[4], v[5]); w.w = pk2(v[6], v[7]); *(u32x4*)(A2 + (size_t)(i * 16 + c) * 384 + 256 + k8) = w; }
    for (int o = tid; o < 1024; o += NTHR) { const int n = 32 * q + (o >> 5), k8 = (o & 31) * 8, p = n >> 1, ri = n & 1, j = k8 >> 4; float v[8];
        const float ar = pwr[p * 17 + 15 - j], ai = pwi[p * 17 + 15 - j];
#pragma unroll
        for (int qq = 0; qq < 8; ++qq) { const int c2 = (k8 & 15) + qq; const float br = bbr[p * 16 + c2], bi = bbi[p * 16 + c2]; v[qq] = ri ? (ar * bi + ai * br) : (ar * br - ai * bi); }
        u32x4 w; w.x = pk2(v[0], v[1]); w.y = pk2(v[2], v[3]); w.z = pk2(v[4], v[5]); w.w = pk2(v[6], v[7]); *(u32x4*)(Bend + (size_t)n * 256 + k8) = w; }
    __syncthreads();
}

__device__ __forceinline__ void router_phase(const bf16* __restrict__ h, const float* __restrict__ rwt, const float* __restrict__ bgr, const float* __restrict__ ber, unsigned* cntg,
                                             int* pdst, float* pw, float* ps, float* srow, LAS unsigned char* lds, int vcu, int G, int wid) {
    const int lane = lane_now(), tid = wid * 64 + lane;
    LAS float* Wl = (LAS float*)lds;
    for (int i = tid; i < RW_LAYER / 4; i += NTHR) ((LAS f32x4*)Wl)[i] = ((const f32x4*)rwt)[i];
    LAS int* lc = (LAS int*)(lds + RSCR_OFF); LAS int* lbase = lc + 32;
    const int rb = wid & 3, kh = wid >> 2, row = lane & 15, kq = lane >> 4;
    for (int blk = vcu; blk < M / 64; blk += G) {
        if (tid < 32) lc[tid] = 0;
        __syncthreads();
        const int t0 = blk * 64;
        const bf16* hp = h + (size_t)(t0 + 16 * rb + row) * D + 512 * kh + 8 * kq;
        const LAS float* wp0 = Wl + row * RW_PITCH + 512 * kh + 8 * kq; const LAS float* wp1 = wp0 + 16 * RW_PITCH; const LAS float* wp2 = Wl + (32 + (row & 3)) * RW_PITCH + 512 * kh + 8 * kq;
        f32x4 a0 = {0.f, 0.f, 0.f, 0.f}, a1 = a0, a2 = a0; float ssl = 0.f;
#pragma unroll 4
        for (int j = 0; j < 16; ++j) { const u32x4 hw = *(const u32x4*)(hp + 32 * j); float a[8];
#pragma unroll
            for (int i = 0; i < 4; ++i) { a[2 * i] = __uint_as_float(hw[i] << 16); a[2 * i + 1] = __uint_as_float(hw[i] & 0xffff0000u); }
#pragma unroll
            for (int hf = 0; hf < 2; ++hf) { const f32x4 b0 = *(const LAS f32x4*)(wp0 + 32 * j + 4 * hf), b1 = *(const LAS f32x4*)(wp1 + 32 * j + 4 * hf), b2 = *(const LAS f32x4*)(wp2 + 32 * j + 4 * hf);
#pragma unroll
                for (int i = 0; i < 4; ++i) { const float av = a[4 * hf + i]; ssl += av * av;
                    a0 = __builtin_amdgcn_mfma_f32_16x16x4f32(av, b0[i], a0, 0, 0, 0); a1 = __builtin_amdgcn_mfma_f32_16x16x4f32(av, b1[i], a1, 0, 0, 0); a2 = __builtin_amdgcn_mfma_f32_16x16x4f32(av, b2[i], a2, 0, 0, 0); } } }
        ssl += __shfl_xor(ssl, 16); ssl += __shfl_xor(ssl, 32);
        LAS float* P = (LAS float*)(lds + RSCR_OFF + 256);
        LAS float* pp = P + (16 * rb) * 40;
        if (kh == 1) {
#pragma unroll
            for (int r = 0; r < 4; ++r) { const int tk = 4 * kq + r; pp[tk * 40 + row] = a0[r]; pp[tk * 40 + 16 + row] = a1[r]; if (row < 4) pp[tk * 40 + 32 + row] = a2[r]; }
            if (kq == 0) pp[row * 40 + 36] = ssl; }
        __syncthreads();
        if (kh == 0) {
#pragma unroll
            for (int r = 0; r < 4; ++r) { const int tk = 4 * kq + r; pp[tk * 40 + row] += a0[r]; pp[tk * 40 + 16 + row] += a1[r]; if (row < 4) pp[tk * 40 + 32 + row] += a2[r]; }
            if (kq == 0) pp[row * 40 + 36] += ssl; }
        __syncthreads();
        int e1 = 0, e2 = 0; float w1 = 0.f, w2 = 0.f, s = 0.f; int sl1 = 0, sl2 = 0;
        if (tid < 64) { LAS float* p0 = P + tid * 40;
            s = rsqrtf(p0[36] * (1.f / D) + RMS_EPS);
            for (int o = 0; o < 36; ++o) p0[o] = p0[o] * s + (o < 4 ? bgr[o] : ber[o - 4]);
            int gi = 0; float gmx = p0[0];
            for (int i = 1; i < 4; ++i) if (p0[i] > gmx) { gmx = p0[i]; gi = i; }
            float den = 0.f; for (int i = 0; i < 4; ++i) den += __expf(p0[i] - gmx);
            const float gp = 1.f / den; const LAS float* sl = p0 + 4 + 8 * gi;
            int i1 = 0; float l1 = sl[0]; for (int i = 1; i < 8; ++i) if (sl[i] > l1) { l1 = sl[i]; i1 = i; }
            int i2 = -1; float l2 = -3.4e38f; for (int i = 0; i < 8; ++i) if (i != i1 && sl[i] > l2) { l2 = sl[i]; i2 = i; }
            const float ex = __expf(l2 - l1); w1 = gp / (1.f + ex); w2 = gp * ex / (1.f + ex); e1 = gi * 8 + i1; e2 = gi * 8 + i2;
            sl1 = __hip_atomic_fetch_add(&lc[e1], 1, __ATOMIC_RELAXED, __HIP_MEMORY_SCOPE_WORKGROUP); sl2 = __hip_atomic_fetch_add(&lc[e2], 1, __ATOMIC_RELAXED, __HIP_MEMORY_SCOPE_WORKGROUP);
            srow[t0 + tid] = s; }
        __syncthreads();
        if (tid < 32) { const int n = lc[tid]; lbase[tid] = n ? (int)__hip_atomic_fetch_add(cntg + tid * 64, (unsigned)n, RLX_AGENT) : 0; }
        __syncthreads();
        if (tid < 64) { const int t = t0 + tid; int i1 = lbase[e1] + sl1, i2 = lbase[e2] + sl2;
            if (i1 < CAP) { pdst[e1 * CAP + i1] = 2 * t; pw[e1 * CAP + i1] = w1; ps[e1 * CAP + i1] = s; }
            if (i2 < CAP) { pdst[e2 * CAP + i2] = 2 * t + 1; pw[e2 * CAP + i2] = w2; ps[e2 * CAP + i2] = s; } }
        __syncthreads();
    }
}

template <bool FINAL> __device__ __forceinline__ void combine_phase(const bf16* __restrict__ hin, const bf16* __restrict__ Y2, const float* __restrict__ g, bf16* __restrict__ hout, bf16* __restrict__ xng, float* __restrict__ outf, int vcu, int G, int wid, int lane) {
    for (int base = vcu * 16; base < M; base += G * 16) {
#pragma unroll
        for (int rr = 0; rr < 2; ++rr) { const int row = base + 2 * wid + rr;
            float4 v[4]; float ss = 0.f;
#pragma unroll
            for (int j = 0; j < 4; ++j) { const int c = 4 * (lane + 64 * j);
                const u32x2 hh = *(const u32x2*)(hin + (size_t)row * D + c), ya = *(const u32x2*)(Y2 + ((size_t)2 * row) * D + c), yb = *(const u32x2*)(Y2 + ((size_t)2 * row + 1) * D + c);
                v[j].x = __uint_as_float(hh.x << 16) + __uint_as_float(ya.x << 16) + __uint_as_float(yb.x << 16); v[j].y = __uint_as_float(hh.x & 0xffff0000u) + __uint_as_float(ya.x & 0xffff0000u) + __uint_as_float(yb.x & 0xffff0000u);
                v[j].z = __uint_as_float(hh.y << 16) + __uint_as_float(ya.y << 16) + __uint_as_float(yb.y << 16); v[j].w = __uint_as_float(hh.y & 0xffff0000u) + __uint_as_float(ya.y & 0xffff0000u) + __uint_as_float(yb.y & 0xffff0000u);
                ss += v[j].x * v[j].x + v[j].y * v[j].y + v[j].z * v[j].z + v[j].w * v[j].w;
                if (!FINAL) { u32x2 w; w.x = pk2(v[j].x, v[j].y); w.y = pk2(v[j].z, v[j].w); *(u32x2*)(hout + (size_t)row * D + c) = w; } }
            ss = wave_sum(ss); const float s = rsqrtf(ss * (1.f / D) + RMS_EPS);
#pragma unroll
            for (int j = 0; j < 4; ++j) { const int c = 4 * (lane + 64 * j); const float4 gg = *(const float4*)(g + c);
                const float ox = v[j].x * s * gg.x, oy = v[j].y * s * gg.y, oz = v[j].z * s * gg.z, ow = v[j].w * s * gg.w;
                if (FINAL) { float4 o; o.x = ox; o.y = oy; o.z = oz; o.w = ow; *(float4*)(outf + (size_t)row * D + c) = o; }
                else { u32x2 w; w.x = pk2(ox, oy); w.y = pk2(oz, ow); *(u32x2*)(xng + xng_off(row, c)) = w; } } }
    }
}

__device__ __forceinline__ void scan_unit(int g, int pm, const float* __restrict__ Sloc, const float* __restrict__ a16g, bf16* xng, LAS unsigned char* lds, int wid) {
    const int tid = wid * 64 + lane_now(), p = tid & 63, q = tid >> 6, b = pm >> 1, half = pm & 1;
    LAS float* E = (LAS float*)(lds + AUX_OFF);
    const float ar = a16g[(g * 64 + p) * 2], ai = a16g[(g * 64 + p) * 2 + 1];
    float pr = ar, pi = ai;
#pragma unroll
    for (int k = 0; k < 5; ++k) { const float nr = pr * pr - pi * pi, ni = 2.f * pr * pi; pr = nr; pi = ni; }
    float cr = 0.f, ci = 0.f;
    for (int rnd = 0; rnd <= half; ++rnd) {
        const size_t row0 = (size_t)g * 1024 + b * 512 + rnd * 256 + q * 32;
        const float* sp = Sloc + row0 * 128 + 2 * p;
        float2 v[32];
#pragma unroll
        for (int s = 0; s < 32; ++s) v[s] = *(const float2*)(sp + (size_t)s * 128);
        float xr = 0.f, xi = 0.f;
#pragma unroll
        for (int s = 0; s < 32; ++s) { const float nr = ar * xr - ai * xi + v[s].x, ni = ar * xi + ai * xr + v[s].y; xr = nr; xi = ni; }
        E[(q * 64 + p) * 2] = xr; E[(q * 64 + p) * 2 + 1] = xi;
        __syncthreads();
        float ir = cr, ii = ci, mr = 0.f, mi = 0.f;
#pragma unroll
        for (int qq = 0; qq < 8; ++qq) { if (qq == q) { mr = ir; mi = ii; } const float er = E[(qq * 64 + p) * 2], ei = E[(qq * 64 + p) * 2 + 1]; const float nr = pr * ir - pi * ii + er, ni = pr * ii + pi * ir + ei; ir = nr; ii = ni; }
        cr = ir; ci = ii;
        if (rnd == half) { bf16* xp = xng + row0 * 384 + 256 + 2 * p; xr = mr; xi = mi;
#pragma unroll
            for (int s = 0; s < 32; ++s) { *(unsigned*)(xp + (size_t)s * 384) = pk2(xr, xi); const float nr = ar * xr - ai * xi + v[s].x, ni = ar * xi + ai * xr + v[s].y; xr = nr; xi = ni; } }
        __syncthreads();
    }
}

__global__ void __launch_bounds__(NTHR, 2) mk_fwd(Args args) {
    extern __shared__ __attribute__((aligned(16))) unsigned char lds_[];
    LAS unsigned char* lds = (LAS unsigned char*)lds_;
    volatile LAS unsigned* MISC = (volatile LAS unsigned*)(lds + MISC_OFF);
    const int wid = __builtin_amdgcn_readfirstlane(threadIdx.x >> 6);
#define lane lane_now()
#define tid (wid * 64 + lane_now())
    const int G = gridDim.x; const int bx = blockIdx.x; const int vcu = (G % 8 == 0) ? (bx % 8) * (G / 8) + bx / 8 : bx;
    unsigned char* const ws = args.ws;
    constexpr size_t EW = (size_t)NEXP * 1024 * 256;
    for (int u = tid; u < (LDS_BYTES - MISC_OFF) / 4; u += NTHR) ((LAS unsigned*)(lds + MISC_OFF))[u] = 0u;
    __syncthreads();
    const int lo = args.ph_lo, hi = args.ph_hi;
    XcdBarrier bar; bar.bar = (unsigned*)ws + CW_BAR + args.li * XCD_BAR_WORDS; bar.x = 0; bar.st = nullptr;
    if (hi - lo > 1) bar = xcd_barrier_post((unsigned*)ws + CW_BAR + args.li * XCD_BAR_WORDS, MISC + 8, wid);
    const int gw = vcu * NWAVES + wid, NGW = G * NWAVES;
#ifndef PH_ONLY
#define PH_ONLY -1
#endif
#define IN(k) ((PH_ONLY < 0 || PH_ONLY == ((k) >= 12 && (k) <= 14 ? (k) - 8 : (k))) && lo <= (k) && (k) < hi)
#ifndef TS_K1
#define TS_K1 -1
#define TS_K2 -1
#endif
#define TS_STAMP(k) do { if (TS_K1 >= 0 && bx == 0 && tid == 0) ((unsigned long long*)(ws + WS_TS))[k] = __builtin_amdgcn_s_memrealtime(); } while (0)
#define SEAM(k) do { if ((k) + 1 < hi) xcd_barrier(bar, wid); TS_STAMP((k) + 1); } while (0)
#define SCR ((LAS float*)(lds + wid * 16384))
    TS_STAMP(0);
    if (IN(0)) {
        const float* w_qkv = args.in[4]; const float* w_o = args.in[5]; const float* w_out = args.in[15];
        for (int it = gw; it < 3072; it += NGW) {
            if (it < 1536) { const int kb = it / 96, nb = it % 96; tr_item(w_qkv, 3072, kb * 64, nb * 32, (bf16*)(ws + WS_WQKV), 1024, nb * 32, nullptr, SCR, lane); }
            else if (it < 2048) { const int r = it - 1536, kb = r >> 5, nb = r & 31; tr_item(w_o, 1024, kb * 64, nb * 32, (bf16*)(ws + WS_WO), 1024, nb * 32, nullptr, SCR, lane); }
            else { const int r = it - 2048, kb = r >> 6, nb = r & 63, n0 = nb * 32, ag = n0 >> 10, cc = n0 & 1023; tr_item(w_out, 2048, kb * 64, n0, (bf16*)(ws + WS_WOUT), 1024, 256 * (cc >> 7) + 128 * ag + (cc & 127), nullptr, SCR, lane); }
        }
        moe_convert(args.in[20], args.in[21], args.in[22], args.in[2], (bf16*)(ws + WS_WGU), (bf16*)(ws + WS_WD), SCR, gw, NGW, lane);
        { float* rwt = (float*)(ws + WS_RWT); const float* norm_ffn = args.in[2];
          for (int o = bx * NTHR + tid; o < 2 * 36 * 1024; o += G * NTHR) { const int layer = o / (36 * 1024), r = o % (36 * 1024), col = r >> 10, k = r & 1023;
            const float gnk = norm_ffn[layer * D + k];
            const float w = col < 4 ? args.in[16][(size_t)layer * 4096 + k * 4 + col] : args.in[18][(size_t)layer * 32768 + ((size_t)((col - 4) >> 3) * 1024 + k) * 8 + ((col - 4) & 7)];
            rwt[layer * RW_LAYER + col * RW_PITCH + k] = w * gnk; } }
        __syncthreads();
        for (int gq = vcu; gq < 256; gq += G) ssm_mats(gq >> 2, gq & 3, args.in[7], args.in[8], args.in[9], args.in[10], args.in[11], args.in[12], args.in[13], args.in[14], ws + WS_SSM, (float*)(ws + WS_A16), (LAS float*)lds, tid);
        { const float* x = args.in[0]; const float* norm_mix = args.in[1]; bf16* XN = (bf16*)(ws + WS_XN);
          for (int m = gw; m < M; m += NGW) { const float4* xr = (const float4*)(x + (size_t)m * D); float4 v[4]; float ss = 0.f;
#pragma unroll
            for (int j = 0; j < 4; ++j) { v[j] = xr[lane + 64 * j]; ss += v[j].x * v[j].x + v[j].y * v[j].y + v[j].z * v[j].z + v[j].w * v[j].w; }
            ss = wave_sum(ss); const float s = rsqrtf(ss * (1.f / D) + RMS_EPS);
#pragma unroll
            for (int j = 0; j < 4; ++j) { const int c = 4 * (lane + 64 * j); const float4 gg = *(const float4*)(norm_mix + c); u32x2 w; w.x = pk2(v[j].x * s * gg.x, v[j].y * s * gg.y); w.y = pk2(v[j].z * s * gg.z, v[j].w * s * gg.w);
                *(u32x2*)(XN + (size_t)m * D + c) = w; } } }
        SEAM(0);
    }
    if (IN(1)) { PhQKV P{ws, (const char*)(ws + WS_XN), G, bx}; gm::gemm_phase(lds, P, wid); SEAM(1); }
    if (IN(2)) {
        const int per = 1024 / G;
        for (int i = 0; i < per; ++i) { const int uid = vcu * per + i; const int bh = uid >> 5, qb = uid & 31;
            at::attn_unit<8>(bh >> 4, bh & 15, qb, (const bf16*)(ws + WS_Q), (const bf16*)(ws + WS_K), (const bf16*)(ws + WS_V), (bf16*)(ws + (args.pad ? WS_XN : WS_Q)), args.in[6], lds, wid); }
        SEAM(2);
    }
    if (IN(3)) { PhWo P{ws, (const char*)(ws + WS_Q), args.in[0], args.out, G, bx}; gm::gemm_phase(lds, P, wid); SEAM(3); }
#define MOE_LAYER(layer, pr) \
    if (IN(pr)) { router_phase((layer) ? (const bf16*)(ws + WS_XN) : (const bf16*)args.out, (const float*)(ws + WS_RWT) + (layer) * RW_LAYER, args.in[17] + (layer) * 4, args.in[19] + (layer) * 32, (unsigned*)ws + CW_CNT + (layer) * 32 * 64, \
                               (int*)(ws + WS_PDST), (float*)(ws + WS_PW), (float*)(ws + WS_PS), (float*)(ws + WS_SROW), lds, vcu, G, wid); SEAM(pr); } \
    if (IN((pr) + 1) || IN((pr) + 2)) { \
        moe_tables(lds, (const unsigned*)ws + CW_CNT + (layer) * 32 * 64, tid); \
        if (IN((pr) + 1)) { const bf16* hbp = (layer) ? (const bf16*)(ws + WS_XN) : (const bf16*)args.out; \
            { PhGateUp P{ws, (const char*)hbp, lds, G, vcu, __builtin_amdgcn_readfirstlane(((const LAS int*)(lds + AUX_OFF))[MT_NN])}; gm::gemm_phase(lds, P, wid); } \
            { const LAS int* mt = (const LAS int*)(lds + AUX_OFF); const int np = 16 * mt[MT_NS]; for (int j = G - 1 - vcu; j < np; j += G) { Unit u; u.pn = 0; moe_decode(lds, mt[MT_SLIST + (j >> 4)], u); tail_job<true>(ws, hbp, u, j & 15, wid); } } \
            SEAM((pr) + 1); } \
        if (IN((pr) + 2)) { { PhDown P{ws, (const char*)(ws + WS_H), lds, G, vcu, __builtin_amdgcn_readfirstlane(((const LAS int*)(lds + AUX_OFF))[MT_NN])}; gm::gemm_phase(lds, P, wid); } \
            { const LAS int* mt = (const LAS int*)(lds + AUX_OFF); const int np = 16 * mt[MT_NS]; for (int j = G - 1 - vcu; j < np; j += G) { Unit u; u.pn = 0; moe_decode(lds, mt[MT_SLIST + (j >> 4)], u); tail_job<false>(ws, (const bf16*)(ws + WS_H), u, j & 15, wid); } } \
            SEAM((pr) + 2); } \
    }
    MOE_LAYER(0, 4)
    if (IN(7)) {
        moe_convert(args.in[20] + EW, args.in[21] + EW, args.in[22] + EW, args.in[2] + D, (bf16*)(ws + WS_WGU), (bf16*)(ws + WS_WD), SCR, gw, NGW, lane);
        combine_phase<false>((const bf16*)args.out, (const bf16*)(ws + WS_Y2), args.in[1] + D, (bf16*)args.out + (size_t)M * D, (bf16*)(ws + WS_XN), nullptr, vcu, G, wid, lane);
        SEAM(7); }
    if (IN(8)) { PhSloc P{ws, (const char*)(ws + WS_XN), G, vcu}; gm::gemm_phase(lds, P, wid); if (10 < hi) xcd_barrier(bar, wid); }
    if (IN(10)) {
        for (int idx = vcu; idx < 256; idx += G) scan_unit(idx >> 2, idx & 3, (const float*)(ws + WS_SLOC), (const float*)(ws + WS_A16), (bf16*)(ws + WS_XN), lds, wid);
        asm volatile("s_waitcnt vmcnt(0)" ::: "memory"); __syncthreads();
        PhY P{ws, (const char*)(ws + WS_XN), G, vcu}; gm::gemm_phase(lds, P, wid); SEAM(10); }
    if (IN(11)) { PhWout P{ws, (const char*)(ws + WS_G), args.out, G, bx}; gm::gemm_phase(lds, P, wid); SEAM(11); }
    MOE_LAYER(1, 12)
#undef MOE_LAYER
    if (IN(15)) { combine_phase<true>((const bf16*)(ws + WS_XN), (const bf16*)(ws + WS_Y2), args.in[3], nullptr, nullptr, args.out, vcu, G, wid, lane);
#if TS_K1 >= 0
        { const unsigned long long* ts = (const unsigned long long*)(ws + WS_TS); const float dtus = (float)(ts[TS_K1 + 1] - ts[TS_K1]) * 1e-2f; const float e = exp2f(rintf(log2f(dtus) * 6.f) / 6.f) * 1e-2f;
          __syncthreads();
          for (int base = vcu * 16; base < M; base += G * 16) for (int i = tid; i < 16 * D; i += NTHR) args.out[(size_t)base * D + i] *= (1.f + e);
          if (TS_K2 >= 0 && bx == 0) { __syncthreads(); if (tid == 0) args.out[0] = exp2f(rintf(log2f((float)(ts[TS_K2 + 1] - ts[TS_K2]) * 1e-2f) * 6.f) / 6.f); } }
#endif
    }
    if (IN(16)) moe_convert(args.in[20] + EW, args.in[21] + EW, args.in[22] + EW, args.in[2] + D, (bf16*)(ws + WS_WGU), (bf16*)(ws + WS_WD), SCR, gw, NGW, lane);
#undef IN
#undef SEAM
#undef SCR
#undef lane
#undef tid
}

#ifndef FUSED
#define FUSED 1
#endif
#ifndef DUP_PH
#define DUP_PH -1
#endif
extern "C" void kernel_launch(void* const* d_in, const int* in_sizes, int n_in, void* d_out, int out_size, void* d_ws, size_t ws_size, hipStream_t stream) {
    static int grid = 0;
    if (grid == 0) {
        if (n_in != 23 || out_size != M * D || ws_size < WS_END) { fprintf(stderr, "kernel_launch: unexpected shapes (n_in %d out %d ws %zu)\n", n_in, out_size, ws_size); grid = -1; return; }
        int dev = 0, cus = 0;
        if (hipGetDevice(&dev) != hipSuccess || hipDeviceGetAttribute(&cus, hipDeviceAttributeMultiprocessorCount, dev) != hipSuccess) { grid = -1; return; }
        if (hipFuncSetAttribute((const void*)mk_fwd, hipFuncAttributeMaxDynamicSharedMemorySize, LDS_BYTES) != hipSuccess) { fprintf(stderr, "kernel_launch: hipFuncSetAttribute failed\n"); grid = -1; return; }
        (void)hipGetLastError();
        grid = cus;
        if (grid != 256) fprintf(stderr, "kernel_launch: %d CUs (built for 256)\n", grid);
    }
    if (grid < 0) return;
    unsigned char* ws = (unsigned char*)d_ws;
    (void)hipMemsetAsync(ws + WS_CTL, 0, CTL_ZERO_BYTES, stream);
    Args a{}; for (int i = 0; i < 23; ++i) a.in[i] = (const float*)d_in[i];
    a.out = (float*)d_out; a.ws = ws;
    int li = 0;
    auto run = [&](int lo, int hi) { a.ph_lo = lo; a.ph_hi = hi; a.li = li++; hipLaunchKernelGGL(mk_fwd, dim3(grid), dim3(NTHR), LDS_BYTES, stream, a); };
    if (FUSED) { run(0, N_PHASES); return; }
    for (int ph = 0; ph < N_PHASES; ++ph) { if (ph == 9) continue;
        if (DUP_PH == ph) { if (ph == 2) { a.pad = 1; run(2, 3); a.pad = 0; } else run(ph, ph + 1); }
        run(ph, ph + 1); }
}
```

```cpp
#include <hip/hip_runtime.h>
#include <cstdio>
#include <cstdint>

typedef unsigned short bf16;
constexpr int BATCH = 2, SEQ = 8192, D = 1024, M = BATCH * SEQ, NH = 16, HD = 64;
constexpr int NEXP = 32, EPG = 8, FE = 256;
constexpr int NREL = 257;
constexpr float RMS_EPS = 1e-6f;
constexpr float LOG2E = 1.4426950408889634f;
constexpr float C2 = 0.125f * LOG2E;

constexpr size_t MiB = 1u << 20;
constexpr size_t WS_CTL = 0;
constexpr size_t WS_XN = 86 * MiB;
constexpr size_t WS_BIG = 134 * MiB;
constexpr size_t WS_Q = WS_BIG, WS_K = WS_BIG + 32 * MiB, WS_V = WS_BIG + 64 * MiB;
constexpr size_t WS_Y2 = WS_BIG, WS_H = WS_BIG + 64 * MiB;
constexpr size_t WS_SLOC = WS_BIG, WS_G = WS_BIG + 32 * MiB;

__device__ __forceinline__ bf16 f2bf(float f) { unsigned u = __float_as_uint(f); return (bf16)((u + 0x7fffu + ((u >> 16) & 1u)) >> 16); }
__device__ __forceinline__ float bf2f(bf16 h) { return __uint_as_float(((unsigned)h) << 16); }
__device__ __forceinline__ float wave_sum(float v) {
#pragma unroll
    for (int o = 1; o < 64; o <<= 1) v += __shfl_xor(v, o);
    return v;
}
__device__ __forceinline__ float gelu_tanh(float x) { const float u = 0.7978845608028654f * (x + 0.044715f * x * x * x); return 0.5f * x * (1.f + tanhf(u)); }

__device__ __forceinline__ size_t xng_off(int t, int col) { const int b = t >> 13, tt = t & 8191, s = tt >> 4, j = tt & 15, g = col >> 4, c = col & 15; return ((size_t)(g * 1024 + b * 512 + s)) * 384 + j * 16 + c; }


#define LAS __attribute__((address_space(3)))
typedef short bf16x8 __attribute__((ext_vector_type(8)));
typedef short s16x4 __attribute__((ext_vector_type(4)));
typedef float f32x4 __attribute__((ext_vector_type(4)));
typedef float f32x16 __attribute__((ext_vector_type(16)));
typedef unsigned u32x4 __attribute__((ext_vector_type(4)));
typedef unsigned u32x2 __attribute__((ext_vector_type(2)));

constexpr int NWAVES = 8, NTHR = 512;
constexpr int CAP = 16384;
constexpr size_t CTL_ZERO_BYTES = 1 * MiB;
constexpr size_t WS_PDST = 1 * MiB, WS_PW = 3 * MiB, WS_PS = 5 * MiB, WS_SROW = 7 * MiB, WS_A16 = 7 * MiB + 65536;
constexpr size_t WS_TS = 7 * MiB + 131072;
constexpr size_t WS_RWT = 8 * MiB;
constexpr size_t WS_WQKV = 9 * MiB, WS_WO = 15 * MiB, WS_WOUT = 17 * MiB, WS_SSM = 21 * MiB;
constexpr size_t WS_WGU = 38 * MiB, WS_WD = 70 * MiB;
constexpr size_t WS_END = 230 * MiB;
constexpr int RW_PITCH = 1028, RW_LAYER = 36 * RW_PITCH;
constexpr int SSM_G_BYTES = 262144, SSM_A2_OFF = 65536;
constexpr int CW_BAR = 4096;
constexpr int CW_CNT = 65536;
constexpr int LDS_BYTES = 160 * 1024, MISC_OFF = LDS_BYTES - 512, AUX_OFF = 128 * 1024, RSCR_OFF = 36 * 1028 * 4;
constexpr int N_PHASES = 16;

__device__ __forceinline__ int lane_now() { int l; asm volatile("v_mbcnt_lo_u32_b32 %0, -1, 0\n\tv_mbcnt_hi_u32_b32 %0, -1, %0" : "=v"(l)); return l; }
__device__ __forceinline__ unsigned cvt_pk_bf16(float lo, float hi) { unsigned r; asm volatile("v_cvt_pk_bf16_f32 %0, %1, %2" : "=v"(r) : "v"(lo), "v"(hi)); return r; }
typedef float f32x2_t __attribute__((ext_vector_type(2))); typedef __bf16 bf16x2_t __attribute__((ext_vector_type(2)));
__device__ __forceinline__ unsigned cvtpk_s(float lo, float hi) { f32x2_t v = {lo, hi}; bf16x2_t b = __builtin_convertvector(v, bf16x2_t); return __builtin_bit_cast(unsigned, b); }
__device__ __forceinline__ unsigned pk2(float lo, float hi) { return (unsigned)f2bf(lo) | ((unsigned)f2bf(hi) << 16); }
#define LDS_WAIT() asm volatile("s_waitcnt lgkmcnt(0)" ::: "memory")
#define VM_WAIT() asm volatile("s_waitcnt vmcnt(0)" ::: "memory")
#define RLX_AGENT __ATOMIC_RELAXED, __HIP_MEMORY_SCOPE_AGENT

#define XB_TMO      128
#define XB_XCNT(j)  (256  + 64 * (j))
#define XB_XSUB(j)  (1280 + 64 * (j))
#define XB_XGEN(j)  (2304 + 64 * (j))
#define XB_TOP      3328
#define XB_TOPGEN   3392
#define XCD_BAR_WORDS 3456
#define XB_SPIN_CAP (1u << 18)
__device__ __forceinline__ unsigned xb_ld(unsigned* p)              { return __hip_atomic_load(p, __ATOMIC_RELAXED, __HIP_MEMORY_SCOPE_AGENT); }
__device__ __forceinline__ unsigned xb_add(unsigned* p, unsigned v) { return __hip_atomic_fetch_add(p, v, __ATOMIC_RELAXED, __HIP_MEMORY_SCOPE_AGENT); }
__device__ __forceinline__ unsigned xb_xcc_id() { return (unsigned)__builtin_amdgcn_s_getreg((3 << 11) | 20) & 0xFu; }
#define XB_SPIN(cond, bar) do { unsigned _sp = 0; while (cond) { __builtin_amdgcn_s_sleep(1); \
    if ((++_sp & 255u) == 0u) { if (xb_ld(&(bar)[XB_TMO])) break; if (_sp > XB_SPIN_CAP) { atomicAdd(&(bar)[XB_TMO], 1u); break; } } } } while (0)
struct XcdBarrier { unsigned* bar; unsigned x; volatile LAS unsigned* st; };
__device__ __forceinline__ XcdBarrier xcd_barrier_post(unsigned* bar, volatile LAS unsigned* st, int wid) {
    XcdBarrier b; b.bar = bar; b.x = xb_xcc_id(); b.st = st;
    if (wid == 0 && lane_now() == 0) (void)xb_add(&bar[XB_XCNT(b.x)], 1u);
    return b;
}
__device__ __forceinline__ void xcd_barrier_complete(unsigned* bar, unsigned x, unsigned& nloc, unsigned& nx) {
    const unsigned G = gridDim.x * gridDim.y * gridDim.z;
    unsigned sum, cnt, mine, sp = 0u;
    for (;;) {
        sum = 0u; cnt = 0u; mine = 0u;
#pragma unroll
        for (unsigned j = 0; j < 16; ++j) { const unsigned c = xb_ld(&bar[XB_XCNT(j)]); sum += c; cnt += (c > 0u) ? 1u : 0u; mine = (j == x) ? c : mine; }
        if (sum == G) break;
        __builtin_amdgcn_s_sleep(1);
        if ((++sp & 255u) == 0u) { if (xb_ld(&bar[XB_TMO])) break; if (sp > XB_SPIN_CAP) { atomicAdd(&bar[XB_TMO], 1u); break; } }
    }
    nloc = mine > 0u ? mine : 1u; nx = cnt > 0u ? cnt : 1u;
}
__device__ __forceinline__ void xcd_barrier(const XcdBarrier& b, int wid) {
    asm volatile("s_waitcnt vmcnt(0)" ::: "memory");
    __syncthreads();
    if (wid == 0 && lane_now() == 0) {
        unsigned* bar = b.bar;
        __builtin_amdgcn_s_waitcnt(0);
        unsigned nloc = b.st[0], nx = b.st[1];
        if (nloc == 0u) { xcd_barrier_complete(bar, b.x, nloc, nx); b.st[0] = nloc; b.st[1] = nx; }
        const unsigned old = xb_add(&bar[XB_XSUB(b.x)], 1u);
        const unsigned gen = old / nloc;
        if (old + 1u == (gen + 1u) * nloc) {
            __builtin_amdgcn_fence(__ATOMIC_RELEASE, "agent");
            asm volatile("s_waitcnt vmcnt(0)" ::: "memory");
            const unsigned og = xb_add(&bar[XB_TOP], 1u);
            const unsigned tg = og / nx;
            if (og + 1u == (tg + 1u) * nx) xb_add(&bar[XB_TOPGEN], 1u);
            else XB_SPIN(xb_ld(&bar[XB_TOPGEN]) == tg, bar);
            __builtin_amdgcn_fence(__ATOMIC_ACQUIRE, "agent");
            xb_add(&bar[XB_XGEN(b.x)], 1u);
            asm volatile("s_waitcnt vmcnt(0)" ::: "memory");
        } else {
            XB_SPIN(xb_ld(&bar[XB_XGEN(b.x)]) == gen, bar);
            __builtin_amdgcn_fence(__ATOMIC_ACQUIRE, "agent");
            asm volatile("s_waitcnt vmcnt(0)" ::: "memory");
        }
    }
    __syncthreads();
}

namespace gm {
constexpr int HTB = 16384;
__device__ __forceinline__ int lds_byte(int r, int c) { const int st = (r >> 4) * 2 + (c >> 5), rr = r & 15, cc = c & 31, ob = rr * 64 + cc * 2; return st * 1024 + (ob ^ (((ob >> 9) & 1) << 5)); }
__device__ __forceinline__ void stage_rc(int b, int& R, int& C) { const int st = b / 1024, sb = b % 1024, swz = sb ^ (((sb >> 9) & 1) << 5); R = (st >> 1) * 16 + swz / 64; C = (st & 1) * 32 + (swz % 64) / 2; }
__device__ __forceinline__ int perm32(int rho) { const int n = rho >> 4, i = rho & 15; return 8 * (i >> 2) + 4 * n + (i & 3); }
struct Unit { int pm, pn, e, gt, cnt; };
__device__ __forceinline__ bool static_unit(int i, int G, int c, int nM, int nN, Unit& u) {
    const int nwg = nM * nN; const long L = (long)i * G + c; if (L >= nwg) return false;
    int wgid = (int)L; { const int q = nwg / 8, r = nwg % 8, xcd = wgid % 8, off = wgid / 8; wgid = (xcd < r ? xcd * (q + 1) : r * (q + 1) + (xcd - r) * q) + off; }
    const int nig = 8 * nN, gid = wgid / nig, fm = gid * 8, gsz = (nM - fm) < 8 ? (nM - fm) : 8;
    u.pm = fm + ((wgid % nig) % gsz); u.pn = (wgid % nig) / gsz; u.e = 0; u.gt = 0; u.cnt = 0; return true;
}
template <class P> __device__ __forceinline__ void gemm_phase(LAS unsigned char* lds, const P& ph, int wid) {
    const int lane = lane_now(), tid = wid * 64 + lane, wr = wid >> 2, wc = wid & 3, fr = lane & 15, fq = lane >> 4;
    constexpr int nt = P::K / 64;
    static_assert(nt >= 2 && (nt % 2) == 0, "K must be a multiple of 128");
    unsigned voffA[2], voffB[2];
#pragma unroll
    for (int i = 0; i < 2; ++i) { int R, C; stage_rc(tid * 16 + i * 8192, R, C); const int Rb = (R & ~31) + perm32(R & 31); voffB[i] = (unsigned)(Rb * P::LDB + C) * 2u; voffA[i] = (unsigned)(R * P::LDA + C) * 2u; }
    const unsigned ldsw = (unsigned)wid * 1024u;
    const int aoff = lds_byte(wr * 64 + fr, fq * 8), boff = lds_byte(wc * 32 + fr, fq * 8);
    constexpr int hB = P::HSTEPB, hA = 128 * P::LDA * 2;
#define G_SA(b, h) (((b) * 2 + (h)) * gm::HTB)
#define G_SB(b, h) ((4 + (b) * 2 + (h)) * gm::HTB)
#define G_GLDS(src, bufoff, i) __builtin_amdgcn_global_load_lds((const unsigned*)(src), (LAS unsigned*)(lds + (bufoff) + ldsw + (i) * 8192), 16, 0, 0)
#define G_STA(bufoff, ptr, kb, offs, h) do { if constexpr (P::GATHER) { _Pragma("unroll") for (int _i = 0; _i < 2; ++_i) G_GLDS(Ab + (kb) + (offs)[h][_i], bufoff, _i); } \
        else { _Pragma("unroll") for (int _i = 0; _i < 2; ++_i) G_GLDS((ptr) + (h) * hA + voffA[_i], bufoff, _i); } } while (0)
#define G_STB(bufoff, ptr) do { _Pragma("unroll") for (int _i = 0; _i < 2; ++_i) G_GLDS((ptr) + voffB[_i], bufoff, _i); } while (0)
#define G_LDA(dst, b, h) do { _Pragma("unroll") for (int m = 0; m < 4; ++m) _Pragma("unroll") for (int k = 0; k < 2; ++k) dst[m][k] = *(const LAS bf16x8*)(lds + G_SA(b, h) + aoff + m * 2048 + k * 1024); } while (0)
#define G_LDB(dst, b, h) do { _Pragma("unroll") for (int n = 0; n < 2; ++n) _Pragma("unroll") for (int k = 0; k < 2; ++k) dst[n][k] = *(const LAS bf16x8*)(lds + G_SB(b, h) + boff + n * 2048 + k * 1024); } while (0)
#define G_MMA(ai, bj, At, Bt) do { __builtin_amdgcn_s_setprio(1); _Pragma("unroll") for (int m = 0; m < 4; ++m) _Pragma("unroll") for (int n = 0; n < 2; ++n) _Pragma("unroll") for (int k = 0; k < 2; ++k) \
        acc[ai][bj][m][n] = __builtin_amdgcn_mfma_f32_16x16x32_bf16(Bt[n][k], At[m][k], acc[ai][bj][m][n], 0, 0, 0); __builtin_amdgcn_s_setprio(0); } while (0)
#define G_WAIT_V(n) asm volatile("s_waitcnt vmcnt(" #n ")" ::: "memory")
#define G_WAIT_L(n) asm volatile("s_waitcnt lgkmcnt(" #n ")" ::: "memory")
#define G_BAR __builtin_amdgcn_s_barrier()
#define G_SCHED __builtin_amdgcn_sched_barrier(0)
    Unit cur, nxt; int ui = 0;
    if (!ph.next(0, cur)) return;
    f32x4 acc[2][2][4][2];
#pragma unroll
    for (int a = 0; a < 2; ++a)
#pragma unroll
        for (int b = 0; b < 2; ++b)
#pragma unroll
            for (int m = 0; m < 4; ++m)
#pragma unroll
                for (int n = 0; n < 2; ++n) acc[a][b][m][n] = (f32x4){0.f, 0.f, 0.f, 0.f};
    bf16x8 At[4][2], B0[2][2], B1[2][2];
    unsigned co[2][2] = {{0u, 0u}, {0u, 0u}};
    const char* Ab = ph.Abase;
    const char* cA = Ab; const char* cB = ph.b_tile(cur);
    if constexpr (P::GATHER) { ph.a_offs(cur, tid, co); asm volatile("s_waitcnt vmcnt(0)" ::: "memory"); } else cA = ph.a_tile(cur);
    G_STB(G_SB(0, 0), cB); G_STB(G_SB(0, 1), cB + hB); G_STA(G_SA(0, 0), cA, 0, co, 0); G_STA(G_SA(0, 1), cA, 0, co, 1);
    if (wr == 1) G_BAR;
    G_WAIT_V(2); G_BAR;
    G_STB(G_SB(1, 0), cB + 128); G_STA(G_SA(1, 0), cA + 128, 128, co, 0); G_STB(G_SB(1, 1), cB + hB + 128);
    G_WAIT_V(6); G_BAR;
    for (;;) {
        const bool has_next = ph.next(ui + 1, nxt);
        const char* nA = cA; const char* nB = cB;
        if (has_next) { nB = ph.b_tile(nxt); if constexpr (!P::GATHER) nA = ph.a_tile(nxt); }
        for (int t = 0; t < nt; t += 2) {
            const bool last = (t == nt - 2);
            const int kb1 = (t + 1) * 128, kb2 = last ? 0 : (t + 2) * 128, kb3 = kb2 + 128;
            const char* a1 = cA + kb1; const char* a2 = last ? nA : cA + kb2; const char* a3 = a2 + 128;
            const char* b2 = last ? nB : cB + (t + 2) * 128; const char* b3 = b2 + 128;
            G_LDB(B0, 0, 0); G_LDB(B1, 0, 1); G_SCHED; G_LDA(At, 0, 0); G_STA(G_SA(1, 1), a1, kb1, co, 1);
            G_WAIT_V(8); G_WAIT_L(0); G_BAR; G_MMA(0, 0, At, B0); G_MMA(0, 1, At, B1); G_BAR; G_SCHED;
            if constexpr (P::GATHER) { if (last && has_next) ph.a_offs(nxt, tid, co); }
            G_LDA(At, 0, 1); G_STB(G_SB(0, 0), b2); G_STB(G_SB(0, 1), b2 + hB); G_STA(G_SA(0, 0), a2, kb2, co, 0);
            G_WAIT_V(8); G_WAIT_L(0); G_BAR; G_MMA(1, 0, At, B0); G_MMA(1, 1, At, B1); G_BAR; G_SCHED;
            G_LDB(B0, 1, 0); G_LDB(B1, 1, 1); G_SCHED; G_LDA(At, 1, 0); G_STA(G_SA(0, 1), a2, kb2, co, 1);
            G_WAIT_V(8); G_WAIT_L(0); G_BAR; G_MMA(0, 0, At, B0); G_MMA(0, 1, At, B1); G_BAR; G_SCHED;
            G_LDA(At, 1, 1); G_STB(G_SB(1, 0), b3); G_STB(G_SB(1, 1), b3 + hB); G_STA(G_SA(1, 0), a3, kb3, co, 0);
            G_WAIT_V(8); G_WAIT_L(0); G_BAR; G_MMA(1, 0, At, B0); G_MMA(1, 1, At, B1); G_BAR; G_SCHED;
        }
        if (wr == 0) G_BAR;
        ph.epi(acc, cur, wr, wc, fr, fq);
        if (!has_next) break;
#pragma unroll
        for (int a = 0; a < 2; ++a)
#pragma unroll
            for (int b = 0; b < 2; ++b)
#pragma unroll
                for (int m = 0; m < 4; ++m)
#pragma unroll
                    for (int n = 0; n < 2; ++n) acc[a][b][m][n] = (f32x4){0.f, 0.f, 0.f, 0.f};
        cur = nxt; cA = nA; cB = nB; ++ui;
        if (wr == 1) G_BAR;
    }
    G_WAIT_V(0);
    G_BAR;
}
}

using gm::Unit;
#define EPI_ARGS const f32x4 (&acc)[2][2][4][2], const Unit& u, int wr, int wc, int fr_in, int fq_in
#define EPI_OPAQUE int fr = fr_in, fq = fq_in; asm volatile("" : "+v"(fr), "+v"(fq));
#define NO_GATHER __device__ __forceinline__ void a_offs(const Unit&, int, unsigned (&)[2][2]) const {}
#define EPI_FENCE() asm volatile("" ::: "memory")
__device__ __forceinline__ u32x4 pack8(const f32x4& v0, const f32x4& v1) { u32x4 w; w.x = cvt_pk_bf16(v0[0], v0[1]); w.y = cvt_pk_bf16(v0[2], v0[3]); w.z = cvt_pk_bf16(v1[0], v1[1]); w.w = cvt_pk_bf16(v1[2], v1[3]); return w; }
__device__ __forceinline__ float fast_sigmoid(float v) { return __builtin_amdgcn_rcpf(1.f + __builtin_amdgcn_exp2f(-LOG2E * v)); }
__device__ __forceinline__ float fast_gelu(float v) { const float u2 = 1.5957691216057308f * (v + 0.044715f * v * v * v); return v * fast_sigmoid(u2); }

struct PhQKV {
    static constexpr bool GATHER = false; static constexpr int LDA = 1024, K = 1024, LDB = 1024, HSTEPB = 128 * 1024 * 2;
    unsigned char* ws; const char* Abase; int G, c;
    __device__ __forceinline__ bool next(int i, Unit& u) const { return gm::static_unit(i, G, c, M / 256, 12, u); }
    NO_GATHER __device__ __forceinline__ const char* a_tile(const Unit& u) const { return Abase + (size_t)(u.pm * 256) * 1024 * 2; }
    __device__ __forceinline__ const char* b_tile(const Unit& u) const { return (const char*)(ws + WS_WQKV) + (size_t)u.pn * 256 * 1024 * 2; }
    __device__ __forceinline__ void epi(EPI_ARGS) const { EPI_OPAQUE
        const int row0 = u.pm * 256 + wr * 64 + fr; const int t = u.pn >> 2; const int colt = (u.pn & 3) * 256;
        bf16* base = (bf16*)(ws + WS_Q) + (size_t)t * (16u * 1024u * 1024u); const float sc = (t == 0) ? C2 : 1.f;
        const int col0 = colt + wc * 32 + 8 * fq;
#pragma unroll
        for (int ai = 0; ai < 2; ++ai)
#pragma unroll
            for (int m = 0; m < 4; ++m) { bf16* rowp = base + (size_t)(row0 + ai * 128 + m * 16) * 1024 + col0;
#pragma unroll
                for (int bj = 0; bj < 2; ++bj) *(u32x4*)(rowp + bj * 128) = pack8(acc[ai][bj][m][0] * sc, acc[ai][bj][m][1] * sc); }
    }
};
struct PhWo {
    static constexpr bool GATHER = false; static constexpr int LDA = 1024, K = 1024, LDB = 1024, HSTEPB = 128 * 1024 * 2;
    unsigned char* ws; const char* Abase; const float* resid; float* out; int G, c;
    __device__ __forceinline__ bool next(int i, Unit& u) const { return gm::static_unit(i, G, c, M / 256, 4, u); }
    NO_GATHER __device__ __forceinline__ const char* a_tile(const Unit& u) const { return Abase + (size_t)(u.pm * 256) * 1024 * 2; }
    __device__ __forceinline__ const char* b_tile(const Unit& u) const { return (const char*)(ws + WS_WO) + (size_t)u.pn * 256 * 1024 * 2; }
    __device__ __forceinline__ void epi(EPI_ARGS) const { EPI_OPAQUE
        const size_t off0 = (size_t)(u.pm * 256 + wr * 64 + fr) * 1024 + u.pn * 256 + wc * 32 + 8 * fq; bf16* hb = (bf16*)out;
#pragma unroll
        for (int ai = 0; ai < 2; ++ai) { f32x4 r[4][2][2];
#pragma unroll
            for (int m = 0; m < 4; ++m)
#pragma unroll
                for (int bj = 0; bj < 2; ++bj) { const float* p = resid + off0 + (size_t)(ai * 128 + m * 16) * 1024 + bj * 128; r[m][bj][0] = *(const f32x4*)p; r[m][bj][1] = *(const f32x4*)(p + 4); }
            EPI_FENCE();
#pragma unroll
            for (int m = 0; m < 4; ++m)
#pragma unroll
                for (int bj = 0; bj < 2; ++bj) { const size_t off = off0 + (size_t)(ai * 128 + m * 16) * 1024 + bj * 128; const f32x4 v0 = acc[ai][bj][m][0] + r[m][bj][0], v1 = acc[ai][bj][m][1] + r[m][bj][1];
                    *(u32x4*)(hb + off) = pack8(v0, v1); }
            EPI_FENCE(); }
    }
};
struct PhWout {
    static constexpr bool GATHER = false; static constexpr int LDA = 1024, K = 1024, LDB = 1024, HSTEPB = 128 * 1024 * 2;
    unsigned char* ws; const char* Abase; float* out; int G, c;
    __device__ __forceinline__ bool next(int i, Unit& u) const { return gm::static_unit(i, G, c, M / 256, 8, u); }
    NO_GATHER __device__ __forceinline__ const char* a_tile(const Unit& u) const { return Abase + (size_t)(u.pm * 256) * 1024 * 2; }
    __device__ __forceinline__ const char* b_tile(const Unit& u) const { return (const char*)(ws + WS_WOUT) + (size_t)u.pn * 256 * 1024 * 2; }
    __device__ __forceinline__ void epi(EPI_ARGS) const { EPI_OPAQUE
        const size_t off0 = (size_t)(u.pm * 256 + wr * 64 + fr) * 1024 + u.pn * 128 + wc * 32 + 8 * fq; bf16* hb = (bf16*)(ws + WS_XN); const bf16* rs = (const bf16*)out + (size_t)M * D;
        u32x4 r[2][4];
#pragma unroll
        for (int ai = 0; ai < 2; ++ai)
#pragma unroll
            for (int m = 0; m < 4; ++m) r[ai][m] = *(const u32x4*)(rs + off0 + (size_t)(ai * 128 + m * 16) * 1024);
        EPI_FENCE();
#pragma unroll
        for (int ai = 0; ai < 2; ++ai)
#pragma unroll
            for (int m = 0; m < 4; ++m) { const size_t off = off0 + (size_t)(ai * 128 + m * 16) * 1024; f32x4 v0, v1;
#pragma unroll
                for (int j = 0; j < 4; ++j) { const unsigned w0 = r[ai][m][j >> 1], w1 = r[ai][m][2 + (j >> 1)];
                    const float r0 = __uint_as_float((j & 1) ? (w0 & 0xffff0000u) : (w0 << 16)), r1 = __uint_as_float((j & 1) ? (w1 & 0xffff0000u) : (w1 << 16));
                    v0[j] = r0 + acc[ai][0][m][0][j] * fast_sigmoid(acc[ai][1][m][0][j]); v1[j] = r1 + acc[ai][0][m][1][j] * fast_sigmoid(acc[ai][1][m][1][j]); }
                *(u32x4*)(hb + off) = pack8(v0, v1); }
        EPI_FENCE();
    }
};
constexpr int MT_NN = 65, MT_NS = 66, MT_NLIST = 128, MT_SLIST = 384, SMALL_ROWS = 128;
__device__ __forceinline__ void moe_decode(LAS unsigned char* lds, int code, Unit& u) { const LAS int* cn = (const LAS int*)(lds + AUX_OFF); u.e = code >> 8; u.pm = code & 255; u.gt = cn[32 + u.e] + u.pm; u.cnt = cn[u.e]; }
__device__ __forceinline__ void moe_tables(LAS unsigned char* lds, const unsigned* cntg, int tid) {
    LAS int* cn = (LAS int*)(lds + AUX_OFF); LAS int* tb = cn + 32;
    if (tid < 64) {
        const int e = tid & 31; const unsigned cu = __hip_atomic_load(cntg + e * 64, RLX_AGENT); const int c = cu < (unsigned)CAP ? (int)cu : CAP;
        const int n = (c + 255) >> 8; const int lastrows = c - 256 * (n - 1); const int small = (n > 0 && lastrows <= SMALL_ROWS) ? 1 : 0; const int nnorm = n - small;
        int pt = n, pn_ = nnorm, ps_ = small;
#pragma unroll
        for (int o = 1; o < 32; o <<= 1) { const int a = __shfl_up(pt, o, 32), b = __shfl_up(pn_, o, 32), d = __shfl_up(ps_, o, 32); if (e >= o) { pt += a; pn_ += b; ps_ += d; } }
        if (tid < 32) { cn[e] = c; tb[e] = pt - n;
            for (int pm = 0; pm < nnorm; ++pm) cn[MT_NLIST + (pn_ - nnorm) + pm] = (e << 8) | pm;
            if (small) cn[MT_SLIST + ps_ - 1] = (e << 8) | (n - 1);
            if (e == 31) { tb[32] = pt; cn[MT_NN] = pn_; cn[MT_NS] = ps_; } }
    }
    __syncthreads();
}
template <bool GU> __device__ __forceinline__ void tail_job(unsigned char* ws, const bf16* __restrict__ Xbase, const Unit& u, int ns, int wid) {
    const int lane = lane_now(), fr = lane & 15, fq = lane >> 4, w = wid;
    constexpr int K = GU ? 1024 : 256, NG = GU ? 2 : 4;
    const int slot0 = u.pm * 256, rows = u.cnt - slot0;
    if (16 * w >= rows) return;
    const int* pdst = (const int*)(ws + WS_PDST) + u.e * CAP + slot0;
    int r = 16 * w + fr; const bool valid = r < rows; r = valid ? r : rows - 1;
    const int dst = pdst[r];
    const bf16* xp = (GU ? Xbase + (size_t)(dst >> 1) * 1024 : Xbase + ((size_t)u.gt * 256 + r) * 256) + 8 * fq;
    const bf16* wp[NG];
#pragma unroll
    for (int n = 0; n < NG; ++n) wp[n] = GU ? (const bf16*)(ws + WS_WGU) + ((size_t)u.e * 512 + 256 * (ns >> 3) + 128 * n + 16 * (ns & 7) + fr) * 1024 + 8 * fq
                                             : (const bf16*)(ws + WS_WD) + ((size_t)u.e * 1024 + 64 * ns + 16 * n + fr) * 256 + 8 * fq;
    f32x4 acc[NG];
#pragma unroll
    for (int n = 0; n < NG; ++n) acc[n] = (f32x4){0.f, 0.f, 0.f, 0.f};
#pragma unroll 8
    for (int ks = 0; ks < K / 32; ++ks) { const bf16x8 xf = *(const bf16x8*)(xp + 32 * ks); bf16x8 wf[NG];
#pragma unroll
        for (int n = 0; n < NG; ++n) wf[n] = *(const bf16x8*)(wp[n] + 32 * ks);
#pragma unroll
        for (int n = 0; n < NG; ++n) acc[n] = __builtin_amdgcn_mfma_f32_16x16x32_bf16(wf[n], xf, acc[n], 0, 0, 0); }
    if (valid) {
        if (GU) { const float sc = ((const float*)(ws + WS_PS))[u.e * CAP + slot0 + r]; float v[4];
#pragma unroll
            for (int j = 0; j < 4; ++j) { const float gg = acc[0][j] * sc, uu = acc[NG - 1][j] * sc; v[j] = gg * fast_sigmoid(gg) * uu; }
            u32x2 o; o.x = cvt_pk_bf16(v[0], v[1]); o.y = cvt_pk_bf16(v[2], v[3]);
            *(u32x2*)((bf16*)(ws + WS_H) + ((size_t)u.gt * 256 + r) * 256 + 16 * ns + 4 * fq) = o; }
        else { const float wt = ((const float*)(ws + WS_PW))[u.e * CAP + slot0 + r];
#pragma unroll
            for (int n = 0; n < NG; ++n) { u32x2 o; o.x = cvt_pk_bf16(acc[n][0] * wt, acc[n][1] * wt); o.y = cvt_pk_bf16(acc[n][2] * wt, acc[n][3] * wt);
                *(u32x2*)((bf16*)(ws + WS_Y2) + (size_t)dst * 1024 + 64 * ns + 16 * n + 4 * fq) = o; } } }
}
struct PhGateUp {
    static constexpr bool GATHER = true; static constexpr int LDA = 1024, K = 1024, LDB = 1024, HSTEPB = 128 * 1024 * 2;
    unsigned char* ws; const char* Abase; LAS unsigned char* lds; int G, c, nn;
    __device__ __forceinline__ bool next(int i, Unit& u) const { const int idx = i * G + c; if (idx >= 2 * nn) return false; u.pn = idx & 1; moe_decode(lds, ((const LAS int*)(lds + AUX_OFF))[MT_NLIST + (idx >> 1)], u); return true; }
    __device__ __forceinline__ void a_offs(const Unit& u, int tid, unsigned (&o)[2][2]) const { const int* pdst = (const int*)(ws + WS_PDST);
#pragma unroll
        for (int i = 0; i < 2; ++i) { int R, C; gm::stage_rc(tid * 16 + i * 8192, R, C);
#pragma unroll
            for (int h = 0; h < 2; ++h) { int slot = u.pm * 256 + 128 * h + R; slot = slot < u.cnt ? slot : u.cnt - 1; const int tok = pdst[u.e * CAP + slot] >> 1; o[h][i] = (unsigned)(tok * 1024 + C) * 2u; } }
    }
    __device__ __forceinline__ const char* a_tile(const Unit&) const { return Abase; }
    __device__ __forceinline__ const char* b_tile(const Unit& u) const { return (const char*)(ws + WS_WGU) + ((size_t)u.e * 512 + u.pn * 256) * 1024 * 2; }
    __device__ __forceinline__ void epi(EPI_ARGS) const { EPI_OPAQUE
        const int r0 = wr * 64 + fr, col0 = u.pn * 128 + wc * 32 + 8 * fq; const float* ps = (const float*)(ws + WS_PS) + u.e * CAP; bf16* H = (bf16*)(ws + WS_H);
        float sv[2][4];
#pragma unroll
        for (int ai = 0; ai < 2; ++ai)
#pragma unroll
            for (int m = 0; m < 4; ++m) { int slot = u.pm * 256 + r0 + ai * 128 + m * 16; slot = slot < u.cnt ? slot : u.cnt - 1; sv[ai][m] = ps[slot]; }
        EPI_FENCE();
#pragma unroll
        for (int ai = 0; ai < 2; ++ai)
#pragma unroll
            for (int m = 0; m < 4; ++m) { const int r = r0 + ai * 128 + m * 16; const float s = sv[ai][m];
                f32x4 v0, v1;
#pragma unroll
                for (int j = 0; j < 4; ++j) { const float g0 = acc[ai][0][m][0][j] * s, u0 = acc[ai][1][m][0][j] * s, g1 = acc[ai][0][m][1][j] * s, u1 = acc[ai][1][m][1][j] * s;
                    v0[j] = g0 * fast_sigmoid(g0) * u0; v1[j] = g1 * fast_sigmoid(g1) * u1; }
                *(u32x4*)(H + ((size_t)u.gt * 256 + r) * 256 + col0) = pack8(v0, v1); }
        EPI_FENCE();
    }
};
struct PhDown {
    static constexpr bool GATHER = false; static constexpr int LDA = 256, K = 256, LDB = 256, HSTEPB = 128 * 256 * 2;
    unsigned char* ws; const char* Abase; LAS unsigned char* lds; int G, c, nn;
    __device__ __forceinline__ bool next(int i, Unit& u) const { const int idx = i * G + c; if (idx >= 4 * nn) return false; u.pn = idx & 3; moe_decode(lds, ((const LAS int*)(lds + AUX_OFF))[MT_NLIST + (idx >> 2)], u); return true; }
    NO_GATHER __device__ __forceinline__ const char* a_tile(const Unit& u) const { return Abase + (size_t)(u.gt * 256) * 256 * 2; }
    __device__ __forceinline__ const char* b_tile(const Unit& u) const { return (const char*)(ws + WS_WD) + ((size_t)u.e * 1024 + u.pn * 256) * 256 * 2; }
    __device__ __forceinline__ void epi(EPI_ARGS) const { EPI_OPAQUE
        const int r0 = u.pm * 256 + wr * 64 + fr, col0 = u.pn * 256 + wc * 32 + 8 * fq; const int* pdst = (const int*)(ws + WS_PDST) + u.e * CAP; const float* pw = (const float*)(ws + WS_PW) + u.e * CAP; bf16* Y2 = (bf16*)(ws + WS_Y2);
        int slot = r0 < u.cnt ? r0 : u.cnt - 1; int dn = pdst[slot]; float wn = pw[slot];
#pragma unroll
        for (int g = 0; g < 8; ++g) { const int ai = g >> 2, m = g & 3; const int dcur = dn; const float wcur = wn;
            if (g < 7) { int s2 = r0 + ((g + 1) >> 2) * 128 + ((g + 1) & 3) * 16; s2 = s2 < u.cnt ? s2 : u.cnt - 1; dn = pdst[s2]; wn = pw[s2]; }
            if (r0 + ai * 128 + m * 16 < u.cnt) { bf16* yp = Y2 + (size_t)dcur * 1024 + col0;
#pragma unroll
                for (int bj = 0; bj < 2; ++bj) *(u32x4*)(yp + bj * 128) = pack8(acc[ai][bj][m][0] * wcur, acc[ai][bj][m][1] * wcur); }
            EPI_FENCE(); }
    }
};
struct PhSloc {
    static constexpr bool GATHER = false; static constexpr int LDA = 384, K = 256, LDB = 256, HSTEPB = 0;
    unsigned char* ws; const char* Abase; int G, c;
    __device__ __forceinline__ bool next(int i, Unit& u) const { const int idx = i * G + c; if (idx >= 256) return false; u.e = idx >> 2; u.pm = idx & 3; u.pn = 0; u.gt = 0; u.cnt = 0; return true; }
    NO_GATHER __device__ __forceinline__ const char* a_tile(const Unit& u) const { return Abase + (size_t)(u.e * 1024 + u.pm * 256) * 384 * 2; }
    __device__ __forceinline__ const char* b_tile(const Unit& u) const { return (const char*)(ws + WS_SSM) + (size_t)u.e * SSM_G_BYTES; }
    __device__ __forceinline__ void epi(EPI_ARGS) const { EPI_OPAQUE
        const int r0 = u.e * 1024 + u.pm * 256 + wr * 64 + fr, col0 = wc * 32 + 8 * fq; float* Sloc = (float*)(ws + WS_SLOC);
#pragma unroll
        for (int ai = 0; ai < 2; ++ai)
#pragma unroll
            for (int m = 0; m < 4; ++m) { float* p = Sloc + (size_t)(r0 + ai * 128 + m * 16) * 128 + col0; *(f32x4*)p = acc[ai][0][m][0]; *(f32x4*)(p + 4) = acc[ai][0][m][1]; }
    }
};
struct PhY {
    static constexpr bool GATHER = false; static constexpr int LDA = 384, K = 384, LDB = 384, HSTEPB = 128 * 384 * 2;
    unsigned char* ws; const char* Abase; int G, c;
    __device__ __forceinline__ bool next(int i, Unit& u) const { const int idx = i * G + c; if (idx >= 256) return false; u.e = idx >> 2; u.pm = idx & 3; u.pn = 0; u.gt = 0; u.cnt = 0; return true; }
    NO_GATHER __device__ __forceinline__ const char* a_tile(const Unit& u) const { return Abase + (size_t)(u.e * 1024 + u.pm * 256) * 384 * 2; }
    __device__ __forceinline__ const char* b_tile(const Unit& u) const { return (const char*)(ws + WS_SSM) + (size_t)u.e * SSM_G_BYTES + SSM_A2_OFF; }
    __device__ __forceinline__ void epi(EPI_ARGS) const { EPI_OPAQUE
        const int nb = (u.pm & 1) * 256 + wr * 64 + fr;
        bf16* p = (bf16*)(ws + WS_G) + ((size_t)(u.pm >> 1) * SEQ + 16 * nb + 2 * wc + (fq >> 1)) * 1024 + 16 * u.e + 8 * (fq & 1);
#pragma unroll
        for (int ai = 0; ai < 2; ++ai)
#pragma unroll
            for (int m = 0; m < 4; ++m) {
#pragma unroll
                for (int bj = 0; bj < 2; ++bj) { f32x4 v0, v1;
#pragma unroll
                    for (int j = 0; j < 4; ++j) { v0[j] = fast_gelu(acc[ai][bj][m][0][j]); v1[j] = fast_gelu(acc[ai][bj][m][1][j]); }
                    *(u32x4*)(p + bj * 8 * 1024) = pack8(v0, v1); }
                p += (m == 3 ? (128 - 48) : 16) * 16 * 1024; asm volatile("" : "+v"(p) :: "memory"); }
    }
};

namespace at {
constexpr int NSLOT = 4, SLOTB = 8192;
constexpr int LDS_K = 0, LDS_V = NSLOT * SLOTB, LDS_WS = 2 * NSLOT * SLOTB, LDS_TBL = LDS_WS + 2048, LDS_OST = LDS_TBL + 2048, LDS_TOTAL = LDS_OST + 8 * 4096;
typedef short v4i16_t __attribute__((ext_vector_type(4)));
__device__ __forceinline__ int crow(int r, int hi) { return (r & 3) + 8 * (r >> 2) + 4 * hi; }
__device__ __forceinline__ void glds16(const void* gsrc, unsigned lds_dst) { unsigned keep;
    asm volatile("s_mov_b32 %0, m0\n\ts_mov_b32 m0, %2\n\ts_nop 0\n\tglobal_load_lds_dwordx4 %1, off\n\ts_mov_b32 m0, %0" : "=&s"(keep) : "v"(gsrc), "s"(lds_dst) : "memory"); }
__device__ __forceinline__ s16x4 vtr(const LAS unsigned char* p) { return __builtin_bit_cast(s16x4, __builtin_amdgcn_ds_read_tr16_b64_v4i16((LAS v4i16_t*)p)); }
#define AT_WAIT_BAR(N) asm volatile("s_waitcnt vmcnt(" #N ") lgkmcnt(0)\n\ts_barrier" ::: "memory")
template <int THR> __device__ __forceinline__ void attn_unit(int b, int h, int qb, const bf16* Q, const bf16* __restrict__ K, const bf16* __restrict__ V, bf16* O, const float* __restrict__ relb, LAS unsigned char* shm, int wid) {
    const int lane = lane_now(), tid = wid * 64 + lane, r32 = lane & 31, hi = lane >> 5;
    const long rowbase = (long)b * SEQ; const int q0 = qb * 256; const int cq = 4 * qb + (wid >> 1);
    const bf16* Qw = Q + (rowbase + q0 + wid * 32) * D + h * 64;
    const unsigned lds0 = (unsigned)(uintptr_t)shm;
    LAS float* wsf = (LAS float*)(shm + LDS_WS) + wid * 64; LAS float* tbl = (LAS float*)(shm + LDS_TBL);
    const int kc_lo = (4 * qb - 8) < 0 ? 0 : (4 * qb - 8); const int NT = 4 * qb + 3 - kc_lo + 1;
    const int ta = ((cq - 8) < kc_lo ? kc_lo : (cq - 8)) - kc_lo, tb_ = cq - kc_lo;
    if (tid < 320) tbl[tid] = relb[h * NREL + (tid < 256 ? tid : 256)] * LOG2E;
    const bf16* ksrc = K + (rowbase + kc_lo * 64 + lane) * D + h * 64 + wid * 8;
    const bf16* vsrc = V + (rowbase + kc_lo * 64 + 16 * (wid & 3) + (lane >> 2)) * D + h * 64 + (wid >> 2) * 32 + (lane & 3) * 8;
    const unsigned kdst = lds0 + LDS_K + wid * 1024, vdst = lds0 + LDS_V + wid * 1024;
#define AT_DMA(t) do { const unsigned so_ = (unsigned)((t) & 3) * SLOTB; glds16(ksrc + (long)(t) * 64 * D, (unsigned)__builtin_amdgcn_readfirstlane(kdst + so_)); glds16(vsrc + (long)(t) * 64 * D, (unsigned)__builtin_amdgcn_readfirstlane(vdst + so_)); } while (0)
    bf16x8 qr[4];
#pragma unroll
    for (int d0 = 0; d0 < 4; ++d0) qr[d0] = *reinterpret_cast<const bf16x8*>(&Qw[(long)r32 * D + d0 * 16 + hi * 8]);
    AT_DMA(0); AT_DMA(1); AT_DMA(2);
    asm volatile("" : "+v"(qr[0]), "+v"(qr[1]), "+v"(qr[2]), "+v"(qr[3]));
    float mrow = -1e30f, lsum = 0.f; f32x16 o[2]; o[0] = f32x16{}; o[1] = f32x16{};
    f32x16 s0 = f32x16{}, s1 = f32x16{};
    f32x16 cfar = f32x16{};
    const int qoff = 32 * (wid & 1) + r32 + 128 - 4 * hi;
#define AT_CINIT(P0, P1, kc_, msub_) do { const int delta_ = cq - (kc_); \
        if (delta_ >= 3) { P0 = cfar; P1 = cfar; } \
        else { const LAS float* tb = tbl + (64 * delta_ + qoff); _Pragma("unroll") for (int r = 0; r < 16; ++r) { const int kj = (r & 3) + 8 * (r >> 2); P0[r] = tb[-kj] - (msub_); P1[r] = tb[-kj - 32] - (msub_); } } } while (0)
#define AT_KLOAD(t_) do { const LAS unsigned char* kp = shm + LDS_K + ((t_) & 3) * SLOTB + hi * 1024 + r32 * 16; \
        _Pragma("unroll") for (int d0 = 0; d0 < 4; ++d0) { kf[2 * d0] = *(const LAS bf16x8*)(kp + d0 * 2048); kf[2 * d0 + 1] = *(const LAS bf16x8*)(kp + d0 * 2048 + 512); } } while (0)
#define AT_QK(P0, P1) do { _Pragma("unroll") for (int d0 = 0; d0 < 4; ++d0) { \
            P0 = __builtin_amdgcn_mfma_f32_32x32x16_bf16(kf[2 * d0], qr[d0], P0, 0, 0, 0); P1 = __builtin_amdgcn_mfma_f32_32x32x16_bf16(kf[2 * d0 + 1], qr[d0], P1, 0, 0, 0); } } while (0)
#define AT_CFAR() do { const float c0_ = tbl[256] - mrow; _Pragma("unroll") for (int r = 0; r < 16; ++r) cfar[r] = c0_; } while (0)
#define AT_STATS() do { float ra = fmaxf(fmaxf(s0[0], s0[1]), s1[0]), rb2 = fmaxf(fmaxf(s0[2], s0[3]), s1[1]); ra = fmaxf(fmaxf(ra, s1[2]), s1[3]); \
        _Pragma("unroll") for (int r = 4; r < 16; r += 4) { ra = fmaxf(fmaxf(ra, s0[r]), s0[r + 1]); rb2 = fmaxf(fmaxf(rb2, s0[r + 2]), s0[r + 3]); ra = fmaxf(fmaxf(ra, s1[r]), s1[r + 1]); rb2 = fmaxf(fmaxf(rb2, s1[r + 2]), s1[r + 3]); } \
        float rm = fmaxf(ra, rb2); { auto rr = __builtin_amdgcn_permlane32_swap(__float_as_uint(rm), __float_as_uint(rm), false, false); rm = fmaxf(__uint_as_float(rr[0]), __uint_as_float(rr[1])); } \
        if (mrow < -1e29f) { mrow = rm; _Pragma("unroll") for (int r = 0; r < 16; ++r) { s0[r] -= rm; s1[r] -= rm; } AT_CFAR(); } \
        else if (__any(rm > (float)THR)) { const float dl = fmaxf(rm, 0.f), f = __builtin_amdgcn_exp2f(-dl); mrow += dl; lsum *= f; \
            if (hi == 0) wsf[r32] = f; LDS_WAIT(); \
            _Pragma("unroll") for (int r = 0; r < 16; ++r) { const float fr_ = wsf[crow(r, hi)]; o[0][r] *= fr_; o[1][r] *= fr_; s0[r] -= dl; s1[r] -= dl; } AT_CFAR(); } } while (0)
#define AT_EXP_PACK() float sacc = 0.f, sacc2 = 0.f; \
        _Pragma("unroll") for (int r = 0; r < 16; ++r) { s0[r] = __builtin_amdgcn_exp2f(s0[r]); s1[r] = __builtin_amdgcn_exp2f(s1[r]); sacc += s0[r]; sacc2 += s1[r]; } \
        lsum += sacc + sacc2; \
        const u32x4 pw0 = (u32x4){cvtpk_s(s0[0], s0[1]), cvtpk_s(s0[2], s0[3]), cvtpk_s(s0[4], s0[5]), cvtpk_s(s0[6], s0[7])}; \
        const u32x4 pw1 = (u32x4){cvtpk_s(s0[8], s0[9]), cvtpk_s(s0[10], s0[11]), cvtpk_s(s0[12], s0[13]), cvtpk_s(s0[14], s0[15])}; \
        const u32x4 pw2 = (u32x4){cvtpk_s(s1[0], s1[1]), cvtpk_s(s1[2], s1[3]), cvtpk_s(s1[4], s1[5]), cvtpk_s(s1[6], s1[7])}; \
        const u32x4 pw3 = (u32x4){cvtpk_s(s1[8], s1[9]), cvtpk_s(s1[10], s1[11]), cvtpk_s(s1[12], s1[13]), cvtpk_s(s1[14], s1[15])}; \
        const bf16x8 pa[4] = {__builtin_bit_cast(bf16x8, pw0), __builtin_bit_cast(bf16x8, pw1), __builtin_bit_cast(bf16x8, pw2), __builtin_bit_cast(bf16x8, pw3)};
#define AT_VLOAD(t_) do { const LAS unsigned char* vp = shm + LDS_V + ((t_) & 3) * SLOTB + ((lane >> 4) & 1) * 32 + (lane & 3) * 8 + (4 * hi + ((lane & 15) >> 2)) * 64; \
        _Pragma("unroll") for (int d0 = 0; d0 < 2; ++d0) _Pragma("unroll") for (int ks = 0; ks < 4; ++ks) { vlo[d0 * 4 + ks] = vtr(vp + d0 * 4096 + ks * 1024); vhi[d0 * 4 + ks] = vtr(vp + d0 * 4096 + ks * 1024 + 512); } } while (0)
#define AT_PV() do { _Pragma("unroll") for (int d0 = 0; d0 < 2; ++d0) _Pragma("unroll") for (int ks = 0; ks < 4; ++ks) { const s16x4 lo = vlo[d0 * 4 + ks], hh = vhi[d0 * 4 + ks]; \
            const bf16x8 vf = (bf16x8){lo[0], lo[1], lo[2], lo[3], hh[0], hh[1], hh[2], hh[3]}; o[d0] = __builtin_amdgcn_mfma_f32_32x32x16_bf16(pa[ks], vf, o[d0], 0, 0, 0); } } while (0)
    bf16x8 kf[8]; s16x4 vlo[8], vhi[8];
    for (int t = 0; t < NT; ++t) {
        if (t + 2 < NT) { AT_WAIT_BAR(4); } else if (t + 1 < NT) { AT_WAIT_BAR(2); } else { AT_WAIT_BAR(0); }
        if (t + 3 < NT) AT_DMA(t + 3);
        if (t >= ta && t <= tb_) {
            AT_KLOAD(t); AT_VLOAD(t);
            __builtin_amdgcn_sched_barrier(0);
            if (mrow < -1e29f) { const float c0_ = tbl[256]; _Pragma("unroll") for (int r = 0; r < 16; ++r) cfar[r] = c0_; }
            AT_CINIT(s0, s1, kc_lo + t, (mrow < -1e29f ? 0.f : mrow));
            AT_QK(s0, s1);
            AT_STATS();
            AT_EXP_PACK()
            AT_PV();
        }
    }
    { auto rr = __builtin_amdgcn_permlane32_swap(__float_as_uint(lsum), __float_as_uint(lsum), false, false); lsum = __uint_as_float(rr[0]) + __uint_as_float(rr[1]); }
    if (hi == 0) wsf[32 + r32] = lsum;
    LDS_WAIT();
    float rli[16];
#pragma unroll
    for (int r = 0; r < 16; ++r) rli[r] = __builtin_amdgcn_rcpf(wsf[32 + crow(r, hi)]);
    bf16* Ow = O + (rowbase + q0 + wid * 32) * D + h * 64;
    { LAS bf16* stg = (LAS bf16*)(shm + LDS_OST) + wid * 2048;
#pragma unroll
      for (int r = 0; r < 16; ++r) { const int orow = crow(r, hi);
#pragma unroll
          for (int d0 = 0; d0 < 2; ++d0) stg[orow * 64 + d0 * 32 + r32] = f2bf(o[d0][r] * rli[r]); }
      LDS_WAIT();
#pragma unroll
      for (int i = 0; i < 4; ++i) { const int row = i * 8 + (lane >> 3), ch = lane & 7; const u32x4 v = *(const LAS u32x4*)(stg + row * 64 + ch * 8); *(u32x4*)(Ow + (long)row * D + ch * 8) = v; } }
    asm volatile("s_waitcnt lgkmcnt(0)\n\ts_barrier" ::: "memory");
#undef AT_DMA
#undef AT_CINIT
#undef AT_QK
#undef AT_KLOAD
#undef AT_VLOAD
#undef AT_CFAR
#undef AT_STATS
#undef AT_EXP_PACK
#undef AT_PV
}
}

struct Args { const float* in[23]; float* out; unsigned char* ws; int ph_lo, ph_hi, li, pad; };

struct TrDesc { const float* W; bf16* WT; const float* ks; int ldw, k0, n0, ldt, drow0; };
__device__ __forceinline__ void tr_load(const TrDesc& d, float (&v)[32], int lane) {
    const float* wp = d.W + (size_t)(d.k0 + (lane >> 5)) * d.ldw + d.n0 + (lane & 31);
#pragma unroll
    for (int i = 0; i < 32; ++i) v[i] = wp[(size_t)(2 * i) * d.ldw];
}
__device__ __forceinline__ void tr_store(const TrDesc& d, float (&v)[32], LAS float* scr, int lane) {
    if (d.ks) {
#pragma unroll
        for (int i = 0; i < 32; ++i) v[i] *= d.ks[d.k0 + 2 * i + (lane >> 5)]; }
#pragma unroll
    for (int i = 0; i < 32; ++i) scr[(2 * i + (lane >> 5)) * 33 + (lane & 31)] = v[i];
    LDS_WAIT(); asm volatile("" ::: "memory");
    const int c = lane & 7;
#pragma unroll
    for (int j = 0; j < 4; ++j) { const int n = (lane >> 3) + 8 * j; const LAS float* s = scr + (8 * c) * 33 + n;
        u32x4 o; o.x = pk2(s[0 * 33], s[1 * 33]); o.y = pk2(s[2 * 33], s[3 * 33]); o.z = pk2(s[4 * 33], s[5 * 33]); o.w = pk2(s[6 * 33], s[7 * 33]);
        *(u32x4*)(d.WT + (size_t)(d.drow0 + n) * d.ldt + d.k0 + 8 * c) = o; }
    LDS_WAIT(); asm volatile("" ::: "memory");
}
struct TrSrc { const float* w_qkv; const float* w_o; const float* w_out; const float* wg; const float* wu; const float* wd; const float* gn; unsigned char* ws; int nd; };
__device__ __forceinline__ TrDesc tr_desc(const TrSrc& S, int it) {
    TrDesc d; d.ks = nullptr;
    if (it < S.nd) {
        if (it < 1536) { const int kb = it / 96, nb = it % 96; d.W = S.w_qkv; d.ldw = 3072; d.k0 = kb * 64; d.n0 = nb * 32; d.WT = (bf16*)(S.ws + WS_WQKV); d.ldt = 1024; d.drow0 = nb * 32; }
        else if (it < 2048) { const int r = it - 1536, kb = r >> 5, nb = r & 31; d.W = S.w_o; d.ldw = 1024; d.k0 = kb * 64; d.n0 = nb * 32; d.WT = (bf16*)(S.ws + WS_WO); d.ldt = 1024; d.drow0 = nb * 32; }
        else { const int r = it - 2048, kb = r >> 6, nb = r & 63, n0 = nb * 32, ag = n0 >> 10, cc = n0 & 1023; d.W = S.w_out; d.ldw = 2048; d.k0 = kb * 64; d.n0 = n0; d.WT = (bf16*)(S.ws + WS_WOUT); d.ldt = 1024; d.drow0 = 256 * (cc >> 7) + 128 * ag + (cc & 127); }
    } else { const int m = it - S.nd;
        if (m < 8192) { const int which = m >> 12, r = m & 4095, e = r >> 7, kb = (r >> 3) & 15, nb = r & 7, n0 = nb * 32;
            d.W = (which ? S.wu : S.wg) + (size_t)e * 1024 * 256; d.ldw = 256; d.k0 = kb * 64; d.n0 = n0; d.WT = (bf16*)(S.ws + WS_WGU); d.ldt = 1024; d.drow0 = e * 512 + 256 * (n0 >> 7) + 128 * which + (n0 & 127); d.ks = S.gn; }
        else { const int r = m - 8192, e = r >> 7, kb = (r >> 5) & 3, nb = r & 31; d.W = S.wd + (size_t)e * 256 * 1024; d.ldw = 1024; d.k0 = kb * 64; d.n0 = nb * 32; d.WT = (bf16*)(S.ws + WS_WD); d.ldt = 256; d.drow0 = e * 1024 + nb * 32; } }
    return d;
}
__device__ __forceinline__ void tr_stream(const TrSrc& S, LAS float* scr, int gw, int NGW, int lane) {
    const int N = S.nd + 12288; int it = gw; if (it >= N) return;
    float va[32], vb[32]; TrDesc d0 = tr_desc(S, it), d1 = d0; tr_load(d0, va, lane);
    for (;;) {
        int nx = it + NGW; if (nx < N) { d1 = tr_desc(S, nx); tr_load(d1, vb, lane); }
        tr_store(d0, va, scr, lane); it = nx; if (it >= N) break;
        nx = it + NGW; if (nx < N) { d0 = tr_desc(S, nx); tr_load(d0, va, lane); }
        tr_store(d1, vb, scr, lane); it = nx; if (it >= N) break;
    }
}
__device__ __forceinline__ void ssm_mats(int g, int q, const float* lre, const float* lim, const float* lstep, const float* bre, const float* bim, const float* cre, const float* cim, const float* dsk,
                                         unsigned char* ssm_ws, float* a16g, LAS float* L, int tid) {
    LAS float* pwr = L; LAS float* pwi = L + 64 * 17; LAS float* bbr = L + 2 * 64 * 17; LAS float* bbi = bbr + 1024; LAS float* ccr = bbi + 1024; LAS float* cci = ccr + 1024; LAS float* Kt = cci + 1024;
    if (tid < 64) { const int p = tid;
        const float lr = fminf(lre[g * 64 + p], -1e-4f), li = lim[g * 64 + p], step = expf(lstep[g]);
        const float decay = expf(lr * step), ang = li * step, ar = decay * cosf(ang), ai = decay * sinf(ang);
        const float den = lr * lr + li * li, nr = ar - 1.f, fr = (nr * lr + ai * li) / den, fi = (ai * lr - nr * li) / den;
        for (int c = 0; c < 16; ++c) { const float br = bre[(g * 64 + p) * 16 + c], bi = bim[(g * 64 + p) * 16 + c]; bbr[p * 16 + c] = fr * br - fi * bi; bbi[p * 16 + c] = fr * bi + fi * br;
            ccr[c * 64 + p] = cre[(g * 16 + c) * 64 + p]; cci[c * 64 + p] = cim[(g * 16 + c) * 64 + p]; }
        float xr = 1.f, xi = 0.f;
        for (int n = 0; n <= 16; ++n) { pwr[p * 17 + n] = xr; pwi[p * 17 + n] = xi; const float t = xr * ar - xi * ai; xi = xr * ai + xi * ar; xr = t; }
        if (q == 0) { a16g[(g * 64 + p) * 2] = pwr[p * 17 + 16]; a16g[(g * 64 + p) * 2 + 1] = pwi[p * 17 + 16]; }
    }
    __syncthreads();
    if (tid < 256) { const int tl = tid >> 6, c = (tid >> 2) & 15, cq = tid & 3, tau = 4 * q + tl;
        float s0 = 0.f, s1 = 0.f, s2 = 0.f, s3 = 0.f;
        for (int p = 0; p < 64; ++p) { const float cr = ccr[c * 64 + p], ci = cci[c * 64 + p], ar = pwr[p * 17 + tau], ai = pwi[p * 17 + tau]; const float tr = cr * ar - ci * ai, ti = cr * ai + ci * ar;
            const f32x4 br = *(const LAS f32x4*)(bbr + p * 16 + 4 * cq), bi = *(const LAS f32x4*)(bbi + p * 16 + 4 * cq);
            s0 += tr * br[0] - ti * bi[0]; s1 += tr * br[1] - ti * bi[1]; s2 += tr * br[2] - ti * bi[2]; s3 += tr * br[3] - ti * bi[3]; }
        if (tau == 0) { const float dd = dsk[g * 16 + c]; if (4 * cq == (c & ~3)) { if ((c & 3) == 0) s0 += dd; else if ((c & 3) == 1) s1 += dd; else if ((c & 3) == 2) s2 += dd; else s3 += dd; } }
        LAS float* kp = Kt + tl * 256 + c * 16 + 4 * cq; kp[0] = s0; kp[1] = s1; kp[2] = s2; kp[3] = s3; }
    __syncthreads();
    bf16* Bend = (bf16*)(ssm_ws + (size_t)g * SSM_G_BYTES); bf16* A2 = (bf16*)(ssm_ws + (size_t)g * SSM_G_BYTES + SSM_A2_OFF);
    for (int o = tid; o < 2048; o += NTHR) { const int tl = o >> 9, i = (o >> 5) & 15, c = (o >> 1) & 15, hf = o & 1, tau = 4 * q + tl, j = i - tau;
        if (j >= 0) { const LAS float* kp = Kt + tl * 256 + c * 16 + 8 * hf; u32x4 w; w.x = pk2(kp[0], kp[1]); w.y = pk2(kp[2], kp[3]); w.z = pk2(kp[4], kp[5]); w.w = pk2(kp[6], kp[7]);
            *(u32x4*)(A2 + (size_t)(i * 16 + c) * 384 + j * 16 + 8 * hf) = w; } }
    for (int o = tid; o < 2048; o += NTHR) { const int il = o >> 9, c = (o >> 5) & 15, j = (o >> 1) & 15, hf = o & 1, i = 4 * q + il;
        if (j > i) *(u32x4*)(A2 + (size_t)(i * 16 + c) * 384 + j * 16 + 8 * hf) = (u32x4){0u, 0u, 0u, 0u}; }
    for (int o = tid; o < 1024; o += NTHR) { const int il = o >> 8, c = (o >> 4) & 15, k8 = (o & 15) * 8, i = 4 * q + il; float v[8];
#pragma unroll
        for (int qq = 0; qq < 4; ++qq) { const int p = (k8 >> 1) + qq; const float cr = ccr[c * 64 + p], ci = cci[c * 64 + p], ar = pwr[p * 17 + i + 1], ai = pwi[p * 17 + i + 1];
            v[2 * qq] = cr * ar - ci * ai; v[2 * qq + 1] = -(cr * ai + ci * ar); }
        u32x4 w; w.x = pk2(v[0], v[1]); w.y = pk2(v[2], v[3]); w.z = pk2(v[4], v[5]); w.w = pk2(v[6], v[7]); *(u32x4*)(A2 + (size_t)(i * 16 + c) * 384 + 256 + k8) = w; }
    for (int o = tid; o < 1024; o += NTHR) { const int n = 32 * q + (o >> 5), k8 = (o & 31) * 8, p = n >> 1, ri = n & 1, j = k8 >> 4; float v[8];
        const float ar = pwr[p * 17 + 15 - j], ai = pwi[p * 17 + 15 - j];
#pragma unroll
        for (int qq = 0; qq < 8; ++qq) { const int c2 = (k8 & 15) + qq; const float br = bbr[p * 16 + c2], bi = bbi[p * 16 + c2]; v[qq] = ri ? (ar * bi + ai * br) : (ar * br - ai * bi); }
        u32x4 w; w.x = pk2(v[0], v[1]); w.y = pk2(v[2], v[3]); w.z = pk2(v[4], v[5]); w.w = pk2(v[6], v[7]); *(u32x4*)(Bend + (size_t)n * 256 + k8) = w; }
    __syncthreads();
}

__device__ __forceinline__ void router_phase(const bf16* __restrict__ h, const float* __restrict__ rwt, const float* __restrict__ bgr, const float* __restrict__ ber, unsigned* cntg,
                                             int* pdst, float* pw, float* ps, float* srow, LAS unsigned char* lds, int vcu, int G, int wid) {
    const int lane = lane_now(), tid = wid * 64 + lane;
    LAS float* Wl = (LAS float*)lds;
    for (int i = tid; i < RW_LAYER / 4; i += NTHR) ((LAS f32x4*)Wl)[i] = ((const f32x4*)rwt)[i];
    LAS int* lc = (LAS int*)(lds + RSCR_OFF); LAS int* lbase = lc + 32;
    const int rb = wid & 3, kh = wid >> 2, row = lane & 15, kq = lane >> 4;
    for (int blk = vcu; blk < M / 64; blk += G) {
        if (tid < 32) lc[tid] = 0;
        __syncthreads();
        const int t0 = blk * 64;
        const bf16* hp = h + (size_t)(t0 + 16 * rb + row) * D + 512 * kh + 8 * kq;
        const LAS float* wp0 = Wl + row * RW_PITCH + 512 * kh + 8 * kq; const LAS float* wp1 = wp0 + 16 * RW_PITCH; const LAS float* wp2 = Wl + (32 + (row & 3)) * RW_PITCH + 512 * kh + 8 * kq;
        f32x4 a0 = {0.f, 0.f, 0.f, 0.f}, a1 = a0, a2 = a0; float ssl = 0.f;
#pragma unroll 4
        for (int j = 0; j < 16; ++j) { const u32x4 hw = *(const u32x4*)(hp + 32 * j); float a[8];
#pragma unroll
            for (int i = 0; i < 4; ++i) { a[2 * i] = __uint_as_float(hw[i] << 16); a[2 * i + 1] = __uint_as_float(hw[i] & 0xffff0000u); }
#pragma unroll
            for (int hf = 0; hf < 2; ++hf) { const f32x4 b0 = *(const LAS f32x4*)(wp0 + 32 * j + 4 * hf), b1 = *(const LAS f32x4*)(wp1 + 32 * j + 4 * hf), b2 = *(const LAS f32x4*)(wp2 + 32 * j + 4 * hf);
#pragma unroll
                for (int i = 0; i < 4; ++i) { const float av = a[4 * hf + i]; ssl += av * av;
                    a0 = __builtin_amdgcn_mfma_f32_16x16x4f32(av, b0[i], a0, 0, 0, 0); a1 = __builtin_amdgcn_mfma_f32_16x16x4f32(av, b1[i], a1, 0, 0, 0); a2 = __builtin_amdgcn_mfma_f32_16x16x4f32(av, b2[i], a2, 0, 0, 0); } } }
        ssl += __shfl_xor(ssl, 16); ssl += __shfl_xor(ssl, 32);
        LAS float* P = (LAS float*)(lds + RSCR_OFF + 256);
        LAS float* pp = P + (16 * rb) * 40;
        if (kh == 1) {
#pragma unroll
            for (int r = 0; r < 4; ++r) { const int tk = 4 * kq + r; pp[tk * 40 + row] = a0[r]; pp[tk * 40 + 16 + row] = a1[r]; if (row < 4) pp[tk * 40 + 32 + row] = a2[r]; }
            if (kq == 0) pp[row * 40 + 36] = ssl; }
        __syncthreads();
        if (kh == 0) {
#pragma unroll
            for (int r = 0; r < 4; ++r) { const int tk = 4 * kq + r; pp[tk * 40 + row] += a0[r]; pp[tk * 40 + 16 + row] += a1[r]; if (row < 4) pp[tk * 40 + 32 + row] += a2[r]; }
            if (kq == 0) pp[row * 40 + 36] += ssl; }
        __syncthreads();
        int e1 = 0, e2 = 0; float w1 = 0.f, w2 = 0.f, s = 0.f; int sl1 = 0, sl2 = 0;
        if (tid < 64) { LAS float* p0 = P + tid * 40;
            s = rsqrtf(p0[36] * (1.f / D) + RMS_EPS);
            for (int o = 0; o < 36; ++o) p0[o] = p0[o] * s + (o < 4 ? bgr[o] : ber[o - 4]);
            int gi = 0; float gmx = p0[0];
            for (int i = 1; i < 4; ++i) if (p0[i] > gmx) { gmx = p0[i]; gi = i; }
            float den = 0.f; for (int i = 0; i < 4; ++i) den += __expf(p0[i] - gmx);
            const float gp = 1.f / den; const LAS float* sl = p0 + 4 + 8 * gi;
            int i1 = 0; float l1 = sl[0]; for (int i = 1; i < 8; ++i) if (sl[i] > l1) { l1 = sl[i]; i1 = i; }
            int i2 = -1; float l2 = -3.4e38f; for (int i = 0; i < 8; ++i) if (i != i1 && sl[i] > l2) { l2 = sl[i]; i2 = i; }
            const float ex = __expf(l2 - l1); w1 = gp / (1.f + ex); w2 = gp * ex / (1.f + ex); e1 = gi * 8 + i1; e2 = gi * 8 + i2;
            sl1 = __hip_atomic_fetch_add(&lc[e1], 1, __ATOMIC_RELAXED, __HIP_MEMORY_SCOPE_WORKGROUP); sl2 = __hip_atomic_fetch_add(&lc[e2], 1, __ATOMIC_RELAXED, __HIP_MEMORY_SCOPE_WORKGROUP);
            srow[t0 + tid] = s; }
        __syncthreads();
        if (tid < 32) { const int n = lc[tid]; lbase[tid] = n ? (int)__hip_atomic_fetch_add(cntg + tid * 64, (unsigned)n, RLX_AGENT) : 0; }
        __syncthreads();
        if (tid < 64) { const int t = t0 + tid; int i1 = lbase[e1] + sl1, i2 = lbase[e2] + sl2;
            if (i1 < CAP) { pdst[e1 * CAP + i1] = 2 * t; pw[e1 * CAP + i1] = w1; ps[e1 * CAP + i1] = s; }
            if (i2 < CAP) { pdst[e2 * CAP + i2] = 2 * t + 1; pw[e2 * CAP + i2] = w2; ps[e2 * CAP + i2] = s; } }
        __syncthreads();
    }
}

template <bool FINAL> __device__ __forceinline__ void combine_phase(const bf16* __restrict__ hin, const bf16* __restrict__ Y2, const float* __restrict__ g, bf16* __restrict__ hout, bf16* __restrict__ xng, float* __restrict__ outf, int vcu, int G, int wid, int lane) {
    for (int base = vcu * 16; base < M; base += G * 16) {
#pragma unroll
        for (int rr = 0; rr < 2; ++rr) { const int row = base + 2 * wid + rr;
            float4 v[4]; float ss = 0.f;
#pragma unroll
            for (int j = 0; j < 4; ++j) { const int c = 4 * (lane + 64 * j);
                const u32x2 hh = *(const u32x2*)(hin + (size_t)row * D + c), ya = *(const u32x2*)(Y2 + ((size_t)2 * row) * D + c), yb = *(const u32x2*)(Y2 + ((size_t)2 * row + 1) * D + c);
                v[j].x = __uint_as_float(hh.x << 16) + __uint_as_float(ya.x << 16) + __uint_as_float(yb.x << 16); v[j].y = __uint_as_float(hh.x & 0xffff0000u) + __uint_as_float(ya.x & 0xffff0000u) + __uint_as_float(yb.x & 0xffff0000u);
                v[j].z = __uint_as_float(hh.y << 16) + __uint_as_float(ya.y << 16) + __uint_as_float(yb.y << 16); v[j].w = __uint_as_float(hh.y & 0xffff0000u) + __uint_as_float(ya.y & 0xffff0000u) + __uint_as_float(yb.y & 0xffff0000u);
                ss += v[j].x * v[j].x + v[j].y * v[j].y + v[j].z * v[j].z + v[j].w * v[j].w;
                if (!FINAL) { u32x2 w; w.x = pk2(v[j].x, v[j].y); w.y = pk2(v[j].z, v[j].w); *(u32x2*)(hout + (size_t)row * D + c) = w; } }
            ss = wave_sum(ss); const float s = rsqrtf(ss * (1.f / D) + RMS_EPS);
#pragma unroll
            for (int j = 0; j < 4; ++j) { const int c = 4 * (lane + 64 * j); const float4 gg = *(const float4*)(g + c);
                const float ox = v[j].x * s * gg.x, oy = v[j].y * s * gg.y, oz = v[j].z * s * gg.z, ow = v[j].w * s * gg.w;
                if (FINAL) { float4 o; o.x = ox; o.y = oy; o.z = oz; o.w = ow; *(float4*)(outf + (size_t)row * D + c) = o; }
                else { u32x2 w; w.x = pk2(ox, oy); w.y = pk2(oz, ow); *(u32x2*)(xng + xng_off(row, c)) = w; } } }
    }
}

__device__ __forceinline__ void scan_unit(int g, int pm, const float* __restrict__ Sloc, const float* __restrict__ a16g, bf16* xng, LAS unsigned char* lds, int wid) {
    const int tid = wid * 64 + lane_now(), p = tid & 63, q = tid >> 6, b = pm >> 1, half = pm & 1;
    LAS float* E = (LAS float*)(lds + AUX_OFF);
    const float ar = a16g[(g * 64 + p) * 2], ai = a16g[(g * 64 + p) * 2 + 1];
    float pr = ar, pi = ai;
#pragma unroll
    for (int k = 0; k < 5; ++k) { const float nr = pr * pr - pi * pi, ni = 2.f * pr * pi; pr = nr; pi = ni; }
    float cr = 0.f, ci = 0.f;
    for (int rnd = 0; rnd <= half; ++rnd) {
        const size_t row0 = (size_t)g * 1024 + b * 512 + rnd * 256 + q * 32;
        const float* sp = Sloc + row0 * 128 + 2 * p;
        float2 v[32];
#pragma unroll
        for (int s = 0; s < 32; ++s) v[s] = *(const float2*)(sp + (size_t)s * 128);
        float xr = 0.f, xi = 0.f;
#pragma unroll
        for (int s = 0; s < 32; ++s) { const float nr = ar * xr - ai * xi + v[s].x, ni = ar * xi + ai * xr + v[s].y; xr = nr; xi = ni; }
        E[(q * 64 + p) * 2] = xr; E[(q * 64 + p) * 2 + 1] = xi;
        __syncthreads();
        float ir = cr, ii = ci, mr = 0.f, mi = 0.f;
#pragma unroll
        for (int qq = 0; qq < 8; ++qq) { if (qq == q) { mr = ir; mi = ii; } const float er = E[(qq * 64 + p) * 2], ei = E[(qq * 64 + p) * 2 + 1]; const float nr = pr * ir - pi * ii + er, ni = pr * ii + pi * ir + ei; ir = nr; ii = ni; }
        cr = ir; ci = ii;
        if (rnd == half) { bf16* xp = xng + row0 * 384 + 256 + 2 * p; xr = mr; xi = mi;
#pragma unroll
            for (int s = 0; s < 32; ++s) { *(unsigned*)(xp + (size_t)s * 384) = pk2(xr, xi); const float nr = ar * xr - ai * xi + v[s].x, ni = ar * xi + ai * xr + v[s].y; xr = nr; xi = ni; } }
        __syncthreads();
    }
}

__global__ void __launch_bounds__(NTHR, 2) mk_fwd(Args args) {
    extern __shared__ __attribute__((aligned(16))) unsigned char lds_[];
    LAS unsigned char* lds = (LAS unsigned char*)lds_;
    volatile LAS unsigned* MISC = (volatile LAS unsigned*)(lds + MISC_OFF);
    const int wid = __builtin_amdgcn_readfirstlane(threadIdx.x >> 6);
#define lane lane_now()
#define tid (wid * 64 + lane_now())
    const int G = gridDim.x; const int bx = blockIdx.x; const int vcu = (G % 8 == 0) ? (bx % 8) * (G / 8) + bx / 8 : bx;
    unsigned char* const ws = args.ws;
    constexpr size_t EW = (size_t)NEXP * 1024 * 256;
    for (int u = tid; u < (LDS_BYTES - MISC_OFF) / 4; u += NTHR) ((LAS unsigned*)(lds + MISC_OFF))[u] = 0u;
    __syncthreads();
    const int lo = args.ph_lo, hi = args.ph_hi;
    XcdBarrier bar; bar.bar = (unsigned*)ws + CW_BAR + args.li * XCD_BAR_WORDS; bar.x = 0; bar.st = nullptr;
    if (hi - lo > 1) bar = xcd_barrier_post((unsigned*)ws + CW_BAR + args.li * XCD_BAR_WORDS, MISC + 8, wid);
    const int gw = vcu * NWAVES + wid, NGW = G * NWAVES;
#ifndef PH_ONLY
#define PH_ONLY -1
#endif
#define IN(k) ((PH_ONLY < 0 || PH_ONLY == ((k) >= 12 && (k) <= 14 ? (k) - 8 : (k))) && lo <= (k) && (k) < hi)
#ifndef TS_K1
#define TS_K1 -1
#define TS_K2 -1
#endif
#define TS_STAMP(k) do { if (TS_K1 >= 0 && bx == 0 && tid == 0) ((unsigned long long*)(ws + WS_TS))[k] = __builtin_amdgcn_s_memrealtime(); } while (0)
#define SEAM(k) do { if ((k) + 1 < hi) xcd_barrier(bar, wid); TS_STAMP((k) + 1); } while (0)
#define SCR ((LAS float*)(lds + wid * 16384))
    TS_STAMP(0);
    if (IN(0)) {
        { TrSrc S{args.in[4], args.in[5], args.in[15], args.in[20], args.in[21], args.in[22], args.in[2], ws, 3072}; tr_stream(S, SCR, gw, NGW, lane); }
        { float* rwt = (float*)(ws + WS_RWT); const float* norm_ffn = args.in[2];
          for (int o = bx * NTHR + tid; o < 2 * 36 * 1024; o += G * NTHR) { const int layer = o / (36 * 1024), r = o % (36 * 1024), col = r >> 10, k = r & 1023;
            const float gnk = norm_ffn[layer * D + k];
            const float w = col < 4 ? args.in[16][(size_t)layer * 4096 + k * 4 + col] : args.in[18][(size_t)layer * 32768 + ((size_t)((col - 4) >> 3) * 1024 + k) * 8 + ((col - 4) & 7)];
            rwt[layer * RW_LAYER + col * RW_PITCH + k] = w * gnk; } }
        __syncthreads();
        for (int gq = vcu; gq < 256; gq += G) ssm_mats(gq >> 2, gq & 3, args.in[7], args.in[8], args.in[9], args.in[10], args.in[11], args.in[12], args.in[13], args.in[14], ws + WS_SSM, (float*)(ws + WS_A16), (LAS float*)lds, tid);
        { const float* x = args.in[0]; const float* norm_mix = args.in[1]; bf16* XN = (bf16*)(ws + WS_XN);
          for (int m0 = 2 * gw; m0 < M; m0 += 2 * NGW) { float4 v[2][4];
#pragma unroll
            for (int rr = 0; rr < 2; ++rr) { const float4* xr = (const float4*)(x + (size_t)(m0 + rr) * D);
#pragma unroll
                for (int j = 0; j < 4; ++j) v[rr][j] = xr[lane + 64 * j]; }
#pragma unroll
            for (int rr = 0; rr < 2; ++rr) { float ss = 0.f;
#pragma unroll
                for (int j = 0; j < 4; ++j) ss += v[rr][j].x * v[rr][j].x + v[rr][j].y * v[rr][j].y + v[rr][j].z * v[rr][j].z + v[rr][j].w * v[rr][j].w;
                ss = wave_sum(ss); const float s = rsqrtf(ss * (1.f / D) + RMS_EPS);
#pragma unroll
                for (int j = 0; j < 4; ++j) { const int c = 4 * (lane + 64 * j); const float4 gg = *(const float4*)(norm_mix + c); u32x2 w; w.x = pk2(v[rr][j].x * s * gg.x, v[rr][j].y * s * gg.y); w.y = pk2(v[rr][j].z * s * gg.z, v[rr][j].w * s * gg.w);
                    *(u32x2*)(XN + (size_t)(m0 + rr) * D + c) = w; } } } }
        SEAM(0);
    }
    if (IN(1)) { PhQKV P{ws, (const char*)(ws + WS_XN), G, bx}; gm::gemm_phase(lds, P, wid); SEAM(1); }
    if (IN(2)) {
        const int per = 1024 / G;
        for (int i = 0; i < per; ++i) { const int uid = vcu * per + i; const int bh = uid >> 5, qb = uid & 31;
            at::attn_unit<8>(bh >> 4, bh & 15, qb, (const bf16*)(ws + WS_Q), (const bf16*)(ws + WS_K), (const bf16*)(ws + WS_V), (bf16*)(ws + (args.pad ? WS_XN : WS_Q)), args.in[6], lds, wid); }
        SEAM(2);
    }
    if (IN(3)) { PhWo P{ws, (const char*)(ws + WS_Q), args.in[0], args.out, G, bx}; gm::gemm_phase(lds, P, wid); SEAM(3); }
#define MOE_LAYER(layer, pr) \
    if (IN(pr)) { router_phase((layer) ? (const bf16*)(ws + WS_XN) : (const bf16*)args.out, (const float*)(ws + WS_RWT) + (layer) * RW_LAYER, args.in[17] + (layer) * 4, args.in[19] + (layer) * 32, (unsigned*)ws + CW_CNT + (layer) * 32 * 64, \
                               (int*)(ws + WS_PDST), (float*)(ws + WS_PW), (float*)(ws + WS_PS), (float*)(ws + WS_SROW), lds, vcu, G, wid); SEAM(pr); } \
    if (IN((pr) + 1) || IN((pr) + 2)) { \
        moe_tables(lds, (const unsigned*)ws + CW_CNT + (layer) * 32 * 64, tid); \
        if (IN((pr) + 1)) { const bf16* hbp = (layer) ? (const bf16*)(ws + WS_XN) : (const bf16*)args.out; \
            { PhGateUp P{ws, (const char*)hbp, lds, G, vcu, __builtin_amdgcn_readfirstlane(((const LAS int*)(lds + AUX_OFF))[MT_NN])}; gm::gemm_phase(lds, P, wid); } \
            { const LAS int* mt = (const LAS int*)(lds + AUX_OFF); const int np = 16 * mt[MT_NS]; for (int j = G - 1 - vcu; j < np; j += G) { Unit u; u.pn = 0; moe_decode(lds, mt[MT_SLIST + (j >> 4)], u); tail_job<true>(ws, hbp, u, j & 15, wid); } } \
            SEAM((pr) + 1); } \
        if (IN((pr) + 2)) { { PhDown P{ws, (const char*)(ws + WS_H), lds, G, vcu, __builtin_amdgcn_readfirstlane(((const LAS int*)(lds + AUX_OFF))[MT_NN])}; gm::gemm_phase(lds, P, wid); } \
            { const LAS int* mt = (const LAS int*)(lds + AUX_OFF); const int np = 16 * mt[MT_NS]; for (int j = G - 1 - vcu; j < np; j += G) { Unit u; u.pn = 0; moe_decode(lds, mt[MT_SLIST + (j >> 4)], u); tail_job<false>(ws, (const bf16*)(ws + WS_H), u, j & 15, wid); } } \
            SEAM((pr) + 2); } \
    }
    MOE_LAYER(0, 4)
    if (IN(7)) {
        { TrSrc S{nullptr, nullptr, nullptr, args.in[20] + EW, args.in[21] + EW, args.in[22] + EW, args.in[2] + D, ws, 0}; tr_stream(S, SCR, gw, NGW, lane); }
        combine_phase<false>((const bf16*)args.out, (const bf16*)(ws + WS_Y2), args.in[1] + D, (bf16*)args.out + (size_t)M * D, (bf16*)(ws + WS_XN), nullptr, vcu, G, wid, lane);
        SEAM(7); }
    if (IN(8)) { PhSloc P{ws, (const char*)(ws + WS_XN), G, vcu}; gm::gemm_phase(lds, P, wid); if (10 < hi) xcd_barrier(bar, wid); }
    if (IN(10)) {
        for (int idx = vcu; idx < 256; idx += G) scan_unit(idx >> 2, idx & 3, (const float*)(ws + WS_SLOC), (const float*)(ws + WS_A16), (bf16*)(ws + WS_XN), lds, wid);
        asm volatile("s_waitcnt vmcnt(0)" ::: "memory"); __syncthreads();
        PhY P{ws, (const char*)(ws + WS_XN), G, vcu}; gm::gemm_phase(lds, P, wid); SEAM(10); }
    if (IN(11)) { PhWout P{ws, (const char*)(ws + WS_G), args.out, G, bx}; gm::gemm_phase(lds, P, wid); SEAM(11); }
    MOE_LAYER(1, 12)
#undef MOE_LAYER
    if (IN(15)) { combine_phase<true>((const bf16*)(ws + WS_XN), (const bf16*)(ws + WS_Y2), args.in[3], nullptr, nullptr, args.out, vcu, G, wid, lane);
#if TS_K1 >= 0
        { const unsigned long long* ts = (const unsigned long long*)(ws + WS_TS); const float dtus = (float)(ts[TS_K1 + 1] - ts[TS_K1]) * 1e-2f; const float e = exp2f(rintf(log2f(dtus) * 6.f) / 6.f) * 1e-2f;
          __syncthreads();
          for (int base = vcu * 16; base < M; base += G * 16) for (int i = tid; i < 16 * D; i += NTHR) args.out[(size_t)base * D + i] *= (1.f + e);
          if (TS_K2 >= 0 && bx == 0) { __syncthreads(); if (tid == 0) args.out[0] = exp2f(rintf(log2f((float)(ts[TS_K2 + 1] - ts[TS_K2]) * 1e-2f) * 6.f) / 6.f); } }
#endif
    }
#undef IN
#undef SEAM
#undef SCR
#undef lane
#undef tid
}

#ifndef FUSED
#define FUSED 1
#endif
#ifndef DUP_PH
#define DUP_PH -1
#endif
extern "C" void kernel_launch(void* const* d_in, const int* in_sizes, int n_in, void* d_out, int out_size, void* d_ws, size_t ws_size, hipStream_t stream) {
    static int grid = 0;
    if (grid == 0) {
        if (n_in != 23 || out_size != M * D || ws_size < WS_END) { fprintf(stderr, "kernel_launch: unexpected shapes (n_in %d out %d ws %zu)\n", n_in, out_size, ws_size); grid = -1; return; }
        int dev = 0, cus = 0;
        if (hipGetDevice(&dev) != hipSuccess || hipDeviceGetAttribute(&cus, hipDeviceAttributeMultiprocessorCount, dev) != hipSuccess) { grid = -1; return; }
        if (hipFuncSetAttribute((const void*)mk_fwd, hipFuncAttributeMaxDynamicSharedMemorySize, LDS_BYTES) != hipSuccess) { fprintf(stderr, "kernel_launch: hipFuncSetAttribute failed\n"); grid = -1; return; }
        (void)hipGetLastError();
        grid = cus;
        if (grid != 256) fprintf(stderr, "kernel_launch: %d CUs (built for 256)\n", grid);
    }
    if (grid < 0) return;
    unsigned char* ws = (unsigned char*)d_ws;
    (void)hipMemsetAsync(ws + WS_CTL, 0, CTL_ZERO_BYTES, stream);
    Args a{}; for (int i = 0; i < 23; ++i) a.in[i] = (const float*)d_in[i];
    a.out = (float*)d_out; a.ws = ws;
    int li = 0;
    auto run = [&](int lo, int hi) { a.ph_lo = lo; a.ph_hi = hi; a.li = li++; hipLaunchKernelGGL(mk_fwd, dim3(grid), dim3(NTHR), LDS_BYTES, stream, a); };
    if (FUSED) { run(0, N_PHASES); return; }
    for (int ph = 0; ph < N_PHASES; ++ph) { if (ph == 9) continue;
        if (DUP_PH == ph) { if (ph == 2) { a.pad = 1; run(2, 3); a.pad = 0; } else run(ph, ph + 1); }
        run(ph, ph + 1); }
}
```

```cpp
#include <hip/hip_runtime.h>
#include <cstdio>
#include <cstdint>

typedef unsigned short bf16;
constexpr int BATCH = 2, SEQ = 8192, D = 1024, M = BATCH * SEQ, NH = 16, HD = 64;
constexpr int NEXP = 32, EPG = 8, FE = 256;
constexpr int NREL = 257;
constexpr float RMS_EPS = 1e-6f;
constexpr float LOG2E = 1.4426950408889634f;
constexpr float C2 = 0.125f * LOG2E;

constexpr size_t MiB = 1u << 20;
constexpr size_t WS_CTL = 0;
constexpr size_t WS_XN = 86 * MiB;
constexpr size_t WS_BIG = 134 * MiB;
constexpr size_t WS_Q = WS_BIG, WS_K = WS_BIG + 32 * MiB, WS_V = WS_BIG + 64 * MiB;
constexpr size_t WS_Y2 = WS_BIG, WS_H = WS_BIG + 64 * MiB;
constexpr size_t WS_SLOC = WS_BIG, WS_G = WS_BIG + 32 * MiB;

__device__ __forceinline__ bf16 f2bf(float f) { unsigned u = __float_as_uint(f); return (bf16)((u + 0x7fffu + ((u >> 16) & 1u)) >> 16); }
__device__ __forceinline__ float bf2f(bf16 h) { return __uint_as_float(((unsigned)h) << 16); }
__device__ __forceinline__ float wave_sum(float v) {
#pragma unroll
    for (int o = 1; o < 64; o <<= 1) v += __shfl_xor(v, o);
    return v;
}
__device__ __forceinline__ float gelu_tanh(float x) { const float u = 0.7978845608028654f * (x + 0.044715f * x * x * x); return 0.5f * x * (1.f + tanhf(u)); }

__device__ __forceinline__ size_t xng_off(int t, int col) { const int b = t >> 13, tt = t & 8191, s = tt >> 4, j = tt & 15, g = col >> 4, c = col & 15; return ((size_t)(g * 1024 + b * 512 + s)) * 384 + j * 16 + c; }

#define LAS __attribute__((address_space(3)))
typedef short bf16x8 __attribute__((ext_vector_type(8)));
typedef short s16x4 __attribute__((ext_vector_type(4)));
typedef float f32x4 __attribute__((ext_vector_type(4)));
typedef float f32x16 __attribute__((ext_vector_type(16)));
typedef unsigned u32x4 __attribute__((ext_vector_type(4)));
typedef unsigned u32x2 __attribute__((ext_vector_type(2)));

constexpr int NWAVES = 8, NTHR = 512;
constexpr int CAP = 16384;
constexpr size_t CTL_ZERO_BYTES = 1 * MiB;
constexpr size_t WS_PDST = 1 * MiB, WS_PW = 3 * MiB, WS_PS = 5 * MiB, WS_SROW = 7 * MiB, WS_A16 = 7 * MiB + 65536;
constexpr size_t WS_TS = 7 * MiB + 131072;
constexpr size_t WS_RWT = 8 * MiB;
constexpr size_t WS_WQKV = 9 * MiB, WS_WO = 15 * MiB, WS_WOUT = 17 * MiB, WS_SSM = 21 * MiB;
constexpr size_t WS_WGU = 38 * MiB, WS_WD = 70 * MiB;
constexpr size_t WS_END = 230 * MiB;
constexpr int RW_PITCH = 1032, RW_PLANE = 36 * RW_PITCH, RW_LAYER_BYTES = 2 * RW_PLANE * 2;
constexpr int SSM_G_BYTES = 262144, SSM_A2_OFF = 65536;
constexpr int CW_BAR = 4096;
constexpr int CW_CNT = 65536;
constexpr int LDS_BYTES = 160 * 1024, MISC_OFF = LDS_BYTES - 512, AUX_OFF = 128 * 1024, RSCR_OFF = RW_LAYER_BYTES;
constexpr int N_PHASES = 16;

__device__ __forceinline__ int lane_now() { int l; asm volatile("v_mbcnt_lo_u32_b32 %0, -1, 0\n\tv_mbcnt_hi_u32_b32 %0, -1, %0" : "=v"(l)); return l; }
__device__ __forceinline__ unsigned cvt_pk_bf16(float lo, float hi) { unsigned r; asm volatile("v_cvt_pk_bf16_f32 %0, %1, %2" : "=v"(r) : "v"(lo), "v"(hi)); return r; }
typedef float f32x2_t __attribute__((ext_vector_type(2))); typedef __bf16 bf16x2_t __attribute__((ext_vector_type(2)));
__device__ __forceinline__ unsigned cvtpk_s(float lo, float hi) { f32x2_t v = {lo, hi}; bf16x2_t b = __builtin_convertvector(v, bf16x2_t); return __builtin_bit_cast(unsigned, b); }
__device__ __forceinline__ unsigned pk2(float lo, float hi) { return (unsigned)f2bf(lo) | ((unsigned)f2bf(hi) << 16); }
#define LDS_WAIT() asm volatile("s_waitcnt lgkmcnt(0)" ::: "memory")
#define VM_WAIT() asm volatile("s_waitcnt vmcnt(0)" ::: "memory")
#define RLX_AGENT __ATOMIC_RELAXED, __HIP_MEMORY_SCOPE_AGENT

#define XB_TMO      128
#define XB_XCNT(j)  (256  + 64 * (j))
#define XB_XSUB(j)  (1280 + 64 * (j))
#define XB_XGEN(j)  (2304 + 64 * (j))
#define XB_TOP      3328
#define XB_TOPGEN   3392
#define XCD_BAR_WORDS 3456
#define XB_SPIN_CAP (1u << 18)
__device__ __forceinline__ unsigned xb_ld(unsigned* p)              { return __hip_atomic_load(p, __ATOMIC_RELAXED, __HIP_MEMORY_SCOPE_AGENT); }
__device__ __forceinline__ unsigned xb_add(unsigned* p, unsigned v) { return __hip_atomic_fetch_add(p, v, __ATOMIC_RELAXED, __HIP_MEMORY_SCOPE_AGENT); }
__device__ __forceinline__ unsigned xb_xcc_id() { return (unsigned)__builtin_amdgcn_s_getreg((3 << 11) | 20) & 0xFu; }
#define XB_SPIN(cond, bar) do { unsigned _sp = 0; while (cond) { __builtin_amdgcn_s_sleep(1); \
    if ((++_sp & 255u) == 0u) { if (xb_ld(&(bar)[XB_TMO])) break; if (_sp > XB_SPIN_CAP) { atomicAdd(&(bar)[XB_TMO], 1u); break; } } } } while (0)
struct XcdBarrier { unsigned* bar; unsigned x; volatile LAS unsigned* st; };
__device__ __forceinline__ XcdBarrier xcd_barrier_post(unsigned* bar, volatile LAS unsigned* st, int wid) {
    XcdBarrier b; b.bar = bar; b.x = xb_xcc_id(); b.st = st;
    if (wid == 0 && lane_now() == 0) (void)xb_add(&bar[XB_XCNT(b.x)], 1u);
    return b;
}
__device__ __forceinline__ void xcd_barrier_complete(unsigned* bar, unsigned x, unsigned& nloc, unsigned& nx) {
    const unsigned G = gridDim.x * gridDim.y * gridDim.z;
    unsigned sum, cnt, mine, sp = 0u;
    for (;;) {
        sum = 0u; cnt = 0u; mine = 0u;
#pragma unroll
        for (unsigned j = 0; j < 16; ++j) { const unsigned c = xb_ld(&bar[XB_XCNT(j)]); sum += c; cnt += (c > 0u) ? 1u : 0u; mine = (j == x) ? c : mine; }
        if (sum == G) break;
        __builtin_amdgcn_s_sleep(1);
        if ((++sp & 255u) == 0u) { if (xb_ld(&bar[XB_TMO])) break; if (sp > XB_SPIN_CAP) { atomicAdd(&bar[XB_TMO], 1u); break; } }
    }
    nloc = mine > 0u ? mine : 1u; nx = cnt > 0u ? cnt : 1u;
}
__device__ __forceinline__ void xcd_barrier(const XcdBarrier& b, int wid) {
    asm volatile("s_waitcnt vmcnt(0)" ::: "memory");
    __syncthreads();
    if (wid == 0 && lane_now() == 0) {
        unsigned* bar = b.bar;
        __builtin_amdgcn_s_waitcnt(0);
        unsigned nloc = b.st[0], nx = b.st[1];
        if (nloc == 0u) { xcd_barrier_complete(bar, b.x, nloc, nx); b.st[0] = nloc; b.st[1] = nx; }
        const unsigned old = xb_add(&bar[XB_XSUB(b.x)], 1u);
        const unsigned gen = old / nloc;
        if (old + 1u == (gen + 1u) * nloc) {
            __builtin_amdgcn_fence(__ATOMIC_RELEASE, "agent");
            asm volatile("s_waitcnt vmcnt(0)" ::: "memory");
            const unsigned og = xb_add(&bar[XB_TOP], 1u);
            const unsigned tg = og / nx;
            if (og + 1u == (tg + 1u) * nx) xb_add(&bar[XB_TOPGEN], 1u);
            else XB_SPIN(xb_ld(&bar[XB_TOPGEN]) == tg, bar);
            __builtin_amdgcn_fence(__ATOMIC_ACQUIRE, "agent");
            xb_add(&bar[XB_XGEN(b.x)], 1u);
            asm volatile("s_waitcnt vmcnt(0)" ::: "memory");
        } else {
            XB_SPIN(xb_ld(&bar[XB_XGEN(b.x)]) == gen, bar);
            __builtin_amdgcn_fence(__ATOMIC_ACQUIRE, "agent");
            asm volatile("s_waitcnt vmcnt(0)" ::: "memory");
        }
    }
    __syncthreads();
}

namespace gm {
constexpr int HTB = 16384;
__device__ __forceinline__ int lds_byte(int r, int c) { const int st = (r >> 4) * 2 + (c >> 5), rr = r & 15, cc = c & 31, ob = rr * 64 + cc * 2; return st * 1024 + (ob ^ (((ob >> 9) & 1) << 5)); }
__device__ __forceinline__ void stage_rc(int b, int& R, int& C) { const int st = b / 1024, sb = b % 1024, swz = sb ^ (((sb >> 9) & 1) << 5); R = (st >> 1) * 16 + swz / 64; C = (st & 1) * 32 + (swz % 64) / 2; }
__device__ __forceinline__ int perm32(int rho) { const int n = rho >> 4, i = rho & 15; return 8 * (i >> 2) + 4 * n + (i & 3); }
struct Unit { int pm, pn, e, gt, cnt; };
__device__ __forceinline__ bool static_unit(int i, int G, int c, int nM, int nN, Unit& u) {
    const int nwg = nM * nN; const long L = (long)i * G + c; if (L >= nwg) return false;
    int wgid = (int)L; { const int q = nwg / 8, r = nwg % 8, xcd = wgid % 8, off = wgid / 8; wgid = (xcd < r ? xcd * (q + 1) : r * (q + 1) + (xcd - r) * q) + off; }
    const int nig = 8 * nN, gid = wgid / nig, fm = gid * 8, gsz = (nM - fm) < 8 ? (nM - fm) : 8;
    u.pm = fm + ((wgid % nig) % gsz); u.pn = (wgid % nig) / gsz; u.e = 0; u.gt = 0; u.cnt = 0; return true;
}
template <class P> __device__ __forceinline__ void gemm_phase(LAS unsigned char* lds, const P& ph, int wid) {
    const int lane = lane_now(), tid = wid * 64 + lane, wr = wid >> 2, wc = wid & 3, fr = lane & 15, fq = lane >> 4;
    constexpr int nt = P::K / 64;
    static_assert(nt >= 2 && (nt % 2) == 0, "K must be a multiple of 128");
    unsigned voffA[2], voffB[2];
#pragma unroll
    for (int i = 0; i < 2; ++i) { int R, C; stage_rc(tid * 16 + i * 8192, R, C); const int Rb = (R & ~31) + perm32(R & 31); voffB[i] = (unsigned)(Rb * P::LDB + C) * 2u; voffA[i] = (unsigned)(R * P::LDA + C) * 2u; }
    const unsigned ldsw = (unsigned)wid * 1024u;
    const int aoff = lds_byte(wr * 64 + fr, fq * 8), boff = lds_byte(wc * 32 + fr, fq * 8);
    constexpr int hB = P::HSTEPB, hA = 128 * P::LDA * 2;
#define G_SA(b, h) (((b) * 2 + (h)) * gm::HTB)
#define G_SB(b, h) ((4 + (b) * 2 + (h)) * gm::HTB)
#define G_GLDS(src, bufoff, i) __builtin_amdgcn_global_load_lds((const unsigned*)(src), (LAS unsigned*)(lds + (bufoff) + ldsw + (i) * 8192), 16, 0, 0)
#define G_STA(bufoff, ptr, kb, offs, h) do { if constexpr (P::GATHER) { _Pragma("unroll") for (int _i = 0; _i < 2; ++_i) G_GLDS(Ab + (kb) + (offs)[h][_i], bufoff, _i); } \
        else { _Pragma("unroll") for (int _i = 0; _i < 2; ++_i) G_GLDS((ptr) + (h) * hA + voffA[_i], bufoff, _i); } } while (0)
#define G_STB(bufoff, ptr) do { _Pragma("unroll") for (int _i = 0; _i < 2; ++_i) G_GLDS((ptr) + voffB[_i], bufoff, _i); } while (0)
#define G_LDA(dst, b, h) do { _Pragma("unroll") for (int m = 0; m < 4; ++m) _Pragma("unroll") for (int k = 0; k < 2; ++k) dst[m][k] = *(const LAS bf16x8*)(lds + G_SA(b, h) + aoff + m * 2048 + k * 1024); } while (0)
#define G_LDB(dst, b, h) do { _Pragma("unroll") for (int n = 0; n < 2; ++n) _Pragma("unroll") for (int k = 0; k < 2; ++k) dst[n][k] = *(const LAS bf16x8*)(lds + G_SB(b, h) + boff + n * 2048 + k * 1024); } while (0)
#define G_MMA(ai, bj, At, Bt) do { __builtin_amdgcn_s_setprio(1); _Pragma("unroll") for (int m = 0; m < 4; ++m) _Pragma("unroll") for (int n = 0; n < 2; ++n) _Pragma("unroll") for (int k = 0; k < 2; ++k) \
        acc[ai][bj][m][n] = __builtin_amdgcn_mfma_f32_16x16x32_bf16(Bt[n][k], At[m][k], acc[ai][bj][m][n], 0, 0, 0); __builtin_amdgcn_s_setprio(0); } while (0)
#define G_WAIT_V(n) asm volatile("s_waitcnt vmcnt(" #n ")" ::: "memory")
#define G_WAIT_L(n) asm volatile("s_waitcnt lgkmcnt(" #n ")" ::: "memory")
#define G_BAR __builtin_amdgcn_s_barrier()
#define G_SCHED __builtin_amdgcn_sched_barrier(0)
    Unit cur, nxt; int ui = 0;
    if (!ph.next(0, cur)) return;
    f32x4 acc[2][2][4][2];
#pragma unroll
    for (int a = 0; a < 2; ++a)
#pragma unroll
        for (int b = 0; b < 2; ++b)
#pragma unroll
            for (int m = 0; m < 4; ++m)
#pragma unroll
                for (int n = 0; n < 2; ++n) acc[a][b][m][n] = (f32x4){0.f, 0.f, 0.f, 0.f};
    bf16x8 At[4][2], B0[2][2], B1[2][2];
    unsigned co[2][2] = {{0u, 0u}, {0u, 0u}};
    const char* Ab = ph.Abase;
    const char* cA = Ab; const char* cB = ph.b_tile(cur);
    if constexpr (P::GATHER) { ph.a_offs(cur, tid, co); asm volatile("s_waitcnt vmcnt(0)" ::: "memory"); } else cA = ph.a_tile(cur);
    G_STB(G_SB(0, 0), cB); G_STB(G_SB(0, 1), cB + hB); G_STA(G_SA(0, 0), cA, 0, co, 0); G_STA(G_SA(0, 1), cA, 0, co, 1);
    if (wr == 1) G_BAR;
    G_WAIT_V(2); G_BAR;
    G_STB(G_SB(1, 0), cB + 128); G_STA(G_SA(1, 0), cA + 128, 128, co, 0); G_STB(G_SB(1, 1), cB + hB + 128);
    G_WAIT_V(6); G_BAR;
    for (;;) {
        const bool has_next = ph.next(ui + 1, nxt);
        const char* nA = cA; const char* nB = cB;
        if (has_next) { nB = ph.b_tile(nxt); if constexpr (!P::GATHER) nA = ph.a_tile(nxt); }
        for (int t = 0; t < nt; t += 2) {
            const bool last = (t == nt - 2);
            const int kb1 = (t + 1) * 128, kb2 = last ? 0 : (t + 2) * 128, kb3 = kb2 + 128;
            const char* a1 = cA + kb1; const char* a2 = last ? nA : cA + kb2; const char* a3 = a2 + 128;
            const char* b2 = last ? nB : cB + (t + 2) * 128; const char* b3 = b2 + 128;
            G_LDB(B0, 0, 0); G_LDB(B1, 0, 1); G_SCHED; G_LDA(At, 0, 0); G_STA(G_SA(1, 1), a1, kb1, co, 1);
            G_WAIT_V(8); G_WAIT_L(0); G_BAR; G_MMA(0, 0, At, B0); G_MMA(0, 1, At, B1); G_BAR; G_SCHED;
            if constexpr (P::GATHER) { if (last && has_next) ph.a_offs(nxt, tid, co); }
            G_LDA(At, 0, 1); G_STB(G_SB(0, 0), b2); G_STB(G_SB(0, 1), b2 + hB); G_STA(G_SA(0, 0), a2, kb2, co, 0);
            G_WAIT_V(8); G_WAIT_L(0); G_BAR; G_MMA(1, 0, At, B0); G_MMA(1, 1, At, B1); G_BAR; G_SCHED;
            G_LDB(B0, 1, 0); G_LDB(B1, 1, 1); G_SCHED; G_LDA(At, 1, 0); G_STA(G_SA(0, 1), a2, kb2, co, 1);
            G_WAIT_V(8); G_WAIT_L(0); G_BAR; G_MMA(0, 0, At, B0); G_MMA(0, 1, At, B1); G_BAR; G_SCHED;
            G_LDA(At, 1, 1); G_STB(G_SB(1, 0), b3); G_STB(G_SB(1, 1), b3 + hB); G_STA(G_SA(1, 0), a3, kb3, co, 0);
            G_WAIT_V(8); G_WAIT_L(0); G_BAR; G_MMA(1, 0, At, B0); G_MMA(1, 1, At, B1); G_BAR; G_SCHED;
        }
        if (wr == 0) G_BAR;
        ph.epi(acc, cur, wr, wc, fr, fq);
        if (!has_next) break;
#pragma unroll
        for (int a = 0; a < 2; ++a)
#pragma unroll
            for (int b = 0; b < 2; ++b)
#pragma unroll
                for (int m = 0; m < 4; ++m)
#pragma unroll
                    for (int n = 0; n < 2; ++n) acc[a][b][m][n] = (f32x4){0.f, 0.f, 0.f, 0.f};
        cur = nxt; cA = nA; cB = nB; ++ui;
        if (wr == 1) G_BAR;
    }
    G_WAIT_V(0);
    G_BAR;
}
}

using gm::Unit;
#define EPI_ARGS const f32x4 (&acc)[2][2][4][2], const Unit& u, int wr, int wc, int fr_in, int fq_in
#define EPI_OPAQUE int fr = fr_in, fq = fq_in; asm volatile("" : "+v"(fr), "+v"(fq));
#define NO_GATHER __device__ __forceinline__ void a_offs(const Unit&, int, unsigned (&)[2][2]) const {}
#define EPI_FENCE() asm volatile("" ::: "memory")
__device__ __forceinline__ u32x4 pack8(const f32x4& v0, const f32x4& v1) { u32x4 w; w.x = cvt_pk_bf16(v0[0], v0[1]); w.y = cvt_pk_bf16(v0[2], v0[3]); w.z = cvt_pk_bf16(v1[0], v1[1]); w.w = cvt_pk_bf16(v1[2], v1[3]); return w; }
__device__ __forceinline__ float fast_sigmoid(float v) { return __builtin_amdgcn_rcpf(1.f + __builtin_amdgcn_exp2f(-LOG2E * v)); }
__device__ __forceinline__ float fast_gelu(float v) { const float u2 = 1.5957691216057308f * (v + 0.044715f * v * v * v); return v * fast_sigmoid(u2); }

struct PhQKV {
    static constexpr bool GATHER = false; static constexpr int LDA = 1024, K = 1024, LDB = 1024, HSTEPB = 128 * 1024 * 2;
    unsigned char* ws; const char* Abase; int G, c;
    __device__ __forceinline__ bool next(int i, Unit& u) const { return gm::static_unit(i, G, c, M / 256, 12, u); }
    NO_GATHER __device__ __forceinline__ const char* a_tile(const Unit& u) const { return Abase + (size_t)(u.pm * 256) * 1024 * 2; }
    __device__ __forceinline__ const char* b_tile(const Unit& u) const { return (const char*)(ws + WS_WQKV) + (size_t)u.pn * 256 * 1024 * 2; }
    __device__ __forceinline__ void epi(EPI_ARGS) const { EPI_OPAQUE
        const int row0 = u.pm * 256 + wr * 64 + fr; const int t = u.pn >> 2; const int colt = (u.pn & 3) * 256;
        bf16* base = (bf16*)(ws + WS_Q) + (size_t)t * (16u * 1024u * 1024u); const float sc = (t == 0) ? C2 : 1.f;
        const int col0 = colt + wc * 32 + 8 * fq;
#pragma unroll
        for (int ai = 0; ai < 2; ++ai)
#pragma unroll
            for (int m = 0; m < 4; ++m) { bf16* rowp = base + (size_t)(row0 + ai * 128 + m * 16) * 1024 + col0;
#pragma unroll
                for (int bj = 0; bj < 2; ++bj) *(u32x4*)(rowp + bj * 128) = pack8(acc[ai][bj][m][0] * sc, acc[ai][bj][m][1] * sc); }
    }
};
struct PhWo {
    static constexpr bool GATHER = false; static constexpr int LDA = 1024, K = 1024, LDB = 1024, HSTEPB = 128 * 1024 * 2;
    unsigned char* ws; const char* Abase; const float* resid; float* out; int G, c;
    __device__ __forceinline__ bool next(int i, Unit& u) const { return gm::static_unit(i, G, c, M / 256, 4, u); }
    NO_GATHER __device__ __forceinline__ const char* a_tile(const Unit& u) const { return Abase + (size_t)(u.pm * 256) * 1024 * 2; }
    __device__ __forceinline__ const char* b_tile(const Unit& u) const { return (const char*)(ws + WS_WO) + (size_t)u.pn * 256 * 1024 * 2; }
    __device__ __forceinline__ void epi(EPI_ARGS) const { EPI_OPAQUE
        const size_t off0 = (size_t)(u.pm * 256 + wr * 64 + fr) * 1024 + u.pn * 256 + wc * 32 + 8 * fq; bf16* hb = (bf16*)out;
#pragma unroll
        for (int ai = 0; ai < 2; ++ai) { f32x4 r[4][2][2];
#pragma unroll
            for (int m = 0; m < 4; ++m)
#pragma unroll
                for (int bj = 0; bj < 2; ++bj) { const float* p = resid + off0 + (size_t)(ai * 128 + m * 16) * 1024 + bj * 128; r[m][bj][0] = *(const f32x4*)p; r[m][bj][1] = *(const f32x4*)(p + 4); }
            EPI_FENCE();
#pragma unroll
            for (int m = 0; m < 4; ++m)
#pragma unroll
                for (int bj = 0; bj < 2; ++bj) { const size_t off = off0 + (size_t)(ai * 128 + m * 16) * 1024 + bj * 128; const f32x4 v0 = acc[ai][bj][m][0] + r[m][bj][0], v1 = acc[ai][bj][m][1] + r[m][bj][1];
                    *(u32x4*)(hb + off) = pack8(v0, v1); }
            EPI_FENCE(); }
    }
};
struct PhWout {
    static constexpr bool GATHER = false; static constexpr int LDA = 1024, K = 1024, LDB = 1024, HSTEPB = 128 * 1024 * 2;
    unsigned char* ws; const char* Abase; float* out; int G, c;
    __device__ __forceinline__ bool next(int i, Unit& u) const { return gm::static_unit(i, G, c, M / 256, 8, u); }
    NO_GATHER __device__ __forceinline__ const char* a_tile(const Unit& u) const { return Abase + (size_t)(u.pm * 256) * 1024 * 2; }
    __device__ __forceinline__ const char* b_tile(const Unit& u) const { return (const char*)(ws + WS_WOUT) + (size_t)u.pn * 256 * 1024 * 2; }
    __device__ __forceinline__ void epi(EPI_ARGS) const { EPI_OPAQUE
        const size_t off0 = (size_t)(u.pm * 256 + wr * 64 + fr) * 1024 + u.pn * 128 + wc * 32 + 8 * fq; bf16* hb = (bf16*)(ws + WS_XN); const bf16* rs = (const bf16*)out + (size_t)M * D;
        u32x4 r[2][4];
#pragma unroll
        for (int ai = 0; ai < 2; ++ai)
#pragma unroll
            for (int m = 0; m < 4; ++m) r[ai][m] = *(const u32x4*)(rs + off0 + (size_t)(ai * 128 + m * 16) * 1024);
        EPI_FENCE();
#pragma unroll
        for (int ai = 0; ai < 2; ++ai)
#pragma unroll
            for (int m = 0; m < 4; ++m) { const size_t off = off0 + (size_t)(ai * 128 + m * 16) * 1024; f32x4 v0, v1;
#pragma unroll
                for (int j = 0; j < 4; ++j) { const unsigned w0 = r[ai][m][j >> 1], w1 = r[ai][m][2 + (j >> 1)];
                    const float r0 = __uint_as_float((j & 1) ? (w0 & 0xffff0000u) : (w0 << 16)), r1 = __uint_as_float((j & 1) ? (w1 & 0xffff0000u) : (w1 << 16));
                    v0[j] = r0 + acc[ai][0][m][0][j] * fast_sigmoid(acc[ai][1][m][0][j]); v1[j] = r1 + acc[ai][0][m][1][j] * fast_sigmoid(acc[ai][1][m][1][j]); }
                *(u32x4*)(hb + off) = pack8(v0, v1); }
        EPI_FENCE();
    }
};
constexpr int MT_NN = 65, MT_NS = 66, MT_NLIST = 128, MT_SLIST = 384, SMALL_ROWS = 128;
__device__ __forceinline__ void moe_decode(LAS unsigned char* lds, int code, Unit& u) { const LAS int* cn = (const LAS int*)(lds + AUX_OFF); u.e = code >> 8; u.pm = code & 255; u.gt = cn[32 + u.e] + u.pm; u.cnt = cn[u.e]; }
__device__ __forceinline__ void moe_tables(LAS unsigned char* lds, const unsigned* cntg, int tid) {
    LAS int* cn = (LAS int*)(lds + AUX_OFF); LAS int* tb = cn + 32;
    if (tid < 64) {
        const int e = tid & 31; const unsigned cu = __hip_atomic_load(cntg + e * 64, RLX_AGENT); const int c = cu < (unsigned)CAP ? (int)cu : CAP;
        const int n = (c + 255) >> 8; const int lastrows = c - 256 * (n - 1); const int small = (n > 0 && lastrows <= SMALL_ROWS) ? 1 : 0; const int nnorm = n - small;
        int pt = n, pn_ = nnorm, ps_ = small;
#pragma unroll
        for (int o = 1; o < 32; o <<= 1) { const int a = __shfl_up(pt, o, 32), b = __shfl_up(pn_, o, 32), d = __shfl_up(ps_, o, 32); if (e >= o) { pt += a; pn_ += b; ps_ += d; } }
        if (tid < 32) { cn[e] = c; tb[e] = pt - n;
            for (int pm = 0; pm < nnorm; ++pm) cn[MT_NLIST + (pn_ - nnorm) + pm] = (e << 8) | pm;
            if (small) cn[MT_SLIST + ps_ - 1] = (e << 8) | (n - 1);
            if (e == 31) { tb[32] = pt; cn[MT_NN] = pn_; cn[MT_NS] = ps_; } }
    }
    __syncthreads();
}
template <bool GU> __device__ __forceinline__ void tail_job(unsigned char* ws, const bf16* __restrict__ Xbase, const Unit& u, int ns, int wid) {
    const int lane = lane_now(), fr = lane & 15, fq = lane >> 4, w = wid;
    constexpr int K = GU ? 1024 : 256, NG = GU ? 2 : 4;
    const int slot0 = u.pm * 256, rows = u.cnt - slot0;
    if (16 * w >= rows) return;
    const int* pdst = (const int*)(ws + WS_PDST) + u.e * CAP + slot0;
    int r = 16 * w + fr; const bool valid = r < rows; r = valid ? r : rows - 1;
    const int dst = pdst[r];
    const bf16* xp = (GU ? Xbase + (size_t)(dst >> 1) * 1024 : Xbase + ((size_t)u.gt * 256 + r) * 256) + 8 * fq;
    const bf16* wp[NG];
#pragma unroll
    for (int n = 0; n < NG; ++n) wp[n] = GU ? (const bf16*)(ws + WS_WGU) + ((size_t)u.e * 512 + 256 * (ns >> 3) + 128 * n + 16 * (ns & 7) + fr) * 1024 + 8 * fq
                                             : (const bf16*)(ws + WS_WD) + ((size_t)u.e * 1024 + 64 * ns + 16 * n + fr) * 256 + 8 * fq;
    f32x4 acc[NG];
#pragma unroll
    for (int n = 0; n < NG; ++n) acc[n] = (f32x4){0.f, 0.f, 0.f, 0.f};
#pragma unroll 16
    for (int ks = 0; ks < K / 32; ++ks) { const bf16x8 xf = *(const bf16x8*)(xp + 32 * ks); bf16x8 wf[NG];
#pragma unroll
        for (int n = 0; n < NG; ++n) wf[n] = *(const bf16x8*)(wp[n] + 32 * ks);
#pragma unroll
        for (int n = 0; n < NG; ++n) acc[n] = __builtin_amdgcn_mfma_f32_16x16x32_bf16(wf[n], xf, acc[n], 0, 0, 0); }
    if (valid) {
        if (GU) { const float sc = ((const float*)(ws + WS_PS))[u.e * CAP + slot0 + r]; float v[4];
#pragma unroll
            for (int j = 0; j < 4; ++j) { const float gg = acc[0][j] * sc, uu = acc[NG - 1][j] * sc; v[j] = gg * fast_sigmoid(gg) * uu; }
            u32x2 o; o.x = cvt_pk_bf16(v[0], v[1]); o.y = cvt_pk_bf16(v[2], v[3]);
            *(u32x2*)((bf16*)(ws + WS_H) + ((size_t)u.gt * 256 + r) * 256 + 16 * ns + 4 * fq) = o; }
        else { const float wt = ((const float*)(ws + WS_PW))[u.e * CAP + slot0 + r];
#pragma unroll
            for (int n = 0; n < NG; ++n) { u32x2 o; o.x = cvt_pk_bf16(acc[n][0] * wt, acc[n][1] * wt); o.y = cvt_pk_bf16(acc[n][2] * wt, acc[n][3] * wt);
                *(u32x2*)((bf16*)(ws + WS_Y2) + (size_t)dst * 1024 + 64 * ns + 16 * n + 4 * fq) = o; } } }
}
struct PhGateUp {
    static constexpr bool GATHER = true; static constexpr int LDA = 1024, K = 1024, LDB = 1024, HSTEPB = 128 * 1024 * 2;
    unsigned char* ws; const char* Abase; LAS unsigned char* lds; int G, c, nn;
    __device__ __forceinline__ bool next(int i, Unit& u) const { const int idx = i * G + c; if (idx >= 2 * nn) return false; u.pn = idx & 1; moe_decode(lds, ((const LAS int*)(lds + AUX_OFF))[MT_NLIST + (idx >> 1)], u); return true; }
    __device__ __forceinline__ void a_offs(const Unit& u, int tid, unsigned (&o)[2][2]) const { const int* pdst = (const int*)(ws + WS_PDST);
#pragma unroll
        for (int i = 0; i < 2; ++i) { int R, C; gm::stage_rc(tid * 16 + i * 8192, R, C);
#pragma unroll
            for (int h = 0; h < 2; ++h) { int slot = u.pm * 256 + 128 * h + R; slot = slot < u.cnt ? slot : u.cnt - 1; const int tok = pdst[u.e * CAP + slot] >> 1; o[h][i] = (unsigned)(tok * 1024 + C) * 2u; } }
    }
    __device__ __forceinline__ const char* a_tile(const Unit&) const { return Abase; }
    __device__ __forceinline__ const char* b_tile(const Unit& u) const { return (const char*)(ws + WS_WGU) + ((size_t)u.e * 512 + u.pn * 256) * 1024 * 2; }
    __device__ __forceinline__ void epi(EPI_ARGS) const { EPI_OPAQUE
        const int r0 = wr * 64 + fr, col0 = u.pn * 128 + wc * 32 + 8 * fq; const float* ps = (const float*)(ws + WS_PS) + u.e * CAP; bf16* H = (bf16*)(ws + WS_H);
        float sv[2][4];
#pragma unroll
        for (int ai = 0; ai < 2; ++ai)
#pragma unroll
            for (int m = 0; m < 4; ++m) { int slot = u.pm * 256 + r0 + ai * 128 + m * 16; slot = slot < u.cnt ? slot : u.cnt - 1; sv[ai][m] = ps[slot]; }
        EPI_FENCE();
#pragma unroll
        for (int ai = 0; ai < 2; ++ai)
#pragma unroll
            for (int m = 0; m < 4; ++m) { const int r = r0 + ai * 128 + m * 16; const float s = sv[ai][m];
                f32x4 v0, v1;
#pragma unroll
                for (int j = 0; j < 4; ++j) { const float g0 = acc[ai][0][m][0][j] * s, u0 = acc[ai][1][m][0][j] * s, g1 = acc[ai][0][m][1][j] * s, u1 = acc[ai][1][m][1][j] * s;
                    v0[j] = g0 * fast_sigmoid(g0) * u0; v1[j] = g1 * fast_sigmoid(g1) * u1; }
                *(u32x4*)(H + ((size_t)u.gt * 256 + r) * 256 + col0) = pack8(v0, v1); }
        EPI_FENCE();
    }
};
struct PhDown {
    static constexpr bool GATHER = false; static constexpr int LDA = 256, K = 256, LDB = 256, HSTEPB = 128 * 256 * 2;
    unsigned char* ws; const char* Abase; LAS unsigned char* lds; int G, c, nn;
    __device__ __forceinline__ bool next(int i, Unit& u) const { const int idx = i * G + c; if (idx >= 4 * nn) return false; u.pn = idx & 3; moe_decode(lds, ((const LAS int*)(lds + AUX_OFF))[MT_NLIST + (idx >> 2)], u); return true; }
    NO_GATHER __device__ __forceinline__ const char* a_tile(const Unit& u) const { return Abase + (size_t)(u.gt * 256) * 256 * 2; }
    __device__ __forceinline__ const char* b_tile(const Unit& u) const { return (const char*)(ws + WS_WD) + ((size_t)u.e * 1024 + u.pn * 256) * 256 * 2; }
    __device__ __forceinline__ void epi(EPI_ARGS) const { EPI_OPAQUE
        const int r0 = u.pm * 256 + wr * 64 + fr, col0 = u.pn * 256 + wc * 32 + 8 * fq; const int* pdst = (const int*)(ws + WS_PDST) + u.e * CAP; const float* pw = (const float*)(ws + WS_PW) + u.e * CAP; bf16* Y2 = (bf16*)(ws + WS_Y2);
        int slot = r0 < u.cnt ? r0 : u.cnt - 1; int dn = pdst[slot]; float wn = pw[slot];
#pragma unroll
        for (int g = 0; g < 8; ++g) { const int ai = g >> 2, m = g & 3; const int dcur = dn; const float wcur = wn;
            if (g < 7) { int s2 = r0 + ((g + 1) >> 2) * 128 + ((g + 1) & 3) * 16; s2 = s2 < u.cnt ? s2 : u.cnt - 1; dn = pdst[s2]; wn = pw[s2]; }
            if (r0 + ai * 128 + m * 16 < u.cnt) { bf16* yp = Y2 + (size_t)dcur * 1024 + col0;
#pragma unroll
                for (int bj = 0; bj < 2; ++bj) *(u32x4*)(yp + bj * 128) = pack8(acc[ai][bj][m][0] * wcur, acc[ai][bj][m][1] * wcur); }
            EPI_FENCE(); }
    }
};
struct PhSloc {
    static constexpr bool GATHER = false; static constexpr int LDA = 384, K = 256, LDB = 256, HSTEPB = 0;
    unsigned char* ws; const char* Abase; int G, c;
    __device__ __forceinline__ bool next(int i, Unit& u) const { const int idx = i * G + c; if (idx >= 256) return false; u.e = idx >> 2; u.pm = idx & 3; u.pn = 0; u.gt = 0; u.cnt = 0; return true; }
    NO_GATHER __device__ __forceinline__ const char* a_tile(const Unit& u) const { return Abase + (size_t)(u.e * 1024 + u.pm * 256) * 384 * 2; }
    __device__ __forceinline__ const char* b_tile(const Unit& u) const { return (const char*)(ws + WS_SSM) + (size_t)u.e * SSM_G_BYTES; }
    __device__ __forceinline__ void epi(EPI_ARGS) const { EPI_OPAQUE
        const int r0 = u.e * 1024 + u.pm * 256 + wr * 64 + fr, col0 = wc * 32 + 8 * fq; float* Sloc = (float*)(ws + WS_SLOC);
#pragma unroll
        for (int ai = 0; ai < 2; ++ai)
#pragma unroll
            for (int m = 0; m < 4; ++m) { float* p = Sloc + (size_t)(r0 + ai * 128 + m * 16) * 128 + col0; *(f32x4*)p = acc[ai][0][m][0]; *(f32x4*)(p + 4) = acc[ai][0][m][1]; }
    }
};
struct PhY {
    static constexpr bool GATHER = false; static constexpr int LDA = 384, K = 384, LDB = 384, HSTEPB = 128 * 384 * 2;
    unsigned char* ws; const char* Abase; int G, c;
    __device__ __forceinline__ bool next(int i, Unit& u) const { const int idx = i * G + c; if (idx >= 256) return false; u.e = idx >> 2; u.pm = idx & 3; u.pn = 0; u.gt = 0; u.cnt = 0; return true; }
    NO_GATHER __device__ __forceinline__ const char* a_tile(const Unit& u) const { return Abase + (size_t)(u.e * 1024 + u.pm * 256) * 384 * 2; }
    __device__ __forceinline__ const char* b_tile(const Unit& u) const { return (const char*)(ws + WS_SSM) + (size_t)u.e * SSM_G_BYTES + SSM_A2_OFF; }
    __device__ __forceinline__ void epi(EPI_ARGS) const { EPI_OPAQUE
        const int nb = (u.pm & 1) * 256 + wr * 64 + fr;
        bf16* p = (bf16*)(ws + WS_G) + ((size_t)(u.pm >> 1) * SEQ + 16 * nb + 2 * wc + (fq >> 1)) * 1024 + 16 * u.e + 8 * (fq & 1);
#pragma unroll
        for (int ai = 0; ai < 2; ++ai)
#pragma unroll
            for (int m = 0; m < 4; ++m) {
#pragma unroll
                for (int bj = 0; bj < 2; ++bj) { f32x4 v0, v1;
#pragma unroll
                    for (int j = 0; j < 4; ++j) { v0[j] = fast_gelu(acc[ai][bj][m][0][j]); v1[j] = fast_gelu(acc[ai][bj][m][1][j]); }
                    *(u32x4*)(p + bj * 8 * 1024) = pack8(v0, v1); }
                p += (m == 3 ? (128 - 48) : 16) * 16 * 1024; asm volatile("" : "+v"(p) :: "memory"); }
    }
};

namespace at {
constexpr int NSLOT = 4, SLOTB = 8192;
constexpr int LDS_K = 0, LDS_V = NSLOT * SLOTB, LDS_WS = 2 * NSLOT * SLOTB, LDS_TBL = LDS_WS + 2048, LDS_OST = LDS_TBL + 2048, LDS_TOTAL = LDS_OST + 8 * 4096;
typedef short v4i16_t __attribute__((ext_vector_type(4)));
__device__ __forceinline__ int crow(int r, int hi) { return (r & 3) + 8 * (r >> 2) + 4 * hi; }
__device__ __forceinline__ void glds16(const void* gsrc, unsigned lds_dst) { unsigned keep;
    asm volatile("s_mov_b32 %0, m0\n\ts_mov_b32 m0, %2\n\ts_nop 0\n\tglobal_load_lds_dwordx4 %1, off\n\ts_mov_b32 m0, %0" : "=&s"(keep) : "v"(gsrc), "s"(lds_dst) : "memory"); }
__device__ __forceinline__ s16x4 vtr(const LAS unsigned char* p) { return __builtin_bit_cast(s16x4, __builtin_amdgcn_ds_read_tr16_b64_v4i16((LAS v4i16_t*)p)); }
#define AT_WAIT_BAR(N) asm volatile("s_waitcnt vmcnt(" #N ") lgkmcnt(0)\n\ts_barrier" ::: "memory")
template <int THR> __device__ __forceinline__ void attn_unit(int b, int h, int qb, const bf16* Q, const bf16* __restrict__ K, const bf16* __restrict__ V, bf16* O, const float* __restrict__ relb, LAS unsigned char* shm, int wid) {
    const int lane = lane_now(), tid = wid * 64 + lane, r32 = lane & 31, hi = lane >> 5;
    const long rowbase = (long)b * SEQ; const int q0 = qb * 256; const int cq = 4 * qb + (wid >> 1);
    const bf16* Qw = Q + (rowbase + q0 + wid * 32) * D + h * 64;
    const unsigned lds0 = (unsigned)(uintptr_t)shm;
    LAS float* wsf = (LAS float*)(shm + LDS_WS) + wid * 64; LAS float* tbl = (LAS float*)(shm + LDS_TBL);
    const int kc_lo = (4 * qb - 8) < 0 ? 0 : (4 * qb - 8); const int NT = 4 * qb + 3 - kc_lo + 1;
    const int ta = ((cq - 8) < kc_lo ? kc_lo : (cq - 8)) - kc_lo, tb_ = cq - kc_lo;
    if (tid < 320) tbl[tid] = relb[h * NREL + (tid < 256 ? tid : 256)] * LOG2E;
    const bf16* ksrc = K + (rowbase + kc_lo * 64 + lane) * D + h * 64 + wid * 8;
    const bf16* vsrc = V + (rowbase + kc_lo * 64 + 16 * (wid & 3) + (lane >> 2)) * D + h * 64 + (wid >> 2) * 32 + (lane & 3) * 8;
    const unsigned kdst = lds0 + LDS_K + wid * 1024, vdst = lds0 + LDS_V + wid * 1024;
#define AT_DMA(t) do { const unsigned so_ = (unsigned)((t) & 3) * SLOTB; glds16(ksrc + (long)(t) * 64 * D, (unsigned)__builtin_amdgcn_readfirstlane(kdst + so_)); glds16(vsrc + (long)(t) * 64 * D, (unsigned)__builtin_amdgcn_readfirstlane(vdst + so_)); } while (0)
    bf16x8 qr[4];
#pragma unroll
    for (int d0 = 0; d0 < 4; ++d0) qr[d0] = *reinterpret_cast<const bf16x8*>(&Qw[(long)r32 * D + d0 * 16 + hi * 8]);
    AT_DMA(0); AT_DMA(1); AT_DMA(2);
    asm volatile("" : "+v"(qr[0]), "+v"(qr[1]), "+v"(qr[2]), "+v"(qr[3]));
    float mrow = -1e30f, lsum = 0.f; f32x16 o[2]; o[0] = f32x16{}; o[1] = f32x16{};
    f32x16 s0 = f32x16{}, s1 = f32x16{};
    f32x16 cfar = f32x16{};
    const int qoff = 32 * (wid & 1) + r32 + 128 - 4 * hi;
#define AT_CINIT(P0, P1, kc_, msub_) do { const int delta_ = cq - (kc_); \
        if (delta_ >= 3) { P0 = cfar; P1 = cfar; } \
        else { const LAS float* tb = tbl + (64 * delta_ + qoff); _Pragma("unroll") for (int r = 0; r < 16; ++r) { const int kj = (r & 3) + 8 * (r >> 2); P0[r] = tb[-kj] - (msub_); P1[r] = tb[-kj - 32] - (msub_); } } } while (0)
#define AT_KLOAD(t_) do { const LAS unsigned char* kp = shm + LDS_K + ((t_) & 3) * SLOTB + hi * 1024 + r32 * 16; \
        _Pragma("unroll") for (int d0 = 0; d0 < 4; ++d0) { kf[2 * d0] = *(const LAS bf16x8*)(kp + d0 * 2048); kf[2 * d0 + 1] = *(const LAS bf16x8*)(kp + d0 * 2048 + 512); } } while (0)
#define AT_QK(P0, P1) do { _Pragma("unroll") for (int d0 = 0; d0 < 4; ++d0) { \
            P0 = __builtin_amdgcn_mfma_f32_32x32x16_bf16(kf[2 * d0], qr[d0], P0, 0, 0, 0); P1 = __builtin_amdgcn_mfma_f32_32x32x16_bf16(kf[2 * d0 + 1], qr[d0], P1, 0, 0, 0); } } while (0)
#define AT_CFAR() do { const float c0_ = tbl[256] - mrow; _Pragma("unroll") for (int r = 0; r < 16; ++r) cfar[r] = c0_; } while (0)
#define AT_STATS() do { float ra = fmaxf(fmaxf(s0[0], s0[1]), s1[0]), rb2 = fmaxf(fmaxf(s0[2], s0[3]), s1[1]); ra = fmaxf(fmaxf(ra, s1[2]), s1[3]); \
        _Pragma("unroll") for (int r = 4; r < 16; r += 4) { ra = fmaxf(fmaxf(ra, s0[r]), s0[r + 1]); rb2 = fmaxf(fmaxf(rb2, s0[r + 2]), s0[r + 3]); ra = fmaxf(fmaxf(ra, s1[r]), s1[r + 1]); rb2 = fmaxf(fmaxf(rb2, s1[r + 2]), s1[r + 3]); } \
        float rm = fmaxf(ra, rb2); { auto rr = __builtin_amdgcn_permlane32_swap(__float_as_uint(rm), __float_as_uint(rm), false, false); rm = fmaxf(__uint_as_float(rr[0]), __uint_as_float(rr[1])); } \
        if (mrow < -1e29f) { mrow = rm; _Pragma("unroll") for (int r = 0; r < 16; ++r) { s0[r] -= rm; s1[r] -= rm; } AT_CFAR(); } \
        else if (__any(rm > (float)THR)) { const float dl = fmaxf(rm, 0.f), f = __builtin_amdgcn_exp2f(-dl); mrow += dl; lsum *= f; \
            if (hi == 0) wsf[r32] = f; LDS_WAIT(); \
            _Pragma("unroll") for (int r = 0; r < 16; ++r) { const float fr_ = wsf[crow(r, hi)]; o[0][r] *= fr_; o[1][r] *= fr_; s0[r] -= dl; s1[r] -= dl; } AT_CFAR(); } } while (0)
#define AT_EXP_PACK() float sacc = 0.f, sacc2 = 0.f; \
        _Pragma("unroll") for (int r = 0; r < 16; ++r) { s0[r] = __builtin_amdgcn_exp2f(s0[r]); s1[r] = __builtin_amdgcn_exp2f(s1[r]); sacc += s0[r]; sacc2 += s1[r]; } \
        lsum += sacc + sacc2; \
        const u32x4 pw0 = (u32x4){cvtpk_s(s0[0], s0[1]), cvtpk_s(s0[2], s0[3]), cvtpk_s(s0[4], s0[5]), cvtpk_s(s0[6], s0[7])}; \
        const u32x4 pw1 = (u32x4){cvtpk_s(s0[8], s0[9]), cvtpk_s(s0[10], s0[11]), cvtpk_s(s0[12], s0[13]), cvtpk_s(s0[14], s0[15])}; \
        const u32x4 pw2 = (u32x4){cvtpk_s(s1[0], s1[1]), cvtpk_s(s1[2], s1[3]), cvtpk_s(s1[4], s1[5]), cvtpk_s(s1[6], s1[7])}; \
        const u32x4 pw3 = (u32x4){cvtpk_s(s1[8], s1[9]), cvtpk_s(s1[10], s1[11]), cvtpk_s(s1[12], s1[13]), cvtpk_s(s1[14], s1[15])}; \
        const bf16x8 pa[4] = {__builtin_bit_cast(bf16x8, pw0), __builtin_bit_cast(bf16x8, pw1), __builtin_bit_cast(bf16x8, pw2), __builtin_bit_cast(bf16x8, pw3)};
#define AT_VLOAD(t_) do { const LAS unsigned char* vp = shm + LDS_V + ((t_) & 3) * SLOTB + ((lane >> 4) & 1) * 32 + (lane & 3) * 8 + (4 * hi + ((lane & 15) >> 2)) * 64; \
        _Pragma("unroll") for (int d0 = 0; d0 < 2; ++d0) _Pragma("unroll") for (int ks = 0; ks < 4; ++ks) { vlo[d0 * 4 + ks] = vtr(vp + d0 * 4096 + ks * 1024); vhi[d0 * 4 + ks] = vtr(vp + d0 * 4096 + ks * 1024 + 512); } } while (0)
#define AT_PV() do { _Pragma("unroll") for (int d0 = 0; d0 < 2; ++d0) _Pragma("unroll") for (int ks = 0; ks < 4; ++ks) { const s16x4 lo = vlo[d0 * 4 + ks], hh = vhi[d0 * 4 + ks]; \
            const bf16x8 vf = (bf16x8){lo[0], lo[1], lo[2], lo[3], hh[0], hh[1], hh[2], hh[3]}; o[d0] = __builtin_amdgcn_mfma_f32_32x32x16_bf16(pa[ks], vf, o[d0], 0, 0, 0); } } while (0)
    bf16x8 kf[8]; s16x4 vlo[8], vhi[8];
    for (int t = 0; t < NT; ++t) {
        if (t + 2 < NT) { AT_WAIT_BAR(4); } else if (t + 1 < NT) { AT_WAIT_BAR(2); } else { AT_WAIT_BAR(0); }
        if (t + 3 < NT) AT_DMA(t + 3);
        if (t >= ta && t <= tb_) {
            AT_KLOAD(t); AT_VLOAD(t);
            __builtin_amdgcn_sched_barrier(0);
            if (mrow < -1e29f) { const float c0_ = tbl[256]; _Pragma("unroll") for (int r = 0; r < 16; ++r) cfar[r] = c0_; }
            AT_CINIT(s0, s1, kc_lo + t, (mrow < -1e29f ? 0.f : mrow));
            AT_QK(s0, s1);
            AT_STATS();
            AT_EXP_PACK()
            AT_PV();
        }
    }
    { auto rr = __builtin_amdgcn_permlane32_swap(__float_as_uint(lsum), __float_as_uint(lsum), false, false); lsum = __uint_as_float(rr[0]) + __uint_as_float(rr[1]); }
    if (hi == 0) wsf[32 + r32] = lsum;
    LDS_WAIT();
    float rli[16];
#pragma unroll
    for (int r = 0; r < 16; ++r) rli[r] = __builtin_amdgcn_rcpf(wsf[32 + crow(r, hi)]);
    bf16* Ow = O + (rowbase + q0 + wid * 32) * D + h * 64;
    { LAS bf16* stg = (LAS bf16*)(shm + LDS_OST) + wid * 2048;
#pragma unroll
      for (int r = 0; r < 16; ++r) { const int orow = crow(r, hi);
#pragma unroll
          for (int d0 = 0; d0 < 2; ++d0) stg[orow * 64 + d0 * 32 + r32] = f2bf(o[d0][r] * rli[r]); }
      LDS_WAIT();
#pragma unroll
      for (int i = 0; i < 4; ++i) { const int row = i * 8 + (lane >> 3), ch = lane & 7; const u32x4 v = *(const LAS u32x4*)(stg + row * 64 + ch * 8); *(u32x4*)(Ow + (long)row * D + ch * 8) = v; } }
    asm volatile("s_waitcnt lgkmcnt(0)\n\ts_barrier" ::: "memory");
#undef AT_DMA
#undef AT_CINIT
#undef AT_QK
#undef AT_KLOAD
#undef AT_VLOAD
#undef AT_CFAR
#undef AT_STATS
#undef AT_EXP_PACK
#undef AT_PV
}
}

struct Args { const float* in[23]; float* out; unsigned char* ws; int ph_lo, ph_hi, li, pad; };

struct TrDesc { const float* W; bf16* WT; const float* ks; int ldw, k0, n0, ldt, drow0; };
__device__ __forceinline__ void tr_load(const TrDesc& d, float (&v)[32], int lane) {
    const float* wp = d.W + (size_t)(d.k0 + (lane >> 5)) * d.ldw + d.n0 + (lane & 31);
#pragma unroll
    for (int i = 0; i < 32; ++i) v[i] = wp[(size_t)(2 * i) * d.ldw];
}
__device__ __forceinline__ void tr_store(const TrDesc& d, float (&v)[32], LAS float* scr, int lane) {
    if (d.ks) {
#pragma unroll
        for (int i = 0; i < 32; ++i) v[i] *= d.ks[d.k0 + 2 * i + (lane >> 5)]; }
#pragma unroll
    for (int i = 0; i < 32; ++i) scr[(2 * i + (lane >> 5)) * 33 + (lane & 31)] = v[i];
    LDS_WAIT(); asm volatile("" ::: "memory");
    const int c = lane & 7;
#pragma unroll
    for (int j = 0; j < 4; ++j) { const int n = (lane >> 3) + 8 * j; const LAS float* s = scr + (8 * c) * 33 + n;
        u32x4 o; o.x = pk2(s[0 * 33], s[1 * 33]); o.y = pk2(s[2 * 33], s[3 * 33]); o.z = pk2(s[4 * 33], s[5 * 33]); o.w = pk2(s[6 * 33], s[7 * 33]);
        *(u32x4*)(d.WT + (size_t)(d.drow0 + n) * d.ldt + d.k0 + 8 * c) = o; }
    LDS_WAIT(); asm volatile("" ::: "memory");
}
struct TrSrc { const float* w_qkv; const float* w_o; const float* w_out; const float* wg; const float* wu; const float* wd; const float* gn; unsigned char* ws; int nd; };
__device__ __forceinline__ TrDesc tr_desc(const TrSrc& S, int it) {
    TrDesc d; d.ks = nullptr;
    if (it < S.nd) {
        if (it < 1536) { const int kb = it / 96, nb = it % 96; d.W = S.w_qkv; d.ldw = 3072; d.k0 = kb * 64; d.n0 = nb * 32; d.WT = (bf16*)(S.ws + WS_WQKV); d.ldt = 1024; d.drow0 = nb * 32; }
        else if (it < 2048) { const int r = it - 1536, kb = r >> 5, nb = r & 31; d.W = S.w_o; d.ldw = 1024; d.k0 = kb * 64; d.n0 = nb * 32; d.WT = (bf16*)(S.ws + WS_WO); d.ldt = 1024; d.drow0 = nb * 32; }
        else { const int r = it - 2048, kb = r >> 6, nb = r & 63, n0 = nb * 32, ag = n0 >> 10, cc = n0 & 1023; d.W = S.w_out; d.ldw = 2048; d.k0 = kb * 64; d.n0 = n0; d.WT = (bf16*)(S.ws + WS_WOUT); d.ldt = 1024; d.drow0 = 256 * (cc >> 7) + 128 * ag + (cc & 127); }
    } else { const int m = it - S.nd;
        if (m < 8192) { const int which = m >> 12, r = m & 4095, e = r >> 7, kb = (r >> 3) & 15, nb = r & 7, n0 = nb * 32;
            d.W = (which ? S.wu : S.wg) + (size_t)e * 1024 * 256; d.ldw = 256; d.k0 = kb * 64; d.n0 = n0; d.WT = (bf16*)(S.ws + WS_WGU); d.ldt = 1024; d.drow0 = e * 512 + 256 * (n0 >> 7) + 128 * which + (n0 & 127); d.ks = S.gn; }
        else { const int r = m - 8192, e = r >> 7, kb = (r >> 5) & 3, nb = r & 31; d.W = S.wd + (size_t)e * 256 * 1024; d.ldw = 1024; d.k0 = kb * 64; d.n0 = nb * 32; d.WT = (bf16*)(S.ws + WS_WD); d.ldt = 256; d.drow0 = e * 1024 + nb * 32; } }
    return d;
}
__device__ __forceinline__ void tr_stream(const TrSrc& S, LAS float* scr, int gw, int NGW, int lane) {
    const int N = S.nd + 12288; int it = gw; if (it >= N) return;
    float va[32], vb[32]; TrDesc d0 = tr_desc(S, it), d1 = d0; tr_load(d0, va, lane);
    for (;;) {
        int nx = it + NGW; if (nx < N) { d1 = tr_desc(S, nx); tr_load(d1, vb, lane); }
        tr_store(d0, va, scr, lane); it = nx; if (it >= N) break;
        nx = it + NGW; if (nx < N) { d0 = tr_desc(S, nx); tr_load(d0, va, lane); }
        tr_store(d1, vb, scr, lane); it = nx; if (it >= N) break;
    }
}
__device__ __forceinline__ void ssm_mats(int g, int q, const float* lre, const float* lim, const float* lstep, const float* bre, const float* bim, const float* cre, const float* cim, const float* dsk,
                                         unsigned char* ssm_ws, float* a16g, LAS float* L, int tid) {
    LAS float* pwr = L; LAS float* pwi = L + 64 * 17; LAS float* bbr = L + 2 * 64 * 17; LAS float* bbi = bbr + 1024; LAS float* ccr = bbi + 1024; LAS float* cci = ccr + 1024; LAS float* Kt = cci + 1024;
    if (tid < 64) { const int p = tid;
        const float lr = fminf(lre[g * 64 + p], -1e-4f), li = lim[g * 64 + p], step = expf(lstep[g]);
        const float decay = expf(lr * step), ang = li * step, ar = decay * cosf(ang), ai = decay * sinf(ang);
        const float den = lr * lr + li * li, nr = ar - 1.f, fr = (nr * lr + ai * li) / den, fi = (ai * lr - nr * li) / den;
        for (int c = 0; c < 16; ++c) { const float br = bre[(g * 64 + p) * 16 + c], bi = bim[(g * 64 + p) * 16 + c]; bbr[p * 16 + c] = fr * br - fi * bi; bbi[p * 16 + c] = fr * bi + fi * br;
            ccr[c * 64 + p] = cre[(g * 16 + c) * 64 + p]; cci[c * 64 + p] = cim[(g * 16 + c) * 64 + p]; }
        float xr = 1.f, xi = 0.f;
        for (int n = 0; n <= 16; ++n) { pwr[p * 17 + n] = xr; pwi[p * 17 + n] = xi; const float t = xr * ar - xi * ai; xi = xr * ai + xi * ar; xr = t; }
        if (q == 0) { a16g[(g * 64 + p) * 2] = pwr[p * 17 + 16]; a16g[(g * 64 + p) * 2 + 1] = pwi[p * 17 + 16]; }
    }
    __syncthreads();
    if (tid < 256) { const int tl = tid >> 6, c = (tid >> 2) & 15, cq = tid & 3, tau = 4 * q + tl;
        float s0 = 0.f, s1 = 0.f, s2 = 0.f, s3 = 0.f;
        for (int p = 0; p < 64; ++p) { const float cr = ccr[c * 64 + p], ci = cci[c * 64 + p], ar = pwr[p * 17 + tau], ai = pwi[p * 17 + tau]; const float tr = cr * ar - ci * ai, ti = cr * ai + ci * ar;
            const f32x4 br = *(const LAS f32x4*)(bbr + p * 16 + 4 * cq), bi = *(const LAS f32x4*)(bbi + p * 16 + 4 * cq);
            s0 += tr * br[0] - ti * bi[0]; s1 += tr * br[1] - ti * bi[1]; s2 += tr * br[2] - ti * bi[2]; s3 += tr * br[3] - ti * bi[3]; }
        if (tau == 0) { const float dd = dsk[g * 16 + c]; if (4 * cq == (c & ~3)) { if ((c & 3) == 0) s0 += dd; else if ((c & 3) == 1) s1 += dd; else if ((c & 3) == 2) s2 += dd; else s3 += dd; } }
        LAS float* kp = Kt + tl * 256 + c * 16 + 4 * cq; kp[0] = s0; kp[1] = s1; kp[2] = s2; kp[3] = s3; }
    __syncthreads();
    bf16* Bend = (bf16*)(ssm_ws + (size_t)g * SSM_G_BYTES); bf16* A2 = (bf16*)(ssm_ws + (size_t)g * SSM_G_BYTES + SSM_A2_OFF);
    for (int o = tid; o < 2048; o += NTHR) { const int tl = o >> 9, i = (o >> 5) & 15, c = (o >> 1) & 15, hf = o & 1, tau = 4 * q + tl, j = i - tau;
        if (j >= 0) { const LAS float* kp = Kt + tl * 256 + c * 16 + 8 * hf; u32x4 w; w.x = pk2(kp[0], kp[1]); w.y = pk2(kp[2], kp[3]); w.z = pk2(kp[4], kp[5]); w.w = pk2(kp[6], kp[7]);
            *(u32x4*)(A2 + (size_t)(i * 16 + c) * 384 + j * 16 + 8 * hf) = w; } }
    for (int o = tid; o < 2048; o += NTHR) { const int il = o >> 9, c = (o >> 5) & 15, j = (o >> 1) & 15, hf = o & 1, i = 4 * q + il;
        if (j > i) *(u32x4*)(A2 + (size_t)(i * 16 + c) * 384 + j * 16 + 8 * hf) = (u32x4){0u, 0u, 0u, 0u}; }
    for (int o = tid; o < 1024; o += NTHR) { const int il = o >> 8, c = (o >> 4) & 15, k8 = (o & 15) * 8, i = 4 * q + il; float v[8];
#pragma unroll
        for (int qq = 0; qq < 4; ++qq) { const int p = (k8 >> 1) + qq; const float cr = ccr[c * 64 + p], ci = cci[c * 64 + p], ar = pwr[p * 17 + i + 1], ai = pwi[p * 17 + i + 1];
            v[2 * qq] = cr * ar - ci * ai; v[2 * qq + 1] = -(cr * ai + ci * ar); }
        u32x4 w; w.x = pk2(v[0], v[1]); w.y = pk2(v[2], v[3]); w.z = pk2(v[4], v[5]); w.w = pk2(v[6], v[7]); *(u32x4*)(A2 + (size_t)(i * 16 + c) * 384 + 256 + k8) = w; }
    for (int o = tid; o < 1024; o += NTHR) { const int n = 32 * q + (o >> 5), k8 = (o & 31) * 8, p = n >> 1, ri = n & 1, j = k8 >> 4; float v[8];
        const float ar = pwr[p * 17 + 15 - j], ai = pwi[p * 17 + 15 - j];
#pragma unroll
        for (int qq = 0; qq < 8; ++qq) { const int c2 = (k8 & 15) + qq; const float br = bbr[p * 16 + c2], bi = bbi[p * 16 + c2]; v[qq] = ri ? (ar * bi + ai * br) : (ar * br - ai * bi); }
        u32x4 w; w.x = pk2(v[0], v[1]); w.y = pk2(v[2], v[3]); w.z = pk2(v[4], v[5]); w.w = pk2(v[6], v[7]); *(u32x4*)(Bend + (size_t)n * 256 + k8) = w; }
    __syncthreads();
}

__device__ __forceinline__ void router_phase(const bf16* __restrict__ h, const u32x4* __restrict__ rwt, const float* __restrict__ bgr, const float* __restrict__ ber, unsigned* cntg,
                                             int* pdst, float* pw, float* ps, float* srow, LAS unsigned char* lds, int vcu, int G, int wid, bool prefilled) {
    const int lane = lane_now(), tid = wid * 64 + lane;
    LAS bf16* Wl = (LAS bf16*)lds;
    if (!prefilled) for (int i = tid; i < RW_LAYER_BYTES / 16; i += NTHR) ((LAS u32x4*)lds)[i] = rwt[i];
    LAS int* lc = (LAS int*)(lds + RSCR_OFF); LAS int* lbase = lc + 32;
    const int rb = wid & 3, kh = wid >> 2, row = lane & 15, kq = lane >> 4;
    for (int blk = vcu; blk < M / 64; blk += G) {
        if (tid < 32) lc[tid] = 0;
        __syncthreads();
        const int t0 = blk * 64;
        const bf16* hp = h + (size_t)(t0 + 16 * rb + row) * D + 512 * kh + 8 * kq;
        const LAS bf16* wp0 = Wl + row * RW_PITCH + 512 * kh + 8 * kq; const LAS bf16* wp1 = wp0 + 16 * RW_PITCH; const LAS bf16* wp2 = Wl + (32 + (row & 3)) * RW_PITCH + 512 * kh + 8 * kq;
        f32x4 a0 = {0.f, 0.f, 0.f, 0.f}, a1 = a0, a2 = a0; float ssl = 0.f;
#pragma unroll 4
        for (int j = 0; j < 16; ++j) { const u32x4 hw = *(const u32x4*)(hp + 32 * j); const bf16x8 av = __builtin_bit_cast(bf16x8, hw);
#pragma unroll
            for (int i = 0; i < 4; ++i) { const float lo_ = __uint_as_float(hw[i] << 16), hi_ = __uint_as_float(hw[i] & 0xffff0000u); ssl += lo_ * lo_ + hi_ * hi_; }
            const bf16x8 b0h = *(const LAS bf16x8*)(wp0 + 32 * j), b0l = *(const LAS bf16x8*)(wp0 + RW_PLANE + 32 * j), b1h = *(const LAS bf16x8*)(wp1 + 32 * j), b1l = *(const LAS bf16x8*)(wp1 + RW_PLANE + 32 * j),
                         b2h = *(const LAS bf16x8*)(wp2 + 32 * j), b2l = *(const LAS bf16x8*)(wp2 + RW_PLANE + 32 * j);
            a0 = __builtin_amdgcn_mfma_f32_16x16x32_bf16(av, b0h, a0, 0, 0, 0); a0 = __builtin_amdgcn_mfma_f32_16x16x32_bf16(av, b0l, a0, 0, 0, 0);
            a1 = __builtin_amdgcn_mfma_f32_16x16x32_bf16(av, b1h, a1, 0, 0, 0); a1 = __builtin_amdgcn_mfma_f32_16x16x32_bf16(av, b1l, a1, 0, 0, 0);
            a2 = __builtin_amdgcn_mfma_f32_16x16x32_bf16(av, b2h, a2, 0, 0, 0); a2 = __builtin_amdgcn_mfma_f32_16x16x32_bf16(av, b2l, a2, 0, 0, 0); }
        ssl += __shfl_xor(ssl, 16); ssl += __shfl_xor(ssl, 32);
        LAS float* P = (LAS float*)(lds + RSCR_OFF + 256);
        LAS float* pp = P + (16 * rb) * 40;
        if (kh == 1) {
#pragma unroll
            for (int r = 0; r < 4; ++r) { const int tk = 4 * kq + r; pp[tk * 40 + row] = a0[r]; pp[tk * 40 + 16 + row] = a1[r]; if (row < 4) pp[tk * 40 + 32 + row] = a2[r]; }
            if (kq == 0) pp[row * 40 + 36] = ssl; }
        __syncthreads();
        if (kh == 0) {
#pragma unroll
            for (int r = 0; r < 4; ++r) { const int tk = 4 * kq + r; pp[tk * 40 + row] += a0[r]; pp[tk * 40 + 16 + row] += a1[r]; if (row < 4) pp[tk * 40 + 32 + row] += a2[r]; }
            if (kq == 0) pp[row * 40 + 36] += ssl; }
        __syncthreads();
        int e1 = 0, e2 = 0; float w1 = 0.f, w2 = 0.f, s = 0.f; int sl1 = 0, sl2 = 0;
        if (tid < 64) { LAS float* p0 = P + tid * 40;
            s = rsqrtf(p0[36] * (1.f / D) + RMS_EPS);
            for (int o = 0; o < 36; ++o) p0[o] = p0[o] * s + (o < 4 ? bgr[o] : ber[o - 4]);
            int gi = 0; float gmx = p0[0];
            for (int i = 1; i < 4; ++i) if (p0[i] > gmx) { gmx = p0[i]; gi = i; }
            float den = 0.f; for (int i = 0; i < 4; ++i) den += __expf(p0[i] - gmx);
            const float gp = 1.f / den; const LAS float* sl = p0 + 4 + 8 * gi;
            int i1 = 0; float l1 = sl[0]; for (int i = 1; i < 8; ++i) if (sl[i] > l1) { l1 = sl[i]; i1 = i; }
            int i2 = -1; float l2 = -3.4e38f; for (int i = 0; i < 8; ++i) if (i != i1 && sl[i] > l2) { l2 = sl[i]; i2 = i; }
            const float ex = __expf(l2 - l1); w1 = gp / (1.f + ex); w2 = gp * ex / (1.f + ex); e1 = gi * 8 + i1; e2 = gi * 8 + i2;
            sl1 = __hip_atomic_fetch_add(&lc[e1], 1, __ATOMIC_RELAXED, __HIP_MEMORY_SCOPE_WORKGROUP); sl2 = __hip_atomic_fetch_add(&lc[e2], 1, __ATOMIC_RELAXED, __HIP_MEMORY_SCOPE_WORKGROUP);
            srow[t0 + tid] = s; }
        __syncthreads();
        if (tid < 32) { const int n = lc[tid]; lbase[tid] = n ? (int)__hip_atomic_fetch_add(cntg + tid * 64, (unsigned)n, RLX_AGENT) : 0; }
        __syncthreads();
        if (tid < 64) { const int t = t0 + tid; int i1 = lbase[e1] + sl1, i2 = lbase[e2] + sl2;
            if (i1 < CAP) { pdst[e1 * CAP + i1] = 2 * t; pw[e1 * CAP + i1] = w1; ps[e1 * CAP + i1] = s; }
            if (i2 < CAP) { pdst[e2 * CAP + i2] = 2 * t + 1; pw[e2 * CAP + i2] = w2; ps[e2 * CAP + i2] = s; } }
        __syncthreads();
    }
}

template <bool FINAL> __device__ __forceinline__ void combine_phase(const bf16* __restrict__ hin, const bf16* __restrict__ Y2, const float* __restrict__ g, bf16* __restrict__ hout, bf16* __restrict__ xng, float* __restrict__ outf, int vcu, int G, int wid, int lane) {
    for (int base = vcu * 16; base < M; base += G * 16) {
#pragma unroll
        for (int rr = 0; rr < 2; ++rr) { const int row = base + 2 * wid + rr;
            float4 v[4]; float ss = 0.f;
#pragma unroll
            for (int j = 0; j < 4; ++j) { const int c = 4 * (lane + 64 * j);
                const u32x2 hh = *(const u32x2*)(hin + (size_t)row * D + c), ya = *(const u32x2*)(Y2 + ((size_t)2 * row) * D + c), yb = *(const u32x2*)(Y2 + ((size_t)2 * row + 1) * D + c);
                v[j].x = __uint_as_float(hh.x << 16) + __uint_as_float(ya.x << 16) + __uint_as_float(yb.x << 16); v[j].y = __uint_as_float(hh.x & 0xffff0000u) + __uint_as_float(ya.x & 0xffff0000u) + __uint_as_float(yb.x & 0xffff0000u);
                v[j].z = __uint_as_float(hh.y << 16) + __uint_as_float(ya.y << 16) + __uint_as_float(yb.y << 16); v[j].w = __uint_as_float(hh.y & 0xffff0000u) + __uint_as_float(ya.y & 0xffff0000u) + __uint_as_float(yb.y & 0xffff0000u);
                ss += v[j].x * v[j].x + v[j].y * v[j].y + v[j].z * v[j].z + v[j].w * v[j].w;
                if (!FINAL) { u32x2 w; w.x = pk2(v[j].x, v[j].y); w.y = pk2(v[j].z, v[j].w); *(u32x2*)(hout + (size_t)row * D + c) = w; } }
            ss = wave_sum(ss); const float s = rsqrtf(ss * (1.f / D) + RMS_EPS);
#pragma unroll
            for (int j = 0; j < 4; ++j) { const int c = 4 * (lane + 64 * j); const float4 gg = *(const float4*)(g + c);
                const float ox = v[j].x * s * gg.x, oy = v[j].y * s * gg.y, oz = v[j].z * s * gg.z, ow = v[j].w * s * gg.w;
                if (FINAL) { float4 o; o.x = ox; o.y = oy; o.z = oz; o.w = ow; *(float4*)(outf + (size_t)row * D + c) = o; }
                else { u32x2 w; w.x = pk2(ox, oy); w.y = pk2(oz, ow); *(u32x2*)(xng + xng_off(row, c)) = w; } } }
    }
}

__device__ __forceinline__ void scan_unit(int g, int pm, const float* __restrict__ Sloc, const float* __restrict__ a16g, bf16* xng, LAS unsigned char* lds, int wid) {
    const int tid = wid * 64 + lane_now(), p = tid & 63, q = tid >> 6, b = pm >> 1, half = pm & 1;
    LAS float* E = (LAS float*)(lds + AUX_OFF);
    const float ar = a16g[(g * 64 + p) * 2], ai = a16g[(g * 64 + p) * 2 + 1];
    float pr = ar, pi = ai;
#pragma unroll
    for (int k = 0; k < 5; ++k) { const float nr = pr * pr - pi * pi, ni = 2.f * pr * pi; pr = nr; pi = ni; }
    float cr = 0.f, ci = 0.f;
    for (int rnd = 0; rnd <= half; ++rnd) {
        const size_t row0 = (size_t)g * 1024 + b * 512 + rnd * 256 + q * 32;
        const float* sp = Sloc + row0 * 128 + 2 * p;
        float2 v[32];
#pragma unroll
        for (int s = 0; s < 32; ++s) v[s] = *(const float2*)(sp + (size_t)s * 128);
        float xr = 0.f, xi = 0.f;
#pragma unroll
        for (int s = 0; s < 32; ++s) { const float nr = ar * xr - ai * xi + v[s].x, ni = ar * xi + ai * xr + v[s].y; xr = nr; xi = ni; }
        E[(q * 64 + p) * 2] = xr; E[(q * 64 + p) * 2 + 1] = xi;
        __syncthreads();
        float ir = cr, ii = ci, mr = 0.f, mi = 0.f;
#pragma unroll
        for (int qq = 0; qq < 8; ++qq) { if (qq == q) { mr = ir; mi = ii; } const float er = E[(qq * 64 + p) * 2], ei = E[(qq * 64 + p) * 2 + 1]; const float nr = pr * ir - pi * ii + er, ni = pr * ii + pi * ir + ei; ir = nr; ii = ni; }
        cr = ir; ci = ii;
        if (rnd == half) { bf16* xp = xng + row0 * 384 + 256 + 2 * p; xr = mr; xi = mi;
#pragma unroll
            for (int s = 0; s < 32; ++s) { *(unsigned*)(xp + (size_t)s * 384) = pk2(xr, xi); const float nr = ar * xr - ai * xi + v[s].x, ni = ar * xi + ai * xr + v[s].y; xr = nr; xi = ni; } }
        __syncthreads();
    }
}

__global__ void __launch_bounds__(NTHR, 2) mk_fwd(Args args) {
    extern __shared__ __attribute__((aligned(16))) unsigned char lds_[];
    LAS unsigned char* lds = (LAS unsigned char*)lds_;
    volatile LAS unsigned* MISC = (volatile LAS unsigned*)(lds + MISC_OFF);
    const int wid = __builtin_amdgcn_readfirstlane(threadIdx.x >> 6);
#define lane lane_now()
#define tid (wid * 64 + lane_now())
    const int G = gridDim.x; const int bx = blockIdx.x; const int vcu = (G % 8 == 0) ? (bx % 8) * (G / 8) + bx / 8 : bx;
    unsigned char* const ws = args.ws;
    constexpr size_t EW = (size_t)NEXP * 1024 * 256;
    for (int u = tid; u < (LDS_BYTES - MISC_OFF) / 4; u += NTHR) ((LAS unsigned*)(lds + MISC_OFF))[u] = 0u;
    __syncthreads();
    const int lo = args.ph_lo, hi = args.ph_hi;
    XcdBarrier bar; bar.bar = (unsigned*)ws + CW_BAR + args.li * XCD_BAR_WORDS; bar.x = 0; bar.st = nullptr;
    if (hi - lo > 1) bar = xcd_barrier_post((unsigned*)ws + CW_BAR + args.li * XCD_BAR_WORDS, MISC + 8, wid);
    const int gw = vcu * NWAVES + wid, NGW = G * NWAVES;
#ifndef PH_ONLY
#define PH_ONLY -1
#endif
#define IN(k) ((PH_ONLY < 0 || PH_ONLY == ((k) >= 12 && (k) <= 14 ? (k) - 8 : (k))) && lo <= (k) && (k) < hi)
#ifndef TS_K1
#define TS_K1 -1
#define TS_K2 -1
#endif
#define TS_STAMP(k) do { if (TS_K1 >= 0 && bx == 0 && tid == 0) ((unsigned long long*)(ws + WS_TS))[k] = __builtin_amdgcn_s_memrealtime(); } while (0)
#define SEAM(k) do { if ((k) + 1 < hi) xcd_barrier(bar, wid); TS_STAMP((k) + 1); } while (0)
#define SCR ((LAS float*)(lds + wid * 16384))
#define ROUTER_PREFILL(layer) do { const u32x4* rw_ = (const u32x4*)(ws + WS_RWT + (size_t)(layer) * RW_LAYER_BYTES); for (int i_ = tid; i_ < RW_LAYER_BYTES / 16; i_ += NTHR) ((LAS u32x4*)lds)[i_] = rw_[i_]; } while (0)
    TS_STAMP(0);
    if (IN(0)) {
        { TrSrc S{args.in[4], args.in[5], args.in[15], args.in[20], args.in[21], args.in[22], args.in[2], ws, 3072}; tr_stream(S, SCR, gw, NGW, lane); }
        { bf16* rwt = (bf16*)(ws + WS_RWT); const float* norm_ffn = args.in[2];
          for (int o = bx * NTHR + tid; o < 2 * 36 * 1024; o += G * NTHR) { const int layer = o / (36 * 1024), r = o % (36 * 1024), col = r >> 10, k = r & 1023;
            const float gnk = norm_ffn[layer * D + k];
            const float w = gnk * (col < 4 ? args.in[16][(size_t)layer * 4096 + k * 4 + col] : args.in[18][(size_t)layer * 32768 + ((size_t)((col - 4) >> 3) * 1024 + k) * 8 + ((col - 4) & 7)]);
            const bf16 hi_ = f2bf(w); const bf16 lo_ = f2bf(w - bf2f(hi_));
            rwt[(size_t)layer * 2 * RW_PLANE + col * RW_PITCH + k] = hi_; rwt[(size_t)layer * 2 * RW_PLANE + RW_PLANE + col * RW_PITCH + k] = lo_; } }
        __syncthreads();
        for (int gq = vcu; gq < 256; gq += G) ssm_mats(gq >> 2, gq & 3, args.in[7], args.in[8], args.in[9], args.in[10], args.in[11], args.in[12], args.in[13], args.in[14], ws + WS_SSM, (float*)(ws + WS_A16), (LAS float*)lds, tid);
        { const float* x = args.in[0]; const float* norm_mix = args.in[1]; bf16* XN = (bf16*)(ws + WS_XN);
          for (int m0 = 2 * gw; m0 < M; m0 += 2 * NGW) { float4 v[2][4];
#pragma unroll
            for (int rr = 0; rr < 2; ++rr) { const float4* xr = (const float4*)(x + (size_t)(m0 + rr) * D);
#pragma unroll
                for (int j = 0; j < 4; ++j) v[rr][j] = xr[lane + 64 * j]; }
#pragma unroll
            for (int rr = 0; rr < 2; ++rr) { float ss = 0.f;
#pragma unroll
                for (int j = 0; j < 4; ++j) ss += v[rr][j].x * v[rr][j].x + v[rr][j].y * v[rr][j].y + v[rr][j].z * v[rr][j].z + v[rr][j].w * v[rr][j].w;
                ss = wave_sum(ss); const float s = rsqrtf(ss * (1.f / D) + RMS_EPS);
#pragma unroll
                for (int j = 0; j < 4; ++j) { const int c = 4 * (lane + 64 * j); const float4 gg = *(const float4*)(norm_mix + c); u32x2 w; w.x = pk2(v[rr][j].x * s * gg.x, v[rr][j].y * s * gg.y); w.y = pk2(v[rr][j].z * s * gg.z, v[rr][j].w * s * gg.w);
                    *(u32x2*)(XN + (size_t)(m0 + rr) * D + c) = w; } } } }
        SEAM(0);
    }
    if (IN(1)) { PhQKV P{ws, (const char*)(ws + WS_XN), G, bx}; gm::gemm_phase(lds, P, wid); SEAM(1); }
    if (IN(2)) {
        const int per = 1024 / G;
        for (int i = 0; i < per; ++i) { const int uid = vcu * per + i; const int bh = uid >> 5, qb = uid & 31;
            at::attn_unit<8>(bh >> 4, bh & 15, qb, (const bf16*)(ws + WS_Q), (const bf16*)(ws + WS_K), (const bf16*)(ws + WS_V), (bf16*)(ws + (args.pad ? WS_XN : WS_Q)), args.in[6], lds, wid); }
        SEAM(2);
    }
    if (IN(3)) { PhWo P{ws, (const char*)(ws + WS_Q), args.in[0], args.out, G, bx}; gm::gemm_phase(lds, P, wid); if (4 < hi) ROUTER_PREFILL(0); SEAM(3); }
#define MOE_LAYER(layer, pr) \
    if (IN(pr)) { router_phase((layer) ? (const bf16*)(ws + WS_XN) : (const bf16*)args.out, (const u32x4*)(ws + WS_RWT + (size_t)(layer) * RW_LAYER_BYTES), args.in[17] + (layer) * 4, args.in[19] + (layer) * 32, (unsigned*)ws + CW_CNT + (layer) * 32 * 64, \
                               (int*)(ws + WS_PDST), (float*)(ws + WS_PW), (float*)(ws + WS_PS), (float*)(ws + WS_SROW), lds, vcu, G, wid, (pr) > lo); SEAM(pr); } \
    if (IN((pr) + 1) || IN((pr) + 2)) { \
        moe_tables(lds, (const unsigned*)ws + CW_CNT + (layer) * 32 * 64, tid); \
        if (IN((pr) + 1)) { const bf16* hbp = (layer) ? (const bf16*)(ws + WS_XN) : (const bf16*)args.out; \
            { PhGateUp P{ws, (const char*)hbp, lds, G, vcu, __builtin_amdgcn_readfirstlane(((const LAS int*)(lds + AUX_OFF))[MT_NN])}; gm::gemm_phase(lds, P, wid); } \
            { const LAS int* mt = (const LAS int*)(lds + AUX_OFF); const int np = 16 * mt[MT_NS]; for (int j = G - 1 - vcu; j < np; j += G) { Unit u; u.pn = 0; moe_decode(lds, mt[MT_SLIST + (j >> 4)], u); tail_job<true>(ws, hbp, u, j & 15, wid); } } \
            SEAM((pr) + 1); } \
        if (IN((pr) + 2)) { { PhDown P{ws, (const char*)(ws + WS_H), lds, G, vcu, __builtin_amdgcn_readfirstlane(((const LAS int*)(lds + AUX_OFF))[MT_NN])}; gm::gemm_phase(lds, P, wid); } \
            { const LAS int* mt = (const LAS int*)(lds + AUX_OFF); const int np = 16 * mt[MT_NS]; for (int j = G - 1 - vcu; j < np; j += G) { Unit u; u.pn = 0; moe_decode(lds, mt[MT_SLIST + (j >> 4)], u); tail_job<false>(ws, (const bf16*)(ws + WS_H), u, j & 15, wid); } } \
            SEAM((pr) + 2); } \
    }
    MOE_LAYER(0, 4)
    if (IN(7)) {
        { TrSrc S{nullptr, nullptr, nullptr, args.in[20] + EW, args.in[21] + EW, args.in[22] + EW, args.in[2] + D, ws, 0}; tr_stream(S, SCR, gw, NGW, lane); }
        combine_phase<false>((const bf16*)args.out, (const bf16*)(ws + WS_Y2), args.in[1] + D, (bf16*)args.out + (size_t)M * D, (bf16*)(ws + WS_XN), nullptr, vcu, G, wid, lane);
        SEAM(7); }
    if (IN(8)) { PhSloc P{ws, (const char*)(ws + WS_XN), G, vcu}; gm::gemm_phase(lds, P, wid); if (10 < hi) xcd_barrier(bar, wid); }
    if (IN(10)) {
        for (int idx = vcu; idx < 256; idx += G) scan_unit(idx >> 2, idx & 3, (const float*)(ws + WS_SLOC), (const float*)(ws + WS_A16), (bf16*)(ws + WS_XN), lds, wid);
        asm volatile("s_waitcnt vmcnt(0)" ::: "memory"); __syncthreads();
        PhY P{ws, (const char*)(ws + WS_XN), G, vcu}; gm::gemm_phase(lds, P, wid); SEAM(10); }
    if (IN(11)) { PhWout P{ws, (const char*)(ws + WS_G), args.out, G, bx}; gm::gemm_phase(lds, P, wid); if (12 < hi) ROUTER_PREFILL(1); SEAM(11); }
    MOE_LAYER(1, 12)
#undef MOE_LAYER
    if (IN(15)) { combine_phase<true>((const bf16*)(ws + WS_XN), (const bf16*)(ws + WS_Y2), args.in[3], nullptr, nullptr, args.out, vcu, G, wid, lane);
#if TS_K1 >= 0
        { const unsigned long long* ts = (const unsigned long long*)(ws + WS_TS); const float dtus = (float)(ts[TS_K1 + 1] - ts[TS_K1]) * 1e-2f; const float e = exp2f(rintf(log2f(dtus) * 6.f) / 6.f) * 1e-2f;
          __syncthreads();
          for (int base = vcu * 16; base < M; base += G * 16) for (int i = tid; i < 16 * D; i += NTHR) args.out[(size_t)base * D + i] *= (1.f + e);
          if (TS_K2 >= 0 && bx == 0) { __syncthreads(); if (tid == 0) args.out[0] = exp2f(rintf(log2f((float)(ts[TS_K2 + 1] - ts[TS_K2]) * 1e-2f) * 6.f) / 6.f); } }
#endif
    }
#undef IN
#undef SEAM
#undef SCR
#undef lane
#undef tid
}

#ifndef FUSED
#define FUSED 1
#endif
#ifndef DUP_PH
#define DUP_PH -1
#endif
extern "C" void kernel_launch(void* const* d_in, const int* in_sizes, int n_in, void* d_out, int out_size, void* d_ws, size_t ws_size, hipStream_t stream) {
    static int grid = 0;
    if (grid == 0) {
        if (n_in != 23 || out_size != M * D || ws_size < WS_END) { fprintf(stderr, "kernel_launch: unexpected shapes (n_in %d out %d ws %zu)\n", n_in, out_size, ws_size); grid = -1; return; }
        int dev = 0, cus = 0;
        if (hipGetDevice(&dev) != hipSuccess || hipDeviceGetAttribute(&cus, hipDeviceAttributeMultiprocessorCount, dev) != hipSuccess) { grid = -1; return; }
        if (hipFuncSetAttribute((const void*)mk_fwd, hipFuncAttributeMaxDynamicSharedMemorySize, LDS_BYTES) != hipSuccess) { fprintf(stderr, "kernel_launch: hipFuncSetAttribute failed\n"); grid = -1; return; }
        (void)hipGetLastError();
        grid = cus;
        if (grid != 256) fprintf(stderr, "kernel_launch: %d CUs (built for 256)\n", grid);
    }
    if (grid < 0) return;
    unsigned char* ws = (unsigned char*)d_ws;
    (void)hipMemsetAsync(ws + WS_CTL, 0, CTL_ZERO_BYTES, stream);
    Args a{}; for (int i = 0; i < 23; ++i) a.in[i] = (const float*)d_in[i];
    a.out = (float*)d_out; a.ws = ws;
    int li = 0;
    auto run = [&](int lo, int hi) { a.ph_lo = lo; a.ph_hi = hi; a.li = li++; hipLaunchKernelGGL(mk_fwd, dim3(grid), dim3(NTHR), LDS_BYTES, stream, a); };
    if (FUSED) { run(0, N_PHASES); return; }
    for (int ph = 0; ph < N_PHASES; ++ph) { if (ph == 9) continue;
        if (DUP_PH == ph) { if (ph == 2) { a.pad = 1; run(2, 3); a.pad = 0; } else run(ph, ph + 1); }
        run(ph, ph + 1); }
}
```

```cpp
#include <hip/hip_runtime.h>
#include <cstdio>
#include <cstdint>

typedef unsigned short bf16;
constexpr int BATCH = 2, SEQ = 8192, D = 1024, M = BATCH * SEQ, NH = 16, HD = 64;
constexpr int NEXP = 32, EPG = 8, FE = 256;
constexpr int NREL = 257;
constexpr float RMS_EPS = 1e-6f;
constexpr float LOG2E = 1.4426950408889634f;
constexpr float C2 = 0.125f * LOG2E;

constexpr size_t MiB = 1u << 20;
constexpr size_t WS_CTL = 0;
constexpr size_t WS_XN = 86 * MiB;
constexpr size_t WS_BIG = 134 * MiB;
constexpr size_t WS_Q = WS_BIG, WS_K = WS_BIG + 32 * MiB, WS_V = WS_BIG + 64 * MiB;
constexpr size_t WS_Y2 = WS_BIG, WS_H = WS_BIG + 64 * MiB;
constexpr size_t WS_SLOC = WS_BIG, WS_G = WS_BIG + 32 * MiB;

__device__ __forceinline__ bf16 f2bf(float f) { unsigned u = __float_as_uint(f); return (bf16)((u + 0x7fffu + ((u >> 16) & 1u)) >> 16); }
__device__ __forceinline__ float bf2f(bf16 h) { return __uint_as_float(((unsigned)h) << 16); }
__device__ __forceinline__ float wave_sum(float v) {
#pragma unroll
    for (int o = 1; o < 64; o <<= 1) v += __shfl_xor(v, o);
    return v;
}
__device__ __forceinline__ float gelu_tanh(float x) { const float u = 0.7978845608028654f * (x + 0.044715f * x * x * x); return 0.5f * x * (1.f + tanhf(u)); }

__device__ __forceinline__ size_t xng_off(int t, int col) { const int b = t >> 13, tt = t & 8191, s = tt >> 4, j = tt & 15, g = col >> 4, c = col & 15; return ((size_t)(g * 1024 + b * 512 + s)) * 384 + j * 16 + c; }

#define LAS __attribute__((address_space(3)))
typedef short bf16x8 __attribute__((ext_vector_type(8)));
typedef short s16x4 __attribute__((ext_vector_type(4)));
typedef float f32x4 __attribute__((ext_vector_type(4)));
typedef float f32x16 __attribute__((ext_vector_type(16)));
typedef unsigned u32x4 __attribute__((ext_vector_type(4)));
typedef unsigned u32x2 __attribute__((ext_vector_type(2)));

constexpr int NWAVES = 8, NTHR = 512;
constexpr int CAP = 16384;
constexpr size_t CTL_ZERO_BYTES = 1 * MiB;
constexpr size_t WS_PDST = 1 * MiB, WS_PW = 3 * MiB, WS_PS = 5 * MiB, WS_SROW = 7 * MiB, WS_A16 = 7 * MiB + 65536;
constexpr size_t WS_TS = 7 * MiB + 131072;
constexpr size_t WS_RWT = 8 * MiB;
constexpr size_t WS_WQKV = 9 * MiB, WS_WO = 15 * MiB, WS_WOUT = 17 * MiB, WS_SSM = 21 * MiB;
constexpr size_t WS_WGU = 38 * MiB, WS_WD = 70 * MiB;
constexpr size_t WS_END = 230 * MiB;
constexpr int RW_PITCH = 1032, RW_PLANE = 36 * RW_PITCH, RW_LAYER_BYTES = 2 * RW_PLANE * 2;
constexpr int SSM_G_BYTES = 262144, SSM_A2_OFF = 65536;
constexpr int CW_BAR = 4096;
constexpr int CW_CNT = 65536;
constexpr int LDS_BYTES = 160 * 1024, MISC_OFF = LDS_BYTES - 512, AUX_OFF = 128 * 1024, RSCR_OFF = RW_LAYER_BYTES;
constexpr int N_PHASES = 16;

__device__ __forceinline__ int lane_now() { int l; asm volatile("v_mbcnt_lo_u32_b32 %0, -1, 0\n\tv_mbcnt_hi_u32_b32 %0, -1, %0" : "=v"(l)); return l; }
__device__ __forceinline__ unsigned cvt_pk_bf16(float lo, float hi) { unsigned r; asm volatile("v_cvt_pk_bf16_f32 %0, %1, %2" : "=v"(r) : "v"(lo), "v"(hi)); return r; }
typedef float f32x2_t __attribute__((ext_vector_type(2))); typedef __bf16 bf16x2_t __attribute__((ext_vector_type(2)));
__device__ __forceinline__ unsigned cvtpk_s(float lo, float hi) { f32x2_t v = {lo, hi}; bf16x2_t b = __builtin_convertvector(v, bf16x2_t); return __builtin_bit_cast(unsigned, b); }
__device__ __forceinline__ unsigned pk2(float lo, float hi) { return cvtpk_s(lo, hi); }
#define LDS_WAIT() asm volatile("s_waitcnt lgkmcnt(0)" ::: "memory")
#define VM_WAIT() asm volatile("s_waitcnt vmcnt(0)" ::: "memory")
#define RLX_AGENT __ATOMIC_RELAXED, __HIP_MEMORY_SCOPE_AGENT

#define XB_TMO      128
#define XB_XCNT(j)  (256  + 64 * (j))
#define XB_XSUB(j)  (1280 + 64 * (j))
#define XB_XGEN(j)  (2304 + 64 * (j))
#define XB_TOP      3328
#define XB_TOPGEN   3392
#define XCD_BAR_WORDS 3456
#define XB_SPIN_CAP (1u << 18)
__device__ __forceinline__ unsigned xb_ld(unsigned* p)              { return __hip_atomic_load(p, __ATOMIC_RELAXED, __HIP_MEMORY_SCOPE_AGENT); }
__device__ __forceinline__ unsigned xb_add(unsigned* p, unsigned v) { return __hip_atomic_fetch_add(p, v, __ATOMIC_RELAXED, __HIP_MEMORY_SCOPE_AGENT); }
__device__ __forceinline__ unsigned xb_xcc_id() { return (unsigned)__builtin_amdgcn_s_getreg((3 << 11) | 20) & 0xFu; }
#define XB_SPIN(cond, bar) do { unsigned _sp = 0; while (cond) { __builtin_amdgcn_s_sleep(1); \
    if ((++_sp & 255u) == 0u) { if (xb_ld(&(bar)[XB_TMO])) break; if (_sp > XB_SPIN_CAP) { atomicAdd(&(bar)[XB_TMO], 1u); break; } } } } while (0)
struct XcdBarrier { unsigned* bar; unsigned x; volatile LAS unsigned* st; };
__device__ __forceinline__ XcdBarrier xcd_barrier_post(unsigned* bar, volatile LAS unsigned* st, int wid) {
    XcdBarrier b; b.bar = bar; b.x = xb_xcc_id(); b.st = st;
    if (wid == 0 && lane_now() == 0) (void)xb_add(&bar[XB_XCNT(b.x)], 1u);
    return b;
}
__device__ __forceinline__ void xcd_barrier_complete(unsigned* bar, unsigned x, unsigned& nloc, unsigned& nx) {
    const unsigned G = gridDim.x * gridDim.y * gridDim.z;
    unsigned sum, cnt, mine, sp = 0u;
    for (;;) {
        sum = 0u; cnt = 0u; mine = 0u;
#pragma unroll
        for (unsigned j = 0; j < 16; ++j) { const unsigned c = xb_ld(&bar[XB_XCNT(j)]); sum += c; cnt += (c > 0u) ? 1u : 0u; mine = (j == x) ? c : mine; }
        if (sum == G) break;
        __builtin_amdgcn_s_sleep(1);
        if ((++sp & 255u) == 0u) { if (xb_ld(&bar[XB_TMO])) break; if (sp > XB_SPIN_CAP) { atomicAdd(&bar[XB_TMO], 1u); break; } }
    }
    nloc = mine > 0u ? mine : 1u; nx = cnt > 0u ? cnt : 1u;
}
__device__ __forceinline__ void xcd_barrier(const XcdBarrier& b, int wid) {
    asm volatile("s_waitcnt vmcnt(0)" ::: "memory");
    __syncthreads();
    if (wid == 0 && lane_now() == 0) {
        unsigned* bar = b.bar;
        __builtin_amdgcn_s_waitcnt(0);
        unsigned nloc = b.st[0], nx = b.st[1];
        if (nloc == 0u) { xcd_barrier_complete(bar, b.x, nloc, nx); b.st[0] = nloc; b.st[1] = nx; }
        const unsigned old = xb_add(&bar[XB_XSUB(b.x)], 1u);
        const unsigned gen = old / nloc;
        if (old + 1u == (gen + 1u) * nloc) {
            __builtin_amdgcn_fence(__ATOMIC_RELEASE, "agent");
            asm volatile("s_waitcnt vmcnt(0)" ::: "memory");
            const unsigned og = xb_add(&bar[XB_TOP], 1u);
            const unsigned tg = og / nx;
            if (og + 1u == (tg + 1u) * nx) xb_add(&bar[XB_TOPGEN], 1u);
            else XB_SPIN(xb_ld(&bar[XB_TOPGEN]) == tg, bar);
            __builtin_amdgcn_fence(__ATOMIC_ACQUIRE, "agent");
            xb_add(&bar[XB_XGEN(b.x)], 1u);
            asm volatile("s_waitcnt vmcnt(0)" ::: "memory");
        } else {
            XB_SPIN(xb_ld(&bar[XB_XGEN(b.x)]) == gen, bar);
            __builtin_amdgcn_fence(__ATOMIC_ACQUIRE, "agent");
            asm volatile("s_waitcnt vmcnt(0)" ::: "memory");
        }
    }
    __syncthreads();
}

namespace gm {
constexpr int HTB = 16384;
__device__ __forceinline__ int lds_byte(int r, int c) { const int st = (r >> 4) * 2 + (c >> 5), rr = r & 15, cc = c & 31, ob = rr * 64 + cc * 2; return st * 1024 + (ob ^ (((ob >> 9) & 1) << 5)); }
__device__ __forceinline__ void stage_rc(int b, int& R, int& C) { const int st = b / 1024, sb = b % 1024, swz = sb ^ (((sb >> 9) & 1) << 5); R = (st >> 1) * 16 + swz / 64; C = (st & 1) * 32 + (swz % 64) / 2; }
__device__ __forceinline__ int perm32(int rho) { const int n = rho >> 4, i = rho & 15; return 8 * (i >> 2) + 4 * n + (i & 3); }
struct Unit { int pm, pn, e, gt, cnt; };
__device__ __forceinline__ bool static_unit(int i, int G, int c, int nM, int nN, Unit& u) {
    const int nwg = nM * nN; const long L = (long)i * G + c; if (L >= nwg) return false;
    int wgid = (int)L; { const int q = nwg / 8, r = nwg % 8, xcd = wgid % 8, off = wgid / 8; wgid = (xcd < r ? xcd * (q + 1) : r * (q + 1) + (xcd - r) * q) + off; }
    const int nig = 8 * nN, gid = wgid / nig, fm = gid * 8, gsz = (nM - fm) < 8 ? (nM - fm) : 8;
    u.pm = fm + ((wgid % nig) % gsz); u.pn = (wgid % nig) / gsz; u.e = 0; u.gt = 0; u.cnt = 0; return true;
}
template <class P> __device__ __forceinline__ void gemm_phase(LAS unsigned char* lds, const P& ph, int wid) {
    const int lane = lane_now(), tid = wid * 64 + lane, wr = wid >> 2, wc = wid & 3, fr = lane & 15, fq = lane >> 4;
    constexpr int nt = P::K / 64;
    static_assert(nt >= 2 && (nt % 2) == 0, "K must be a multiple of 128");
    unsigned voffA[2], voffB[2];
#pragma unroll
    for (int i = 0; i < 2; ++i) { int R, C; stage_rc(tid * 16 + i * 8192, R, C); const int Rb = (R & ~31) + perm32(R & 31); voffB[i] = (unsigned)(Rb * P::LDB + C) * 2u; voffA[i] = (unsigned)(R * P::LDA + C) * 2u; }
    const unsigned ldsw = (unsigned)wid * 1024u;
    const int aoff = lds_byte(wr * 64 + fr, fq * 8), boff = lds_byte(wc * 32 + fr, fq * 8);
    constexpr int hB = P::HSTEPB, hA = 128 * P::LDA * 2;
#define G_SA(b, h) (((b) * 2 + (h)) * gm::HTB)
#define G_SB(b, h) ((4 + (b) * 2 + (h)) * gm::HTB)
#define G_GLDS(src, bufoff, i) __builtin_amdgcn_global_load_lds((const unsigned*)(src), (LAS unsigned*)(lds + (bufoff) + ldsw + (i) * 8192), 16, 0, 0)
#define G_STA(bufoff, ptr, kb, offs, h) do { if constexpr (P::GATHER) { _Pragma("unroll") for (int _i = 0; _i < 2; ++_i) G_GLDS(Ab + (kb) + (offs)[h][_i], bufoff, _i); } \
        else { _Pragma("unroll") for (int _i = 0; _i < 2; ++_i) G_GLDS((ptr) + (h) * hA + voffA[_i], bufoff, _i); } } while (0)
#define G_STB(bufoff, ptr) do { _Pragma("unroll") for (int _i = 0; _i < 2; ++_i) G_GLDS((ptr) + voffB[_i], bufoff, _i); } while (0)
#define G_LDA(dst, b, h) do { _Pragma("unroll") for (int m = 0; m < 4; ++m) _Pragma("unroll") for (int k = 0; k < 2; ++k) dst[m][k] = *(const LAS bf16x8*)(lds + G_SA(b, h) + aoff + m * 2048 + k * 1024); } while (0)
#define G_LDB(dst, b, h) do { _Pragma("unroll") for (int n = 0; n < 2; ++n) _Pragma("unroll") for (int k = 0; k < 2; ++k) dst[n][k] = *(const LAS bf16x8*)(lds + G_SB(b, h) + boff + n * 2048 + k * 1024); } while (0)
#define G_MMA(ai, bj, At, Bt) do { __builtin_amdgcn_s_setprio(1); _Pragma("unroll") for (int m = 0; m < 4; ++m) _Pragma("unroll") for (int n = 0; n < 2; ++n) _Pragma("unroll") for (int k = 0; k < 2; ++k) \
        acc[ai][bj][m][n] = __builtin_amdgcn_mfma_f32_16x16x32_bf16(Bt[n][k], At[m][k], acc[ai][bj][m][n], 0, 0, 0); __builtin_amdgcn_s_setprio(0); } while (0)
#define G_WAIT_V(n) asm volatile("s_waitcnt vmcnt(" #n ")" ::: "memory")
#define G_WAIT_L(n) asm volatile("s_waitcnt lgkmcnt(" #n ")" ::: "memory")
#define G_BAR __builtin_amdgcn_s_barrier()
#define G_SCHED __builtin_amdgcn_sched_barrier(0)
    Unit cur, nxt; int ui = 0;
    if (!ph.next(0, cur)) return;
    f32x4 acc[2][2][4][2];
#pragma unroll
    for (int a = 0; a < 2; ++a)
#pragma unroll
        for (int b = 0; b < 2; ++b)
#pragma unroll
            for (int m = 0; m < 4; ++m)
#pragma unroll
                for (int n = 0; n < 2; ++n) acc[a][b][m][n] = (f32x4){0.f, 0.f, 0.f, 0.f};
    bf16x8 At[4][2], B0[2][2], B1[2][2];
    unsigned co[2][2] = {{0u, 0u}, {0u, 0u}};
    const char* Ab = ph.Abase;
    const char* cA = Ab; const char* cB = ph.b_tile(cur);
    if constexpr (P::GATHER) { ph.a_offs(cur, tid, co); asm volatile("s_waitcnt vmcnt(0)" ::: "memory"); } else cA = ph.a_tile(cur);
    G_STB(G_SB(0, 0), cB); G_STB(G_SB(0, 1), cB + hB); G_STA(G_SA(0, 0), cA, 0, co, 0); G_STA(G_SA(0, 1), cA, 0, co, 1);
    if (wr == 1) G_BAR;
    G_WAIT_V(2); G_BAR;
    G_STB(G_SB(1, 0), cB + 128); G_STA(G_SA(1, 0), cA + 128, 128, co, 0); G_STB(G_SB(1, 1), cB + hB + 128);
    G_WAIT_V(6); G_BAR;
    for (;;) {
        const bool has_next = ph.next(ui + 1, nxt);
        const char* nA = cA; const char* nB = cB;
        if (has_next) { nB = ph.b_tile(nxt); if constexpr (!P::GATHER) nA = ph.a_tile(nxt); }
        for (int t = 0; t < nt; t += 2) {
            const bool last = (t == nt - 2);
            const int kb1 = (t + 1) * 128, kb2 = last ? 0 : (t + 2) * 128, kb3 = kb2 + 128;
            const char* a1 = cA + kb1; const char* a2 = last ? nA : cA + kb2; const char* a3 = a2 + 128;
            const char* b2 = last ? nB : cB + (t + 2) * 128; const char* b3 = b2 + 128;
            G_LDB(B0, 0, 0); G_LDB(B1, 0, 1); G_SCHED; G_LDA(At, 0, 0); G_STA(G_SA(1, 1), a1, kb1, co, 1);
            G_WAIT_V(8); G_WAIT_L(0); G_BAR; G_MMA(0, 0, At, B0); G_MMA(0, 1, At, B1); G_BAR; G_SCHED;
            if constexpr (P::GATHER) { if (last && has_next) ph.a_offs(nxt, tid, co); }
            G_LDA(At, 0, 1); G_STB(G_SB(0, 0), b2); G_STB(G_SB(0, 1), b2 + hB); G_STA(G_SA(0, 0), a2, kb2, co, 0);
            G_WAIT_V(8); G_WAIT_L(0); G_BAR; G_MMA(1, 0, At, B0); G_MMA(1, 1, At, B1); G_BAR; G_SCHED;
            G_LDB(B0, 1, 0); G_LDB(B1, 1, 1); G_SCHED; G_LDA(At, 1, 0); G_STA(G_SA(0, 1), a2, kb2, co, 1);
            G_WAIT_V(8); G_WAIT_L(0); G_BAR; G_MMA(0, 0, At, B0); G_MMA(0, 1, At, B1); G_BAR; G_SCHED;
            G_LDA(At, 1, 1); G_STB(G_SB(1, 0), b3); G_STB(G_SB(1, 1), b3 + hB); G_STA(G_SA(1, 0), a3, kb3, co, 0);
            G_WAIT_V(8); G_WAIT_L(0); G_BAR; G_MMA(1, 0, At, B0); G_MMA(1, 1, At, B1); G_BAR; G_SCHED;
        }
        if (wr == 0) G_BAR;
        ph.epi(acc, cur, wr, wc, fr, fq);
        if (!has_next) break;
#pragma unroll
        for (int a = 0; a < 2; ++a)
#pragma unroll
            for (int b = 0; b < 2; ++b)
#pragma unroll
                for (int m = 0; m < 4; ++m)
#pragma unroll
                    for (int n = 0; n < 2; ++n) acc[a][b][m][n] = (f32x4){0.f, 0.f, 0.f, 0.f};
        cur = nxt; cA = nA; cB = nB; ++ui;
        if (wr == 1) G_BAR;
    }
    G_WAIT_V(0);
    G_BAR;
}
}

using gm::Unit;
#define EPI_ARGS const f32x4 (&acc)[2][2][4][2], const Unit& u, int wr, int wc, int fr_in, int fq_in
#define EPI_OPAQUE int fr = fr_in, fq = fq_in; asm volatile("" : "+v"(fr), "+v"(fq));
#define NO_GATHER __device__ __forceinline__ void a_offs(const Unit&, int, unsigned (&)[2][2]) const {}
#define EPI_FENCE() asm volatile("" ::: "memory")
__device__ __forceinline__ u32x4 pack8(const f32x4& v0, const f32x4& v1) { u32x4 w; w.x = cvt_pk_bf16(v0[0], v0[1]); w.y = cvt_pk_bf16(v0[2], v0[3]); w.z = cvt_pk_bf16(v1[0], v1[1]); w.w = cvt_pk_bf16(v1[2], v1[3]); return w; }
__device__ __forceinline__ float fast_sigmoid(float v) { return __builtin_amdgcn_rcpf(1.f + __builtin_amdgcn_exp2f(-LOG2E * v)); }
__device__ __forceinline__ float fast_gelu(float v) { const float u2 = 1.5957691216057308f * (v + 0.044715f * v * v * v); return v * fast_sigmoid(u2); }

struct PhQKV {
    static constexpr bool GATHER = false; static constexpr int LDA = 1024, K = 1024, LDB = 1024, HSTEPB = 128 * 1024 * 2;
    unsigned char* ws; const char* Abase; int G, c;
    __device__ __forceinline__ bool next(int i, Unit& u) const { return gm::static_unit(i, G, c, M / 256, 12, u); }
    NO_GATHER __device__ __forceinline__ const char* a_tile(const Unit& u) const { return Abase + (size_t)(u.pm * 256) * 1024 * 2; }
    __device__ __forceinline__ const char* b_tile(const Unit& u) const { return (const char*)(ws + WS_WQKV) + (size_t)u.pn * 256 * 1024 * 2; }
    __device__ __forceinline__ void epi(EPI_ARGS) const { EPI_OPAQUE
        const int row0 = u.pm * 256 + wr * 64 + fr; const int t = u.pn >> 2; const int colt = (u.pn & 3) * 256;
        bf16* base = (bf16*)(ws + WS_Q) + (size_t)t * (16u * 1024u * 1024u); const float sc = (t == 0) ? C2 : 1.f;
        const int col0 = colt + wc * 32 + 8 * fq;
#pragma unroll
        for (int ai = 0; ai < 2; ++ai)
#pragma unroll
            for (int m = 0; m < 4; ++m) { bf16* rowp = base + (size_t)(row0 + ai * 128 + m * 16) * 1024 + col0;
#pragma unroll
                for (int bj = 0; bj < 2; ++bj) *(u32x4*)(rowp + bj * 128) = pack8(acc[ai][bj][m][0] * sc, acc[ai][bj][m][1] * sc); }
    }
};
struct PhWo {
    static constexpr bool GATHER = false; static constexpr int LDA = 1024, K = 1024, LDB = 1024, HSTEPB = 128 * 1024 * 2;
    unsigned char* ws; const char* Abase; const float* resid; float* out; int G, c;
    __device__ __forceinline__ bool next(int i, Unit& u) const { return gm::static_unit(i, G, c, M / 256, 4, u); }
    NO_GATHER __device__ __forceinline__ const char* a_tile(const Unit& u) const { return Abase + (size_t)(u.pm * 256) * 1024 * 2; }
    __device__ __forceinline__ const char* b_tile(const Unit& u) const { return (const char*)(ws + WS_WO) + (size_t)u.pn * 256 * 1024 * 2; }
    __device__ __forceinline__ void epi(EPI_ARGS) const { EPI_OPAQUE
        const size_t off0 = (size_t)(u.pm * 256 + wr * 64 + fr) * 1024 + u.pn * 256 + wc * 32 + 8 * fq; bf16* hb = (bf16*)out;
#pragma unroll
        for (int ai = 0; ai < 2; ++ai) { f32x4 r[4][2][2];
#pragma unroll
            for (int m = 0; m < 4; ++m)
#pragma unroll
                for (int bj = 0; bj < 2; ++bj) { const float* p = resid + off0 + (size_t)(ai * 128 + m * 16) * 1024 + bj * 128; r[m][bj][0] = *(const f32x4*)p; r[m][bj][1] = *(const f32x4*)(p + 4); }
            EPI_FENCE();
#pragma unroll
            for (int m = 0; m < 4; ++m)
#pragma unroll
                for (int bj = 0; bj < 2; ++bj) { const size_t off = off0 + (size_t)(ai * 128 + m * 16) * 1024 + bj * 128; const f32x4 v0 = acc[ai][bj][m][0] + r[m][bj][0], v1 = acc[ai][bj][m][1] + r[m][bj][1];
                    *(u32x4*)(hb + off) = pack8(v0, v1); }
            EPI_FENCE(); }
    }
};
struct PhWout {
    static constexpr bool GATHER = false; static constexpr int LDA = 1024, K = 1024, LDB = 1024, HSTEPB = 128 * 1024 * 2;
    unsigned char* ws; const char* Abase; float* out; int G, c;
    __device__ __forceinline__ bool next(int i, Unit& u) const { return gm::static_unit(i, G, c, M / 256, 8, u); }
    NO_GATHER __device__ __forceinline__ const char* a_tile(const Unit& u) const { return Abase + (size_t)(u.pm * 256) * 1024 * 2; }
    __device__ __forceinline__ const char* b_tile(const Unit& u) const { return (const char*)(ws + WS_WOUT) + (size_t)u.pn * 256 * 1024 * 2; }
    __device__ __forceinline__ void epi(EPI_ARGS) const { EPI_OPAQUE
        const size_t off0 = (size_t)(u.pm * 256 + wr * 64 + fr) * 1024 + u.pn * 128 + wc * 32 + 8 * fq; bf16* hb = (bf16*)(ws + WS_XN); const bf16* rs = (const bf16*)out + (size_t)M * D;
        u32x4 r[2][4];
#pragma unroll
        for (int ai = 0; ai < 2; ++ai)
#pragma unroll
            for (int m = 0; m < 4; ++m) r[ai][m] = *(const u32x4*)(rs + off0 + (size_t)(ai * 128 + m * 16) * 1024);
        EPI_FENCE();
#pragma unroll
        for (int ai = 0; ai < 2; ++ai)
#pragma unroll
            for (int m = 0; m < 4; ++m) { const size_t off = off0 + (size_t)(ai * 128 + m * 16) * 1024; f32x4 v0, v1;
#pragma unroll
                for (int j = 0; j < 4; ++j) { const unsigned w0 = r[ai][m][j >> 1], w1 = r[ai][m][2 + (j >> 1)];
                    const float r0 = __uint_as_float((j & 1) ? (w0 & 0xffff0000u) : (w0 << 16)), r1 = __uint_as_float((j & 1) ? (w1 & 0xffff0000u) : (w1 << 16));
                    v0[j] = r0 + acc[ai][0][m][0][j] * fast_sigmoid(acc[ai][1][m][0][j]); v1[j] = r1 + acc[ai][0][m][1][j] * fast_sigmoid(acc[ai][1][m][1][j]); }
                *(u32x4*)(hb + off) = pack8(v0, v1); }
        EPI_FENCE();
    }
};
constexpr int MT_NN = 65, MT_NS = 66, MT_NLIST = 128, MT_SLIST = 384, SMALL_ROWS = 128;
__device__ __forceinline__ void moe_decode(LAS unsigned char* lds, int code, Unit& u) { const LAS int* cn = (const LAS int*)(lds + AUX_OFF); u.e = code >> 8; u.pm = code & 255; u.gt = cn[32 + u.e] + u.pm; u.cnt = cn[u.e]; }
__device__ __forceinline__ void moe_tables(LAS unsigned char* lds, const unsigned* cntg, int tid) {
    LAS int* cn = (LAS int*)(lds + AUX_OFF); LAS int* tb = cn + 32;
    if (tid < 64) {
        const int e = tid & 31; const unsigned cu = __hip_atomic_load(cntg + e * 64, RLX_AGENT); const int c = cu < (unsigned)CAP ? (int)cu : CAP;
        const int n = (c + 255) >> 8; const int lastrows = c - 256 * (n - 1); const int small = (n > 0 && lastrows <= SMALL_ROWS) ? 1 : 0; const int nnorm = n - small;
        int pt = n, pn_ = nnorm, ps_ = small;
#pragma unroll
        for (int o = 1; o < 32; o <<= 1) { const int a = __shfl_up(pt, o, 32), b = __shfl_up(pn_, o, 32), d = __shfl_up(ps_, o, 32); if (e >= o) { pt += a; pn_ += b; ps_ += d; } }
        if (tid < 32) { cn[e] = c; tb[e] = pt - n;
            for (int pm = 0; pm < nnorm; ++pm) cn[MT_NLIST + (pn_ - nnorm) + pm] = (e << 8) | pm;
            if (small) cn[MT_SLIST + ps_ - 1] = (e << 8) | (n - 1);
            if (e == 31) { tb[32] = pt; cn[MT_NN] = pn_; cn[MT_NS] = ps_; } }
    }
    __syncthreads();
}
template <bool GU> __device__ __forceinline__ void tail_job(unsigned char* ws, const bf16* __restrict__ Xbase, const Unit& u, int ns, int wid) {
    const int lane = lane_now(), fr = lane & 15, fq = lane >> 4, w = wid;
    constexpr int K = GU ? 1024 : 256, NG = GU ? 2 : 4;
    const int slot0 = u.pm * 256, rows = u.cnt - slot0;
    if (16 * w >= rows) return;
    const int* pdst = (const int*)(ws + WS_PDST) + u.e * CAP + slot0;
    int r = 16 * w + fr; const bool valid = r < rows; r = valid ? r : rows - 1;
    const int dst = pdst[r];
    const bf16* xp = (GU ? Xbase + (size_t)(dst >> 1) * 1024 : Xbase + ((size_t)u.gt * 256 + r) * 256) + 8 * fq;
    const bf16* wp[NG];
#pragma unroll
    for (int n = 0; n < NG; ++n) wp[n] = GU ? (const bf16*)(ws + WS_WGU) + ((size_t)u.e * 512 + 256 * (ns >> 3) + 128 * n + 16 * (ns & 7) + fr) * 1024 + 8 * fq
                                             : (const bf16*)(ws + WS_WD) + ((size_t)u.e * 1024 + 64 * ns + 16 * n + fr) * 256 + 8 * fq;
    f32x4 acc[NG];
#pragma unroll
    for (int n = 0; n < NG; ++n) acc[n] = (f32x4){0.f, 0.f, 0.f, 0.f};
#pragma unroll 16
    for (int ks = 0; ks < K / 32; ++ks) { const bf16x8 xf = *(const bf16x8*)(xp + 32 * ks); bf16x8 wf[NG];
#pragma unroll
        for (int n = 0; n < NG; ++n) wf[n] = *(const bf16x8*)(wp[n] + 32 * ks);
#pragma unroll
        for (int n = 0; n < NG; ++n) acc[n] = __builtin_amdgcn_mfma_f32_16x16x32_bf16(wf[n], xf, acc[n], 0, 0, 0); }
    if (valid) {
        if (GU) { const float sc = ((const float*)(ws + WS_PS))[u.e * CAP + slot0 + r]; float v[4];
#pragma unroll
            for (int j = 0; j < 4; ++j) { const float gg = acc[0][j] * sc, uu = acc[NG - 1][j] * sc; v[j] = gg * fast_sigmoid(gg) * uu; }
            u32x2 o; o.x = cvt_pk_bf16(v[0], v[1]); o.y = cvt_pk_bf16(v[2], v[3]);
            *(u32x2*)((bf16*)(ws + WS_H) + ((size_t)u.gt * 256 + r) * 256 + 16 * ns + 4 * fq) = o; }
        else { const float wt = ((const float*)(ws + WS_PW))[u.e * CAP + slot0 + r];
#pragma unroll
            for (int n = 0; n < NG; ++n) { u32x2 o; o.x = cvt_pk_bf16(acc[n][0] * wt, acc[n][1] * wt); o.y = cvt_pk_bf16(acc[n][2] * wt, acc[n][3] * wt);
                *(u32x2*)((bf16*)(ws + WS_Y2) + (size_t)dst * 1024 + 64 * ns + 16 * n + 4 * fq) = o; } } }
}
struct PhGateUp {
    static constexpr bool GATHER = true; static constexpr int LDA = 1024, K = 1024, LDB = 1024, HSTEPB = 128 * 1024 * 2;
    unsigned char* ws; const char* Abase; LAS unsigned char* lds; int G, c, nn;
    __device__ __forceinline__ bool next(int i, Unit& u) const { const int idx = i * G + c; if (idx >= 2 * nn) return false; u.pn = idx & 1; moe_decode(lds, ((const LAS int*)(lds + AUX_OFF))[MT_NLIST + (idx >> 1)], u); return true; }
    __device__ __forceinline__ void a_offs(const Unit& u, int tid, unsigned (&o)[2][2]) const { const int* pdst = (const int*)(ws + WS_PDST);
#pragma unroll
        for (int i = 0; i < 2; ++i) { int R, C; gm::stage_rc(tid * 16 + i * 8192, R, C);
#pragma unroll
            for (int h = 0; h < 2; ++h) { int slot = u.pm * 256 + 128 * h + R; slot = slot < u.cnt ? slot : u.cnt - 1; const int tok = pdst[u.e * CAP + slot] >> 1; o[h][i] = (unsigned)(tok * 1024 + C) * 2u; } }
    }
    __device__ __forceinline__ const char* a_tile(const Unit&) const { return Abase; }
    __device__ __forceinline__ const char* b_tile(const Unit& u) const { return (const char*)(ws + WS_WGU) + ((size_t)u.e * 512 + u.pn * 256) * 1024 * 2; }
    __device__ __forceinline__ void epi(EPI_ARGS) const { EPI_OPAQUE
        const int r0 = wr * 64 + fr, col0 = u.pn * 128 + wc * 32 + 8 * fq; const float* ps = (const float*)(ws + WS_PS) + u.e * CAP; bf16* H = (bf16*)(ws + WS_H);
        float sv[2][4];
#pragma unroll
        for (int ai = 0; ai < 2; ++ai)
#pragma unroll
            for (int m = 0; m < 4; ++m) { int slot = u.pm * 256 + r0 + ai * 128 + m * 16; slot = slot < u.cnt ? slot : u.cnt - 1; sv[ai][m] = ps[slot]; }
        EPI_FENCE();
#pragma unroll
        for (int ai = 0; ai < 2; ++ai)
#pragma unroll
            for (int m = 0; m < 4; ++m) { const int r = r0 + ai * 128 + m * 16; const float s = sv[ai][m];
                f32x4 v0, v1;
#pragma unroll
                for (int j = 0; j < 4; ++j) { const float g0 = acc[ai][0][m][0][j] * s, u0 = acc[ai][1][m][0][j] * s, g1 = acc[ai][0][m][1][j] * s, u1 = acc[ai][1][m][1][j] * s;
                    v0[j] = g0 * fast_sigmoid(g0) * u0; v1[j] = g1 * fast_sigmoid(g1) * u1; }
                *(u32x4*)(H + ((size_t)u.gt * 256 + r) * 256 + col0) = pack8(v0, v1); }
        EPI_FENCE();
    }
};
struct PhDown {
    static constexpr bool GATHER = false; static constexpr int LDA = 256, K = 256, LDB = 256, HSTEPB = 128 * 256 * 2;
    unsigned char* ws; const char* Abase; LAS unsigned char* lds; int G, c, nn;
    __device__ __forceinline__ bool next(int i, Unit& u) const { const int idx = i * G + c; if (idx >= 4 * nn) return false; u.pn = idx & 3; moe_decode(lds, ((const LAS int*)(lds + AUX_OFF))[MT_NLIST + (idx >> 2)], u); return true; }
    NO_GATHER __device__ __forceinline__ const char* a_tile(const Unit& u) const { return Abase + (size_t)(u.gt * 256) * 256 * 2; }
    __device__ __forceinline__ const char* b_tile(const Unit& u) const { return (const char*)(ws + WS_WD) + ((size_t)u.e * 1024 + u.pn * 256) * 256 * 2; }
    __device__ __forceinline__ void epi(EPI_ARGS) const { EPI_OPAQUE
        const int r0 = u.pm * 256 + wr * 64 + fr, col0 = u.pn * 256 + wc * 32 + 8 * fq; const int* pdst = (const int*)(ws + WS_PDST) + u.e * CAP; const float* pw = (const float*)(ws + WS_PW) + u.e * CAP; bf16* Y2 = (bf16*)(ws + WS_Y2);
        int slot = r0 < u.cnt ? r0 : u.cnt - 1; int dn = pdst[slot]; float wn = pw[slot];
#pragma unroll
        for (int g = 0; g < 8; ++g) { const int ai = g >> 2, m = g & 3; const int dcur = dn; const float wcur = wn;
            if (g < 7) { int s2 = r0 + ((g + 1) >> 2) * 128 + ((g + 1) & 3) * 16; s2 = s2 < u.cnt ? s2 : u.cnt - 1; dn = pdst[s2]; wn = pw[s2]; }
            if (r0 + ai * 128 + m * 16 < u.cnt) { bf16* yp = Y2 + (size_t)dcur * 1024 + col0;
#pragma unroll
                for (int bj = 0; bj < 2; ++bj) *(u32x4*)(yp + bj * 128) = pack8(acc[ai][bj][m][0] * wcur, acc[ai][bj][m][1] * wcur); }
            EPI_FENCE(); }
    }
};
struct PhSloc {
    static constexpr bool GATHER = false; static constexpr int LDA = 384, K = 256, LDB = 256, HSTEPB = 0;
    unsigned char* ws; const char* Abase; int G, c;
    __device__ __forceinline__ bool next(int i, Unit& u) const { const int idx = i * G + c; if (idx >= 256) return false; u.e = idx >> 2; u.pm = idx & 3; u.pn = 0; u.gt = 0; u.cnt = 0; return true; }
    NO_GATHER __device__ __forceinline__ const char* a_tile(const Unit& u) const { return Abase + (size_t)(u.e * 1024 + u.pm * 256) * 384 * 2; }
    __device__ __forceinline__ const char* b_tile(const Unit& u) const { return (const char*)(ws + WS_SSM) + (size_t)u.e * SSM_G_BYTES; }
    __device__ __forceinline__ void epi(EPI_ARGS) const { EPI_OPAQUE
        const int r0 = u.e * 1024 + u.pm * 256 + wr * 64 + fr, col0 = wc * 32 + 8 * fq; float* Sloc = (float*)(ws + WS_SLOC);
#pragma unroll
        for (int ai = 0; ai < 2; ++ai)
#pragma unroll
            for (int m = 0; m < 4; ++m) { float* p = Sloc + (size_t)(r0 + ai * 128 + m * 16) * 128 + col0; *(f32x4*)p = acc[ai][0][m][0]; *(f32x4*)(p + 4) = acc[ai][0][m][1]; }
    }
};
struct PhY {
    static constexpr bool GATHER = false; static constexpr int LDA = 384, K = 384, LDB = 384, HSTEPB = 128 * 384 * 2;
    unsigned char* ws; const char* Abase; int G, c;
    __device__ __forceinline__ bool next(int i, Unit& u) const { const int idx = i * G + c; if (idx >= 256) return false; u.e = idx >> 2; u.pm = idx & 3; u.pn = 0; u.gt = 0; u.cnt = 0; return true; }
    NO_GATHER __device__ __forceinline__ const char* a_tile(const Unit& u) const { return Abase + (size_t)(u.e * 1024 + u.pm * 256) * 384 * 2; }
    __device__ __forceinline__ const char* b_tile(const Unit& u) const { return (const char*)(ws + WS_SSM) + (size_t)u.e * SSM_G_BYTES + SSM_A2_OFF; }
    __device__ __forceinline__ void epi(EPI_ARGS) const { EPI_OPAQUE
        const int nb = (u.pm & 1) * 256 + wr * 64 + fr;
        bf16* p = (bf16*)(ws + WS_G) + ((size_t)(u.pm >> 1) * SEQ + 16 * nb + 2 * wc + (fq >> 1)) * 1024 + 16 * u.e + 8 * (fq & 1);
#pragma unroll
        for (int ai = 0; ai < 2; ++ai)
#pragma unroll
            for (int m = 0; m < 4; ++m) {
#pragma unroll
                for (int bj = 0; bj < 2; ++bj) { f32x4 v0, v1;
#pragma unroll
                    for (int j = 0; j < 4; ++j) { v0[j] = fast_gelu(acc[ai][bj][m][0][j]); v1[j] = fast_gelu(acc[ai][bj][m][1][j]); }
                    *(u32x4*)(p + bj * 8 * 1024) = pack8(v0, v1); }
                p += (m == 3 ? (128 - 48) : 16) * 16 * 1024; asm volatile("" : "+v"(p) :: "memory"); }
    }
};

namespace at {
constexpr int NSLOT = 4, SLOTB = 8192;
constexpr int LDS_K = 0, LDS_V = NSLOT * SLOTB, LDS_WS = 2 * NSLOT * SLOTB, LDS_TBL = LDS_WS + 2048, LDS_OST = LDS_TBL + 2048, LDS_TOTAL = LDS_OST + 8 * 4096;
typedef short v4i16_t __attribute__((ext_vector_type(4)));
__device__ __forceinline__ int crow(int r, int hi) { return (r & 3) + 8 * (r >> 2) + 4 * hi; }
__device__ __forceinline__ void glds16(const void* gsrc, unsigned lds_dst) { unsigned keep;
    asm volatile("s_mov_b32 %0, m0\n\ts_mov_b32 m0, %2\n\ts_nop 0\n\tglobal_load_lds_dwordx4 %1, off\n\ts_mov_b32 m0, %0" : "=&s"(keep) : "v"(gsrc), "s"(lds_dst) : "memory"); }
__device__ __forceinline__ s16x4 vtr(const LAS unsigned char* p) { return __builtin_bit_cast(s16x4, __builtin_amdgcn_ds_read_tr16_b64_v4i16((LAS v4i16_t*)p)); }
#define AT_WAIT_BAR(N) asm volatile("s_waitcnt vmcnt(" #N ") lgkmcnt(0)\n\ts_barrier" ::: "memory")
template <int THR> __device__ __forceinline__ void attn_unit(int b, int h, int qb, const bf16* Q, const bf16* __restrict__ K, const bf16* __restrict__ V, bf16* O, const float* __restrict__ relb, LAS unsigned char* shm, int wid) {
    const int lane = lane_now(), tid = wid * 64 + lane, r32 = lane & 31, hi = lane >> 5;
    const long rowbase = (long)b * SEQ; const int q0 = qb * 256; const int cq = 4 * qb + (wid >> 1);
    const bf16* Qw = Q + (rowbase + q0 + wid * 32) * D + h * 64;
    const unsigned lds0 = (unsigned)(uintptr_t)shm;
    LAS float* wsf = (LAS float*)(shm + LDS_WS) + wid * 64; LAS float* tbl = (LAS float*)(shm + LDS_TBL);
    const int kc_lo = (4 * qb - 8) < 0 ? 0 : (4 * qb - 8); const int NT = 4 * qb + 3 - kc_lo + 1;
    const int ta = ((cq - 8) < kc_lo ? kc_lo : (cq - 8)) - kc_lo, tb_ = cq - kc_lo;
    if (tid < 320) tbl[tid] = relb[h * NREL + (tid < 256 ? tid : 256)] * LOG2E;
    const bf16* ksrc = K + (rowbase + kc_lo * 64 + lane) * D + h * 64 + wid * 8;
    const bf16* vsrc = V + (rowbase + kc_lo * 64 + 16 * (wid & 3) + (lane >> 2)) * D + h * 64 + (wid >> 2) * 32 + (lane & 3) * 8;
    const unsigned kdst = lds0 + LDS_K + wid * 1024, vdst = lds0 + LDS_V + wid * 1024;
#define AT_DMA(t) do { const unsigned so_ = (unsigned)((t) & 3) * SLOTB; glds16(ksrc + (long)(t) * 64 * D, (unsigned)__builtin_amdgcn_readfirstlane(kdst + so_)); glds16(vsrc + (long)(t) * 64 * D, (unsigned)__builtin_amdgcn_readfirstlane(vdst + so_)); } while (0)
    bf16x8 qr[4];
#pragma unroll
    for (int d0 = 0; d0 < 4; ++d0) qr[d0] = *reinterpret_cast<const bf16x8*>(&Qw[(long)r32 * D + d0 * 16 + hi * 8]);
    AT_DMA(0); AT_DMA(1); AT_DMA(2);
    asm volatile("" : "+v"(qr[0]), "+v"(qr[1]), "+v"(qr[2]), "+v"(qr[3]));
    float mrow = -1e30f, lsum = 0.f; f32x16 o[2]; o[0] = f32x16{}; o[1] = f32x16{};
    f32x16 s0 = f32x16{}, s1 = f32x16{};
    f32x16 cfar = f32x16{};
    const int qoff = 32 * (wid & 1) + r32 + 128 - 4 * hi;
#define AT_CINIT(P0, P1, kc_, msub_) do { const int delta_ = cq - (kc_); \
        if (delta_ >= 3) { P0 = cfar; P1 = cfar; } \
        else { const LAS float* tb = tbl + (64 * delta_ + qoff); _Pragma("unroll") for (int r = 0; r < 16; ++r) { const int kj = (r & 3) + 8 * (r >> 2); P0[r] = tb[-kj] - (msub_); P1[r] = tb[-kj - 32] - (msub_); } } } while (0)
#define AT_KLOAD(t_) do { const LAS unsigned char* kp = shm + LDS_K + ((t_) & 3) * SLOTB + hi * 1024 + r32 * 16; \
        _Pragma("unroll") for (int d0 = 0; d0 < 4; ++d0) { kf[2 * d0] = *(const LAS bf16x8*)(kp + d0 * 2048); kf[2 * d0 + 1] = *(const LAS bf16x8*)(kp + d0 * 2048 + 512); } } while (0)
#define AT_QK(P0, P1) do { _Pragma("unroll") for (int d0 = 0; d0 < 4; ++d0) { \
            P0 = __builtin_amdgcn_mfma_f32_32x32x16_bf16(kf[2 * d0], qr[d0], P0, 0, 0, 0); P1 = __builtin_amdgcn_mfma_f32_32x32x16_bf16(kf[2 * d0 + 1], qr[d0], P1, 0, 0, 0); } } while (0)
#define AT_CFAR() do { const float c0_ = tbl[256] - mrow; _Pragma("unroll") for (int r = 0; r < 16; ++r) cfar[r] = c0_; } while (0)
#define AT_STATS() do { float ra = fmaxf(fmaxf(s0[0], s0[1]), s1[0]), rb2 = fmaxf(fmaxf(s0[2], s0[3]), s1[1]); ra = fmaxf(fmaxf(ra, s1[2]), s1[3]); \
        _Pragma("unroll") for (int r = 4; r < 16; r += 4) { ra = fmaxf(fmaxf(ra, s0[r]), s0[r + 1]); rb2 = fmaxf(fmaxf(rb2, s0[r + 2]), s0[r + 3]); ra = fmaxf(fmaxf(ra, s1[r]), s1[r + 1]); rb2 = fmaxf(fmaxf(rb2, s1[r + 2]), s1[r + 3]); } \
        float rm = fmaxf(ra, rb2); { auto rr = __builtin_amdgcn_permlane32_swap(__float_as_uint(rm), __float_as_uint(rm), false, false); rm = fmaxf(__uint_as_float(rr[0]), __uint_as_float(rr[1])); } \
        if (mrow < -1e29f) { mrow = rm; _Pragma("unroll") for (int r = 0; r < 16; ++r) { s0[r] -= rm; s1[r] -= rm; } AT_CFAR(); } \
        else if (__any(rm > (float)THR)) { const float dl = fmaxf(rm, 0.f), f = __builtin_amdgcn_exp2f(-dl); mrow += dl; lsum *= f; \
            if (hi == 0) wsf[r32] = f; LDS_WAIT(); \
            _Pragma("unroll") for (int r = 0; r < 16; ++r) { const float fr_ = wsf[crow(r, hi)]; o[0][r] *= fr_; o[1][r] *= fr_; s0[r] -= dl; s1[r] -= dl; } AT_CFAR(); } } while (0)
#define AT_EXP_PACK() float sacc = 0.f, sacc2 = 0.f; \
        _Pragma("unroll") for (int r = 0; r < 16; ++r) { s0[r] = __builtin_amdgcn_exp2f(s0[r]); s1[r] = __builtin_amdgcn_exp2f(s1[r]); sacc += s0[r]; sacc2 += s1[r]; } \
        lsum += sacc + sacc2; \
        const u32x4 pw0 = (u32x4){cvtpk_s(s0[0], s0[1]), cvtpk_s(s0[2], s0[3]), cvtpk_s(s0[4], s0[5]), cvtpk_s(s0[6], s0[7])}; \
        const u32x4 pw1 = (u32x4){cvtpk_s(s0[8], s0[9]), cvtpk_s(s0[10], s0[11]), cvtpk_s(s0[12], s0[13]), cvtpk_s(s0[14], s0[15])}; \
        const u32x4 pw2 = (u32x4){cvtpk_s(s1[0], s1[1]), cvtpk_s(s1[2], s1[3]), cvtpk_s(s1[4], s1[5]), cvtpk_s(s1[6], s1[7])}; \
        const u32x4 pw3 = (u32x4){cvtpk_s(s1[8], s1[9]), cvtpk_s(s1[10], s1[11]), cvtpk_s(s1[12], s1[13]), cvtpk_s(s1[14], s1[15])}; \
        const bf16x8 pa[4] = {__builtin_bit_cast(bf16x8, pw0), __builtin_bit_cast(bf16x8, pw1), __builtin_bit_cast(bf16x8, pw2), __builtin_bit_cast(bf16x8, pw3)};
#define AT_VLOAD(t_) do { const LAS unsigned char* vp = shm + LDS_V + ((t_) & 3) * SLOTB + ((lane >> 4) & 1) * 32 + (lane & 3) * 8 + (4 * hi + ((lane & 15) >> 2)) * 64; \
        _Pragma("unroll") for (int d0 = 0; d0 < 2; ++d0) _Pragma("unroll") for (int ks = 0; ks < 4; ++ks) { vlo[d0 * 4 + ks] = vtr(vp + d0 * 4096 + ks * 1024); vhi[d0 * 4 + ks] = vtr(vp + d0 * 4096 + ks * 1024 + 512); } } while (0)
#define AT_PV() do { _Pragma("unroll") for (int d0 = 0; d0 < 2; ++d0) _Pragma("unroll") for (int ks = 0; ks < 4; ++ks) { const s16x4 lo = vlo[d0 * 4 + ks], hh = vhi[d0 * 4 + ks]; \
            const bf16x8 vf = (bf16x8){lo[0], lo[1], lo[2], lo[3], hh[0], hh[1], hh[2], hh[3]}; o[d0] = __builtin_amdgcn_mfma_f32_32x32x16_bf16(pa[ks], vf, o[d0], 0, 0, 0); } } while (0)
    bf16x8 kf[8]; s16x4 vlo[8], vhi[8];
    for (int t = 0; t < NT; ++t) {
        if (t + 2 < NT) { AT_WAIT_BAR(4); } else if (t + 1 < NT) { AT_WAIT_BAR(2); } else { AT_WAIT_BAR(0); }
        if (t + 3 < NT) AT_DMA(t + 3);
        if (t >= ta && t <= tb_) {
            AT_KLOAD(t); AT_VLOAD(t);
            __builtin_amdgcn_sched_barrier(0);
            if (mrow < -1e29f) { const float c0_ = tbl[256]; _Pragma("unroll") for (int r = 0; r < 16; ++r) cfar[r] = c0_; }
            AT_CINIT(s0, s1, kc_lo + t, (mrow < -1e29f ? 0.f : mrow));
            AT_QK(s0, s1);
            AT_STATS();
            AT_EXP_PACK()
            AT_PV();
        }
    }
    { auto rr = __builtin_amdgcn_permlane32_swap(__float_as_uint(lsum), __float_as_uint(lsum), false, false); lsum = __uint_as_float(rr[0]) + __uint_as_float(rr[1]); }
    if (hi == 0) wsf[32 + r32] = lsum;
    LDS_WAIT();
    float rli[16];
#pragma unroll
    for (int r = 0; r < 16; ++r) rli[r] = __builtin_amdgcn_rcpf(wsf[32 + crow(r, hi)]);
    bf16* Ow = O + (rowbase + q0 + wid * 32) * D + h * 64;
    { LAS bf16* stg = (LAS bf16*)(shm + LDS_OST) + wid * 2048;
#pragma unroll
      for (int r = 0; r < 16; ++r) { const int orow = crow(r, hi);
#pragma unroll
          for (int d0 = 0; d0 < 2; ++d0) stg[orow * 64 + d0 * 32 + r32] = f2bf(o[d0][r] * rli[r]); }
      LDS_WAIT();
#pragma unroll
      for (int i = 0; i < 4; ++i) { const int row = i * 8 + (lane >> 3), ch = lane & 7; const u32x4 v = *(const LAS u32x4*)(stg + row * 64 + ch * 8); *(u32x4*)(Ow + (long)row * D + ch * 8) = v; } }
    asm volatile("s_waitcnt lgkmcnt(0)\n\ts_barrier" ::: "memory");
#undef AT_DMA
#undef AT_CINIT
#undef AT_QK
#undef AT_KLOAD
#undef AT_VLOAD
#undef AT_CFAR
#undef AT_STATS
#undef AT_EXP_PACK
#undef AT_PV
}
}

struct Args { const float* in[23]; float* out; unsigned char* ws; int ph_lo, ph_hi, li, pad; };

struct TrDesc { const float* W; bf16* WT; const float* ks; int ldw, k0, n0, ldt, drow0; };
__device__ __forceinline__ void tr_load(const TrDesc& d, float (&v)[32], int lane) {
    const float* wp = d.W + (size_t)(d.k0 + (lane >> 5)) * d.ldw + d.n0 + (lane & 31);
#pragma unroll
    for (int i = 0; i < 32; ++i) v[i] = wp[(size_t)(2 * i) * d.ldw];
}
__device__ __forceinline__ void tr_store(const TrDesc& d, float (&v)[32], LAS float* scr, int lane) {
    if (d.ks) {
#pragma unroll
        for (int i = 0; i < 32; ++i) v[i] *= d.ks[d.k0 + 2 * i + (lane >> 5)]; }
#pragma unroll
    for (int i = 0; i < 32; ++i) scr[(2 * i + (lane >> 5)) * 33 + (lane & 31)] = v[i];
    LDS_WAIT(); asm volatile("" ::: "memory");
    const int c = lane & 7;
#pragma unroll
    for (int j = 0; j < 4; ++j) { const int n = (lane >> 3) + 8 * j; const LAS float* s = scr + (8 * c) * 33 + n;
        u32x4 o; o.x = pk2(s[0 * 33], s[1 * 33]); o.y = pk2(s[2 * 33], s[3 * 33]); o.z = pk2(s[4 * 33], s[5 * 33]); o.w = pk2(s[6 * 33], s[7 * 33]);
        *(u32x4*)(d.WT + (size_t)(d.drow0 + n) * d.ldt + d.k0 + 8 * c) = o; }
    LDS_WAIT(); asm volatile("" ::: "memory");
}
struct TrSrc { const float* w_qkv; const float* w_o; const float* w_out; const float* wg; const float* wu; const float* wd; const float* gn; unsigned char* ws; int nd; };
__device__ __forceinline__ TrDesc tr_desc(const TrSrc& S, int it) {
    TrDesc d; d.ks = nullptr;
    if (it < S.nd) {
        if (it < 1536) { const int kb = it / 96, nb = it % 96; d.W = S.w_qkv; d.ldw = 3072; d.k0 = kb * 64; d.n0 = nb * 32; d.WT = (bf16*)(S.ws + WS_WQKV); d.ldt = 1024; d.drow0 = nb * 32; }
        else if (it < 2048) { const int r = it - 1536, kb = r >> 5, nb = r & 31; d.W = S.w_o; d.ldw = 1024; d.k0 = kb * 64; d.n0 = nb * 32; d.WT = (bf16*)(S.ws + WS_WO); d.ldt = 1024; d.drow0 = nb * 32; }
        else { const int r = it - 2048, kb = r >> 6, nb = r & 63, n0 = nb * 32, ag = n0 >> 10, cc = n0 & 1023; d.W = S.w_out; d.ldw = 2048; d.k0 = kb * 64; d.n0 = n0; d.WT = (bf16*)(S.ws + WS_WOUT); d.ldt = 1024; d.drow0 = 256 * (cc >> 7) + 128 * ag + (cc & 127); }
    } else { const int m = it - S.nd;
        if (m < 8192) { const int which = m >> 12, r = m & 4095, e = r >> 7, kb = (r >> 3) & 15, nb = r & 7, n0 = nb * 32;
            d.W = (which ? S.wu : S.wg) + (size_t)e * 1024 * 256; d.ldw = 256; d.k0 = kb * 64; d.n0 = n0; d.WT = (bf16*)(S.ws + WS_WGU); d.ldt = 1024; d.drow0 = e * 512 + 256 * (n0 >> 7) + 128 * which + (n0 & 127); d.ks = S.gn; }
        else { const int r = m - 8192, e = r >> 7, kb = (r >> 5) & 3, nb = r & 31; d.W = S.wd + (size_t)e * 256 * 1024; d.ldw = 1024; d.k0 = kb * 64; d.n0 = nb * 32; d.WT = (bf16*)(S.ws + WS_WD); d.ldt = 256; d.drow0 = e * 1024 + nb * 32; } }
    return d;
}
__device__ __forceinline__ void tr_stream(const TrSrc& S, LAS float* scr, int gw, int NGW, int lane) {
    const int N = S.nd + 12288; int it = gw; if (it >= N) return;
    float va[32], vb[32]; TrDesc d0 = tr_desc(S, it), d1 = d0; tr_load(d0, va, lane);
    for (;;) {
        int nx = it + NGW; if (nx < N) { d1 = tr_desc(S, nx); tr_load(d1, vb, lane); }
        tr_store(d0, va, scr, lane); it = nx; if (it >= N) break;
        nx = it + NGW; if (nx < N) { d0 = tr_desc(S, nx); tr_load(d0, va, lane); }
        tr_store(d1, vb, scr, lane); it = nx; if (it >= N) break;
    }
}
__device__ __forceinline__ void ssm_mats(int g, int q, const float* lre, const float* lim, const float* lstep, const float* bre, const float* bim, const float* cre, const float* cim, const float* dsk,
                                         unsigned char* ssm_ws, float* a16g, LAS float* L, int tid) {
    LAS float* pwr = L; LAS float* pwi = L + 64 * 17; LAS float* bbr = L + 2 * 64 * 17; LAS float* bbi = bbr + 1024; LAS float* ccr = bbi + 1024; LAS float* cci = ccr + 1024; LAS float* Kt = cci + 1024;
    if (tid < 64) { const int p = tid;
        const float lr = fminf(lre[g * 64 + p], -1e-4f), li = lim[g * 64 + p], step = expf(lstep[g]);
        const float decay = expf(lr * step), ang = li * step, ar = decay * cosf(ang), ai = decay * sinf(ang);
        const float den = lr * lr + li * li, nr = ar - 1.f, fr = (nr * lr + ai * li) / den, fi = (ai * lr - nr * li) / den;
        for (int c = 0; c < 16; ++c) { const float br = bre[(g * 64 + p) * 16 + c], bi = bim[(g * 64 + p) * 16 + c]; bbr[p * 16 + c] = fr * br - fi * bi; bbi[p * 16 + c] = fr * bi + fi * br;
            ccr[c * 64 + p] = cre[(g * 16 + c) * 64 + p]; cci[c * 64 + p] = cim[(g * 16 + c) * 64 + p]; }
        float xr = 1.f, xi = 0.f;
        for (int n = 0; n <= 16; ++n) { pwr[p * 17 + n] = xr; pwi[p * 17 + n] = xi; const float t = xr * ar - xi * ai; xi = xr * ai + xi * ar; xr = t; }
        if (q == 0) { a16g[(g * 64 + p) * 2] = pwr[p * 17 + 16]; a16g[(g * 64 + p) * 2 + 1] = pwi[p * 17 + 16]; }
    }
    __syncthreads();
    if (tid < 256) { const int tl = tid >> 6, c = (tid >> 2) & 15, cq = tid & 3, tau = 4 * q + tl;
        float s0 = 0.f, s1 = 0.f, s2 = 0.f, s3 = 0.f;
        for (int p = 0; p < 64; ++p) { const float cr = ccr[c * 64 + p], ci = cci[c * 64 + p], ar = pwr[p * 17 + tau], ai = pwi[p * 17 + tau]; const float tr = cr * ar - ci * ai, ti = cr * ai + ci * ar;
            const f32x4 br = *(const LAS f32x4*)(bbr + p * 16 + 4 * cq), bi = *(const LAS f32x4*)(bbi + p * 16 + 4 * cq);
            s0 += tr * br[0] - ti * bi[0]; s1 += tr * br[1] - ti * bi[1]; s2 += tr * br[2] - ti * bi[2]; s3 += tr * br[3] - ti * bi[3]; }
        if (tau == 0) { const float dd = dsk[g * 16 + c]; if (4 * cq == (c & ~3)) { if ((c & 3) == 0) s0 += dd; else if ((c & 3) == 1) s1 += dd; else if ((c & 3) == 2) s2 += dd; else s3 += dd; } }
        LAS float* kp = Kt + tl * 256 + c * 16 + 4 * cq; kp[0] = s0; kp[1] = s1; kp[2] = s2; kp[3] = s3; }
    __syncthreads();
    bf16* Bend = (bf16*)(ssm_ws + (size_t)g * SSM_G_BYTES); bf16* A2 = (bf16*)(ssm_ws + (size_t)g * SSM_G_BYTES + SSM_A2_OFF);
    for (int o = tid; o < 2048; o += NTHR) { const int tl = o >> 9, i = (o >> 5) & 15, c = (o >> 1) & 15, hf = o & 1, tau = 4 * q + tl, j = i - tau;
        if (j >= 0) { const LAS float* kp = Kt + tl * 256 + c * 16 + 8 * hf; u32x4 w; w.x = pk2(kp[0], kp[1]); w.y = pk2(kp[2], kp[3]); w.z = pk2(kp[4], kp[5]); w.w = pk2(kp[6], kp[7]);
            *(u32x4*)(A2 + (size_t)(i * 16 + c) * 384 + j * 16 + 8 * hf) = w; } }
    for (int o = tid; o < 2048; o += NTHR) { const int il = o >> 9, c = (o >> 5) & 15, j = (o >> 1) & 15, hf = o & 1, i = 4 * q + il;
        if (j > i) *(u32x4*)(A2 + (size_t)(i * 16 + c) * 384 + j * 16 + 8 * hf) = (u32x4){0u, 0u, 0u, 0u}; }
    for (int o = tid; o < 1024; o += NTHR) { const int il = o >> 8, c = (o >> 4) & 15, k8 = (o & 15) * 8, i = 4 * q + il; float v[8];
#pragma unroll
        for (int qq = 0; qq < 4; ++qq) { const int p = (k8 >> 1) + qq; const float cr = ccr[c * 64 + p], ci = cci[c * 64 + p], ar = pwr[p * 17 + i + 1], ai = pwi[p * 17 + i + 1];
            v[2 * qq] = cr * ar - ci * ai; v[2 * qq + 1] = -(cr * ai + ci * ar); }
        u32x4 w; w.x = pk2(v[0], v[1]); w.y = pk2(v[2], v[3]); w.z = pk2(v[4], v[5]); w.w = pk2(v[6], v[7]); *(u32x4*)(A2 + (size_t)(i * 16 + c) * 384 + 256 + k8) = w; }
    for (int o = tid; o < 1024; o += NTHR) { const int n = 32 * q + (o >> 5), k8 = (o & 31) * 8, p = n >> 1, ri = n & 1, j = k8 >> 4; float v[8];
        const float ar = pwr[p * 17 + 15 - j], ai = pwi[p * 17 + 15 - j];
#pragma unroll
        for (int qq = 0; qq < 8; ++qq) { const int c2 = (k8 & 15) + qq; const float br = bbr[p * 16 + c2], bi = bbi[p * 16 + c2]; v[qq] = ri ? (ar * bi + ai * br) : (ar * br - ai * bi); }
        u32x4 w; w.x = pk2(v[0], v[1]); w.y = pk2(v[2], v[3]); w.z = pk2(v[4], v[5]); w.w = pk2(v[6], v[7]); *(u32x4*)(Bend + (size_t)n * 256 + k8) = w; }
    __syncthreads();
}

__device__ __forceinline__ void router_phase(const bf16* __restrict__ h, const u32x4* __restrict__ rwt, const float* __restrict__ bgr, const float* __restrict__ ber, unsigned* cntg,
                                             int* pdst, float* pw, float* ps, float* srow, LAS unsigned char* lds, int vcu, int G, int wid, bool prefilled) {
    const int lane = lane_now(), tid = wid * 64 + lane;
    LAS bf16* Wl = (LAS bf16*)lds;
    if (!prefilled) for (int i = tid; i < RW_LAYER_BYTES / 16; i += NTHR) ((LAS u32x4*)lds)[i] = rwt[i];
    LAS int* lc = (LAS int*)(lds + RSCR_OFF); LAS int* lbase = lc + 32;
    const int rb = wid & 3, kh = wid >> 2, row = lane & 15, kq = lane >> 4;
    for (int blk = vcu; blk < M / 64; blk += G) {
        if (tid < 32) lc[tid] = 0;
        __syncthreads();
        const int t0 = blk * 64;
        const bf16* hp = h + (size_t)(t0 + 16 * rb + row) * D + 512 * kh + 8 * kq;
        const LAS bf16* wp0 = Wl + row * RW_PITCH + 512 * kh + 8 * kq; const LAS bf16* wp1 = wp0 + 16 * RW_PITCH; const LAS bf16* wp2 = Wl + (32 + (row & 3)) * RW_PITCH + 512 * kh + 8 * kq;
        f32x4 a0 = {0.f, 0.f, 0.f, 0.f}, a1 = a0, a2 = a0; float ssl = 0.f;
#pragma unroll 4
        for (int j = 0; j < 16; ++j) { const u32x4 hw = *(const u32x4*)(hp + 32 * j); const bf16x8 av = __builtin_bit_cast(bf16x8, hw);
#pragma unroll
            for (int i = 0; i < 4; ++i) { const float lo_ = __uint_as_float(hw[i] << 16), hi_ = __uint_as_float(hw[i] & 0xffff0000u); ssl += lo_ * lo_ + hi_ * hi_; }
            const bf16x8 b0h = *(const LAS bf16x8*)(wp0 + 32 * j), b0l = *(const LAS bf16x8*)(wp0 + RW_PLANE + 32 * j), b1h = *(const LAS bf16x8*)(wp1 + 32 * j), b1l = *(const LAS bf16x8*)(wp1 + RW_PLANE + 32 * j),
                         b2h = *(const LAS bf16x8*)(wp2 + 32 * j), b2l = *(const LAS bf16x8*)(wp2 + RW_PLANE + 32 * j);
            a0 = __builtin_amdgcn_mfma_f32_16x16x32_bf16(av, b0h, a0, 0, 0, 0); a0 = __builtin_amdgcn_mfma_f32_16x16x32_bf16(av, b0l, a0, 0, 0, 0);
            a1 = __builtin_amdgcn_mfma_f32_16x16x32_bf16(av, b1h, a1, 0, 0, 0); a1 = __builtin_amdgcn_mfma_f32_16x16x32_bf16(av, b1l, a1, 0, 0, 0);
            a2 = __builtin_amdgcn_mfma_f32_16x16x32_bf16(av, b2h, a2, 0, 0, 0); a2 = __builtin_amdgcn_mfma_f32_16x16x32_bf16(av, b2l, a2, 0, 0, 0); }
        ssl += __shfl_xor(ssl, 16); ssl += __shfl_xor(ssl, 32);
        LAS float* P = (LAS float*)(lds + RSCR_OFF + 256);
        LAS float* pp = P + (16 * rb) * 40;
        if (kh == 1) {
#pragma unroll
            for (int r = 0; r < 4; ++r) { const int tk = 4 * kq + r; pp[tk * 40 + row] = a0[r]; pp[tk * 40 + 16 + row] = a1[r]; if (row < 4) pp[tk * 40 + 32 + row] = a2[r]; }
            if (kq == 0) pp[row * 40 + 36] = ssl; }
        __syncthreads();
        if (kh == 0) {
#pragma unroll
            for (int r = 0; r < 4; ++r) { const int tk = 4 * kq + r; pp[tk * 40 + row] += a0[r]; pp[tk * 40 + 16 + row] += a1[r]; if (row < 4) pp[tk * 40 + 32 + row] += a2[r]; }
            if (kq == 0) pp[row * 40 + 36] += ssl; }
        __syncthreads();
        int e1 = 0, e2 = 0; float w1 = 0.f, w2 = 0.f, s = 0.f; int sl1 = 0, sl2 = 0;
        if (tid < 64) { LAS float* p0 = P + tid * 40;
            s = rsqrtf(p0[36] * (1.f / D) + RMS_EPS);
            for (int o = 0; o < 36; ++o) p0[o] = p0[o] * s + (o < 4 ? bgr[o] : ber[o - 4]);
            int gi = 0; float gmx = p0[0];
            for (int i = 1; i < 4; ++i) if (p0[i] > gmx) { gmx = p0[i]; gi = i; }
            float den = 0.f; for (int i = 0; i < 4; ++i) den += __expf(p0[i] - gmx);
            const float gp = 1.f / den; const LAS float* sl = p0 + 4 + 8 * gi;
            int i1 = 0; float l1 = sl[0]; for (int i = 1; i < 8; ++i) if (sl[i] > l1) { l1 = sl[i]; i1 = i; }
            int i2 = -1; float l2 = -3.4e38f; for (int i = 0; i < 8; ++i) if (i != i1 && sl[i] > l2) { l2 = sl[i]; i2 = i; }
            const float ex = __expf(l2 - l1); w1 = gp / (1.f + ex); w2 = gp * ex / (1.f + ex); e1 = gi * 8 + i1; e2 = gi * 8 + i2;
            sl1 = __hip_atomic_fetch_add(&lc[e1], 1, __ATOMIC_RELAXED, __HIP_MEMORY_SCOPE_WORKGROUP); sl2 = __hip_atomic_fetch_add(&lc[e2], 1, __ATOMIC_RELAXED, __HIP_MEMORY_SCOPE_WORKGROUP);
            srow[t0 + tid] = s; }
        __syncthreads();
        if (tid < 32) { const int n = lc[tid]; lbase[tid] = n ? (int)__hip_atomic_fetch_add(cntg + tid * 64, (unsigned)n, RLX_AGENT) : 0; }
        __syncthreads();
        if (tid < 64) { const int t = t0 + tid; int i1 = lbase[e1] + sl1, i2 = lbase[e2] + sl2;
            if (i1 < CAP) { pdst[e1 * CAP + i1] = 2 * t; pw[e1 * CAP + i1] = w1; ps[e1 * CAP + i1] = s; }
            if (i2 < CAP) { pdst[e2 * CAP + i2] = 2 * t + 1; pw[e2 * CAP + i2] = w2; ps[e2 * CAP + i2] = s; } }
        __syncthreads();
    }
}

template <bool FINAL> __device__ __forceinline__ void combine_phase(const bf16* __restrict__ hin, const bf16* __restrict__ Y2, const float* __restrict__ g, bf16* __restrict__ hout, bf16* __restrict__ xng, float* __restrict__ outf, int vcu, int G, int wid, int lane) {
    for (int base = vcu * 16; base < M; base += G * 16) {
#pragma unroll
        for (int rr = 0; rr < 2; ++rr) { const int row = base + 2 * wid + rr;
            float4 v[4]; float ss = 0.f;
#pragma unroll
            for (int j = 0; j < 4; ++j) { const int c = 4 * (lane + 64 * j);
                const u32x2 hh = *(const u32x2*)(hin + (size_t)row * D + c), ya = *(const u32x2*)(Y2 + ((size_t)2 * row) * D + c), yb = *(const u32x2*)(Y2 + ((size_t)2 * row + 1) * D + c);
                v[j].x = __uint_as_float(hh.x << 16) + __uint_as_float(ya.x << 16) + __uint_as_float(yb.x << 16); v[j].y = __uint_as_float(hh.x & 0xffff0000u) + __uint_as_float(ya.x & 0xffff0000u) + __uint_as_float(yb.x & 0xffff0000u);
                v[j].z = __uint_as_float(hh.y << 16) + __uint_as_float(ya.y << 16) + __uint_as_float(yb.y << 16); v[j].w = __uint_as_float(hh.y & 0xffff0000u) + __uint_as_float(ya.y & 0xffff0000u) + __uint_as_float(yb.y & 0xffff0000u);
                ss += v[j].x * v[j].x + v[j].y * v[j].y + v[j].z * v[j].z + v[j].w * v[j].w;
                if (!FINAL) { u32x2 w; w.x = pk2(v[j].x, v[j].y); w.y = pk2(v[j].z, v[j].w); *(u32x2*)(hout + (size_t)row * D + c) = w; } }
            ss = wave_sum(ss); const float s = rsqrtf(ss * (1.f / D) + RMS_EPS);
#pragma unroll
            for (int j = 0; j < 4; ++j) { const int c = 4 * (lane + 64 * j); const float4 gg = *(const float4*)(g + c);
                const float ox = v[j].x * s * gg.x, oy = v[j].y * s * gg.y, oz = v[j].z * s * gg.z, ow = v[j].w * s * gg.w;
                if (FINAL) { float4 o; o.x = ox; o.y = oy; o.z = oz; o.w = ow; *(float4*)(outf + (size_t)row * D + c) = o; }
                else { u32x2 w; w.x = pk2(ox, oy); w.y = pk2(oz, ow); *(u32x2*)(xng + xng_off(row, c)) = w; } } }
    }
}

__device__ __forceinline__ void scan_unit(int g, int pm, const float* __restrict__ Sloc, const float* __restrict__ a16g, bf16* xng, LAS unsigned char* lds, int wid) {
    const int tid = wid * 64 + lane_now(), p = tid & 63, q = tid >> 6, b = pm >> 1, half = pm & 1;
    LAS float* E = (LAS float*)(lds + AUX_OFF);
    const float ar = a16g[(g * 64 + p) * 2], ai = a16g[(g * 64 + p) * 2 + 1];
    float pr = ar, pi = ai;
#pragma unroll
    for (int k = 0; k < 5; ++k) { const float nr = pr * pr - pi * pi, ni = 2.f * pr * pi; pr = nr; pi = ni; }
    float cr = 0.f, ci = 0.f;
    for (int rnd = 0; rnd <= half; ++rnd) {
        const size_t row0 = (size_t)g * 1024 + b * 512 + rnd * 256 + q * 32;
        const float* sp = Sloc + row0 * 128 + 2 * p;
        float2 v[32];
#pragma unroll
        for (int s = 0; s < 32; ++s) v[s] = *(const float2*)(sp + (size_t)s * 128);
        float xr = 0.f, xi = 0.f;
#pragma unroll
        for (int s = 0; s < 32; ++s) { const float nr = ar * xr - ai * xi + v[s].x, ni = ar * xi + ai * xr + v[s].y; xr = nr; xi = ni; }
        E[(q * 64 + p) * 2] = xr; E[(q * 64 + p) * 2 + 1] = xi;
        __syncthreads();
        float ir = cr, ii = ci, mr = 0.f, mi = 0.f;
#pragma unroll
        for (int qq = 0; qq < 8; ++qq) { if (qq == q) { mr = ir; mi = ii; } const float er = E[(qq * 64 + p) * 2], ei = E[(qq * 64 + p) * 2 + 1]; const float nr = pr * ir - pi * ii + er, ni = pr * ii + pi * ir + ei; ir = nr; ii = ni; }
        cr = ir; ci = ii;
        if (rnd == half) { bf16* xp = xng + row0 * 384 + 256 + 2 * p; xr = mr; xi = mi;
#pragma unroll
            for (int s = 0; s < 32; ++s) { *(unsigned*)(xp + (size_t)s * 384) = pk2(xr, xi); const float nr = ar * xr - ai * xi + v[s].x, ni = ar * xi + ai * xr + v[s].y; xr = nr; xi = ni; } }
        __syncthreads();
    }
}

__global__ void __launch_bounds__(NTHR, 2) mk_fwd(Args args) {
    extern __shared__ __attribute__((aligned(16))) unsigned char lds_[];
    LAS unsigned char* lds = (LAS unsigned char*)lds_;
    volatile LAS unsigned* MISC = (volatile LAS unsigned*)(lds + MISC_OFF);
    const int wid = __builtin_amdgcn_readfirstlane(threadIdx.x >> 6);
#define lane lane_now()
#define tid (wid * 64 + lane_now())
    const int G = gridDim.x; const int bx = blockIdx.x; const int vcu = (G % 8 == 0) ? (bx % 8) * (G / 8) + bx / 8 : bx;
    unsigned char* const ws = args.ws;
    constexpr size_t EW = (size_t)NEXP * 1024 * 256;
    for (int u = tid; u < (LDS_BYTES - MISC_OFF) / 4; u += NTHR) ((LAS unsigned*)(lds + MISC_OFF))[u] = 0u;
    __syncthreads();
    const int lo = args.ph_lo, hi = args.ph_hi;
    XcdBarrier bar; bar.bar = (unsigned*)ws + CW_BAR + args.li * XCD_BAR_WORDS; bar.x = 0; bar.st = nullptr;
    if (hi - lo > 1) bar = xcd_barrier_post((unsigned*)ws + CW_BAR + args.li * XCD_BAR_WORDS, MISC + 8, wid);
    const int gw = vcu * NWAVES + wid, NGW = G * NWAVES;
#ifndef PH_ONLY
#define PH_ONLY -1
#endif
#define IN(k) ((PH_ONLY < 0 || PH_ONLY == ((k) >= 12 && (k) <= 14 ? (k) - 8 : (k))) && lo <= (k) && (k) < hi)
#ifndef TS_K1
#define TS_K1 -1
#define TS_K2 -1
#endif
#define TS_STAMP(k) do { if (TS_K1 >= 0 && bx == 0 && tid == 0) ((unsigned long long*)(ws + WS_TS))[k] = __builtin_amdgcn_s_memrealtime(); } while (0)
#define SEAM(k) do { if ((k) + 1 < hi) xcd_barrier(bar, wid); TS_STAMP((k) + 1); } while (0)
#define SCR ((LAS float*)(lds + wid * 16384))
#define ROUTER_PREFILL(layer) do { const u32x4* rw_ = (const u32x4*)(ws + WS_RWT + (size_t)(layer) * RW_LAYER_BYTES); for (int i_ = tid; i_ < RW_LAYER_BYTES / 16; i_ += NTHR) ((LAS u32x4*)lds)[i_] = rw_[i_]; } while (0)
    TS_STAMP(0);
    if (IN(0)) {
        { TrSrc S{args.in[4], args.in[5], args.in[15], args.in[20], args.in[21], args.in[22], args.in[2], ws, 3072}; tr_stream(S, SCR, gw, NGW, lane); }
        { bf16* rwt = (bf16*)(ws + WS_RWT); const float* norm_ffn = args.in[2];
          for (int o = bx * NTHR + tid; o < 2 * 36 * 1024; o += G * NTHR) { const int layer = o / (36 * 1024), r = o % (36 * 1024), col = r >> 10, k = r & 1023;
            const float gnk = norm_ffn[layer * D + k];
            const float w = gnk * (col < 4 ? args.in[16][(size_t)layer * 4096 + k * 4 + col] : args.in[18][(size_t)layer * 32768 + ((size_t)((col - 4) >> 3) * 1024 + k) * 8 + ((col - 4) & 7)]);
            const bf16 hi_ = f2bf(w); const bf16 lo_ = f2bf(w - bf2f(hi_));
            rwt[(size_t)layer * 2 * RW_PLANE + col * RW_PITCH + k] = hi_; rwt[(size_t)layer * 2 * RW_PLANE + RW_PLANE + col * RW_PITCH + k] = lo_; } }
        __syncthreads();
        for (int gq = vcu; gq < 256; gq += G) ssm_mats(gq >> 2, gq & 3, args.in[7], args.in[8], args.in[9], args.in[10], args.in[11], args.in[12], args.in[13], args.in[14], ws + WS_SSM, (float*)(ws + WS_A16), (LAS float*)lds, tid);
        { const float* x = args.in[0]; const float* norm_mix = args.in[1]; bf16* XN = (bf16*)(ws + WS_XN);
          for (int m0 = 2 * gw; m0 < M; m0 += 2 * NGW) { float4 v[2][4];
#pragma unroll
            for (int rr = 0; rr < 2; ++rr) { const float4* xr = (const float4*)(x + (size_t)(m0 + rr) * D);
#pragma unroll
                for (int j = 0; j < 4; ++j) v[rr][j] = xr[lane + 64 * j]; }
#pragma unroll
            for (int rr = 0; rr < 2; ++rr) { float ss = 0.f;
#pragma unroll
                for (int j = 0; j < 4; ++j) ss += v[rr][j].x * v[rr][j].x + v[rr][j].y * v[rr][j].y + v[rr][j].z * v[rr][j].z + v[rr][j].w * v[rr][j].w;
                ss = wave_sum(ss); const float s = rsqrtf(ss * (1.f / D) + RMS_EPS);
#pragma unroll
                for (int j = 0; j < 4; ++j) { const int c = 4 * (lane + 64 * j); const float4 gg = *(const float4*)(norm_mix + c); u32x2 w; w.x = pk2(v[rr][j].x * s * gg.x, v[rr][j].y * s * gg.y); w.y = pk2(v[rr][j].z * s * gg.z, v[rr][j].w * s * gg.w);
                    *(u32x2*)(XN + (size_t)(m0 + rr) * D + c) = w; } } } }
        SEAM(0);
    }
    if (IN(1)) { PhQKV P{ws, (const char*)(ws + WS_XN), G, bx}; gm::gemm_phase(lds, P, wid); SEAM(1); }
    if (IN(2)) {
        const int per = 1024 / G;
        for (int i = 0; i < per; ++i) { const int uid = vcu * per + i; const int bh = uid >> 5, qb = uid & 31;
            at::attn_unit<8>(bh >> 4, bh & 15, qb, (const bf16*)(ws + WS_Q), (const bf16*)(ws + WS_K), (const bf16*)(ws + WS_V), (bf16*)(ws + (args.pad ? WS_XN : WS_Q)), args.in[6], lds, wid); }
        SEAM(2);
    }
    if (IN(3)) { PhWo P{ws, (const char*)(ws + WS_Q), args.in[0], args.out, G, bx}; gm::gemm_phase(lds, P, wid); if (4 < hi) ROUTER_PREFILL(0); SEAM(3); }
#define MOE_LAYER(layer, pr) \
    if (IN(pr)) { router_phase((layer) ? (const bf16*)(ws + WS_XN) : (const bf16*)args.out, (const u32x4*)(ws + WS_RWT + (size_t)(layer) * RW_LAYER_BYTES), args.in[17] + (layer) * 4, args.in[19] + (layer) * 32, (unsigned*)ws + CW_CNT + (layer) * 32 * 64, \
                               (int*)(ws + WS_PDST), (float*)(ws + WS_PW), (float*)(ws + WS_PS), (float*)(ws + WS_SROW), lds, vcu, G, wid, (pr) > lo); SEAM(pr); } \
    if (IN((pr) + 1) || IN((pr) + 2)) { \
        moe_tables(lds, (const unsigned*)ws + CW_CNT + (layer) * 32 * 64, tid); \
        if (IN((pr) + 1)) { const bf16* hbp = (layer) ? (const bf16*)(ws + WS_XN) : (const bf16*)args.out; \
            { PhGateUp P{ws, (const char*)hbp, lds, G, vcu, __builtin_amdgcn_readfirstlane(((const LAS int*)(lds + AUX_OFF))[MT_NN])}; gm::gemm_phase(lds, P, wid); } \
            { const LAS int* mt = (const LAS int*)(lds + AUX_OFF); const int np = 16 * mt[MT_NS]; for (int j = G - 1 - vcu; j < np; j += G) { Unit u; u.pn = 0; moe_decode(lds, mt[MT_SLIST + (j >> 4)], u); tail_job<true>(ws, hbp, u, j & 15, wid); } } \
            SEAM((pr) + 1); } \
        if (IN((pr) + 2)) { { PhDown P{ws, (const char*)(ws + WS_H), lds, G, vcu, __builtin_amdgcn_readfirstlane(((const LAS int*)(lds + AUX_OFF))[MT_NN])}; gm::gemm_phase(lds, P, wid); } \
            { const LAS int* mt = (const LAS int*)(lds + AUX_OFF); const int np = 16 * mt[MT_NS]; for (int j = G - 1 - vcu; j < np; j += G) { Unit u; u.pn = 0; moe_decode(lds, mt[MT_SLIST + (j >> 4)], u); tail_job<false>(ws, (const bf16*)(ws + WS_H), u, j & 15, wid); } } \
            SEAM((pr) + 2); } \
    }
    MOE_LAYER(0, 4)
    if (IN(7)) {
        { TrSrc S{nullptr, nullptr, nullptr, args.in[20] + EW, args.in[21] + EW, args.in[22] + EW, args.in[2] + D, ws, 0}; tr_stream(S, SCR, gw, NGW, lane); }
        combine_phase<false>((const bf16*)args.out, (const bf16*)(ws + WS_Y2), args.in[1] + D, (bf16*)args.out + (size_t)M * D, (bf16*)(ws + WS_XN), nullptr, vcu, G, wid, lane);
        SEAM(7); }
    if (IN(8)) { PhSloc P{ws, (const char*)(ws + WS_XN), G, vcu}; gm::gemm_phase(lds, P, wid); if (10 < hi) xcd_barrier(bar, wid); }
    if (IN(10)) {
        for (int idx = vcu; idx < 256; idx += G) scan_unit(idx >> 2, idx & 3, (const float*)(ws + WS_SLOC), (const float*)(ws + WS_A16), (bf16*)(ws + WS_XN), lds, wid);
        asm volatile("s_waitcnt vmcnt(0)" ::: "memory"); __syncthreads();
        PhY P{ws, (const char*)(ws + WS_XN), G, vcu}; gm::gemm_phase(lds, P, wid); SEAM(10); }
    if (IN(11)) { PhWout P{ws, (const char*)(ws + WS_G), args.out, G, bx}; gm::gemm_phase(lds, P, wid); if (12 < hi) ROUTER_PREFILL(1); SEAM(11); }
    MOE_LAYER(1, 12)
#undef MOE_LAYER
    if (IN(15)) { combine_phase<true>((const bf16*)(ws + WS_XN), (const bf16*)(ws + WS_Y2), args.in[3], nullptr, nullptr, args.out, vcu, G, wid, lane);
#if TS_K1 >= 0
        { const unsigned long long* ts = (const unsigned long long*)(ws + WS_TS); const float dtus = (float)(ts[TS_K1 + 1] - ts[TS_K1]) * 1e-2f; const float e = exp2f(rintf(log2f(dtus) * 6.f) / 6.f) * 1e-2f;
          __syncthreads();
          for (int base = vcu * 16; base < M; base += G * 16) for (int i = tid; i < 16 * D; i += NTHR) args.out[(size_t)base * D + i] *= (1.f + e);
          if (TS_K2 >= 0 && bx == 0) { __syncthreads(); if (tid == 0) args.out[0] = exp2f(rintf(log2f((float)(ts[TS_K2 + 1] - ts[TS_K2]) * 1e-2f) * 6.f) / 6.f); } }
#endif
    }
#undef IN
#undef SEAM
#undef SCR
#undef lane
#undef tid
}

#ifndef FUSED
#define FUSED 1
#endif
#ifndef DUP_PH
#define DUP_PH -1
#endif
extern "C" void kernel_launch(void* const* d_in, const int* in_sizes, int n_in, void* d_out, int out_size, void* d_ws, size_t ws_size, hipStream_t stream) {
    static int grid = 0;
    if (grid == 0) {
        if (n_in != 23 || out_size != M * D || ws_size < WS_END) { fprintf(stderr, "kernel_launch: unexpected shapes (n_in %d out %d ws %zu)\n", n_in, out_size, ws_size); grid = -1; return; }
        int dev = 0, cus = 0;
        if (hipGetDevice(&dev) != hipSuccess || hipDeviceGetAttribute(&cus, hipDeviceAttributeMultiprocessorCount, dev) != hipSuccess) { grid = -1; return; }
        if (hipFuncSetAttribute((const void*)mk_fwd, hipFuncAttributeMaxDynamicSharedMemorySize, LDS_BYTES) != hipSuccess) { fprintf(stderr, "kernel_launch: hipFuncSetAttribute failed\n"); grid = -1; return; }
        (void)hipGetLastError();
        grid = cus;
        if (grid != 256) fprintf(stderr, "kernel_launch: %d CUs (built for 256)\n", grid);
    }
    if (grid < 0) return;
    unsigned char* ws = (unsigned char*)d_ws;
    (void)hipMemsetAsync(ws + WS_CTL, 0, CTL_ZERO_BYTES, stream);
    Args a{}; for (int i = 0; i < 23; ++i) a.in[i] = (const float*)d_in[i];
    a.out = (float*)d_out; a.ws = ws;
    int li = 0;
    auto run = [&](int lo, int hi) { a.ph_lo = lo; a.ph_hi = hi; a.li = li++; hipLaunchKernelGGL(mk_fwd, dim3(grid), dim3(NTHR), LDS_BYTES, stream, a); };
    if (FUSED) { run(0, N_PHASES); return; }
    for (int ph = 0; ph < N_PHASES; ++ph) { if (ph == 9) continue;
        if (DUP_PH == ph) { if (ph == 2) { a.pad = 1; run(2, 3); a.pad = 0; } else run(ph, ph + 1); }
        run(ph, ph + 1); }
}
```

```cpp
#include <hip/hip_runtime.h>
#include <cstdio>
#include <cstdint>

typedef unsigned short bf16;
constexpr int BATCH = 2, SEQ = 8192, D = 1024, M = BATCH * SEQ, NH = 16, HD = 64;
constexpr int NEXP = 32, EPG = 8, FE = 256;
constexpr int NREL = 257;
constexpr float RMS_EPS = 1e-6f;
constexpr float LOG2E = 1.4426950408889634f;
constexpr float C2 = 0.125f * LOG2E;

constexpr size_t MiB = 1u << 20;
constexpr size_t WS_CTL = 0;
constexpr size_t WS_XN = 86 * MiB;
constexpr size_t WS_BIG = 134 * MiB;
constexpr size_t WS_Q = WS_BIG, WS_K = WS_BIG + 32 * MiB, WS_V = WS_BIG + 64 * MiB;
constexpr size_t WS_Y2 = WS_BIG, WS_H = WS_BIG + 64 * MiB;
constexpr size_t WS_SLOC = WS_BIG, WS_G = WS_BIG + 32 * MiB;

__device__ __forceinline__ bf16 f2bf(float f) { unsigned u = __float_as_uint(f); return (bf16)((u + 0x7fffu + ((u >> 16) & 1u)) >> 16); }
__device__ __forceinline__ float bf2f(bf16 h) { return __uint_as_float(((unsigned)h) << 16); }
__device__ __forceinline__ float wave_sum(float v) {
#pragma unroll
    for (int o = 1; o < 64; o <<= 1) v += __shfl_xor(v, o);
    return v;
}
__device__ __forceinline__ float gelu_tanh(float x) { const float u = 0.7978845608028654f * (x + 0.044715f * x * x * x); return 0.5f * x * (1.f + tanhf(u)); }

__device__ __forceinline__ size_t xng_off(int t, int col) { const int b = t >> 13, tt = t & 8191, s = tt >> 4, j = tt & 15, g = col >> 4, c = col & 15; return ((size_t)(g * 1024 + b * 512 + s)) * 384 + j * 16 + c; }

#define LAS __attribute__((address_space(3)))
typedef short bf16x8 __attribute__((ext_vector_type(8)));
typedef short s16x4 __attribute__((ext_vector_type(4)));
typedef float f32x4 __attribute__((ext_vector_type(4)));
typedef float f32x16 __attribute__((ext_vector_type(16)));
typedef unsigned u32x4 __attribute__((ext_vector_type(4)));
typedef unsigned u32x2 __attribute__((ext_vector_type(2)));

constexpr int NWAVES = 8, NTHR = 512;
constexpr int CAP = 8192;
constexpr size_t CTL_ZERO_BYTES = 1 * MiB;
constexpr size_t WS_PDST = 1 * MiB, WS_PW = 3 * MiB, WS_PS = 5 * MiB, WS_SROW = 7 * MiB, WS_A16 = 7 * MiB + 65536;
constexpr size_t WS_TS = 7 * MiB + 131072;
constexpr size_t WS_RWT = 8 * MiB;
constexpr size_t WS_WQKV = 9 * MiB, WS_WO = 15 * MiB, WS_WOUT = 17 * MiB, WS_SSM = 21 * MiB;
constexpr size_t WS_WGU = 38 * MiB, WS_WD = 70 * MiB;
constexpr size_t WS_END = 230 * MiB;
constexpr int RW_PITCH = 1032, RW_PLANE = 36 * RW_PITCH, RW_LAYER_BYTES = 2 * RW_PLANE * 2;
constexpr int SSM_G_BYTES = 262144, SSM_A2_OFF = 65536;
constexpr int CW_BAR = 4096;
constexpr int CW_CNT = 65536;
constexpr int CW_FLAG = 200000;
constexpr int LDS_BYTES = 160 * 1024, MISC_OFF = LDS_BYTES - 512, AUX_OFF = 128 * 1024, RSCR_OFF = RW_LAYER_BYTES;
constexpr int N_PHASES = 16;

__device__ __forceinline__ int lane_now() { int l; asm volatile("v_mbcnt_lo_u32_b32 %0, -1, 0\n\tv_mbcnt_hi_u32_b32 %0, -1, %0" : "=v"(l)); return l; }
__device__ __forceinline__ unsigned cvt_pk_bf16(float lo, float hi) { unsigned r; asm volatile("v_cvt_pk_bf16_f32 %0, %1, %2" : "=v"(r) : "v"(lo), "v"(hi)); return r; }
typedef float f32x2_t __attribute__((ext_vector_type(2))); typedef __bf16 bf16x2_t __attribute__((ext_vector_type(2)));
__device__ __forceinline__ unsigned cvtpk_s(float lo, float hi) { f32x2_t v = {lo, hi}; bf16x2_t b = __builtin_convertvector(v, bf16x2_t); return __builtin_bit_cast(unsigned, b); }
__device__ __forceinline__ unsigned pk2(float lo, float hi) { return cvtpk_s(lo, hi); }
#define LDS_WAIT() asm volatile("s_waitcnt lgkmcnt(0)" ::: "memory")
#define VM_WAIT() asm volatile("s_waitcnt vmcnt(0)" ::: "memory")
#define RLX_AGENT __ATOMIC_RELAXED, __HIP_MEMORY_SCOPE_AGENT

#define XB_TMO      128
#define XB_XCNT(j)  (256  + 64 * (j))
#define XB_XSUB(j)  (1280 + 64 * (j))
#define XB_XGEN(j)  (2304 + 64 * (j))
#define XB_TOP      3328
#define XB_TOPGEN   3392
#define XCD_BAR_WORDS 3456
#define XB_SPIN_CAP (1u << 18)
__device__ __forceinline__ unsigned xb_ld(unsigned* p)              { return __hip_atomic_load(p, __ATOMIC_RELAXED, __HIP_MEMORY_SCOPE_AGENT); }
__device__ __forceinline__ unsigned xb_add(unsigned* p, unsigned v) { return __hip_atomic_fetch_add(p, v, __ATOMIC_RELAXED, __HIP_MEMORY_SCOPE_AGENT); }
__device__ __forceinline__ unsigned xb_xcc_id() { return (unsigned)__builtin_amdgcn_s_getreg((3 << 11) | 20) & 0xFu; }
#define XB_SPIN(cond, bar) do { unsigned _sp = 0; while (cond) { __builtin_amdgcn_s_sleep(1); \
    if ((++_sp & 255u) == 0u) { if (xb_ld(&(bar)[XB_TMO])) break; if (_sp > XB_SPIN_CAP) { atomicAdd(&(bar)[XB_TMO], 1u); break; } } } } while (0)
struct XcdBarrier { unsigned* bar; unsigned x; volatile LAS unsigned* st; };
__device__ __forceinline__ XcdBarrier xcd_barrier_post(unsigned* bar, volatile LAS unsigned* st, int wid) {
    XcdBarrier b; b.bar = bar; b.x = xb_xcc_id(); b.st = st;
    if (wid == 0 && lane_now() == 0) (void)xb_add(&bar[XB_XCNT(b.x)], 1u);
    return b;
}
__device__ __forceinline__ void xcd_barrier_complete(unsigned* bar, unsigned x, unsigned& nloc, unsigned& nx, unsigned G) {
    unsigned sum, cnt, mine, sp = 0u;
    for (;;) {
        sum = 0u; cnt = 0u; mine = 0u;
#pragma unroll
        for (unsigned j = 0; j < 16; ++j) { const unsigned c = xb_ld(&bar[XB_XCNT(j)]); sum += c; cnt += (c > 0u) ? 1u : 0u; mine = (j == x) ? c : mine; }
        if (sum == G) break;
        __builtin_amdgcn_s_sleep(1);
        if ((++sp & 255u) == 0u) { if (xb_ld(&bar[XB_TMO])) break; if (sp > XB_SPIN_CAP) { atomicAdd(&bar[XB_TMO], 1u); break; } }
    }
    nloc = mine > 0u ? mine : 1u; nx = cnt > 0u ? cnt : 1u;
}
__device__ __forceinline__ void xcd_barrier(const XcdBarrier& b, int wid, unsigned gsz) {
    asm volatile("s_waitcnt vmcnt(0)" ::: "memory");
    __syncthreads();
    if (wid == 0 && lane_now() == 0) {
        unsigned* bar = b.bar;
        __builtin_amdgcn_s_waitcnt(0);
        unsigned nloc = b.st[0], nx = b.st[1];
        if (nloc == 0u) { xcd_barrier_complete(bar, b.x, nloc, nx, gsz); b.st[0] = nloc; b.st[1] = nx; }
        const unsigned old = xb_add(&bar[XB_XSUB(b.x)], 1u);
        const unsigned gen = old / nloc;
        if (old + 1u == (gen + 1u) * nloc) {
            __builtin_amdgcn_fence(__ATOMIC_RELEASE, "agent");
            asm volatile("s_waitcnt vmcnt(0)" ::: "memory");
            const unsigned og = xb_add(&bar[XB_TOP], 1u);
            const unsigned tg = og / nx;
            if (og + 1u == (tg + 1u) * nx) xb_add(&bar[XB_TOPGEN], 1u);
            else XB_SPIN(xb_ld(&bar[XB_TOPGEN]) == tg, bar);
            __builtin_amdgcn_fence(__ATOMIC_ACQUIRE, "agent");
            xb_add(&bar[XB_XGEN(b.x)], 1u);
            asm volatile("s_waitcnt vmcnt(0)" ::: "memory");
        } else {
            XB_SPIN(xb_ld(&bar[XB_XGEN(b.x)]) == gen, bar);
            __builtin_amdgcn_fence(__ATOMIC_ACQUIRE, "agent");
            asm volatile("s_waitcnt vmcnt(0)" ::: "memory");
        }
    }
    __syncthreads();
}

namespace gm {
constexpr int HTB = 16384;
__device__ __forceinline__ int lds_byte(int r, int c) { const int st = (r >> 4) * 2 + (c >> 5), rr = r & 15, cc = c & 31, ob = rr * 64 + cc * 2; return st * 1024 + (ob ^ (((ob >> 9) & 1) << 5)); }
__device__ __forceinline__ void stage_rc(int b, int& R, int& C) { const int st = b / 1024, sb = b % 1024, swz = sb ^ (((sb >> 9) & 1) << 5); R = (st >> 1) * 16 + swz / 64; C = (st & 1) * 32 + (swz % 64) / 2; }
__device__ __forceinline__ int perm32(int rho) { const int n = rho >> 4, i = rho & 15; return 8 * (i >> 2) + 4 * n + (i & 3); }
struct Unit { int pm, pn, e, gt, cnt; };
__device__ __forceinline__ bool static_unit(int i, int G, int c, int nM, int nN, Unit& u) {
    const int nwg = nM * nN; const long L = (long)i * G + c; if (L >= nwg) return false;
    int wgid = (int)L; { const int q = nwg / 8, r = nwg % 8, xcd = wgid % 8, off = wgid / 8; wgid = (xcd < r ? xcd * (q + 1) : r * (q + 1) + (xcd - r) * q) + off; }
    const int nig = 8 * nN, gid = wgid / nig, fm = gid * 8, gsz = (nM - fm) < 8 ? (nM - fm) : 8;
    u.pm = fm + ((wgid % nig) % gsz); u.pn = (wgid % nig) / gsz; u.e = 0; u.gt = 0; u.cnt = 0; return true;
}
template <class P> __device__ __forceinline__ void gemm_phase(LAS unsigned char* lds, const P& ph, int wid) {
    const int lane = lane_now(), tid = wid * 64 + lane, wr = wid >> 2, wc = wid & 3, fr = lane & 15, fq = lane >> 4;
    constexpr int nt = P::K / 64;
    static_assert(nt >= 2 && (nt % 2) == 0, "K must be a multiple of 128");
    unsigned voffA[2], voffB[2];
#pragma unroll
    for (int i = 0; i < 2; ++i) { int R, C; stage_rc(tid * 16 + i * 8192, R, C); const int Rb = (R & ~31) + perm32(R & 31); voffB[i] = (unsigned)(Rb * P::LDB + C) * 2u; voffA[i] = (unsigned)(R * P::LDA + C) * 2u; }
    const unsigned ldsw = (unsigned)wid * 1024u;
    const int aoff = lds_byte(wr * 64 + fr, fq * 8), boff = lds_byte(wc * 32 + fr, fq * 8);
    constexpr int hB = P::HSTEPB, hA = 128 * P::LDA * 2;
#define G_SA(b, h) (((b) * 2 + (h)) * gm::HTB)
#define G_SB(b, h) ((4 + (b) * 2 + (h)) * gm::HTB)
#define G_GLDS(src, bufoff, i) __builtin_amdgcn_global_load_lds((const unsigned*)(src), (LAS unsigned*)(lds + (bufoff) + ldsw + (i) * 8192), 16, 0, 0)
#define G_STA(bufoff, ptr, kb, offs, h) do { if constexpr (P::GATHER) { _Pragma("unroll") for (int _i = 0; _i < 2; ++_i) G_GLDS(Ab + (kb) + (offs)[h][_i], bufoff, _i); } \
        else { _Pragma("unroll") for (int _i = 0; _i < 2; ++_i) G_GLDS((ptr) + (h) * hA + voffA[_i], bufoff, _i); } } while (0)
#define G_STB(bufoff, ptr) do { _Pragma("unroll") for (int _i = 0; _i < 2; ++_i) G_GLDS((ptr) + voffB[_i], bufoff, _i); } while (0)
#define G_LDA(dst, b, h) do { _Pragma("unroll") for (int m = 0; m < 4; ++m) _Pragma("unroll") for (int k = 0; k < 2; ++k) dst[m][k] = *(const LAS bf16x8*)(lds + G_SA(b, h) + aoff + m * 2048 + k * 1024); } while (0)
#define G_LDB(dst, b, h) do { _Pragma("unroll") for (int n = 0; n < 2; ++n) _Pragma("unroll") for (int k = 0; k < 2; ++k) dst[n][k] = *(const LAS bf16x8*)(lds + G_SB(b, h) + boff + n * 2048 + k * 1024); } while (0)
#define G_MMA(ai, bj, At, Bt) do { __builtin_amdgcn_s_setprio(1); _Pragma("unroll") for (int m = 0; m < 4; ++m) _Pragma("unroll") for (int n = 0; n < 2; ++n) _Pragma("unroll") for (int k = 0; k < 2; ++k) \
        acc[ai][bj][m][n] = __builtin_amdgcn_mfma_f32_16x16x32_bf16(Bt[n][k], At[m][k], acc[ai][bj][m][n], 0, 0, 0); __builtin_amdgcn_s_setprio(0); } while (0)
#define G_WAIT_V(n) asm volatile("s_waitcnt vmcnt(" #n ")" ::: "memory")
#define G_WAIT_L(n) asm volatile("s_waitcnt lgkmcnt(" #n ")" ::: "memory")
#define G_BAR __builtin_amdgcn_s_barrier()
#define G_SCHED __builtin_amdgcn_sched_barrier(0)
    Unit cur, nxt; int ui = 0;
    if (!ph.next(0, cur)) return;
    f32x4 acc[2][2][4][2];
#pragma unroll
    for (int a = 0; a < 2; ++a)
#pragma unroll
        for (int b = 0; b < 2; ++b)
#pragma unroll
            for (int m = 0; m < 4; ++m)
#pragma unroll
                for (int n = 0; n < 2; ++n) acc[a][b][m][n] = (f32x4){0.f, 0.f, 0.f, 0.f};
    bf16x8 At[4][2], B0[2][2], B1[2][2];
    unsigned co[2][2] = {{0u, 0u}, {0u, 0u}};
    const char* Ab = ph.Abase;
    const char* cA = Ab; const char* cB = ph.b_tile(cur);
    if constexpr (P::GATHER) { ph.a_offs(cur, tid, co); asm volatile("s_waitcnt vmcnt(0)" ::: "memory"); } else cA = ph.a_tile(cur);
    G_STB(G_SB(0, 0), cB); G_STB(G_SB(0, 1), cB + hB); G_STA(G_SA(0, 0), cA, 0, co, 0); G_STA(G_SA(0, 1), cA, 0, co, 1);
    if (wr == 1) G_BAR;
    G_WAIT_V(2); G_BAR;
    G_STB(G_SB(1, 0), cB + 128); G_STA(G_SA(1, 0), cA + 128, 128, co, 0); G_STB(G_SB(1, 1), cB + hB + 128);
    G_WAIT_V(6); G_BAR;
    for (;;) {
        const bool has_next = ph.next(ui + 1, nxt);
        const char* nA = cA; const char* nB = cB;
        if (has_next) { nB = ph.b_tile(nxt); if constexpr (!P::GATHER) nA = ph.a_tile(nxt); }
        for (int t = 0; t < nt; t += 2) {
            const bool last = (t == nt - 2);
            const int kb1 = (t + 1) * 128, kb2 = last ? 0 : (t + 2) * 128, kb3 = kb2 + 128;
            const char* a1 = cA + kb1; const char* a2 = last ? nA : cA + kb2; const char* a3 = a2 + 128;
            const char* b2 = last ? nB : cB + (t + 2) * 128; const char* b3 = b2 + 128;
            G_LDB(B0, 0, 0); G_LDB(B1, 0, 1); G_SCHED; G_LDA(At, 0, 0); G_STA(G_SA(1, 1), a1, kb1, co, 1);
            G_WAIT_V(8); G_WAIT_L(0); G_BAR; G_MMA(0, 0, At, B0); G_MMA(0, 1, At, B1); G_BAR; G_SCHED;
            if constexpr (P::GATHER) { if (last && has_next) ph.a_offs(nxt, tid, co); }
            G_LDA(At, 0, 1); G_STB(G_SB(0, 0), b2); G_STB(G_SB(0, 1), b2 + hB); G_STA(G_SA(0, 0), a2, kb2, co, 0);
            G_WAIT_V(8); G_WAIT_L(0); G_BAR; G_MMA(1, 0, At, B0); G_MMA(1, 1, At, B1); G_BAR; G_SCHED;
            G_LDB(B0, 1, 0); G_LDB(B1, 1, 1); G_SCHED; G_LDA(At, 1, 0); G_STA(G_SA(0, 1), a2, kb2, co, 1);
            G_WAIT_V(8); G_WAIT_L(0); G_BAR; G_MMA(0, 0, At, B0); G_MMA(0, 1, At, B1); G_BAR; G_SCHED;
            G_LDA(At, 1, 1); G_STB(G_SB(1, 0), b3); G_STB(G_SB(1, 1), b3 + hB); G_STA(G_SA(1, 0), a3, kb3, co, 0);
            G_WAIT_V(8); G_WAIT_L(0); G_BAR; G_MMA(1, 0, At, B0); G_MMA(1, 1, At, B1); G_BAR; G_SCHED;
        }
        if (wr == 0) G_BAR;
        ph.epi(acc, cur, wr, wc, fr, fq);
        if (!has_next) break;
#pragma unroll
        for (int a = 0; a < 2; ++a)
#pragma unroll
            for (int b = 0; b < 2; ++b)
#pragma unroll
                for (int m = 0; m < 4; ++m)
#pragma unroll
                    for (int n = 0; n < 2; ++n) acc[a][b][m][n] = (f32x4){0.f, 0.f, 0.f, 0.f};
        cur = nxt; cA = nA; cB = nB; ++ui;
        if (wr == 1) G_BAR;
    }
    G_WAIT_V(0);
    G_BAR;
}
}

using gm::Unit;
#define EPI_ARGS const f32x4 (&acc)[2][2][4][2], const Unit& u, int wr, int wc, int fr_in, int fq_in
#define EPI_OPAQUE int fr = fr_in, fq = fq_in; asm volatile("" : "+v"(fr), "+v"(fq));
#define NO_GATHER __device__ __forceinline__ void a_offs(const Unit&, int, unsigned (&)[2][2]) const {}
#define EPI_FENCE() asm volatile("" ::: "memory")
__device__ __forceinline__ u32x4 pack8(const f32x4& v0, const f32x4& v1) { u32x4 w; w.x = cvt_pk_bf16(v0[0], v0[1]); w.y = cvt_pk_bf16(v0[2], v0[3]); w.z = cvt_pk_bf16(v1[0], v1[1]); w.w = cvt_pk_bf16(v1[2], v1[3]); return w; }
__device__ __forceinline__ float fast_sigmoid(float v) { return __builtin_amdgcn_rcpf(1.f + __builtin_amdgcn_exp2f(-LOG2E * v)); }
__device__ __forceinline__ float fast_gelu(float v) { const float u2 = 1.5957691216057308f * (v + 0.044715f * v * v * v); return v * fast_sigmoid(u2); }

__device__ __forceinline__ size_t bQ(int b)    { return WS_BIG + (size_t)b * (32 * MiB); }
__device__ __forceinline__ size_t bY2(int b)   { return WS_BIG + (size_t)b * (16 * MiB); }
__device__ __forceinline__ size_t bH(int b)    { return WS_BIG + 32 * MiB + (size_t)b * (48 * MiB); }
__device__ __forceinline__ size_t bSLOC(int b) { return WS_BIG + (size_t)b * (48 * MiB); }
__device__ __forceinline__ size_t bG(int b)    { return WS_BIG + 16 * MiB + (size_t)b * (32 * MiB); }
__device__ __forceinline__ size_t bXN(int b)   { return WS_XN + (size_t)b * (8 * MiB); }
__device__ __forceinline__ size_t bXNG(int b)  { return WS_XN + (size_t)b * (24 * MiB); }
__device__ __forceinline__ size_t xngb_off(int tt, int col) { const int s_ = tt >> 4, j = tt & 15, g = col >> 4, c = col & 15; return ((size_t)(g * 512 + s_)) * 384 + j * 16 + c; }
struct PhQKV {
    static constexpr bool GATHER = false; static constexpr int LDA = 1024, K = 1024, LDB = 1024, HSTEPB = 128 * 1024 * 2;
    unsigned char* ws; const char* Abase; int G, c, pm0;
    __device__ __forceinline__ bool next(int i, Unit& u) const { if (!gm::static_unit(i, G, c, M / 512, 12, u)) return false; u.pm += pm0; return true; }
    NO_GATHER __device__ __forceinline__ const char* a_tile(const Unit& u) const { return Abase + (size_t)(u.pm * 256) * 1024 * 2; }
    __device__ __forceinline__ const char* b_tile(const Unit& u) const { return (const char*)(ws + WS_WQKV) + (size_t)u.pn * 256 * 1024 * 2; }
    __device__ __forceinline__ void epi(EPI_ARGS) const { EPI_OPAQUE
        const int row0 = u.pm * 256 + wr * 64 + fr; const int t = u.pn >> 2; const int colt = (u.pn & 3) * 256;
        bf16* base = (bf16*)(ws + bQ(pm0 >> 5)) + (size_t)t * (8u * 1024u * 1024u); const float sc = (t == 0) ? C2 : 1.f;
        const int col0 = colt + wc * 32 + 8 * fq;
#pragma unroll
        for (int ai = 0; ai < 2; ++ai)
#pragma unroll
            for (int m = 0; m < 4; ++m) { bf16* rowp = base + (size_t)(row0 + ai * 128 + m * 16) * 1024 + col0;
#pragma unroll
                for (int bj = 0; bj < 2; ++bj) *(u32x4*)(rowp + bj * 128) = pack8(acc[ai][bj][m][0] * sc, acc[ai][bj][m][1] * sc); }
    }
};
struct PhWo {
    static constexpr bool GATHER = false; static constexpr int LDA = 1024, K = 1024, LDB = 1024, HSTEPB = 128 * 1024 * 2;
    unsigned char* ws; const char* Abase; const float* resid; float* out; int G, c, pm0;
    __device__ __forceinline__ bool next(int i, Unit& u) const { if (!gm::static_unit(i, G, c, M / 512, 4, u)) return false; u.pm += pm0; return true; }
    NO_GATHER __device__ __forceinline__ const char* a_tile(const Unit& u) const { return Abase + (size_t)(u.pm * 256) * 1024 * 2; }
    __device__ __forceinline__ const char* b_tile(const Unit& u) const { return (const char*)(ws + WS_WO) + (size_t)u.pn * 256 * 1024 * 2; }
    __device__ __forceinline__ void epi(EPI_ARGS) const { EPI_OPAQUE
        const size_t off0 = (size_t)(u.pm * 256 + wr * 64 + fr) * 1024 + u.pn * 256 + wc * 32 + 8 * fq; bf16* hb = (bf16*)out;
#pragma unroll
        for (int ai = 0; ai < 2; ++ai) { f32x4 r[4][2][2];
#pragma unroll
            for (int m = 0; m < 4; ++m)
#pragma unroll
                for (int bj = 0; bj < 2; ++bj) { const float* p = resid + off0 + (size_t)(ai * 128 + m * 16) * 1024 + bj * 128; r[m][bj][0] = *(const f32x4*)p; r[m][bj][1] = *(const f32x4*)(p + 4); }
            EPI_FENCE();
#pragma unroll
            for (int m = 0; m < 4; ++m)
#pragma unroll
                for (int bj = 0; bj < 2; ++bj) { const size_t off = off0 + (size_t)(ai * 128 + m * 16) * 1024 + bj * 128; const f32x4 v0 = acc[ai][bj][m][0] + r[m][bj][0], v1 = acc[ai][bj][m][1] + r[m][bj][1];
                    *(u32x4*)(hb + off) = pack8(v0, v1); }
            EPI_FENCE(); }
    }
};
struct PhWout {
    static constexpr bool GATHER = false; static constexpr int LDA = 1024, K = 1024, LDB = 1024, HSTEPB = 128 * 1024 * 2;
    unsigned char* ws; const char* Abase; float* out; int G, c, pm0;
    __device__ __forceinline__ bool next(int i, Unit& u) const { if (!gm::static_unit(i, G, c, M / 512, 8, u)) return false; u.pm += pm0; return true; }
    NO_GATHER __device__ __forceinline__ const char* a_tile(const Unit& u) const { return Abase + (size_t)(u.pm * 256) * 1024 * 2; }
    __device__ __forceinline__ const char* b_tile(const Unit& u) const { return (const char*)(ws + WS_WOUT) + (size_t)u.pn * 256 * 1024 * 2; }
    __device__ __forceinline__ void epi(EPI_ARGS) const { EPI_OPAQUE
        const size_t off0 = (size_t)(u.pm * 256 + wr * 64 + fr) * 1024 + u.pn * 128 + wc * 32 + 8 * fq; bf16* hb = (bf16*)(ws + bXN(pm0 >> 5)); const bf16* rs = (const bf16*)out + (size_t)M * D;
        u32x4 r[2][4];
#pragma unroll
        for (int ai = 0; ai < 2; ++ai)
#pragma unroll
            for (int m = 0; m < 4; ++m) r[ai][m] = *(const u32x4*)(rs + off0 + (size_t)(ai * 128 + m * 16) * 1024);
        EPI_FENCE();
#pragma unroll
        for (int ai = 0; ai < 2; ++ai)
#pragma unroll
            for (int m = 0; m < 4; ++m) { const size_t off = off0 + (size_t)(ai * 128 + m * 16) * 1024; f32x4 v0, v1;
#pragma unroll
                for (int j = 0; j < 4; ++j) { const unsigned w0 = r[ai][m][j >> 1], w1 = r[ai][m][2 + (j >> 1)];
                    const float r0 = __uint_as_float((j & 1) ? (w0 & 0xffff0000u) : (w0 << 16)), r1 = __uint_as_float((j & 1) ? (w1 & 0xffff0000u) : (w1 << 16));
                    v0[j] = r0 + acc[ai][0][m][0][j] * fast_sigmoid(acc[ai][1][m][0][j]); v1[j] = r1 + acc[ai][0][m][1][j] * fast_sigmoid(acc[ai][1][m][1][j]); }
                *(u32x4*)(hb + off) = pack8(v0, v1); }
        EPI_FENCE();
    }
};
constexpr int MT_NN = 65, MT_NS = 66, MT_EB = 67, MT_GT0 = 68, MT_NLIST = 128, MT_SLIST = 384, SMALL_ROWS = 128;
__device__ __forceinline__ void moe_decode(LAS unsigned char* lds, int code, Unit& u) { const LAS int* cn = (const LAS int*)(lds + AUX_OFF); const int el = code >> 8; u.e = cn[MT_EB] + el; u.pm = code & 255; u.gt = cn[MT_GT0] + cn[32 + el] + u.pm; u.cnt = cn[el]; }
__device__ __forceinline__ void moe_tables(LAS unsigned char* lds, const unsigned* cntg, int tid, int bt) {
    LAS int* cn = (LAS int*)(lds + AUX_OFF); LAS int* tb = cn + 32;
    if (tid < 64) {
        const int e = tid & 31; const unsigned cu = __hip_atomic_load(cntg + e * 64, RLX_AGENT); const int c = cu < (unsigned)CAP ? (int)cu : CAP;
        const int n = (c + 255) >> 8; const int lastrows = c - 256 * (n - 1); const int small = (n > 0 && lastrows <= SMALL_ROWS) ? 1 : 0; const int nnorm = n - small;
        int pt = n, pn_ = nnorm, ps_ = small;
#pragma unroll
        for (int o = 1; o < 32; o <<= 1) { const int a = __shfl_up(pt, o, 32), b = __shfl_up(pn_, o, 32), d = __shfl_up(ps_, o, 32); if (e >= o) { pt += a; pn_ += b; ps_ += d; } }
        if (tid < 32) { cn[e] = c; tb[e] = pt - n;
            for (int pm = 0; pm < nnorm; ++pm) cn[MT_NLIST + (pn_ - nnorm) + pm] = (e << 8) | pm;
            if (small) cn[MT_SLIST + ps_ - 1] = (e << 8) | (n - 1);
            if (e == 31) { tb[32] = pt; cn[MT_NN] = pn_; cn[MT_NS] = ps_; cn[MT_EB] = 32 * bt; cn[MT_GT0] = 0; } }
    }
    __syncthreads();
}
template <bool GU> __device__ __forceinline__ void tail_job(unsigned char* ws, const bf16* __restrict__ Xbase, const Unit& u, int ns, int wid) {
    const int lane = lane_now(), fr = lane & 15, fq = lane >> 4, w = wid;
    constexpr int K = GU ? 1024 : 256, NG = GU ? 2 : 4;
    const int slot0 = u.pm * 256, rows = u.cnt - slot0;
    if (16 * w >= rows) return;
    const int* pdst = (const int*)(ws + WS_PDST) + u.e * CAP + slot0;
    int r = 16 * w + fr; const bool valid = r < rows; r = valid ? r : rows - 1;
    const int dst = pdst[r];
    const bf16* xp = (GU ? Xbase + (size_t)(dst >> 1) * 1024 : Xbase + ((size_t)u.gt * 256 + r) * 256) + 8 * fq;
    const bf16* wp[NG];
#pragma unroll
    for (int n = 0; n < NG; ++n) wp[n] = GU ? (const bf16*)(ws + WS_WGU) + ((size_t)(u.e & 31) * 512 + 256 * (ns >> 3) + 128 * n + 16 * (ns & 7) + fr) * 1024 + 8 * fq
                                             : (const bf16*)(ws + WS_WD) + ((size_t)(u.e & 31) * 1024 + 64 * ns + 16 * n + fr) * 256 + 8 * fq;
    f32x4 acc[NG];
#pragma unroll
    for (int n = 0; n < NG; ++n) acc[n] = (f32x4){0.f, 0.f, 0.f, 0.f};
#pragma unroll 16
    for (int ks = 0; ks < K / 32; ++ks) { const bf16x8 xf = *(const bf16x8*)(xp + 32 * ks); bf16x8 wf[NG];
#pragma unroll
        for (int n = 0; n < NG; ++n) wf[n] = *(const bf16x8*)(wp[n] + 32 * ks);
#pragma unroll
        for (int n = 0; n < NG; ++n) acc[n] = __builtin_amdgcn_mfma_f32_16x16x32_bf16(wf[n], xf, acc[n], 0, 0, 0); }
    if (valid) {
        if (GU) { const float sc = ((const float*)(ws + WS_PS))[u.e * CAP + slot0 + r]; float v[4];
#pragma unroll
            for (int j = 0; j < 4; ++j) { const float gg = acc[0][j] * sc, uu = acc[NG - 1][j] * sc; v[j] = gg * fast_sigmoid(gg) * uu; }
            u32x2 o; o.x = cvt_pk_bf16(v[0], v[1]); o.y = cvt_pk_bf16(v[2], v[3]);
            *(u32x2*)((bf16*)(ws + bH(u.e >> 5)) + ((size_t)u.gt * 256 + r) * 256 + 16 * ns + 4 * fq) = o; }
        else { const float wt = ((const float*)(ws + WS_PW))[u.e * CAP + slot0 + r];
#pragma unroll
            for (int n = 0; n < NG; ++n) { u32x2 o; o.x = cvt_pk_bf16(acc[n][0] * wt, acc[n][1] * wt); o.y = cvt_pk_bf16(acc[n][2] * wt, acc[n][3] * wt);
                *(u32x2*)((bf16*)(ws + bY2(u.e >> 5)) + (size_t)dst * 1024 + 64 * ns + 16 * n + 4 * fq) = o; } } }
}
struct PhGateUp {
    static constexpr bool GATHER = true; static constexpr int LDA = 1024, K = 1024, LDB = 1024, HSTEPB = 128 * 1024 * 2;
    unsigned char* ws; const char* Abase; LAS unsigned char* lds; int G, c, nn;
    __device__ __forceinline__ bool next(int i, Unit& u) const { const int idx = i * G + c; if (idx >= 2 * nn) return false; u.pn = idx & 1; moe_decode(lds, ((const LAS int*)(lds + AUX_OFF))[MT_NLIST + (idx >> 1)], u); return true; }
    __device__ __forceinline__ void a_offs(const Unit& u, int tid, unsigned (&o)[2][2]) const { const int* pdst = (const int*)(ws + WS_PDST);
#pragma unroll
        for (int i = 0; i < 2; ++i) { int R, C; gm::stage_rc(tid * 16 + i * 8192, R, C);
#pragma unroll
            for (int h = 0; h < 2; ++h) { int slot = u.pm * 256 + 128 * h + R; slot = slot < u.cnt ? slot : u.cnt - 1; const int tok = pdst[u.e * CAP + slot] >> 1; o[h][i] = (unsigned)(tok * 1024 + C) * 2u; } }
    }
    __device__ __forceinline__ const char* a_tile(const Unit&) const { return Abase; }
    __device__ __forceinline__ const char* b_tile(const Unit& u) const { return (const char*)(ws + WS_WGU) + ((size_t)(u.e & 31) * 512 + u.pn * 256) * 1024 * 2; }
    __device__ __forceinline__ void epi(EPI_ARGS) const { EPI_OPAQUE
        const int r0 = wr * 64 + fr, col0 = u.pn * 128 + wc * 32 + 8 * fq; const float* ps = (const float*)(ws + WS_PS) + u.e * CAP; bf16* H = (bf16*)(ws + bH(u.e >> 5));
        float sv[2][4];
#pragma unroll
        for (int ai = 0; ai < 2; ++ai)
#pragma unroll
            for (int m = 0; m < 4; ++m) { int slot = u.pm * 256 + r0 + ai * 128 + m * 16; slot = slot < u.cnt ? slot : u.cnt - 1; sv[ai][m] = ps[slot]; }
        EPI_FENCE();
#pragma unroll
        for (int ai = 0; ai < 2; ++ai)
#pragma unroll
            for (int m = 0; m < 4; ++m) { const int r = r0 + ai * 128 + m * 16; const float s = sv[ai][m];
                f32x4 v0, v1;
#pragma unroll
                for (int j = 0; j < 4; ++j) { const float g0 = acc[ai][0][m][0][j] * s, u0 = acc[ai][1][m][0][j] * s, g1 = acc[ai][0][m][1][j] * s, u1 = acc[ai][1][m][1][j] * s;
                    v0[j] = g0 * fast_sigmoid(g0) * u0; v1[j] = g1 * fast_sigmoid(g1) * u1; }
                *(u32x4*)(H + ((size_t)u.gt * 256 + r) * 256 + col0) = pack8(v0, v1); }
        EPI_FENCE();
    }
};
struct PhDown {
    static constexpr bool GATHER = false; static constexpr int LDA = 256, K = 256, LDB = 256, HSTEPB = 128 * 256 * 2;
    unsigned char* ws; const char* Abase; LAS unsigned char* lds; int G, c, nn;
    __device__ __forceinline__ bool next(int i, Unit& u) const { const int idx = i * G + c; if (idx >= 4 * nn) return false; u.pn = idx & 3; moe_decode(lds, ((const LAS int*)(lds + AUX_OFF))[MT_NLIST + (idx >> 2)], u); return true; }
    NO_GATHER __device__ __forceinline__ const char* a_tile(const Unit& u) const { return Abase + (size_t)(u.gt * 256) * 256 * 2; }
    __device__ __forceinline__ const char* b_tile(const Unit& u) const { return (const char*)(ws + WS_WD) + ((size_t)(u.e & 31) * 1024 + u.pn * 256) * 256 * 2; }
    __device__ __forceinline__ void epi(EPI_ARGS) const { EPI_OPAQUE
        const int r0 = u.pm * 256 + wr * 64 + fr, col0 = u.pn * 256 + wc * 32 + 8 * fq; const int* pdst = (const int*)(ws + WS_PDST) + u.e * CAP; const float* pw = (const float*)(ws + WS_PW) + u.e * CAP; bf16* Y2 = (bf16*)(ws + bY2(u.e >> 5));
        int slot = r0 < u.cnt ? r0 : u.cnt - 1; int dn = pdst[slot]; float wn = pw[slot];
#pragma unroll
        for (int g = 0; g < 8; ++g) { const int ai = g >> 2, m = g & 3; const int dcur = dn; const float wcur = wn;
            if (g < 7) { int s2 = r0 + ((g + 1) >> 2) * 128 + ((g + 1) & 3) * 16; s2 = s2 < u.cnt ? s2 : u.cnt - 1; dn = pdst[s2]; wn = pw[s2]; }
            if (r0 + ai * 128 + m * 16 < u.cnt) { bf16* yp = Y2 + (size_t)dcur * 1024 + col0;
#pragma unroll
                for (int bj = 0; bj < 2; ++bj) *(u32x4*)(yp + bj * 128) = pack8(acc[ai][bj][m][0] * wcur, acc[ai][bj][m][1] * wcur); }
            EPI_FENCE(); }
    }
};
struct PhSloc {
    static constexpr bool GATHER = false; static constexpr int LDA = 384, K = 256, LDB = 256, HSTEPB = 0;
    unsigned char* ws; const char* Abase; int G, c, bt;
    __device__ __forceinline__ bool next(int i, Unit& u) const { const int idx = i * G + c; if (idx >= 128) return false; u.e = idx >> 1; u.pm = 2 * bt + (idx & 1); u.pn = 0; u.gt = 0; u.cnt = 0; return true; }
    NO_GATHER __device__ __forceinline__ const char* a_tile(const Unit& u) const { return Abase + (size_t)(u.e * 512 + (u.pm & 1) * 256) * 384 * 2; }
    __device__ __forceinline__ const char* b_tile(const Unit& u) const { return (const char*)(ws + WS_SSM) + (size_t)u.e * SSM_G_BYTES; }
    __device__ __forceinline__ void epi(EPI_ARGS) const { EPI_OPAQUE
        const int r0 = u.e * 512 + (u.pm & 1) * 256 + wr * 64 + fr, col0 = wc * 32 + 8 * fq; float* Sloc = (float*)(ws + bSLOC(bt));
#pragma unroll
        for (int ai = 0; ai < 2; ++ai)
#pragma unroll
            for (int m = 0; m < 4; ++m) { float* p = Sloc + (size_t)(r0 + ai * 128 + m * 16) * 128 + col0; *(f32x4*)p = acc[ai][0][m][0]; *(f32x4*)(p + 4) = acc[ai][0][m][1]; }
    }
};
struct PhY {
    static constexpr bool GATHER = false; static constexpr int LDA = 384, K = 384, LDB = 384, HSTEPB = 128 * 384 * 2;
    unsigned char* ws; const char* Abase; int G, c, bt;
    __device__ __forceinline__ bool next(int i, Unit& u) const { const int idx = i * G + c; if (idx >= 128) return false; u.e = idx >> 1; u.pm = 2 * bt + (idx & 1); u.pn = 0; u.gt = 0; u.cnt = 0; return true; }
    NO_GATHER __device__ __forceinline__ const char* a_tile(const Unit& u) const { return Abase + (size_t)(u.e * 512 + (u.pm & 1) * 256) * 384 * 2; }
    __device__ __forceinline__ const char* b_tile(const Unit& u) const { return (const char*)(ws + WS_SSM) + (size_t)u.e * SSM_G_BYTES + SSM_A2_OFF; }
    __device__ __forceinline__ void epi(EPI_ARGS) const { EPI_OPAQUE
        const int nb = (u.pm & 1) * 256 + wr * 64 + fr;
        bf16* p = (bf16*)(ws + bG(u.pm >> 1)) + ((size_t)(u.pm >> 1) * SEQ + 16 * nb + 2 * wc + (fq >> 1)) * 1024 + 16 * u.e + 8 * (fq & 1);
#pragma unroll
        for (int ai = 0; ai < 2; ++ai)
#pragma unroll
            for (int m = 0; m < 4; ++m) {
#pragma unroll
                for (int bj = 0; bj < 2; ++bj) { f32x4 v0, v1;
#pragma unroll
                    for (int j = 0; j < 4; ++j) { v0[j] = fast_gelu(acc[ai][bj][m][0][j]); v1[j] = fast_gelu(acc[ai][bj][m][1][j]); }
                    *(u32x4*)(p + bj * 8 * 1024) = pack8(v0, v1); }
                p += (m == 3 ? (128 - 48) : 16) * 16 * 1024; asm volatile("" : "+v"(p) :: "memory"); }
    }
};

namespace at {
constexpr int NSLOT = 4, SLOTB = 8192;
constexpr int LDS_K = 0, LDS_V = NSLOT * SLOTB, LDS_WS = 2 * NSLOT * SLOTB, LDS_TBL = LDS_WS + 2048, LDS_OST = LDS_TBL + 2048, LDS_TOTAL = LDS_OST + 8 * 4096;
typedef short v4i16_t __attribute__((ext_vector_type(4)));
__device__ __forceinline__ int crow(int r, int hi) { return (r & 3) + 8 * (r >> 2) + 4 * hi; }
__device__ __forceinline__ void glds16(const void* gsrc, unsigned lds_dst) { unsigned keep;
    asm volatile("s_mov_b32 %0, m0\n\ts_mov_b32 m0, %2\n\ts_nop 0\n\tglobal_load_lds_dwordx4 %1, off\n\ts_mov_b32 m0, %0" : "=&s"(keep) : "v"(gsrc), "s"(lds_dst) : "memory"); }
__device__ __forceinline__ s16x4 vtr(const LAS unsigned char* p) { return __builtin_bit_cast(s16x4, __builtin_amdgcn_ds_read_tr16_b64_v4i16((LAS v4i16_t*)p)); }
#define AT_WAIT_BAR(N) asm volatile("s_waitcnt vmcnt(" #N ") lgkmcnt(0)\n\ts_barrier" ::: "memory")
template <int THR> __device__ __forceinline__ void attn_unit(int b, int h, int qb, const bf16* Q, const bf16* __restrict__ K, const bf16* __restrict__ V, bf16* O, const float* __restrict__ relb, LAS unsigned char* shm, int wid) {
    const int lane = lane_now(), tid = wid * 64 + lane, r32 = lane & 31, hi = lane >> 5;
    const long rowbase = (long)b * SEQ; const int q0 = qb * 256; const int cq = 4 * qb + (wid >> 1);
    const bf16* Qw = Q + (rowbase + q0 + wid * 32) * D + h * 64;
    const unsigned lds0 = (unsigned)(uintptr_t)shm;
    LAS float* wsf = (LAS float*)(shm + LDS_WS) + wid * 64; LAS float* tbl = (LAS float*)(shm + LDS_TBL);
    const int kc_lo = (4 * qb - 8) < 0 ? 0 : (4 * qb - 8); const int NT = 4 * qb + 3 - kc_lo + 1;
    const int ta = ((cq - 8) < kc_lo ? kc_lo : (cq - 8)) - kc_lo, tb_ = cq - kc_lo;
    if (tid < 320) tbl[tid] = relb[h * NREL + (tid < 256 ? tid : 256)] * LOG2E;
    const bf16* ksrc = K + (rowbase + kc_lo * 64 + lane) * D + h * 64 + wid * 8;
    const bf16* vsrc = V + (rowbase + kc_lo * 64 + 16 * (wid & 3) + (lane >> 2)) * D + h * 64 + (wid >> 2) * 32 + (lane & 3) * 8;
    const unsigned kdst = lds0 + LDS_K + wid * 1024, vdst = lds0 + LDS_V + wid * 1024;
#define AT_DMA(t) do { const unsigned so_ = (unsigned)((t) & 3) * SLOTB; glds16(ksrc + (long)(t) * 64 * D, (unsigned)__builtin_amdgcn_readfirstlane(kdst + so_)); glds16(vsrc + (long)(t) * 64 * D, (unsigned)__builtin_amdgcn_readfirstlane(vdst + so_)); } while (0)
    bf16x8 qr[4];
#pragma unroll
    for (int d0 = 0; d0 < 4; ++d0) qr[d0] = *reinterpret_cast<const bf16x8*>(&Qw[(long)r32 * D + d0 * 16 + hi * 8]);
    AT_DMA(0); AT_DMA(1); AT_DMA(2);
    asm volatile("" : "+v"(qr[0]), "+v"(qr[1]), "+v"(qr[2]), "+v"(qr[3]));
    float mrow = -1e30f, lsum = 0.f; f32x16 o[2]; o[0] = f32x16{}; o[1] = f32x16{};
    f32x16 s0 = f32x16{}, s1 = f32x16{};
    f32x16 cfar = f32x16{};
    const int qoff = 32 * (wid & 1) + r32 + 128 - 4 * hi;
#define AT_CINIT(P0, P1, kc_, msub_) do { const int delta_ = cq - (kc_); \
        if (delta_ >= 3) { P0 = cfar; P1 = cfar; } \
        else { const LAS float* tb = tbl + (64 * delta_ + qoff); _Pragma("unroll") for (int r = 0; r < 16; ++r) { const int kj = (r & 3) + 8 * (r >> 2); P0[r] = tb[-kj] - (msub_); P1[r] = tb[-kj - 32] - (msub_); } } } while (0)
#define AT_KLOAD(t_) do { const LAS unsigned char* kp = shm + LDS_K + ((t_) & 3) * SLOTB + hi * 1024 + r32 * 16; \
        _Pragma("unroll") for (int d0 = 0; d0 < 4; ++d0) { kf[2 * d0] = *(const LAS bf16x8*)(kp + d0 * 2048); kf[2 * d0 + 1] = *(const LAS bf16x8*)(kp + d0 * 2048 + 512); } } while (0)
#define AT_QK(P0, P1) do { _Pragma("unroll") for (int d0 = 0; d0 < 4; ++d0) { \
            P0 = __builtin_amdgcn_mfma_f32_32x32x16_bf16(kf[2 * d0], qr[d0], P0, 0, 0, 0); P1 = __builtin_amdgcn_mfma_f32_32x32x16_bf16(kf[2 * d0 + 1], qr[d0], P1, 0, 0, 0); } } while (0)
#define AT_CFAR() do { const float c0_ = tbl[256] - mrow; _Pragma("unroll") for (int r = 0; r < 16; ++r) cfar[r] = c0_; } while (0)
#define AT_STATS() do { float ra = fmaxf(fmaxf(s0[0], s0[1]), s1[0]), rb2 = fmaxf(fmaxf(s0[2], s0[3]), s1[1]); ra = fmaxf(fmaxf(ra, s1[2]), s1[3]); \
        _Pragma("unroll") for (int r = 4; r < 16; r += 4) { ra = fmaxf(fmaxf(ra, s0[r]), s0[r + 1]); rb2 = fmaxf(fmaxf(rb2, s0[r + 2]), s0[r + 3]); ra = fmaxf(fmaxf(ra, s1[r]), s1[r + 1]); rb2 = fmaxf(fmaxf(rb2, s1[r + 2]), s1[r + 3]); } \
        float rm = fmaxf(ra, rb2); { auto rr = __builtin_amdgcn_permlane32_swap(__float_as_uint(rm), __float_as_uint(rm), false, false); rm = fmaxf(__uint_as_float(rr[0]), __uint_as_float(rr[1])); } \
        if (mrow < -1e29f) { mrow = rm; _Pragma("unroll") for (int r = 0; r < 16; ++r) { s0[r] -= rm; s1[r] -= rm; } AT_CFAR(); } \
        else if (__any(rm > (float)THR)) { const float dl = fmaxf(rm, 0.f), f = __builtin_amdgcn_exp2f(-dl); mrow += dl; lsum *= f; \
            if (hi == 0) wsf[r32] = f; LDS_WAIT(); \
            _Pragma("unroll") for (int r = 0; r < 16; ++r) { const float fr_ = wsf[crow(r, hi)]; o[0][r] *= fr_; o[1][r] *= fr_; s0[r] -= dl; s1[r] -= dl; } AT_CFAR(); } } while (0)
#define AT_EXP_PACK() float sacc = 0.f, sacc2 = 0.f; \
        _Pragma("unroll") for (int r = 0; r < 16; ++r) { s0[r] = __builtin_amdgcn_exp2f(s0[r]); s1[r] = __builtin_amdgcn_exp2f(s1[r]); sacc += s0[r]; sacc2 += s1[r]; } \
        lsum += sacc + sacc2; \
        const u32x4 pw0 = (u32x4){cvtpk_s(s0[0], s0[1]), cvtpk_s(s0[2], s0[3]), cvtpk_s(s0[4], s0[5]), cvtpk_s(s0[6], s0[7])}; \
        const u32x4 pw1 = (u32x4){cvtpk_s(s0[8], s0[9]), cvtpk_s(s0[10], s0[11]), cvtpk_s(s0[12], s0[13]), cvtpk_s(s0[14], s0[15])}; \
        const u32x4 pw2 = (u32x4){cvtpk_s(s1[0], s1[1]), cvtpk_s(s1[2], s1[3]), cvtpk_s(s1[4], s1[5]), cvtpk_s(s1[6], s1[7])}; \
        const u32x4 pw3 = (u32x4){cvtpk_s(s1[8], s1[9]), cvtpk_s(s1[10], s1[11]), cvtpk_s(s1[12], s1[13]), cvtpk_s(s1[14], s1[15])}; \
        const bf16x8 pa[4] = {__builtin_bit_cast(bf16x8, pw0), __builtin_bit_cast(bf16x8, pw1), __builtin_bit_cast(bf16x8, pw2), __builtin_bit_cast(bf16x8, pw3)};
#define AT_VLOAD(t_) do { const LAS unsigned char* vp = shm + LDS_V + ((t_) & 3) * SLOTB + ((lane >> 4) & 1) * 32 + (lane & 3) * 8 + (4 * hi + ((lane & 15) >> 2)) * 64; \
        _Pragma("unroll") for (int d0 = 0; d0 < 2; ++d0) _Pragma("unroll") for (int ks = 0; ks < 4; ++ks) { vlo[d0 * 4 + ks] = vtr(vp + d0 * 4096 + ks * 1024); vhi[d0 * 4 + ks] = vtr(vp + d0 * 4096 + ks * 1024 + 512); } } while (0)
#define AT_PV() do { _Pragma("unroll") for (int d0 = 0; d0 < 2; ++d0) _Pragma("unroll") for (int ks = 0; ks < 4; ++ks) { const s16x4 lo = vlo[d0 * 4 + ks], hh = vhi[d0 * 4 + ks]; \
            const bf16x8 vf = (bf16x8){lo[0], lo[1], lo[2], lo[3], hh[0], hh[1], hh[2], hh[3]}; o[d0] = __builtin_amdgcn_mfma_f32_32x32x16_bf16(pa[ks], vf, o[d0], 0, 0, 0); } } while (0)
    bf16x8 kf[8]; s16x4 vlo[8], vhi[8];
    for (int t = 0; t < NT; ++t) {
        if (t + 2 < NT) { AT_WAIT_BAR(4); } else if (t + 1 < NT) { AT_WAIT_BAR(2); } else { AT_WAIT_BAR(0); }
        if (t + 3 < NT) AT_DMA(t + 3);
        if (t >= ta && t <= tb_) {
            AT_KLOAD(t); AT_VLOAD(t);
            __builtin_amdgcn_sched_barrier(0);
            if (mrow < -1e29f) { const float c0_ = tbl[256]; _Pragma("unroll") for (int r = 0; r < 16; ++r) cfar[r] = c0_; }
            AT_CINIT(s0, s1, kc_lo + t, (mrow < -1e29f ? 0.f : mrow));
            AT_QK(s0, s1);
            AT_STATS();
            AT_EXP_PACK()
            AT_PV();
        }
    }
    { auto rr = __builtin_amdgcn_permlane32_swap(__float_as_uint(lsum), __float_as_uint(lsum), false, false); lsum = __uint_as_float(rr[0]) + __uint_as_float(rr[1]); }
    if (hi == 0) wsf[32 + r32] = lsum;
    LDS_WAIT();
    float rli[16];
#pragma unroll
    for (int r = 0; r < 16; ++r) rli[r] = __builtin_amdgcn_rcpf(wsf[32 + crow(r, hi)]);
    bf16* Ow = O + (rowbase + q0 + wid * 32) * D + h * 64;
    { LAS bf16* stg = (LAS bf16*)(shm + LDS_OST) + wid * 2048;
#pragma unroll
      for (int r = 0; r < 16; ++r) { const int orow = crow(r, hi);
#pragma unroll
          for (int d0 = 0; d0 < 2; ++d0) stg[orow * 64 + d0 * 32 + r32] = f2bf(o[d0][r] * rli[r]); }
      LDS_WAIT();
#pragma unroll
      for (int i = 0; i < 4; ++i) { const int row = i * 8 + (lane >> 3), ch = lane & 7; const u32x4 v = *(const LAS u32x4*)(stg + row * 64 + ch * 8); *(u32x4*)(Ow + (long)row * D + ch * 8) = v; } }
    asm volatile("s_waitcnt lgkmcnt(0)\n\ts_barrier" ::: "memory");
#undef AT_DMA
#undef AT_CINIT
#undef AT_QK
#undef AT_KLOAD
#undef AT_VLOAD
#undef AT_CFAR
#undef AT_STATS
#undef AT_EXP_PACK
#undef AT_PV
}
}

struct Args { const float* in[23]; float* out; unsigned char* ws; int ph_lo, ph_hi, li, pad; };

struct TrDesc { const float* W; bf16* WT; const float* ks; int ldw, k0, n0, ldt, drow0; };
__device__ __forceinline__ void tr_load(const TrDesc& d, float (&v)[32], int lane) {
    const float* wp = d.W + (size_t)(d.k0 + (lane >> 5)) * d.ldw + d.n0 + (lane & 31);
#pragma unroll
    for (int i = 0; i < 32; ++i) v[i] = wp[(size_t)(2 * i) * d.ldw];
}
__device__ __forceinline__ void tr_store(const TrDesc& d, float (&v)[32], LAS float* scr, int lane) {
    if (d.ks) {
#pragma unroll
        for (int i = 0; i < 32; ++i) v[i] *= d.ks[d.k0 + 2 * i + (lane >> 5)]; }
#pragma unroll
    for (int i = 0; i < 32; ++i) scr[(2 * i + (lane >> 5)) * 33 + (lane & 31)] = v[i];
    LDS_WAIT(); asm volatile("" ::: "memory");
    const int c = lane & 7;
#pragma unroll
    for (int j = 0; j < 4; ++j) { const int n = (lane >> 3) + 8 * j; const LAS float* s = scr + (8 * c) * 33 + n;
        u32x4 o; o.x = pk2(s[0 * 33], s[1 * 33]); o.y = pk2(s[2 * 33], s[3 * 33]); o.z = pk2(s[4 * 33], s[5 * 33]); o.w = pk2(s[6 * 33], s[7 * 33]);
        *(u32x4*)(d.WT + (size_t)(d.drow0 + n) * d.ldt + d.k0 + 8 * c) = o; }
    LDS_WAIT(); asm volatile("" ::: "memory");
}
struct TrSrc { const float* w_qkv; const float* w_o; const float* w_out; const float* wg; const float* wu; const float* wd; const float* gn; unsigned char* ws; int nd, first, last; };
__device__ __forceinline__ TrSrc mk_trsrc(const float* a, const float* b, const float* c, const float* wg, const float* wu, const float* wd, const float* gn, unsigned char* ws, int nd, int f, int l) { TrSrc S; S.w_qkv = a; S.w_o = b; S.w_out = c; S.wg = wg; S.wu = wu; S.wd = wd; S.gn = gn; S.ws = ws; S.nd = nd; S.first = f; S.last = l; return S; }
__device__ __forceinline__ TrDesc tr_desc(const TrSrc& S, int it) {
    TrDesc d; d.ks = nullptr;
    if (it < S.nd) {
        if (it < 1536) { const int kb = it / 96, nb = it % 96; d.W = S.w_qkv; d.ldw = 3072; d.k0 = kb * 64; d.n0 = nb * 32; d.WT = (bf16*)(S.ws + WS_WQKV); d.ldt = 1024; d.drow0 = nb * 32; }
        else if (it < 2048) { const int r = it - 1536, kb = r >> 5, nb = r & 31; d.W = S.w_o; d.ldw = 1024; d.k0 = kb * 64; d.n0 = nb * 32; d.WT = (bf16*)(S.ws + WS_WO); d.ldt = 1024; d.drow0 = nb * 32; }
        else { const int r = it - 2048, kb = r >> 6, nb = r & 63, n0 = nb * 32, ag = n0 >> 10, cc = n0 & 1023; d.W = S.w_out; d.ldw = 2048; d.k0 = kb * 64; d.n0 = n0; d.WT = (bf16*)(S.ws + WS_WOUT); d.ldt = 1024; d.drow0 = 256 * (cc >> 7) + 128 * ag + (cc & 127); }
    } else { const int m = it - S.nd;
        if (m < 8192) { const int which = m >> 12, r = m & 4095, e = r >> 7, kb = (r >> 3) & 15, nb = r & 7, n0 = nb * 32;
            d.W = (which ? S.wu : S.wg) + (size_t)e * 1024 * 256; d.ldw = 256; d.k0 = kb * 64; d.n0 = n0; d.WT = (bf16*)(S.ws + WS_WGU); d.ldt = 1024; d.drow0 = e * 512 + 256 * (n0 >> 7) + 128 * which + (n0 & 127); d.ks = S.gn; }
        else { const int r = m - 8192, e = r >> 7, kb = (r >> 5) & 3, nb = r & 31; d.W = S.wd + (size_t)e * 256 * 1024; d.ldw = 1024; d.k0 = kb * 64; d.n0 = nb * 32; d.WT = (bf16*)(S.ws + WS_WD); d.ldt = 256; d.drow0 = e * 1024 + nb * 32; } }
    return d;
}
__device__ __forceinline__ void tr_stream(const TrSrc& S, LAS float* scr, int gw, int NGW, int lane) {
    const int N = S.last; int it = S.first + gw; if (it >= N) return;
    float va[32], vb[32]; TrDesc d0 = tr_desc(S, it), d1 = d0; tr_load(d0, va, lane);
    for (;;) {
        int nx = it + NGW; if (nx < N) { d1 = tr_desc(S, nx); tr_load(d1, vb, lane); }
        tr_store(d0, va, scr, lane); it = nx; if (it >= N) break;
        nx = it + NGW; if (nx < N) { d0 = tr_desc(S, nx); tr_load(d0, va, lane); }
        tr_store(d1, vb, scr, lane); it = nx; if (it >= N) break;
    }
}
__device__ __forceinline__ void ssm_mats(int g, int q, const float* lre, const float* lim, const float* lstep, const float* bre, const float* bim, const float* cre, const float* cim, const float* dsk,
                                         unsigned char* ssm_ws, float* a16g, LAS float* L, int tid) {
    LAS float* pwr = L; LAS float* pwi = L + 64 * 17; LAS float* bbr = L + 2 * 64 * 17; LAS float* bbi = bbr + 1024; LAS float* ccr = bbi + 1024; LAS float* cci = ccr + 1024; LAS float* Kt = cci + 1024;
    if (tid < 64) { const int p = tid;
        const float lr = fminf(lre[g * 64 + p], -1e-4f), li = lim[g * 64 + p], step = expf(lstep[g]);
        const float decay = expf(lr * step), ang = li * step, ar = decay * cosf(ang), ai = decay * sinf(ang);
        const float den = lr * lr + li * li, nr = ar - 1.f, fr = (nr * lr + ai * li) / den, fi = (ai * lr - nr * li) / den;
        for (int c = 0; c < 16; ++c) { const float br = bre[(g * 64 + p) * 16 + c], bi = bim[(g * 64 + p) * 16 + c]; bbr[p * 16 + c] = fr * br - fi * bi; bbi[p * 16 + c] = fr * bi + fi * br;
            ccr[c * 64 + p] = cre[(g * 16 + c) * 64 + p]; cci[c * 64 + p] = cim[(g * 16 + c) * 64 + p]; }
        float xr = 1.f, xi = 0.f;
        for (int n = 0; n <= 16; ++n) { pwr[p * 17 + n] = xr; pwi[p * 17 + n] = xi; const float t = xr * ar - xi * ai; xi = xr * ai + xi * ar; xr = t; }
        if (q == 0) { a16g[(g * 64 + p) * 2] = pwr[p * 17 + 16]; a16g[(g * 64 + p) * 2 + 1] = pwi[p * 17 + 16]; }
    }
    __syncthreads();
    if (tid < 256) { const int tl = tid >> 6, c = (tid >> 2) & 15, cq = tid & 3, tau = 4 * q + tl;
        float s0 = 0.f, s1 = 0.f, s2 = 0.f, s3 = 0.f;
        for (int p = 0; p < 64; ++p) { const float cr = ccr[c * 64 + p], ci = cci[c * 64 + p], ar = pwr[p * 17 + tau], ai = pwi[p * 17 + tau]; const float tr = cr * ar - ci * ai, ti = cr * ai + ci * ar;
            const f32x4 br = *(const LAS f32x4*)(bbr + p * 16 + 4 * cq), bi = *(const LAS f32x4*)(bbi + p * 16 + 4 * cq);
            s0 += tr * br[0] - ti * bi[0]; s1 += tr * br[1] - ti * bi[1]; s2 += tr * br[2] - ti * bi[2]; s3 += tr * br[3] - ti * bi[3]; }
        if (tau == 0) { const float dd = dsk[g * 16 + c]; if (4 * cq == (c & ~3)) { if ((c & 3) == 0) s0 += dd; else if ((c & 3) == 1) s1 += dd; else if ((c & 3) == 2) s2 += dd; else s3 += dd; } }
        LAS float* kp = Kt + tl * 256 + c * 16 + 4 * cq; kp[0] = s0; kp[1] = s1; kp[2] = s2; kp[3] = s3; }
    __syncthreads();
    bf16* Bend = (bf16*)(ssm_ws + (size_t)g * SSM_G_BYTES); bf16* A2 = (bf16*)(ssm_ws + (size_t)g * SSM_G_BYTES + SSM_A2_OFF);
    for (int o = tid; o < 2048; o += NTHR) { const int tl = o >> 9, i = (o >> 5) & 15, c = (o >> 1) & 15, hf = o & 1, tau = 4 * q + tl, j = i - tau;
        if (j >= 0) { const LAS float* kp = Kt + tl * 256 + c * 16 + 8 * hf; u32x4 w; w.x = pk2(kp[0], kp[1]); w.y = pk2(kp[2], kp[3]); w.z = pk2(kp[4], kp[5]); w.w = pk2(kp[6], kp[7]);
            *(u32x4*)(A2 + (size_t)(i * 16 + c) * 384 + j * 16 + 8 * hf) = w; } }
    for (int o = tid; o < 2048; o += NTHR) { const int il = o >> 9, c = (o >> 5) & 15, j = (o >> 1) & 15, hf = o & 1, i = 4 * q + il;
        if (j > i) *(u32x4*)(A2 + (size_t)(i * 16 + c) * 384 + j * 16 + 8 * hf) = (u32x4){0u, 0u, 0u, 0u}; }
    for (int o = tid; o < 1024; o += NTHR) { const int il = o >> 8, c = (o >> 4) & 15, k8 = (o & 15) * 8, i = 4 * q + il; float v[8];
#pragma unroll
        for (int qq = 0; qq < 4; ++qq) { const int p = (k8 >> 1) + qq; const float cr = ccr[c * 64 + p], ci = cci[c * 64 + p], ar = pwr[p * 17 + i + 1], ai = pwi[p * 17 + i + 1];
            v[2 * qq] = cr * ar - ci * ai; v[2 * qq + 1] = -(cr * ai + ci * ar); }
        u32x4 w; w.x = pk2(v[0], v[1]); w.y = pk2(v[2], v[3]); w.z = pk2(v[4], v[5]); w.w = pk2(v[6], v[7]); *(u32x4*)(A2 + (size_t)(i * 16 + c) * 384 + 256 + k8) = w; }
    for (int o = tid; o < 1024; o += NTHR) { const int n = 32 * q + (o >> 5), k8 = (o & 31) * 8, p = n >> 1, ri = n & 1, j = k8 >> 4; float v[8];
        const float ar = pwr[p * 17 + 15 - j], ai = pwi[p * 17 + 15 - j];
#pragma unroll
        for (int qq = 0; qq < 8; ++qq) { const int c2 = (k8 & 15) + qq; const float br = bbr[p * 16 + c2], bi = bbi[p * 16 + c2]; v[qq] = ri ? (ar * bi + ai * br) : (ar * br - ai * bi); }
        u32x4 w; w.x = pk2(v[0], v[1]); w.y = pk2(v[2], v[3]); w.z = pk2(v[4], v[5]); w.w = pk2(v[6], v[7]); *(u32x4*)(Bend + (size_t)n * 256 + k8) = w; }
    __syncthreads();
}

__device__ __forceinline__ void router_phase(const bf16* __restrict__ h, const u32x4* __restrict__ rwt, const float* __restrict__ bgr, const float* __restrict__ ber, unsigned* cntg,
                                             int* pdst, float* pw, float* ps, float* srow, LAS unsigned char* lds, int vcu, int G, int wid, bool prefilled, int blk0, int nblk, int eb) {
    const int lane = lane_now(), tid = wid * 64 + lane;
    LAS bf16* Wl = (LAS bf16*)lds;
    if (!prefilled) for (int i = tid; i < RW_LAYER_BYTES / 16; i += NTHR) ((LAS u32x4*)lds)[i] = rwt[i];
    LAS int* lc = (LAS int*)(lds + RSCR_OFF); LAS int* lbase = lc + 32;
    const int rb = wid & 3, kh = wid >> 2, row = lane & 15, kq = lane >> 4;
    for (int blk = blk0 + vcu; blk < blk0 + nblk; blk += G) {
        if (tid < 32) lc[tid] = 0;
        __syncthreads();
        const int t0 = blk * 64;
        const bf16* hp = h + (size_t)(t0 + 16 * rb + row) * D + 512 * kh + 8 * kq;
        const LAS bf16* wp0 = Wl + row * RW_PITCH + 512 * kh + 8 * kq; const LAS bf16* wp1 = wp0 + 16 * RW_PITCH; const LAS bf16* wp2 = Wl + (32 + (row & 3)) * RW_PITCH + 512 * kh + 8 * kq;
        f32x4 a0 = {0.f, 0.f, 0.f, 0.f}, a1 = a0, a2 = a0; float ssl = 0.f;
#pragma unroll 4
        for (int j = 0; j < 16; ++j) { const u32x4 hw = *(const u32x4*)(hp + 32 * j); const bf16x8 av = __builtin_bit_cast(bf16x8, hw);
#pragma unroll
            for (int i = 0; i < 4; ++i) { const float lo_ = __uint_as_float(hw[i] << 16), hi_ = __uint_as_float(hw[i] & 0xffff0000u); ssl += lo_ * lo_ + hi_ * hi_; }
            const bf16x8 b0h = *(const LAS bf16x8*)(wp0 + 32 * j), b0l = *(const LAS bf16x8*)(wp0 + RW_PLANE + 32 * j), b1h = *(const LAS bf16x8*)(wp1 + 32 * j), b1l = *(const LAS bf16x8*)(wp1 + RW_PLANE + 32 * j),
                         b2h = *(const LAS bf16x8*)(wp2 + 32 * j), b2l = *(const LAS bf16x8*)(wp2 + RW_PLANE + 32 * j);
            a0 = __builtin_amdgcn_mfma_f32_16x16x32_bf16(av, b0h, a0, 0, 0, 0); a0 = __builtin_amdgcn_mfma_f32_16x16x32_bf16(av, b0l, a0, 0, 0, 0);
            a1 = __builtin_amdgcn_mfma_f32_16x16x32_bf16(av, b1h, a1, 0, 0, 0); a1 = __builtin_amdgcn_mfma_f32_16x16x32_bf16(av, b1l, a1, 0, 0, 0);
            a2 = __builtin_amdgcn_mfma_f32_16x16x32_bf16(av, b2h, a2, 0, 0, 0); a2 = __builtin_amdgcn_mfma_f32_16x16x32_bf16(av, b2l, a2, 0, 0, 0); }
        ssl += __shfl_xor(ssl, 16); ssl += __shfl_xor(ssl, 32);
        LAS float* P = (LAS float*)(lds + RSCR_OFF + 256);
        LAS float* pp = P + (16 * rb) * 40;
        if (kh == 1) {
#pragma unroll
            for (int r = 0; r < 4; ++r) { const int tk = 4 * kq + r; pp[tk * 40 + row] = a0[r]; pp[tk * 40 + 16 + row] = a1[r]; if (row < 4) pp[tk * 40 + 32 + row] = a2[r]; }
            if (kq == 0) pp[row * 40 + 36] = ssl; }
        __syncthreads();
        if (kh == 0) {
#pragma unroll
            for (int r = 0; r < 4; ++r) { const int tk = 4 * kq + r; pp[tk * 40 + row] += a0[r]; pp[tk * 40 + 16 + row] += a1[r]; if (row < 4) pp[tk * 40 + 32 + row] += a2[r]; }
            if (kq == 0) pp[row * 40 + 36] += ssl; }
        __syncthreads();
        int e1 = 0, e2 = 0; float w1 = 0.f, w2 = 0.f, s = 0.f; int sl1 = 0, sl2 = 0;
        if (tid < 64) { LAS float* p0 = P + tid * 40;
            s = rsqrtf(p0[36] * (1.f / D) + RMS_EPS);
            for (int o = 0; o < 36; ++o) p0[o] = p0[o] * s + (o < 4 ? bgr[o] : ber[o - 4]);
            int gi = 0; float gmx = p0[0];
            for (int i = 1; i < 4; ++i) if (p0[i] > gmx) { gmx = p0[i]; gi = i; }
            float den = 0.f; for (int i = 0; i < 4; ++i) den += __expf(p0[i] - gmx);
            const float gp = 1.f / den; const LAS float* sl = p0 + 4 + 8 * gi;
            int i1 = 0; float l1 = sl[0]; for (int i = 1; i < 8; ++i) if (sl[i] > l1) { l1 = sl[i]; i1 = i; }
            int i2 = -1; float l2 = -3.4e38f; for (int i = 0; i < 8; ++i) if (i != i1 && sl[i] > l2) { l2 = sl[i]; i2 = i; }
            const float ex = __expf(l2 - l1); w1 = gp / (1.f + ex); w2 = gp * ex / (1.f + ex); e1 = gi * 8 + i1; e2 = gi * 8 + i2;
            sl1 = __hip_atomic_fetch_add(&lc[e1], 1, __ATOMIC_RELAXED, __HIP_MEMORY_SCOPE_WORKGROUP); sl2 = __hip_atomic_fetch_add(&lc[e2], 1, __ATOMIC_RELAXED, __HIP_MEMORY_SCOPE_WORKGROUP);
            }
        __syncthreads();
        if (tid < 32) { const int n = lc[tid]; lbase[tid] = n ? (int)__hip_atomic_fetch_add(cntg + tid * 64, (unsigned)n, RLX_AGENT) : 0; }
        __syncthreads();
        if (tid < 64) { const int t = t0 + tid; int i1 = lbase[e1] + sl1, i2 = lbase[e2] + sl2;
            if (i1 < CAP) { const int q1 = (eb + e1) * CAP + i1; pdst[q1] = 2 * t; pw[q1] = w1; ps[q1] = s; }
            if (i2 < CAP) { const int q2 = (eb + e2) * CAP + i2; pdst[q2] = 2 * t + 1; pw[q2] = w2; ps[q2] = s; } }
        __syncthreads();
    }
}

template <bool FINAL> __device__ __forceinline__ void combine_phase(const bf16* __restrict__ hin, const bf16* __restrict__ Y2, const float* __restrict__ g, bf16* __restrict__ hout, bf16* __restrict__ xng, float* __restrict__ outf, int vcu, int G, int wid, int lane, int row0, int nrows) {
    for (int base = row0 + vcu * 16; base < row0 + nrows; base += G * 16) {
#pragma unroll
        for (int rr = 0; rr < 2; ++rr) { const int row = base + 2 * wid + rr;
            float4 v[4]; float ss = 0.f;
#pragma unroll
            for (int j = 0; j < 4; ++j) { const int c = 4 * (lane + 64 * j);
                const u32x2 hh = *(const u32x2*)(hin + (size_t)row * D + c), ya = *(const u32x2*)(Y2 + ((size_t)2 * row) * D + c), yb = *(const u32x2*)(Y2 + ((size_t)2 * row + 1) * D + c);
                v[j].x = __uint_as_float(hh.x << 16) + __uint_as_float(ya.x << 16) + __uint_as_float(yb.x << 16); v[j].y = __uint_as_float(hh.x & 0xffff0000u) + __uint_as_float(ya.x & 0xffff0000u) + __uint_as_float(yb.x & 0xffff0000u);
                v[j].z = __uint_as_float(hh.y << 16) + __uint_as_float(ya.y << 16) + __uint_as_float(yb.y << 16); v[j].w = __uint_as_float(hh.y & 0xffff0000u) + __uint_as_float(ya.y & 0xffff0000u) + __uint_as_float(yb.y & 0xffff0000u);
                ss += v[j].x * v[j].x + v[j].y * v[j].y + v[j].z * v[j].z + v[j].w * v[j].w;
                if (!FINAL) { u32x2 w; w.x = pk2(v[j].x, v[j].y); w.y = pk2(v[j].z, v[j].w); *(u32x2*)(hout + (size_t)row * D + c) = w; } }
            ss = wave_sum(ss); const float s = rsqrtf(ss * (1.f / D) + RMS_EPS);
#pragma unroll
            for (int j = 0; j < 4; ++j) { const int c = 4 * (lane + 64 * j); const float4 gg = *(const float4*)(g + c);
                const float ox = v[j].x * s * gg.x, oy = v[j].y * s * gg.y, oz = v[j].z * s * gg.z, ow = v[j].w * s * gg.w;
                if (FINAL) { float4 o; o.x = ox; o.y = oy; o.z = oz; o.w = ow; *(float4*)(outf + (size_t)row * D + c) = o; }
                else { u32x2 w; w.x = pk2(ox, oy); w.y = pk2(oz, ow); *(u32x2*)(xng + xngb_off(row & (SEQ - 1), c)) = w; } } }
    }
}

__device__ __forceinline__ void scan_unit(int g, int pm, const float* __restrict__ Sloc, const float* __restrict__ a16g, bf16* xng, LAS unsigned char* lds, int wid) {
    const int tid = wid * 64 + lane_now(), p = tid & 63, q = tid >> 6, b = pm >> 1, half = pm & 1;
    LAS float* E = (LAS float*)(lds + AUX_OFF);
    const float ar = a16g[(g * 64 + p) * 2], ai = a16g[(g * 64 + p) * 2 + 1];
    float pr = ar, pi = ai;
#pragma unroll
    for (int k = 0; k < 5; ++k) { const float nr = pr * pr - pi * pi, ni = 2.f * pr * pi; pr = nr; pi = ni; }
    float cr = 0.f, ci = 0.f;
    for (int rnd = 0; rnd <= half; ++rnd) {
        const size_t row0 = (size_t)g * 512 + rnd * 256 + q * 32;
        const float* sp = Sloc + row0 * 128 + 2 * p;
        float2 v[32];
#pragma unroll
        for (int s = 0; s < 32; ++s) v[s] = *(const float2*)(sp + (size_t)s * 128);
        float xr = 0.f, xi = 0.f;
#pragma unroll
        for (int s = 0; s < 32; ++s) { const float nr = ar * xr - ai * xi + v[s].x, ni = ar * xi + ai * xr + v[s].y; xr = nr; xi = ni; }
        E[(q * 64 + p) * 2] = xr; E[(q * 64 + p) * 2 + 1] = xi;
        __syncthreads();
        float ir = cr, ii = ci, mr = 0.f, mi = 0.f;
#pragma unroll
        for (int qq = 0; qq < 8; ++qq) { if (qq == q) { mr = ir; mi = ii; } const float er = E[(qq * 64 + p) * 2], ei = E[(qq * 64 + p) * 2 + 1]; const float nr = pr * ir - pi * ii + er, ni = pr * ii + pi * ir + ei; ir = nr; ii = ni; }
        cr = ir; ci = ii;
        if (rnd == half) { bf16* xp = xng + row0 * 384 + 256 + 2 * p; xr = mr; xi = mi;
#pragma unroll
            for (int s = 0; s < 32; ++s) { *(unsigned*)(xp + (size_t)s * 384) = pk2(xr, xi); const float nr = ar * xr - ai * xi + v[s].x, ni = ar * xi + ai * xr + v[s].y; xr = nr; xi = ni; } }
        __syncthreads();
    }
}

__global__ void __launch_bounds__(NTHR, 2) mk_fwd(Args args) {
    extern __shared__ __attribute__((aligned(16))) unsigned char lds_[];
    LAS unsigned char* lds = (LAS unsigned char*)lds_;
    volatile LAS unsigned* MISC = (volatile LAS unsigned*)(lds + MISC_OFF);
    const int wid = __builtin_amdgcn_readfirstlane(threadIdx.x >> 6);
#define lane lane_now()
#define tid (wid * 64 + lane_now())
    const int bx = blockIdx.x; const int grp = (bx >> 3) & 1; const int lb = (bx & 7) + 8 * (bx >> 4);
    const int G = (int)gridDim.x >> 1; const int vcu = (G % 8 == 0) ? (lb % 8) * (G / 8) + lb / 8 : lb;
    const int bt = grp, R0 = bt * SEQ, pm0 = bt * (SEQ / 256);
    unsigned char* const ws = args.ws;
    constexpr size_t EW = (size_t)NEXP * 1024 * 256;
    for (int u = tid; u < (LDS_BYTES - MISC_OFF) / 4; u += NTHR) ((LAS unsigned*)(lds + MISC_OFF))[u] = 0u;
    __syncthreads();
    XcdBarrier bar = xcd_barrier_post((unsigned*)ws + CW_BAR + grp * XCD_BAR_WORDS, MISC + 8, wid);
    const int gw = vcu * NWAVES + wid, NGW = G * NWAVES;
#define SEAM() xcd_barrier(bar, wid, (unsigned)G)
#define SCR ((LAS float*)(lds + wid * 16384))
#define FLAG_SET(k) do { if (vcu == 0 && wid == 0 && lane_now() == 0) { __builtin_amdgcn_fence(__ATOMIC_RELEASE, "agent"); asm volatile("s_waitcnt vmcnt(0)" ::: "memory"); __hip_atomic_store((unsigned*)ws + CW_FLAG + 64 * (k), 1u, RLX_AGENT); } } while (0)
#define FLAG_WAIT(k) do { if (wid == 0 && lane_now() == 0) { unsigned sp_ = 0; while (__hip_atomic_load((unsigned*)ws + CW_FLAG + 64 * (k), RLX_AGENT) == 0u) { __builtin_amdgcn_s_sleep(2); if (++sp_ > (1u << 24)) break; } \
        __builtin_amdgcn_fence(__ATOMIC_ACQUIRE, "agent"); asm volatile("s_waitcnt vmcnt(0)" ::: "memory"); } __syncthreads(); } while (0)
    enum { F_WQKV = 0, F_L0 = 1, F_B6 = 2, F_L1 = 3, F_B7 = 4 };
#define ROUTER_PREFILL(layer) do { const u32x4* rw_ = (const u32x4*)(ws + WS_RWT + (size_t)(layer) * RW_LAYER_BYTES); for (int i_ = tid; i_ < RW_LAYER_BYTES / 16; i_ += NTHR) ((LAS u32x4*)lds)[i_] = rw_[i_]; } while (0)
#define WITH_SIDE(side, ...) do { if (vcu & 1) { side; } __VA_ARGS__; if (!(vcu & 1)) { side; } } while (0)

    if (grp == 1) {
        { const TrSrc S = mk_trsrc(args.in[4], args.in[5], args.in[15], args.in[20], args.in[21], args.in[22], args.in[2], ws, 3072, 1536, 3072 + 12288); tr_stream(S, SCR, gw, NGW, lane); }
        { bf16* rwt = (bf16*)(ws + WS_RWT); const float* norm_ffn = args.in[2];
          for (int o = vcu * NTHR + tid; o < 2 * 36 * 1024; o += G * NTHR) { const int layer = o / (36 * 1024), r = o % (36 * 1024), col = r >> 10, k = r & 1023;
            const float gnk = norm_ffn[layer * D + k];
            const float w = gnk * (col < 4 ? args.in[16][(size_t)layer * 4096 + k * 4 + col] : args.in[18][(size_t)layer * 32768 + ((size_t)((col - 4) >> 3) * 1024 + k) * 8 + ((col - 4) & 7)]);
            const bf16 hi_ = f2bf(w); const bf16 lo_ = f2bf(w - bf2f(hi_));
            rwt[(size_t)layer * 2 * RW_PLANE + col * RW_PITCH + k] = hi_; rwt[(size_t)layer * 2 * RW_PLANE + RW_PLANE + col * RW_PITCH + k] = lo_; } }
        __syncthreads();
        for (int gq = vcu; gq < 256; gq += G) ssm_mats(gq >> 2, gq & 3, args.in[7], args.in[8], args.in[9], args.in[10], args.in[11], args.in[12], args.in[13], args.in[14], ws + WS_SSM, (float*)(ws + WS_A16), (LAS float*)lds, tid);
        SEAM(); FLAG_SET(F_L0);
        FLAG_WAIT(F_WQKV);
    } else {
        { const TrSrc S = mk_trsrc(args.in[4], args.in[5], args.in[15], args.in[20], args.in[21], args.in[22], args.in[2], ws, 3072, 0, 1536); tr_stream(S, SCR, gw, NGW, lane); }
    }
    {
        const float* x = args.in[0]; const float* norm_mix = args.in[1]; bf16* XN = (bf16*)(ws + bXN(bt));
        for (int m0 = R0 + 2 * gw; m0 < R0 + SEQ; m0 += 2 * NGW) { float4 v[2][4];
#pragma unroll
            for (int rr = 0; rr < 2; ++rr) { const float4* xr = (const float4*)(x + (size_t)(m0 + rr) * D);
#pragma unroll
                for (int j = 0; j < 4; ++j) v[rr][j] = xr[lane + 64 * j]; }
#pragma unroll
            for (int rr = 0; rr < 2; ++rr) { float ss = 0.f;
#pragma unroll
                for (int j = 0; j < 4; ++j) ss += v[rr][j].x * v[rr][j].x + v[rr][j].y * v[rr][j].y + v[rr][j].z * v[rr][j].z + v[rr][j].w * v[rr][j].w;
                ss = wave_sum(ss); const float s = rsqrtf(ss * (1.f / D) + RMS_EPS);
#pragma unroll
                for (int j = 0; j < 4; ++j) { const int c = 4 * (lane + 64 * j); const float4 gg = *(const float4*)(norm_mix + c); u32x2 w; w.x = pk2(v[rr][j].x * s * gg.x, v[rr][j].y * s * gg.y); w.y = pk2(v[rr][j].z * s * gg.z, v[rr][j].w * s * gg.w);
                    *(u32x2*)(XN + (size_t)(m0 + rr) * D + c) = w; } } }
        SEAM(); if (grp == 0) FLAG_SET(F_WQKV);
    }
    { PhQKV P{ws, (const char*)(ws + bXN(bt)), G, lb, pm0}; gm::gemm_phase(lds, P, wid); SEAM(); }
    {
        const int per = 512 / G;
        for (int i = 0; i < per; ++i) { const int uid = vcu * per + i; at::attn_unit<8>(bt, uid >> 5, uid & 31, (const bf16*)(ws + bQ(bt)), (const bf16*)(ws + bQ(bt) + 16 * MiB), (const bf16*)(ws + bQ(bt) + 32 * MiB), (bf16*)(ws + bQ(bt)), args.in[6], lds, wid); }
        SEAM();
    }
    if (grp == 0) FLAG_WAIT(F_L0);
    { PhWo P{ws, (const char*)(ws + bQ(bt)), args.in[0], args.out, G, lb, pm0}; gm::gemm_phase(lds, P, wid); ROUTER_PREFILL(0); SEAM(); }
#define MOE_LAYER(layer) do { \
        router_phase((layer) ? (const bf16*)(ws + bXN(bt)) : (const bf16*)args.out, (const u32x4*)(ws + WS_RWT + (size_t)(layer) * RW_LAYER_BYTES), args.in[17] + (layer) * 4, args.in[19] + (layer) * 32, (unsigned*)ws + CW_CNT + ((layer) * 2 + bt) * 32 * 64, \
                     (int*)(ws + WS_PDST), (float*)(ws + WS_PW), (float*)(ws + WS_PS), (float*)(ws + WS_SROW), lds, vcu, G, wid, true, R0 / 64, SEQ / 64, 32 * bt); SEAM(); \
        moe_tables(lds, (const unsigned*)ws + CW_CNT + ((layer) * 2 + bt) * 32 * 64, tid, bt); const bf16* hbp = (layer) ? (const bf16*)(ws + bXN(bt)) : (const bf16*)args.out; \
        { PhGateUp P{ws, (const char*)hbp, lds, G, vcu, __builtin_amdgcn_readfirstlane(((const LAS int*)(lds + AUX_OFF))[MT_NN])}; gm::gemm_phase(lds, P, wid); } \
        { const LAS int* mt = (const LAS int*)(lds + AUX_OFF); const int np = 16 * mt[MT_NS]; for (int j = G - 1 - vcu; j < np; j += G) { Unit u; u.pn = 0; moe_decode(lds, mt[MT_SLIST + (j >> 4)], u); tail_job<true>(ws, hbp, u, j & 15, wid); } } \
        SEAM(); \
        { PhDown P{ws, (const char*)(ws + bH(bt)), lds, G, vcu, __builtin_amdgcn_readfirstlane(((const LAS int*)(lds + AUX_OFF))[MT_NN])}; gm::gemm_phase(lds, P, wid); } \
        { const LAS int* mt = (const LAS int*)(lds + AUX_OFF); const int np = 16 * mt[MT_NS]; for (int j = G - 1 - vcu; j < np; j += G) { Unit u; u.pn = 0; moe_decode(lds, mt[MT_SLIST + (j >> 4)], u); tail_job<false>(ws, (const bf16*)(ws + bH(bt)), u, j & 15, wid); } } \
        SEAM(); } while (0)
    MOE_LAYER(0);
    if (grp == 1) FLAG_SET(F_B6);
    combine_phase<false>((const bf16*)args.out, (const bf16*)(ws + bY2(bt)), args.in[1] + D, (bf16*)args.out + (size_t)M * D, (bf16*)(ws + bXNG(bt)), nullptr, vcu, G, wid, lane, R0, SEQ); SEAM();
    if (grp == 1) FLAG_SET(F_B7);
    { PhSloc P{ws, (const char*)(ws + bXNG(bt)), G, vcu, bt}; gm::gemm_phase(lds, P, wid); SEAM(); }
    {
        for (int idx = vcu; idx < 128; idx += G) scan_unit(idx >> 1, 2 * bt + (idx & 1), (const float*)(ws + bSLOC(bt)), (const float*)(ws + WS_A16), (bf16*)(ws + bXNG(bt)), lds, wid);
        asm volatile("s_waitcnt vmcnt(0)" ::: "memory"); __syncthreads();
        PhY P{ws, (const char*)(ws + bXNG(bt)), G, vcu, bt}; gm::gemm_phase(lds, P, wid); SEAM(); }
    if (grp == 0) {
        WITH_SIDE({ FLAG_WAIT(F_B6); const TrSrc S = mk_trsrc(nullptr, nullptr, nullptr, args.in[20] + EW, args.in[21] + EW, args.in[22] + EW, args.in[2] + D, ws, 0, 0, 12288); tr_stream(S, SCR, gw, NGW, lane); __syncthreads(); },
                  { PhWout P{ws, (const char*)(ws + bG(bt)), args.out, G, lb, pm0}; gm::gemm_phase(lds, P, wid); });
        ROUTER_PREFILL(1); SEAM(); FLAG_SET(F_L1);
    } else {
        { PhWout P{ws, (const char*)(ws + bG(bt)), args.out, G, lb, pm0}; gm::gemm_phase(lds, P, wid); }
        ROUTER_PREFILL(1); SEAM(); FLAG_WAIT(F_L1);
    }
    MOE_LAYER(1);
    if (grp == 0) FLAG_WAIT(F_B7);
    combine_phase<true>((const bf16*)(ws + bXN(bt)), (const bf16*)(ws + bY2(bt)), args.in[3], nullptr, nullptr, args.out, vcu, G, wid, lane, R0, SEQ);
#undef MOE_LAYER
#undef SEAM
#undef SCR
#undef lane
#undef tid
}

extern "C" void kernel_launch(void* const* d_in, const int* in_sizes, int n_in, void* d_out, int out_size, void* d_ws, size_t ws_size, hipStream_t stream) {
    static int grid = 0;
    if (grid == 0) {
        if (n_in != 23 || out_size != M * D || ws_size < WS_END) { fprintf(stderr, "kernel_launch: unexpected shapes (n_in %d out %d ws %zu)\n", n_in, out_size, ws_size); grid = -1; return; }
        int dev = 0, cus = 0;
        if (hipGetDevice(&dev) != hipSuccess || hipDeviceGetAttribute(&cus, hipDeviceAttributeMultiprocessorCount, dev) != hipSuccess) { grid = -1; return; }
        if (hipFuncSetAttribute((const void*)mk_fwd, hipFuncAttributeMaxDynamicSharedMemorySize, LDS_BYTES) != hipSuccess) { fprintf(stderr, "kernel_launch: hipFuncSetAttribute failed\n"); grid = -1; return; }
        (void)hipGetLastError();
        grid = 256;
        if (cus != 256) fprintf(stderr, "kernel_launch: %d CUs (built for 256)\n", cus);
    }
    if (grid < 0) return;
    unsigned char* ws = (unsigned char*)d_ws;
    (void)hipMemsetAsync(ws + WS_CTL, 0, CTL_ZERO_BYTES, stream);
    Args a{}; for (int i = 0; i < 23; ++i) a.in[i] = (const float*)d_in[i];
    a.out = (float*)d_out; a.ws = ws; a.ph_lo = 0; a.ph_hi = N_PHASES; a.li = 0;
    hipLaunchKernelGGL(mk_fwd, dim3(grid), dim3(NTHR), LDS_BYTES, stream, a);
}
```

```cpp
#include <hip/hip_runtime.h>
#include <cstdio>
#include <cstdint>

typedef unsigned short bf16;
constexpr int BATCH = 2, SEQ = 8192, D = 1024, M = BATCH * SEQ, NH = 16, HD = 64;
constexpr int NEXP = 32, EPG = 8, FE = 256;
constexpr int NREL = 257;
constexpr float RMS_EPS = 1e-6f;
constexpr float LOG2E = 1.4426950408889634f;
constexpr float C2 = 0.125f * LOG2E;

constexpr size_t MiB = 1u << 20;
constexpr size_t WS_CTL = 0;
constexpr size_t WS_XN = 86 * MiB;
constexpr size_t WS_BIG = 134 * MiB;
constexpr size_t WS_Q = WS_BIG, WS_K = WS_BIG + 32 * MiB, WS_V = WS_BIG + 64 * MiB;
constexpr size_t WS_Y2 = WS_BIG, WS_H = WS_BIG + 64 * MiB;
constexpr size_t WS_SLOC = WS_BIG, WS_G = WS_BIG + 32 * MiB;

__device__ __forceinline__ bf16 f2bf(float f) { unsigned u = __float_as_uint(f); return (bf16)((u + 0x7fffu + ((u >> 16) & 1u)) >> 16); }
__device__ __forceinline__ float bf2f(bf16 h) { return __uint_as_float(((unsigned)h) << 16); }
__device__ __forceinline__ float wave_sum(float v) {
#pragma unroll
    for (int o = 1; o < 64; o <<= 1) v += __shfl_xor(v, o);
    return v;
}
__device__ __forceinline__ float gelu_tanh(float x) { const float u = 0.7978845608028654f * (x + 0.044715f * x * x * x); return 0.5f * x * (1.f + tanhf(u)); }

__device__ __forceinline__ size_t xng_off(int t, int col) { const int b = t >> 13, tt = t & 8191, s = tt >> 4, j = tt & 15, g = col >> 4, c = col & 15; return ((size_t)(g * 1024 + b * 512 + s)) * 384 + j * 16 + c; }

#define LAS __attribute__((address_space(3)))
typedef short bf16x8 __attribute__((ext_vector_type(8)));
typedef short s16x4 __attribute__((ext_vector_type(4)));
typedef float f32x4 __attribute__((ext_vector_type(4)));
typedef float f32x16 __attribute__((ext_vector_type(16)));
typedef unsigned u32x4 __attribute__((ext_vector_type(4)));
typedef unsigned u32x2 __attribute__((ext_vector_type(2)));

constexpr int NWAVES = 8, NTHR = 512;
constexpr int CAP = 16384;
constexpr size_t CTL_ZERO_BYTES = 1 * MiB;
constexpr size_t WS_PDST = 1 * MiB, WS_PW = 3 * MiB, WS_PS = 5 * MiB, WS_SROW = 7 * MiB, WS_A16 = 7 * MiB + 65536;
constexpr size_t WS_TS = 7 * MiB + 131072;
constexpr size_t WS_RWT = 8 * MiB;
constexpr size_t WS_WQKV = 9 * MiB, WS_WO = 15 * MiB, WS_WOUT = 17 * MiB, WS_SSM = 21 * MiB;
constexpr size_t WS_WGU = 38 * MiB, WS_WD = 70 * MiB;
constexpr size_t WS_END = 230 * MiB;
constexpr int RW_PITCH = 1032, RW_PLANE = 36 * RW_PITCH, RW_LAYER_BYTES = 2 * RW_PLANE * 2;
constexpr int SSM_G_BYTES = 262144, SSM_A2_OFF = 65536;
constexpr int CW_BAR = 4096;
constexpr int CW_CNT = 65536;
constexpr int LDS_BYTES = 160 * 1024, MISC_OFF = LDS_BYTES - 512, AUX_OFF = 128 * 1024, RSCR_OFF = RW_LAYER_BYTES;
constexpr int N_PHASES = 16;

__device__ __forceinline__ int lane_now() { int l; asm volatile("v_mbcnt_lo_u32_b32 %0, -1, 0\n\tv_mbcnt_hi_u32_b32 %0, -1, %0" : "=v"(l)); return l; }
__device__ __forceinline__ unsigned cvt_pk_bf16(float lo, float hi) { unsigned r; asm volatile("v_cvt_pk_bf16_f32 %0, %1, %2" : "=v"(r) : "v"(lo), "v"(hi)); return r; }
typedef float f32x2_t __attribute__((ext_vector_type(2))); typedef __bf16 bf16x2_t __attribute__((ext_vector_type(2)));
__device__ __forceinline__ unsigned cvtpk_s(float lo, float hi) { f32x2_t v = {lo, hi}; bf16x2_t b = __builtin_convertvector(v, bf16x2_t); return __builtin_bit_cast(unsigned, b); }
__device__ __forceinline__ unsigned pk2(float lo, float hi) { return cvtpk_s(lo, hi); }
#define LDS_WAIT() asm volatile("s_waitcnt lgkmcnt(0)" ::: "memory")
#define VM_WAIT() asm volatile("s_waitcnt vmcnt(0)" ::: "memory")
#define RLX_AGENT __ATOMIC_RELAXED, __HIP_MEMORY_SCOPE_AGENT

#define XB_TMO      128
#define XB_XCNT(j)  (256  + 64 * (j))
#define XB_XSUB(j)  (1280 + 64 * (j))
#define XB_XGEN(j)  (2304 + 64 * (j))
#define XB_TOP      3328
#define XB_TOPGEN   3392
#define XCD_BAR_WORDS 3456
#define XB_SPIN_CAP (1u << 18)
__device__ __forceinline__ unsigned xb_ld(unsigned* p)              { return __hip_atomic_load(p, __ATOMIC_RELAXED, __HIP_MEMORY_SCOPE_AGENT); }
__device__ __forceinline__ unsigned xb_add(unsigned* p, unsigned v) { return __hip_atomic_fetch_add(p, v, __ATOMIC_RELAXED, __HIP_MEMORY_SCOPE_AGENT); }
__device__ __forceinline__ unsigned xb_xcc_id() { return (unsigned)__builtin_amdgcn_s_getreg((3 << 11) | 20) & 0xFu; }
#define XB_SPIN(cond, bar) do { unsigned _sp = 0; while (cond) { __builtin_amdgcn_s_sleep(1); \
    if ((++_sp & 255u) == 0u) { if (xb_ld(&(bar)[XB_TMO])) break; if (_sp > XB_SPIN_CAP) { atomicAdd(&(bar)[XB_TMO], 1u); break; } } } } while (0)
struct XcdBarrier { unsigned* bar; unsigned x; volatile LAS unsigned* st; };
__device__ __forceinline__ XcdBarrier xcd_barrier_post(unsigned* bar, volatile LAS unsigned* st, int wid) {
    XcdBarrier b; b.bar = bar; b.x = xb_xcc_id(); b.st = st;
    if (wid == 0 && lane_now() == 0) (void)xb_add(&bar[XB_XCNT(b.x)], 1u);
    return b;
}
__device__ __forceinline__ void xcd_barrier_complete(unsigned* bar, unsigned x, unsigned& nloc, unsigned& nx) {
    const unsigned G = gridDim.x * gridDim.y * gridDim.z;
    unsigned sum, cnt, mine, sp = 0u;
    for (;;) {
        sum = 0u; cnt = 0u; mine = 0u;
#pragma unroll
        for (unsigned j = 0; j < 16; ++j) { const unsigned c = xb_ld(&bar[XB_XCNT(j)]); sum += c; cnt += (c > 0u) ? 1u : 0u; mine = (j == x) ? c : mine; }
        if (sum == G) break;
        __builtin_amdgcn_s_sleep(1);
        if ((++sp & 255u) == 0u) { if (xb_ld(&bar[XB_TMO])) break; if (sp > XB_SPIN_CAP) { atomicAdd(&bar[XB_TMO], 1u); break; } }
    }
    nloc = mine > 0u ? mine : 1u; nx = cnt > 0u ? cnt : 1u;
}
__device__ __forceinline__ void xcd_barrier(const XcdBarrier& b, int wid) {
    asm volatile("s_waitcnt vmcnt(0)" ::: "memory");
    __syncthreads();
    if (wid == 0 && lane_now() == 0) {
        unsigned* bar = b.bar;
        __builtin_amdgcn_s_waitcnt(0);
        unsigned nloc = b.st[0], nx = b.st[1];
        if (nloc == 0u) { xcd_barrier_complete(bar, b.x, nloc, nx); b.st[0] = nloc; b.st[1] = nx; }
        const unsigned old = xb_add(&bar[XB_XSUB(b.x)], 1u);
        const unsigned gen = old / nloc;
        if (old + 1u == (gen + 1u) * nloc) {
            __builtin_amdgcn_fence(__ATOMIC_RELEASE, "agent");
            asm volatile("s_waitcnt vmcnt(0)" ::: "memory");
            (void)xb_add(&bar[XB_TOP], 1u);
        }
        XB_SPIN(xb_ld(&bar[XB_TOP]) < (gen + 1u) * nx, bar);
        __builtin_amdgcn_fence(__ATOMIC_ACQUIRE, "agent");
        asm volatile("s_waitcnt vmcnt(0)" ::: "memory");
    }
    __syncthreads();
}

__device__ __forceinline__ void xcd_arrive(const XcdBarrier& b, int wid) {
    asm volatile("s_waitcnt vmcnt(0)" ::: "memory");
    __syncthreads();
    if (wid == 0 && lane_now() == 0) {
        unsigned* bar = b.bar;
        __builtin_amdgcn_s_waitcnt(0);
        unsigned nloc = b.st[0], nx = b.st[1];
        if (nloc == 0u) { xcd_barrier_complete(bar, b.x, nloc, nx); b.st[0] = nloc; b.st[1] = nx; }
        const unsigned old = xb_add(&bar[XB_XSUB(b.x)], 1u);
        const unsigned gen = old / nloc;
        if (old + 1u == (gen + 1u) * nloc) {
            __builtin_amdgcn_fence(__ATOMIC_RELEASE, "agent");
            asm volatile("s_waitcnt vmcnt(0)" ::: "memory");
            (void)xb_add(&bar[XB_TOP], 1u);
            b.st[3] = 1u;
        } else {
            b.st[3] = 0u;
            asm volatile("buffer_inv sc1" ::: "memory");
        }
        b.st[2] = (gen + 1u) * nx; b.st[4] = gen;
    }
}
__device__ __forceinline__ void xcd_wait(const XcdBarrier& b, int wid) {
    if (wid == 0 && lane_now() == 0) {
        unsigned* bar = b.bar; const unsigned target = b.st[2];
        if (b.st[3]) {
            XB_SPIN(xb_ld(&bar[XB_TOP]) < target, bar);
            __builtin_amdgcn_fence(__ATOMIC_ACQUIRE, "agent");
            asm volatile("s_waitcnt vmcnt(0)" ::: "memory");
            (void)xb_add(&bar[XB_XGEN(b.x)], 1u);
        } else {
            const unsigned gen = b.st[4];
            XB_SPIN(xb_ld(&bar[XB_XGEN(b.x)]) <= gen, bar);
            asm volatile("s_waitcnt vmcnt(0)" ::: "memory");
        }
    }
    __syncthreads();
}

namespace gm {
constexpr int HTB = 16384;
__device__ __forceinline__ int lds_byte(int r, int c) { const int st = (r >> 4) * 2 + (c >> 5), rr = r & 15, cc = c & 31, ob = rr * 64 + cc * 2; return st * 1024 + (ob ^ (((ob >> 9) & 1) << 5)); }
__device__ __forceinline__ void stage_rc(int b, int& R, int& C) { const int st = b / 1024, sb = b % 1024, swz = sb ^ (((sb >> 9) & 1) << 5); R = (st >> 1) * 16 + swz / 64; C = (st & 1) * 32 + (swz % 64) / 2; }
__device__ __forceinline__ int perm32(int rho) { const int n = rho >> 4, i = rho & 15; return 8 * (i >> 2) + 4 * n + (i & 3); }
struct Unit { int pm, pn, e, gt, cnt; };
__device__ __forceinline__ bool static_unit(int i, int G, int c, int nM, int nN, Unit& u) {
    const int nwg = nM * nN; const long L = (long)i * G + c; if (L >= nwg) return false;
    int wgid = (int)L; { const int q = nwg / 8, r = nwg % 8, xcd = wgid % 8, off = wgid / 8; wgid = (xcd < r ? xcd * (q + 1) : r * (q + 1) + (xcd - r) * q) + off; }
    const int nig = 8 * nN, gid = wgid / nig, fm = gid * 8, gsz = (nM - fm) < 8 ? (nM - fm) : 8;
    u.pm = fm + ((wgid % nig) % gsz); u.pn = (wgid % nig) / gsz; u.e = 0; u.gt = 0; u.cnt = 0; return true;
}
template <class P> __device__ __forceinline__ void gemm_phase(LAS unsigned char* lds, const P& ph, int wid) {
    const int lane = lane_now(), tid = wid * 64 + lane, wr = wid >> 2, wc = wid & 3, fr = lane & 15, fq = lane >> 4;
    constexpr int nt = P::K / 64;
    static_assert(nt >= 2 && (nt % 2) == 0, "K must be a multiple of 128");
    unsigned voffA[2], voffB[2];
#pragma unroll
    for (int i = 0; i < 2; ++i) { int R, C; stage_rc(tid * 16 + i * 8192, R, C); const int Rb = (R & ~31) + perm32(R & 31); voffB[i] = (unsigned)(Rb * P::LDB + C) * 2u; voffA[i] = (unsigned)(R * P::LDA + C) * 2u; }
    const unsigned ldsw = (unsigned)wid * 1024u;
    const int aoff = lds_byte(wr * 64 + fr, fq * 8), boff = lds_byte(wc * 32 + fr, fq * 8);
    constexpr int hB = P::HSTEPB, hA = 128 * P::LDA * 2;
#define G_SA(b, h) (((b) * 2 + (h)) * gm::HTB)
#define G_SB(b, h) ((4 + (b) * 2 + (h)) * gm::HTB)
#define G_GLDS(src, bufoff, i) __builtin_amdgcn_global_load_lds((const unsigned*)(src), (LAS unsigned*)(lds + (bufoff) + ldsw + (i) * 8192), 16, 0, 0)
#define G_STA(bufoff, ptr, kb, offs, h) do { if constexpr (P::GATHER) { _Pragma("unroll") for (int _i = 0; _i < 2; ++_i) G_GLDS(Ab + (kb) + (offs)[h][_i], bufoff, _i); } \
        else { _Pragma("unroll") for (int _i = 0; _i < 2; ++_i) G_GLDS((ptr) + (h) * hA + voffA[_i], bufoff, _i); } } while (0)
#define G_STB(bufoff, ptr) do { _Pragma("unroll") for (int _i = 0; _i < 2; ++_i) G_GLDS((ptr) + voffB[_i], bufoff, _i); } while (0)
#define G_LDA(dst, b, h) do { _Pragma("unroll") for (int m = 0; m < 4; ++m) _Pragma("unroll") for (int k = 0; k < 2; ++k) dst[m][k] = *(const LAS bf16x8*)(lds + G_SA(b, h) + aoff + m * 2048 + k * 1024); } while (0)
#define G_LDB(dst, b, h) do { _Pragma("unroll") for (int n = 0; n < 2; ++n) _Pragma("unroll") for (int k = 0; k < 2; ++k) dst[n][k] = *(const LAS bf16x8*)(lds + G_SB(b, h) + boff + n * 2048 + k * 1024); } while (0)
#define G_MMA(ai, bj, At, Bt) do { __builtin_amdgcn_s_setprio(1); _Pragma("unroll") for (int m = 0; m < 4; ++m) _Pragma("unroll") for (int n = 0; n < 2; ++n) _Pragma("unroll") for (int k = 0; k < 2; ++k) \
        acc[ai][bj][m][n] = __builtin_amdgcn_mfma_f32_16x16x32_bf16(Bt[n][k], At[m][k], acc[ai][bj][m][n], 0, 0, 0); __builtin_amdgcn_s_setprio(0); } while (0)
#define G_WAIT_V(n) asm volatile("s_waitcnt vmcnt(" #n ")" ::: "memory")
#define G_WAIT_L(n) asm volatile("s_waitcnt lgkmcnt(" #n ")" ::: "memory")
#define G_BAR __builtin_amdgcn_s_barrier()
#define G_SCHED __builtin_amdgcn_sched_barrier(0)
    Unit cur, nxt; int ui = 0;
    if (!ph.next(0, cur)) return;
    f32x4 acc[2][2][4][2];
#pragma unroll
    for (int a = 0; a < 2; ++a)
#pragma unroll
        for (int b = 0; b < 2; ++b)
#pragma unroll
            for (int m = 0; m < 4; ++m)
#pragma unroll
                for (int n = 0; n < 2; ++n) acc[a][b][m][n] = (f32x4){0.f, 0.f, 0.f, 0.f};
    bf16x8 At[4][2], B0[2][2], B1[2][2];
    unsigned co[2][2] = {{0u, 0u}, {0u, 0u}};
    const char* Ab = ph.Abase;
    const char* cA = Ab; const char* cB = ph.b_tile(cur);
    if constexpr (P::GATHER) { ph.a_offs(cur, tid, co); asm volatile("s_waitcnt vmcnt(0)" ::: "memory"); } else cA = ph.a_tile(cur);
    G_STB(G_SB(0, 0), cB); G_STB(G_SB(0, 1), cB + hB); G_STA(G_SA(0, 0), cA, 0, co, 0); G_STA(G_SA(0, 1), cA, 0, co, 1);
    if (wr == 1) G_BAR;
    G_WAIT_V(2); G_BAR;
    G_STB(G_SB(1, 0), cB + 128); G_STA(G_SA(1, 0), cA + 128, 128, co, 0); G_STB(G_SB(1, 1), cB + hB + 128);
    G_WAIT_V(6); G_BAR;
    for (;;) {
        const bool has_next = ph.next(ui + 1, nxt);
        const char* nA = cA; const char* nB = cB;
        if (has_next) { nB = ph.b_tile(nxt); if constexpr (!P::GATHER) nA = ph.a_tile(nxt); }
        for (int t = 0; t < nt; t += 2) {
            const bool last = (t == nt - 2);
            const int kb1 = (t + 1) * 128, kb2 = last ? 0 : (t + 2) * 128, kb3 = kb2 + 128;
            const char* a1 = cA + kb1; const char* a2 = last ? nA : cA + kb2; const char* a3 = a2 + 128;
            const char* b2 = last ? nB : cB + (t + 2) * 128; const char* b3 = b2 + 128;
            G_LDB(B0, 0, 0); G_LDB(B1, 0, 1); G_SCHED; G_LDA(At, 0, 0); G_STA(G_SA(1, 1), a1, kb1, co, 1);
            G_WAIT_V(8); G_WAIT_L(0); G_BAR; G_MMA(0, 0, At, B0); G_MMA(0, 1, At, B1); G_BAR; G_SCHED;
            if constexpr (P::GATHER) { if (last && has_next) ph.a_offs(nxt, tid, co); }
            G_LDA(At, 0, 1); G_STB(G_SB(0, 0), b2); G_STB(G_SB(0, 1), b2 + hB); G_STA(G_SA(0, 0), a2, kb2, co, 0);
            G_WAIT_V(8); G_WAIT_L(0); G_BAR; G_MMA(1, 0, At, B0); G_MMA(1, 1, At, B1); G_BAR; G_SCHED;
            G_LDB(B0, 1, 0); G_LDB(B1, 1, 1); G_SCHED; G_LDA(At, 1, 0); G_STA(G_SA(0, 1), a2, kb2, co, 1);
            G_WAIT_V(8); G_WAIT_L(0); G_BAR; G_MMA(0, 0, At, B0); G_MMA(0, 1, At, B1); G_BAR; G_SCHED;
            G_LDA(At, 1, 1); G_STB(G_SB(1, 0), b3); G_STB(G_SB(1, 1), b3 + hB); G_STA(G_SA(1, 0), a3, kb3, co, 0);
            G_WAIT_V(8); G_WAIT_L(0); G_BAR; G_MMA(1, 0, At, B0); G_MMA(1, 1, At, B1); G_BAR; G_SCHED;
        }
        if (wr == 0) G_BAR;
        ph.epi(acc, cur, wr, wc, fr, fq);
        if (!has_next) break;
#pragma unroll
        for (int a = 0; a < 2; ++a)
#pragma unroll
            for (int b = 0; b < 2; ++b)
#pragma unroll
                for (int m = 0; m < 4; ++m)
#pragma unroll
                    for (int n = 0; n < 2; ++n) acc[a][b][m][n] = (f32x4){0.f, 0.f, 0.f, 0.f};
        cur = nxt; cA = nA; cB = nB; ++ui;
        if (wr == 1) G_BAR;
    }
    G_WAIT_V(0);
    G_BAR;
}
}

using gm::Unit;
#define EPI_ARGS const f32x4 (&acc)[2][2][4][2], const Unit& u, int wr, int wc, int fr_in, int fq_in
#define EPI_OPAQUE int fr = fr_in, fq = fq_in; asm volatile("" : "+v"(fr), "+v"(fq));
#define NO_GATHER __device__ __forceinline__ void a_offs(const Unit&, int, unsigned (&)[2][2]) const {}
#define EPI_FENCE() asm volatile("" ::: "memory")
__device__ __forceinline__ u32x4 pack8(const f32x4& v0, const f32x4& v1) { u32x4 w; w.x = cvt_pk_bf16(v0[0], v0[1]); w.y = cvt_pk_bf16(v0[2], v0[3]); w.z = cvt_pk_bf16(v1[0], v1[1]); w.w = cvt_pk_bf16(v1[2], v1[3]); return w; }
__device__ __forceinline__ float fast_sigmoid(float v) { return __builtin_amdgcn_rcpf(1.f + __builtin_amdgcn_exp2f(-LOG2E * v)); }
__device__ __forceinline__ float fast_gelu(float v) { const float u2 = 1.5957691216057308f * (v + 0.044715f * v * v * v); return v * fast_sigmoid(u2); }

struct PhQKV {
    static constexpr bool GATHER = false; static constexpr int LDA = 1024, K = 1024, LDB = 1024, HSTEPB = 128 * 1024 * 2;
    unsigned char* ws; const char* Abase; int G, c;
    __device__ __forceinline__ bool next(int i, Unit& u) const { return gm::static_unit(i, G, c, M / 256, 12, u); }
    NO_GATHER __device__ __forceinline__ const char* a_tile(const Unit& u) const { return Abase + (size_t)(u.pm * 256) * 1024 * 2; }
    __device__ __forceinline__ const char* b_tile(const Unit& u) const { return (const char*)(ws + WS_WQKV) + (size_t)u.pn * 256 * 1024 * 2; }
    __device__ __forceinline__ void epi(EPI_ARGS) const { EPI_OPAQUE
        const int row0 = u.pm * 256 + wr * 64 + fr; const int t = u.pn >> 2; const int colt = (u.pn & 3) * 256;
        bf16* base = (bf16*)(ws + WS_Q) + (size_t)t * (16u * 1024u * 1024u); const float sc = (t == 0) ? C2 : 1.f;
        const int col0 = colt + wc * 32 + 8 * fq;
#pragma unroll
        for (int ai = 0; ai < 2; ++ai)
#pragma unroll
            for (int m = 0; m < 4; ++m) { bf16* rowp = base + (size_t)(row0 + ai * 128 + m * 16) * 1024 + col0;
#pragma unroll
                for (int bj = 0; bj < 2; ++bj) *(u32x4*)(rowp + bj * 128) = pack8(acc[ai][bj][m][0] * sc, acc[ai][bj][m][1] * sc); }
    }
};
struct PhWo {
    static constexpr bool GATHER = false; static constexpr int LDA = 1024, K = 1024, LDB = 1024, HSTEPB = 128 * 1024 * 2;
    unsigned char* ws; const char* Abase; const float* resid; float* out; int G, c;
    __device__ __forceinline__ bool next(int i, Unit& u) const { return gm::static_unit(i, G, c, M / 256, 4, u); }
    NO_GATHER __device__ __forceinline__ const char* a_tile(const Unit& u) const { return Abase + (size_t)(u.pm * 256) * 1024 * 2; }
    __device__ __forceinline__ const char* b_tile(const Unit& u) const { return (const char*)(ws + WS_WO) + (size_t)u.pn * 256 * 1024 * 2; }
    __device__ __forceinline__ void epi(EPI_ARGS) const { EPI_OPAQUE
        const size_t off0 = (size_t)(u.pm * 256 + wr * 64 + fr) * 1024 + u.pn * 256 + wc * 32 + 8 * fq; bf16* hb = (bf16*)out;
#pragma unroll
        for (int ai = 0; ai < 2; ++ai) { f32x4 r[4][2][2];
#pragma unroll
            for (int m = 0; m < 4; ++m)
#pragma unroll
                for (int bj = 0; bj < 2; ++bj) { const float* p = resid + off0 + (size_t)(ai * 128 + m * 16) * 1024 + bj * 128; r[m][bj][0] = *(const f32x4*)p; r[m][bj][1] = *(const f32x4*)(p + 4); }
            EPI_FENCE();
#pragma unroll
            for (int m = 0; m < 4; ++m)
#pragma unroll
                for (int bj = 0; bj < 2; ++bj) { const size_t off = off0 + (size_t)(ai * 128 + m * 16) * 1024 + bj * 128; const f32x4 v0 = acc[ai][bj][m][0] + r[m][bj][0], v1 = acc[ai][bj][m][1] + r[m][bj][1];
                    *(u32x4*)(hb + off) = pack8(v0, v1); }
            EPI_FENCE(); }
    }
};
struct PhWout {
    static constexpr bool GATHER = false; static constexpr int LDA = 1024, K = 1024, LDB = 1024, HSTEPB = 128 * 1024 * 2;
    unsigned char* ws; const char* Abase; float* out; int G, c;
    __device__ __forceinline__ bool next(int i, Unit& u) const { return gm::static_unit(i, G, c, M / 256, 8, u); }
    NO_GATHER __device__ __forceinline__ const char* a_tile(const Unit& u) const { return Abase + (size_t)(u.pm * 256) * 1024 * 2; }
    __device__ __forceinline__ const char* b_tile(const Unit& u) const { return (const char*)(ws + WS_WOUT) + (size_t)u.pn * 256 * 1024 * 2; }
    __device__ __forceinline__ void epi(EPI_ARGS) const { EPI_OPAQUE
        const size_t off0 = (size_t)(u.pm * 256 + wr * 64 + fr) * 1024 + u.pn * 128 + wc * 32 + 8 * fq; bf16* hb = (bf16*)(ws + WS_XN); const bf16* rs = (const bf16*)out + (size_t)M * D;
        u32x4 r[2][4];
#pragma unroll
        for (int ai = 0; ai < 2; ++ai)
#pragma unroll
            for (int m = 0; m < 4; ++m) r[ai][m] = *(const u32x4*)(rs + off0 + (size_t)(ai * 128 + m * 16) * 1024);
        EPI_FENCE();
#pragma unroll
        for (int ai = 0; ai < 2; ++ai)
#pragma unroll
            for (int m = 0; m < 4; ++m) { const size_t off = off0 + (size_t)(ai * 128 + m * 16) * 1024; f32x4 v0, v1;
#pragma unroll
                for (int j = 0; j < 4; ++j) { const unsigned w0 = r[ai][m][j >> 1], w1 = r[ai][m][2 + (j >> 1)];
                    const float r0 = __uint_as_float((j & 1) ? (w0 & 0xffff0000u) : (w0 << 16)), r1 = __uint_as_float((j & 1) ? (w1 & 0xffff0000u) : (w1 << 16));
                    v0[j] = r0 + acc[ai][0][m][0][j] * fast_sigmoid(acc[ai][1][m][0][j]); v1[j] = r1 + acc[ai][0][m][1][j] * fast_sigmoid(acc[ai][1][m][1][j]); }
                *(u32x4*)(hb + off) = pack8(v0, v1); }
        EPI_FENCE();
    }
};
constexpr int MT_NN = 65, MT_NS = 66, MT_NLIST = 128, MT_SLIST = 384, SMALL_ROWS = 128;
#ifndef TILE_BUDGET
#define TILE_BUDGET 128
#endif
__device__ __forceinline__ void moe_decode(LAS unsigned char* lds, int code, Unit& u) { const LAS int* cn = (const LAS int*)(lds + AUX_OFF); u.e = code >> 8; u.pm = code & 127; u.gt = __builtin_amdgcn_readfirstlane(cn[32 + u.e]) + u.pm; u.cnt = __builtin_amdgcn_readfirstlane(cn[u.e]); }
__device__ __forceinline__ void moe_tables(LAS unsigned char* lds, const unsigned* cntg, int tid) {
    LAS int* cn = (LAS int*)(lds + AUX_OFF); LAS int* tb = cn + 32;
    if (tid < 64) {
        const int e = tid & 31; const unsigned cu = __hip_atomic_load(cntg + e * 64, RLX_AGENT); const int c = cu < (unsigned)CAP ? (int)cu : CAP;
        const int n = (c + 255) >> 8, full = c >> 8, rem = c & 255;
        int sfull = full;
#pragma unroll
        for (int o = 1; o < 32; o <<= 1) sfull += __shfl_xor(sfull, o, 32);
        const int budget = TILE_BUDGET - sfull; int rank = 0;
#pragma unroll 8
        for (int o = 0; o < 32; ++o) { const int r = __shfl(rem, o, 32); rank += (r > rem || (r == rem && o < e)) ? 1 : 0; }
        const bool prom = rem > 0 && rank < budget;
        const int nnorm = full + (prom ? 1 : 0), small = prom ? 0 : (rem > SMALL_ROWS ? 2 : (rem > 0 ? 1 : 0));
        int pt = n, pn_ = nnorm, ps_ = small;
#pragma unroll
        for (int o = 1; o < 32; o <<= 1) { const int a = __shfl_up(pt, o, 32), b = __shfl_up(pn_, o, 32), d = __shfl_up(ps_, o, 32); if (e >= o) { pt += a; pn_ += b; ps_ += d; } }
        if (tid < 32) { cn[e] = c; tb[e] = pt - n;
            for (int pm = 0; pm < nnorm; ++pm) cn[MT_NLIST + (pn_ - nnorm) + pm] = (e << 8) | pm;
            for (int hf = 0; hf < small; ++hf) cn[MT_SLIST + (ps_ - small) + hf] = (e << 8) | (hf << 7) | (n - 1);
            if (e == 31) { tb[32] = pt; cn[MT_NN] = pn_; cn[MT_NS] = ps_; } }
    }
    __syncthreads();
}
template <bool GU> __device__ __forceinline__ void tail_job(unsigned char* ws, const bf16* __restrict__ Xbase, const Unit& u, int ns, int wid, LAS unsigned char* lds) {
    const int lane = lane_now(), fr = lane & 15, fq = lane >> 4, w = wid, tid_ = wid * 64 + lane;
    constexpr int K = GU ? 1024 : 256, NG = GU ? 2 : 4;
    constexpr int PITCH = K * 2 + 16;
    constexpr int CH = K / 8, NCH = 16 * NG * CH / NTHR;
    constexpr int NKS = K / 32, NPRE = NKS < 16 ? NKS : 16;
    const int slot0 = u.pm * 256 + u.pn * 128, rows = u.cnt - slot0;
    const bool active = 16 * w < rows;
    int r = 16 * w + fr; const bool valid = r < rows; r = valid ? r : rows - 1; r = r < 0 ? 0 : r;
    const int dst = active ? ((const int*)(ws + WS_PDST))[u.e * CAP + slot0 + r] : 0;
    u32x4 st[NCH];
#pragma unroll
    for (int i = 0; i < NCH; ++i) { const int ci = tid_ + i * NTHR, row = ci / CH, ch = ci % CH;
        const bf16* src = GU ? (const bf16*)(ws + WS_WGU) + ((size_t)u.e * 512 + 256 * (ns >> 3) + 128 * (row >> 4) + 16 * (ns & 7) + (row & 15)) * 1024 + ch * 8
                             : (const bf16*)(ws + WS_WD) + ((size_t)u.e * 1024 + 64 * ns + row) * 256 + ch * 8;
        st[i] = *(const u32x4*)src; }
    const bf16* xp = (GU ? Xbase + (size_t)(dst >> 1) * 1024 : Xbase + ((size_t)u.gt * 256 + u.pn * 128 + r) * 256) + 8 * fq;
    bf16x8 xa[NPRE];
    if (active) {
#pragma unroll
        for (int ks = 0; ks < NPRE; ++ks) xa[ks] = *(const bf16x8*)(xp + 32 * ks); }
    __syncthreads();
#pragma unroll
    for (int i = 0; i < NCH; ++i) { const int ci = tid_ + i * NTHR, row = ci / CH, ch = ci % CH; *(LAS u32x4*)(lds + row * PITCH + ch * 16) = st[i]; }
    __syncthreads();
    if (!active) return;
    const LAS unsigned char* wl = lds + fr * PITCH + fq * 16;
    f32x4 acc[NG];
#pragma unroll
    for (int n = 0; n < NG; ++n) acc[n] = (f32x4){0.f, 0.f, 0.f, 0.f};
    bf16x8 xb[NKS - NPRE > 0 ? NKS - NPRE : 1];
    if (NKS > NPRE) {
#pragma unroll
        for (int ks = NPRE; ks < NKS; ++ks) xb[ks - NPRE] = *(const bf16x8*)(xp + 32 * ks); }
#pragma unroll
    for (int ks = 0; ks < NKS; ++ks) { const bf16x8 xf = ks < NPRE ? xa[ks < NPRE ? ks : 0] : xb[ks >= NPRE ? ks - NPRE : 0]; bf16x8 wf[NG];
#pragma unroll
        for (int n = 0; n < NG; ++n) wf[n] = *(const LAS bf16x8*)(wl + n * 16 * PITCH + ks * 64);
#pragma unroll
        for (int n = 0; n < NG; ++n) acc[n] = __builtin_amdgcn_mfma_f32_16x16x32_bf16(wf[n], xf, acc[n], 0, 0, 0); }
    if (valid) {
        if (GU) { const float sc = ((const float*)(ws + WS_PS))[u.e * CAP + slot0 + r]; float v[4];
#pragma unroll
            for (int j = 0; j < 4; ++j) { const float gg = acc[0][j] * sc, uu = acc[NG - 1][j] * sc; v[j] = gg * fast_sigmoid(gg) * uu; }
            u32x2 o; o.x = cvt_pk_bf16(v[0], v[1]); o.y = cvt_pk_bf16(v[2], v[3]);
            *(u32x2*)((bf16*)(ws + WS_H) + ((size_t)u.gt * 256 + u.pn * 128 + r) * 256 + 16 * ns + 4 * fq) = o; }
        else { const float wt = ((const float*)(ws + WS_PW))[u.e * CAP + slot0 + r];
#pragma unroll
            for (int n = 0; n < NG; ++n) { u32x2 o; o.x = cvt_pk_bf16(acc[n][0] * wt, acc[n][1] * wt); o.y = cvt_pk_bf16(acc[n][2] * wt, acc[n][3] * wt);
                *(u32x2*)((bf16*)(ws + WS_Y2) + (size_t)dst * 1024 + 64 * ns + 16 * n + 4 * fq) = o; } } }
}
struct PhGateUp {
    static constexpr bool GATHER = true; static constexpr int LDA = 1024, K = 1024, LDB = 1024, HSTEPB = 128 * 1024 * 2;
    unsigned char* ws; const char* Abase; LAS unsigned char* lds; int G, c, nn;
    __device__ __forceinline__ bool next(int i, Unit& u) const { const int idx = i * G + c; if (idx >= 2 * nn) return false; u.pn = idx & 1; moe_decode(lds, ((const LAS int*)(lds + AUX_OFF))[MT_NLIST + (idx >> 1)], u); return true; }
    __device__ __forceinline__ void a_offs(const Unit& u, int tid, unsigned (&o)[2][2]) const { const int* pdst = (const int*)(ws + WS_PDST);
#pragma unroll
        for (int i = 0; i < 2; ++i) { int R, C; gm::stage_rc(tid * 16 + i * 8192, R, C);
#pragma unroll
            for (int h = 0; h < 2; ++h) { int slot = u.pm * 256 + 128 * h + R; slot = slot < u.cnt ? slot : u.cnt - 1; const int tok = pdst[u.e * CAP + slot] >> 1; o[h][i] = (unsigned)(tok * 1024 + C) * 2u; } }
    }
    __device__ __forceinline__ const char* a_tile(const Unit&) const { return Abase; }
    __device__ __forceinline__ const char* b_tile(const Unit& u) const { return (const char*)(ws + WS_WGU) + ((size_t)u.e * 512 + u.pn * 256) * 1024 * 2; }
    __device__ __forceinline__ void epi(EPI_ARGS) const { EPI_OPAQUE
        const int r0 = wr * 64 + fr, col0 = u.pn * 128 + wc * 32 + 8 * fq; const float* ps = (const float*)(ws + WS_PS) + u.e * CAP; bf16* H = (bf16*)(ws + WS_H);
        float sv[2][4];
#pragma unroll
        for (int ai = 0; ai < 2; ++ai)
#pragma unroll
            for (int m = 0; m < 4; ++m) { int slot = u.pm * 256 + r0 + ai * 128 + m * 16; slot = slot < u.cnt ? slot : u.cnt - 1; sv[ai][m] = ps[slot]; }
        EPI_FENCE();
#pragma unroll
        for (int ai = 0; ai < 2; ++ai)
#pragma unroll
            for (int m = 0; m < 4; ++m) { const int r = r0 + ai * 128 + m * 16; const float s = sv[ai][m];
                f32x4 v0, v1;
#pragma unroll
                for (int j = 0; j < 4; ++j) { const float g0 = acc[ai][0][m][0][j] * s, u0 = acc[ai][1][m][0][j] * s, g1 = acc[ai][0][m][1][j] * s, u1 = acc[ai][1][m][1][j] * s;
                    v0[j] = g0 * fast_sigmoid(g0) * u0; v1[j] = g1 * fast_sigmoid(g1) * u1; }
                *(u32x4*)(H + ((size_t)u.gt * 256 + r) * 256 + col0) = pack8(v0, v1); }
        EPI_FENCE();
    }
};
struct PhDown {
    static constexpr bool GATHER = false; static constexpr int LDA = 256, K = 256, LDB = 256, HSTEPB = 128 * 256 * 2;
    unsigned char* ws; const char* Abase; LAS unsigned char* lds; int G, c, nn;
    __device__ __forceinline__ bool next(int i, Unit& u) const { const int idx = i * G + c; if (idx >= 4 * nn) return false; u.pn = idx & 3; moe_decode(lds, ((const LAS int*)(lds + AUX_OFF))[MT_NLIST + (idx >> 2)], u); return true; }
    NO_GATHER __device__ __forceinline__ const char* a_tile(const Unit& u) const { return Abase + (size_t)(u.gt * 256) * 256 * 2; }
    __device__ __forceinline__ const char* b_tile(const Unit& u) const { return (const char*)(ws + WS_WD) + ((size_t)u.e * 1024 + u.pn * 256) * 256 * 2; }
    __device__ __forceinline__ void epi(EPI_ARGS) const { EPI_OPAQUE
        const int r0 = u.pm * 256 + wr * 64 + fr, col0 = u.pn * 256 + wc * 32 + 8 * fq; const int* pdst = (const int*)(ws + WS_PDST) + u.e * CAP; const float* pw = (const float*)(ws + WS_PW) + u.e * CAP; bf16* Y2 = (bf16*)(ws + WS_Y2);
        int slot = r0 < u.cnt ? r0 : u.cnt - 1; int dn = pdst[slot]; float wn = pw[slot];
#pragma unroll
        for (int g = 0; g < 8; ++g) { const int ai = g >> 2, m = g & 3; const int dcur = dn; const float wcur = wn;
            if (g < 7) { int s2 = r0 + ((g + 1) >> 2) * 128 + ((g + 1) & 3) * 16; s2 = s2 < u.cnt ? s2 : u.cnt - 1; dn = pdst[s2]; wn = pw[s2]; }
            if (r0 + ai * 128 + m * 16 < u.cnt) { bf16* yp = Y2 + (size_t)dcur * 1024 + col0;
#pragma unroll
                for (int bj = 0; bj < 2; ++bj) *(u32x4*)(yp + bj * 128) = pack8(acc[ai][bj][m][0] * wcur, acc[ai][bj][m][1] * wcur); }
            EPI_FENCE(); }
    }
};
struct PhSloc {
    static constexpr bool GATHER = false; static constexpr int LDA = 384, K = 256, LDB = 256, HSTEPB = 0;
    unsigned char* ws; const char* Abase; int G, c;
    __device__ __forceinline__ bool next(int i, Unit& u) const { const int idx = i * G + c; if (idx >= 256) return false; u.e = idx >> 2; u.pm = idx & 3; u.pn = 0; u.gt = 0; u.cnt = 0; return true; }
    NO_GATHER __device__ __forceinline__ const char* a_tile(const Unit& u) const { return Abase + (size_t)(u.e * 1024 + u.pm * 256) * 384 * 2; }
    __device__ __forceinline__ const char* b_tile(const Unit& u) const { return (const char*)(ws + WS_SSM) + (size_t)u.e * SSM_G_BYTES; }
    __device__ __forceinline__ void epi(EPI_ARGS) const { EPI_OPAQUE
        const int r0 = u.e * 1024 + u.pm * 256 + wr * 64 + fr, col0 = wc * 32 + 8 * fq; float* Sloc = (float*)(ws + WS_SLOC);
#pragma unroll
        for (int ai = 0; ai < 2; ++ai)
#pragma unroll
            for (int m = 0; m < 4; ++m) { float* p = Sloc + (size_t)(r0 + ai * 128 + m * 16) * 128 + col0; *(f32x4*)p = acc[ai][0][m][0]; *(f32x4*)(p + 4) = acc[ai][0][m][1]; }
    }
};
struct PhY {
    static constexpr bool GATHER = false; static constexpr int LDA = 384, K = 384, LDB = 384, HSTEPB = 128 * 384 * 2;
    unsigned char* ws; const char* Abase; int G, c;
    __device__ __forceinline__ bool next(int i, Unit& u) const { const int idx = i * G + c; if (idx >= 256) return false; u.e = idx >> 2; u.pm = idx & 3; u.pn = 0; u.gt = 0; u.cnt = 0; return true; }
    NO_GATHER __device__ __forceinline__ const char* a_tile(const Unit& u) const { return Abase + (size_t)(u.e * 1024 + u.pm * 256) * 384 * 2; }
    __device__ __forceinline__ const char* b_tile(const Unit& u) const { return (const char*)(ws + WS_SSM) + (size_t)u.e * SSM_G_BYTES + SSM_A2_OFF; }
    __device__ __forceinline__ void epi(EPI_ARGS) const { EPI_OPAQUE
        const int nb = (u.pm & 1) * 256 + wr * 64 + fr;
        bf16* p = (bf16*)(ws + WS_G) + ((size_t)(u.pm >> 1) * SEQ + 16 * nb + 2 * wc + (fq >> 1)) * 1024 + 16 * u.e + 8 * (fq & 1);
#pragma unroll
        for (int ai = 0; ai < 2; ++ai)
#pragma unroll
            for (int m = 0; m < 4; ++m) {
#pragma unroll
                for (int bj = 0; bj < 2; ++bj) { f32x4 v0, v1;
#pragma unroll
                    for (int j = 0; j < 4; ++j) { v0[j] = fast_gelu(acc[ai][bj][m][0][j]); v1[j] = fast_gelu(acc[ai][bj][m][1][j]); }
                    *(u32x4*)(p + bj * 8 * 1024) = pack8(v0, v1); }
                p += (m == 3 ? (128 - 48) : 16) * 16 * 1024; asm volatile("" : "+v"(p) :: "memory"); }
    }
};

namespace at {
constexpr int NSLOT = 4, SLOTB = 8192;
constexpr int LDS_K = 0, LDS_V = NSLOT * SLOTB, LDS_WS = 2 * NSLOT * SLOTB, LDS_TBL = LDS_WS + 2048, LDS_OST = LDS_TBL + 2048, LDS_TOTAL = LDS_OST + 8 * 4096;
typedef short v4i16_t __attribute__((ext_vector_type(4)));
__device__ __forceinline__ int crow(int r, int hi) { return (r & 3) + 8 * (r >> 2) + 4 * hi; }
__device__ __forceinline__ void glds16(const void* gsrc, unsigned lds_dst) { unsigned keep;
    asm volatile("s_mov_b32 %0, m0\n\ts_mov_b32 m0, %2\n\ts_nop 0\n\tglobal_load_lds_dwordx4 %1, off\n\ts_mov_b32 m0, %0" : "=&s"(keep) : "v"(gsrc), "s"(lds_dst) : "memory"); }
__device__ __forceinline__ s16x4 vtr(const LAS unsigned char* p) { return __builtin_bit_cast(s16x4, __builtin_amdgcn_ds_read_tr16_b64_v4i16((LAS v4i16_t*)p)); }
#define AT_WAIT_BAR(N) asm volatile("s_waitcnt vmcnt(" #N ") lgkmcnt(0)\n\ts_barrier" ::: "memory")
template <int THR> __device__ __forceinline__ void attn_unit(int b, int h, int qb, const bf16* Q, const bf16* __restrict__ K, const bf16* __restrict__ V, bf16* O, const float* __restrict__ relb, LAS unsigned char* shm, int wid) {
    const int lane = lane_now(), tid = wid * 64 + lane, r32 = lane & 31, hi = lane >> 5;
    const long rowbase = (long)b * SEQ; const int q0 = qb * 256; const int cq = 4 * qb + (wid >> 1);
    const bf16* Qw = Q + (rowbase + q0 + wid * 32) * D + h * 64;
    const unsigned lds0 = (unsigned)(uintptr_t)shm;
    LAS float* wsf = (LAS float*)(shm + LDS_WS) + wid * 64; LAS float* tbl = (LAS float*)(shm + LDS_TBL);
    const int kc_lo = (4 * qb - 8) < 0 ? 0 : (4 * qb - 8); const int NT = 4 * qb + 3 - kc_lo + 1;
    const int ta = ((cq - 8) < kc_lo ? kc_lo : (cq - 8)) - kc_lo, tb_ = cq - kc_lo;
    if (tid < 320) tbl[tid] = relb[h * NREL + (tid < 256 ? tid : 256)] * LOG2E;
    const bf16* ksrc = K + (rowbase + kc_lo * 64 + lane) * D + h * 64 + wid * 8;
    const bf16* vsrc = V + (rowbase + kc_lo * 64 + 16 * (wid & 3) + (lane >> 2)) * D + h * 64 + (wid >> 2) * 32 + (lane & 3) * 8;
    const unsigned kdst = lds0 + LDS_K + wid * 1024, vdst = lds0 + LDS_V + wid * 1024;
#define AT_DMA(t) do { const unsigned so_ = (unsigned)((t) & 3) * SLOTB; glds16(ksrc + (long)(t) * 64 * D, (unsigned)__builtin_amdgcn_readfirstlane(kdst + so_)); glds16(vsrc + (long)(t) * 64 * D, (unsigned)__builtin_amdgcn_readfirstlane(vdst + so_)); } while (0)
    bf16x8 qr[4];
#pragma unroll
    for (int d0 = 0; d0 < 4; ++d0) qr[d0] = *reinterpret_cast<const bf16x8*>(&Qw[(long)r32 * D + d0 * 16 + hi * 8]);
    AT_DMA(0); AT_DMA(1); AT_DMA(2);
    asm volatile("" : "+v"(qr[0]), "+v"(qr[1]), "+v"(qr[2]), "+v"(qr[3]));
    float mrow = -1e30f, lsum = 0.f; f32x16 o[2]; o[0] = f32x16{}; o[1] = f32x16{};
    f32x16 s0 = f32x16{}, s1 = f32x16{};
    f32x16 cfar = f32x16{};
    const int qoff = 32 * (wid & 1) + r32 + 128 - 4 * hi;
#define AT_CINIT(P0, P1, kc_, msub_) do { const int delta_ = cq - (kc_); \
        if (delta_ >= 3) { P0 = cfar; P1 = cfar; } \
        else { const LAS float* tb = tbl + (64 * delta_ + qoff); _Pragma("unroll") for (int r = 0; r < 16; ++r) { const int kj = (r & 3) + 8 * (r >> 2); P0[r] = tb[-kj] - (msub_); P1[r] = tb[-kj - 32] - (msub_); } } } while (0)
#define AT_KLOAD(t_) do { const LAS unsigned char* kp = shm + LDS_K + ((t_) & 3) * SLOTB + hi * 1024 + r32 * 16; \
        _Pragma("unroll") for (int d0 = 0; d0 < 4; ++d0) { kf[2 * d0] = *(const LAS bf16x8*)(kp + d0 * 2048); kf[2 * d0 + 1] = *(const LAS bf16x8*)(kp + d0 * 2048 + 512); } } while (0)
#define AT_QK(P0, P1) do { _Pragma("unroll") for (int d0 = 0; d0 < 4; ++d0) { \
            P0 = __builtin_amdgcn_mfma_f32_32x32x16_bf16(kf[2 * d0], qr[d0], P0, 0, 0, 0); P1 = __builtin_amdgcn_mfma_f32_32x32x16_bf16(kf[2 * d0 + 1], qr[d0], P1, 0, 0, 0); } } while (0)
#define AT_CFAR() do { const float c0_ = tbl[256] - mrow; _Pragma("unroll") for (int r = 0; r < 16; ++r) cfar[r] = c0_; } while (0)
#define AT_STATS() do { float ra = fmaxf(fmaxf(s0[0], s0[1]), s1[0]), rb2 = fmaxf(fmaxf(s0[2], s0[3]), s1[1]); ra = fmaxf(fmaxf(ra, s1[2]), s1[3]); \
        _Pragma("unroll") for (int r = 4; r < 16; r += 4) { ra = fmaxf(fmaxf(ra, s0[r]), s0[r + 1]); rb2 = fmaxf(fmaxf(rb2, s0[r + 2]), s0[r + 3]); ra = fmaxf(fmaxf(ra, s1[r]), s1[r + 1]); rb2 = fmaxf(fmaxf(rb2, s1[r + 2]), s1[r + 3]); } \
        float rm = fmaxf(ra, rb2); { auto rr = __builtin_amdgcn_permlane32_swap(__float_as_uint(rm), __float_as_uint(rm), false, false); rm = fmaxf(__uint_as_float(rr[0]), __uint_as_float(rr[1])); } \
        if (mrow < -1e29f) { mrow = rm; _Pragma("unroll") for (int r = 0; r < 16; ++r) { s0[r] -= rm; s1[r] -= rm; } AT_CFAR(); } \
        else if (__any(rm > (float)THR)) { const float dl = fmaxf(rm, 0.f), f = __builtin_amdgcn_exp2f(-dl); mrow += dl; lsum *= f; \
            if (hi == 0) wsf[r32] = f; LDS_WAIT(); \
            _Pragma("unroll") for (int r = 0; r < 16; ++r) { const float fr_ = wsf[crow(r, hi)]; o[0][r] *= fr_; o[1][r] *= fr_; s0[r] -= dl; s1[r] -= dl; } AT_CFAR(); } } while (0)
#define AT_EXP_PACK() float sacc = 0.f, sacc2 = 0.f; \
        _Pragma("unroll") for (int r = 0; r < 16; ++r) { s0[r] = __builtin_amdgcn_exp2f(s0[r]); s1[r] = __builtin_amdgcn_exp2f(s1[r]); sacc += s0[r]; sacc2 += s1[r]; } \
        lsum += sacc + sacc2; \
        const u32x4 pw0 = (u32x4){cvtpk_s(s0[0], s0[1]), cvtpk_s(s0[2], s0[3]), cvtpk_s(s0[4], s0[5]), cvtpk_s(s0[6], s0[7])}; \
        const u32x4 pw1 = (u32x4){cvtpk_s(s0[8], s0[9]), cvtpk_s(s0[10], s0[11]), cvtpk_s(s0[12], s0[13]), cvtpk_s(s0[14], s0[15])}; \
        const u32x4 pw2 = (u32x4){cvtpk_s(s1[0], s1[1]), cvtpk_s(s1[2], s1[3]), cvtpk_s(s1[4], s1[5]), cvtpk_s(s1[6], s1[7])}; \
        const u32x4 pw3 = (u32x4){cvtpk_s(s1[8], s1[9]), cvtpk_s(s1[10], s1[11]), cvtpk_s(s1[12], s1[13]), cvtpk_s(s1[14], s1[15])}; \
        const bf16x8 pa[4] = {__builtin_bit_cast(bf16x8, pw0), __builtin_bit_cast(bf16x8, pw1), __builtin_bit_cast(bf16x8, pw2), __builtin_bit_cast(bf16x8, pw3)};
#define AT_VLOAD(t_) do { const LAS unsigned char* vp = shm + LDS_V + ((t_) & 3) * SLOTB + ((lane >> 4) & 1) * 32 + (lane & 3) * 8 + (4 * hi + ((lane & 15) >> 2)) * 64; \
        _Pragma("unroll") for (int d0 = 0; d0 < 2; ++d0) _Pragma("unroll") for (int ks = 0; ks < 4; ++ks) { vlo[d0 * 4 + ks] = vtr(vp + d0 * 4096 + ks * 1024); vhi[d0 * 4 + ks] = vtr(vp + d0 * 4096 + ks * 1024 + 512); } } while (0)
#define AT_PV() do { _Pragma("unroll") for (int d0 = 0; d0 < 2; ++d0) _Pragma("unroll") for (int ks = 0; ks < 4; ++ks) { const s16x4 lo = vlo[d0 * 4 + ks], hh = vhi[d0 * 4 + ks]; \
            const bf16x8 vf = (bf16x8){lo[0], lo[1], lo[2], lo[3], hh[0], hh[1], hh[2], hh[3]}; o[d0] = __builtin_amdgcn_mfma_f32_32x32x16_bf16(pa[ks], vf, o[d0], 0, 0, 0); } } while (0)
    bf16x8 kf[8]; s16x4 vlo[8], vhi[8];
    for (int t = 0; t < NT; ++t) {
        if (t + 2 < NT) { AT_WAIT_BAR(4); } else if (t + 1 < NT) { AT_WAIT_BAR(2); } else { AT_WAIT_BAR(0); }
        if (t + 3 < NT) AT_DMA(t + 3);
        if (t >= ta && t <= tb_) {
            AT_KLOAD(t); AT_VLOAD(t);
            __builtin_amdgcn_sched_barrier(0);
            if (mrow < -1e29f) { const float c0_ = tbl[256]; _Pragma("unroll") for (int r = 0; r < 16; ++r) cfar[r] = c0_; }
            AT_CINIT(s0, s1, kc_lo + t, (mrow < -1e29f ? 0.f : mrow));
            AT_QK(s0, s1);
            AT_STATS();
            AT_EXP_PACK()
            AT_PV();
        }
    }
    { auto rr = __builtin_amdgcn_permlane32_swap(__float_as_uint(lsum), __float_as_uint(lsum), false, false); lsum = __uint_as_float(rr[0]) + __uint_as_float(rr[1]); }
    if (hi == 0) wsf[32 + r32] = lsum;
    LDS_WAIT();
    float rli[16];
#pragma unroll
    for (int r = 0; r < 16; ++r) rli[r] = __builtin_amdgcn_rcpf(wsf[32 + crow(r, hi)]);
    bf16* Ow = O + (rowbase + q0 + wid * 32) * D + h * 64;
    { LAS bf16* stg = (LAS bf16*)(shm + LDS_OST) + wid * 2048;
#pragma unroll
      for (int r = 0; r < 16; ++r) { const int orow = crow(r, hi);
#pragma unroll
          for (int d0 = 0; d0 < 2; ++d0) stg[orow * 64 + d0 * 32 + r32] = f2bf(o[d0][r] * rli[r]); }
      LDS_WAIT();
#pragma unroll
      for (int i = 0; i < 4; ++i) { const int row = i * 8 + (lane >> 3), ch = lane & 7; const u32x4 v = *(const LAS u32x4*)(stg + row * 64 + ch * 8); *(u32x4*)(Ow + (long)row * D + ch * 8) = v; } }
    asm volatile("s_waitcnt lgkmcnt(0)\n\ts_barrier" ::: "memory");
#undef AT_DMA
#undef AT_CINIT
#undef AT_QK
#undef AT_KLOAD
#undef AT_VLOAD
#undef AT_CFAR
#undef AT_STATS
#undef AT_EXP_PACK
#undef AT_PV
}
}

struct Args { const float* in[23]; float* out; unsigned char* ws; int ph_lo, ph_hi, li, pad; };

struct TrDesc { const float* W; bf16* WT; const float* ks; int ldw, k0, n0, ldt, drow0; };
__device__ __forceinline__ void tr_load(const TrDesc& d, float (&v)[32], int lane) {
    const float* wp = d.W + (size_t)(d.k0 + (lane >> 5)) * d.ldw + d.n0 + (lane & 31);
#pragma unroll
    for (int i = 0; i < 32; ++i) v[i] = wp[(size_t)(2 * i) * d.ldw];
}
__device__ __forceinline__ void tr_store(const TrDesc& d, float (&v)[32], LAS float* scr, int lane) {
    if (d.ks) {
#pragma unroll
        for (int i = 0; i < 32; ++i) v[i] *= d.ks[d.k0 + 2 * i + (lane >> 5)]; }
#pragma unroll
    for (int i = 0; i < 32; ++i) scr[(2 * i + (lane >> 5)) * 33 + (lane & 31)] = v[i];
    LDS_WAIT(); asm volatile("" ::: "memory");
    const int c = lane & 7;
#pragma unroll
    for (int j = 0; j < 4; ++j) { const int n = (lane >> 3) + 8 * j; const LAS float* s = scr + (8 * c) * 33 + n;
        u32x4 o; o.x = pk2(s[0 * 33], s[1 * 33]); o.y = pk2(s[2 * 33], s[3 * 33]); o.z = pk2(s[4 * 33], s[5 * 33]); o.w = pk2(s[6 * 33], s[7 * 33]);
        *(u32x4*)(d.WT + (size_t)(d.drow0 + n) * d.ldt + d.k0 + 8 * c) = o; }
    LDS_WAIT(); asm volatile("" ::: "memory");
}
struct TrSrc { const float* w_qkv; const float* w_o; const float* w_out; const float* wg; const float* wu; const float* wd; const float* gn; unsigned char* ws; int nd, first, last; };
__device__ __forceinline__ TrDesc tr_desc(const TrSrc& S, int it) {
    TrDesc d; d.ks = nullptr;
    if (it < S.nd) {
        if (it < 1536) { const int kb = it / 96, nb = it % 96; d.W = S.w_qkv; d.ldw = 3072; d.k0 = kb * 64; d.n0 = nb * 32; d.WT = (bf16*)(S.ws + WS_WQKV); d.ldt = 1024; d.drow0 = nb * 32; }
        else if (it < 2048) { const int r = it - 1536, kb = r >> 5, nb = r & 31; d.W = S.w_o; d.ldw = 1024; d.k0 = kb * 64; d.n0 = nb * 32; d.WT = (bf16*)(S.ws + WS_WO); d.ldt = 1024; d.drow0 = nb * 32; }
        else { const int r = it - 2048, kb = r >> 6, nb = r & 63, n0 = nb * 32, ag = n0 >> 10, cc = n0 & 1023; d.W = S.w_out; d.ldw = 2048; d.k0 = kb * 64; d.n0 = n0; d.WT = (bf16*)(S.ws + WS_WOUT); d.ldt = 1024; d.drow0 = 256 * (cc >> 7) + 128 * ag + (cc & 127); }
    } else { const int m = it - S.nd;
        if (m < 8192) { const int which = m >> 12, r = m & 4095, e = r >> 7, kb = (r >> 3) & 15, nb = r & 7, n0 = nb * 32;
            d.W = (which ? S.wu : S.wg) + (size_t)e * 1024 * 256; d.ldw = 256; d.k0 = kb * 64; d.n0 = n0; d.WT = (bf16*)(S.ws + WS_WGU); d.ldt = 1024; d.drow0 = e * 512 + 256 * (n0 >> 7) + 128 * which + (n0 & 127); d.ks = S.gn; }
        else { const int r = m - 8192, e = r >> 7, kb = (r >> 5) & 3, nb = r & 31; d.W = S.wd + (size_t)e * 256 * 1024; d.ldw = 1024; d.k0 = kb * 64; d.n0 = nb * 32; d.WT = (bf16*)(S.ws + WS_WD); d.ldt = 256; d.drow0 = e * 1024 + nb * 32; } }
    return d;
}
__device__ __forceinline__ TrSrc mk_trsrc(const float* a, const float* b, const float* c, const float* g, const float* u, const float* d, const float* gn, unsigned char* ws, int nd, int first, int last) { TrSrc S; S.w_qkv = a; S.w_o = b; S.w_out = c; S.wg = g; S.wu = u; S.wd = d; S.gn = gn; S.ws = ws; S.nd = nd; S.first = first; S.last = last; return S; }
__device__ __forceinline__ void tr_stream(const TrSrc& S, LAS float* scr, int gw, int NGW, int lane) {
    const int N = S.last; int it = S.first + gw; if (it >= N) return;
    float va[32], vb[32]; TrDesc d0 = tr_desc(S, it), d1 = d0; tr_load(d0, va, lane);
    for (;;) {
        int nx = it + NGW; if (nx < N) { d1 = tr_desc(S, nx); tr_load(d1, vb, lane); }
        tr_store(d0, va, scr, lane); it = nx; if (it >= N) break;
        nx = it + NGW; if (nx < N) { d0 = tr_desc(S, nx); tr_load(d0, va, lane); }
        tr_store(d1, vb, scr, lane); it = nx; if (it >= N) break;
    }
}
__device__ __forceinline__ void ssm_mats(int g, int q, const float* lre, const float* lim, const float* lstep, const float* bre, const float* bim, const float* cre, const float* cim, const float* dsk,
                                         unsigned char* ssm_ws, float* a16g, LAS float* L, int tid) {
    LAS float* pwr = L; LAS float* pwi = L + 64 * 17; LAS float* bbr = L + 2 * 64 * 17; LAS float* bbi = bbr + 1024; LAS float* ccr = bbi + 1024; LAS float* cci = ccr + 1024; LAS float* Kt = cci + 1024;
    if (tid < 64) { const int p = tid;
        const float lr = fminf(lre[g * 64 + p], -1e-4f), li = lim[g * 64 + p], step = expf(lstep[g]);
        const float decay = expf(lr * step), ang = li * step, ar = decay * cosf(ang), ai = decay * sinf(ang);
        const float den = lr * lr + li * li, nr = ar - 1.f, fr = (nr * lr + ai * li) / den, fi = (ai * lr - nr * li) / den;
        for (int c = 0; c < 16; ++c) { const float br = bre[(g * 64 + p) * 16 + c], bi = bim[(g * 64 + p) * 16 + c]; bbr[p * 16 + c] = fr * br - fi * bi; bbi[p * 16 + c] = fr * bi + fi * br;
            ccr[c * 64 + p] = cre[(g * 16 + c) * 64 + p]; cci[c * 64 + p] = cim[(g * 16 + c) * 64 + p]; }
        float xr = 1.f, xi = 0.f;
        for (int n = 0; n <= 16; ++n) { pwr[p * 17 + n] = xr; pwi[p * 17 + n] = xi; const float t = xr * ar - xi * ai; xi = xr * ai + xi * ar; xr = t; }
        if (q == 0) { a16g[(g * 64 + p) * 2] = pwr[p * 17 + 16]; a16g[(g * 64 + p) * 2 + 1] = pwi[p * 17 + 16]; }
    }
    __syncthreads();
    if (tid < 256) { const int tl = tid >> 6, c = (tid >> 2) & 15, cq = tid & 3, tau = 4 * q + tl;
        float s0 = 0.f, s1 = 0.f, s2 = 0.f, s3 = 0.f;
        for (int p = 0; p < 64; ++p) { const float cr = ccr[c * 64 + p], ci = cci[c * 64 + p], ar = pwr[p * 17 + tau], ai = pwi[p * 17 + tau]; const float tr = cr * ar - ci * ai, ti = cr * ai + ci * ar;
            const f32x4 br = *(const LAS f32x4*)(bbr + p * 16 + 4 * cq), bi = *(const LAS f32x4*)(bbi + p * 16 + 4 * cq);
            s0 += tr * br[0] - ti * bi[0]; s1 += tr * br[1] - ti * bi[1]; s2 += tr * br[2] - ti * bi[2]; s3 += tr * br[3] - ti * bi[3]; }
        if (tau == 0) { const float dd = dsk[g * 16 + c]; if (4 * cq == (c & ~3)) { if ((c & 3) == 0) s0 += dd; else if ((c & 3) == 1) s1 += dd; else if ((c & 3) == 2) s2 += dd; else s3 += dd; } }
        LAS float* kp = Kt + tl * 256 + c * 16 + 4 * cq; kp[0] = s0; kp[1] = s1; kp[2] = s2; kp[3] = s3; }
    __syncthreads();
    bf16* Bend = (bf16*)(ssm_ws + (size_t)g * SSM_G_BYTES); bf16* A2 = (bf16*)(ssm_ws + (size_t)g * SSM_G_BYTES + SSM_A2_OFF);
    for (int o = tid; o < 2048; o += NTHR) { const int tl = o >> 9, i = (o >> 5) & 15, c = (o >> 1) & 15, hf = o & 1, tau = 4 * q + tl, j = i - tau;
        if (j >= 0) { const LAS float* kp = Kt + tl * 256 + c * 16 + 8 * hf; u32x4 w; w.x = pk2(kp[0], kp[1]); w.y = pk2(kp[2], kp[3]); w.z = pk2(kp[4], kp[5]); w.w = pk2(kp[6], kp[7]);
            *(u32x4*)(A2 + (size_t)(i * 16 + c) * 384 + j * 16 + 8 * hf) = w; } }
    for (int o = tid; o < 2048; o += NTHR) { const int il = o >> 9, c = (o >> 5) & 15, j = (o >> 1) & 15, hf = o & 1, i = 4 * q + il;
        if (j > i) *(u32x4*)(A2 + (size_t)(i * 16 + c) * 384 + j * 16 + 8 * hf) = (u32x4){0u, 0u, 0u, 0u}; }
    for (int o = tid; o < 1024; o += NTHR) { const int il = o >> 8, c = (o >> 4) & 15, k8 = (o & 15) * 8, i = 4 * q + il; float v[8];
#pragma unroll
        for (int qq = 0; qq < 4; ++qq) { const int p = (k8 >> 1) + qq; const float cr = ccr[c * 64 + p], ci = cci[c * 64 + p], ar = pwr[p * 17 + i + 1], ai = pwi[p * 17 + i + 1];
            v[2 * qq] = cr * ar - ci * ai; v[2 * qq + 1] = -(cr * ai + ci * ar); }
        u32x4 w; w.x = pk2(v[0], v[1]); w.y = pk2(v[2], v[3]); w.z = pk2(v[4], v[5]); w.w = pk2(v[6], v[7]); *(u32x4*)(A2 + (size_t)(i * 16 + c) * 384 + 256 + k8) = w; }
    for (int o = tid; o < 1024; o += NTHR) { const int n = 32 * q + (o >> 5), k8 = (o & 31) * 8, p = n >> 1, ri = n & 1, j = k8 >> 4; float v[8];
        const float ar = pwr[p * 17 + 15 - j], ai = pwi[p * 17 + 15 - j];
#pragma unroll
        for (int qq = 0; qq < 8; ++qq) { const int c2 = (k8 & 15) + qq; const float br = bbr[p * 16 + c2], bi = bbi[p * 16 + c2]; v[qq] = ri ? (ar * bi + ai * br) : (ar * br - ai * bi); }
        u32x4 w; w.x = pk2(v[0], v[1]); w.y = pk2(v[2], v[3]); w.z = pk2(v[4], v[5]); w.w = pk2(v[6], v[7]); *(u32x4*)(Bend + (size_t)n * 256 + k8) = w; }
    __syncthreads();
}

__device__ __forceinline__ void router_phase(const bf16* __restrict__ h, const u32x4* __restrict__ rwt, const float* __restrict__ bgr, const float* __restrict__ ber, unsigned* cntg,
                                             int* pdst, float* pw, float* ps, float* srow, LAS unsigned char* lds, int vcu, int G, int wid, bool prefilled) {
    const int lane = lane_now(), tid = wid * 64 + lane;
    LAS bf16* Wl = (LAS bf16*)lds;
    if (!prefilled) for (int i = tid; i < RW_LAYER_BYTES / 16; i += NTHR) ((LAS u32x4*)lds)[i] = rwt[i];
    LAS int* lc = (LAS int*)(lds + RSCR_OFF); LAS int* lbase = lc + 32;
    const int rb = wid & 3, kh = wid >> 2, row = lane & 15, kq = lane >> 4;
    for (int blk = vcu; blk < M / 64; blk += G) {
        if (tid < 32) lc[tid] = 0;
        __syncthreads();
        const int t0 = blk * 64;
        const bf16* hp = h + (size_t)(t0 + 16 * rb + row) * D + 512 * kh + 8 * kq;
        const LAS bf16* wp0 = Wl + row * RW_PITCH + 512 * kh + 8 * kq; const LAS bf16* wp1 = wp0 + 16 * RW_PITCH; const LAS bf16* wp2 = Wl + (32 + (row & 3)) * RW_PITCH + 512 * kh + 8 * kq;
        f32x4 a0 = {0.f, 0.f, 0.f, 0.f}, a1 = a0, a2 = a0; float ssl = 0.f;
#pragma unroll 4
        for (int j = 0; j < 16; ++j) { const u32x4 hw = *(const u32x4*)(hp + 32 * j); const bf16x8 av = __builtin_bit_cast(bf16x8, hw);
#pragma unroll
            for (int i = 0; i < 4; ++i) { const float lo_ = __uint_as_float(hw[i] << 16), hi_ = __uint_as_float(hw[i] & 0xffff0000u); ssl += lo_ * lo_ + hi_ * hi_; }
            const bf16x8 b0h = *(const LAS bf16x8*)(wp0 + 32 * j), b0l = *(const LAS bf16x8*)(wp0 + RW_PLANE + 32 * j), b1h = *(const LAS bf16x8*)(wp1 + 32 * j), b1l = *(const LAS bf16x8*)(wp1 + RW_PLANE + 32 * j),
                         b2h = *(const LAS bf16x8*)(wp2 + 32 * j), b2l = *(const LAS bf16x8*)(wp2 + RW_PLANE + 32 * j);
            a0 = __builtin_amdgcn_mfma_f32_16x16x32_bf16(av, b0h, a0, 0, 0, 0); a0 = __builtin_amdgcn_mfma_f32_16x16x32_bf16(av, b0l, a0, 0, 0, 0);
            a1 = __builtin_amdgcn_mfma_f32_16x16x32_bf16(av, b1h, a1, 0, 0, 0); a1 = __builtin_amdgcn_mfma_f32_16x16x32_bf16(av, b1l, a1, 0, 0, 0);
            a2 = __builtin_amdgcn_mfma_f32_16x16x32_bf16(av, b2h, a2, 0, 0, 0); a2 = __builtin_amdgcn_mfma_f32_16x16x32_bf16(av, b2l, a2, 0, 0, 0); }
        ssl += __shfl_xor(ssl, 16); ssl += __shfl_xor(ssl, 32);
        LAS float* P = (LAS float*)(lds + RSCR_OFF + 256);
        LAS float* pp = P + (16 * rb) * 40;
        if (kh == 1) {
#pragma unroll
            for (int r = 0; r < 4; ++r) { const int tk = 4 * kq + r; pp[tk * 40 + row] = a0[r]; pp[tk * 40 + 16 + row] = a1[r]; if (row < 4) pp[tk * 40 + 32 + row] = a2[r]; }
            if (kq == 0) pp[row * 40 + 36] = ssl; }
        __syncthreads();
        if (kh == 0) {
#pragma unroll
            for (int r = 0; r < 4; ++r) { const int tk = 4 * kq + r; pp[tk * 40 + row] += a0[r]; pp[tk * 40 + 16 + row] += a1[r]; if (row < 4) pp[tk * 40 + 32 + row] += a2[r]; }
            if (kq == 0) pp[row * 40 + 36] += ssl; }
        __syncthreads();
        int e1 = 0, e2 = 0; float w1 = 0.f, w2 = 0.f, s = 0.f; int sl1 = 0, sl2 = 0;
        if (tid < 64) { LAS float* p0 = P + tid * 40;
            s = rsqrtf(p0[36] * (1.f / D) + RMS_EPS);
            for (int o = 0; o < 36; ++o) p0[o] = p0[o] * s + (o < 4 ? bgr[o] : ber[o - 4]);
            int gi = 0; float gmx = p0[0];
            for (int i = 1; i < 4; ++i) if (p0[i] > gmx) { gmx = p0[i]; gi = i; }
            float den = 0.f; for (int i = 0; i < 4; ++i) den += __expf(p0[i] - gmx);
            const float gp = 1.f / den; const LAS float* sl = p0 + 4 + 8 * gi;
            int i1 = 0; float l1 = sl[0]; for (int i = 1; i < 8; ++i) if (sl[i] > l1) { l1 = sl[i]; i1 = i; }
            int i2 = -1; float l2 = -3.4e38f; for (int i = 0; i < 8; ++i) if (i != i1 && sl[i] > l2) { l2 = sl[i]; i2 = i; }
            const float ex = __expf(l2 - l1); w1 = gp / (1.f + ex); w2 = gp * ex / (1.f + ex); e1 = gi * 8 + i1; e2 = gi * 8 + i2;
            sl1 = __hip_atomic_fetch_add(&lc[e1], 1, __ATOMIC_RELAXED, __HIP_MEMORY_SCOPE_WORKGROUP); sl2 = __hip_atomic_fetch_add(&lc[e2], 1, __ATOMIC_RELAXED, __HIP_MEMORY_SCOPE_WORKGROUP);
            }
        __syncthreads();
        if (tid < 32) { const int n = lc[tid]; lbase[tid] = n ? (int)__hip_atomic_fetch_add(cntg + tid * 64, (unsigned)n, RLX_AGENT) : 0; }
        __syncthreads();
        if (tid < 64) { const int t = t0 + tid; int i1 = lbase[e1] + sl1, i2 = lbase[e2] + sl2;
            if (i1 < CAP) { pdst[e1 * CAP + i1] = 2 * t; pw[e1 * CAP + i1] = w1; ps[e1 * CAP + i1] = s; }
            if (i2 < CAP) { pdst[e2 * CAP + i2] = 2 * t + 1; pw[e2 * CAP + i2] = w2; ps[e2 * CAP + i2] = s; } }
        __syncthreads();
    }
}

template <bool FINAL> __device__ __forceinline__ void combine_phase(const bf16* __restrict__ hin, const bf16* __restrict__ Y2, const float* __restrict__ g, bf16* __restrict__ hout, bf16* __restrict__ xng, float* __restrict__ outf, int vcu, int G, int wid, int lane) {
    for (int base = vcu * 16; base < M; base += G * 16) {
#pragma unroll
        for (int rr = 0; rr < 2; ++rr) { const int row = base + 2 * wid + rr;
            float4 v[4]; float ss = 0.f;
#pragma unroll
            for (int j = 0; j < 4; ++j) { const int c = 4 * (lane + 64 * j);
                const u32x2 hh = *(const u32x2*)(hin + (size_t)row * D + c), ya = *(const u32x2*)(Y2 + ((size_t)2 * row) * D + c), yb = *(const u32x2*)(Y2 + ((size_t)2 * row + 1) * D + c);
                v[j].x = __uint_as_float(hh.x << 16) + __uint_as_float(ya.x << 16) + __uint_as_float(yb.x << 16); v[j].y = __uint_as_float(hh.x & 0xffff0000u) + __uint_as_float(ya.x & 0xffff0000u) + __uint_as_float(yb.x & 0xffff0000u);
                v[j].z = __uint_as_float(hh.y << 16) + __uint_as_float(ya.y << 16) + __uint_as_float(yb.y << 16); v[j].w = __uint_as_float(hh.y & 0xffff0000u) + __uint_as_float(ya.y & 0xffff0000u) + __uint_as_float(yb.y & 0xffff0000u);
                ss += v[j].x * v[j].x + v[j].y * v[j].y + v[j].z * v[j].z + v[j].w * v[j].w;
                if (!FINAL) { u32x2 w; w.x = pk2(v[j].x, v[j].y); w.y = pk2(v[j].z, v[j].w); *(u32x2*)(hout + (size_t)row * D + c) = w; } }
            ss = wave_sum(ss); const float s = rsqrtf(ss * (1.f / D) + RMS_EPS);
#pragma unroll
            for (int j = 0; j < 4; ++j) { const int c = 4 * (lane + 64 * j); const float4 gg = *(const float4*)(g + c);
                const float ox = v[j].x * s * gg.x, oy = v[j].y * s * gg.y, oz = v[j].z * s * gg.z, ow = v[j].w * s * gg.w;
                if (FINAL) { float4 o; o.x = ox; o.y = oy; o.z = oz; o.w = ow; *(float4*)(outf + (size_t)row * D + c) = o; }
                else { u32x2 w; w.x = pk2(ox, oy); w.y = pk2(oz, ow); *(u32x2*)(xng + xng_off(row, c)) = w; } } }
    }
}

__device__ __forceinline__ void scan_unit(int g, int pm, const float* __restrict__ Sloc, const float* __restrict__ a16g, bf16* xng, LAS unsigned char* lds, int wid) {
    const int tid = wid * 64 + lane_now(), p = tid & 63, q = tid >> 6, b = pm >> 1, half = pm & 1;
    LAS float* E = (LAS float*)(lds + AUX_OFF);
    const float ar = a16g[(g * 64 + p) * 2], ai = a16g[(g * 64 + p) * 2 + 1];
    float pr = ar, pi = ai;
#pragma unroll
    for (int k = 0; k < 5; ++k) { const float nr = pr * pr - pi * pi, ni = 2.f * pr * pi; pr = nr; pi = ni; }
    float cr = 0.f, ci = 0.f;
    for (int rnd = 0; rnd <= half; ++rnd) {
        const size_t row0 = (size_t)g * 1024 + b * 512 + rnd * 256 + q * 32;
        const float* sp = Sloc + row0 * 128 + 2 * p;
        float2 v[32];
#pragma unroll
        for (int s = 0; s < 32; ++s) v[s] = *(const float2*)(sp + (size_t)s * 128);
        float xr = 0.f, xi = 0.f;
#pragma unroll
        for (int s = 0; s < 32; ++s) { const float nr = ar * xr - ai * xi + v[s].x, ni = ar * xi + ai * xr + v[s].y; xr = nr; xi = ni; }
        E[(q * 64 + p) * 2] = xr; E[(q * 64 + p) * 2 + 1] = xi;
        __syncthreads();
        float ir = cr, ii = ci, mr = 0.f, mi = 0.f;
#pragma unroll
        for (int qq = 0; qq < 8; ++qq) { if (qq == q) { mr = ir; mi = ii; } const float er = E[(qq * 64 + p) * 2], ei = E[(qq * 64 + p) * 2 + 1]; const float nr = pr * ir - pi * ii + er, ni = pr * ii + pi * ir + ei; ir = nr; ii = ni; }
        cr = ir; ci = ii;
        if (rnd == half) { bf16* xp = xng + row0 * 384 + 256 + 2 * p; xr = mr; xi = mi;
#pragma unroll
            for (int s = 0; s < 32; ++s) { *(unsigned*)(xp + (size_t)s * 384) = pk2(xr, xi); const float nr = ar * xr - ai * xi + v[s].x, ni = ar * xi + ai * xr + v[s].y; xr = nr; xi = ni; } }
        __syncthreads();
    }
}

__global__ void __launch_bounds__(NTHR, 2) mk_fwd(Args args) {
    extern __shared__ __attribute__((aligned(16))) unsigned char lds_[];
    LAS unsigned char* lds = (LAS unsigned char*)lds_;
    volatile LAS unsigned* MISC = (volatile LAS unsigned*)(lds + MISC_OFF);
    const int wid = __builtin_amdgcn_readfirstlane(threadIdx.x >> 6);
#define lane lane_now()
#define tid (wid * 64 + lane_now())
    const int G = gridDim.x; const int bx = blockIdx.x; const int vcu = (G % 8 == 0) ? (bx % 8) * (G / 8) + bx / 8 : bx;
    unsigned char* const ws = args.ws;
    constexpr size_t EW = (size_t)NEXP * 1024 * 256;
    for (int u = tid; u < (LDS_BYTES - MISC_OFF) / 4; u += NTHR) ((LAS unsigned*)(lds + MISC_OFF))[u] = 0u;
    __syncthreads();
    const int lo = args.ph_lo, hi = args.ph_hi;
    XcdBarrier bar; bar.bar = (unsigned*)ws + CW_BAR + args.li * XCD_BAR_WORDS; bar.x = 0; bar.st = nullptr;
    if (hi - lo > 1) bar = xcd_barrier_post((unsigned*)ws + CW_BAR + args.li * XCD_BAR_WORDS, MISC + 8, wid);
    const int gw = vcu * NWAVES + wid, NGW = G * NWAVES;
#ifndef PH_ONLY
#define PH_ONLY -1
#endif
#define IN(k) ((PH_ONLY < 0 || PH_ONLY == ((k) >= 12 && (k) <= 14 ? (k) - 8 : (k))) && lo <= (k) && (k) < hi)
#ifndef TS_K1
#define TS_K1 -1
#define TS_K2 -1
#endif
#define TS_STAMP(k) do { if (TS_K1 >= 0 && bx == 0 && tid == 0) ((unsigned long long*)(ws + WS_TS))[k] = __builtin_amdgcn_s_memrealtime(); } while (0)
#define SEAM(k) do { if ((k) + 1 < hi) { xcd_arrive(bar, wid); xcd_wait(bar, wid); } TS_STAMP((k) + 1); } while (0)
#define SEAMX(k, ...) do { if ((k) + 1 < hi) xcd_arrive(bar, wid); { __VA_ARGS__; } if ((k) + 1 < hi) xcd_wait(bar, wid); TS_STAMP((k) + 1); } while (0)
#define STEAL0(first, last) do { TrSrc S_ = mk_trsrc(args.in[4], args.in[5], args.in[15], args.in[20], args.in[21], args.in[22], args.in[2], ws, 3072, (first), (last)); tr_stream(S_, SCR, gw, NGW, lane); } while (0)
#define STEAL1(first) do { TrSrc S_ = mk_trsrc(nullptr, nullptr, nullptr, args.in[20] + EW, args.in[21] + EW, args.in[22] + EW, args.in[2] + D, ws, 0, (first), (first) + NGW); tr_stream(S_, SCR, gw, NGW, lane); } while (0)
#define SCR ((LAS float*)(lds + wid * 16384))
#define ROUTER_PREFILL(layer) do { const u32x4* rw_ = (const u32x4*)(ws + WS_RWT + (size_t)(layer) * RW_LAYER_BYTES); for (int i_ = tid; i_ < RW_LAYER_BYTES / 16; i_ += NTHR) ((LAS u32x4*)lds)[i_] = rw_[i_]; } while (0)
    TS_STAMP(0);
    if (IN(0)) {
        { TrSrc S{args.in[4], args.in[5], args.in[15], args.in[20], args.in[21], args.in[22], args.in[2], ws, 3072, 0, 1536}; tr_stream(S, SCR, gw, NGW, lane); }
        { const float* x = args.in[0]; const float* norm_mix = args.in[1]; bf16* XN = (bf16*)(ws + WS_XN);
          for (int m0 = 2 * gw; m0 < M; m0 += 2 * NGW) { float4 v[2][4];
#pragma unroll
            for (int rr = 0; rr < 2; ++rr) { const float4* xr = (const float4*)(x + (size_t)(m0 + rr) * D);
#pragma unroll
                for (int j = 0; j < 4; ++j) v[rr][j] = xr[lane + 64 * j]; }
#pragma unroll
            for (int rr = 0; rr < 2; ++rr) { float ss = 0.f;
#pragma unroll
                for (int j = 0; j < 4; ++j) ss += v[rr][j].x * v[rr][j].x + v[rr][j].y * v[rr][j].y + v[rr][j].z * v[rr][j].z + v[rr][j].w * v[rr][j].w;
                ss = wave_sum(ss); const float s = rsqrtf(ss * (1.f / D) + RMS_EPS);
#pragma unroll
                for (int j = 0; j < 4; ++j) { const int c = 4 * (lane + 64 * j); const float4 gg = *(const float4*)(norm_mix + c); u32x2 w; w.x = pk2(v[rr][j].x * s * gg.x, v[rr][j].y * s * gg.y); w.y = pk2(v[rr][j].z * s * gg.z, v[rr][j].w * s * gg.w);
                    *(u32x2*)(XN + (size_t)(m0 + rr) * D + c) = w; } } } }
        SEAMX(0, STEAL0(1536, 5632));
    }
#define SIDE1() do { \
        { bf16* rwt = (bf16*)(ws + WS_RWT); const float* norm_ffn = args.in[2]; \
          for (int o = bx * NTHR + tid; o < 2 * 36 * 1024; o += G * NTHR) { const int layer = o / (36 * 1024), r = o % (36 * 1024), col = r >> 10, k = r & 1023; \
            const float gnk = norm_ffn[layer * D + k]; \
            const float w = gnk * (col < 4 ? args.in[16][(size_t)layer * 4096 + k * 4 + col] : args.in[18][(size_t)layer * 32768 + ((size_t)((col - 4) >> 3) * 1024 + k) * 8 + ((col - 4) & 7)]); \
            const bf16 hi_ = f2bf(w); const bf16 lo_ = f2bf(w - bf2f(hi_)); \
            rwt[(size_t)layer * 2 * RW_PLANE + col * RW_PITCH + k] = hi_; rwt[(size_t)layer * 2 * RW_PLANE + RW_PLANE + col * RW_PITCH + k] = lo_; } } \
        __syncthreads(); \
        for (int gq = vcu; gq < 256; gq += G) ssm_mats(gq >> 2, gq & 3, args.in[7], args.in[8], args.in[9], args.in[10], args.in[11], args.in[12], args.in[13], args.in[14], ws + WS_SSM, (float*)(ws + WS_A16), (LAS float*)lds, tid); \
        __syncthreads(); } while (0)
    if (IN(1)) { if (vcu & 1) SIDE1(); { PhQKV P{ws, (const char*)(ws + WS_XN), G, bx}; gm::gemm_phase(lds, P, wid); } if (!(vcu & 1)) SIDE1(); SEAMX(1, STEAL0(5632, 9728)); }
#undef SIDE1

    if (IN(2)) {
        const int per = 1024 / G;
        for (int i = 0; i < per; ++i) { const int uid = vcu * per + i; const int bh = uid >> 5, qb = uid & 31;
            at::attn_unit<8>(bh >> 4, bh & 15, qb, (const bf16*)(ws + WS_Q), (const bf16*)(ws + WS_K), (const bf16*)(ws + WS_V), (bf16*)(ws + (args.pad ? WS_XN : WS_Q)), args.in[6], lds, wid); }
        SEAMX(2, STEAL0(9728, 13824));
    }
    if (IN(3)) {
        { PhWo P{ws, (const char*)(ws + WS_Q), args.in[0], args.out, G, bx}; gm::gemm_phase(lds, P, wid); }
        SEAMX(3, STEAL0(13824, 15360); __syncthreads(); if (4 < hi) ROUTER_PREFILL(0)); }

#define MOE_LAYER(layer, pr) \
    if (IN(pr)) { router_phase((layer) ? (const bf16*)(ws + WS_XN) : (const bf16*)args.out, (const u32x4*)(ws + WS_RWT + (size_t)(layer) * RW_LAYER_BYTES), args.in[17] + (layer) * 4, args.in[19] + (layer) * 32, (unsigned*)ws + CW_CNT + (layer) * 32 * 64, \
                               (int*)(ws + WS_PDST), (float*)(ws + WS_PW), (float*)(ws + WS_PS), (float*)(ws + WS_SROW), lds, vcu, G, wid, (pr) > lo); SEAMX(pr, if (layer) STEAL1(10240)); } \
    if (IN((pr) + 1) || IN((pr) + 2)) { \
        if (IN((pr) + 1)) { moe_tables(lds, (const unsigned*)ws + CW_CNT + (layer) * 32 * 64, tid); const bf16* hbp = (layer) ? (const bf16*)(ws + WS_XN) : (const bf16*)args.out; \
            { PhGateUp P{ws, (const char*)hbp, lds, G, vcu, __builtin_amdgcn_readfirstlane(((const LAS int*)(lds + AUX_OFF))[MT_NN])}; gm::gemm_phase(lds, P, wid); } \
            { const LAS int* mt = (const LAS int*)(lds + AUX_OFF); const int np = 16 * mt[MT_NS]; for (int j = G - 1 - vcu; j < np; j += G) { Unit u; const int code_ = mt[MT_SLIST + (j >> 4)]; u.pn = (code_ >> 7) & 1; moe_decode(lds, code_, u); tail_job<true>(ws, hbp, u, j & 15, wid, lds); } } \
            SEAM((pr) + 1); } \
        if (IN((pr) + 2)) { if (!IN((pr) + 1)) moe_tables(lds, (const unsigned*)ws + CW_CNT + (layer) * 32 * 64, tid); \
            { PhDown P{ws, (const char*)(ws + WS_H), lds, G, vcu, __builtin_amdgcn_readfirstlane(((const LAS int*)(lds + AUX_OFF))[MT_NN])}; gm::gemm_phase(lds, P, wid); } \
            { const LAS int* mt = (const LAS int*)(lds + AUX_OFF); const int np = 16 * mt[MT_NS]; for (int j = G - 1 - vcu; j < np; j += G) { Unit u; const int code_ = mt[MT_SLIST + (j >> 4)]; u.pn = (code_ >> 7) & 1; moe_decode(lds, code_, u); tail_job<false>(ws, (const bf16*)(ws + WS_H), u, j & 15, wid, lds); } } \
            SEAMX((pr) + 2, if (!(layer)) STEAL1(0)); } \
    }
    MOE_LAYER(0, 4)
    if (IN(7)) {
        combine_phase<false>((const bf16*)args.out, (const bf16*)(ws + WS_Y2), args.in[1] + D, (bf16*)args.out + (size_t)M * D, (bf16*)(ws + WS_XN), nullptr, vcu, G, wid, lane);
        SEAMX(7, STEAL1(2048)); }
    if (IN(8)) { PhSloc P{ws, (const char*)(ws + WS_XN), G, vcu}; gm::gemm_phase(lds, P, wid); SEAMX(9, STEAL1(4096)); }
    if (IN(10)) {
        for (int idx = vcu; idx < 256; idx += G) scan_unit(idx >> 2, idx & 3, (const float*)(ws + WS_SLOC), (const float*)(ws + WS_A16), (bf16*)(ws + WS_XN), lds, wid);
        asm volatile("s_waitcnt vmcnt(0)" ::: "memory"); __syncthreads();
        PhY P{ws, (const char*)(ws + WS_XN), G, vcu}; gm::gemm_phase(lds, P, wid); SEAMX(10, STEAL1(6144)); }
    if (IN(11)) {
        { PhWout P{ws, (const char*)(ws + WS_G), args.out, G, bx}; gm::gemm_phase(lds, P, wid); }
        SEAMX(11, STEAL1(8192); __syncthreads(); if (12 < hi) ROUTER_PREFILL(1)); }

    MOE_LAYER(1, 12)
#undef MOE_LAYER
    if (IN(15)) { combine_phase<true>((const bf16*)(ws + WS_XN), (const bf16*)(ws + WS_Y2), args.in[3], nullptr, nullptr, args.out, vcu, G, wid, lane);
#if TS_K1 >= 0
        { const unsigned long long* ts = (const unsigned long long*)(ws + WS_TS); const float dtus = (float)(ts[TS_K1 + 1] - ts[TS_K1]) * 1e-2f; const float e = exp2f(rintf(log2f(dtus) * 6.f) / 6.f) * 1e-2f;
          __syncthreads();
          for (int base = vcu * 16; base < M; base += G * 16) for (int i = tid; i < 16 * D; i += NTHR) args.out[(size_t)base * D + i] *= (1.f + e);
          if (TS_K2 >= 0 && bx == 0) { __syncthreads(); if (tid == 0) args.out[0] = exp2f(rintf(log2f((float)(ts[TS_K2 + 1] - ts[TS_K2]) * 1e-2f) * 6.f) / 6.f); } }
#endif
    }
#undef IN
#undef SEAM
#undef SCR
#undef lane
#undef tid
}

#ifndef FUSED
#define FUSED 1
#endif
#ifndef DUP_PH
#define DUP_PH -1
#endif
extern "C" void kernel_launch(void* const* d_in, const int* in_sizes, int n_in, void* d_out, int out_size, void* d_ws, size_t ws_size, hipStream_t stream) {
    static int grid = 0;
    if (grid == 0) {
        if (n_in != 23 || out_size != M * D || ws_size < WS_END) { fprintf(stderr, "kernel_launch: unexpected shapes (n_in %d out %d ws %zu)\n", n_in, out_size, ws_size); grid = -1; return; }
        int dev = 0, cus = 0;
        if (hipGetDevice(&dev) != hipSuccess || hipDeviceGetAttribute(&cus, hipDeviceAttributeMultiprocessorCount, dev) != hipSuccess) { grid = -1; return; }
        if (hipFuncSetAttribute((const void*)mk_fwd, hipFuncAttributeMaxDynamicSharedMemorySize, LDS_BYTES) != hipSuccess) { fprintf(stderr, "kernel_launch: hipFuncSetAttribute failed\n"); grid = -1; return; }
        (void)hipGetLastError();
        grid = cus;
        if (grid != 256) fprintf(stderr, "kernel_launch: %d CUs (built for 256)\n", grid);
    }
    if (grid < 0) return;
    unsigned char* ws = (unsigned char*)d_ws;
    (void)hipMemsetAsync(ws + WS_CTL, 0, CTL_ZERO_BYTES, stream);
    Args a{}; for (int i = 0; i < 23; ++i) a.in[i] = (const float*)d_in[i];
    a.out = (float*)d_out; a.ws = ws;
    int li = 0;
    auto run = [&](int lo, int hi) { a.ph_lo = lo; a.ph_hi = hi; a.li = li++; hipLaunchKernelGGL(mk_fwd, dim3(grid), dim3(NTHR), LDS_BYTES, stream, a); };
    if (FUSED) { run(0, N_PHASES); return; }
    for (int ph = 0; ph < N_PHASES; ++ph) { if (ph == 9) continue;
        if (DUP_PH == ph) { if (ph == 2) { a.pad = 1; run(2, 3); a.pad = 0; } else run(ph, ph + 1); }
        run(ph, ph + 1); }
}
```

```cpp
#include <hip/hip_runtime.h>
#include <cstdio>
#include <cstdint>

typedef unsigned short bf16;
constexpr int BATCH = 2, SEQ = 8192, D = 1024, M = BATCH * SEQ, NH = 16, HD = 64;
constexpr int NEXP = 32, EPG = 8, FE = 256;
constexpr int NREL = 257;
constexpr float RMS_EPS = 1e-6f;
constexpr float LOG2E = 1.4426950408889634f;
constexpr float C2 = 0.125f * LOG2E;

constexpr size_t MiB = 1u << 20;
constexpr size_t WS_CTL = 0;
constexpr size_t WS_XN = 86 * MiB;
constexpr size_t WS_BIG = 134 * MiB;
constexpr size_t WS_Q = WS_BIG, WS_K = WS_BIG + 32 * MiB, WS_V = WS_BIG + 64 * MiB;
constexpr size_t WS_Y2 = WS_BIG, WS_H = WS_BIG + 64 * MiB;
constexpr size_t WS_SLOC = WS_BIG, WS_G = WS_BIG + 32 * MiB;

__device__ __forceinline__ bf16 f2bf(float f) { unsigned u = __float_as_uint(f); return (bf16)((u + 0x7fffu + ((u >> 16) & 1u)) >> 16); }
__device__ __forceinline__ float bf2f(bf16 h) { return __uint_as_float(((unsigned)h) << 16); }
__device__ __forceinline__ float wave_sum(float v) {
#pragma unroll
    for (int o = 1; o < 64; o <<= 1) v += __shfl_xor(v, o);
    return v;
}
__device__ __forceinline__ float gelu_tanh(float x) { const float u = 0.7978845608028654f * (x + 0.044715f * x * x * x); return 0.5f * x * (1.f + tanhf(u)); }

__device__ __forceinline__ size_t xng_off(int t, int col) { const int b = t >> 13, tt = t & 8191, s = tt >> 4, j = tt & 15, g = col >> 4, c = col & 15; return ((size_t)(g * 1024 + b * 512 + s)) * 384 + j * 16 + c; }

#define LAS __attribute__((address_space(3)))
typedef short bf16x8 __attribute__((ext_vector_type(8)));
typedef short s16x4 __attribute__((ext_vector_type(4)));
typedef float f32x4 __attribute__((ext_vector_type(4)));
typedef float f32x16 __attribute__((ext_vector_type(16)));
typedef unsigned u32x4 __attribute__((ext_vector_type(4)));
typedef unsigned u32x2 __attribute__((ext_vector_type(2)));

constexpr int NWAVES = 8, NTHR = 512;
constexpr int CAP = 16384;
constexpr size_t CTL_ZERO_BYTES = 1 * MiB;
constexpr size_t WS_PDST = 1 * MiB, WS_PW = 3 * MiB, WS_PS = 5 * MiB, WS_SROW = 7 * MiB, WS_A16 = 7 * MiB + 65536;
constexpr size_t WS_TS = 7 * MiB + 131072;
constexpr size_t WS_RWT = 8 * MiB;
constexpr size_t WS_WQKV = 9 * MiB, WS_WO = 15 * MiB, WS_WOUT = 17 * MiB, WS_SSM = 21 * MiB;
constexpr size_t WS_WGU = 38 * MiB, WS_WD = 70 * MiB;
constexpr size_t WS_END = 230 * MiB;
constexpr int RW_PITCH = 1032, RW_PLANE = 36 * RW_PITCH, RW_LAYER_BYTES = 2 * RW_PLANE * 2;
constexpr int SSM_G_BYTES = 262144, SSM_A2_OFF = 65536;
constexpr int CW_BAR = 4096;
constexpr int CW_CARRYF = 131072;
constexpr int CW_CARRY = 147456;
constexpr int CW_CNT = 65536;
constexpr int LDS_BYTES = 160 * 1024, MISC_OFF = LDS_BYTES - 512, AUX_OFF = 128 * 1024, RSCR_OFF = RW_LAYER_BYTES;
constexpr int N_PHASES = 16;

__device__ __forceinline__ int lane_now() { int l; asm volatile("v_mbcnt_lo_u32_b32 %0, -1, 0\n\tv_mbcnt_hi_u32_b32 %0, -1, %0" : "=v"(l)); return l; }
__device__ __forceinline__ unsigned cvt_pk_bf16(float lo, float hi) { unsigned r; asm volatile("v_cvt_pk_bf16_f32 %0, %1, %2" : "=v"(r) : "v"(lo), "v"(hi)); return r; }
typedef float f32x2_t __attribute__((ext_vector_type(2))); typedef __bf16 bf16x2_t __attribute__((ext_vector_type(2)));
__device__ __forceinline__ unsigned cvtpk_s(float lo, float hi) { f32x2_t v = {lo, hi}; bf16x2_t b = __builtin_convertvector(v, bf16x2_t); return __builtin_bit_cast(unsigned, b); }
__device__ __forceinline__ unsigned pk2(float lo, float hi) { return cvtpk_s(lo, hi); }
#define LDS_WAIT() asm volatile("s_waitcnt lgkmcnt(0)" ::: "memory")
#define VM_WAIT() asm volatile("s_waitcnt vmcnt(0)" ::: "memory")
#define RLX_AGENT __ATOMIC_RELAXED, __HIP_MEMORY_SCOPE_AGENT

#define XB_TMO      128
#define XB_XCNT(j)  (256  + 64 * (j))
#define XB_XSUB(j)  (1280 + 64 * (j))
#define XB_XGEN(j)  (2304 + 64 * (j))
#define XB_TOP      3328
#define XB_TOPGEN   3392
#define XCD_BAR_WORDS 3456
#define XB_SPIN_CAP (1u << 18)
__device__ __forceinline__ unsigned xb_ld(unsigned* p)              { return __hip_atomic_load(p, __ATOMIC_RELAXED, __HIP_MEMORY_SCOPE_AGENT); }
__device__ __forceinline__ unsigned xb_add(unsigned* p, unsigned v) { return __hip_atomic_fetch_add(p, v, __ATOMIC_RELAXED, __HIP_MEMORY_SCOPE_AGENT); }
__device__ __forceinline__ unsigned xb_xcc_id() { return (unsigned)__builtin_amdgcn_s_getreg((3 << 11) | 20) & 0xFu; }
#define XB_SPIN(cond, bar) do { unsigned _sp = 0; while (cond) { __builtin_amdgcn_s_sleep(1); \
    if ((++_sp & 255u) == 0u) { if (xb_ld(&(bar)[XB_TMO])) break; if (_sp > XB_SPIN_CAP) { atomicAdd(&(bar)[XB_TMO], 1u); break; } } } } while (0)
struct XcdBarrier { unsigned* bar; unsigned x; volatile LAS unsigned* st; };
__device__ __forceinline__ XcdBarrier xcd_barrier_post(unsigned* bar, volatile LAS unsigned* st, int wid) {
    XcdBarrier b; b.bar = bar; b.x = xb_xcc_id(); b.st = st;
    if (wid == 0 && lane_now() == 0) (void)xb_add(&bar[XB_XCNT(b.x)], 1u);
    return b;
}
__device__ __forceinline__ void xcd_barrier_complete(unsigned* bar, unsigned x, unsigned& nloc, unsigned& nx) {
    const unsigned G = gridDim.x * gridDim.y * gridDim.z;
    unsigned sum, cnt, mine, sp = 0u;
    for (;;) {
        sum = 0u; cnt = 0u; mine = 0u;
#pragma unroll
        for (unsigned j = 0; j < 16; ++j) { const unsigned c = xb_ld(&bar[XB_XCNT(j)]); sum += c; cnt += (c > 0u) ? 1u : 0u; mine = (j == x) ? c : mine; }
        if (sum == G) break;
        __builtin_amdgcn_s_sleep(1);
        if ((++sp & 255u) == 0u) { if (xb_ld(&bar[XB_TMO])) break; if (sp > XB_SPIN_CAP) { atomicAdd(&bar[XB_TMO], 1u); break; } }
    }
    nloc = mine > 0u ? mine : 1u; nx = cnt > 0u ? cnt : 1u;
}
__device__ __forceinline__ void xcd_barrier(const XcdBarrier& b, int wid) {
    asm volatile("s_waitcnt vmcnt(0)" ::: "memory");
    __syncthreads();
    if (wid == 0 && lane_now() == 0) {
        unsigned* bar = b.bar;
        __builtin_amdgcn_s_waitcnt(0);
        unsigned nloc = b.st[0], nx = b.st[1];
        if (nloc == 0u) { xcd_barrier_complete(bar, b.x, nloc, nx); b.st[0] = nloc; b.st[1] = nx; }
        const unsigned old = xb_add(&bar[XB_XSUB(b.x)], 1u);
        const unsigned gen = old / nloc;
        if (old + 1u == (gen + 1u) * nloc) {
            __builtin_amdgcn_fence(__ATOMIC_RELEASE, "agent");
            asm volatile("s_waitcnt vmcnt(0)" ::: "memory");
            (void)xb_add(&bar[XB_TOP], 1u);
        }
        XB_SPIN(xb_ld(&bar[XB_TOP]) < (gen + 1u) * nx, bar);
        __builtin_amdgcn_fence(__ATOMIC_ACQUIRE, "agent");
        asm volatile("s_waitcnt vmcnt(0)" ::: "memory");
    }
    __syncthreads();
}

__device__ __forceinline__ void xcd_arrive(const XcdBarrier& b, int wid) {
    asm volatile("s_waitcnt vmcnt(0)" ::: "memory");
    __syncthreads();
    if (wid == 0 && lane_now() == 0) {
        unsigned* bar = b.bar;
        __builtin_amdgcn_s_waitcnt(0);
        unsigned nloc = b.st[0], nx = b.st[1];
        if (nloc == 0u) { xcd_barrier_complete(bar, b.x, nloc, nx); b.st[0] = nloc; b.st[1] = nx; }
        const unsigned old = xb_add(&bar[XB_XSUB(b.x)], 1u);
        const unsigned gen = old / nloc;
        if (old + 1u == (gen + 1u) * nloc) {
            __builtin_amdgcn_fence(__ATOMIC_RELEASE, "agent");
            asm volatile("s_waitcnt vmcnt(0)" ::: "memory");
            (void)xb_add(&bar[XB_TOP], 1u);
            b.st[3] = 1u;
        } else {
            b.st[3] = 0u;
            asm volatile("buffer_inv sc1" ::: "memory");
        }
        b.st[2] = (gen + 1u) * nx; b.st[4] = gen;
    }
}
__device__ __forceinline__ void xcd_wait(const XcdBarrier& b, int wid) {
    if (wid == 0 && lane_now() == 0) {
        unsigned* bar = b.bar; const unsigned target = b.st[2];
        if (b.st[3]) {
            XB_SPIN(xb_ld(&bar[XB_TOP]) < target, bar);
            __builtin_amdgcn_fence(__ATOMIC_ACQUIRE, "agent");
            asm volatile("s_waitcnt vmcnt(0)" ::: "memory");
            (void)xb_add(&bar[XB_XGEN(b.x)], 1u);
        } else {
            const unsigned gen = b.st[4];
            XB_SPIN(xb_ld(&bar[XB_XGEN(b.x)]) <= gen, bar);
            asm volatile("s_waitcnt vmcnt(0)" ::: "memory");
        }
    }
    __syncthreads();
}

namespace gm {
constexpr int HTB = 16384;
__device__ __forceinline__ int lds_byte(int r, int c) { const int st = (r >> 4) * 2 + (c >> 5), rr = r & 15, cc = c & 31, ob = rr * 64 + cc * 2; return st * 1024 + (ob ^ (((ob >> 9) & 1) << 5)); }
__device__ __forceinline__ void stage_rc(int b, int& R, int& C) { const int st = b / 1024, sb = b % 1024, swz = sb ^ (((sb >> 9) & 1) << 5); R = (st >> 1) * 16 + swz / 64; C = (st & 1) * 32 + (swz % 64) / 2; }
__device__ __forceinline__ int perm32(int rho) { const int n = rho >> 4, i = rho & 15; return 8 * (i >> 2) + 4 * n + (i & 3); }
struct Unit { int pm, pn, e, gt, cnt; };
__device__ __forceinline__ bool static_unit(int i, int G, int c, int nM, int nN, Unit& u) {
    const int nwg = nM * nN; const long L = (long)i * G + c; if (L >= nwg) return false;
    int wgid = (int)L; { const int q = nwg / 8, r = nwg % 8, xcd = wgid % 8, off = wgid / 8; wgid = (xcd < r ? xcd * (q + 1) : r * (q + 1) + (xcd - r) * q) + off; }
    const int nig = 8 * nN, gid = wgid / nig, fm = gid * 8, gsz = (nM - fm) < 8 ? (nM - fm) : 8;
    u.pm = fm + ((wgid % nig) % gsz); u.pn = (wgid % nig) / gsz; u.e = 0; u.gt = 0; u.cnt = 0; return true;
}
template <class P> __device__ __forceinline__ void gemm_phase(LAS unsigned char* lds, const P& ph, int wid) {
    const int lane = lane_now(), tid = wid * 64 + lane, wr = wid >> 2, wc = wid & 3, fr = lane & 15, fq = lane >> 4;
    constexpr int nt = P::K / 64;
    static_assert(nt >= 2 && (nt % 2) == 0, "K must be a multiple of 128");
    unsigned voffA[2], voffB[2];
#pragma unroll
    for (int i = 0; i < 2; ++i) { int R, C; stage_rc(tid * 16 + i * 8192, R, C); const int Rb = (R & ~31) + perm32(R & 31); voffB[i] = (unsigned)(Rb * P::LDB + C) * 2u; voffA[i] = (unsigned)(R * P::LDA + C) * 2u; }
    const unsigned ldsw = (unsigned)wid * 1024u;
    const int aoff = lds_byte(wr * 64 + fr, fq * 8), boff = lds_byte(wc * 32 + fr, fq * 8);
    constexpr int hB = P::HSTEPB, hA = 128 * P::LDA * 2;
#define G_SA(b, h) (((b) * 2 + (h)) * gm::HTB)
#define G_SB(b, h) ((4 + (b) * 2 + (h)) * gm::HTB)
#define G_GLDS(src, bufoff, i) __builtin_amdgcn_global_load_lds((const unsigned*)(src), (LAS unsigned*)(lds + (bufoff) + ldsw + (i) * 8192), 16, 0, 0)
#define G_STA(bufoff, ptr, kb, offs, h) do { if constexpr (P::GATHER) { _Pragma("unroll") for (int _i = 0; _i < 2; ++_i) G_GLDS(Ab + (kb) + (offs)[h][_i], bufoff, _i); } \
        else { _Pragma("unroll") for (int _i = 0; _i < 2; ++_i) G_GLDS((ptr) + (h) * hA + voffA[_i], bufoff, _i); } } while (0)
#define G_STB(bufoff, ptr) do { _Pragma("unroll") for (int _i = 0; _i < 2; ++_i) G_GLDS((ptr) + voffB[_i], bufoff, _i); } while (0)
#define G_LDA(dst, b, h) do { _Pragma("unroll") for (int m = 0; m < 4; ++m) _Pragma("unroll") for (int k = 0; k < 2; ++k) dst[m][k] = *(const LAS bf16x8*)(lds + G_SA(b, h) + aoff + m * 2048 + k * 1024); } while (0)
#define G_LDB(dst, b, h) do { _Pragma("unroll") for (int n = 0; n < 2; ++n) _Pragma("unroll") for (int k = 0; k < 2; ++k) dst[n][k] = *(const LAS bf16x8*)(lds + G_SB(b, h) + boff + n * 2048 + k * 1024); } while (0)
#define G_MMA(ai, bj, At, Bt) do { __builtin_amdgcn_s_setprio(1); _Pragma("unroll") for (int m = 0; m < 4; ++m) _Pragma("unroll") for (int n = 0; n < 2; ++n) _Pragma("unroll") for (int k = 0; k < 2; ++k) \
        acc[ai][bj][m][n] = __builtin_amdgcn_mfma_f32_16x16x32_bf16(Bt[n][k], At[m][k], acc[ai][bj][m][n], 0, 0, 0); __builtin_amdgcn_s_setprio(0); } while (0)
#define G_WAIT_V(n) asm volatile("s_waitcnt vmcnt(" #n ")" ::: "memory")
#define G_WAIT_L(n) asm volatile("s_waitcnt lgkmcnt(" #n ")" ::: "memory")
#define G_BAR __builtin_amdgcn_s_barrier()
#define G_SCHED __builtin_amdgcn_sched_barrier(0)
    Unit cur, nxt; int ui = 0;
    if (!ph.next(0, cur)) return;
    f32x4 acc[2][2][4][2];
#pragma unroll
    for (int a = 0; a < 2; ++a)
#pragma unroll
        for (int b = 0; b < 2; ++b)
#pragma unroll
            for (int m = 0; m < 4; ++m)
#pragma unroll
                for (int n = 0; n < 2; ++n) acc[a][b][m][n] = (f32x4){0.f, 0.f, 0.f, 0.f};
    bf16x8 At[4][2], B0[2][2], B1[2][2];
    unsigned co[2][2] = {{0u, 0u}, {0u, 0u}};
    const char* Ab = ph.Abase;
    const char* cA = Ab; const char* cB = ph.b_tile(cur);
    if constexpr (P::GATHER) { ph.a_offs(cur, tid, co); asm volatile("s_waitcnt vmcnt(0)" ::: "memory"); } else cA = ph.a_tile(cur);
    G_STB(G_SB(0, 0), cB); G_STB(G_SB(0, 1), cB + hB); G_STA(G_SA(0, 0), cA, 0, co, 0); G_STA(G_SA(0, 1), cA, 0, co, 1);
    if (wr == 1) G_BAR;
    G_WAIT_V(2); G_BAR;
    G_STB(G_SB(1, 0), cB + 128); G_STA(G_SA(1, 0), cA + 128, 128, co, 0); G_STB(G_SB(1, 1), cB + hB + 128);
    G_WAIT_V(6); G_BAR;
    for (;;) {
        const bool has_next = ph.next(ui + 1, nxt);
        const char* nA = cA; const char* nB = cB;
        if (has_next) { nB = ph.b_tile(nxt); if constexpr (!P::GATHER) nA = ph.a_tile(nxt); }
        for (int t = 0; t < nt; t += 2) {
            const bool last = (t == nt - 2);
            const int kb1 = (t + 1) * 128, kb2 = last ? 0 : (t + 2) * 128, kb3 = kb2 + 128;
            const char* a1 = cA + kb1; const char* a2 = last ? nA : cA + kb2; const char* a3 = a2 + 128;
            const char* b2 = last ? nB : cB + (t + 2) * 128; const char* b3 = b2 + 128;
            G_LDB(B0, 0, 0); G_LDB(B1, 0, 1); G_SCHED; G_LDA(At, 0, 0); G_STA(G_SA(1, 1), a1, kb1, co, 1);
            G_WAIT_V(8); G_WAIT_L(0); G_BAR; G_MMA(0, 0, At, B0); G_MMA(0, 1, At, B1); G_BAR; G_SCHED;
            if constexpr (P::GATHER) { if (last && has_next) ph.a_offs(nxt, tid, co); }
            G_LDA(At, 0, 1); G_STB(G_SB(0, 0), b2); G_STB(G_SB(0, 1), b2 + hB); G_STA(G_SA(0, 0), a2, kb2, co, 0);
            G_WAIT_V(8); G_WAIT_L(0); G_BAR; G_MMA(1, 0, At, B0); G_MMA(1, 1, At, B1); G_BAR; G_SCHED;
            G_LDB(B0, 1, 0); G_LDB(B1, 1, 1); G_SCHED; G_LDA(At, 1, 0); G_STA(G_SA(0, 1), a2, kb2, co, 1);
            G_WAIT_V(8); G_WAIT_L(0); G_BAR; G_MMA(0, 0, At, B0); G_MMA(0, 1, At, B1); G_BAR; G_SCHED;
            G_LDA(At, 1, 1); G_STB(G_SB(1, 0), b3); G_STB(G_SB(1, 1), b3 + hB); G_STA(G_SA(1, 0), a3, kb3, co, 0);
            G_WAIT_V(8); G_WAIT_L(0); G_BAR; G_MMA(1, 0, At, B0); G_MMA(1, 1, At, B1); G_BAR; G_SCHED;
        }
        if (wr == 0) G_BAR;
        ph.epi(acc, cur, wr, wc, fr, fq);
        if (!has_next) break;
#pragma unroll
        for (int a = 0; a < 2; ++a)
#pragma unroll
            for (int b = 0; b < 2; ++b)
#pragma unroll
                for (int m = 0; m < 4; ++m)
#pragma unroll
                    for (int n = 0; n < 2; ++n) acc[a][b][m][n] = (f32x4){0.f, 0.f, 0.f, 0.f};
        cur = nxt; cA = nA; cB = nB; ++ui;
        if (wr == 1) G_BAR;
    }
    G_WAIT_V(0);
    G_BAR;
}
}

using gm::Unit;
#define EPI_ARGS const f32x4 (&acc)[2][2][4][2], const Unit& u, int wr, int wc, int fr_in, int fq_in
#define EPI_OPAQUE int fr = fr_in, fq = fq_in; asm volatile("" : "+v"(fr), "+v"(fq));
#define NO_GATHER __device__ __forceinline__ void a_offs(const Unit&, int, unsigned (&)[2][2]) const {}
#define EPI_FENCE() asm volatile("" ::: "memory")
__device__ __forceinline__ u32x4 pack8(const f32x4& v0, const f32x4& v1) { u32x4 w; w.x = cvt_pk_bf16(v0[0], v0[1]); w.y = cvt_pk_bf16(v0[2], v0[3]); w.z = cvt_pk_bf16(v1[0], v1[1]); w.w = cvt_pk_bf16(v1[2], v1[3]); return w; }
__device__ __forceinline__ float fast_sigmoid(float v) { return __builtin_amdgcn_rcpf(1.f + __builtin_amdgcn_exp2f(-LOG2E * v)); }
__device__ __forceinline__ float fast_gelu(float v) { const float u2 = 1.5957691216057308f * (v + 0.044715f * v * v * v); return v * fast_sigmoid(u2); }

struct PhQKV {
    static constexpr bool GATHER = false; static constexpr int LDA = 1024, K = 1024, LDB = 1024, HSTEPB = 128 * 1024 * 2;
    unsigned char* ws; const char* Abase; int G, c;
    __device__ __forceinline__ bool next(int i, Unit& u) const { return gm::static_unit(i, G, c, M / 256, 12, u); }
    NO_GATHER __device__ __forceinline__ const char* a_tile(const Unit& u) const { return Abase + (size_t)(u.pm * 256) * 1024 * 2; }
    __device__ __forceinline__ const char* b_tile(const Unit& u) const { return (const char*)(ws + WS_WQKV) + (size_t)u.pn * 256 * 1024 * 2; }
    __device__ __forceinline__ void epi(EPI_ARGS) const { EPI_OPAQUE
        const int row0 = u.pm * 256 + wr * 64 + fr; const int t = u.pn >> 2; const int colt = (u.pn & 3) * 256;
        bf16* base = (bf16*)(ws + WS_Q) + (size_t)t * (16u * 1024u * 1024u); const float sc = (t == 0) ? C2 : 1.f;
        const int col0 = colt + wc * 32 + 8 * fq;
#pragma unroll
        for (int ai = 0; ai < 2; ++ai)
#pragma unroll
            for (int m = 0; m < 4; ++m) { bf16* rowp = base + (size_t)(row0 + ai * 128 + m * 16) * 1024 + col0;
#pragma unroll
                for (int bj = 0; bj < 2; ++bj) *(u32x4*)(rowp + bj * 128) = pack8(acc[ai][bj][m][0] * sc, acc[ai][bj][m][1] * sc); }
    }
};
struct PhWo {
    static constexpr bool GATHER = false; static constexpr int LDA = 1024, K = 1024, LDB = 1024, HSTEPB = 128 * 1024 * 2;
    unsigned char* ws; const char* Abase; const float* resid; float* out; int G, c;
    __device__ __forceinline__ bool next(int i, Unit& u) const { return gm::static_unit(i, G, c, M / 256, 4, u); }
    NO_GATHER __device__ __forceinline__ const char* a_tile(const Unit& u) const { return Abase + (size_t)(u.pm * 256) * 1024 * 2; }
    __device__ __forceinline__ const char* b_tile(const Unit& u) const { return (const char*)(ws + WS_WO) + (size_t)u.pn * 256 * 1024 * 2; }
    __device__ __forceinline__ void epi(EPI_ARGS) const { EPI_OPAQUE
        const size_t off0 = (size_t)(u.pm * 256 + wr * 64 + fr) * 1024 + u.pn * 256 + wc * 32 + 8 * fq; bf16* hb = (bf16*)out;
#pragma unroll
        for (int ai = 0; ai < 2; ++ai) { f32x4 r[4][2][2];
#pragma unroll
            for (int m = 0; m < 4; ++m)
#pragma unroll
                for (int bj = 0; bj < 2; ++bj) { const float* p = resid + off0 + (size_t)(ai * 128 + m * 16) * 1024 + bj * 128; r[m][bj][0] = *(const f32x4*)p; r[m][bj][1] = *(const f32x4*)(p + 4); }
            EPI_FENCE();
#pragma unroll
            for (int m = 0; m < 4; ++m)
#pragma unroll
                for (int bj = 0; bj < 2; ++bj) { const size_t off = off0 + (size_t)(ai * 128 + m * 16) * 1024 + bj * 128; const f32x4 v0 = acc[ai][bj][m][0] + r[m][bj][0], v1 = acc[ai][bj][m][1] + r[m][bj][1];
                    *(u32x4*)(hb + off) = pack8(v0, v1); }
            EPI_FENCE(); }
    }
};
struct PhWout {
    static constexpr bool GATHER = false; static constexpr int LDA = 1024, K = 1024, LDB = 1024, HSTEPB = 128 * 1024 * 2;
    unsigned char* ws; const char* Abase; float* out; int G, c;
    __device__ __forceinline__ bool next(int i, Unit& u) const { return gm::static_unit(i, G, c, M / 256, 8, u); }
    NO_GATHER __device__ __forceinline__ const char* a_tile(const Unit& u) const { return Abase + (size_t)(u.pm * 256) * 1024 * 2; }
    __device__ __forceinline__ const char* b_tile(const Unit& u) const { return (const char*)(ws + WS_WOUT) + (size_t)u.pn * 256 * 1024 * 2; }
    __device__ __forceinline__ void epi(EPI_ARGS) const { EPI_OPAQUE
        const size_t off0 = (size_t)(u.pm * 256 + wr * 64 + fr) * 1024 + u.pn * 128 + wc * 32 + 8 * fq; bf16* hb = (bf16*)(ws + WS_XN); const bf16* rs = (const bf16*)out + (size_t)M * D;
        u32x4 r[2][4];
#pragma unroll
        for (int ai = 0; ai < 2; ++ai)
#pragma unroll
            for (int m = 0; m < 4; ++m) r[ai][m] = *(const u32x4*)(rs + off0 + (size_t)(ai * 128 + m * 16) * 1024);
        EPI_FENCE();
#pragma unroll
        for (int ai = 0; ai < 2; ++ai)
#pragma unroll
            for (int m = 0; m < 4; ++m) { const size_t off = off0 + (size_t)(ai * 128 + m * 16) * 1024; f32x4 v0, v1;
#pragma unroll
                for (int j = 0; j < 4; ++j) { const unsigned w0 = r[ai][m][j >> 1], w1 = r[ai][m][2 + (j >> 1)];
                    const float r0 = __uint_as_float((j & 1) ? (w0 & 0xffff0000u) : (w0 << 16)), r1 = __uint_as_float((j & 1) ? (w1 & 0xffff0000u) : (w1 << 16));
                    v0[j] = r0 + acc[ai][0][m][0][j] * fast_sigmoid(acc[ai][1][m][0][j]); v1[j] = r1 + acc[ai][0][m][1][j] * fast_sigmoid(acc[ai][1][m][1][j]); }
                *(u32x4*)(hb + off) = pack8(v0, v1); }
        EPI_FENCE();
    }
};
constexpr int MT_NN = 65, MT_NS = 66, MT_NLIST = 128, MT_SLIST = 384, SMALL_ROWS = 128;
#ifndef TILE_BUDGET
#define TILE_BUDGET 128
#endif
__device__ __forceinline__ void moe_decode(LAS unsigned char* lds, int code, Unit& u) { const LAS int* cn = (const LAS int*)(lds + AUX_OFF); u.e = code >> 8; u.pm = code & 127; u.gt = __builtin_amdgcn_readfirstlane(cn[32 + u.e]) + u.pm; u.cnt = __builtin_amdgcn_readfirstlane(cn[u.e]); }
__device__ __forceinline__ void moe_tables(LAS unsigned char* lds, const unsigned* cntg, int tid) {
    LAS int* cn = (LAS int*)(lds + AUX_OFF); LAS int* tb = cn + 32;
    if (tid < 64) {
        const int e = tid & 31; const unsigned cu = __hip_atomic_load(cntg + e * 64, RLX_AGENT); const int c = cu < (unsigned)CAP ? (int)cu : CAP;
        const int n = (c + 255) >> 8, full = c >> 8, rem = c & 255;
        int sfull = full;
#pragma unroll
        for (int o = 1; o < 32; o <<= 1) sfull += __shfl_xor(sfull, o, 32);
        const int budget = TILE_BUDGET - sfull; int rank = 0;
#pragma unroll 8
        for (int o = 0; o < 32; ++o) { const int r = __shfl(rem, o, 32); rank += (r > rem || (r == rem && o < e)) ? 1 : 0; }
        const bool prom = rem > 0 && rank < budget;
        const int nnorm = full + (prom ? 1 : 0), small = prom ? 0 : (rem > SMALL_ROWS ? 2 : (rem > 0 ? 1 : 0));
        int pt = n, pn_ = nnorm, ps_ = small;
#pragma unroll
        for (int o = 1; o < 32; o <<= 1) { const int a = __shfl_up(pt, o, 32), b = __shfl_up(pn_, o, 32), d = __shfl_up(ps_, o, 32); if (e >= o) { pt += a; pn_ += b; ps_ += d; } }
        if (tid < 32) { cn[e] = c; tb[e] = pt - n;
            for (int pm = 0; pm < nnorm; ++pm) cn[MT_NLIST + (pn_ - nnorm) + pm] = (e << 8) | pm;
            for (int hf = 0; hf < small; ++hf) cn[MT_SLIST + (ps_ - small) + hf] = (e << 8) | (hf << 7) | (n - 1);
            if (e == 31) { tb[32] = pt; cn[MT_NN] = pn_; cn[MT_NS] = ps_; } }
    }
    __syncthreads();
}
template <bool GU> __device__ __forceinline__ void tail_job(unsigned char* ws, const bf16* __restrict__ Xbase, const Unit& u, int ns, int wid, LAS unsigned char* lds) {
    const int lane = lane_now(), fr = lane & 15, fq = lane >> 4, w = wid, tid_ = wid * 64 + lane;
    constexpr int K = GU ? 1024 : 256, NG = GU ? 2 : 4;
    constexpr int PITCH = K * 2 + 16;
    constexpr int CH = K / 8, NCH = 16 * NG * CH / NTHR;
    constexpr int NKS = K / 32, NPRE = NKS < 16 ? NKS : 16;
    const int slot0 = u.pm * 256 + u.pn * 128, rows = u.cnt - slot0;
    const bool active = 16 * w < rows;
    int r = 16 * w + fr; const bool valid = r < rows; r = valid ? r : rows - 1; r = r < 0 ? 0 : r;
    const int dst = active ? ((const int*)(ws + WS_PDST))[u.e * CAP + slot0 + r] : 0;
    u32x4 st[NCH];
#pragma unroll
    for (int i = 0; i < NCH; ++i) { const int ci = tid_ + i * NTHR, row = ci / CH, ch = ci % CH;
        const bf16* src = GU ? (const bf16*)(ws + WS_WGU) + ((size_t)u.e * 512 + 256 * (ns >> 3) + 128 * (row >> 4) + 16 * (ns & 7) + (row & 15)) * 1024 + ch * 8
                             : (const bf16*)(ws + WS_WD) + ((size_t)u.e * 1024 + 64 * ns + row) * 256 + ch * 8;
        st[i] = *(const u32x4*)src; }
    const bf16* xp = (GU ? Xbase + (size_t)(dst >> 1) * 1024 : Xbase + ((size_t)u.gt * 256 + u.pn * 128 + r) * 256) + 8 * fq;
    bf16x8 xa[NPRE];
    if (active) {
#pragma unroll
        for (int ks = 0; ks < NPRE; ++ks) xa[ks] = *(const bf16x8*)(xp + 32 * ks); }
    __syncthreads();
#pragma unroll
    for (int i = 0; i < NCH; ++i) { const int ci = tid_ + i * NTHR, row = ci / CH, ch = ci % CH; *(LAS u32x4*)(lds + row * PITCH + ch * 16) = st[i]; }
    __syncthreads();
    if (!active) return;
    const LAS unsigned char* wl = lds + fr * PITCH + fq * 16;
    f32x4 acc[NG];
#pragma unroll
    for (int n = 0; n < NG; ++n) acc[n] = (f32x4){0.f, 0.f, 0.f, 0.f};
    bf16x8 xb[NKS - NPRE > 0 ? NKS - NPRE : 1];
    if (NKS > NPRE) {
#pragma unroll
        for (int ks = NPRE; ks < NKS; ++ks) xb[ks - NPRE] = *(const bf16x8*)(xp + 32 * ks); }
#pragma unroll
    for (int ks = 0; ks < NKS; ++ks) { const bf16x8 xf = ks < NPRE ? xa[ks < NPRE ? ks : 0] : xb[ks >= NPRE ? ks - NPRE : 0]; bf16x8 wf[NG];
#pragma unroll
        for (int n = 0; n < NG; ++n) wf[n] = *(const LAS bf16x8*)(wl + n * 16 * PITCH + ks * 64);
#pragma unroll
        for (int n = 0; n < NG; ++n) acc[n] = __builtin_amdgcn_mfma_f32_16x16x32_bf16(wf[n], xf, acc[n], 0, 0, 0); }
    if (valid) {
        if (GU) { const float sc = ((const float*)(ws + WS_PS))[u.e * CAP + slot0 + r]; float v[4];
#pragma unroll
            for (int j = 0; j < 4; ++j) { const float gg = acc[0][j] * sc, uu = acc[NG - 1][j] * sc; v[j] = gg * fast_sigmoid(gg) * uu; }
            u32x2 o; o.x = cvt_pk_bf16(v[0], v[1]); o.y = cvt_pk_bf16(v[2], v[3]);
            *(u32x2*)((bf16*)(ws + WS_H) + ((size_t)u.gt * 256 + u.pn * 128 + r) * 256 + 16 * ns + 4 * fq) = o; }
        else { const float wt = ((const float*)(ws + WS_PW))[u.e * CAP + slot0 + r];
#pragma unroll
            for (int n = 0; n < NG; ++n) { u32x2 o; o.x = cvt_pk_bf16(acc[n][0] * wt, acc[n][1] * wt); o.y = cvt_pk_bf16(acc[n][2] * wt, acc[n][3] * wt);
                *(u32x2*)((bf16*)(ws + WS_Y2) + (size_t)dst * 1024 + 64 * ns + 16 * n + 4 * fq) = o; } } }
}
struct PhGateUp {
    static constexpr bool GATHER = true; static constexpr int LDA = 1024, K = 1024, LDB = 1024, HSTEPB = 128 * 1024 * 2;
    unsigned char* ws; const char* Abase; LAS unsigned char* lds; int G, c, nn;
    __device__ __forceinline__ bool next(int i, Unit& u) const { const int idx = i * G + c; if (idx >= 2 * nn) return false; u.pn = idx & 1; moe_decode(lds, ((const LAS int*)(lds + AUX_OFF))[MT_NLIST + (idx >> 1)], u); return true; }
    __device__ __forceinline__ void a_offs(const Unit& u, int tid, unsigned (&o)[2][2]) const { const int* pdst = (const int*)(ws + WS_PDST);
#pragma unroll
        for (int i = 0; i < 2; ++i) { int R, C; gm::stage_rc(tid * 16 + i * 8192, R, C);
#pragma unroll
            for (int h = 0; h < 2; ++h) { int slot = u.pm * 256 + 128 * h + R; slot = slot < u.cnt ? slot : u.cnt - 1; const int tok = pdst[u.e * CAP + slot] >> 1; o[h][i] = (unsigned)(tok * 1024 + C) * 2u; } }
    }
    __device__ __forceinline__ const char* a_tile(const Unit&) const { return Abase; }
    __device__ __forceinline__ const char* b_tile(const Unit& u) const { return (const char*)(ws + WS_WGU) + ((size_t)u.e * 512 + u.pn * 256) * 1024 * 2; }
    __device__ __forceinline__ void epi(EPI_ARGS) const { EPI_OPAQUE
        const int r0 = wr * 64 + fr, col0 = u.pn * 128 + wc * 32 + 8 * fq; const float* ps = (const float*)(ws + WS_PS) + u.e * CAP; bf16* H = (bf16*)(ws + WS_H);
        float sv[2][4];
#pragma unroll
        for (int ai = 0; ai < 2; ++ai)
#pragma unroll
            for (int m = 0; m < 4; ++m) { int slot = u.pm * 256 + r0 + ai * 128 + m * 16; slot = slot < u.cnt ? slot : u.cnt - 1; sv[ai][m] = ps[slot]; }
        EPI_FENCE();
#pragma unroll
        for (int ai = 0; ai < 2; ++ai)
#pragma unroll
            for (int m = 0; m < 4; ++m) { const int r = r0 + ai * 128 + m * 16; const float s = sv[ai][m];
                f32x4 v0, v1;
#pragma unroll
                for (int j = 0; j < 4; ++j) { const float g0 = acc[ai][0][m][0][j] * s, u0 = acc[ai][1][m][0][j] * s, g1 = acc[ai][0][m][1][j] * s, u1 = acc[ai][1][m][1][j] * s;
                    v0[j] = g0 * fast_sigmoid(g0) * u0; v1[j] = g1 * fast_sigmoid(g1) * u1; }
                *(u32x4*)(H + ((size_t)u.gt * 256 + r) * 256 + col0) = pack8(v0, v1); }
        EPI_FENCE();
    }
};
struct PhDown {
    static constexpr bool GATHER = false; static constexpr int LDA = 256, K = 256, LDB = 256, HSTEPB = 128 * 256 * 2;
    unsigned char* ws; const char* Abase; LAS unsigned char* lds; int G, c, nn;
    __device__ __forceinline__ bool next(int i, Unit& u) const { const int idx = i * G + c; if (idx >= 4 * nn) return false; u.pn = idx & 3; moe_decode(lds, ((const LAS int*)(lds + AUX_OFF))[MT_NLIST + (idx >> 2)], u); return true; }
    NO_GATHER __device__ __forceinline__ const char* a_tile(const Unit& u) const { return Abase + (size_t)(u.gt * 256) * 256 * 2; }
    __device__ __forceinline__ const char* b_tile(const Unit& u) const { return (const char*)(ws + WS_WD) + ((size_t)u.e * 1024 + u.pn * 256) * 256 * 2; }
    __device__ __forceinline__ void epi(EPI_ARGS) const { EPI_OPAQUE
        const int r0 = u.pm * 256 + wr * 64 + fr, col0 = u.pn * 256 + wc * 32 + 8 * fq; const int* pdst = (const int*)(ws + WS_PDST) + u.e * CAP; const float* pw = (const float*)(ws + WS_PW) + u.e * CAP; bf16* Y2 = (bf16*)(ws + WS_Y2);
        int slot = r0 < u.cnt ? r0 : u.cnt - 1; int dn = pdst[slot]; float wn = pw[slot];
#pragma unroll
        for (int g = 0; g < 8; ++g) { const int ai = g >> 2, m = g & 3; const int dcur = dn; const float wcur = wn;
            if (g < 7) { int s2 = r0 + ((g + 1) >> 2) * 128 + ((g + 1) & 3) * 16; s2 = s2 < u.cnt ? s2 : u.cnt - 1; dn = pdst[s2]; wn = pw[s2]; }
            if (r0 + ai * 128 + m * 16 < u.cnt) { bf16* yp = Y2 + (size_t)dcur * 1024 + col0;
#pragma unroll
                for (int bj = 0; bj < 2; ++bj) *(u32x4*)(yp + bj * 128) = pack8(acc[ai][bj][m][0] * wcur, acc[ai][bj][m][1] * wcur); }
            EPI_FENCE(); }
    }
};
struct PhSloc {
    static constexpr bool GATHER = false; static constexpr int LDA = 384, K = 256, LDB = 256, HSTEPB = 0;
    unsigned char* ws; const char* Abase; int G, c;
    __device__ __forceinline__ bool next(int i, Unit& u) const { const int idx = i * G + c; if (idx >= 256) return false; u.e = idx >> 2; u.pm = idx & 3; u.pn = 0; u.gt = 0; u.cnt = 0; return true; }
    NO_GATHER __device__ __forceinline__ const char* a_tile(const Unit& u) const { return Abase + (size_t)(u.e * 1024 + u.pm * 256) * 384 * 2; }
    __device__ __forceinline__ const char* b_tile(const Unit& u) const { return (const char*)(ws + WS_SSM) + (size_t)u.e * SSM_G_BYTES; }
    __device__ __forceinline__ void epi(EPI_ARGS) const { EPI_OPAQUE
        const int r0 = u.e * 1024 + u.pm * 256 + wr * 64 + fr, col0 = wc * 32 + 8 * fq; float* Sloc = (float*)(ws + WS_SLOC);
#pragma unroll
        for (int ai = 0; ai < 2; ++ai)
#pragma unroll
            for (int m = 0; m < 4; ++m) { float* p = Sloc + (size_t)(r0 + ai * 128 + m * 16) * 128 + col0; *(f32x4*)p = acc[ai][0][m][0]; *(f32x4*)(p + 4) = acc[ai][0][m][1]; }
    }
};
struct PhY {
    static constexpr bool GATHER = false; static constexpr int LDA = 384, K = 384, LDB = 384, HSTEPB = 128 * 384 * 2;
    unsigned char* ws; const char* Abase; int G, c;
    __device__ __forceinline__ bool next(int i, Unit& u) const { const int idx = i * G + c; if (idx >= 256) return false; u.e = idx >> 2; u.pm = idx & 3; u.pn = 0; u.gt = 0; u.cnt = 0; return true; }
    NO_GATHER __device__ __forceinline__ const char* a_tile(const Unit& u) const { return Abase + (size_t)(u.e * 1024 + u.pm * 256) * 384 * 2; }
    __device__ __forceinline__ const char* b_tile(const Unit& u) const { return (const char*)(ws + WS_SSM) + (size_t)u.e * SSM_G_BYTES + SSM_A2_OFF; }
    __device__ __forceinline__ void epi(EPI_ARGS) const { EPI_OPAQUE
        const int nb = (u.pm & 1) * 256 + wr * 64 + fr;
        bf16* p = (bf16*)(ws + WS_G) + ((size_t)(u.pm >> 1) * SEQ + 16 * nb + 2 * wc + (fq >> 1)) * 1024 + 16 * u.e + 8 * (fq & 1);
#pragma unroll
        for (int ai = 0; ai < 2; ++ai)
#pragma unroll
            for (int m = 0; m < 4; ++m) {
#pragma unroll
                for (int bj = 0; bj < 2; ++bj) { f32x4 v0, v1;
#pragma unroll
                    for (int j = 0; j < 4; ++j) { v0[j] = fast_gelu(acc[ai][bj][m][0][j]); v1[j] = fast_gelu(acc[ai][bj][m][1][j]); }
                    *(u32x4*)(p + bj * 8 * 1024) = pack8(v0, v1); }
                p += (m == 3 ? (128 - 48) : 16) * 16 * 1024; asm volatile("" : "+v"(p) :: "memory"); }
    }
};

namespace at {
constexpr int NSLOT = 4, SLOTB = 8192;
constexpr int LDS_K = 0, LDS_V = NSLOT * SLOTB, LDS_WS = 2 * NSLOT * SLOTB, LDS_TBL = LDS_WS + 2048, LDS_OST = LDS_TBL + 2048, LDS_TOTAL = LDS_OST + 8 * 4096;
typedef short v4i16_t __attribute__((ext_vector_type(4)));
__device__ __forceinline__ int crow(int r, int hi) { return (r & 3) + 8 * (r >> 2) + 4 * hi; }
__device__ __forceinline__ void glds16(const void* gsrc, unsigned lds_dst) { unsigned keep;
    asm volatile("s_mov_b32 %0, m0\n\ts_mov_b32 m0, %2\n\ts_nop 0\n\tglobal_load_lds_dwordx4 %1, off\n\ts_mov_b32 m0, %0" : "=&s"(keep) : "v"(gsrc), "s"(lds_dst) : "memory"); }
__device__ __forceinline__ s16x4 vtr(const LAS unsigned char* p) { return __builtin_bit_cast(s16x4, __builtin_amdgcn_ds_read_tr16_b64_v4i16((LAS v4i16_t*)p)); }
#define AT_WAIT_BAR(N) asm volatile("s_waitcnt vmcnt(" #N ") lgkmcnt(0)\n\ts_barrier" ::: "memory")
template <int THR> __device__ __forceinline__ void attn_unit(int b, int h, int qb, const bf16* Q, const bf16* __restrict__ K, const bf16* __restrict__ V, bf16* O, const float* __restrict__ relb, LAS unsigned char* shm, int wid) {
    const int lane = lane_now(), tid = wid * 64 + lane, r32 = lane & 31, hi = lane >> 5;
    const long rowbase = (long)b * SEQ; const int q0 = qb * 256; const int cq = 4 * qb + (wid >> 1);
    const bf16* Qw = Q + (rowbase + q0 + wid * 32) * D + h * 64;
    const unsigned lds0 = (unsigned)(uintptr_t)shm;
    LAS float* wsf = (LAS float*)(shm + LDS_WS) + wid * 64; LAS float* tbl = (LAS float*)(shm + LDS_TBL);
    const int kc_lo = (4 * qb - 8) < 0 ? 0 : (4 * qb - 8); const int NT = 4 * qb + 3 - kc_lo + 1;
    const int ta = ((cq - 8) < kc_lo ? kc_lo : (cq - 8)) - kc_lo, tb_ = cq - kc_lo;
    if (tid < 320) tbl[tid] = relb[h * NREL + (tid < 256 ? tid : 256)] * LOG2E;
    const bf16* ksrc = K + (rowbase + kc_lo * 64 + lane) * D + h * 64 + wid * 8;
    const bf16* vsrc = V + (rowbase + kc_lo * 64 + 16 * (wid & 3) + (lane >> 2)) * D + h * 64 + (wid >> 2) * 32 + (lane & 3) * 8;
    const unsigned kdst = lds0 + LDS_K + wid * 1024, vdst = lds0 + LDS_V + wid * 1024;
#define AT_DMA(t) do { const unsigned so_ = (unsigned)((t) & 3) * SLOTB; glds16(ksrc + (long)(t) * 64 * D, (unsigned)__builtin_amdgcn_readfirstlane(kdst + so_)); glds16(vsrc + (long)(t) * 64 * D, (unsigned)__builtin_amdgcn_readfirstlane(vdst + so_)); } while (0)
    bf16x8 qr[4];
#pragma unroll
    for (int d0 = 0; d0 < 4; ++d0) qr[d0] = *reinterpret_cast<const bf16x8*>(&Qw[(long)r32 * D + d0 * 16 + hi * 8]);
    AT_DMA(0); AT_DMA(1); AT_DMA(2);
    asm volatile("" : "+v"(qr[0]), "+v"(qr[1]), "+v"(qr[2]), "+v"(qr[3]));
    float mrow = -1e30f, lsum = 0.f; f32x16 o[2]; o[0] = f32x16{}; o[1] = f32x16{};
    f32x16 s0 = f32x16{}, s1 = f32x16{};
    f32x16 cfar = f32x16{};
    const int qoff = 32 * (wid & 1) + r32 + 128 - 4 * hi;
#define AT_CINIT(P0, P1, kc_, msub_) do { const int delta_ = cq - (kc_); \
        if (delta_ >= 3) { P0 = cfar; P1 = cfar; } \
        else { const LAS float* tb = tbl + (64 * delta_ + qoff); _Pragma("unroll") for (int r = 0; r < 16; ++r) { const int kj = (r & 3) + 8 * (r >> 2); P0[r] = tb[-kj] - (msub_); P1[r] = tb[-kj - 32] - (msub_); } } } while (0)
#define AT_KLOAD(t_) do { const LAS unsigned char* kp = shm + LDS_K + ((t_) & 3) * SLOTB + hi * 1024 + r32 * 16; \
        _Pragma("unroll") for (int d0 = 0; d0 < 4; ++d0) { kf[2 * d0] = *(const LAS bf16x8*)(kp + d0 * 2048); kf[2 * d0 + 1] = *(const LAS bf16x8*)(kp + d0 * 2048 + 512); } } while (0)
#define AT_QK(P0, P1) do { _Pragma("unroll") for (int d0 = 0; d0 < 4; ++d0) { \
            P0 = __builtin_amdgcn_mfma_f32_32x32x16_bf16(kf[2 * d0], qr[d0], P0, 0, 0, 0); P1 = __builtin_amdgcn_mfma_f32_32x32x16_bf16(kf[2 * d0 + 1], qr[d0], P1, 0, 0, 0); } } while (0)
#define AT_CFAR() do { const float c0_ = tbl[256] - mrow; _Pragma("unroll") for (int r = 0; r < 16; ++r) cfar[r] = c0_; } while (0)
#define AT_STATS() do { float ra = fmaxf(fmaxf(s0[0], s0[1]), s1[0]), rb2 = fmaxf(fmaxf(s0[2], s0[3]), s1[1]); ra = fmaxf(fmaxf(ra, s1[2]), s1[3]); \
        _Pragma("unroll") for (int r = 4; r < 16; r += 4) { ra = fmaxf(fmaxf(ra, s0[r]), s0[r + 1]); rb2 = fmaxf(fmaxf(rb2, s0[r + 2]), s0[r + 3]); ra = fmaxf(fmaxf(ra, s1[r]), s1[r + 1]); rb2 = fmaxf(fmaxf(rb2, s1[r + 2]), s1[r + 3]); } \
        float rm = fmaxf(ra, rb2); { auto rr = __builtin_amdgcn_permlane32_swap(__float_as_uint(rm), __float_as_uint(rm), false, false); rm = fmaxf(__uint_as_float(rr[0]), __uint_as_float(rr[1])); } \
        if (mrow < -1e29f) { mrow = rm; _Pragma("unroll") for (int r = 0; r < 16; ++r) { s0[r] -= rm; s1[r] -= rm; } AT_CFAR(); } \
        else if (__any(rm > (float)THR)) { const float dl = fmaxf(rm, 0.f), f = __builtin_amdgcn_exp2f(-dl); mrow += dl; lsum *= f; \
            if (hi == 0) wsf[r32] = f; LDS_WAIT(); \
            _Pragma("unroll") for (int r = 0; r < 16; ++r) { const float fr_ = wsf[crow(r, hi)]; o[0][r] *= fr_; o[1][r] *= fr_; s0[r] -= dl; s1[r] -= dl; } AT_CFAR(); } } while (0)
#define AT_EXP_PACK() float sacc = 0.f, sacc2 = 0.f; \
        _Pragma("unroll") for (int r = 0; r < 16; ++r) { s0[r] = __builtin_amdgcn_exp2f(s0[r]); s1[r] = __builtin_amdgcn_exp2f(s1[r]); sacc += s0[r]; sacc2 += s1[r]; } \
        lsum += sacc + sacc2; \
        const u32x4 pw0 = (u32x4){cvtpk_s(s0[0], s0[1]), cvtpk_s(s0[2], s0[3]), cvtpk_s(s0[4], s0[5]), cvtpk_s(s0[6], s0[7])}; \
        const u32x4 pw1 = (u32x4){cvtpk_s(s0[8], s0[9]), cvtpk_s(s0[10], s0[11]), cvtpk_s(s0[12], s0[13]), cvtpk_s(s0[14], s0[15])}; \
        const u32x4 pw2 = (u32x4){cvtpk_s(s1[0], s1[1]), cvtpk_s(s1[2], s1[3]), cvtpk_s(s1[4], s1[5]), cvtpk_s(s1[6], s1[7])}; \
        const u32x4 pw3 = (u32x4){cvtpk_s(s1[8], s1[9]), cvtpk_s(s1[10], s1[11]), cvtpk_s(s1[12], s1[13]), cvtpk_s(s1[14], s1[15])}; \
        const bf16x8 pa[4] = {__builtin_bit_cast(bf16x8, pw0), __builtin_bit_cast(bf16x8, pw1), __builtin_bit_cast(bf16x8, pw2), __builtin_bit_cast(bf16x8, pw3)};
#define AT_VLOAD(t_) do { const LAS unsigned char* vp = shm + LDS_V + ((t_) & 3) * SLOTB + ((lane >> 4) & 1) * 32 + (lane & 3) * 8 + (4 * hi + ((lane & 15) >> 2)) * 64; \
        _Pragma("unroll") for (int d0 = 0; d0 < 2; ++d0) _Pragma("unroll") for (int ks = 0; ks < 4; ++ks) { vlo[d0 * 4 + ks] = vtr(vp + d0 * 4096 + ks * 1024); vhi[d0 * 4 + ks] = vtr(vp + d0 * 4096 + ks * 1024 + 512); } } while (0)
#define AT_PV() do { _Pragma("unroll") for (int d0 = 0; d0 < 2; ++d0) _Pragma("unroll") for (int ks = 0; ks < 4; ++ks) { const s16x4 lo = vlo[d0 * 4 + ks], hh = vhi[d0 * 4 + ks]; \
            const bf16x8 vf = (bf16x8){lo[0], lo[1], lo[2], lo[3], hh[0], hh[1], hh[2], hh[3]}; o[d0] = __builtin_amdgcn_mfma_f32_32x32x16_bf16(pa[ks], vf, o[d0], 0, 0, 0); } } while (0)
    bf16x8 kf[8]; s16x4 vlo[8], vhi[8];
    for (int t = 0; t < NT; ++t) {
        if (t + 2 < NT) { AT_WAIT_BAR(4); } else if (t + 1 < NT) { AT_WAIT_BAR(2); } else { AT_WAIT_BAR(0); }
        if (t + 3 < NT) AT_DMA(t + 3);
        if (t >= ta && t <= tb_) {
            AT_KLOAD(t); AT_VLOAD(t);
            __builtin_amdgcn_sched_barrier(0);
            if (mrow < -1e29f) { const float c0_ = tbl[256]; _Pragma("unroll") for (int r = 0; r < 16; ++r) cfar[r] = c0_; }
            AT_CINIT(s0, s1, kc_lo + t, (mrow < -1e29f ? 0.f : mrow));
            AT_QK(s0, s1);
            AT_STATS();
            AT_EXP_PACK()
            AT_PV();
        }
    }
    { auto rr = __builtin_amdgcn_permlane32_swap(__float_as_uint(lsum), __float_as_uint(lsum), false, false); lsum = __uint_as_float(rr[0]) + __uint_as_float(rr[1]); }
    if (hi == 0) wsf[32 + r32] = lsum;
    LDS_WAIT();
    float rli[16];
#pragma unroll
    for (int r = 0; r < 16; ++r) rli[r] = __builtin_amdgcn_rcpf(wsf[32 + crow(r, hi)]);
    bf16* Ow = O + (rowbase + q0 + wid * 32) * D + h * 64;
    { LAS bf16* stg = (LAS bf16*)(shm + LDS_OST) + wid * 2048;
#pragma unroll
      for (int r = 0; r < 16; ++r) { const int orow = crow(r, hi);
#pragma unroll
          for (int d0 = 0; d0 < 2; ++d0) stg[orow * 64 + d0 * 32 + r32] = f2bf(o[d0][r] * rli[r]); }
      LDS_WAIT();
#pragma unroll
      for (int i = 0; i < 4; ++i) { const int row = i * 8 + (lane >> 3), ch = lane & 7; const u32x4 v = *(const LAS u32x4*)(stg + row * 64 + ch * 8); *(u32x4*)(Ow + (long)row * D + ch * 8) = v; } }
    asm volatile("s_waitcnt lgkmcnt(0)\n\ts_barrier" ::: "memory");
#undef AT_DMA
#undef AT_CINIT
#undef AT_QK
#undef AT_KLOAD
#undef AT_VLOAD
#undef AT_CFAR
#undef AT_STATS
#undef AT_EXP_PACK
#undef AT_PV
}
}

struct Args { const float* in[23]; float* out; unsigned char* ws; int ph_lo, ph_hi, li, pad; };

struct TrDesc { const float* W; bf16* WT; const float* ks; int ldw, k0, n0, ldt, drow0; };
__device__ __forceinline__ void tr_load(const TrDesc& d, float (&v)[32], int lane) {
    const float* wp = d.W + (size_t)(d.k0 + (lane >> 5)) * d.ldw + d.n0 + (lane & 31);
#pragma unroll
    for (int i = 0; i < 32; ++i) v[i] = wp[(size_t)(2 * i) * d.ldw];
}
__device__ __forceinline__ void tr_store(const TrDesc& d, float (&v)[32], LAS float* scr, int lane) {
    if (d.ks) {
#pragma unroll
        for (int i = 0; i < 32; ++i) v[i] *= d.ks[d.k0 + 2 * i + (lane >> 5)]; }
#pragma unroll
    for (int i = 0; i < 32; ++i) scr[(2 * i + (lane >> 5)) * 33 + (lane & 31)] = v[i];
    LDS_WAIT(); asm volatile("" ::: "memory");
    const int c = lane & 7;
#pragma unroll
    for (int j = 0; j < 4; ++j) { const int n = (lane >> 3) + 8 * j; const LAS float* s = scr + (8 * c) * 33 + n;
        u32x4 o; o.x = pk2(s[0 * 33], s[1 * 33]); o.y = pk2(s[2 * 33], s[3 * 33]); o.z = pk2(s[4 * 33], s[5 * 33]); o.w = pk2(s[6 * 33], s[7 * 33]);
        *(u32x4*)(d.WT + (size_t)(d.drow0 + n) * d.ldt + d.k0 + 8 * c) = o; }
    LDS_WAIT(); asm volatile("" ::: "memory");
}
struct TrSrc { const float* w_qkv; const float* w_o; const float* w_out; const float* wg; const float* wu; const float* wd; const float* gn; unsigned char* ws; int nd, first, last; };
__device__ __forceinline__ TrDesc tr_desc(const TrSrc& S, int it) {
    TrDesc d; d.ks = nullptr;
    if (it < S.nd) {
        if (it < 1536) { const int kb = it / 96, nb = it % 96; d.W = S.w_qkv; d.ldw = 3072; d.k0 = kb * 64; d.n0 = nb * 32; d.WT = (bf16*)(S.ws + WS_WQKV); d.ldt = 1024; d.drow0 = nb * 32; }
        else if (it < 2048) { const int r = it - 1536, kb = r >> 5, nb = r & 31; d.W = S.w_o; d.ldw = 1024; d.k0 = kb * 64; d.n0 = nb * 32; d.WT = (bf16*)(S.ws + WS_WO); d.ldt = 1024; d.drow0 = nb * 32; }
        else { const int r = it - 2048, kb = r >> 6, nb = r & 63, n0 = nb * 32, ag = n0 >> 10, cc = n0 & 1023; d.W = S.w_out; d.ldw = 2048; d.k0 = kb * 64; d.n0 = n0; d.WT = (bf16*)(S.ws + WS_WOUT); d.ldt = 1024; d.drow0 = 256 * (cc >> 7) + 128 * ag + (cc & 127); }
    } else { const int m = it - S.nd;
        if (m < 8192) { const int which = m >> 12, r = m & 4095, e = r >> 7, kb = (r >> 3) & 15, nb = r & 7, n0 = nb * 32;
            d.W = (which ? S.wu : S.wg) + (size_t)e * 1024 * 256; d.ldw = 256; d.k0 = kb * 64; d.n0 = n0; d.WT = (bf16*)(S.ws + WS_WGU); d.ldt = 1024; d.drow0 = e * 512 + 256 * (n0 >> 7) + 128 * which + (n0 & 127); d.ks = S.gn; }
        else { const int r = m - 8192, e = r >> 7, kb = (r >> 5) & 3, nb = r & 31; d.W = S.wd + (size_t)e * 256 * 1024; d.ldw = 1024; d.k0 = kb * 64; d.n0 = nb * 32; d.WT = (bf16*)(S.ws + WS_WD); d.ldt = 256; d.drow0 = e * 1024 + nb * 32; } }
    return d;
}
__device__ __forceinline__ TrSrc mk_trsrc(const float* a, const float* b, const float* c, const float* g, const float* u, const float* d, const float* gn, unsigned char* ws, int nd, int first, int last) { TrSrc S; S.w_qkv = a; S.w_o = b; S.w_out = c; S.wg = g; S.wu = u; S.wd = d; S.gn = gn; S.ws = ws; S.nd = nd; S.first = first; S.last = last; return S; }
__device__ __forceinline__ void tr_stream(const TrSrc& S, LAS float* scr, int gw, int NGW, int lane) {
    const int N = S.last; int it = S.first + gw; if (it >= N) return;
    float va[32], vb[32]; TrDesc d0 = tr_desc(S, it), d1 = d0; tr_load(d0, va, lane);
    for (;;) {
        int nx = it + NGW; if (nx < N) { d1 = tr_desc(S, nx); tr_load(d1, vb, lane); }
        tr_store(d0, va, scr, lane); it = nx; if (it >= N) break;
        nx = it + NGW; if (nx < N) { d0 = tr_desc(S, nx); tr_load(d0, va, lane); }
        tr_store(d1, vb, scr, lane); it = nx; if (it >= N) break;
    }
}
__device__ __forceinline__ void ssm_mats(int g, int q, const float* lre, const float* lim, const float* lstep, const float* bre, const float* bim, const float* cre, const float* cim, const float* dsk,
                                         unsigned char* ssm_ws, float* a16g, LAS float* L, int tid) {
    LAS float* pwr = L; LAS float* pwi = L + 64 * 17; LAS float* bbr = L + 2 * 64 * 17; LAS float* bbi = bbr + 1024; LAS float* ccr = bbi + 1024; LAS float* cci = ccr + 1024; LAS float* Kt = cci + 1024;
    if (tid < 64) { const int p = tid;
        const float lr = fminf(lre[g * 64 + p], -1e-4f), li = lim[g * 64 + p], step = expf(lstep[g]);
        const float decay = expf(lr * step), ang = li * step, ar = decay * cosf(ang), ai = decay * sinf(ang);
        const float den = lr * lr + li * li, nr = ar - 1.f, fr = (nr * lr + ai * li) / den, fi = (ai * lr - nr * li) / den;
        for (int c = 0; c < 16; ++c) { const float br = bre[(g * 64 + p) * 16 + c], bi = bim[(g * 64 + p) * 16 + c]; bbr[p * 16 + c] = fr * br - fi * bi; bbi[p * 16 + c] = fr * bi + fi * br;
            ccr[c * 64 + p] = cre[(g * 16 + c) * 64 + p]; cci[c * 64 + p] = cim[(g * 16 + c) * 64 + p]; }
        float xr = 1.f, xi = 0.f;
        for (int n = 0; n <= 16; ++n) { pwr[p * 17 + n] = xr; pwi[p * 17 + n] = xi; const float t = xr * ar - xi * ai; xi = xr * ai + xi * ar; xr = t; }
        if (q == 0) { a16g[(g * 64 + p) * 2] = pwr[p * 17 + 16]; a16g[(g * 64 + p) * 2 + 1] = pwi[p * 17 + 16]; }
    }
    __syncthreads();
    if (tid < 256) { const int tl = tid >> 6, c = (tid >> 2) & 15, cq = tid & 3, tau = 4 * q + tl;
        float s0 = 0.f, s1 = 0.f, s2 = 0.f, s3 = 0.f;
        for (int p = 0; p < 64; ++p) { const float cr = ccr[c * 64 + p], ci = cci[c * 64 + p], ar = pwr[p * 17 + tau], ai = pwi[p * 17 + tau]; const float tr = cr * ar - ci * ai, ti = cr * ai + ci * ar;
            const f32x4 br = *(const LAS f32x4*)(bbr + p * 16 + 4 * cq), bi = *(const LAS f32x4*)(bbi + p * 16 + 4 * cq);
            s0 += tr * br[0] - ti * bi[0]; s1 += tr * br[1] - ti * bi[1]; s2 += tr * br[2] - ti * bi[2]; s3 += tr * br[3] - ti * bi[3]; }
        if (tau == 0) { const float dd = dsk[g * 16 + c]; if (4 * cq == (c & ~3)) { if ((c & 3) == 0) s0 += dd; else if ((c & 3) == 1) s1 += dd; else if ((c & 3) == 2) s2 += dd; else s3 += dd; } }
        LAS float* kp = Kt + tl * 256 + c * 16 + 4 * cq; kp[0] = s0; kp[1] = s1; kp[2] = s2; kp[3] = s3; }
    __syncthreads();
    bf16* Bend = (bf16*)(ssm_ws + (size_t)g * SSM_G_BYTES); bf16* A2 = (bf16*)(ssm_ws + (size_t)g * SSM_G_BYTES + SSM_A2_OFF);
    for (int o = tid; o < 2048; o += NTHR) { const int tl = o >> 9, i = (o >> 5) & 15, c = (o >> 1) & 15, hf = o & 1, tau = 4 * q + tl, j = i - tau;
        if (j >= 0) { const LAS float* kp = Kt + tl * 256 + c * 16 + 8 * hf; u32x4 w; w.x = pk2(kp[0], kp[1]); w.y = pk2(kp[2], kp[3]); w.z = pk2(kp[4], kp[5]); w.w = pk2(kp[6], kp[7]);
            *(u32x4*)(A2 + (size_t)(i * 16 + c) * 384 + j * 16 + 8 * hf) = w; } }
    for (int o = tid; o < 2048; o += NTHR) { const int il = o >> 9, c = (o >> 5) & 15, j = (o >> 1) & 15, hf = o & 1, i = 4 * q + il;
        if (j > i) *(u32x4*)(A2 + (size_t)(i * 16 + c) * 384 + j * 16 + 8 * hf) = (u32x4){0u, 0u, 0u, 0u}; }
    for (int o = tid; o < 1024; o += NTHR) { const int il = o >> 8, c = (o >> 4) & 15, k8 = (o & 15) * 8, i = 4 * q + il; float v[8];
#pragma unroll
        for (int qq = 0; qq < 4; ++qq) { const int p = (k8 >> 1) + qq; const float cr = ccr[c * 64 + p], ci = cci[c * 64 + p], ar = pwr[p * 17 + i + 1], ai = pwi[p * 17 + i + 1];
            v[2 * qq] = cr * ar - ci * ai; v[2 * qq + 1] = -(cr * ai + ci * ar); }
        u32x4 w; w.x = pk2(v[0], v[1]); w.y = pk2(v[2], v[3]); w.z = pk2(v[4], v[5]); w.w = pk2(v[6], v[7]); *(u32x4*)(A2 + (size_t)(i * 16 + c) * 384 + 256 + k8) = w; }
    for (int o = tid; o < 1024; o += NTHR) { const int n = 32 * q + (o >> 5), k8 = (o & 31) * 8, p = n >> 1, ri = n & 1, j = k8 >> 4; float v[8];
        const float ar = pwr[p * 17 + 15 - j], ai = pwi[p * 17 + 15 - j];
#pragma unroll
        for (int qq = 0; qq < 8; ++qq) { const int c2 = (k8 & 15) + qq; const float br = bbr[p * 16 + c2], bi = bbi[p * 16 + c2]; v[qq] = ri ? (ar * bi + ai * br) : (ar * br - ai * bi); }
        u32x4 w; w.x = pk2(v[0], v[1]); w.y = pk2(v[2], v[3]); w.z = pk2(v[4], v[5]); w.w = pk2(v[6], v[7]); *(u32x4*)(Bend + (size_t)n * 256 + k8) = w; }
    __syncthreads();
}

__device__ __forceinline__ void router_phase(const bf16* __restrict__ h, const u32x4* __restrict__ rwt, const float* __restrict__ bgr, const float* __restrict__ ber, unsigned* cntg,
                                             int* pdst, float* pw, float* ps, float* srow, LAS unsigned char* lds, int vcu, int G, int wid, bool prefilled) {
    const int lane = lane_now(), tid = wid * 64 + lane;
    LAS bf16* Wl = (LAS bf16*)lds;
    if (!prefilled) for (int i = tid; i < RW_LAYER_BYTES / 16; i += NTHR) ((LAS u32x4*)lds)[i] = rwt[i];
    LAS int* lc = (LAS int*)(lds + RSCR_OFF); LAS int* lbase = lc + 32;
    const int rb = wid & 3, kh = wid >> 2, row = lane & 15, kq = lane >> 4;
    for (int blk = vcu; blk < M / 64; blk += G) {
        if (tid < 32) lc[tid] = 0;
        __syncthreads();
        const int t0 = blk * 64;
        const bf16* hp = h + (size_t)(t0 + 16 * rb + row) * D + 512 * kh + 8 * kq;
        const LAS bf16* wp0 = Wl + row * RW_PITCH + 512 * kh + 8 * kq; const LAS bf16* wp1 = wp0 + 16 * RW_PITCH; const LAS bf16* wp2 = Wl + (32 + (row & 3)) * RW_PITCH + 512 * kh + 8 * kq;
        f32x4 a0 = {0.f, 0.f, 0.f, 0.f}, a1 = a0, a2 = a0; float ssl = 0.f;
#pragma unroll 4
        for (int j = 0; j < 16; ++j) { const u32x4 hw = *(const u32x4*)(hp + 32 * j); const bf16x8 av = __builtin_bit_cast(bf16x8, hw);
#pragma unroll
            for (int i = 0; i < 4; ++i) { const float lo_ = __uint_as_float(hw[i] << 16), hi_ = __uint_as_float(hw[i] & 0xffff0000u); ssl += lo_ * lo_ + hi_ * hi_; }
            const bf16x8 b0h = *(const LAS bf16x8*)(wp0 + 32 * j), b0l = *(const LAS bf16x8*)(wp0 + RW_PLANE + 32 * j), b1h = *(const LAS bf16x8*)(wp1 + 32 * j), b1l = *(const LAS bf16x8*)(wp1 + RW_PLANE + 32 * j),
                         b2h = *(const LAS bf16x8*)(wp2 + 32 * j), b2l = *(const LAS bf16x8*)(wp2 + RW_PLANE + 32 * j);
            a0 = __builtin_amdgcn_mfma_f32_16x16x32_bf16(av, b0h, a0, 0, 0, 0); a0 = __builtin_amdgcn_mfma_f32_16x16x32_bf16(av, b0l, a0, 0, 0, 0);
            a1 = __builtin_amdgcn_mfma_f32_16x16x32_bf16(av, b1h, a1, 0, 0, 0); a1 = __builtin_amdgcn_mfma_f32_16x16x32_bf16(av, b1l, a1, 0, 0, 0);
            a2 = __builtin_amdgcn_mfma_f32_16x16x32_bf16(av, b2h, a2, 0, 0, 0); a2 = __builtin_amdgcn_mfma_f32_16x16x32_bf16(av, b2l, a2, 0, 0, 0); }
        ssl += __shfl_xor(ssl, 16); ssl += __shfl_xor(ssl, 32);
        LAS float* P = (LAS float*)(lds + RSCR_OFF + 256);
        LAS float* pp = P + (16 * rb) * 40;
        if (kh == 1) {
#pragma unroll
            for (int r = 0; r < 4; ++r) { const int tk = 4 * kq + r; pp[tk * 40 + row] = a0[r]; pp[tk * 40 + 16 + row] = a1[r]; if (row < 4) pp[tk * 40 + 32 + row] = a2[r]; }
            if (kq == 0) pp[row * 40 + 36] = ssl; }
        __syncthreads();
        if (kh == 0) {
#pragma unroll
            for (int r = 0; r < 4; ++r) { const int tk = 4 * kq + r; pp[tk * 40 + row] += a0[r]; pp[tk * 40 + 16 + row] += a1[r]; if (row < 4) pp[tk * 40 + 32 + row] += a2[r]; }
            if (kq == 0) pp[row * 40 + 36] += ssl; }
        __syncthreads();
        int e1 = 0, e2 = 0; float w1 = 0.f, w2 = 0.f, s = 0.f; int sl1 = 0, sl2 = 0;
        if (tid < 64) { LAS float* p0 = P + tid * 40;
            s = rsqrtf(p0[36] * (1.f / D) + RMS_EPS);
            for (int o = 0; o < 36; ++o) p0[o] = p0[o] * s + (o < 4 ? bgr[o] : ber[o - 4]);
            int gi = 0; float gmx = p0[0];
            for (int i = 1; i < 4; ++i) if (p0[i] > gmx) { gmx = p0[i]; gi = i; }
            float den = 0.f; for (int i = 0; i < 4; ++i) den += __expf(p0[i] - gmx);
            const float gp = 1.f / den; const LAS float* sl = p0 + 4 + 8 * gi;
            int i1 = 0; float l1 = sl[0]; for (int i = 1; i < 8; ++i) if (sl[i] > l1) { l1 = sl[i]; i1 = i; }
            int i2 = -1; float l2 = -3.4e38f; for (int i = 0; i < 8; ++i) if (i != i1 && sl[i] > l2) { l2 = sl[i]; i2 = i; }
            const float ex = __expf(l2 - l1); w1 = gp / (1.f + ex); w2 = gp * ex / (1.f + ex); e1 = gi * 8 + i1; e2 = gi * 8 + i2;
            sl1 = __hip_atomic_fetch_add(&lc[e1], 1, __ATOMIC_RELAXED, __HIP_MEMORY_SCOPE_WORKGROUP); sl2 = __hip_atomic_fetch_add(&lc[e2], 1, __ATOMIC_RELAXED, __HIP_MEMORY_SCOPE_WORKGROUP);
            }
        __syncthreads();
        if (tid < 32) { const int n = lc[tid]; lbase[tid] = n ? (int)__hip_atomic_fetch_add(cntg + tid * 64, (unsigned)n, RLX_AGENT) : 0; }
        __syncthreads();
        if (tid < 64) { const int t = t0 + tid; int i1 = lbase[e1] + sl1, i2 = lbase[e2] + sl2;
            if (i1 < CAP) { pdst[e1 * CAP + i1] = 2 * t; pw[e1 * CAP + i1] = w1; ps[e1 * CAP + i1] = s; }
            if (i2 < CAP) { pdst[e2 * CAP + i2] = 2 * t + 1; pw[e2 * CAP + i2] = w2; ps[e2 * CAP + i2] = s; } }
        __syncthreads();
    }
}

template <bool FINAL> __device__ __forceinline__ void combine_phase(const bf16* __restrict__ hin, const bf16* __restrict__ Y2, const float* __restrict__ g, bf16* __restrict__ hout, bf16* __restrict__ xng, float* __restrict__ outf, int vcu, int G, int wid, int lane) {
    for (int base = vcu * 16; base < M; base += G * 16) {
#pragma unroll
        for (int rr = 0; rr < 2; ++rr) { const int row = base + 2 * wid + rr;
            float4 v[4]; float ss = 0.f;
#pragma unroll
            for (int j = 0; j < 4; ++j) { const int c = 4 * (lane + 64 * j);
                const u32x2 hh = *(const u32x2*)(hin + (size_t)row * D + c), ya = *(const u32x2*)(Y2 + ((size_t)2 * row) * D + c), yb = *(const u32x2*)(Y2 + ((size_t)2 * row + 1) * D + c);
                v[j].x = __uint_as_float(hh.x << 16) + __uint_as_float(ya.x << 16) + __uint_as_float(yb.x << 16); v[j].y = __uint_as_float(hh.x & 0xffff0000u) + __uint_as_float(ya.x & 0xffff0000u) + __uint_as_float(yb.x & 0xffff0000u);
                v[j].z = __uint_as_float(hh.y << 16) + __uint_as_float(ya.y << 16) + __uint_as_float(yb.y << 16); v[j].w = __uint_as_float(hh.y & 0xffff0000u) + __uint_as_float(ya.y & 0xffff0000u) + __uint_as_float(yb.y & 0xffff0000u);
                ss += v[j].x * v[j].x + v[j].y * v[j].y + v[j].z * v[j].z + v[j].w * v[j].w;
                if (!FINAL) { u32x2 w; w.x = pk2(v[j].x, v[j].y); w.y = pk2(v[j].z, v[j].w); *(u32x2*)(hout + (size_t)row * D + c) = w; } }
            ss = wave_sum(ss); const float s = rsqrtf(ss * (1.f / D) + RMS_EPS);
#pragma unroll
            for (int j = 0; j < 4; ++j) { const int c = 4 * (lane + 64 * j); const float4 gg = *(const float4*)(g + c);
                const float ox = v[j].x * s * gg.x, oy = v[j].y * s * gg.y, oz = v[j].z * s * gg.z, ow = v[j].w * s * gg.w;
                if (FINAL) { float4 o; o.x = ox; o.y = oy; o.z = oz; o.w = ow; *(float4*)(outf + (size_t)row * D + c) = o; }
                else { u32x2 w; w.x = pk2(ox, oy); w.y = pk2(oz, ow); *(u32x2*)(xng + xng_off(row, c)) = w; } } }
    }
}

__device__ __forceinline__ void scan_unit(int g, int pm, const float* __restrict__ Sloc, const float* __restrict__ a16g, bf16* xng, unsigned* ctl, LAS unsigned char* lds, int wid) {
    const int tid = wid * 64 + lane_now(), p = tid & 63, q = tid >> 6, b = pm >> 1, half = pm & 1;
    LAS float* E = (LAS float*)(lds + AUX_OFF);
    const float ar = a16g[(g * 64 + p) * 2], ai = a16g[(g * 64 + p) * 2 + 1];
    float pr = ar, pi = ai;
#pragma unroll
    for (int k = 0; k < 5; ++k) { const float nr = pr * pr - pi * pi, ni = 2.f * pr * pi; pr = nr; pi = ni; }
    unsigned* flag = ctl + CW_CARRYF + (2 * g + b) * 64;
    unsigned long long* slot = (unsigned long long*)ctl + CW_CARRY / 2 + (2 * g + b) * 64 + p;
    const size_t row0 = (size_t)g * 1024 + b * 512 + half * 256 + q * 32;
    const float* sp = Sloc + row0 * 128 + 2 * p;
    float2 v[32];
#pragma unroll
    for (int s = 0; s < 32; ++s) v[s] = *(const float2*)(sp + (size_t)s * 128);
    float xr = 0.f, xi = 0.f;
#pragma unroll
    for (int s = 0; s < 32; ++s) { const float nr = ar * xr - ai * xi + v[s].x, ni = ar * xi + ai * xr + v[s].y; xr = nr; xi = ni; }
    E[(q * 64 + p) * 2] = xr; E[(q * 64 + p) * 2 + 1] = xi;
    if (half && tid == 0) { unsigned sp_ = 0; while (__hip_atomic_load(flag, __ATOMIC_RELAXED, __HIP_MEMORY_SCOPE_AGENT) == 0u) { __builtin_amdgcn_s_sleep(1); if (++sp_ > (1u << 22)) break; } }
    __syncthreads();
    float cr = 0.f, ci = 0.f;
    if (half) { const unsigned long long cv = __hip_atomic_load(slot, __ATOMIC_RELAXED, __HIP_MEMORY_SCOPE_AGENT); cr = __uint_as_float((unsigned)cv); ci = __uint_as_float((unsigned)(cv >> 32)); }
    float ir = cr, ii = ci, mr = 0.f, mi = 0.f;
#pragma unroll
    for (int qq = 0; qq < 8; ++qq) { if (qq == q) { mr = ir; mi = ii; } const float er = E[(qq * 64 + p) * 2], ei = E[(qq * 64 + p) * 2 + 1]; const float nr = pr * ir - pi * ii + er, ni = pr * ii + pi * ir + ei; ir = nr; ii = ni; }
    if (!half && q == 0) {
        __hip_atomic_store(slot, (unsigned long long)__float_as_uint(ir) | ((unsigned long long)__float_as_uint(ii) << 32), __ATOMIC_RELAXED, __HIP_MEMORY_SCOPE_AGENT);
        asm volatile("s_waitcnt vmcnt(0)" ::: "memory");
        if (p == 0) __hip_atomic_store(flag, 1u, __ATOMIC_RELAXED, __HIP_MEMORY_SCOPE_AGENT); }
    { bf16* xp = xng + row0 * 384 + 256 + 2 * p; xr = mr; xi = mi;
#pragma unroll
      for (int s = 0; s < 32; ++s) { *(unsigned*)(xp + (size_t)s * 384) = pk2(xr, xi); const float nr = ar * xr - ai * xi + v[s].x, ni = ar * xi + ai * xr + v[s].y; xr = nr; xi = ni; } }
    __syncthreads();
}

__global__ void __launch_bounds__(NTHR, 2) mk_fwd(Args args) {
    extern __shared__ __attribute__((aligned(16))) unsigned char lds_[];
    LAS unsigned char* lds = (LAS unsigned char*)lds_;
    volatile LAS unsigned* MISC = (volatile LAS unsigned*)(lds + MISC_OFF);
    const int wid = __builtin_amdgcn_readfirstlane(threadIdx.x >> 6);
#define lane lane_now()
#define tid (wid * 64 + lane_now())
    const int G = gridDim.x; const int bx = blockIdx.x; const int vcu = (G % 8 == 0) ? (bx % 8) * (G / 8) + bx / 8 : bx;
    unsigned char* const ws = args.ws;
    constexpr size_t EW = (size_t)NEXP * 1024 * 256;
    for (int u = tid; u < (LDS_BYTES - MISC_OFF) / 4; u += NTHR) ((LAS unsigned*)(lds + MISC_OFF))[u] = 0u;
    __syncthreads();
    const int lo = args.ph_lo, hi = args.ph_hi;
    XcdBarrier bar; bar.bar = (unsigned*)ws + CW_BAR + args.li * XCD_BAR_WORDS; bar.x = 0; bar.st = nullptr;
    if (hi - lo > 1) bar = xcd_barrier_post((unsigned*)ws + CW_BAR + args.li * XCD_BAR_WORDS, MISC + 8, wid);
    const int gw = vcu * NWAVES + wid, NGW = G * NWAVES;
#ifndef PH_ONLY
#define PH_ONLY -1
#endif
#define IN(k) ((PH_ONLY < 0 || PH_ONLY == ((k) >= 12 && (k) <= 14 ? (k) - 8 : (k))) && lo <= (k) && (k) < hi)
#ifndef TS_K1
#define TS_K1 -1
#define TS_K2 -1
#endif
#define TS_STAMP(k) do { if (TS_K1 >= 0 && bx == 0 && tid == 0) ((unsigned long long*)(ws + WS_TS))[k] = __builtin_amdgcn_s_memrealtime(); } while (0)
#define SEAM(k) do { if ((k) + 1 < hi) { xcd_arrive(bar, wid); xcd_wait(bar, wid); } TS_STAMP((k) + 1); } while (0)
#define SEAMX(k, ...) do { if ((k) + 1 < hi) xcd_arrive(bar, wid); { __VA_ARGS__; } if ((k) + 1 < hi) xcd_wait(bar, wid); TS_STAMP((k) + 1); } while (0)
#define STEAL0(first, last) do { TrSrc S_ = mk_trsrc(args.in[4], args.in[5], args.in[15], args.in[20], args.in[21], args.in[22], args.in[2], ws, 3072, (first), (last)); tr_stream(S_, SCR, gw, NGW, lane); } while (0)
#define STEAL1(first) do { TrSrc S_ = mk_trsrc(nullptr, nullptr, nullptr, args.in[20] + EW, args.in[21] + EW, args.in[22] + EW, args.in[2] + D, ws, 0, (first), (first) + NGW); tr_stream(S_, SCR, gw, NGW, lane); } while (0)
#define SCR ((LAS float*)(lds + wid * 16384))
#define ROUTER_PREFILL(layer) do { const u32x4* rw_ = (const u32x4*)(ws + WS_RWT + (size_t)(layer) * RW_LAYER_BYTES); for (int i_ = tid; i_ < RW_LAYER_BYTES / 16; i_ += NTHR) ((LAS u32x4*)lds)[i_] = rw_[i_]; } while (0)
    TS_STAMP(0);
    if (IN(0)) {
        { TrSrc S{args.in[4], args.in[5], args.in[15], args.in[20], args.in[21], args.in[22], args.in[2], ws, 3072, 0, 1536}; tr_stream(S, SCR, gw, NGW, lane); }
        { const float* x = args.in[0]; const float* norm_mix = args.in[1]; bf16* XN = (bf16*)(ws + WS_XN);
          for (int m0 = 2 * gw; m0 < M; m0 += 2 * NGW) { float4 v[2][4];
#pragma unroll
            for (int rr = 0; rr < 2; ++rr) { const float4* xr = (const float4*)(x + (size_t)(m0 + rr) * D);
#pragma unroll
                for (int j = 0; j < 4; ++j) v[rr][j] = xr[lane + 64 * j]; }
#pragma unroll
            for (int rr = 0; rr < 2; ++rr) { float ss = 0.f;
#pragma unroll
                for (int j = 0; j < 4; ++j) ss += v[rr][j].x * v[rr][j].x + v[rr][j].y * v[rr][j].y + v[rr][j].z * v[rr][j].z + v[rr][j].w * v[rr][j].w;
                ss = wave_sum(ss); const float s = rsqrtf(ss * (1.f / D) + RMS_EPS);
#pragma unroll
                for (int j = 0; j < 4; ++j) { const int c = 4 * (lane + 64 * j); const float4 gg = *(const float4*)(norm_mix + c); u32x2 w; w.x = pk2(v[rr][j].x * s * gg.x, v[rr][j].y * s * gg.y); w.y = pk2(v[rr][j].z * s * gg.z, v[rr][j].w * s * gg.w);
                    *(u32x2*)(XN + (size_t)(m0 + rr) * D + c) = w; } } } }
        SEAMX(0, STEAL0(1536, 5632));
    }
#define SIDE1() do { \
        { bf16* rwt = (bf16*)(ws + WS_RWT); const float* norm_ffn = args.in[2]; \
          for (int o = bx * NTHR + tid; o < 2 * 36 * 1024; o += G * NTHR) { const int layer = o / (36 * 1024), r = o % (36 * 1024), col = r >> 10, k = r & 1023; \
            const float gnk = norm_ffn[layer * D + k]; \
            const float w = gnk * (col < 4 ? args.in[16][(size_t)layer * 4096 + k * 4 + col] : args.in[18][(size_t)layer * 32768 + ((size_t)((col - 4) >> 3) * 1024 + k) * 8 + ((col - 4) & 7)]); \
            const bf16 hi_ = f2bf(w); const bf16 lo_ = f2bf(w - bf2f(hi_)); \
            rwt[(size_t)layer * 2 * RW_PLANE + col * RW_PITCH + k] = hi_; rwt[(size_t)layer * 2 * RW_PLANE + RW_PLANE + col * RW_PITCH + k] = lo_; } } \
        __syncthreads(); \
        for (int gq = vcu; gq < 256; gq += G) ssm_mats(gq >> 2, gq & 3, args.in[7], args.in[8], args.in[9], args.in[10], args.in[11], args.in[12], args.in[13], args.in[14], ws + WS_SSM, (float*)(ws + WS_A16), (LAS float*)lds, tid); \
        __syncthreads(); } while (0)
    if (IN(1)) { if (vcu & 1) SIDE1(); { PhQKV P{ws, (const char*)(ws + WS_XN), G, bx}; gm::gemm_phase(lds, P, wid); } if (!(vcu & 1)) SIDE1(); SEAMX(1, STEAL0(5632, 9728)); }
#undef SIDE1

    if (IN(2)) {
        const int per = 1024 / G;
        for (int i = 0; i < per; ++i) { const int uid = vcu * per + i; const int bh = uid >> 5, qb = uid & 31;
            at::attn_unit<8>(bh >> 4, bh & 15, qb, (const bf16*)(ws + WS_Q), (const bf16*)(ws + WS_K), (const bf16*)(ws + WS_V), (bf16*)(ws + (args.pad ? WS_XN : WS_Q)), args.in[6], lds, wid); }
        SEAMX(2, STEAL0(9728, 13824));
    }
    if (IN(3)) {
        { PhWo P{ws, (const char*)(ws + WS_Q), args.in[0], args.out, G, bx}; gm::gemm_phase(lds, P, wid); }
        SEAMX(3, STEAL0(13824, 15360); __syncthreads(); if (4 < hi) ROUTER_PREFILL(0)); }

#define MOE_LAYER(layer, pr) \
    if (IN(pr)) { router_phase((layer) ? (const bf16*)(ws + WS_XN) : (const bf16*)args.out, (const u32x4*)(ws + WS_RWT + (size_t)(layer) * RW_LAYER_BYTES), args.in[17] + (layer) * 4, args.in[19] + (layer) * 32, (unsigned*)ws + CW_CNT + (layer) * 32 * 64, \
                               (int*)(ws + WS_PDST), (float*)(ws + WS_PW), (float*)(ws + WS_PS), (float*)(ws + WS_SROW), lds, vcu, G, wid, (pr) > lo); SEAMX(pr, if (layer) STEAL1(10240)); } \
    if (IN((pr) + 1) || IN((pr) + 2)) { \
        if (IN((pr) + 1)) { moe_tables(lds, (const unsigned*)ws + CW_CNT + (layer) * 32 * 64, tid); const bf16* hbp = (layer) ? (const bf16*)(ws + WS_XN) : (const bf16*)args.out; \
            { PhGateUp P{ws, (const char*)hbp, lds, G, vcu, __builtin_amdgcn_readfirstlane(((const LAS int*)(lds + AUX_OFF))[MT_NN])}; gm::gemm_phase(lds, P, wid); } \
            { const LAS int* mt = (const LAS int*)(lds + AUX_OFF); const int np = 16 * mt[MT_NS]; for (int j = G - 1 - vcu; j < np; j += G) { Unit u; const int code_ = mt[MT_SLIST + (j >> 4)]; u.pn = (code_ >> 7) & 1; moe_decode(lds, code_, u); tail_job<true>(ws, hbp, u, j & 15, wid, lds); } } \
            SEAM((pr) + 1); } \
        if (IN((pr) + 2)) { if (!IN((pr) + 1)) moe_tables(lds, (const unsigned*)ws + CW_CNT + (layer) * 32 * 64, tid); \
            { PhDown P{ws, (const char*)(ws + WS_H), lds, G, vcu, __builtin_amdgcn_readfirstlane(((const LAS int*)(lds + AUX_OFF))[MT_NN])}; gm::gemm_phase(lds, P, wid); } \
            { const LAS int* mt = (const LAS int*)(lds + AUX_OFF); const int np = 16 * mt[MT_NS]; for (int j = G - 1 - vcu; j < np; j += G) { Unit u; const int code_ = mt[MT_SLIST + (j >> 4)]; u.pn = (code_ >> 7) & 1; moe_decode(lds, code_, u); tail_job<false>(ws, (const bf16*)(ws + WS_H), u, j & 15, wid, lds); } } \
            SEAMX((pr) + 2, if (!(layer)) STEAL1(0)); } \
    }
    MOE_LAYER(0, 4)
    if (IN(7)) {
        combine_phase<false>((const bf16*)args.out, (const bf16*)(ws + WS_Y2), args.in[1] + D, (bf16*)args.out + (size_t)M * D, (bf16*)(ws + WS_XN), nullptr, vcu, G, wid, lane);
        SEAMX(7, STEAL1(2048); STEAL1(4096)); }
    if (IN(8)) { PhSloc P{ws, (const char*)(ws + WS_XN), G, vcu}; gm::gemm_phase(lds, P, wid); asm volatile("s_waitcnt vmcnt(0)" ::: "memory"); __syncthreads(); }
    if (IN(10)) {
        for (int idx = vcu; idx < 256; idx += G) scan_unit(idx >> 2, idx & 3, (const float*)(ws + WS_SLOC), (const float*)(ws + WS_A16), (bf16*)(ws + WS_XN), (unsigned*)ws, lds, wid);
        asm volatile("s_waitcnt vmcnt(0)" ::: "memory"); __syncthreads();
        PhY P{ws, (const char*)(ws + WS_XN), G, vcu}; gm::gemm_phase(lds, P, wid); SEAMX(10, STEAL1(6144)); }
    if (IN(11)) {
        { PhWout P{ws, (const char*)(ws + WS_G), args.out, G, bx}; gm::gemm_phase(lds, P, wid); }
        SEAMX(11, STEAL1(8192); __syncthreads(); if (12 < hi) ROUTER_PREFILL(1)); }

    MOE_LAYER(1, 12)
#undef MOE_LAYER
    if (IN(15)) { combine_phase<true>((const bf16*)(ws + WS_XN), (const bf16*)(ws + WS_Y2), args.in[3], nullptr, nullptr, args.out, vcu, G, wid, lane);
#if TS_K1 >= 0
        { const unsigned long long* ts = (const unsigned long long*)(ws + WS_TS); const float dtus = (float)(ts[TS_K1 + 1] - ts[TS_K1]) * 1e-2f; const float e = exp2f(rintf(log2f(dtus) * 6.f) / 6.f) * 1e-2f;
          __syncthreads();
          for (int base = vcu * 16; base < M; base += G * 16) for (int i = tid; i < 16 * D; i += NTHR) args.out[(size_t)base * D + i] *= (1.f + e);
          if (TS_K2 >= 0 && bx == 0) { __syncthreads(); if (tid == 0) args.out[0] = exp2f(rintf(log2f((float)(ts[TS_K2 + 1] - ts[TS_K2]) * 1e-2f) * 6.f) / 6.f); } }
#endif
    }
#undef IN
#undef SEAM
#undef SCR
#undef lane
#undef tid
}

#ifndef FUSED
#define FUSED 1
#endif
#ifndef DUP_PH
#define DUP_PH -1
#endif
extern "C" void kernel_launch(void* const* d_in, const int* in_sizes, int n_in, void* d_out, int out_size, void* d_ws, size_t ws_size, hipStream_t stream) {
    static int grid = 0;
    if (grid == 0) {
        if (n_in != 23 || out_size != M * D || ws_size < WS_END) { fprintf(stderr, "kernel_launch: unexpected shapes (n_in %d out %d ws %zu)\n", n_in, out_size, ws_size); grid = -1; return; }
        int dev = 0, cus = 0;
        if (hipGetDevice(&dev) != hipSuccess || hipDeviceGetAttribute(&cus, hipDeviceAttributeMultiprocessorCount, dev) != hipSuccess) { grid = -1; return; }
        if (hipFuncSetAttribute((const void*)mk_fwd, hipFuncAttributeMaxDynamicSharedMemorySize, LDS_BYTES) != hipSuccess) { fprintf(stderr, "kernel_launch: hipFuncSetAttribute failed\n"); grid = -1; return; }
        (void)hipGetLastError();
        grid = cus;
        if (grid != 256) fprintf(stderr, "kernel_launch: %d CUs (built for 256)\n", grid);
    }
    if (grid < 0) return;
    unsigned char* ws = (unsigned char*)d_ws;
    (void)hipMemsetAsync(ws + WS_CTL, 0, CTL_ZERO_BYTES, stream);
    Args a{}; for (int i = 0; i < 23; ++i) a.in[i] = (const float*)d_in[i];
    a.out = (float*)d_out; a.ws = ws;
    int li = 0;
    auto run = [&](int lo, int hi) { a.ph_lo = lo; a.ph_hi = hi; a.li = li++; hipLaunchKernelGGL(mk_fwd, dim3(grid), dim3(NTHR), LDS_BYTES, stream, a); };
    if (FUSED) { run(0, N_PHASES); return; }
    for (int ph = 0; ph < N_PHASES; ++ph) { if (ph == 9) continue;
        if (DUP_PH == ph) { if (ph == 2) { a.pad = 1; run(2, 3); a.pad = 0; } else run(ph, ph + 1); }
        run(ph, ph + 1); }
}
```

```cpp
#include <hip/hip_runtime.h>
#include <cstdio>
#include <cstdint>

typedef unsigned short bf16;
constexpr int BATCH = 2, SEQ = 8192, D = 1024, M = BATCH * SEQ, NH = 16, HD = 64;
constexpr int NEXP = 32, EPG = 8, FE = 256;
constexpr int NREL = 257;
constexpr float RMS_EPS = 1e-6f;
constexpr float LOG2E = 1.4426950408889634f;
constexpr float C2 = 0.125f * LOG2E;

constexpr size_t MiB = 1u << 20;
constexpr size_t WS_CTL = 0;
constexpr size_t WS_XN = 86 * MiB;
constexpr size_t WS_BIG = 134 * MiB;
constexpr size_t WS_Q = WS_BIG, WS_K = WS_BIG + 32 * MiB, WS_V = WS_BIG + 64 * MiB;
constexpr size_t WS_Y2 = WS_BIG, WS_H = WS_BIG + 64 * MiB;
constexpr size_t WS_SLOC = WS_BIG, WS_G = WS_BIG + 32 * MiB;

__device__ __forceinline__ bf16 f2bf(float f) { unsigned u = __float_as_uint(f); return (bf16)((u + 0x7fffu + ((u >> 16) & 1u)) >> 16); }
__device__ __forceinline__ float bf2f(bf16 h) { return __uint_as_float(((unsigned)h) << 16); }
__device__ __forceinline__ float wave_sum(float v) {
#pragma unroll
    for (int o = 1; o < 64; o <<= 1) v += __shfl_xor(v, o);
    return v;
}
__device__ __forceinline__ float gelu_tanh(float x) { const float u = 0.7978845608028654f * (x + 0.044715f * x * x * x); return 0.5f * x * (1.f + tanhf(u)); }

__device__ __forceinline__ size_t xng_off(int t, int col) { const int b = t >> 13, tt = t & 8191, s = tt >> 4, j = tt & 15, g = col >> 4, c = col & 15; return ((size_t)(g * 1024 + b * 512 + s)) * 384 + j * 16 + c; }

#define LAS __attribute__((address_space(3)))
typedef short bf16x8 __attribute__((ext_vector_type(8)));
typedef short s16x4 __attribute__((ext_vector_type(4)));
typedef float f32x4 __attribute__((ext_vector_type(4)));
typedef float f32x16 __attribute__((ext_vector_type(16)));
typedef unsigned u32x4 __attribute__((ext_vector_type(4)));
typedef unsigned u32x2 __attribute__((ext_vector_type(2)));

constexpr int NWAVES = 8, NTHR = 512;
constexpr int CAP = 16384;
constexpr size_t CTL_ZERO_BYTES = 1 * MiB;
constexpr size_t WS_PDST = 1 * MiB, WS_PW = 3 * MiB, WS_PS = 5 * MiB, WS_SROW = 7 * MiB, WS_A16 = 7 * MiB + 65536;
constexpr size_t WS_TS = 7 * MiB + 131072;
constexpr size_t WS_RWT = 8 * MiB;
constexpr size_t WS_WQKV = 9 * MiB, WS_WO = 15 * MiB, WS_WOUT = 17 * MiB, WS_SSM = 21 * MiB;
constexpr size_t WS_WGU = 38 * MiB, WS_WD = 70 * MiB;
constexpr size_t WS_END = 230 * MiB;
constexpr int RW_PITCH = 1032, RW_PLANE = 36 * RW_PITCH, RW_LAYER_BYTES = 2 * RW_PLANE * 2;
constexpr int SSM_G_BYTES = 262144, SSM_A2_OFF = 65536;
constexpr int CW_BAR = 4096;
constexpr int CW_CARRYF = 131072;
constexpr int CW_CARRY = 147456;
constexpr int CW_CNT = 65536;
constexpr int LDS_BYTES = 160 * 1024, MISC_OFF = LDS_BYTES - 512, AUX_OFF = 128 * 1024, RSCR_OFF = RW_LAYER_BYTES;
constexpr int N_PHASES = 16;

__device__ __forceinline__ int lane_now() { int l; asm volatile("v_mbcnt_lo_u32_b32 %0, -1, 0\n\tv_mbcnt_hi_u32_b32 %0, -1, %0" : "=v"(l)); return l; }
__device__ __forceinline__ unsigned cvt_pk_bf16(float lo, float hi) { unsigned r; asm volatile("v_cvt_pk_bf16_f32 %0, %1, %2" : "=v"(r) : "v"(lo), "v"(hi)); return r; }
typedef float f32x2_t __attribute__((ext_vector_type(2))); typedef __bf16 bf16x2_t __attribute__((ext_vector_type(2)));
__device__ __forceinline__ unsigned cvtpk_s(float lo, float hi) { f32x2_t v = {lo, hi}; bf16x2_t b = __builtin_convertvector(v, bf16x2_t); return __builtin_bit_cast(unsigned, b); }
__device__ __forceinline__ unsigned pk2(float lo, float hi) { return cvtpk_s(lo, hi); }
#define LDS_WAIT() asm volatile("s_waitcnt lgkmcnt(0)" ::: "memory")
#define VM_WAIT() asm volatile("s_waitcnt vmcnt(0)" ::: "memory")
#define RLX_AGENT __ATOMIC_RELAXED, __HIP_MEMORY_SCOPE_AGENT

#define XB_TMO      128
#define XB_XCNT(j)  (256  + 64 * (j))
#define XB_XSUB(j)  (1280 + 64 * (j))
#define XB_XGEN(j)  (2304 + 64 * (j))
#define XB_TOP      3328
#define XB_TOPGEN   3392
#define XCD_BAR_WORDS 3456
#define XB_SPIN_CAP (1u << 18)
__device__ __forceinline__ unsigned xb_ld(unsigned* p)              { return __hip_atomic_load(p, __ATOMIC_RELAXED, __HIP_MEMORY_SCOPE_AGENT); }
__device__ __forceinline__ unsigned xb_add(unsigned* p, unsigned v) { return __hip_atomic_fetch_add(p, v, __ATOMIC_RELAXED, __HIP_MEMORY_SCOPE_AGENT); }
__device__ __forceinline__ int   ag_ld(const int* p)   { return (int)__hip_atomic_load((const unsigned*)p, __ATOMIC_RELAXED, __HIP_MEMORY_SCOPE_AGENT); }
__device__ __forceinline__ float ag_ld(const float* p) { return __uint_as_float(__hip_atomic_load((const unsigned*)p, __ATOMIC_RELAXED, __HIP_MEMORY_SCOPE_AGENT)); }
__device__ __forceinline__ void  ag_st(int* p, int v)     { __hip_atomic_store((unsigned*)p, (unsigned)v, __ATOMIC_RELAXED, __HIP_MEMORY_SCOPE_AGENT); }
__device__ __forceinline__ void  ag_st(float* p, float v) { __hip_atomic_store((unsigned*)p, __float_as_uint(v), __ATOMIC_RELAXED, __HIP_MEMORY_SCOPE_AGENT); }
__device__ __forceinline__ unsigned xb_xcc_id() { return (unsigned)__builtin_amdgcn_s_getreg((3 << 11) | 20) & 0xFu; }
#define XB_SPIN(cond, bar) do { unsigned _sp = 0; while (cond) { __builtin_amdgcn_s_sleep(1); \
    if ((++_sp & 255u) == 0u) { if (xb_ld(&(bar)[XB_TMO])) break; if (_sp > XB_SPIN_CAP) { atomicAdd(&(bar)[XB_TMO], 1u); break; } } } } while (0)
struct XcdBarrier { unsigned* bar; unsigned x; volatile LAS unsigned* st; };
__device__ __forceinline__ XcdBarrier xcd_barrier_post(unsigned* bar, volatile LAS unsigned* st, int wid) {
    XcdBarrier b; b.bar = bar; b.x = xb_xcc_id(); b.st = st;
    if (wid == 0 && lane_now() == 0) (void)xb_add(&bar[XB_XCNT(b.x)], 1u);
    return b;
}
__device__ __forceinline__ void xcd_barrier_complete(unsigned* bar, unsigned x, unsigned& nloc, unsigned& nx) {
    const unsigned G = gridDim.x * gridDim.y * gridDim.z;
    unsigned sum, cnt, mine, sp = 0u;
    for (;;) {
        sum = 0u; cnt = 0u; mine = 0u;
#pragma unroll
        for (unsigned j = 0; j < 16; ++j) { const unsigned c = xb_ld(&bar[XB_XCNT(j)]); sum += c; cnt += (c > 0u) ? 1u : 0u; mine = (j == x) ? c : mine; }
        if (sum == G) break;
        __builtin_amdgcn_s_sleep(1);
        if ((++sp & 255u) == 0u) { if (xb_ld(&bar[XB_TMO])) break; if (sp > XB_SPIN_CAP) { atomicAdd(&bar[XB_TMO], 1u); break; } }
    }
    nloc = mine > 0u ? mine : 1u; nx = cnt > 0u ? cnt : 1u;
}
__device__ __forceinline__ void xcd_barrier(const XcdBarrier& b, int wid) {
    asm volatile("s_waitcnt vmcnt(0)" ::: "memory");
    __syncthreads();
    if (wid == 0 && lane_now() == 0) {
        unsigned* bar = b.bar;
        __builtin_amdgcn_s_waitcnt(0);
        unsigned nloc = b.st[0], nx = b.st[1];
        if (nloc == 0u) { xcd_barrier_complete(bar, b.x, nloc, nx); b.st[0] = nloc; b.st[1] = nx; }
        const unsigned old = xb_add(&bar[XB_XSUB(b.x)], 1u);
        const unsigned gen = old / nloc;
        if (old + 1u == (gen + 1u) * nloc) {
            __builtin_amdgcn_fence(__ATOMIC_RELEASE, "agent");
            asm volatile("s_waitcnt vmcnt(0)" ::: "memory");
            (void)xb_add(&bar[XB_TOP], 1u);
        }
        XB_SPIN(xb_ld(&bar[XB_TOP]) < (gen + 1u) * nx, bar);
        __builtin_amdgcn_fence(__ATOMIC_ACQUIRE, "agent");
        asm volatile("s_waitcnt vmcnt(0)" ::: "memory");
    }
    __syncthreads();
}

__device__ __forceinline__ void xcd_arrive(const XcdBarrier& b, int wid, bool light = false) {
    asm volatile("s_waitcnt vmcnt(0)" ::: "memory");
    __syncthreads();
    if (wid == 0 && lane_now() == 0) {
        unsigned* bar = b.bar;
        __builtin_amdgcn_s_waitcnt(0);
        unsigned nloc = b.st[0], nx = b.st[1];
        if (nloc == 0u) { xcd_barrier_complete(bar, b.x, nloc, nx); b.st[0] = nloc; b.st[1] = nx; }
        const unsigned old = xb_add(&bar[XB_XSUB(b.x)], 1u);
        const unsigned gen = old / nloc;
        if (old + 1u == (gen + 1u) * nloc) {
            if (!light) { __builtin_amdgcn_fence(__ATOMIC_RELEASE, "agent"); asm volatile("s_waitcnt vmcnt(0)" ::: "memory"); }
            (void)xb_add(&bar[XB_TOP], 1u);
            b.st[3] = 1u;
        } else if (light) { b.st[3] = 0u; } else {
            b.st[3] = 0u;
            asm volatile("buffer_inv sc1" ::: "memory");
        }
        b.st[2] = (gen + 1u) * nx; b.st[4] = gen;
    }
}
__device__ __forceinline__ void xcd_wait(const XcdBarrier& b, int wid, bool light = false) {
    if (wid == 0 && lane_now() == 0) {
        unsigned* bar = b.bar; const unsigned target = b.st[2];
        if (b.st[3]) {
            XB_SPIN(xb_ld(&bar[XB_TOP]) < target, bar);
            if (!light) { __builtin_amdgcn_fence(__ATOMIC_ACQUIRE, "agent"); asm volatile("s_waitcnt vmcnt(0)" ::: "memory"); }
            (void)xb_add(&bar[XB_XGEN(b.x)], 1u);
        } else {
            const unsigned gen = b.st[4];
            XB_SPIN(xb_ld(&bar[XB_XGEN(b.x)]) <= gen, bar);
            asm volatile("s_waitcnt vmcnt(0)" ::: "memory");
        }
    }
    __syncthreads();
}

namespace gm {
constexpr int HTB = 16384;
__device__ __forceinline__ int lds_byte(int r, int c) { const int st = (r >> 4) * 2 + (c >> 5), rr = r & 15, cc = c & 31, ob = rr * 64 + cc * 2; return st * 1024 + (ob ^ (((ob >> 9) & 1) << 5)); }
__device__ __forceinline__ void stage_rc(int b, int& R, int& C) { const int st = b / 1024, sb = b % 1024, swz = sb ^ (((sb >> 9) & 1) << 5); R = (st >> 1) * 16 + swz / 64; C = (st & 1) * 32 + (swz % 64) / 2; }
__device__ __forceinline__ int perm32(int rho) { const int n = rho >> 4, i = rho & 15; return 8 * (i >> 2) + 4 * n + (i & 3); }
struct Unit { int pm, pn, e, gt, cnt; };
__device__ __forceinline__ bool static_unit(int i, int G, int c, int nM, int nN, Unit& u) {
    const int nwg = nM * nN; const long L = (long)i * G + c; if (L >= nwg) return false;
    int wgid = (int)L; { const int q = nwg / 8, r = nwg % 8, xcd = wgid % 8, off = wgid / 8; wgid = (xcd < r ? xcd * (q + 1) : r * (q + 1) + (xcd - r) * q) + off; }
    const int nig = 8 * nN, gid = wgid / nig, fm = gid * 8, gsz = (nM - fm) < 8 ? (nM - fm) : 8;
    u.pm = fm + ((wgid % nig) % gsz); u.pn = (wgid % nig) / gsz; u.e = 0; u.gt = 0; u.cnt = 0; return true;
}
template <class P> __device__ __forceinline__ void gemm_phase(LAS unsigned char* lds, const P& ph, int wid) {
    const int lane = lane_now(), tid = wid * 64 + lane, wr = wid >> 2, wc = wid & 3, fr = lane & 15, fq = lane >> 4;
    constexpr int nt = P::K / 64;
    static_assert(nt >= 2 && (nt % 2) == 0, "K must be a multiple of 128");
    unsigned voffA[2], voffB[2];
#pragma unroll
    for (int i = 0; i < 2; ++i) { int R, C; stage_rc(tid * 16 + i * 8192, R, C); const int Rb = (R & ~31) + perm32(R & 31); voffB[i] = (unsigned)(Rb * P::LDB + C) * 2u; voffA[i] = (unsigned)(R * P::LDA + C) * 2u; }
    const unsigned ldsw = (unsigned)wid * 1024u;
    const int aoff = lds_byte(wr * 64 + fr, fq * 8), boff = lds_byte(wc * 32 + fr, fq * 8);
    constexpr int hB = P::HSTEPB, hA = 128 * P::LDA * 2;
#define G_SA(b, h) (((b) * 2 + (h)) * gm::HTB)
#define G_SB(b, h) ((4 + (b) * 2 + (h)) * gm::HTB)
#define G_GLDS(src, bufoff, i) __builtin_amdgcn_global_load_lds((const unsigned*)(src), (LAS unsigned*)(lds + (bufoff) + ldsw + (i) * 8192), 16, 0, 0)
#define G_STA(bufoff, ptr, kb, offs, h) do { if constexpr (P::GATHER) { _Pragma("unroll") for (int _i = 0; _i < 2; ++_i) G_GLDS(Ab + (kb) + (offs)[h][_i], bufoff, _i); } \
        else { _Pragma("unroll") for (int _i = 0; _i < 2; ++_i) G_GLDS((ptr) + (h) * hA + voffA[_i], bufoff, _i); } } while (0)
#define G_STB(bufoff, ptr) do { _Pragma("unroll") for (int _i = 0; _i < 2; ++_i) G_GLDS((ptr) + voffB[_i], bufoff, _i); } while (0)
#define G_LDA(dst, b, h) do { _Pragma("unroll") for (int m = 0; m < 4; ++m) _Pragma("unroll") for (int k = 0; k < 2; ++k) dst[m][k] = *(const LAS bf16x8*)(lds + G_SA(b, h) + aoff + m * 2048 + k * 1024); } while (0)
#define G_LDB(dst, b, h) do { _Pragma("unroll") for (int n = 0; n < 2; ++n) _Pragma("unroll") for (int k = 0; k < 2; ++k) dst[n][k] = *(const LAS bf16x8*)(lds + G_SB(b, h) + boff + n * 2048 + k * 1024); } while (0)
#define G_MMA(ai, bj, At, Bt) do { __builtin_amdgcn_s_setprio(1); _Pragma("unroll") for (int m = 0; m < 4; ++m) _Pragma("unroll") for (int n = 0; n < 2; ++n) _Pragma("unroll") for (int k = 0; k < 2; ++k) \
        acc[ai][bj][m][n] = __builtin_amdgcn_mfma_f32_16x16x32_bf16(Bt[n][k], At[m][k], acc[ai][bj][m][n], 0, 0, 0); __builtin_amdgcn_s_setprio(0); } while (0)
#define G_WAIT_V(n) asm volatile("s_waitcnt vmcnt(" #n ")" ::: "memory")
#define G_WAIT_L(n) asm volatile("s_waitcnt lgkmcnt(" #n ")" ::: "memory")
#define G_BAR __builtin_amdgcn_s_barrier()
#define G_SCHED __builtin_amdgcn_sched_barrier(0)
    Unit cur, nxt; int ui = 0;
    if (!ph.next(0, cur)) return;
    f32x4 acc[2][2][4][2];
#pragma unroll
    for (int a = 0; a < 2; ++a)
#pragma unroll
        for (int b = 0; b < 2; ++b)
#pragma unroll
            for (int m = 0; m < 4; ++m)
#pragma unroll
                for (int n = 0; n < 2; ++n) acc[a][b][m][n] = (f32x4){0.f, 0.f, 0.f, 0.f};
    bf16x8 At[4][2], B0[2][2], B1[2][2];
    unsigned co[2][2] = {{0u, 0u}, {0u, 0u}};
    const char* Ab = ph.Abase;
    const char* cA = Ab; const char* cB = ph.b_tile(cur);
    if constexpr (P::GATHER) { ph.a_offs(cur, tid, co); asm volatile("s_waitcnt vmcnt(0)" ::: "memory"); } else cA = ph.a_tile(cur);
    G_STB(G_SB(0, 0), cB); G_STB(G_SB(0, 1), cB + hB); G_STA(G_SA(0, 0), cA, 0, co, 0); G_STA(G_SA(0, 1), cA, 0, co, 1);
    if (wr == 1) G_BAR;
    G_WAIT_V(2); G_BAR;
    G_STB(G_SB(1, 0), cB + 128); G_STA(G_SA(1, 0), cA + 128, 128, co, 0); G_STB(G_SB(1, 1), cB + hB + 128);
    G_WAIT_V(6); G_BAR;
    for (;;) {
        const bool has_next = ph.next(ui + 1, nxt);
        const char* nA = cA; const char* nB = cB;
        if (has_next) { nB = ph.b_tile(nxt); if constexpr (!P::GATHER) nA = ph.a_tile(nxt); }
        for (int t = 0; t < nt; t += 2) {
            const bool last = (t == nt - 2);
            const int kb1 = (t + 1) * 128, kb2 = last ? 0 : (t + 2) * 128, kb3 = kb2 + 128;
            const char* a1 = cA + kb1; const char* a2 = last ? nA : cA + kb2; const char* a3 = a2 + 128;
            const char* b2 = last ? nB : cB + (t + 2) * 128; const char* b3 = b2 + 128;
            G_LDB(B0, 0, 0); G_LDB(B1, 0, 1); G_SCHED; G_LDA(At, 0, 0); G_STA(G_SA(1, 1), a1, kb1, co, 1);
            G_WAIT_V(8); G_WAIT_L(0); G_BAR; G_MMA(0, 0, At, B0); G_MMA(0, 1, At, B1); G_BAR; G_SCHED;
            if constexpr (P::GATHER) { if (last && has_next) ph.a_offs(nxt, tid, co); }
            G_LDA(At, 0, 1); G_STB(G_SB(0, 0), b2); G_STB(G_SB(0, 1), b2 + hB); G_STA(G_SA(0, 0), a2, kb2, co, 0);
            G_WAIT_V(8); G_WAIT_L(0); G_BAR; G_MMA(1, 0, At, B0); G_MMA(1, 1, At, B1); G_BAR; G_SCHED;
            G_LDB(B0, 1, 0); G_LDB(B1, 1, 1); G_SCHED; G_LDA(At, 1, 0); G_STA(G_SA(0, 1), a2, kb2, co, 1);
            G_WAIT_V(8); G_WAIT_L(0); G_BAR; G_MMA(0, 0, At, B0); G_MMA(0, 1, At, B1); G_BAR; G_SCHED;
            G_LDA(At, 1, 1); G_STB(G_SB(1, 0), b3); G_STB(G_SB(1, 1), b3 + hB); G_STA(G_SA(1, 0), a3, kb3, co, 0);
            G_WAIT_V(8); G_WAIT_L(0); G_BAR; G_MMA(1, 0, At, B0); G_MMA(1, 1, At, B1); G_BAR; G_SCHED;
        }
        if (wr == 0) G_BAR;
        ph.epi(acc, cur, wr, wc, fr, fq);
        if (!has_next) break;
#pragma unroll
        for (int a = 0; a < 2; ++a)
#pragma unroll
            for (int b = 0; b < 2; ++b)
#pragma unroll
                for (int m = 0; m < 4; ++m)
#pragma unroll
                    for (int n = 0; n < 2; ++n) acc[a][b][m][n] = (f32x4){0.f, 0.f, 0.f, 0.f};
        cur = nxt; cA = nA; cB = nB; ++ui;
        if (wr == 1) G_BAR;
    }
    G_WAIT_V(0);
    G_BAR;
}
}

using gm::Unit;
#define EPI_ARGS const f32x4 (&acc)[2][2][4][2], const Unit& u, int wr, int wc, int fr_in, int fq_in
#define EPI_OPAQUE int fr = fr_in, fq = fq_in; asm volatile("" : "+v"(fr), "+v"(fq));
#define NO_GATHER __device__ __forceinline__ void a_offs(const Unit&, int, unsigned (&)[2][2]) const {}
#define EPI_FENCE() asm volatile("" ::: "memory")
__device__ __forceinline__ u32x4 pack8(const f32x4& v0, const f32x4& v1) { u32x4 w; w.x = cvt_pk_bf16(v0[0], v0[1]); w.y = cvt_pk_bf16(v0[2], v0[3]); w.z = cvt_pk_bf16(v1[0], v1[1]); w.w = cvt_pk_bf16(v1[2], v1[3]); return w; }
__device__ __forceinline__ float fast_sigmoid(float v) { return __builtin_amdgcn_rcpf(1.f + __builtin_amdgcn_exp2f(-LOG2E * v)); }
__device__ __forceinline__ float fast_gelu(float v) { const float u2 = 1.5957691216057308f * (v + 0.044715f * v * v * v); return v * fast_sigmoid(u2); }

struct PhQKV {
    static constexpr bool GATHER = false; static constexpr int LDA = 1024, K = 1024, LDB = 1024, HSTEPB = 128 * 1024 * 2;
    unsigned char* ws; const char* Abase; int G, c;
    __device__ __forceinline__ bool next(int i, Unit& u) const { return gm::static_unit(i, G, c, M / 256, 12, u); }
    NO_GATHER __device__ __forceinline__ const char* a_tile(const Unit& u) const { return Abase + (size_t)(u.pm * 256) * 1024 * 2; }
    __device__ __forceinline__ const char* b_tile(const Unit& u) const { return (const char*)(ws + WS_WQKV) + (size_t)u.pn * 256 * 1024 * 2; }
    __device__ __forceinline__ void epi(EPI_ARGS) const { EPI_OPAQUE
        const int row0 = u.pm * 256 + wr * 64 + fr; const int t = u.pn >> 2; const int colt = (u.pn & 3) * 256;
        bf16* base = (bf16*)(ws + WS_Q) + (size_t)t * (16u * 1024u * 1024u); const float sc = (t == 0) ? C2 : 1.f;
        const int col0 = colt + wc * 32 + 8 * fq;
#pragma unroll
        for (int ai = 0; ai < 2; ++ai)
#pragma unroll
            for (int m = 0; m < 4; ++m) { bf16* rowp = base + (size_t)(row0 + ai * 128 + m * 16) * 1024 + col0;
#pragma unroll
                for (int bj = 0; bj < 2; ++bj) *(u32x4*)(rowp + bj * 128) = pack8(acc[ai][bj][m][0] * sc, acc[ai][bj][m][1] * sc); }
    }
};
struct PhWo {
    static constexpr bool GATHER = false; static constexpr int LDA = 1024, K = 1024, LDB = 1024, HSTEPB = 128 * 1024 * 2;
    unsigned char* ws; const char* Abase; const float* resid; float* out; int G, c;
    __device__ __forceinline__ bool next(int i, Unit& u) const { return gm::static_unit(i, G, c, M / 256, 4, u); }
    NO_GATHER __device__ __forceinline__ const char* a_tile(const Unit& u) const { return Abase + (size_t)(u.pm * 256) * 1024 * 2; }
    __device__ __forceinline__ const char* b_tile(const Unit& u) const { return (const char*)(ws + WS_WO) + (size_t)u.pn * 256 * 1024 * 2; }
    __device__ __forceinline__ void epi(EPI_ARGS) const { EPI_OPAQUE
        const size_t off0 = (size_t)(u.pm * 256 + wr * 64 + fr) * 1024 + u.pn * 256 + wc * 32 + 8 * fq; bf16* hb = (bf16*)out;
#pragma unroll
        for (int ai = 0; ai < 2; ++ai) { f32x4 r[4][2][2];
#pragma unroll
            for (int m = 0; m < 4; ++m)
#pragma unroll
                for (int bj = 0; bj < 2; ++bj) { const float* p = resid + off0 + (size_t)(ai * 128 + m * 16) * 1024 + bj * 128; r[m][bj][0] = *(const f32x4*)p; r[m][bj][1] = *(const f32x4*)(p + 4); }
            EPI_FENCE();
#pragma unroll
            for (int m = 0; m < 4; ++m)
#pragma unroll
                for (int bj = 0; bj < 2; ++bj) { const size_t off = off0 + (size_t)(ai * 128 + m * 16) * 1024 + bj * 128; const f32x4 v0 = acc[ai][bj][m][0] + r[m][bj][0], v1 = acc[ai][bj][m][1] + r[m][bj][1];
                    *(u32x4*)(hb + off) = pack8(v0, v1); }
            EPI_FENCE(); }
    }
};
struct PhWout {
    static constexpr bool GATHER = false; static constexpr int LDA = 1024, K = 1024, LDB = 1024, HSTEPB = 128 * 1024 * 2;
    unsigned char* ws; const char* Abase; float* out; int G, c;
    __device__ __forceinline__ bool next(int i, Unit& u) const { return gm::static_unit(i, G, c, M / 256, 8, u); }
    NO_GATHER __device__ __forceinline__ const char* a_tile(const Unit& u) const { return Abase + (size_t)(u.pm * 256) * 1024 * 2; }
    __device__ __forceinline__ const char* b_tile(const Unit& u) const { return (const char*)(ws + WS_WOUT) + (size_t)u.pn * 256 * 1024 * 2; }
    __device__ __forceinline__ void epi(EPI_ARGS) const { EPI_OPAQUE
        const size_t off0 = (size_t)(u.pm * 256 + wr * 64 + fr) * 1024 + u.pn * 128 + wc * 32 + 8 * fq; bf16* hb = (bf16*)(ws + WS_XN); const bf16* rs = (const bf16*)out + (size_t)M * D;
        u32x4 r[2][4];
#pragma unroll
        for (int ai = 0; ai < 2; ++ai)
#pragma unroll
            for (int m = 0; m < 4; ++m) r[ai][m] = *(const u32x4*)(rs + off0 + (size_t)(ai * 128 + m * 16) * 1024);
        EPI_FENCE();
#pragma unroll
        for (int ai = 0; ai < 2; ++ai)
#pragma unroll
            for (int m = 0; m < 4; ++m) { const size_t off = off0 + (size_t)(ai * 128 + m * 16) * 1024; f32x4 v0, v1;
#pragma unroll
                for (int j = 0; j < 4; ++j) { const unsigned w0 = r[ai][m][j >> 1], w1 = r[ai][m][2 + (j >> 1)];
                    const float r0 = __uint_as_float((j & 1) ? (w0 & 0xffff0000u) : (w0 << 16)), r1 = __uint_as_float((j & 1) ? (w1 & 0xffff0000u) : (w1 << 16));
                    v0[j] = r0 + acc[ai][0][m][0][j] * fast_sigmoid(acc[ai][1][m][0][j]); v1[j] = r1 + acc[ai][0][m][1][j] * fast_sigmoid(acc[ai][1][m][1][j]); }
                *(u32x4*)(hb + off) = pack8(v0, v1); }
        EPI_FENCE();
    }
};
constexpr int MT_NN = 65, MT_NS = 66, MT_NLIST = 128, MT_SLIST = 384, SMALL_ROWS = 128;
#ifndef TILE_BUDGET
#define TILE_BUDGET 128
#endif
__device__ __forceinline__ void moe_decode(LAS unsigned char* lds, int code, Unit& u) { const LAS int* cn = (const LAS int*)(lds + AUX_OFF); u.e = code >> 8; u.pm = code & 127; u.gt = __builtin_amdgcn_readfirstlane(cn[32 + u.e]) + u.pm; u.cnt = __builtin_amdgcn_readfirstlane(cn[u.e]); }
__device__ __forceinline__ void moe_tables(LAS unsigned char* lds, const unsigned* cntg, int tid) {
    LAS int* cn = (LAS int*)(lds + AUX_OFF); LAS int* tb = cn + 32;
    if (tid < 64) {
        const int e = tid & 31; const unsigned cu = __hip_atomic_load(cntg + e * 64, RLX_AGENT); const int c = cu < (unsigned)CAP ? (int)cu : CAP;
        const int n = (c + 255) >> 8, full = c >> 8, rem = c & 255;
        int sfull = full;
#pragma unroll
        for (int o = 1; o < 32; o <<= 1) sfull += __shfl_xor(sfull, o, 32);
        const int budget = TILE_BUDGET - sfull; int rank = 0;
#pragma unroll 8
        for (int o = 0; o < 32; ++o) { const int r = __shfl(rem, o, 32); rank += (r > rem || (r == rem && o < e)) ? 1 : 0; }
        const bool prom = rem > 0 && rank < budget;
        const int nnorm = full + (prom ? 1 : 0), small = prom ? 0 : (rem > SMALL_ROWS ? 2 : (rem > 0 ? 1 : 0));
        int pt = n, pn_ = nnorm, ps_ = small;
#pragma unroll
        for (int o = 1; o < 32; o <<= 1) { const int a = __shfl_up(pt, o, 32), b = __shfl_up(pn_, o, 32), d = __shfl_up(ps_, o, 32); if (e >= o) { pt += a; pn_ += b; ps_ += d; } }
        if (tid < 32) { cn[e] = c; tb[e] = pt - n;
            for (int pm = 0; pm < nnorm; ++pm) cn[MT_NLIST + (pn_ - nnorm) + pm] = (e << 8) | pm;
            for (int hf = 0; hf < small; ++hf) cn[MT_SLIST + (ps_ - small) + hf] = (e << 8) | (hf << 7) | (n - 1);
            if (e == 31) { tb[32] = pt; cn[MT_NN] = pn_; cn[MT_NS] = ps_; } }
    }
    __syncthreads();
}
template <bool GU> __device__ __forceinline__ void tail_job(unsigned char* ws, const bf16* __restrict__ Xbase, const Unit& u, int ns, int wid, LAS unsigned char* lds) {
    const int lane = lane_now(), fr = lane & 15, fq = lane >> 4, w = wid, tid_ = wid * 64 + lane;
    constexpr int K = GU ? 1024 : 256, NG = GU ? 2 : 4;
    constexpr int PITCH = K * 2 + 16;
    constexpr int CH = K / 8, NCH = 16 * NG * CH / NTHR;
    constexpr int NKS = K / 32, NPRE = NKS < 16 ? NKS : 16;
    const int slot0 = u.pm * 256 + u.pn * 128, rows = u.cnt - slot0;
    const bool active = 16 * w < rows;
    int r = 16 * w + fr; const bool valid = r < rows; r = valid ? r : rows - 1; r = r < 0 ? 0 : r;
    const int dst = active ? ag_ld((const int*)(ws + WS_PDST) + u.e * CAP + slot0 + r) : 0;
    u32x4 st[NCH];
#pragma unroll
    for (int i = 0; i < NCH; ++i) { const int ci = tid_ + i * NTHR, row = ci / CH, ch = ci % CH;
        const bf16* src = GU ? (const bf16*)(ws + WS_WGU) + ((size_t)u.e * 512 + 256 * (ns >> 3) + 128 * (row >> 4) + 16 * (ns & 7) + (row & 15)) * 1024 + ch * 8
                             : (const bf16*)(ws + WS_WD) + ((size_t)u.e * 1024 + 64 * ns + row) * 256 + ch * 8;
        st[i] = *(const u32x4*)src; }
    const bf16* xp = (GU ? Xbase + (size_t)(dst >> 1) * 1024 : Xbase + ((size_t)u.gt * 256 + u.pn * 128 + r) * 256) + 8 * fq;
    bf16x8 xa[NPRE];
    if (active) {
#pragma unroll
        for (int ks = 0; ks < NPRE; ++ks) xa[ks] = *(const bf16x8*)(xp + 32 * ks); }
    __syncthreads();
#pragma unroll
    for (int i = 0; i < NCH; ++i) { const int ci = tid_ + i * NTHR, row = ci / CH, ch = ci % CH; *(LAS u32x4*)(lds + row * PITCH + ch * 16) = st[i]; }
    __syncthreads();
    if (!active) return;
    const LAS unsigned char* wl = lds + fr * PITCH + fq * 16;
    f32x4 acc[NG];
#pragma unroll
    for (int n = 0; n < NG; ++n) acc[n] = (f32x4){0.f, 0.f, 0.f, 0.f};
    bf16x8 xb[NKS - NPRE > 0 ? NKS - NPRE : 1];
    if (NKS > NPRE) {
#pragma unroll
        for (int ks = NPRE; ks < NKS; ++ks) xb[ks - NPRE] = *(const bf16x8*)(xp + 32 * ks); }
#pragma unroll
    for (int ks = 0; ks < NKS; ++ks) { const bf16x8 xf = ks < NPRE ? xa[ks < NPRE ? ks : 0] : xb[ks >= NPRE ? ks - NPRE : 0]; bf16x8 wf[NG];
#pragma unroll
        for (int n = 0; n < NG; ++n) wf[n] = *(const LAS bf16x8*)(wl + n * 16 * PITCH + ks * 64);
#pragma unroll
        for (int n = 0; n < NG; ++n) acc[n] = __builtin_amdgcn_mfma_f32_16x16x32_bf16(wf[n], xf, acc[n], 0, 0, 0); }
    if (valid) {
        if (GU) { const float sc = ag_ld((const float*)(ws + WS_PS) + u.e * CAP + slot0 + r); float v[4];
#pragma unroll
            for (int j = 0; j < 4; ++j) { const float gg = acc[0][j] * sc, uu = acc[NG - 1][j] * sc; v[j] = gg * fast_sigmoid(gg) * uu; }
            u32x2 o; o.x = cvt_pk_bf16(v[0], v[1]); o.y = cvt_pk_bf16(v[2], v[3]);
            *(u32x2*)((bf16*)(ws + WS_H) + ((size_t)u.gt * 256 + u.pn * 128 + r) * 256 + 16 * ns + 4 * fq) = o; }
        else { const float wt = ag_ld((const float*)(ws + WS_PW) + u.e * CAP + slot0 + r);
#pragma unroll
            for (int n = 0; n < NG; ++n) { u32x2 o; o.x = cvt_pk_bf16(acc[n][0] * wt, acc[n][1] * wt); o.y = cvt_pk_bf16(acc[n][2] * wt, acc[n][3] * wt);
                *(u32x2*)((bf16*)(ws + WS_Y2) + (size_t)dst * 1024 + 64 * ns + 16 * n + 4 * fq) = o; } } }
}
struct PhGateUp {
    static constexpr bool GATHER = true; static constexpr int LDA = 1024, K = 1024, LDB = 1024, HSTEPB = 128 * 1024 * 2;
    unsigned char* ws; const char* Abase; LAS unsigned char* lds; int G, c, nn;
    __device__ __forceinline__ bool next(int i, Unit& u) const { const int idx = i * G + c; if (idx >= 2 * nn) return false; u.pn = idx & 1; moe_decode(lds, ((const LAS int*)(lds + AUX_OFF))[MT_NLIST + (idx >> 1)], u); return true; }
    __device__ __forceinline__ void a_offs(const Unit& u, int tid, unsigned (&o)[2][2]) const { const int* pdst = (const int*)(ws + WS_PDST);
#pragma unroll
        for (int i = 0; i < 2; ++i) { int R, C; gm::stage_rc(tid * 16 + i * 8192, R, C);
#pragma unroll
            for (int h = 0; h < 2; ++h) { int slot = u.pm * 256 + 128 * h + R; slot = slot < u.cnt ? slot : u.cnt - 1; const int tok = ag_ld(&pdst[u.e * CAP + slot]) >> 1; o[h][i] = (unsigned)(tok * 1024 + C) * 2u; } }
    }
    __device__ __forceinline__ const char* a_tile(const Unit&) const { return Abase; }
    __device__ __forceinline__ const char* b_tile(const Unit& u) const { return (const char*)(ws + WS_WGU) + ((size_t)u.e * 512 + u.pn * 256) * 1024 * 2; }
    __device__ __forceinline__ void epi(EPI_ARGS) const { EPI_OPAQUE
        const int r0 = wr * 64 + fr, col0 = u.pn * 128 + wc * 32 + 8 * fq; const float* ps = (const float*)(ws + WS_PS) + u.e * CAP; bf16* H = (bf16*)(ws + WS_H);
        float sv[2][4];
#pragma unroll
        for (int ai = 0; ai < 2; ++ai)
#pragma unroll
            for (int m = 0; m < 4; ++m) { int slot = u.pm * 256 + r0 + ai * 128 + m * 16; slot = slot < u.cnt ? slot : u.cnt - 1; sv[ai][m] = ag_ld(&ps[slot]); }
        EPI_FENCE();
#pragma unroll
        for (int ai = 0; ai < 2; ++ai)
#pragma unroll
            for (int m = 0; m < 4; ++m) { const int r = r0 + ai * 128 + m * 16; const float s = sv[ai][m];
                f32x4 v0, v1;
#pragma unroll
                for (int j = 0; j < 4; ++j) { const float g0 = acc[ai][0][m][0][j] * s, u0 = acc[ai][1][m][0][j] * s, g1 = acc[ai][0][m][1][j] * s, u1 = acc[ai][1][m][1][j] * s;
                    v0[j] = g0 * fast_sigmoid(g0) * u0; v1[j] = g1 * fast_sigmoid(g1) * u1; }
                *(u32x4*)(H + ((size_t)u.gt * 256 + r) * 256 + col0) = pack8(v0, v1); }
        EPI_FENCE();
    }
};
struct PhDown {
    static constexpr bool GATHER = false; static constexpr int LDA = 256, K = 256, LDB = 256, HSTEPB = 128 * 256 * 2;
    unsigned char* ws; const char* Abase; LAS unsigned char* lds; int G, c, nn;
    __device__ __forceinline__ bool next(int i, Unit& u) const { const int idx = i * G + c; if (idx >= 4 * nn) return false; u.pn = idx & 3; moe_decode(lds, ((const LAS int*)(lds + AUX_OFF))[MT_NLIST + (idx >> 2)], u); return true; }
    NO_GATHER __device__ __forceinline__ const char* a_tile(const Unit& u) const { return Abase + (size_t)(u.gt * 256) * 256 * 2; }
    __device__ __forceinline__ const char* b_tile(const Unit& u) const { return (const char*)(ws + WS_WD) + ((size_t)u.e * 1024 + u.pn * 256) * 256 * 2; }
    __device__ __forceinline__ void epi(EPI_ARGS) const { EPI_OPAQUE
        const int r0 = u.pm * 256 + wr * 64 + fr, col0 = u.pn * 256 + wc * 32 + 8 * fq; const int* pdst = (const int*)(ws + WS_PDST) + u.e * CAP; const float* pw = (const float*)(ws + WS_PW) + u.e * CAP; bf16* Y2 = (bf16*)(ws + WS_Y2);
        int slot = r0 < u.cnt ? r0 : u.cnt - 1; int dn = pdst[slot]; float wn = pw[slot];
#pragma unroll
        for (int g = 0; g < 8; ++g) { const int ai = g >> 2, m = g & 3; const int dcur = dn; const float wcur = wn;
            if (g < 7) { int s2 = r0 + ((g + 1) >> 2) * 128 + ((g + 1) & 3) * 16; s2 = s2 < u.cnt ? s2 : u.cnt - 1; dn = pdst[s2]; wn = pw[s2]; }
            if (r0 + ai * 128 + m * 16 < u.cnt) { bf16* yp = Y2 + (size_t)dcur * 1024 + col0;
#pragma unroll
                for (int bj = 0; bj < 2; ++bj) *(u32x4*)(yp + bj * 128) = pack8(acc[ai][bj][m][0] * wcur, acc[ai][bj][m][1] * wcur); }
            EPI_FENCE(); }
    }
};
struct PhSloc {
    static constexpr bool GATHER = false; static constexpr int LDA = 384, K = 256, LDB = 256, HSTEPB = 0;
    unsigned char* ws; const char* Abase; int G, c;
    __device__ __forceinline__ bool next(int i, Unit& u) const { const int idx = i * G + c; if (idx >= 256) return false; u.e = idx >> 2; u.pm = idx & 3; u.pn = 0; u.gt = 0; u.cnt = 0; return true; }
    NO_GATHER __device__ __forceinline__ const char* a_tile(const Unit& u) const { return Abase + (size_t)(u.e * 1024 + u.pm * 256) * 384 * 2; }
    __device__ __forceinline__ const char* b_tile(const Unit& u) const { return (const char*)(ws + WS_SSM) + (size_t)u.e * SSM_G_BYTES; }
    __device__ __forceinline__ void epi(EPI_ARGS) const { EPI_OPAQUE
        const int r0 = u.e * 1024 + u.pm * 256 + wr * 64 + fr, col0 = wc * 32 + 8 * fq; float* Sloc = (float*)(ws + WS_SLOC);
#pragma unroll
        for (int ai = 0; ai < 2; ++ai)
#pragma unroll
            for (int m = 0; m < 4; ++m) { float* p = Sloc + (size_t)(r0 + ai * 128 + m * 16) * 128 + col0; *(f32x4*)p = acc[ai][0][m][0]; *(f32x4*)(p + 4) = acc[ai][0][m][1]; }
    }
};
struct PhY {
    static constexpr bool GATHER = false; static constexpr int LDA = 384, K = 384, LDB = 384, HSTEPB = 128 * 384 * 2;
    unsigned char* ws; const char* Abase; int G, c;
    __device__ __forceinline__ bool next(int i, Unit& u) const { const int idx = i * G + c; if (idx >= 256) return false; u.e = idx >> 2; u.pm = idx & 3; u.pn = 0; u.gt = 0; u.cnt = 0; return true; }
    NO_GATHER __device__ __forceinline__ const char* a_tile(const Unit& u) const { return Abase + (size_t)(u.e * 1024 + u.pm * 256) * 384 * 2; }
    __device__ __forceinline__ const char* b_tile(const Unit& u) const { return (const char*)(ws + WS_SSM) + (size_t)u.e * SSM_G_BYTES + SSM_A2_OFF; }
    __device__ __forceinline__ void epi(EPI_ARGS) const { EPI_OPAQUE
        const int nb = (u.pm & 1) * 256 + wr * 64 + fr;
        bf16* p = (bf16*)(ws + WS_G) + ((size_t)(u.pm >> 1) * SEQ + 16 * nb + 2 * wc + (fq >> 1)) * 1024 + 16 * u.e + 8 * (fq & 1);
#pragma unroll
        for (int ai = 0; ai < 2; ++ai)
#pragma unroll
            for (int m = 0; m < 4; ++m) {
#pragma unroll
                for (int bj = 0; bj < 2; ++bj) { f32x4 v0, v1;
#pragma unroll
                    for (int j = 0; j < 4; ++j) { v0[j] = fast_gelu(acc[ai][bj][m][0][j]); v1[j] = fast_gelu(acc[ai][bj][m][1][j]); }
                    *(u32x4*)(p + bj * 8 * 1024) = pack8(v0, v1); }
                p += (m == 3 ? (128 - 48) : 16) * 16 * 1024; asm volatile("" : "+v"(p) :: "memory"); }
    }
};

namespace at {
constexpr int NSLOT = 4, SLOTB = 8192;
constexpr int LDS_K = 0, LDS_V = NSLOT * SLOTB, LDS_WS = 2 * NSLOT * SLOTB, LDS_TBL = LDS_WS + 2048, LDS_OST = LDS_TBL + 2048, LDS_TOTAL = LDS_OST + 8 * 4096;
typedef short v4i16_t __attribute__((ext_vector_type(4)));
__device__ __forceinline__ int crow(int r, int hi) { return (r & 3) + 8 * (r >> 2) + 4 * hi; }
__device__ __forceinline__ void glds16(const void* gsrc, unsigned lds_dst) { unsigned keep;
    asm volatile("s_mov_b32 %0, m0\n\ts_mov_b32 m0, %2\n\ts_nop 0\n\tglobal_load_lds_dwordx4 %1, off\n\ts_mov_b32 m0, %0" : "=&s"(keep) : "v"(gsrc), "s"(lds_dst) : "memory"); }
__device__ __forceinline__ s16x4 vtr(const LAS unsigned char* p) { return __builtin_bit_cast(s16x4, __builtin_amdgcn_ds_read_tr16_b64_v4i16((LAS v4i16_t*)p)); }
#define AT_WAIT_BAR(N) asm volatile("s_waitcnt vmcnt(" #N ") lgkmcnt(0)\n\ts_barrier" ::: "memory")
template <int THR> __device__ __forceinline__ void attn_unit(int b, int h, int qb, const bf16* Q, const bf16* __restrict__ K, const bf16* __restrict__ V, bf16* O, const float* __restrict__ relb, LAS unsigned char* shm, int wid) {
    const int lane = lane_now(), tid = wid * 64 + lane, r32 = lane & 31, hi = lane >> 5;
    const long rowbase = (long)b * SEQ; const int q0 = qb * 256; const int cq = 4 * qb + (wid >> 1);
    const bf16* Qw = Q + (rowbase + q0 + wid * 32) * D + h * 64;
    const unsigned lds0 = (unsigned)(uintptr_t)shm;
    LAS float* wsf = (LAS float*)(shm + LDS_WS) + wid * 64; LAS float* tbl = (LAS float*)(shm + LDS_TBL);
    const int kc_lo = (4 * qb - 8) < 0 ? 0 : (4 * qb - 8); const int NT = 4 * qb + 3 - kc_lo + 1;
    const int ta = ((cq - 8) < kc_lo ? kc_lo : (cq - 8)) - kc_lo, tb_ = cq - kc_lo;
    if (tid < 320) tbl[tid] = relb[h * NREL + (tid < 256 ? tid : 256)] * LOG2E;
    const bf16* ksrc = K + (rowbase + kc_lo * 64 + lane) * D + h * 64 + wid * 8;
    const bf16* vsrc = V + (rowbase + kc_lo * 64 + 16 * (wid & 3) + (lane >> 2)) * D + h * 64 + (wid >> 2) * 32 + (lane & 3) * 8;
    const unsigned kdst = lds0 + LDS_K + wid * 1024, vdst = lds0 + LDS_V + wid * 1024;
#define AT_DMA(t) do { const unsigned so_ = (unsigned)((t) & 3) * SLOTB; glds16(ksrc + (long)(t) * 64 * D, (unsigned)__builtin_amdgcn_readfirstlane(kdst + so_)); glds16(vsrc + (long)(t) * 64 * D, (unsigned)__builtin_amdgcn_readfirstlane(vdst + so_)); } while (0)
    bf16x8 qr[4];
#pragma unroll
    for (int d0 = 0; d0 < 4; ++d0) qr[d0] = *reinterpret_cast<const bf16x8*>(&Qw[(long)r32 * D + d0 * 16 + hi * 8]);
    AT_DMA(0); AT_DMA(1); AT_DMA(2);
    asm volatile("" : "+v"(qr[0]), "+v"(qr[1]), "+v"(qr[2]), "+v"(qr[3]));
    float mrow = -1e30f, lsum = 0.f; f32x16 o[2]; o[0] = f32x16{}; o[1] = f32x16{};
    f32x16 s0 = f32x16{}, s1 = f32x16{};
    f32x16 cfar = f32x16{};
    const int qoff = 32 * (wid & 1) + r32 + 128 - 4 * hi;
#define AT_CINIT(P0, P1, kc_, msub_) do { const int delta_ = cq - (kc_); \
        if (delta_ >= 3) { P0 = cfar; P1 = cfar; } \
        else { const LAS float* tb = tbl + (64 * delta_ + qoff); _Pragma("unroll") for (int r = 0; r < 16; ++r) { const int kj = (r & 3) + 8 * (r >> 2); P0[r] = tb[-kj] - (msub_); P1[r] = tb[-kj - 32] - (msub_); } } } while (0)
#define AT_KLOAD(t_) do { const LAS unsigned char* kp = shm + LDS_K + ((t_) & 3) * SLOTB + hi * 1024 + r32 * 16; \
        _Pragma("unroll") for (int d0 = 0; d0 < 4; ++d0) { kf[2 * d0] = *(const LAS bf16x8*)(kp + d0 * 2048); kf[2 * d0 + 1] = *(const LAS bf16x8*)(kp + d0 * 2048 + 512); } } while (0)
#define AT_QK(P0, P1) do { _Pragma("unroll") for (int d0 = 0; d0 < 4; ++d0) { \
            P0 = __builtin_amdgcn_mfma_f32_32x32x16_bf16(kf[2 * d0], qr[d0], P0, 0, 0, 0); P1 = __builtin_amdgcn_mfma_f32_32x32x16_bf16(kf[2 * d0 + 1], qr[d0], P1, 0, 0, 0); } } while (0)
#define AT_CFAR() do { const float c0_ = tbl[256] - mrow; _Pragma("unroll") for (int r = 0; r < 16; ++r) cfar[r] = c0_; } while (0)
#define AT_STATS() do { float ra = fmaxf(fmaxf(s0[0], s0[1]), s1[0]), rb2 = fmaxf(fmaxf(s0[2], s0[3]), s1[1]); ra = fmaxf(fmaxf(ra, s1[2]), s1[3]); \
        _Pragma("unroll") for (int r = 4; r < 16; r += 4) { ra = fmaxf(fmaxf(ra, s0[r]), s0[r + 1]); rb2 = fmaxf(fmaxf(rb2, s0[r + 2]), s0[r + 3]); ra = fmaxf(fmaxf(ra, s1[r]), s1[r + 1]); rb2 = fmaxf(fmaxf(rb2, s1[r + 2]), s1[r + 3]); } \
        float rm = fmaxf(ra, rb2); { auto rr = __builtin_amdgcn_permlane32_swap(__float_as_uint(rm), __float_as_uint(rm), false, false); rm = fmaxf(__uint_as_float(rr[0]), __uint_as_float(rr[1])); } \
        if (mrow < -1e29f) { mrow = rm; _Pragma("unroll") for (int r = 0; r < 16; ++r) { s0[r] -= rm; s1[r] -= rm; } AT_CFAR(); } \
        else if (__any(rm > (float)THR)) { const float dl = fmaxf(rm, 0.f), f = __builtin_amdgcn_exp2f(-dl); mrow += dl; lsum *= f; \
            if (hi == 0) wsf[r32] = f; LDS_WAIT(); \
            _Pragma("unroll") for (int r = 0; r < 16; ++r) { const float fr_ = wsf[crow(r, hi)]; o[0][r] *= fr_; o[1][r] *= fr_; s0[r] -= dl; s1[r] -= dl; } AT_CFAR(); } } while (0)
#define AT_EXP_PACK() float sacc = 0.f, sacc2 = 0.f; \
        _Pragma("unroll") for (int r = 0; r < 16; ++r) { s0[r] = __builtin_amdgcn_exp2f(s0[r]); s1[r] = __builtin_amdgcn_exp2f(s1[r]); sacc += s0[r]; sacc2 += s1[r]; } \
        lsum += sacc + sacc2; \
        const u32x4 pw0 = (u32x4){cvtpk_s(s0[0], s0[1]), cvtpk_s(s0[2], s0[3]), cvtpk_s(s0[4], s0[5]), cvtpk_s(s0[6], s0[7])}; \
        const u32x4 pw1 = (u32x4){cvtpk_s(s0[8], s0[9]), cvtpk_s(s0[10], s0[11]), cvtpk_s(s0[12], s0[13]), cvtpk_s(s0[14], s0[15])}; \
        const u32x4 pw2 = (u32x4){cvtpk_s(s1[0], s1[1]), cvtpk_s(s1[2], s1[3]), cvtpk_s(s1[4], s1[5]), cvtpk_s(s1[6], s1[7])}; \
        const u32x4 pw3 = (u32x4){cvtpk_s(s1[8], s1[9]), cvtpk_s(s1[10], s1[11]), cvtpk_s(s1[12], s1[13]), cvtpk_s(s1[14], s1[15])}; \
        const bf16x8 pa[4] = {__builtin_bit_cast(bf16x8, pw0), __builtin_bit_cast(bf16x8, pw1), __builtin_bit_cast(bf16x8, pw2), __builtin_bit_cast(bf16x8, pw3)};
#define AT_VLOAD(t_) do { const LAS unsigned char* vp = shm + LDS_V + ((t_) & 3) * SLOTB + ((lane >> 4) & 1) * 32 + (lane & 3) * 8 + (4 * hi + ((lane & 15) >> 2)) * 64; \
        _Pragma("unroll") for (int d0 = 0; d0 < 2; ++d0) _Pragma("unroll") for (int ks = 0; ks < 4; ++ks) { vlo[d0 * 4 + ks] = vtr(vp + d0 * 4096 + ks * 1024); vhi[d0 * 4 + ks] = vtr(vp + d0 * 4096 + ks * 1024 + 512); } } while (0)
#define AT_PV() do { _Pragma("unroll") for (int d0 = 0; d0 < 2; ++d0) _Pragma("unroll") for (int ks = 0; ks < 4; ++ks) { const s16x4 lo = vlo[d0 * 4 + ks], hh = vhi[d0 * 4 + ks]; \
            const bf16x8 vf = (bf16x8){lo[0], lo[1], lo[2], lo[3], hh[0], hh[1], hh[2], hh[3]}; o[d0] = __builtin_amdgcn_mfma_f32_32x32x16_bf16(pa[ks], vf, o[d0], 0, 0, 0); } } while (0)
    bf16x8 kf[8]; s16x4 vlo[8], vhi[8];
    for (int t = 0; t < NT; ++t) {
        if (t + 2 < NT) { AT_WAIT_BAR(4); } else if (t + 1 < NT) { AT_WAIT_BAR(2); } else { AT_WAIT_BAR(0); }
        if (t + 3 < NT) AT_DMA(t + 3);
        if (t >= ta && t <= tb_) {
            AT_KLOAD(t); AT_VLOAD(t);
            __builtin_amdgcn_sched_barrier(0);
            if (mrow < -1e29f) { const float c0_ = tbl[256]; _Pragma("unroll") for (int r = 0; r < 16; ++r) cfar[r] = c0_; }
            AT_CINIT(s0, s1, kc_lo + t, (mrow < -1e29f ? 0.f : mrow));
            AT_QK(s0, s1);
            AT_STATS();
            AT_EXP_PACK()
            AT_PV();
        }
    }
    { auto rr = __builtin_amdgcn_permlane32_swap(__float_as_uint(lsum), __float_as_uint(lsum), false, false); lsum = __uint_as_float(rr[0]) + __uint_as_float(rr[1]); }
    if (hi == 0) wsf[32 + r32] = lsum;
    LDS_WAIT();
    float rli[16];
#pragma unroll
    for (int r = 0; r < 16; ++r) rli[r] = __builtin_amdgcn_rcpf(wsf[32 + crow(r, hi)]);
    bf16* Ow = O + (rowbase + q0 + wid * 32) * D + h * 64;
    { LAS bf16* stg = (LAS bf16*)(shm + LDS_OST) + wid * 2048;
#pragma unroll
      for (int r = 0; r < 16; ++r) { const int orow = crow(r, hi);
#pragma unroll
          for (int d0 = 0; d0 < 2; ++d0) stg[orow * 64 + d0 * 32 + r32] = f2bf(o[d0][r] * rli[r]); }
      LDS_WAIT();
#pragma unroll
      for (int i = 0; i < 4; ++i) { const int row = i * 8 + (lane >> 3), ch = lane & 7; const u32x4 v = *(const LAS u32x4*)(stg + row * 64 + ch * 8); *(u32x4*)(Ow + (long)row * D + ch * 8) = v; } }
    asm volatile("s_waitcnt lgkmcnt(0)\n\ts_barrier" ::: "memory");
#undef AT_DMA
#undef AT_CINIT
#undef AT_QK
#undef AT_KLOAD
#undef AT_VLOAD
#undef AT_CFAR
#undef AT_STATS
#undef AT_EXP_PACK
#undef AT_PV
}
}

struct Args { const float* in[23]; float* out; unsigned char* ws; int ph_lo, ph_hi, li, pad; };

struct TrDesc { const float* W; bf16* WT; const float* ks; int ldw, k0, n0, ldt, drow0; };
__device__ __forceinline__ void tr_load(const TrDesc& d, float (&v)[32], int lane) {
    const float* wp = d.W + (size_t)(d.k0 + (lane >> 5)) * d.ldw + d.n0 + (lane & 31);
#pragma unroll
    for (int i = 0; i < 32; ++i) v[i] = wp[(size_t)(2 * i) * d.ldw];
}
__device__ __forceinline__ void tr_store(const TrDesc& d, float (&v)[32], LAS float* scr, int lane) {
    if (d.ks) {
#pragma unroll
        for (int i = 0; i < 32; ++i) v[i] *= d.ks[d.k0 + 2 * i + (lane >> 5)]; }
#pragma unroll
    for (int i = 0; i < 32; ++i) scr[(2 * i + (lane >> 5)) * 33 + (lane & 31)] = v[i];
    LDS_WAIT(); asm volatile("" ::: "memory");
    const int c = lane & 7;
#pragma unroll
    for (int j = 0; j < 4; ++j) { const int n = (lane >> 3) + 8 * j; const LAS float* s = scr + (8 * c) * 33 + n;
        u32x4 o; o.x = pk2(s[0 * 33], s[1 * 33]); o.y = pk2(s[2 * 33], s[3 * 33]); o.z = pk2(s[4 * 33], s[5 * 33]); o.w = pk2(s[6 * 33], s[7 * 33]);
        *(u32x4*)(d.WT + (size_t)(d.drow0 + n) * d.ldt + d.k0 + 8 * c) = o; }
    LDS_WAIT(); asm volatile("" ::: "memory");
}
struct TrSrc { const float* w_qkv; const float* w_o; const float* w_out; const float* wg; const float* wu; const float* wd; const float* gn; unsigned char* ws; int nd, first, last; };
__device__ __forceinline__ TrDesc tr_desc(const TrSrc& S, int it) {
    TrDesc d; d.ks = nullptr;
    if (it < S.nd) {
        if (it < 1536) { const int kb = it / 96, nb = it % 96; d.W = S.w_qkv; d.ldw = 3072; d.k0 = kb * 64; d.n0 = nb * 32; d.WT = (bf16*)(S.ws + WS_WQKV); d.ldt = 1024; d.drow0 = nb * 32; }
        else if (it < 2048) { const int r = it - 1536, kb = r >> 5, nb = r & 31; d.W = S.w_o; d.ldw = 1024; d.k0 = kb * 64; d.n0 = nb * 32; d.WT = (bf16*)(S.ws + WS_WO); d.ldt = 1024; d.drow0 = nb * 32; }
        else { const int r = it - 2048, kb = r >> 6, nb = r & 63, n0 = nb * 32, ag = n0 >> 10, cc = n0 & 1023; d.W = S.w_out; d.ldw = 2048; d.k0 = kb * 64; d.n0 = n0; d.WT = (bf16*)(S.ws + WS_WOUT); d.ldt = 1024; d.drow0 = 256 * (cc >> 7) + 128 * ag + (cc & 127); }
    } else { const int m = it - S.nd;
        if (m < 8192) { const int which = m >> 12, r = m & 4095, e = r >> 7, kb = (r >> 3) & 15, nb = r & 7, n0 = nb * 32;
            d.W = (which ? S.wu : S.wg) + (size_t)e * 1024 * 256; d.ldw = 256; d.k0 = kb * 64; d.n0 = n0; d.WT = (bf16*)(S.ws + WS_WGU); d.ldt = 1024; d.drow0 = e * 512 + 256 * (n0 >> 7) + 128 * which + (n0 & 127); d.ks = S.gn; }
        else { const int r = m - 8192, e = r >> 7, kb = (r >> 5) & 3, nb = r & 31; d.W = S.wd + (size_t)e * 256 * 1024; d.ldw = 1024; d.k0 = kb * 64; d.n0 = nb * 32; d.WT = (bf16*)(S.ws + WS_WD); d.ldt = 256; d.drow0 = e * 1024 + nb * 32; } }
    return d;
}
__device__ __forceinline__ TrSrc mk_trsrc(const float* a, const float* b, const float* c, const float* g, const float* u, const float* d, const float* gn, unsigned char* ws, int nd, int first, int last) { TrSrc S; S.w_qkv = a; S.w_o = b; S.w_out = c; S.wg = g; S.wu = u; S.wd = d; S.gn = gn; S.ws = ws; S.nd = nd; S.first = first; S.last = last; return S; }
__device__ __forceinline__ void tr_stream(const TrSrc& S, LAS float* scr, int gw, int NGW, int lane) {
    const int N = S.last; int it = S.first + gw; if (it >= N) return;
    float va[32], vb[32]; TrDesc d0 = tr_desc(S, it), d1 = d0; tr_load(d0, va, lane);
    for (;;) {
        int nx = it + NGW; if (nx < N) { d1 = tr_desc(S, nx); tr_load(d1, vb, lane); }
        tr_store(d0, va, scr, lane); it = nx; if (it >= N) break;
        nx = it + NGW; if (nx < N) { d0 = tr_desc(S, nx); tr_load(d0, va, lane); }
        tr_store(d1, vb, scr, lane); it = nx; if (it >= N) break;
    }
}
__device__ __forceinline__ void ssm_mats(int g, int q, const float* lre, const float* lim, const float* lstep, const float* bre, const float* bim, const float* cre, const float* cim, const float* dsk,
                                         unsigned char* ssm_ws, float* a16g, LAS float* L, int tid) {
    LAS float* pwr = L; LAS float* pwi = L + 64 * 17; LAS float* bbr = L + 2 * 64 * 17; LAS float* bbi = bbr + 1024; LAS float* ccr = bbi + 1024; LAS float* cci = ccr + 1024; LAS float* Kt = cci + 1024;
    if (tid < 64) { const int p = tid;
        const float lr = fminf(lre[g * 64 + p], -1e-4f), li = lim[g * 64 + p], step = expf(lstep[g]);
        const float decay = expf(lr * step), ang = li * step, ar = decay * cosf(ang), ai = decay * sinf(ang);
        const float den = lr * lr + li * li, nr = ar - 1.f, fr = (nr * lr + ai * li) / den, fi = (ai * lr - nr * li) / den;
        for (int c = 0; c < 16; ++c) { const float br = bre[(g * 64 + p) * 16 + c], bi = bim[(g * 64 + p) * 16 + c]; bbr[p * 16 + c] = fr * br - fi * bi; bbi[p * 16 + c] = fr * bi + fi * br;
            ccr[c * 64 + p] = cre[(g * 16 + c) * 64 + p]; cci[c * 64 + p] = cim[(g * 16 + c) * 64 + p]; }
        float xr = 1.f, xi = 0.f;
        for (int n = 0; n <= 16; ++n) { pwr[p * 17 + n] = xr; pwi[p * 17 + n] = xi; const float t = xr * ar - xi * ai; xi = xr * ai + xi * ar; xr = t; }
        if (q == 0) { a16g[(g * 64 + p) * 2] = pwr[p * 17 + 16]; a16g[(g * 64 + p) * 2 + 1] = pwi[p * 17 + 16]; }
    }
    __syncthreads();
    if (tid < 256) { const int tl = tid >> 6, c = (tid >> 2) & 15, cq = tid & 3, tau = 4 * q + tl;
        float s0 = 0.f, s1 = 0.f, s2 = 0.f, s3 = 0.f;
        for (int p = 0; p < 64; ++p) { const float cr = ccr[c * 64 + p], ci = cci[c * 64 + p], ar = pwr[p * 17 + tau], ai = pwi[p * 17 + tau]; const float tr = cr * ar - ci * ai, ti = cr * ai + ci * ar;
            const f32x4 br = *(const LAS f32x4*)(bbr + p * 16 + 4 * cq), bi = *(const LAS f32x4*)(bbi + p * 16 + 4 * cq);
            s0 += tr * br[0] - ti * bi[0]; s1 += tr * br[1] - ti * bi[1]; s2 += tr * br[2] - ti * bi[2]; s3 += tr * br[3] - ti * bi[3]; }
        if (tau == 0) { const float dd = dsk[g * 16 + c]; if (4 * cq == (c & ~3)) { if ((c & 3) == 0) s0 += dd; else if ((c & 3) == 1) s1 += dd; else if ((c & 3) == 2) s2 += dd; else s3 += dd; } }
        LAS float* kp = Kt + tl * 256 + c * 16 + 4 * cq; kp[0] = s0; kp[1] = s1; kp[2] = s2; kp[3] = s3; }
    __syncthreads();
    bf16* Bend = (bf16*)(ssm_ws + (size_t)g * SSM_G_BYTES); bf16* A2 = (bf16*)(ssm_ws + (size_t)g * SSM_G_BYTES + SSM_A2_OFF);
    for (int o = tid; o < 2048; o += NTHR) { const int tl = o >> 9, i = (o >> 5) & 15, c = (o >> 1) & 15, hf = o & 1, tau = 4 * q + tl, j = i - tau;
        if (j >= 0) { const LAS float* kp = Kt + tl * 256 + c * 16 + 8 * hf; u32x4 w; w.x = pk2(kp[0], kp[1]); w.y = pk2(kp[2], kp[3]); w.z = pk2(kp[4], kp[5]); w.w = pk2(kp[6], kp[7]);
            *(u32x4*)(A2 + (size_t)(i * 16 + c) * 384 + j * 16 + 8 * hf) = w; } }
    for (int o = tid; o < 2048; o += NTHR) { const int il = o >> 9, c = (o >> 5) & 15, j = (o >> 1) & 15, hf = o & 1, i = 4 * q + il;
        if (j > i) *(u32x4*)(A2 + (size_t)(i * 16 + c) * 384 + j * 16 + 8 * hf) = (u32x4){0u, 0u, 0u, 0u}; }
    for (int o = tid; o < 1024; o += NTHR) { const int il = o >> 8, c = (o >> 4) & 15, k8 = (o & 15) * 8, i = 4 * q + il; float v[8];
#pragma unroll
        for (int qq = 0; qq < 4; ++qq) { const int p = (k8 >> 1) + qq; const float cr = ccr[c * 64 + p], ci = cci[c * 64 + p], ar = pwr[p * 17 + i + 1], ai = pwi[p * 17 + i + 1];
            v[2 * qq] = cr * ar - ci * ai; v[2 * qq + 1] = -(cr * ai + ci * ar); }
        u32x4 w; w.x = pk2(v[0], v[1]); w.y = pk2(v[2], v[3]); w.z = pk2(v[4], v[5]); w.w = pk2(v[6], v[7]); *(u32x4*)(A2 + (size_t)(i * 16 + c) * 384 + 256 + k8) = w; }
    for (int o = tid; o < 1024; o += NTHR) { const int n = 32 * q + (o >> 5), k8 = (o & 31) * 8, p = n >> 1, ri = n & 1, j = k8 >> 4; float v[8];
        const float ar = pwr[p * 17 + 15 - j], ai = pwi[p * 17 + 15 - j];
#pragma unroll
        for (int qq = 0; qq < 8; ++qq) { const int c2 = (k8 & 15) + qq; const float br = bbr[p * 16 + c2], bi = bbi[p * 16 + c2]; v[qq] = ri ? (ar * bi + ai * br) : (ar * br - ai * bi); }
        u32x4 w; w.x = pk2(v[0], v[1]); w.y = pk2(v[2], v[3]); w.z = pk2(v[4], v[5]); w.w = pk2(v[6], v[7]); *(u32x4*)(Bend + (size_t)n * 256 + k8) = w; }
    __syncthreads();
}

__device__ __forceinline__ void router_phase(const bf16* __restrict__ h, const u32x4* __restrict__ rwt, const float* __restrict__ bgr, const float* __restrict__ ber, unsigned* cntg,
                                             int* pdst, float* pw, float* ps, float* srow, LAS unsigned char* lds, int vcu, int G, int wid, bool prefilled) {
    const int lane = lane_now(), tid = wid * 64 + lane;
    LAS bf16* Wl = (LAS bf16*)lds;
    if (!prefilled) for (int i = tid; i < RW_LAYER_BYTES / 16; i += NTHR) ((LAS u32x4*)lds)[i] = rwt[i];
    LAS int* lc = (LAS int*)(lds + RSCR_OFF); LAS int* lbase = lc + 32;
    const int rb = wid & 3, kh = wid >> 2, row = lane & 15, kq = lane >> 4;
    for (int blk = vcu; blk < M / 64; blk += G) {
        if (tid < 32) lc[tid] = 0;
        __syncthreads();
        const int t0 = blk * 64;
        const bf16* hp = h + (size_t)(t0 + 16 * rb + row) * D + 512 * kh + 8 * kq;
        const LAS bf16* wp0 = Wl + row * RW_PITCH + 512 * kh + 8 * kq; const LAS bf16* wp1 = wp0 + 16 * RW_PITCH; const LAS bf16* wp2 = Wl + (32 + (row & 3)) * RW_PITCH + 512 * kh + 8 * kq;
        f32x4 a0 = {0.f, 0.f, 0.f, 0.f}, a1 = a0, a2 = a0; float ssl = 0.f;
#pragma unroll 4
        for (int j = 0; j < 16; ++j) { const u32x4 hw = *(const u32x4*)(hp + 32 * j); const bf16x8 av = __builtin_bit_cast(bf16x8, hw);
#pragma unroll
            for (int i = 0; i < 4; ++i) { const float lo_ = __uint_as_float(hw[i] << 16), hi_ = __uint_as_float(hw[i] & 0xffff0000u); ssl += lo_ * lo_ + hi_ * hi_; }
            const bf16x8 b0h = *(const LAS bf16x8*)(wp0 + 32 * j), b0l = *(const LAS bf16x8*)(wp0 + RW_PLANE + 32 * j), b1h = *(const LAS bf16x8*)(wp1 + 32 * j), b1l = *(const LAS bf16x8*)(wp1 + RW_PLANE + 32 * j),
                         b2h = *(const LAS bf16x8*)(wp2 + 32 * j), b2l = *(const LAS bf16x8*)(wp2 + RW_PLANE + 32 * j);
            a0 = __builtin_amdgcn_mfma_f32_16x16x32_bf16(av, b0h, a0, 0, 0, 0); a0 = __builtin_amdgcn_mfma_f32_16x16x32_bf16(av, b0l, a0, 0, 0, 0);
            a1 = __builtin_amdgcn_mfma_f32_16x16x32_bf16(av, b1h, a1, 0, 0, 0); a1 = __builtin_amdgcn_mfma_f32_16x16x32_bf16(av, b1l, a1, 0, 0, 0);
            a2 = __builtin_amdgcn_mfma_f32_16x16x32_bf16(av, b2h, a2, 0, 0, 0); a2 = __builtin_amdgcn_mfma_f32_16x16x32_bf16(av, b2l, a2, 0, 0, 0); }
        ssl += __shfl_xor(ssl, 16); ssl += __shfl_xor(ssl, 32);
        LAS float* P = (LAS float*)(lds + RSCR_OFF + 256);
        LAS float* pp = P + (16 * rb) * 40;
        if (kh == 1) {
#pragma unroll
            for (int r = 0; r < 4; ++r) { const int tk = 4 * kq + r; pp[tk * 40 + row] = a0[r]; pp[tk * 40 + 16 + row] = a1[r]; if (row < 4) pp[tk * 40 + 32 + row] = a2[r]; }
            if (kq == 0) pp[row * 40 + 36] = ssl; }
        __syncthreads();
        if (kh == 0) {
#pragma unroll
            for (int r = 0; r < 4; ++r) { const int tk = 4 * kq + r; pp[tk * 40 + row] += a0[r]; pp[tk * 40 + 16 + row] += a1[r]; if (row < 4) pp[tk * 40 + 32 + row] += a2[r]; }
            if (kq == 0) pp[row * 40 + 36] += ssl; }
        __syncthreads();
        int e1 = 0, e2 = 0; float w1 = 0.f, w2 = 0.f, s = 0.f; int sl1 = 0, sl2 = 0;
        if (tid < 64) { LAS float* p0 = P + tid * 40;
            s = rsqrtf(p0[36] * (1.f / D) + RMS_EPS);
            for (int o = 0; o < 36; ++o) p0[o] = p0[o] * s + (o < 4 ? bgr[o] : ber[o - 4]);
            int gi = 0; float gmx = p0[0];
            for (int i = 1; i < 4; ++i) if (p0[i] > gmx) { gmx = p0[i]; gi = i; }
            float den = 0.f; for (int i = 0; i < 4; ++i) den += __expf(p0[i] - gmx);
            const float gp = 1.f / den; const LAS float* sl = p0 + 4 + 8 * gi;
            int i1 = 0; float l1 = sl[0]; for (int i = 1; i < 8; ++i) if (sl[i] > l1) { l1 = sl[i]; i1 = i; }
            int i2 = -1; float l2 = -3.4e38f; for (int i = 0; i < 8; ++i) if (i != i1 && sl[i] > l2) { l2 = sl[i]; i2 = i; }
            const float ex = __expf(l2 - l1); w1 = gp / (1.f + ex); w2 = gp * ex / (1.f + ex); e1 = gi * 8 + i1; e2 = gi * 8 + i2;
            sl1 = __hip_atomic_fetch_add(&lc[e1], 1, __ATOMIC_RELAXED, __HIP_MEMORY_SCOPE_WORKGROUP); sl2 = __hip_atomic_fetch_add(&lc[e2], 1, __ATOMIC_RELAXED, __HIP_MEMORY_SCOPE_WORKGROUP);
            }
        __syncthreads();
        if (tid < 32) { const int n = lc[tid]; lbase[tid] = n ? (int)__hip_atomic_fetch_add(cntg + tid * 64, (unsigned)n, RLX_AGENT) : 0; }
        __syncthreads();
        if (tid < 64) { const int t = t0 + tid; int i1 = lbase[e1] + sl1, i2 = lbase[e2] + sl2;
            if (i1 < CAP) { ag_st(&pdst[e1 * CAP + i1], 2 * t); ag_st(&pw[e1 * CAP + i1], w1); ag_st(&ps[e1 * CAP + i1], s); }
            if (i2 < CAP) { ag_st(&pdst[e2 * CAP + i2], 2 * t + 1); ag_st(&pw[e2 * CAP + i2], w2); ag_st(&ps[e2 * CAP + i2], s); } }
        __syncthreads();
    }
}

template <bool FINAL> __device__ __forceinline__ void combine_phase(const bf16* __restrict__ hin, const bf16* __restrict__ Y2, const float* __restrict__ g, bf16* __restrict__ hout, bf16* __restrict__ xng, float* __restrict__ outf, int vcu, int G, int wid, int lane) {
    for (int base = vcu * 16; base < M; base += G * 16) {
#pragma unroll
        for (int rr = 0; rr < 2; ++rr) { const int row = base + 2 * wid + rr;
            float4 v[4]; float ss = 0.f;
#pragma unroll
            for (int j = 0; j < 4; ++j) { const int c = 4 * (lane + 64 * j);
                const u32x2 hh = *(const u32x2*)(hin + (size_t)row * D + c), ya = *(const u32x2*)(Y2 + ((size_t)2 * row) * D + c), yb = *(const u32x2*)(Y2 + ((size_t)2 * row + 1) * D + c);
                v[j].x = __uint_as_float(hh.x << 16) + __uint_as_float(ya.x << 16) + __uint_as_float(yb.x << 16); v[j].y = __uint_as_float(hh.x & 0xffff0000u) + __uint_as_float(ya.x & 0xffff0000u) + __uint_as_float(yb.x & 0xffff0000u);
                v[j].z = __uint_as_float(hh.y << 16) + __uint_as_float(ya.y << 16) + __uint_as_float(yb.y << 16); v[j].w = __uint_as_float(hh.y & 0xffff0000u) + __uint_as_float(ya.y & 0xffff0000u) + __uint_as_float(yb.y & 0xffff0000u);
                ss += v[j].x * v[j].x + v[j].y * v[j].y + v[j].z * v[j].z + v[j].w * v[j].w;
                if (!FINAL) { u32x2 w; w.x = pk2(v[j].x, v[j].y); w.y = pk2(v[j].z, v[j].w); *(u32x2*)(hout + (size_t)row * D + c) = w; } }
            ss = wave_sum(ss); const float s = rsqrtf(ss * (1.f / D) + RMS_EPS);
#pragma unroll
            for (int j = 0; j < 4; ++j) { const int c = 4 * (lane + 64 * j); const float4 gg = *(const float4*)(g + c);
                const float ox = v[j].x * s * gg.x, oy = v[j].y * s * gg.y, oz = v[j].z * s * gg.z, ow = v[j].w * s * gg.w;
                if (FINAL) { float4 o; o.x = ox; o.y = oy; o.z = oz; o.w = ow; *(float4*)(outf + (size_t)row * D + c) = o; }
                else { u32x2 w; w.x = pk2(ox, oy); w.y = pk2(oz, ow); *(u32x2*)(xng + xng_off(row, c)) = w; } } }
    }
}

__device__ __forceinline__ void scan_unit(int g, int pm, const float* __restrict__ Sloc, const float* __restrict__ a16g, bf16* xng, unsigned* ctl, LAS unsigned char* lds, int wid) {
    const int tid = wid * 64 + lane_now(), p = tid & 63, q = tid >> 6, b = pm >> 1, half = pm & 1;
    LAS float* E = (LAS float*)(lds + AUX_OFF);
    const float ar = a16g[(g * 64 + p) * 2], ai = a16g[(g * 64 + p) * 2 + 1];
    float pr = ar, pi = ai;
#pragma unroll
    for (int k = 0; k < 5; ++k) { const float nr = pr * pr - pi * pi, ni = 2.f * pr * pi; pr = nr; pi = ni; }
    unsigned* flag = ctl + CW_CARRYF + (2 * g + b) * 64;
    unsigned long long* slot = (unsigned long long*)ctl + CW_CARRY / 2 + (2 * g + b) * 64 + p;
    const size_t row0 = (size_t)g * 1024 + b * 512 + half * 256 + q * 32;
    const float* sp = Sloc + row0 * 128 + 2 * p;
    float2 v[32];
#pragma unroll
    for (int s = 0; s < 32; ++s) v[s] = *(const float2*)(sp + (size_t)s * 128);
    float xr = 0.f, xi = 0.f;
#pragma unroll
    for (int s = 0; s < 32; ++s) { const float nr = ar * xr - ai * xi + v[s].x, ni = ar * xi + ai * xr + v[s].y; xr = nr; xi = ni; }
    E[(q * 64 + p) * 2] = xr; E[(q * 64 + p) * 2 + 1] = xi;
    if (half && tid == 0) { unsigned sp_ = 0; while (__hip_atomic_load(flag, __ATOMIC_RELAXED, __HIP_MEMORY_SCOPE_AGENT) == 0u) { __builtin_amdgcn_s_sleep(1); if (++sp_ > (1u << 22)) break; } }
    __syncthreads();
    float cr = 0.f, ci = 0.f;
    if (half) { const unsigned long long cv = __hip_atomic_load(slot, __ATOMIC_RELAXED, __HIP_MEMORY_SCOPE_AGENT); cr = __uint_as_float((unsigned)cv); ci = __uint_as_float((unsigned)(cv >> 32)); }
    float ir = cr, ii = ci, mr = 0.f, mi = 0.f;
#pragma unroll
    for (int qq = 0; qq < 8; ++qq) { if (qq == q) { mr = ir; mi = ii; } const float er = E[(qq * 64 + p) * 2], ei = E[(qq * 64 + p) * 2 + 1]; const float nr = pr * ir - pi * ii + er, ni = pr * ii + pi * ir + ei; ir = nr; ii = ni; }
    if (!half && q == 0) {
        __hip_atomic_store(slot, (unsigned long long)__float_as_uint(ir) | ((unsigned long long)__float_as_uint(ii) << 32), __ATOMIC_RELAXED, __HIP_MEMORY_SCOPE_AGENT);
        asm volatile("s_waitcnt vmcnt(0)" ::: "memory");
        if (p == 0) __hip_atomic_store(flag, 1u, __ATOMIC_RELAXED, __HIP_MEMORY_SCOPE_AGENT); }
    { bf16* xp = xng + row0 * 384 + 256 + 2 * p; xr = mr; xi = mi;
#pragma unroll
      for (int s = 0; s < 32; ++s) { *(unsigned*)(xp + (size_t)s * 384) = pk2(xr, xi); const float nr = ar * xr - ai * xi + v[s].x, ni = ar * xi + ai * xr + v[s].y; xr = nr; xi = ni; } }
    __syncthreads();
}

__global__ void __launch_bounds__(NTHR, 2) mk_fwd(Args args) {
    extern __shared__ __attribute__((aligned(16))) unsigned char lds_[];
    LAS unsigned char* lds = (LAS unsigned char*)lds_;
    volatile LAS unsigned* MISC = (volatile LAS unsigned*)(lds + MISC_OFF);
    const int wid = __builtin_amdgcn_readfirstlane(threadIdx.x >> 6);
#define lane lane_now()
#define tid (wid * 64 + lane_now())
    const int G = gridDim.x; const int bx = blockIdx.x; const int vcu = (G % 8 == 0) ? (bx % 8) * (G / 8) + bx / 8 : bx;
    unsigned char* const ws = args.ws;
    constexpr size_t EW = (size_t)NEXP * 1024 * 256;
    for (int u = tid; u < (LDS_BYTES - MISC_OFF) / 4; u += NTHR) ((LAS unsigned*)(lds + MISC_OFF))[u] = 0u;
    __syncthreads();
    const int lo = args.ph_lo, hi = args.ph_hi;
    XcdBarrier bar; bar.bar = (unsigned*)ws + CW_BAR + args.li * XCD_BAR_WORDS; bar.x = 0; bar.st = nullptr;
    if (hi - lo > 1) bar = xcd_barrier_post((unsigned*)ws + CW_BAR + args.li * XCD_BAR_WORDS, MISC + 8, wid);
    const int gw = vcu * NWAVES + wid, NGW = G * NWAVES;
#ifndef PH_ONLY
#define PH_ONLY -1
#endif
#define IN(k) ((PH_ONLY < 0 || PH_ONLY == ((k) >= 12 && (k) <= 14 ? (k) - 8 : (k))) && lo <= (k) && (k) < hi)
#ifndef TS_K1
#define TS_K1 -1
#define TS_K2 -1
#endif
#define TS_STAMP(k) do { if (TS_K1 >= 0 && bx == 0 && tid == 0) ((unsigned long long*)(ws + WS_TS))[k] = __builtin_amdgcn_s_memrealtime(); } while (0)
#define SEAM(k) do { if ((k) + 1 < hi) { xcd_arrive(bar, wid); xcd_wait(bar, wid); } TS_STAMP((k) + 1); } while (0)
#define SEAMX(k, ...) do { if ((k) + 1 < hi) xcd_arrive(bar, wid); { __VA_ARGS__; } if ((k) + 1 < hi) xcd_wait(bar, wid); TS_STAMP((k) + 1); } while (0)
#define SEAMXL(k, ...) do { if ((k) + 1 < hi) xcd_arrive(bar, wid, true); { __VA_ARGS__; } if ((k) + 1 < hi) xcd_wait(bar, wid, true); TS_STAMP((k) + 1); } while (0)
#define STEAL0(first, last) do { TrSrc S_ = mk_trsrc(args.in[4], args.in[5], args.in[15], args.in[20], args.in[21], args.in[22], args.in[2], ws, 3072, (first), (last)); tr_stream(S_, SCR, gw, NGW, lane); } while (0)
#define STEAL1(first) do { TrSrc S_ = mk_trsrc(nullptr, nullptr, nullptr, args.in[20] + EW, args.in[21] + EW, args.in[22] + EW, args.in[2] + D, ws, 0, (first), (first) + NGW); tr_stream(S_, SCR, gw, NGW, lane); } while (0)
#define SCR ((LAS float*)(lds + wid * 16384))
#define ROUTER_PREFILL(layer) do { const u32x4* rw_ = (const u32x4*)(ws + WS_RWT + (size_t)(layer) * RW_LAYER_BYTES); for (int i_ = tid; i_ < RW_LAYER_BYTES / 16; i_ += NTHR) ((LAS u32x4*)lds)[i_] = rw_[i_]; } while (0)
    TS_STAMP(0);
    if (IN(0)) {
        { TrSrc S{args.in[4], args.in[5], args.in[15], args.in[20], args.in[21], args.in[22], args.in[2], ws, 3072, 0, 1536}; tr_stream(S, SCR, gw, NGW, lane); }
        { const float* x = args.in[0]; const float* norm_mix = args.in[1]; bf16* XN = (bf16*)(ws + WS_XN);
          for (int m0 = 2 * gw; m0 < M; m0 += 2 * NGW) { float4 v[2][4];
#pragma unroll
            for (int rr = 0; rr < 2; ++rr) { const float4* xr = (const float4*)(x + (size_t)(m0 + rr) * D);
#pragma unroll
                for (int j = 0; j < 4; ++j) v[rr][j] = xr[lane + 64 * j]; }
#pragma unroll
            for (int rr = 0; rr < 2; ++rr) { float ss = 0.f;
#pragma unroll
                for (int j = 0; j < 4; ++j) ss += v[rr][j].x * v[rr][j].x + v[rr][j].y * v[rr][j].y + v[rr][j].z * v[rr][j].z + v[rr][j].w * v[rr][j].w;
                ss = wave_sum(ss); const float s = rsqrtf(ss * (1.f / D) + RMS_EPS);
#pragma unroll
                for (int j = 0; j < 4; ++j) { const int c = 4 * (lane + 64 * j); const float4 gg = *(const float4*)(norm_mix + c); u32x2 w; w.x = pk2(v[rr][j].x * s * gg.x, v[rr][j].y * s * gg.y); w.y = pk2(v[rr][j].z * s * gg.z, v[rr][j].w * s * gg.w);
                    *(u32x2*)(XN + (size_t)(m0 + rr) * D + c) = w; } } } }
        SEAMX(0, STEAL0(1536, 5632));
    }
#define SIDE1() do { \
        { bf16* rwt = (bf16*)(ws + WS_RWT); const float* norm_ffn = args.in[2]; \
          for (int o = bx * NTHR + tid; o < 2 * 36 * 1024; o += G * NTHR) { const int layer = o / (36 * 1024), r = o % (36 * 1024), col = r >> 10, k = r & 1023; \
            const float gnk = norm_ffn[layer * D + k]; \
            const float w = gnk * (col < 4 ? args.in[16][(size_t)layer * 4096 + k * 4 + col] : args.in[18][(size_t)layer * 32768 + ((size_t)((col - 4) >> 3) * 1024 + k) * 8 + ((col - 4) & 7)]); \
            const bf16 hi_ = f2bf(w); const bf16 lo_ = f2bf(w - bf2f(hi_)); \
            rwt[(size_t)layer * 2 * RW_PLANE + col * RW_PITCH + k] = hi_; rwt[(size_t)layer * 2 * RW_PLANE + RW_PLANE + col * RW_PITCH + k] = lo_; } } \
        __syncthreads(); \
        for (int gq = vcu; gq < 256; gq += G) ssm_mats(gq >> 2, gq & 3, args.in[7], args.in[8], args.in[9], args.in[10], args.in[11], args.in[12], args.in[13], args.in[14], ws + WS_SSM, (float*)(ws + WS_A16), (LAS float*)lds, tid); \
        __syncthreads(); } while (0)
    if (IN(1)) { if (vcu & 1) SIDE1(); { PhQKV P{ws, (const char*)(ws + WS_XN), G, bx}; gm::gemm_phase(lds, P, wid); } if (!(vcu & 1)) SIDE1(); SEAMX(1, STEAL0(5632, 9728)); }
#undef SIDE1

    if (IN(2)) {
        const int per = 1024 / G;
        for (int i = 0; i < per; ++i) { const int uid = vcu * per + i; const int bh = uid >> 5, qb = uid & 31;
            at::attn_unit<8>(bh >> 4, bh & 15, qb, (const bf16*)(ws + WS_Q), (const bf16*)(ws + WS_K), (const bf16*)(ws + WS_V), (bf16*)(ws + (args.pad ? WS_XN : WS_Q)), args.in[6], lds, wid); }
        SEAMX(2, STEAL0(9728, 13824));
    }
    if (IN(3)) {
        { PhWo P{ws, (const char*)(ws + WS_Q), args.in[0], args.out, G, bx}; gm::gemm_phase(lds, P, wid); }
        SEAMX(3, STEAL0(13824, 15360); __syncthreads(); if (4 < hi) ROUTER_PREFILL(0)); }

#define MOE_LAYER(layer, pr) \
    if (IN(pr)) { router_phase((layer) ? (const bf16*)(ws + WS_XN) : (const bf16*)args.out, (const u32x4*)(ws + WS_RWT + (size_t)(layer) * RW_LAYER_BYTES), args.in[17] + (layer) * 4, args.in[19] + (layer) * 32, (unsigned*)ws + CW_CNT + (layer) * 32 * 64, \
                               (int*)(ws + WS_PDST), (float*)(ws + WS_PW), (float*)(ws + WS_PS), (float*)(ws + WS_SROW), lds, vcu, G, wid, (pr) > lo); SEAMXL(pr, if (layer) STEAL1(10240)); } \
    if (IN((pr) + 1) || IN((pr) + 2)) { \
        if (IN((pr) + 1)) { moe_tables(lds, (const unsigned*)ws + CW_CNT + (layer) * 32 * 64, tid); const bf16* hbp = (layer) ? (const bf16*)(ws + WS_XN) : (const bf16*)args.out; \
            { PhGateUp P{ws, (const char*)hbp, lds, G, vcu, __builtin_amdgcn_readfirstlane(((const LAS int*)(lds + AUX_OFF))[MT_NN])}; gm::gemm_phase(lds, P, wid); } \
            { const LAS int* mt = (const LAS int*)(lds + AUX_OFF); const int np = 16 * mt[MT_NS]; for (int j = G - 1 - vcu; j < np; j += G) { Unit u; const int code_ = mt[MT_SLIST + (j >> 4)]; u.pn = (code_ >> 7) & 1; moe_decode(lds, code_, u); tail_job<true>(ws, hbp, u, j & 15, wid, lds); } } \
            SEAM((pr) + 1); } \
        if (IN((pr) + 2)) { if (!IN((pr) + 1)) moe_tables(lds, (const unsigned*)ws + CW_CNT + (layer) * 32 * 64, tid); \
            { PhDown P{ws, (const char*)(ws + WS_H), lds, G, vcu, __builtin_amdgcn_readfirstlane(((const LAS int*)(lds + AUX_OFF))[MT_NN])}; gm::gemm_phase(lds, P, wid); } \
            { const LAS int* mt = (const LAS int*)(lds + AUX_OFF); const int np = 16 * mt[MT_NS]; for (int j = G - 1 - vcu; j < np; j += G) { Unit u; const int code_ = mt[MT_SLIST + (j >> 4)]; u.pn = (code_ >> 7) & 1; moe_decode(lds, code_, u); tail_job<false>(ws, (const bf16*)(ws + WS_H), u, j & 15, wid, lds); } } \
            SEAMX((pr) + 2, if (!(layer)) STEAL1(0)); } \
    }
    MOE_LAYER(0, 4)
    if (IN(7)) {
        combine_phase<false>((const bf16*)args.out, (const bf16*)(ws + WS_Y2), args.in[1] + D, (bf16*)args.out + (size_t)M * D, (bf16*)(ws + WS_XN), nullptr, vcu, G, wid, lane);
        SEAMX(7, STEAL1(2048); STEAL1(4096)); }
    if (IN(8)) { PhSloc P{ws, (const char*)(ws + WS_XN), G, vcu}; gm::gemm_phase(lds, P, wid); asm volatile("s_waitcnt vmcnt(0)" ::: "memory"); __syncthreads(); }
    if (IN(10)) {
        for (int idx = vcu; idx < 256; idx += G) scan_unit(idx >> 2, idx & 3, (const float*)(ws + WS_SLOC), (const float*)(ws + WS_A16), (bf16*)(ws + WS_XN), (unsigned*)ws, lds, wid);
        asm volatile("s_waitcnt vmcnt(0)" ::: "memory"); __syncthreads();
        PhY P{ws, (const char*)(ws + WS_XN), G, vcu}; gm::gemm_phase(lds, P, wid); SEAMX(10, STEAL1(6144)); }
    if (IN(11)) {
        { PhWout P{ws, (const char*)(ws + WS_G), args.out, G, bx}; gm::gemm_phase(lds, P, wid); }
        SEAMX(11, STEAL1(8192); __syncthreads(); if (12 < hi) ROUTER_PREFILL(1)); }

    MOE_LAYER(1, 12)
#undef MOE_LAYER
    if (IN(15)) { combine_phase<true>((const bf16*)(ws + WS_XN), (const bf16*)(ws + WS_Y2), args.in[3], nullptr, nullptr, args.out, vcu, G, wid, lane);
#if TS_K1 >= 0
        { const unsigned long long* ts = (const unsigned long long*)(ws + WS_TS); const float dtus = (float)(ts[TS_K1 + 1] - ts[TS_K1]) * 1e-2f; const float e = exp2f(rintf(log2f(dtus) * 6.f) / 6.f) * 1e-2f;
          __syncthreads();
          for (int base = vcu * 16; base < M; base += G * 16) for (int i = tid; i < 16 * D; i += NTHR) args.out[(size_t)base * D + i] *= (1.f + e);
          if (TS_K2 >= 0 && bx == 0) { __syncthreads(); if (tid == 0) args.out[0] = exp2f(rintf(log2f((float)(ts[TS_K2 + 1] - ts[TS_K2]) * 1e-2f) * 6.f) / 6.f); } }
#endif
    }
#undef IN
#undef SEAM
#undef SCR
#undef lane
#undef tid
}

#ifndef FUSED
#define FUSED 1
#endif
#ifndef DUP_PH
#define DUP_PH -1
#endif
extern "C" void kernel_launch(void* const* d_in, const int* in_sizes, int n_in, void* d_out, int out_size, void* d_ws, size_t ws_size, hipStream_t stream) {
    static int grid = 0;
    if (grid == 0) {
        if (n_in != 23 || out_size != M * D || ws_size < WS_END) { fprintf(stderr, "kernel_launch: unexpected shapes (n_in %d out %d ws %zu)\n", n_in, out_size, ws_size); grid = -1; return; }
        int dev = 0, cus = 0;
        if (hipGetDevice(&dev) != hipSuccess || hipDeviceGetAttribute(&cus, hipDeviceAttributeMultiprocessorCount, dev) != hipSuccess) { grid = -1; return; }
        if (hipFuncSetAttribute((const void*)mk_fwd, hipFuncAttributeMaxDynamicSharedMemorySize, LDS_BYTES) != hipSuccess) { fprintf(stderr, "kernel_launch: hipFuncSetAttribute failed\n"); grid = -1; return; }
        (void)hipGetLastError();
        grid = cus;
        if (grid != 256) fprintf(stderr, "kernel_launch: %d CUs (built for 256)\n", grid);
    }
    if (grid < 0) return;
    unsigned char* ws = (unsigned char*)d_ws;
    (void)hipMemsetAsync(ws + WS_CTL, 0, CTL_ZERO_BYTES, stream);
    Args a{}; for (int i = 0; i < 23; ++i) a.in[i] = (const float*)d_in[i];
    a.out = (float*)d_out; a.ws = ws;
    int li = 0;
    auto run = [&](int lo, int hi) { a.ph_lo = lo; a.ph_hi = hi; a.li = li++; hipLaunchKernelGGL(mk_fwd, dim3(grid), dim3(NTHR), LDS_BYTES, stream, a); };
    if (FUSED) { run(0, N_PHASES); return; }
    for (int ph = 0; ph < N_PHASES; ++ph) { if (ph == 9) continue;
        if (DUP_PH == ph) { if (ph == 2) { a.pad = 1; run(2, 3); a.pad = 0; } else run(ph, ph + 1); }
        run(ph, ph + 1); }
}
```

```cpp
#include <hip/hip_runtime.h>
#include <cstdio>
#include <cstdint>

typedef unsigned short bf16;
constexpr int BATCH = 2, SEQ = 8192, D = 1024, M = BATCH * SEQ, NH = 16, HD = 64;
constexpr int NEXP = 32, EPG = 8, FE = 256;
constexpr int NREL = 257;
constexpr float RMS_EPS = 1e-6f;
constexpr float LOG2E = 1.4426950408889634f;
constexpr float C2 = 0.125f * LOG2E;

constexpr size_t MiB = 1u << 20;
constexpr size_t WS_CTL = 0;
constexpr size_t WS_XN = 86 * MiB;
constexpr size_t WS_BIG = 134 * MiB;
constexpr size_t WS_Q = WS_BIG, WS_K = WS_BIG + 32 * MiB, WS_V = WS_BIG + 64 * MiB;
constexpr size_t WS_Y2 = WS_BIG, WS_H = WS_BIG + 64 * MiB;
constexpr size_t WS_SLOC = WS_BIG, WS_G = WS_BIG + 32 * MiB;

__device__ __forceinline__ bf16 f2bf(float f) { unsigned u = __float_as_uint(f); return (bf16)((u + 0x7fffu + ((u >> 16) & 1u)) >> 16); }
__device__ __forceinline__ float bf2f(bf16 h) { return __uint_as_float(((unsigned)h) << 16); }
__device__ __forceinline__ float wave_sum(float v) {
#pragma unroll
    for (int o = 1; o < 64; o <<= 1) v += __shfl_xor(v, o);
    return v;
}
__device__ __forceinline__ float gelu_tanh(float x) { const float u = 0.7978845608028654f * (x + 0.044715f * x * x * x); return 0.5f * x * (1.f + tanhf(u)); }

__device__ __forceinline__ size_t xng_off(int t, int col) { const int b = t >> 13, tt = t & 8191, s = tt >> 4, j = tt & 15, g = col >> 4, c = col & 15; return ((size_t)(g * 1024 + b * 512 + s)) * 384 + j * 16 + c; }

#define LAS __attribute__((address_space(3)))
typedef short bf16x8 __attribute__((ext_vector_type(8)));
typedef short s16x4 __attribute__((ext_vector_type(4)));
typedef float f32x4 __attribute__((ext_vector_type(4)));
typedef float f32x16 __attribute__((ext_vector_type(16)));
typedef unsigned u32x4 __attribute__((ext_vector_type(4)));
typedef unsigned u32x2 __attribute__((ext_vector_type(2)));

constexpr int NWAVES = 8, NTHR = 512;
constexpr int CAP = 16384;
constexpr size_t CTL_ZERO_BYTES = 1 * MiB;
constexpr size_t WS_PDST = 1 * MiB, WS_PW = 3 * MiB, WS_PS = 5 * MiB, WS_SROW = 7 * MiB, WS_A16 = 7 * MiB + 65536;
constexpr size_t WS_TS = 7 * MiB + 131072;
constexpr size_t WS_RWT = 8 * MiB;
constexpr size_t WS_WQKV = 9 * MiB, WS_WO = 15 * MiB, WS_WOUT = 17 * MiB, WS_SSM = 21 * MiB;
constexpr size_t WS_WGU = 38 * MiB, WS_WD = 70 * MiB;
constexpr size_t WS_END = 230 * MiB;
constexpr int RW_PITCH = 1032, RW_PLANE = 36 * RW_PITCH, RW_LAYER_BYTES = 2 * RW_PLANE * 2;
constexpr int SSM_G_BYTES = 262144, SSM_A2_OFF = 65536;
constexpr int CW_BAR = 4096;
constexpr int CW_CARRYF = 131072;
constexpr int CW_CARRY = 147456;
constexpr int CW_CNT = 65536;
constexpr int LDS_BYTES = 160 * 1024, MISC_OFF = LDS_BYTES - 512, AUX_OFF = 128 * 1024, RSCR_OFF = RW_LAYER_BYTES;
constexpr int N_PHASES = 16;

__device__ __forceinline__ int lane_now() { int l; asm volatile("v_mbcnt_lo_u32_b32 %0, -1, 0\n\tv_mbcnt_hi_u32_b32 %0, -1, %0" : "=v"(l)); return l; }
__device__ __forceinline__ unsigned cvt_pk_bf16(float lo, float hi) { unsigned r; asm volatile("v_cvt_pk_bf16_f32 %0, %1, %2" : "=v"(r) : "v"(lo), "v"(hi)); return r; }
typedef float f32x2_t __attribute__((ext_vector_type(2))); typedef __bf16 bf16x2_t __attribute__((ext_vector_type(2)));
__device__ __forceinline__ unsigned cvtpk_s(float lo, float hi) { f32x2_t v = {lo, hi}; bf16x2_t b = __builtin_convertvector(v, bf16x2_t); return __builtin_bit_cast(unsigned, b); }
__device__ __forceinline__ unsigned pk2(float lo, float hi) { return cvtpk_s(lo, hi); }
#define LDS_WAIT() asm volatile("s_waitcnt lgkmcnt(0)" ::: "memory")
#define VM_WAIT() asm volatile("s_waitcnt vmcnt(0)" ::: "memory")
#define RLX_AGENT __ATOMIC_RELAXED, __HIP_MEMORY_SCOPE_AGENT

#define XB_TMO      128
#define XB_XCNT(j)  (256  + 64 * (j))
#define XB_XSUB(j)  (1280 + 64 * (j))
#define XB_XGEN(j)  (2304 + 64 * (j))
#define XB_TOP      3328
#define XB_TOPGEN   3392
#define XCD_BAR_WORDS 3456
#define XB_SPIN_CAP (1u << 18)
__device__ __forceinline__ unsigned xb_ld(unsigned* p)              { return __hip_atomic_load(p, __ATOMIC_RELAXED, __HIP_MEMORY_SCOPE_AGENT); }
__device__ __forceinline__ unsigned xb_add(unsigned* p, unsigned v) { return __hip_atomic_fetch_add(p, v, __ATOMIC_RELAXED, __HIP_MEMORY_SCOPE_AGENT); }
__device__ __forceinline__ int   ag_ld(const int* p)   { return (int)__hip_atomic_load((const unsigned*)p, __ATOMIC_RELAXED, __HIP_MEMORY_SCOPE_AGENT); }
__device__ __forceinline__ float ag_ld(const float* p) { return __uint_as_float(__hip_atomic_load((const unsigned*)p, __ATOMIC_RELAXED, __HIP_MEMORY_SCOPE_AGENT)); }
__device__ __forceinline__ void  ag_st(int* p, int v)     { __hip_atomic_store((unsigned*)p, (unsigned)v, __ATOMIC_RELAXED, __HIP_MEMORY_SCOPE_AGENT); }
__device__ __forceinline__ void  ag_st(float* p, float v) { __hip_atomic_store((unsigned*)p, __float_as_uint(v), __ATOMIC_RELAXED, __HIP_MEMORY_SCOPE_AGENT); }
__device__ __forceinline__ unsigned xb_xcc_id() { return (unsigned)__builtin_amdgcn_s_getreg((3 << 11) | 20) & 0xFu; }
#define XB_SPIN(cond, bar) do { unsigned _sp = 0; while (cond) { __builtin_amdgcn_s_sleep(1); \
    if ((++_sp & 255u) == 0u) { if (xb_ld(&(bar)[XB_TMO])) break; if (_sp > XB_SPIN_CAP) { atomicAdd(&(bar)[XB_TMO], 1u); break; } } } } while (0)
struct XcdBarrier { unsigned* bar; unsigned x; volatile LAS unsigned* st; };
__device__ __forceinline__ XcdBarrier xcd_barrier_post(unsigned* bar, volatile LAS unsigned* st, int wid) {
    XcdBarrier b; b.bar = bar; b.x = xb_xcc_id(); b.st = st;
    if (wid == 0 && lane_now() == 0) (void)xb_add(&bar[XB_XCNT(b.x)], 1u);
    return b;
}
__device__ __forceinline__ void xcd_barrier_complete(unsigned* bar, unsigned x, unsigned& nloc, unsigned& nx) {
    const unsigned G = gridDim.x * gridDim.y * gridDim.z;
    unsigned sum, cnt, mine, sp = 0u;
    for (;;) {
        sum = 0u; cnt = 0u; mine = 0u;
#pragma unroll
        for (unsigned j = 0; j < 16; ++j) { const unsigned c = xb_ld(&bar[XB_XCNT(j)]); sum += c; cnt += (c > 0u) ? 1u : 0u; mine = (j == x) ? c : mine; }
        if (sum == G) break;
        __builtin_amdgcn_s_sleep(1);
        if ((++sp & 255u) == 0u) { if (xb_ld(&bar[XB_TMO])) break; if (sp > XB_SPIN_CAP) { atomicAdd(&bar[XB_TMO], 1u); break; } }
    }
    nloc = mine > 0u ? mine : 1u; nx = cnt > 0u ? cnt : 1u;
}
__device__ __forceinline__ void xcd_barrier(const XcdBarrier& b, int wid) {
    asm volatile("s_waitcnt vmcnt(0)" ::: "memory");
    __syncthreads();
    if (wid == 0 && lane_now() == 0) {
        unsigned* bar = b.bar;
        __builtin_amdgcn_s_waitcnt(0);
        unsigned nloc = b.st[0], nx = b.st[1];
        if (nloc == 0u) { xcd_barrier_complete(bar, b.x, nloc, nx); b.st[0] = nloc; b.st[1] = nx; }
        const unsigned old = xb_add(&bar[XB_XSUB(b.x)], 1u);
        const unsigned gen = old / nloc;
        if (old + 1u == (gen + 1u) * nloc) {
            __builtin_amdgcn_fence(__ATOMIC_RELEASE, "agent");
            asm volatile("s_waitcnt vmcnt(0)" ::: "memory");
            (void)xb_add(&bar[XB_TOP], 1u);
        }
        XB_SPIN(xb_ld(&bar[XB_TOP]) < (gen + 1u) * nx, bar);
        __builtin_amdgcn_fence(__ATOMIC_ACQUIRE, "agent");
        asm volatile("s_waitcnt vmcnt(0)" ::: "memory");
    }
    __syncthreads();
}

__device__ __forceinline__ void xcd_arrive(const XcdBarrier& b, int wid, bool light = false) {
    asm volatile("s_waitcnt vmcnt(0)" ::: "memory");
    __syncthreads();
    if (wid == 0 && lane_now() == 0) {
        unsigned* bar = b.bar;
        __builtin_amdgcn_s_waitcnt(0);
        unsigned nloc = b.st[0], nx = b.st[1];
        if (nloc == 0u) { xcd_barrier_complete(bar, b.x, nloc, nx); b.st[0] = nloc; b.st[1] = nx; }
        const unsigned old = xb_add(&bar[XB_XSUB(b.x)], 1u);
        const unsigned gen = old / nloc;
        if (old + 1u == (gen + 1u) * nloc) {
            if (!light) { __builtin_amdgcn_fence(__ATOMIC_RELEASE, "agent"); asm volatile("s_waitcnt vmcnt(0)" ::: "memory"); }
            (void)xb_add(&bar[XB_TOP], 1u);
            b.st[3] = 1u;
        } else if (light) { b.st[3] = 0u; } else {
            b.st[3] = 0u;
            asm volatile("buffer_inv sc1" ::: "memory");
        }
        b.st[2] = (gen + 1u) * nx; b.st[4] = gen;
    }
}
__device__ __forceinline__ void xcd_wait(const XcdBarrier& b, int wid, bool light = false) {
    if (wid == 0 && lane_now() == 0) {
        unsigned* bar = b.bar; const unsigned target = b.st[2];
        if (b.st[3]) {
            XB_SPIN(xb_ld(&bar[XB_TOP]) < target, bar);
            if (!light) { __builtin_amdgcn_fence(__ATOMIC_ACQUIRE, "agent"); asm volatile("s_waitcnt vmcnt(0)" ::: "memory"); }
            (void)xb_add(&bar[XB_XGEN(b.x)], 1u);
        } else {
            const unsigned gen = b.st[4];
            XB_SPIN(xb_ld(&bar[XB_XGEN(b.x)]) <= gen, bar);
            asm volatile("s_waitcnt vmcnt(0)" ::: "memory");
        }
    }
    __syncthreads();
}

namespace gm {
constexpr int HTB = 16384;
__device__ __forceinline__ int lds_byte(int r, int c) { const int st = (r >> 4) * 2 + (c >> 5), rr = r & 15, cc = c & 31, ob = rr * 64 + cc * 2; return st * 1024 + (ob ^ (((ob >> 9) & 1) << 5)); }
__device__ __forceinline__ void stage_rc(int b, int& R, int& C) { const int st = b / 1024, sb = b % 1024, swz = sb ^ (((sb >> 9) & 1) << 5); R = (st >> 1) * 16 + swz / 64; C = (st & 1) * 32 + (swz % 64) / 2; }
__device__ __forceinline__ int perm32(int rho) { const int n = rho >> 4, i = rho & 15; return 8 * (i >> 2) + 4 * n + (i & 3); }
struct Unit { int pm, pn, e, gt, cnt; };
__device__ __forceinline__ bool static_unit(int i, int G, int c, int nM, int nN, Unit& u) {
    const int nwg = nM * nN; const long L = (long)i * G + c; if (L >= nwg) return false;
    int wgid = (int)L; { const int q = nwg / 8, r = nwg % 8, xcd = wgid % 8, off = wgid / 8; wgid = (xcd < r ? xcd * (q + 1) : r * (q + 1) + (xcd - r) * q) + off; }
    const int nig = 8 * nN, gid = wgid / nig, fm = gid * 8, gsz = (nM - fm) < 8 ? (nM - fm) : 8;
    u.pm = fm + ((wgid % nig) % gsz); u.pn = (wgid % nig) / gsz; u.e = 0; u.gt = 0; u.cnt = 0; return true;
}
template <class P> __device__ __forceinline__ void gemm_phase(LAS unsigned char* lds, const P& ph, int wid) {
    const int lane = lane_now(), tid = wid * 64 + lane, wr = wid >> 2, wc = wid & 3, fr = lane & 15, fq = lane >> 4;
    constexpr int nt = P::K / 64;
    static_assert(nt >= 2 && (nt % 2) == 0, "K must be a multiple of 128");
    unsigned voffA[2], voffB[2];
#pragma unroll
    for (int i = 0; i < 2; ++i) { int R, C; stage_rc(tid * 16 + i * 8192, R, C); const int Rb = (R & ~31) + perm32(R & 31); voffB[i] = (unsigned)(Rb * P::LDB + C) * 2u; voffA[i] = (unsigned)(R * P::LDA + C) * 2u; }
    const unsigned ldsw = (unsigned)wid * 1024u;
    const int aoff = lds_byte(wr * 64 + fr, fq * 8), boff = lds_byte(wc * 32 + fr, fq * 8);
    constexpr int hB = P::HSTEPB, hA = 128 * P::LDA * 2;
#define G_SA(b, h) (((b) * 2 + (h)) * gm::HTB)
#define G_SB(b, h) ((4 + (b) * 2 + (h)) * gm::HTB)
#define G_GLDS(src, bufoff, i) __builtin_amdgcn_global_load_lds((const unsigned*)(src), (LAS unsigned*)(lds + (bufoff) + ldsw + (i) * 8192), 16, 0, 0)
#define G_STA(bufoff, ptr, kb, offs, h) do { if constexpr (P::GATHER) { _Pragma("unroll") for (int _i = 0; _i < 2; ++_i) G_GLDS(Ab + (size_t)(kb) * P::KMUL + (offs)[h][_i], bufoff, _i); } \
        else { _Pragma("unroll") for (int _i = 0; _i < 2; ++_i) G_GLDS((ptr) + (h) * hA + voffA[_i], bufoff, _i); } } while (0)
#define G_STB(bufoff, ptr) do { _Pragma("unroll") for (int _i = 0; _i < 2; ++_i) G_GLDS((ptr) + voffB[_i], bufoff, _i); } while (0)
#define G_LDA(dst, b, h) do { _Pragma("unroll") for (int m = 0; m < 4; ++m) _Pragma("unroll") for (int k = 0; k < 2; ++k) dst[m][k] = *(const LAS bf16x8*)(lds + G_SA(b, h) + aoff + m * 2048 + k * 1024); } while (0)
#define G_LDB(dst, b, h) do { _Pragma("unroll") for (int n = 0; n < 2; ++n) _Pragma("unroll") for (int k = 0; k < 2; ++k) dst[n][k] = *(const LAS bf16x8*)(lds + G_SB(b, h) + boff + n * 2048 + k * 1024); } while (0)
#define G_MMA(ai, bj, At, Bt) do { __builtin_amdgcn_s_setprio(1); _Pragma("unroll") for (int m = 0; m < 4; ++m) _Pragma("unroll") for (int n = 0; n < 2; ++n) _Pragma("unroll") for (int k = 0; k < 2; ++k) \
        acc[ai][bj][m][n] = __builtin_amdgcn_mfma_f32_16x16x32_bf16(Bt[n][k], At[m][k], acc[ai][bj][m][n], 0, 0, 0); __builtin_amdgcn_s_setprio(0); } while (0)
#define G_WAIT_V(n) asm volatile("s_waitcnt vmcnt(" #n ")" ::: "memory")
#define G_WAIT_L(n) asm volatile("s_waitcnt lgkmcnt(" #n ")" ::: "memory")
#define G_BAR __builtin_amdgcn_s_barrier()
#define G_SCHED __builtin_amdgcn_sched_barrier(0)
    Unit cur, nxt; int ui = 0;
    if (!ph.next(0, cur)) return;
    f32x4 acc[2][2][4][2];
#pragma unroll
    for (int a = 0; a < 2; ++a)
#pragma unroll
        for (int b = 0; b < 2; ++b)
#pragma unroll
            for (int m = 0; m < 4; ++m)
#pragma unroll
                for (int n = 0; n < 2; ++n) acc[a][b][m][n] = (f32x4){0.f, 0.f, 0.f, 0.f};
    bf16x8 At[4][2], B0[2][2], B1[2][2];
    unsigned co[2][2] = {{0u, 0u}, {0u, 0u}};
    const char* Ab = ph.Abase;
    const char* cA = Ab; const char* cB = ph.b_tile(cur);
    if constexpr (P::GATHER) { ph.a_offs(cur, tid, co); asm volatile("s_waitcnt vmcnt(0)" ::: "memory"); } else cA = ph.a_tile(cur);
    G_STB(G_SB(0, 0), cB); G_STB(G_SB(0, 1), cB + hB); G_STA(G_SA(0, 0), cA, 0, co, 0); G_STA(G_SA(0, 1), cA, 0, co, 1);
    if (wr == 1) G_BAR;
    G_WAIT_V(2); G_BAR;
    G_STB(G_SB(1, 0), cB + 128); G_STA(G_SA(1, 0), cA + 128, 128, co, 0); G_STB(G_SB(1, 1), cB + hB + 128);
    G_WAIT_V(6); G_BAR;
    for (;;) {
        const bool has_next = ph.next(ui + 1, nxt);
        const char* nA = cA; const char* nB = cB;
        if (has_next) { nB = ph.b_tile(nxt); if constexpr (!P::GATHER) nA = ph.a_tile(nxt); }
        for (int t = 0; t < nt; t += 2) {
            const bool last = (t == nt - 2);
            const int kb1 = (t + 1) * 128, kb2 = last ? 0 : (t + 2) * 128, kb3 = kb2 + 128;
            const char* a1 = cA + kb1; const char* a2 = last ? nA : cA + kb2; const char* a3 = a2 + 128;
            const char* b2 = last ? nB : cB + (t + 2) * 128; const char* b3 = b2 + 128;
            G_LDB(B0, 0, 0); G_LDB(B1, 0, 1); G_SCHED; G_LDA(At, 0, 0); G_STA(G_SA(1, 1), a1, kb1, co, 1);
            G_WAIT_V(8); G_WAIT_L(0); G_BAR; G_MMA(0, 0, At, B0); G_MMA(0, 1, At, B1); G_BAR; G_SCHED;
            if constexpr (P::GATHER) { if (last && has_next) ph.a_offs(nxt, tid, co); }
            G_LDA(At, 0, 1); G_STB(G_SB(0, 0), b2); G_STB(G_SB(0, 1), b2 + hB); G_STA(G_SA(0, 0), a2, kb2, co, 0);
            G_WAIT_V(8); G_WAIT_L(0); G_BAR; G_MMA(1, 0, At, B0); G_MMA(1, 1, At, B1); G_BAR; G_SCHED;
            G_LDB(B0, 1, 0); G_LDB(B1, 1, 1); G_SCHED; G_LDA(At, 1, 0); G_STA(G_SA(0, 1), a2, kb2, co, 1);
            G_WAIT_V(8); G_WAIT_L(0); G_BAR; G_MMA(0, 0, At, B0); G_MMA(0, 1, At, B1); G_BAR; G_SCHED;
            G_LDA(At, 1, 1); G_STB(G_SB(1, 0), b3); G_STB(G_SB(1, 1), b3 + hB); G_STA(G_SA(1, 0), a3, kb3, co, 0);
            G_WAIT_V(8); G_WAIT_L(0); G_BAR; G_MMA(1, 0, At, B0); G_MMA(1, 1, At, B1); G_BAR; G_SCHED;
        }
        if (wr == 0) G_BAR;
        ph.epi(acc, cur, wr, wc, fr, fq);
        if (!has_next) break;
#pragma unroll
        for (int a = 0; a < 2; ++a)
#pragma unroll
            for (int b = 0; b < 2; ++b)
#pragma unroll
                for (int m = 0; m < 4; ++m)
#pragma unroll
                    for (int n = 0; n < 2; ++n) acc[a][b][m][n] = (f32x4){0.f, 0.f, 0.f, 0.f};
        cur = nxt; cA = nA; cB = nB; ++ui;
        if (wr == 1) G_BAR;
    }
    G_WAIT_V(0);
    G_BAR;
}
}

using gm::Unit;
#define EPI_ARGS const f32x4 (&acc)[2][2][4][2], const Unit& u, int wr, int wc, int fr_in, int fq_in
#define EPI_OPAQUE int fr = fr_in, fq = fq_in; asm volatile("" : "+v"(fr), "+v"(fq));
#define NO_GATHER __device__ __forceinline__ void a_offs(const Unit&, int, unsigned (&)[2][2]) const {}
#define EPI_FENCE() asm volatile("" ::: "memory")
__device__ __forceinline__ u32x4 pack8(const f32x4& v0, const f32x4& v1) { u32x4 w; w.x = cvt_pk_bf16(v0[0], v0[1]); w.y = cvt_pk_bf16(v0[2], v0[3]); w.z = cvt_pk_bf16(v1[0], v1[1]); w.w = cvt_pk_bf16(v1[2], v1[3]); return w; }
__device__ __forceinline__ float fast_sigmoid(float v) { return __builtin_amdgcn_rcpf(1.f + __builtin_amdgcn_exp2f(-LOG2E * v)); }
__device__ __forceinline__ float fast_gelu(float v) { const float u2 = 1.5957691216057308f * (v + 0.044715f * v * v * v); return v * fast_sigmoid(u2); }

struct PhQKV {
    static constexpr bool GATHER = false; static constexpr int LDA = 1024, K = 1024, LDB = 1024, HSTEPB = 128 * 1024 * 2;
    unsigned char* ws; const char* Abase; int G, c;
    __device__ __forceinline__ bool next(int i, Unit& u) const { return gm::static_unit(i, G, c, M / 256, 12, u); }
    NO_GATHER __device__ __forceinline__ const char* a_tile(const Unit& u) const { return Abase + (size_t)(u.pm * 256) * 1024 * 2; }
    __device__ __forceinline__ const char* b_tile(const Unit& u) const { return (const char*)(ws + WS_WQKV) + (size_t)u.pn * 256 * 1024 * 2; }
    __device__ __forceinline__ void epi(EPI_ARGS) const { EPI_OPAQUE
        const int row0 = u.pm * 256 + wr * 64 + fr; const int t = u.pn >> 2; const int colt = (u.pn & 3) * 256;
        bf16* base = (bf16*)(ws + WS_Q) + (size_t)t * (16u * 1024u * 1024u); const float sc = (t == 0) ? C2 : 1.f;
        const int col0 = colt + wc * 32 + 8 * fq;
#pragma unroll
        for (int ai = 0; ai < 2; ++ai)
#pragma unroll
            for (int m = 0; m < 4; ++m) { bf16* rowp = base + (size_t)(row0 + ai * 128 + m * 16) * 1024 + col0;
#pragma unroll
                for (int bj = 0; bj < 2; ++bj) *(u32x4*)(rowp + bj * 128) = pack8(acc[ai][bj][m][0] * sc, acc[ai][bj][m][1] * sc); }
    }
};
struct PhWo {
    static constexpr bool GATHER = false; static constexpr int LDA = 1024, K = 1024, LDB = 1024, HSTEPB = 128 * 1024 * 2;
    unsigned char* ws; const char* Abase; const float* resid; float* out; int G, c;
    __device__ __forceinline__ bool next(int i, Unit& u) const { return gm::static_unit(i, G, c, M / 256, 4, u); }
    NO_GATHER __device__ __forceinline__ const char* a_tile(const Unit& u) const { return Abase + (size_t)(u.pm * 256) * 1024 * 2; }
    __device__ __forceinline__ const char* b_tile(const Unit& u) const { return (const char*)(ws + WS_WO) + (size_t)u.pn * 256 * 1024 * 2; }
    __device__ __forceinline__ void epi(EPI_ARGS) const { EPI_OPAQUE
        const size_t off0 = (size_t)(u.pm * 256 + wr * 64 + fr) * 1024 + u.pn * 256 + wc * 32 + 8 * fq; bf16* hb = (bf16*)out;
#pragma unroll
        for (int ai = 0; ai < 2; ++ai) { f32x4 r[4][2][2];
#pragma unroll
            for (int m = 0; m < 4; ++m)
#pragma unroll
                for (int bj = 0; bj < 2; ++bj) { const float* p = resid + off0 + (size_t)(ai * 128 + m * 16) * 1024 + bj * 128; r[m][bj][0] = __builtin_nontemporal_load((const f32x4*)p); r[m][bj][1] = __builtin_nontemporal_load((const f32x4*)(p + 4)); }
            EPI_FENCE();
#pragma unroll
            for (int m = 0; m < 4; ++m)
#pragma unroll
                for (int bj = 0; bj < 2; ++bj) { const size_t off = off0 + (size_t)(ai * 128 + m * 16) * 1024 + bj * 128; const f32x4 v0 = acc[ai][bj][m][0] + r[m][bj][0], v1 = acc[ai][bj][m][1] + r[m][bj][1];
                    *(u32x4*)(hb + off) = pack8(v0, v1); }
            EPI_FENCE(); }
    }
};
constexpr int GPLANE = M * 32;
struct PhWout {
    static constexpr bool GATHER = true; static constexpr int KMUL = 4 * GPLANE / 128; static constexpr int LDA = 1024, K = 1024, LDB = 1024, HSTEPB = 128 * 1024 * 2;
    unsigned char* ws; const char* Abase; float* out; int G, c;
    __device__ __forceinline__ bool next(int i, Unit& u) const { return gm::static_unit(i, G, c, M / 256, 8, u); }
    __device__ __forceinline__ void a_offs(const Unit& u, int tid, unsigned (&o)[2][2]) const {
#pragma unroll
        for (int i = 0; i < 2; ++i) { int R, C; gm::stage_rc(tid * 16 + i * 8192, R, C);
#pragma unroll
            for (int h = 0; h < 2; ++h) o[h][i] = (unsigned)((C >> 4) * GPLANE + (u.pm * 256 + 128 * h + R) * 32 + ((C >> 3) & 1) * 16); } }
    __device__ __forceinline__ const char* a_tile(const Unit&) const { return Abase; }
    __device__ __forceinline__ const char* b_tile(const Unit& u) const { return (const char*)(ws + WS_WOUT) + (size_t)u.pn * 256 * 1024 * 2; }
    __device__ __forceinline__ void epi(EPI_ARGS) const { EPI_OPAQUE
        const size_t off0 = (size_t)(u.pm * 256 + wr * 64 + fr) * 1024 + u.pn * 128 + wc * 32 + 8 * fq; bf16* hb = (bf16*)(ws + WS_XN); const bf16* rs = (const bf16*)out + (size_t)M * D;
        u32x4 r[2][4];
#pragma unroll
        for (int ai = 0; ai < 2; ++ai)
#pragma unroll
            for (int m = 0; m < 4; ++m) r[ai][m] = __builtin_nontemporal_load((const u32x4*)(rs + off0 + (size_t)(ai * 128 + m * 16) * 1024));
        EPI_FENCE();
#pragma unroll
        for (int ai = 0; ai < 2; ++ai)
#pragma unroll
            for (int m = 0; m < 4; ++m) { const size_t off = off0 + (size_t)(ai * 128 + m * 16) * 1024; f32x4 v0, v1;
#pragma unroll
                for (int j = 0; j < 4; ++j) { const unsigned w0 = r[ai][m][j >> 1], w1 = r[ai][m][2 + (j >> 1)];
                    const float r0 = __uint_as_float((j & 1) ? (w0 & 0xffff0000u) : (w0 << 16)), r1 = __uint_as_float((j & 1) ? (w1 & 0xffff0000u) : (w1 << 16));
                    v0[j] = r0 + acc[ai][0][m][0][j] * fast_sigmoid(acc[ai][1][m][0][j]); v1[j] = r1 + acc[ai][0][m][1][j] * fast_sigmoid(acc[ai][1][m][1][j]); }
                *(u32x4*)(hb + off) = pack8(v0, v1); }
        EPI_FENCE();
    }
};
constexpr int MT_NN = 65, MT_NS = 66, MT_NLIST = 128, MT_SLIST = 384, MT_NJ = 67, MT_JP = 512, SMALL_ROWS = 128, MT_OFF = AUX_OFF + 2048;
#ifndef TILE_BUDGET
#define TILE_BUDGET 128
#endif
__device__ __forceinline__ void moe_decode(LAS unsigned char* lds, int code, Unit& u) { const LAS int* cn = (const LAS int*)(lds + MT_OFF); u.e = code >> 8; u.pm = code & 63; u.gt = __builtin_amdgcn_readfirstlane(cn[32 + u.e]) + u.pm; u.cnt = __builtin_amdgcn_readfirstlane(cn[u.e]); }
__device__ __forceinline__ void moe_tables(LAS unsigned char* lds, const unsigned* cntg, int tid) {
    LAS int* cn = (LAS int*)(lds + MT_OFF); LAS int* tb = cn + 32;
    if (tid < 64) {
        const int e = tid & 31; const unsigned cu = __hip_atomic_load(cntg + e * 64, RLX_AGENT); const int c = cu < (unsigned)CAP ? (int)cu : CAP;
        const int n = (c + 255) >> 8, full = c >> 8, rem = c & 255;
        int sfull = full;
#pragma unroll
        for (int o = 1; o < 32; o <<= 1) sfull += __shfl_xor(sfull, o, 32);
        const int budget = TILE_BUDGET - sfull; int rank = 0;
#pragma unroll 8
        for (int o = 0; o < 32; ++o) { const int r = __shfl(rem, o, 32); rank += (r > rem || (r == rem && o < e)) ? 1 : 0; }
        const bool prom = rem > 0 && rank < budget;
        const int nnorm = full + (prom ? 1 : 0), small = prom ? 0 : (rem > SMALL_ROWS ? 2 : (rem > 0 ? 1 : 0));
        const int rows0 = rem > 128 ? 128 : rem, rows1 = rem - 128; const int sh0 = (small >= 1 && rows0 <= 64) ? 1 : 0, sh1 = (small == 2 && rows1 <= 64) ? 1 : 0;
        const int j0 = small >= 1 ? (sh0 ? 8 : 16) : 0, j1 = small == 2 ? (sh1 ? 8 : 16) : 0;
        int pt = n, pn_ = nnorm, ps_ = small, pj_ = j0 + j1;
#pragma unroll
        for (int o = 1; o < 32; o <<= 1) { const int a = __shfl_up(pt, o, 32), b = __shfl_up(pn_, o, 32), d = __shfl_up(ps_, o, 32), f = __shfl_up(pj_, o, 32); if (e >= o) { pt += a; pn_ += b; ps_ += d; pj_ += f; } }
        if (tid < 32) { cn[e] = c; tb[e] = pt - n;
            for (int pm = 0; pm < nnorm; ++pm) cn[MT_NLIST + (pn_ - nnorm) + pm] = (e << 8) | pm;
            if (small >= 1) { cn[MT_SLIST + (ps_ - small)] = (e << 8) | (sh0 << 6) | (n - 1); cn[MT_JP + (ps_ - small)] = pj_ - j0 - j1; }
            if (small == 2) { cn[MT_SLIST + (ps_ - small) + 1] = (e << 8) | (1 << 7) | (sh1 << 6) | (n - 1); cn[MT_JP + (ps_ - small) + 1] = pj_ - j1; }
            if (e == 31) { tb[32] = pt; cn[MT_NN] = pn_; cn[MT_NS] = ps_; cn[MT_NJ] = pj_; cn[MT_JP + ps_] = pj_; } }
    }
    __syncthreads();
}
template <bool GU> __device__ __forceinline__ void tail_job(unsigned char* ws, const bf16* __restrict__ Xbase, const Unit& u, int sub, int wid, LAS unsigned char* lds, bool dual) {
    const int lane = lane_now(), fr = lane & 15, fq = lane >> 4, w = dual ? (wid & 3) : wid, img = dual ? (wid >> 2) : 0, ns = dual ? 2 * sub + img : sub, tid_ = wid * 64 + lane;
    constexpr int K = GU ? 1024 : 256, NG = GU ? 2 : 4;
    constexpr int PITCH = K * 2 + 16;
    constexpr int CH = K / 8, NCH = 16 * NG * CH / NTHR;
    constexpr int NKS = K / 32, NPRE = NKS < 16 ? NKS : 16;
    constexpr int IMG = 16 * NG * PITCH;
    const int slot0 = u.pm * 256 + u.pn * 128, rows = u.cnt - slot0;
    const bool active = 16 * w < rows;
    int r = 16 * w + fr; const bool valid = r < rows; r = valid ? r : rows - 1; r = r < 0 ? 0 : r;
    const int dst = active ? ag_ld((const int*)(ws + WS_PDST) + u.e * CAP + slot0 + r) : 0;
    u32x4 st[2][NCH]; const int nsA = dual ? 2 * sub : sub;
#pragma unroll
    for (int im = 0; im < 2; ++im) if (im == 0 || dual) {
#pragma unroll
        for (int i = 0; i < NCH; ++i) { const int ci = tid_ + i * NTHR, row = ci / CH, ch = ci % CH, nsx = nsA + im;
            const bf16* src = GU ? (const bf16*)(ws + WS_WGU) + ((size_t)u.e * 512 + 256 * (nsx >> 3) + 128 * (row >> 4) + 16 * (nsx & 7) + (row & 15)) * 1024 + ch * 8
                                 : (const bf16*)(ws + WS_WD) + ((size_t)u.e * 1024 + 64 * nsx + row) * 256 + ch * 8;
            st[im][i] = *(const u32x4*)src; } }
    const bf16* xp = (GU ? Xbase + (size_t)(dst >> 1) * 1024 : Xbase + ((size_t)u.gt * 256 + u.pn * 128 + r) * 256) + 8 * fq;
    bf16x8 xa[NPRE];
    if (active) {
#pragma unroll
        for (int ks = 0; ks < NPRE; ++ks) xa[ks] = *(const bf16x8*)(xp + 32 * ks); }
    __syncthreads();
#pragma unroll
    for (int im = 0; im < 2; ++im) if (im == 0 || dual) {
#pragma unroll
        for (int i = 0; i < NCH; ++i) { const int ci = tid_ + i * NTHR, row = ci / CH, ch = ci % CH; *(LAS u32x4*)(lds + im * IMG + row * PITCH + ch * 16) = st[im][i]; } }
    __syncthreads();
    if (!active) return;
    const LAS unsigned char* wl = lds + img * IMG + fr * PITCH + fq * 16;
    f32x4 acc[NG];
#pragma unroll
    for (int n = 0; n < NG; ++n) acc[n] = (f32x4){0.f, 0.f, 0.f, 0.f};
    bf16x8 xb[NKS - NPRE > 0 ? NKS - NPRE : 1];
    if (NKS > NPRE) {
#pragma unroll
        for (int ks = NPRE; ks < NKS; ++ks) xb[ks - NPRE] = *(const bf16x8*)(xp + 32 * ks); }
#pragma unroll
    for (int ks = 0; ks < NKS; ++ks) { const bf16x8 xf = ks < NPRE ? xa[ks < NPRE ? ks : 0] : xb[ks >= NPRE ? ks - NPRE : 0]; bf16x8 wf[NG];
#pragma unroll
        for (int n = 0; n < NG; ++n) wf[n] = *(const LAS bf16x8*)(wl + n * 16 * PITCH + ks * 64);
#pragma unroll
        for (int n = 0; n < NG; ++n) acc[n] = __builtin_amdgcn_mfma_f32_16x16x32_bf16(wf[n], xf, acc[n], 0, 0, 0); }
    if (valid) {
        if (GU) { const float sc = ag_ld((const float*)(ws + WS_PS) + u.e * CAP + slot0 + r); float v[4];
#pragma unroll
            for (int j = 0; j < 4; ++j) { const float gg = acc[0][j] * sc, uu = acc[NG - 1][j] * sc; v[j] = gg * fast_sigmoid(gg) * uu; }
            u32x2 o; o.x = cvt_pk_bf16(v[0], v[1]); o.y = cvt_pk_bf16(v[2], v[3]);
            *(u32x2*)((bf16*)(ws + WS_H) + ((size_t)u.gt * 256 + u.pn * 128 + r) * 256 + 16 * ns + 4 * fq) = o; }
        else { const float wt = ag_ld((const float*)(ws + WS_PW) + u.e * CAP + slot0 + r);
#pragma unroll
            for (int n = 0; n < NG; ++n) { u32x2 o; o.x = cvt_pk_bf16(acc[n][0] * wt, acc[n][1] * wt); o.y = cvt_pk_bf16(acc[n][2] * wt, acc[n][3] * wt);
                *(u32x2*)((bf16*)(ws + WS_Y2) + (size_t)dst * 1024 + 64 * ns + 16 * n + 4 * fq) = o; } } }
}
struct PhGateUp {
    static constexpr bool GATHER = true; static constexpr int KMUL = 1; static constexpr int LDA = 1024, K = 1024, LDB = 1024, HSTEPB = 128 * 1024 * 2;
    unsigned char* ws; const char* Abase; LAS unsigned char* lds; int G, c, nn;
    __device__ __forceinline__ bool next(int i, Unit& u) const { const int idx = i * G + c; if (idx >= 2 * nn) return false; u.pn = idx & 1; moe_decode(lds, ((const LAS int*)(lds + MT_OFF))[MT_NLIST + (idx >> 1)], u); return true; }
    __device__ __forceinline__ void a_offs(const Unit& u, int tid, unsigned (&o)[2][2]) const { const int* pdst = (const int*)(ws + WS_PDST);
#pragma unroll
        for (int i = 0; i < 2; ++i) { int R, C; gm::stage_rc(tid * 16 + i * 8192, R, C);
#pragma unroll
            for (int h = 0; h < 2; ++h) { int slot = u.pm * 256 + 128 * h + R; slot = slot < u.cnt ? slot : u.cnt - 1; const int tok = ag_ld(&pdst[u.e * CAP + slot]) >> 1; o[h][i] = (unsigned)(tok * 1024 + C) * 2u; } }
    }
    __device__ __forceinline__ const char* a_tile(const Unit&) const { return Abase; }
    __device__ __forceinline__ const char* b_tile(const Unit& u) const { return (const char*)(ws + WS_WGU) + ((size_t)u.e * 512 + u.pn * 256) * 1024 * 2; }
    __device__ __forceinline__ void epi(EPI_ARGS) const { EPI_OPAQUE
        const int r0 = wr * 64 + fr, col0 = u.pn * 128 + wc * 32 + 8 * fq; const float* ps = (const float*)(ws + WS_PS) + u.e * CAP; bf16* H = (bf16*)(ws + WS_H);
        float sv[2][4];
#pragma unroll
        for (int ai = 0; ai < 2; ++ai)
#pragma unroll
            for (int m = 0; m < 4; ++m) { int slot = u.pm * 256 + r0 + ai * 128 + m * 16; slot = slot < u.cnt ? slot : u.cnt - 1; sv[ai][m] = ag_ld(&ps[slot]); }
        EPI_FENCE();
#pragma unroll
        for (int ai = 0; ai < 2; ++ai)
#pragma unroll
            for (int m = 0; m < 4; ++m) { const int r = r0 + ai * 128 + m * 16; const float s = sv[ai][m];
                f32x4 v0, v1;
#pragma unroll
                for (int j = 0; j < 4; ++j) { const float g0 = acc[ai][0][m][0][j] * s, u0 = acc[ai][1][m][0][j] * s, g1 = acc[ai][0][m][1][j] * s, u1 = acc[ai][1][m][1][j] * s;
                    v0[j] = g0 * fast_sigmoid(g0) * u0; v1[j] = g1 * fast_sigmoid(g1) * u1; }
                *(u32x4*)(H + ((size_t)u.gt * 256 + r) * 256 + col0) = pack8(v0, v1); }
        EPI_FENCE();
    }
};
struct PhDown {
    static constexpr bool GATHER = false; static constexpr int LDA = 256, K = 256, LDB = 256, HSTEPB = 128 * 256 * 2;
    unsigned char* ws; const char* Abase; LAS unsigned char* lds; int G, c, nn;
    __device__ __forceinline__ bool next(int i, Unit& u) const { const int idx = i * G + c; if (idx >= 4 * nn) return false; u.pn = idx & 3; moe_decode(lds, ((const LAS int*)(lds + MT_OFF))[MT_NLIST + (idx >> 2)], u); return true; }
    NO_GATHER __device__ __forceinline__ const char* a_tile(const Unit& u) const { return Abase + (size_t)(u.gt * 256) * 256 * 2; }
    __device__ __forceinline__ const char* b_tile(const Unit& u) const { return (const char*)(ws + WS_WD) + ((size_t)u.e * 1024 + u.pn * 256) * 256 * 2; }
    __device__ __forceinline__ void epi(EPI_ARGS) const { EPI_OPAQUE
        const int r0 = u.pm * 256 + wr * 64 + fr, col0 = u.pn * 256 + wc * 32 + 8 * fq; const int* pdst = (const int*)(ws + WS_PDST) + u.e * CAP; const float* pw = (const float*)(ws + WS_PW) + u.e * CAP; bf16* Y2 = (bf16*)(ws + WS_Y2);
        int slot = r0 < u.cnt ? r0 : u.cnt - 1; int dn = pdst[slot]; float wn = pw[slot];
#pragma unroll
        for (int g = 0; g < 8; ++g) { const int ai = g >> 2, m = g & 3; const int dcur = dn; const float wcur = wn;
            if (g < 7) { int s2 = r0 + ((g + 1) >> 2) * 128 + ((g + 1) & 3) * 16; s2 = s2 < u.cnt ? s2 : u.cnt - 1; dn = pdst[s2]; wn = pw[s2]; }
            if (r0 + ai * 128 + m * 16 < u.cnt) { bf16* yp = Y2 + (size_t)dcur * 1024 + col0;
#pragma unroll
                for (int bj = 0; bj < 2; ++bj) *(u32x4*)(yp + bj * 128) = pack8(acc[ai][bj][m][0] * wcur, acc[ai][bj][m][1] * wcur); }
            EPI_FENCE(); }
    }
};
constexpr int SLOC_PITCH = 132;
struct PhSloc {
    static constexpr bool GATHER = false; static constexpr int LDA = 384, K = 256, LDB = 256, HSTEPB = 0;
    unsigned char* ws; const char* Abase; LAS unsigned char* lds; int G, c;
    __device__ __forceinline__ bool next(int i, Unit& u) const { const int idx = i * G + c; if (idx >= 256) return false; u.e = idx >> 2; u.pm = idx & 3; u.pn = 0; u.gt = 0; u.cnt = 0; return true; }
    NO_GATHER __device__ __forceinline__ const char* a_tile(const Unit& u) const { return Abase + (size_t)(u.e * 1024 + u.pm * 256) * 384 * 2; }
    __device__ __forceinline__ const char* b_tile(const Unit& u) const { return (const char*)(ws + WS_SSM) + (size_t)u.e * SSM_G_BYTES; }
    __device__ __forceinline__ void epi(EPI_ARGS) const { EPI_OPAQUE
        const int r0 = wr * 64 + fr, col0 = wc * 32 + 8 * fq; LAS float* L = (LAS float*)lds;
        asm volatile("s_waitcnt vmcnt(0)" ::: "memory"); __builtin_amdgcn_s_barrier();
#pragma unroll
        for (int ai = 0; ai < 2; ++ai)
#pragma unroll
            for (int m = 0; m < 4; ++m) { LAS float* p = L + (r0 + ai * 128 + m * 16) * SLOC_PITCH + col0; *(LAS f32x4*)p = acc[ai][0][m][0]; *(LAS f32x4*)(p + 4) = acc[ai][0][m][1]; }
    }
};
struct PhY {
    static constexpr bool GATHER = false; static constexpr int LDA = 384, K = 384, LDB = 384, HSTEPB = 128 * 384 * 2;
    unsigned char* ws; const char* Abase; int G, c;
    __device__ __forceinline__ bool next(int i, Unit& u) const { const int idx = i * G + c; if (idx >= 256) return false; u.e = idx >> 2; u.pm = idx & 3; u.pn = 0; u.gt = 0; u.cnt = 0; return true; }
    NO_GATHER __device__ __forceinline__ const char* a_tile(const Unit& u) const { return Abase + (size_t)(u.e * 1024 + u.pm * 256) * 384 * 2; }
    __device__ __forceinline__ const char* b_tile(const Unit& u) const { return (const char*)(ws + WS_SSM) + (size_t)u.e * SSM_G_BYTES + SSM_A2_OFF; }
    __device__ __forceinline__ void epi(EPI_ARGS) const { EPI_OPAQUE
        const int nb = (u.pm & 1) * 256 + wr * 64 + fr;
        bf16* p = (bf16*)(ws + WS_G) + ((size_t)u.e * M + (size_t)(u.pm >> 1) * SEQ + 16 * nb + 2 * wc + (fq >> 1)) * 16 + 8 * (fq & 1);
#pragma unroll
        for (int ai = 0; ai < 2; ++ai)
#pragma unroll
            for (int m = 0; m < 4; ++m) {
#pragma unroll
                for (int bj = 0; bj < 2; ++bj) { f32x4 v0, v1;
#pragma unroll
                    for (int j = 0; j < 4; ++j) { v0[j] = fast_gelu(acc[ai][bj][m][0][j]); v1[j] = fast_gelu(acc[ai][bj][m][1][j]); }
                    *(u32x4*)(p + bj * 8 * 16) = pack8(v0, v1); }
                p += (m == 3 ? (128 - 48) : 16) * 16 * 16; asm volatile("" : "+v"(p) :: "memory"); }
    }
};

namespace at {
constexpr int NSLOT = 4, SLOTB = 8192;
constexpr int LDS_K = 0, LDS_V = NSLOT * SLOTB, LDS_WS = 2 * NSLOT * SLOTB, LDS_TBL = LDS_WS + 2048, LDS_OST = LDS_TBL + 2048, LDS_TOTAL = LDS_OST + 8 * 4096;
typedef short v4i16_t __attribute__((ext_vector_type(4)));
__device__ __forceinline__ int crow(int r, int hi) { return (r & 3) + 8 * (r >> 2) + 4 * hi; }
__device__ __forceinline__ void glds16(const void* gsrc, unsigned lds_dst) { unsigned keep;
    asm volatile("s_mov_b32 %0, m0\n\ts_mov_b32 m0, %2\n\ts_nop 0\n\tglobal_load_lds_dwordx4 %1, off\n\ts_mov_b32 m0, %0" : "=&s"(keep) : "v"(gsrc), "s"(lds_dst) : "memory"); }
__device__ __forceinline__ s16x4 vtr(const LAS unsigned char* p) { return __builtin_bit_cast(s16x4, __builtin_amdgcn_ds_read_tr16_b64_v4i16((LAS v4i16_t*)p)); }
#define AT_WAIT_BAR(N) asm volatile("s_waitcnt vmcnt(" #N ") lgkmcnt(0)\n\ts_barrier" ::: "memory")
template <int THR> __device__ __forceinline__ void attn_unit(int b, int h, int qb, const bf16* Q, const bf16* __restrict__ K, const bf16* __restrict__ V, bf16* O, const float* __restrict__ relb, LAS unsigned char* shm, int wid) {
    const int lane = lane_now(), tid = wid * 64 + lane, r32 = lane & 31, hi = lane >> 5;
    const long rowbase = (long)b * SEQ; const int q0 = qb * 256; const int cq = 4 * qb + (wid >> 1);
    const bf16* Qw = Q + (rowbase + q0 + wid * 32) * D + h * 64;
    const unsigned lds0 = (unsigned)(uintptr_t)shm;
    LAS float* wsf = (LAS float*)(shm + LDS_WS) + wid * 64; LAS float* tbl = (LAS float*)(shm + LDS_TBL);
    const int kc_lo = (4 * qb - 8) < 0 ? 0 : (4 * qb - 8); const int NT = 4 * qb + 3 - kc_lo + 1;
    const int ta = ((cq - 8) < kc_lo ? kc_lo : (cq - 8)) - kc_lo, tb_ = cq - kc_lo;
    if (tid < 320) tbl[tid] = relb[h * NREL + (tid < 256 ? tid : 256)] * LOG2E;
    const bf16* ksrc = K + (rowbase + kc_lo * 64 + lane) * D + h * 64 + wid * 8;
    const bf16* vsrc = V + (rowbase + kc_lo * 64 + 16 * (wid & 3) + (lane >> 2)) * D + h * 64 + (wid >> 2) * 32 + (lane & 3) * 8;
    const unsigned kdst = lds0 + LDS_K + wid * 1024, vdst = lds0 + LDS_V + wid * 1024;
#define AT_DMA(t) do { const unsigned so_ = (unsigned)((t) & 3) * SLOTB; glds16(ksrc + (long)(t) * 64 * D, (unsigned)__builtin_amdgcn_readfirstlane(kdst + so_)); glds16(vsrc + (long)(t) * 64 * D, (unsigned)__builtin_amdgcn_readfirstlane(vdst + so_)); } while (0)
    bf16x8 qr[4];
#pragma unroll
    for (int d0 = 0; d0 < 4; ++d0) qr[d0] = __builtin_nontemporal_load(reinterpret_cast<const bf16x8*>(&Qw[(long)r32 * D + d0 * 16 + hi * 8]));
    AT_DMA(0); AT_DMA(1); AT_DMA(2);
    asm volatile("" : "+v"(qr[0]), "+v"(qr[1]), "+v"(qr[2]), "+v"(qr[3]));
    float mrow = -1e30f, lsum = 0.f; f32x16 o[2]; o[0] = f32x16{}; o[1] = f32x16{};
    f32x16 s0 = f32x16{}, s1 = f32x16{};
    f32x16 cfar = f32x16{};
    const int qoff = 32 * (wid & 1) + r32 + 128 - 4 * hi;
#define AT_CINIT(P0, P1, kc_, msub_) do { const int delta_ = cq - (kc_); \
        if (delta_ >= 3) { P0 = cfar; P1 = cfar; } \
        else { const LAS float* tb = tbl + (64 * delta_ + qoff); _Pragma("unroll") for (int r = 0; r < 16; ++r) { const int kj = (r & 3) + 8 * (r >> 2); P0[r] = tb[-kj] - (msub_); P1[r] = tb[-kj - 32] - (msub_); } } } while (0)
#define AT_KLOAD(t_) do { const LAS unsigned char* kp = shm + LDS_K + ((t_) & 3) * SLOTB + hi * 1024 + r32 * 16; \
        _Pragma("unroll") for (int d0 = 0; d0 < 4; ++d0) { kf[2 * d0] = *(const LAS bf16x8*)(kp + d0 * 2048); kf[2 * d0 + 1] = *(const LAS bf16x8*)(kp + d0 * 2048 + 512); } } while (0)
#define AT_QK(P0, P1) do { _Pragma("unroll") for (int d0 = 0; d0 < 4; ++d0) { \
            P0 = __builtin_amdgcn_mfma_f32_32x32x16_bf16(kf[2 * d0], qr[d0], P0, 0, 0, 0); P1 = __builtin_amdgcn_mfma_f32_32x32x16_bf16(kf[2 * d0 + 1], qr[d0], P1, 0, 0, 0); } } while (0)
#define AT_CFAR() do { const float c0_ = tbl[256] - mrow; _Pragma("unroll") for (int r = 0; r < 16; ++r) cfar[r] = c0_; } while (0)
#define AT_STATS() do { float ra = fmaxf(fmaxf(s0[0], s0[1]), s1[0]), rb2 = fmaxf(fmaxf(s0[2], s0[3]), s1[1]); ra = fmaxf(fmaxf(ra, s1[2]), s1[3]); \
        _Pragma("unroll") for (int r = 4; r < 16; r += 4) { ra = fmaxf(fmaxf(ra, s0[r]), s0[r + 1]); rb2 = fmaxf(fmaxf(rb2, s0[r + 2]), s0[r + 3]); ra = fmaxf(fmaxf(ra, s1[r]), s1[r + 1]); rb2 = fmaxf(fmaxf(rb2, s1[r + 2]), s1[r + 3]); } \
        float rm = fmaxf(ra, rb2); { auto rr = __builtin_amdgcn_permlane32_swap(__float_as_uint(rm), __float_as_uint(rm), false, false); rm = fmaxf(__uint_as_float(rr[0]), __uint_as_float(rr[1])); } \
        if (mrow < -1e29f) { mrow = rm; _Pragma("unroll") for (int r = 0; r < 16; ++r) { s0[r] -= rm; s1[r] -= rm; } AT_CFAR(); } \
        else if (__any(rm > (float)THR)) { const float dl = fmaxf(rm, 0.f), f = __builtin_amdgcn_exp2f(-dl); mrow += dl; lsum *= f; \
            if (hi == 0) wsf[r32] = f; LDS_WAIT(); \
            _Pragma("unroll") for (int r = 0; r < 16; ++r) { const float fr_ = wsf[crow(r, hi)]; o[0][r] *= fr_; o[1][r] *= fr_; s0[r] -= dl; s1[r] -= dl; } AT_CFAR(); } } while (0)
#define AT_EXP_PACK() float sacc = 0.f, sacc2 = 0.f; \
        _Pragma("unroll") for (int r = 0; r < 16; ++r) { s0[r] = __builtin_amdgcn_exp2f(s0[r]); s1[r] = __builtin_amdgcn_exp2f(s1[r]); sacc += s0[r]; sacc2 += s1[r]; } \
        lsum += sacc + sacc2; \
        const u32x4 pw0 = (u32x4){cvtpk_s(s0[0], s0[1]), cvtpk_s(s0[2], s0[3]), cvtpk_s(s0[4], s0[5]), cvtpk_s(s0[6], s0[7])}; \
        const u32x4 pw1 = (u32x4){cvtpk_s(s0[8], s0[9]), cvtpk_s(s0[10], s0[11]), cvtpk_s(s0[12], s0[13]), cvtpk_s(s0[14], s0[15])}; \
        const u32x4 pw2 = (u32x4){cvtpk_s(s1[0], s1[1]), cvtpk_s(s1[2], s1[3]), cvtpk_s(s1[4], s1[5]), cvtpk_s(s1[6], s1[7])}; \
        const u32x4 pw3 = (u32x4){cvtpk_s(s1[8], s1[9]), cvtpk_s(s1[10], s1[11]), cvtpk_s(s1[12], s1[13]), cvtpk_s(s1[14], s1[15])}; \
        const bf16x8 pa[4] = {__builtin_bit_cast(bf16x8, pw0), __builtin_bit_cast(bf16x8, pw1), __builtin_bit_cast(bf16x8, pw2), __builtin_bit_cast(bf16x8, pw3)};
#define AT_VLOAD(t_) do { const LAS unsigned char* vp = shm + LDS_V + ((t_) & 3) * SLOTB + ((lane >> 4) & 1) * 32 + (lane & 3) * 8 + (4 * hi + ((lane & 15) >> 2)) * 64; \
        _Pragma("unroll") for (int d0 = 0; d0 < 2; ++d0) _Pragma("unroll") for (int ks = 0; ks < 4; ++ks) { vlo[d0 * 4 + ks] = vtr(vp + d0 * 4096 + ks * 1024); vhi[d0 * 4 + ks] = vtr(vp + d0 * 4096 + ks * 1024 + 512); } } while (0)
#define AT_PV() do { _Pragma("unroll") for (int d0 = 0; d0 < 2; ++d0) _Pragma("unroll") for (int ks = 0; ks < 4; ++ks) { const s16x4 lo = vlo[d0 * 4 + ks], hh = vhi[d0 * 4 + ks]; \
            const bf16x8 vf = (bf16x8){lo[0], lo[1], lo[2], lo[3], hh[0], hh[1], hh[2], hh[3]}; o[d0] = __builtin_amdgcn_mfma_f32_32x32x16_bf16(pa[ks], vf, o[d0], 0, 0, 0); } } while (0)
    bf16x8 kf[8]; s16x4 vlo[8], vhi[8];
    for (int t = 0; t < NT; ++t) {
        if (t + 2 < NT) { AT_WAIT_BAR(4); } else if (t + 1 < NT) { AT_WAIT_BAR(2); } else { AT_WAIT_BAR(0); }
        if (t + 3 < NT) AT_DMA(t + 3);
        if (t >= ta && t <= tb_) {
            AT_KLOAD(t); AT_VLOAD(t);
            __builtin_amdgcn_sched_barrier(0);
            if (mrow < -1e29f) { const float c0_ = tbl[256]; _Pragma("unroll") for (int r = 0; r < 16; ++r) cfar[r] = c0_; }
            AT_CINIT(s0, s1, kc_lo + t, (mrow < -1e29f ? 0.f : mrow));
            AT_QK(s0, s1);
            AT_STATS();
            AT_EXP_PACK()
            AT_PV();
        }
    }
    { auto rr = __builtin_amdgcn_permlane32_swap(__float_as_uint(lsum), __float_as_uint(lsum), false, false); lsum = __uint_as_float(rr[0]) + __uint_as_float(rr[1]); }
    if (hi == 0) wsf[32 + r32] = lsum;
    LDS_WAIT();
    float rli[16];
#pragma unroll
    for (int r = 0; r < 16; ++r) rli[r] = __builtin_amdgcn_rcpf(wsf[32 + crow(r, hi)]);
    bf16* Ow = O + (rowbase + q0 + wid * 32) * D + h * 64;
    { LAS bf16* stg = (LAS bf16*)(shm + LDS_OST) + wid * 2048;
#pragma unroll
      for (int r = 0; r < 16; ++r) { const int orow = crow(r, hi);
#pragma unroll
          for (int d0 = 0; d0 < 2; ++d0) stg[orow * 64 + d0 * 32 + r32] = f2bf(o[d0][r] * rli[r]); }
      LDS_WAIT();
#pragma unroll
      for (int i = 0; i < 4; ++i) { const int row = i * 8 + (lane >> 3), ch = lane & 7; const u32x4 v = *(const LAS u32x4*)(stg + row * 64 + ch * 8); *(u32x4*)(Ow + (long)row * D + ch * 8) = v; } }
    asm volatile("s_waitcnt lgkmcnt(0)\n\ts_barrier" ::: "memory");
#undef AT_DMA
#undef AT_CINIT
#undef AT_QK
#undef AT_KLOAD
#undef AT_VLOAD
#undef AT_CFAR
#undef AT_STATS
#undef AT_EXP_PACK
#undef AT_PV
}
}
namespace at2 {
constexpr int NSLOT = 4, SLOTB = 16384;
constexpr int LDS_K = 0, LDS_V = NSLOT * SLOTB, LDS_WS = 2 * NSLOT * SLOTB, LDS_TBL = LDS_WS + 4096, LDS_OST = LDS_TBL + 3072, LDS_TOTAL = LDS_OST + 8 * 2048;
using at::crow; using at::glds16; using at::vtr;
__device__ __forceinline__ void glds16s(const void* sbase, unsigned voff, unsigned lds_dst) { unsigned keep;
    asm volatile("s_mov_b32 %0, m0\n\ts_mov_b32 m0, %3\n\ts_nop 0\n\tglobal_load_lds_dwordx4 %1, %2\n\ts_mov_b32 m0, %0" : "=&s"(keep) : "v"(voff), "s"(sbase), "s"(lds_dst) : "memory"); }
__device__ __forceinline__ void glds16_o128(const void* gsrc, unsigned lds_dst) { unsigned keep;
    asm volatile("s_mov_b32 %0, m0\n\ts_mov_b32 m0, %2\n\ts_nop 0\n\tglobal_load_lds_dwordx4 %1, off offset:128\n\ts_mov_b32 m0, %0" : "=&s"(keep) : "v"(gsrc), "s"(lds_dst) : "memory"); }
#define AT_WAIT_BAR(N) asm volatile("s_waitcnt vmcnt(" #N ") lgkmcnt(0)\n\ts_barrier" ::: "memory")
template <int THR> __device__ __forceinline__ void attn_stream(int b, int hp, int qb0, int nu, const bf16* Q, const bf16* __restrict__ K, const bf16* __restrict__ V, bf16* O, const float* __restrict__ relb, LAS unsigned char* shm, int wid) {
    const int lane = lane_now(), tid = wid * 64 + lane, r32 = lane & 31, hi = lane >> 5, hs = wid & 1, h = 2 * hp + hs;
    const long rowbase = (long)b * SEQ;
    const unsigned lds0 = (unsigned)(uintptr_t)shm;
    LAS float* wsf = (LAS float*)(shm + LDS_WS) + wid * 128; LAS float* tbl = (LAS float*)(shm + LDS_TBL) + hs * 320;
    if (tid < 320) { LAS float* t0 = (LAS float*)(shm + LDS_TBL); const int ix = tid < 256 ? tid : 256; t0[tid] = relb[(2 * hp) * NREL + ix] * LOG2E; t0[320 + tid] = relb[(2 * hp + 1) * NREL + ix] * LOG2E; }
    const bf16* kb0 = K + rowbase * D + (2 * hp) * 64;
    const bf16* vb0 = V + (rowbase + 16 * (wid & 3)) * D + (2 * hp) * 64 + (wid >> 2) * 32;
    const int kkA = 8 * wid + (lane >> 4), kkB = kkA + 4;
    const unsigned koffA = (unsigned)((kkA * D + (((lane & 15) ^ (kkA & 15)) * 8)) * 2), koffB = (unsigned)((kkB * D + (((lane & 15) ^ (kkB & 15)) * 8)) * 2);
    const unsigned voff = (unsigned)(((lane >> 2) * D + (lane & 3) * 8) * 2);
    const unsigned kdst = lds0 + LDS_K + wid * 2048, vdst = lds0 + LDS_V + wid * 1024;
#define AT_DMA(kt_, t) do { const unsigned so_ = (unsigned)((t) & 3) * SLOTB; const bf16* kp_ = kb0 + (long)(kt_) * 64 * D; const bf16* vp_ = vb0 + (long)(kt_) * 64 * D; \
        glds16s(kp_, koffA, (unsigned)__builtin_amdgcn_readfirstlane(kdst + so_)); glds16s(kp_, koffB, (unsigned)__builtin_amdgcn_readfirstlane(kdst + so_ + 1024)); \
        glds16s(vp_, voff, (unsigned)__builtin_amdgcn_readfirstlane(vdst + so_)); glds16s(vp_ + 64, voff, (unsigned)__builtin_amdgcn_readfirstlane(vdst + so_ + 8192)); } while (0)
#define AT_QLOAD(cq_) do { const int lq_ = lane_now();     \
        const bf16* Qw = Q + (rowbase + (cq_) * 64 + (lq_ & 31)) * D + h * 64 + (lq_ >> 5) * 8; _Pragma("unroll") for (int d0 = 0; d0 < 4; ++d0) { \
        qrA[d0] = __builtin_nontemporal_load(reinterpret_cast<const bf16x8*>(&Qw[d0 * 16])); \
        qrB[d0] = __builtin_nontemporal_load(reinterpret_cast<const bf16x8*>(&Qw[32 * D + d0 * 16])); } } while (0)
    bf16x8 qrA[4], qrB[4];
    { const int kl0 = (4 * qb0 - 8) < 0 ? 0 : (4 * qb0 - 8); AT_QLOAD(4 * qb0 + (wid >> 1)); AT_DMA(kl0, 0); AT_DMA(kl0 + 1, 1); }
    const unsigned ones1 = hi == 0 ? 0x3F803F80u : 0u;
    const int qoffA = r32 + 128 - 4 * hi;
    bf16x8 kf[8]; s16x4 vlo[8], vhi[8]; bf16x8 paA[4], paB[4];
#define AT_CINIT(P0, P1, kc_, msub_, xo_, cfar_) do { const int delta_ = cq - (kc_); \
        if (delta_ >= 3) { const bf16x8 oa_ = __builtin_bit_cast(bf16x8, (u32x4){ones1, 0u, 0u, 0u}), cb_ = __builtin_bit_cast(bf16x8, (u32x4){cfar_, 0u, 0u, 0u}); \
            P0 = __builtin_amdgcn_mfma_f32_32x32x16_bf16(oa_, cb_, f32x16{}, 0, 0, 0); P1 = __builtin_amdgcn_mfma_f32_32x32x16_bf16(oa_, cb_, f32x16{}, 0, 0, 0); } \
        else { const LAS float* tb = tbl + (64 * delta_ + qoffA); _Pragma("unroll") for (int r = 0; r < 16; ++r) { const int kj = (r & 3) + 8 * (r >> 2); P0[r] = tb[(xo_) - kj] - (msub_); P1[r] = tb[(xo_) - kj - 32] - (msub_); } } } while (0)
#define AT_KLOAD(t_) do { const LAS unsigned char* kp = shm + LDS_K + ((t_) & 3) * SLOTB; const unsigned ka = (unsigned)(r32 * 256 + (((hs * 8 + hi) ^ (r32 & 15)) << 4)); \
        _Pragma("unroll") for (int d0 = 0; d0 < 4; ++d0) { kf[2 * d0] = *(const LAS bf16x8*)(kp + (ka ^ (unsigned)(d0 << 5))); kf[2 * d0 + 1] = *(const LAS bf16x8*)(kp + (ka ^ (unsigned)(d0 << 5)) + 8192); } } while (0)
#define AT_QK(P0, P1, qr_) do { _Pragma("unroll") for (int d0 = 0; d0 < 4; ++d0) { \
            P0 = __builtin_amdgcn_mfma_f32_32x32x16_bf16(kf[2 * d0], qr_[d0], P0, 0, 0, 0); P1 = __builtin_amdgcn_mfma_f32_32x32x16_bf16(kf[2 * d0 + 1], qr_[d0], P1, 0, 0, 0); } } while (0)
#define AT_CFAR(cfar_, mrow_) do { const float c0_ = tbl[256] - (mrow_); const bf16 ch_ = f2bf(c0_); const bf16 cl_ = f2bf(c0_ - bf2f(ch_)); cfar_ = ones1 ? ((unsigned)ch_ | ((unsigned)cl_ << 16)) : 0u; } while (0)
#define AT_STATS(s0, s1, mrow, lsum, o, cfar_, wsx) do { float ra = fmaxf(fmaxf(s0[0], s0[1]), s1[0]), rb2 = fmaxf(fmaxf(s0[2], s0[3]), s1[1]); ra = fmaxf(fmaxf(ra, s1[2]), s1[3]); \
        _Pragma("unroll") for (int r = 4; r < 16; r += 4) { ra = fmaxf(fmaxf(ra, s0[r]), s0[r + 1]); rb2 = fmaxf(fmaxf(rb2, s0[r + 2]), s0[r + 3]); ra = fmaxf(fmaxf(ra, s1[r]), s1[r + 1]); rb2 = fmaxf(fmaxf(rb2, s1[r + 2]), s1[r + 3]); } \
        float rm = fmaxf(ra, rb2); { auto rr = __builtin_amdgcn_permlane32_swap(__float_as_uint(rm), __float_as_uint(rm), false, false); rm = fmaxf(__uint_as_float(rr[0]), __uint_as_float(rr[1])); } \
        if (mrow < -1e29f) { mrow = rm; _Pragma("unroll") for (int r = 0; r < 16; ++r) { s0[r] -= rm; s1[r] -= rm; } AT_CFAR(cfar_, mrow); } \
        else if (__any(rm > (float)THR)) { const float dl = fmaxf(rm, 0.f), f = __builtin_amdgcn_exp2f(-dl); mrow += dl; lsum *= f; \
            const int l2_ = lane_now(), hi2_ = l2_ >> 5;   \
            if (hi2_ == 0) (wsx)[l2_ & 31] = f; LDS_WAIT(); \
            _Pragma("unroll") for (int r = 0; r < 16; ++r) { const float fr_ = (wsx)[crow(r, hi2_)]; o[0][r] *= fr_; o[1][r] *= fr_; s0[r] -= dl; s1[r] -= dl; } AT_CFAR(cfar_, mrow); } } while (0)
#define AT_EXP_PACK(s0, s1, lsum, pa) do { float sacc = 0.f, sacc2 = 0.f; \
        _Pragma("unroll") for (int r = 0; r < 16; ++r) { s0[r] = __builtin_amdgcn_exp2f(s0[r]); s1[r] = __builtin_amdgcn_exp2f(s1[r]); sacc += s0[r]; sacc2 += s1[r]; } \
        lsum += sacc + sacc2; \
        pa[0] = __builtin_bit_cast(bf16x8, (u32x4){cvtpk_s(s0[0], s0[1]), cvtpk_s(s0[2], s0[3]), cvtpk_s(s0[4], s0[5]), cvtpk_s(s0[6], s0[7])}); \
        pa[1] = __builtin_bit_cast(bf16x8, (u32x4){cvtpk_s(s0[8], s0[9]), cvtpk_s(s0[10], s0[11]), cvtpk_s(s0[12], s0[13]), cvtpk_s(s0[14], s0[15])}); \
        pa[2] = __builtin_bit_cast(bf16x8, (u32x4){cvtpk_s(s1[0], s1[1]), cvtpk_s(s1[2], s1[3]), cvtpk_s(s1[4], s1[5]), cvtpk_s(s1[6], s1[7])}); \
        pa[3] = __builtin_bit_cast(bf16x8, (u32x4){cvtpk_s(s1[8], s1[9]), cvtpk_s(s1[10], s1[11]), cvtpk_s(s1[12], s1[13]), cvtpk_s(s1[14], s1[15])}); } while (0)
#define AT_VLOAD(t_) do { const LAS unsigned char* vp = shm + LDS_V + ((t_) & 3) * SLOTB + hs * 8192 + ((lane >> 4) & 1) * 32 + (lane & 3) * 8 + (4 * hi + ((lane & 15) >> 2)) * 64; \
        _Pragma("unroll") for (int d0 = 0; d0 < 2; ++d0) _Pragma("unroll") for (int ks = 0; ks < 4; ++ks) { vlo[d0 * 4 + ks] = vtr(vp + d0 * 4096 + ks * 1024); vhi[d0 * 4 + ks] = vtr(vp + d0 * 4096 + ks * 1024 + 512); } } while (0)
#define AT_PV2() do { _Pragma("unroll") for (int d0 = 0; d0 < 2; ++d0) _Pragma("unroll") for (int ks = 0; ks < 4; ++ks) { const s16x4 lo = vlo[d0 * 4 + ks], hh = vhi[d0 * 4 + ks]; \
            const bf16x8 vf = (bf16x8){lo[0], lo[1], lo[2], lo[3], hh[0], hh[1], hh[2], hh[3]}; \
            oA[d0] = __builtin_amdgcn_mfma_f32_32x32x16_bf16(paA[ks], vf, oA[d0], 0, 0, 0); oB[d0] = __builtin_amdgcn_mfma_f32_32x32x16_bf16(paB[ks], vf, oB[d0], 0, 0, 0); } } while (0)
#define AT_STEP_TOP(j_) do { AT_WAIT_BAR(0); \
        if (2 * (j_) + 2 < NT) { AT_DMA(kc_lo + 2 * (j_) + 2, 2 * (j_) + 2); AT_DMA(kc_lo + 2 * (j_) + 3, 2 * (j_) + 3); } \
        else if (has_next) { AT_DMA(kc_lo_n, 0); AT_DMA(kc_lo_n + 1, 1); } } while (0)
#define AT_OUT(o_, wsx, rbase_) do { _Pragma("unroll") for (int p_ = 0; p_ < 2; ++p_) { \
      _Pragma("unroll") for (int r = 8 * p_; r < 8 * p_ + 8; ++r) { const int orow = crow(r, hie); const float rl_ = __builtin_amdgcn_rcpf((wsx)[32 + orow]); \
          _Pragma("unroll") for (int d0 = 0; d0 < 2; ++d0) stg[(orow - 16 * p_) * 64 + d0 * 32 + r32e] = f2bf(o_[d0][r] * rl_); } \
      LDS_WAIT(); \
      _Pragma("unroll") for (int i = 0; i < 2; ++i) { const u32x4 v = *(const LAS u32x4*)(stg + (i * 8 + (le >> 3)) * 64 + (le & 7) * 8); *(u32x4*)(Ow + (long)((rbase_) + 16 * p_ + i * 8) * D) = v; } \
      LDS_WAIT(); } } while (0)
    for (int u = 0; u < nu; ++u) {
        const int qb = qb0 + u, cq = 4 * qb + (wid >> 1); const bool has_next = u + 1 < nu;
        const int kc_lo = (4 * qb - 8) < 0 ? 0 : (4 * qb - 8), NT = 4 * qb + 3 - kc_lo + 1, kc_lo_n = (4 * qb - 4) < 0 ? 0 : (4 * qb - 4);
        const int ta = ((cq - 8) < kc_lo ? kc_lo : (cq - 8)) - kc_lo, tb_ = cq - kc_lo;
        const int steps = NT >> 1, mylast = tb_ >> 1;
        asm volatile("" : "+v"(qrA[0]), "+v"(qrA[1]), "+v"(qrA[2]), "+v"(qrA[3]), "+v"(qrB[0]), "+v"(qrB[1]), "+v"(qrB[2]), "+v"(qrB[3]));
        float mrowA = -1e30f, lsumA = 0.f, mrowB = -1e30f, lsumB = 0.f; f32x16 oA[2], oB[2]; oA[0] = f32x16{}; oA[1] = f32x16{}; oB[0] = f32x16{}; oB[1] = f32x16{};
        f32x16 sA0 = f32x16{}, sA1 = f32x16{}, sB0 = f32x16{}, sB1 = f32x16{};
        unsigned cfarA = 0u, cfarB = 0u;
        int j = 0;
        for (; j <= mylast; ++j) {
            AT_STEP_TOP(j);
          for (int t = 2 * j; t < 2 * j + 2; ++t) {
            if (t >= ta && t <= tb_) {
                AT_KLOAD(t);
                __builtin_amdgcn_sched_barrier(0);
                const bool first = mrowA < -1e29f;
                if (first) { AT_CFAR(cfarA, 0.f); AT_CFAR(cfarB, 0.f); }
                AT_CINIT(sA0, sA1, kc_lo + t, (first ? 0.f : mrowA), 0, cfarA);
                AT_QK(sA0, sA1, qrA);
                AT_CINIT(sB0, sB1, kc_lo + t, (first ? 0.f : mrowB), 32, cfarB);
                AT_QK(sB0, sB1, qrB);
                __builtin_amdgcn_sched_barrier(0);
                AT_VLOAD(t);
                AT_STATS(sA0, sA1, mrowA, lsumA, oA, cfarA, wsf);
                AT_EXP_PACK(sA0, sA1, lsumA, paA);
                AT_STATS(sB0, sB1, mrowB, lsumB, oB, cfarB, (wsf + 64));
                AT_EXP_PACK(sB0, sB1, lsumB, paB);
                AT_PV2();
            }
          }
        }
        if (has_next) AT_QLOAD(cq + 4);
        { auto rr = __builtin_amdgcn_permlane32_swap(__float_as_uint(lsumA), __float_as_uint(lsumA), false, false); lsumA = __uint_as_float(rr[0]) + __uint_as_float(rr[1]); }
        { auto rr = __builtin_amdgcn_permlane32_swap(__float_as_uint(lsumB), __float_as_uint(lsumB), false, false); lsumB = __uint_as_float(rr[0]) + __uint_as_float(rr[1]); }
        const int le = lane_now(), r32e = le & 31, hie = le >> 5;
        if (hie == 0) { wsf[32 + r32e] = lsumA; wsf[96 + r32e] = lsumB; }
        LDS_WAIT();
        { bf16* Ow = O + (rowbase + cq * 64 + (le >> 3)) * D + h * 64 + (le & 7) * 8;
          LAS bf16* stg = (LAS bf16*)(shm + LDS_OST + wid * 2048);
          AT_OUT(oA, wsf, 0);
          AT_OUT(oB, (wsf + 64), 32); }
        for (; j < steps; ++j) AT_STEP_TOP(j);
    }
    asm volatile("s_waitcnt lgkmcnt(0)\n\ts_barrier" ::: "memory");
#undef AT_STEP_TOP
#undef AT_QLOAD
#undef AT_OUT
#undef AT_DMA
#undef AT_CINIT
#undef AT_QK
#undef AT_KLOAD
#undef AT_VLOAD
#undef AT_CFAR
#undef AT_STATS
#undef AT_EXP_PACK
#undef AT_PV2
}
}

struct Args { const float* in[23]; float* out; unsigned char* ws; int ph_lo, ph_hi, li, pad; };

struct TrDesc { const float* W; bf16* WT; const float* ks; int ldw, k0, n0, ldt, drow0, keep; };
__device__ __forceinline__ void tr_load(const TrDesc& d, float (&v)[32], int lane) {
    const float* wp = d.W + (size_t)(d.k0 + (lane >> 5)) * d.ldw + d.n0 + (lane & 31);
#pragma unroll
    for (int i = 0; i < 32; ++i) v[i] = __builtin_nontemporal_load(wp + (size_t)(2 * i) * d.ldw);
}
__device__ __forceinline__ void tr_store(const TrDesc& d, float (&v)[32], LAS float* scr, int lane) {
    if (d.ks) {
#pragma unroll
        for (int i = 0; i < 32; ++i) v[i] *= d.ks[d.k0 + 2 * i + (lane >> 5)]; }
#pragma unroll
    for (int i = 0; i < 32; ++i) scr[(2 * i + (lane >> 5)) * 33 + (lane & 31)] = v[i];
    LDS_WAIT(); asm volatile("" ::: "memory");
    const int c = lane & 7;
#pragma unroll
    for (int j = 0; j < 4; ++j) { const int n = (lane >> 3) + 8 * j; const LAS float* s = scr + (8 * c) * 33 + n;
        u32x4 o; o.x = pk2(s[0 * 33], s[1 * 33]); o.y = pk2(s[2 * 33], s[3 * 33]); o.z = pk2(s[4 * 33], s[5 * 33]); o.w = pk2(s[6 * 33], s[7 * 33]);
        u32x4* dp = (u32x4*)(d.WT + (size_t)(d.drow0 + n) * d.ldt + d.k0 + 8 * c); if (d.keep) *dp = o; else __builtin_nontemporal_store(o, dp); }
    LDS_WAIT(); asm volatile("" ::: "memory");
}
struct TrSrc { const float* w_qkv; const float* w_o; const float* w_out; const float* wg; const float* wu; const float* wd; const float* gn; unsigned char* ws; int nd, first, last; };
__device__ __forceinline__ TrDesc tr_desc(const TrSrc& S, int it) {
    TrDesc d; d.ks = nullptr; d.keep = 0;
    if (it < S.nd) {
        if (it < 1536) { const int kb = it / 96, nb = it % 96; d.W = S.w_qkv; d.ldw = 3072; d.k0 = kb * 64; d.n0 = nb * 32; d.WT = (bf16*)(S.ws + WS_WQKV); d.ldt = 1024; d.drow0 = nb * 32; d.keep = 1; }
        else if (it < 2048) { const int r = it - 1536, kb = r >> 5, nb = r & 31; d.W = S.w_o; d.ldw = 1024; d.k0 = kb * 64; d.n0 = nb * 32; d.WT = (bf16*)(S.ws + WS_WO); d.ldt = 1024; d.drow0 = nb * 32; }
        else { const int r = it - 2048, kb = r >> 6, nb = r & 63, n0 = nb * 32, ag = n0 >> 10, cc = n0 & 1023; d.W = S.w_out; d.ldw = 2048; d.k0 = kb * 64; d.n0 = n0; d.WT = (bf16*)(S.ws + WS_WOUT); d.ldt = 1024; d.drow0 = 256 * (cc >> 7) + 128 * ag + (cc & 127); }
    } else { const int m = it - S.nd;
        if (m < 8192) { const int which = m >> 12, r = m & 4095, e = r >> 7, kb = (r >> 3) & 15, nb = r & 7, n0 = nb * 32;
            d.W = (which ? S.wu : S.wg) + (size_t)e * 1024 * 256; d.ldw = 256; d.k0 = kb * 64; d.n0 = n0; d.WT = (bf16*)(S.ws + WS_WGU); d.ldt = 1024; d.drow0 = e * 512 + 256 * (n0 >> 7) + 128 * which + (n0 & 127); d.ks = S.gn; }
        else { const int r = m - 8192, e = r >> 7, kb = (r >> 5) & 3, nb = r & 31; d.W = S.wd + (size_t)e * 256 * 1024; d.ldw = 1024; d.k0 = kb * 64; d.n0 = nb * 32; d.WT = (bf16*)(S.ws + WS_WD); d.ldt = 256; d.drow0 = e * 1024 + nb * 32; } }
    return d;
}
__device__ __forceinline__ TrSrc mk_trsrc(const float* a, const float* b, const float* c, const float* g, const float* u, const float* d, const float* gn, unsigned char* ws, int nd, int first, int last) { TrSrc S; S.w_qkv = a; S.w_o = b; S.w_out = c; S.wg = g; S.wu = u; S.wd = d; S.gn = gn; S.ws = ws; S.nd = nd; S.first = first; S.last = last; return S; }
__device__ __forceinline__ void tr_stream(const TrSrc& S, LAS float* scr, int gw, int NGW, int lane) {
    const int N = S.last; int it = S.first + gw; if (it >= N) return;
    float va[32], vb[32]; TrDesc d0 = tr_desc(S, it), d1 = d0; tr_load(d0, va, lane);
    for (;;) {
        int nx = it + NGW; if (nx < N) { d1 = tr_desc(S, nx); tr_load(d1, vb, lane); }
        tr_store(d0, va, scr, lane); it = nx; if (it >= N) break;
        nx = it + NGW; if (nx < N) { d0 = tr_desc(S, nx); tr_load(d0, va, lane); }
        tr_store(d1, vb, scr, lane); it = nx; if (it >= N) break;
    }
}
__device__ __forceinline__ void ssm_mats(int g, int q, const float* lre, const float* lim, const float* lstep, const float* bre, const float* bim, const float* cre, const float* cim, const float* dsk,
                                         unsigned char* ssm_ws, float* a16g, LAS float* L, int tid) {
    LAS float* pwr = L; LAS float* pwi = L + 64 * 17; LAS float* bbr = L + 2 * 64 * 17; LAS float* bbi = bbr + 1024; LAS float* ccr = bbi + 1024; LAS float* cci = ccr + 1024; LAS float* Kt = cci + 1024;
    if (tid < 64) { const int p = tid;
        const float lr = fminf(lre[g * 64 + p], -1e-4f), li = lim[g * 64 + p], step = expf(lstep[g]);
        const float decay = expf(lr * step), ang = li * step, ar = decay * cosf(ang), ai = decay * sinf(ang);
        const float den = lr * lr + li * li, nr = ar - 1.f, fr = (nr * lr + ai * li) / den, fi = (ai * lr - nr * li) / den;
        for (int c = 0; c < 16; ++c) { const float br = bre[(g * 64 + p) * 16 + c], bi = bim[(g * 64 + p) * 16 + c]; bbr[p * 16 + c] = fr * br - fi * bi; bbi[p * 16 + c] = fr * bi + fi * br;
            ccr[c * 64 + p] = cre[(g * 16 + c) * 64 + p]; cci[c * 64 + p] = cim[(g * 16 + c) * 64 + p]; }
        float xr = 1.f, xi = 0.f;
        for (int n = 0; n <= 16; ++n) { pwr[p * 17 + n] = xr; pwi[p * 17 + n] = xi; const float t = xr * ar - xi * ai; xi = xr * ai + xi * ar; xr = t; }
        if (q == 0) { a16g[(g * 64 + p) * 2] = pwr[p * 17 + 16]; a16g[(g * 64 + p) * 2 + 1] = pwi[p * 17 + 16]; }
    }
    __syncthreads();
    if (tid < 256) { const int tl = tid >> 6, c = (tid >> 2) & 15, cq = tid & 3, tau = 4 * q + tl;
        float s0 = 0.f, s1 = 0.f, s2 = 0.f, s3 = 0.f;
        for (int p = 0; p < 64; ++p) { const float cr = ccr[c * 64 + p], ci = cci[c * 64 + p], ar = pwr[p * 17 + tau], ai = pwi[p * 17 + tau]; const float tr = cr * ar - ci * ai, ti = cr * ai + ci * ar;
            const f32x4 br = *(const LAS f32x4*)(bbr + p * 16 + 4 * cq), bi = *(const LAS f32x4*)(bbi + p * 16 + 4 * cq);
            s0 += tr * br[0] - ti * bi[0]; s1 += tr * br[1] - ti * bi[1]; s2 += tr * br[2] - ti * bi[2]; s3 += tr * br[3] - ti * bi[3]; }
        if (tau == 0) { const float dd = dsk[g * 16 + c]; if (4 * cq == (c & ~3)) { if ((c & 3) == 0) s0 += dd; else if ((c & 3) == 1) s1 += dd; else if ((c & 3) == 2) s2 += dd; else s3 += dd; } }
        LAS float* kp = Kt + tl * 256 + c * 16 + 4 * cq; kp[0] = s0; kp[1] = s1; kp[2] = s2; kp[3] = s3; }
    __syncthreads();
    bf16* Bend = (bf16*)(ssm_ws + (size_t)g * SSM_G_BYTES); bf16* A2 = (bf16*)(ssm_ws + (size_t)g * SSM_G_BYTES + SSM_A2_OFF);
    for (int o = tid; o < 2048; o += NTHR) { const int tl = o >> 9, i = (o >> 5) & 15, c = (o >> 1) & 15, hf = o & 1, tau = 4 * q + tl, j = i - tau;
        if (j >= 0) { const LAS float* kp = Kt + tl * 256 + c * 16 + 8 * hf; u32x4 w; w.x = pk2(kp[0], kp[1]); w.y = pk2(kp[2], kp[3]); w.z = pk2(kp[4], kp[5]); w.w = pk2(kp[6], kp[7]);
            *(u32x4*)(A2 + (size_t)(i * 16 + c) * 384 + j * 16 + 8 * hf) = w; } }
    for (int o = tid; o < 2048; o += NTHR) { const int il = o >> 9, c = (o >> 5) & 15, j = (o >> 1) & 15, hf = o & 1, i = 4 * q + il;
        if (j > i) *(u32x4*)(A2 + (size_t)(i * 16 + c) * 384 + j * 16 + 8 * hf) = (u32x4){0u, 0u, 0u, 0u}; }
    for (int o = tid; o < 1024; o += NTHR) { const int il = o >> 8, c = (o >> 4) & 15, k8 = (o & 15) * 8, i = 4 * q + il; float v[8];
#pragma unroll
        for (int qq = 0; qq < 4; ++qq) { const int p = (k8 >> 1) + qq; const float cr = ccr[c * 64 + p], ci = cci[c * 64 + p], ar = pwr[p * 17 + i + 1], ai = pwi[p * 17 + i + 1];
            v[2 * qq] = cr * ar - ci * ai; v[2 * qq + 1] = -(cr * ai + ci * ar); }
        u32x4 w; w.x = pk2(v[0], v[1]); w.y = pk2(v[2], v[3]); w.z = pk2(v[4], v[5]); w.w = pk2(v[6], v[7]); *(u32x4*)(A2 + (size_t)(i * 16 + c) * 384 + 256 + k8) = w; }
    for (int o = tid; o < 1024; o += NTHR) { const int n = 32 * q + (o >> 5), k8 = (o & 31) * 8, p = n >> 1, ri = n & 1, j = k8 >> 4; float v[8];
        const float ar = pwr[p * 17 + 15 - j], ai = pwi[p * 17 + 15 - j];
#pragma unroll
        for (int qq = 0; qq < 8; ++qq) { const int c2 = (k8 & 15) + qq; const float br = bbr[p * 16 + c2], bi = bbi[p * 16 + c2]; v[qq] = ri ? (ar * bi + ai * br) : (ar * br - ai * bi); }
        u32x4 w; w.x = pk2(v[0], v[1]); w.y = pk2(v[2], v[3]); w.z = pk2(v[4], v[5]); w.w = pk2(v[6], v[7]); *(u32x4*)(Bend + (size_t)n * 256 + k8) = w; }
    __syncthreads();
}

__device__ __forceinline__ void router_phase(const bf16* __restrict__ h, const u32x4* __restrict__ rwt, const float* __restrict__ bgr, const float* __restrict__ ber, unsigned* cntg,
                                             int* pdst, float* pw, float* ps, float* srow, LAS unsigned char* lds, int vcu, int G, int wid, bool prefilled) {
    const int lane = lane_now(), tid = wid * 64 + lane;
    LAS bf16* Wl = (LAS bf16*)lds;
    if (!prefilled) for (int i = tid; i < RW_LAYER_BYTES / 16; i += NTHR) ((LAS u32x4*)lds)[i] = rwt[i];
    LAS int* lc = (LAS int*)(lds + RSCR_OFF); LAS int* lbase = lc + 32;
    const int rb = wid & 3, kh = wid >> 2, row = lane & 15, kq = lane >> 4;
    for (int blk = vcu; blk < M / 64; blk += G) {
        if (tid < 32) lc[tid] = 0;
        __syncthreads();
        const int t0 = blk * 64;
        const bf16* hp = h + (size_t)(t0 + 16 * rb + row) * D + 512 * kh + 8 * kq;
        const LAS bf16* wp0 = Wl + row * RW_PITCH + 512 * kh + 8 * kq; const LAS bf16* wp1 = wp0 + 16 * RW_PITCH; const LAS bf16* wp2 = Wl + (32 + (row & 3)) * RW_PITCH + 512 * kh + 8 * kq;
        f32x4 a0 = {0.f, 0.f, 0.f, 0.f}, a1 = a0, a2 = a0; float ssl = 0.f;
#pragma unroll 4
        for (int j = 0; j < 16; ++j) { const u32x4 hw = *(const u32x4*)(hp + 32 * j); const bf16x8 av = __builtin_bit_cast(bf16x8, hw);
#pragma unroll
            for (int i = 0; i < 4; ++i) { const float lo_ = __uint_as_float(hw[i] << 16), hi_ = __uint_as_float(hw[i] & 0xffff0000u); ssl += lo_ * lo_ + hi_ * hi_; }
            const bf16x8 b0h = *(const LAS bf16x8*)(wp0 + 32 * j), b0l = *(const LAS bf16x8*)(wp0 + RW_PLANE + 32 * j), b1h = *(const LAS bf16x8*)(wp1 + 32 * j), b1l = *(const LAS bf16x8*)(wp1 + RW_PLANE + 32 * j),
                         b2h = *(const LAS bf16x8*)(wp2 + 32 * j), b2l = *(const LAS bf16x8*)(wp2 + RW_PLANE + 32 * j);
            a0 = __builtin_amdgcn_mfma_f32_16x16x32_bf16(av, b0h, a0, 0, 0, 0); a0 = __builtin_amdgcn_mfma_f32_16x16x32_bf16(av, b0l, a0, 0, 0, 0);
            a1 = __builtin_amdgcn_mfma_f32_16x16x32_bf16(av, b1h, a1, 0, 0, 0); a1 = __builtin_amdgcn_mfma_f32_16x16x32_bf16(av, b1l, a1, 0, 0, 0);
            a2 = __builtin_amdgcn_mfma_f32_16x16x32_bf16(av, b2h, a2, 0, 0, 0); a2 = __builtin_amdgcn_mfma_f32_16x16x32_bf16(av, b2l, a2, 0, 0, 0); }
        ssl += __shfl_xor(ssl, 16); ssl += __shfl_xor(ssl, 32);
        LAS float* P = (LAS float*)(lds + RSCR_OFF + 256);
        LAS float* pp = P + (16 * rb) * 40;
        if (kh == 1) {
#pragma unroll
            for (int r = 0; r < 4; ++r) { const int tk = 4 * kq + r; pp[tk * 40 + row] = a0[r]; pp[tk * 40 + 16 + row] = a1[r]; if (row < 4) pp[tk * 40 + 32 + row] = a2[r]; }
            if (kq == 0) pp[row * 40 + 36] = ssl; }
        __syncthreads();
        if (kh == 0) {
#pragma unroll
            for (int r = 0; r < 4; ++r) { const int tk = 4 * kq + r; pp[tk * 40 + row] += a0[r]; pp[tk * 40 + 16 + row] += a1[r]; if (row < 4) pp[tk * 40 + 32 + row] += a2[r]; }
            if (kq == 0) pp[row * 40 + 36] += ssl; }
        __syncthreads();
        int e1 = 0, e2 = 0; float w1 = 0.f, w2 = 0.f, s = 0.f; int sl1 = 0, sl2 = 0;
        if (tid < 64) { LAS float* p0 = P + tid * 40;
            s = rsqrtf(p0[36] * (1.f / D) + RMS_EPS);
            for (int o = 0; o < 36; ++o) p0[o] = p0[o] * s + (o < 4 ? bgr[o] : ber[o - 4]);
            int gi = 0; float gmx = p0[0];
            for (int i = 1; i < 4; ++i) if (p0[i] > gmx) { gmx = p0[i]; gi = i; }
            float den = 0.f; for (int i = 0; i < 4; ++i) den += __expf(p0[i] - gmx);
            const float gp = 1.f / den; const LAS float* sl = p0 + 4 + 8 * gi;
            int i1 = 0; float l1 = sl[0]; for (int i = 1; i < 8; ++i) if (sl[i] > l1) { l1 = sl[i]; i1 = i; }
            int i2 = -1; float l2 = -3.4e38f; for (int i = 0; i < 8; ++i) if (i != i1 && sl[i] > l2) { l2 = sl[i]; i2 = i; }
            const float ex = __expf(l2 - l1); w1 = gp / (1.f + ex); w2 = gp * ex / (1.f + ex); e1 = gi * 8 + i1; e2 = gi * 8 + i2;
            sl1 = __hip_atomic_fetch_add(&lc[e1], 1, __ATOMIC_RELAXED, __HIP_MEMORY_SCOPE_WORKGROUP); sl2 = __hip_atomic_fetch_add(&lc[e2], 1, __ATOMIC_RELAXED, __HIP_MEMORY_SCOPE_WORKGROUP);
            }
        __syncthreads();
        if (tid < 32) { const int n = lc[tid]; lbase[tid] = n ? (int)__hip_atomic_fetch_add(cntg + tid * 64, (unsigned)n, RLX_AGENT) : 0; }
        __syncthreads();
        if (tid < 64) { const int t = t0 + tid; int i1 = lbase[e1] + sl1, i2 = lbase[e2] + sl2;
            if (i1 < CAP) { ag_st(&pdst[e1 * CAP + i1], 2 * t); ag_st(&pw[e1 * CAP + i1], w1); ag_st(&ps[e1 * CAP + i1], s); }
            if (i2 < CAP) { ag_st(&pdst[e2 * CAP + i2], 2 * t + 1); ag_st(&pw[e2 * CAP + i2], w2); ag_st(&ps[e2 * CAP + i2], s); } }
        __syncthreads();
    }
}

template <bool FINAL> __device__ __forceinline__ void combine_phase(const bf16* __restrict__ hin, const bf16* __restrict__ Y2, const float* __restrict__ g, bf16* __restrict__ hout, bf16* __restrict__ xng, float* __restrict__ outf, int vcu, int G, int wid, int lane) {
    for (int base = vcu * 16; base < M; base += G * 16) {
#pragma unroll
        for (int rr = 0; rr < 2; ++rr) { const int row = base + 2 * wid + rr;
            float4 v[4]; float ss = 0.f;
#pragma unroll
            for (int j = 0; j < 4; ++j) { const int c = 4 * (lane + 64 * j);
                const u32x2 hh = __builtin_nontemporal_load((const u32x2*)(hin + (size_t)row * D + c)), ya = __builtin_nontemporal_load((const u32x2*)(Y2 + ((size_t)2 * row) * D + c)), yb = __builtin_nontemporal_load((const u32x2*)(Y2 + ((size_t)2 * row + 1) * D + c));
                v[j].x = __uint_as_float(hh.x << 16) + __uint_as_float(ya.x << 16) + __uint_as_float(yb.x << 16); v[j].y = __uint_as_float(hh.x & 0xffff0000u) + __uint_as_float(ya.x & 0xffff0000u) + __uint_as_float(yb.x & 0xffff0000u);
                v[j].z = __uint_as_float(hh.y << 16) + __uint_as_float(ya.y << 16) + __uint_as_float(yb.y << 16); v[j].w = __uint_as_float(hh.y & 0xffff0000u) + __uint_as_float(ya.y & 0xffff0000u) + __uint_as_float(yb.y & 0xffff0000u);
                ss += v[j].x * v[j].x + v[j].y * v[j].y + v[j].z * v[j].z + v[j].w * v[j].w;
                if (!FINAL) { u32x2 w; w.x = pk2(v[j].x, v[j].y); w.y = pk2(v[j].z, v[j].w); *(u32x2*)(hout + (size_t)row * D + c) = w; } }
            ss = wave_sum(ss); const float s = rsqrtf(ss * (1.f / D) + RMS_EPS);
#pragma unroll
            for (int j = 0; j < 4; ++j) { const int c = 4 * (lane + 64 * j); const float4 gg = *(const float4*)(g + c);
                const float ox = v[j].x * s * gg.x, oy = v[j].y * s * gg.y, oz = v[j].z * s * gg.z, ow = v[j].w * s * gg.w;
                if (FINAL) { f32x4 o = {ox, oy, oz, ow}; __builtin_nontemporal_store(o, (f32x4*)(outf + (size_t)row * D + c)); }
                else { u32x2 w; w.x = pk2(ox, oy); w.y = pk2(oz, ow); *(u32x2*)(xng + xng_off(row, c)) = w; } } }
    }
}

__device__ __forceinline__ void scan_unit(int g, int pm, const float* __restrict__ Sloc, const float* __restrict__ a16g, bf16* xng, unsigned* ctl, LAS unsigned char* lds, int wid) {
    const int tid = wid * 64 + lane_now(), p = tid & 63, q = tid >> 6, b = pm >> 1, half = pm & 1;
    LAS float* E = (LAS float*)(lds + AUX_OFF + 8192);
    const float ar = a16g[(g * 64 + p) * 2], ai = a16g[(g * 64 + p) * 2 + 1];
    float pr = ar, pi = ai;
#pragma unroll
    for (int k = 0; k < 5; ++k) { const float nr = pr * pr - pi * pi, ni = 2.f * pr * pi; pr = nr; pi = ni; }
    unsigned* flag = ctl + CW_CARRYF + (2 * g + b) * 64;
    unsigned long long* slot = (unsigned long long*)ctl + CW_CARRY / 2 + (2 * g + b) * 64 + p;
    const size_t row0 = (size_t)g * 1024 + b * 512 + half * 256 + q * 32;
    const LAS float* sp = (const LAS float*)lds + (q * 32) * SLOC_PITCH + 2 * p;
    float2 v[32];
#pragma unroll
    for (int s = 0; s < 32; ++s) { const f32x2_t t_ = *(const LAS f32x2_t*)(sp + s * SLOC_PITCH); v[s].x = t_[0]; v[s].y = t_[1]; }
    float xr = 0.f, xi = 0.f;
#pragma unroll
    for (int s = 0; s < 32; ++s) { const float nr = ar * xr - ai * xi + v[s].x, ni = ar * xi + ai * xr + v[s].y; xr = nr; xi = ni; }
    E[(q * 64 + p) * 2] = xr; E[(q * 64 + p) * 2 + 1] = xi;
    if (half && tid == 0) { unsigned sp_ = 0; while (__hip_atomic_load(flag, __ATOMIC_RELAXED, __HIP_MEMORY_SCOPE_AGENT) == 0u) { __builtin_amdgcn_s_sleep(1); if (++sp_ > (1u << 22)) break; } }
    __syncthreads();
    float cr = 0.f, ci = 0.f;
    if (half) { const unsigned long long cv = __hip_atomic_load(slot, __ATOMIC_RELAXED, __HIP_MEMORY_SCOPE_AGENT); cr = __uint_as_float((unsigned)cv); ci = __uint_as_float((unsigned)(cv >> 32)); }
    float ir = cr, ii = ci, mr = 0.f, mi = 0.f;
#pragma unroll
    for (int qq = 0; qq < 8; ++qq) { if (qq == q) { mr = ir; mi = ii; } const float er = E[(qq * 64 + p) * 2], ei = E[(qq * 64 + p) * 2 + 1]; const float nr = pr * ir - pi * ii + er, ni = pr * ii + pi * ir + ei; ir = nr; ii = ni; }
    if (!half && q == 0) {
        __hip_atomic_store(slot, (unsigned long long)__float_as_uint(ir) | ((unsigned long long)__float_as_uint(ii) << 32), __ATOMIC_RELAXED, __HIP_MEMORY_SCOPE_AGENT);
        asm volatile("s_waitcnt vmcnt(0)" ::: "memory");
        if (p == 0) __hip_atomic_store(flag, 1u, __ATOMIC_RELAXED, __HIP_MEMORY_SCOPE_AGENT); }
    { bf16* xp = xng + row0 * 384 + 256 + 2 * p; xr = mr; xi = mi;
#pragma unroll
      for (int s = 0; s < 32; ++s) { *(unsigned*)(xp + (size_t)s * 384) = pk2(xr, xi); const float nr = ar * xr - ai * xi + v[s].x, ni = ar * xi + ai * xr + v[s].y; xr = nr; xi = ni; } }
    __syncthreads();
}

__global__ void __launch_bounds__(NTHR, 2) mk_fwd(Args args) {
    extern __shared__ __attribute__((aligned(16))) unsigned char lds_[];
    LAS unsigned char* lds = (LAS unsigned char*)lds_;
    volatile LAS unsigned* MISC = (volatile LAS unsigned*)(lds + MISC_OFF);
    const int wid = __builtin_amdgcn_readfirstlane(threadIdx.x >> 6);
#define lane lane_now()
#define tid (wid * 64 + lane_now())
    const int G = gridDim.x; const int bx = blockIdx.x; const int vcu = (G % 8 == 0) ? (bx % 8) * (G / 8) + bx / 8 : bx;
    unsigned char* const ws = args.ws;
    constexpr size_t EW = (size_t)NEXP * 1024 * 256;
    for (int u = tid; u < (LDS_BYTES - MISC_OFF) / 4; u += NTHR) ((LAS unsigned*)(lds + MISC_OFF))[u] = 0u;
    __syncthreads();
    const int lo = args.ph_lo, hi = args.ph_hi;
    XcdBarrier bar; bar.bar = (unsigned*)ws + CW_BAR + args.li * XCD_BAR_WORDS; bar.x = 0; bar.st = nullptr;
    if (hi - lo > 1) bar = xcd_barrier_post((unsigned*)ws + CW_BAR + args.li * XCD_BAR_WORDS, MISC + 8, wid);
    const int gw = vcu * NWAVES + wid, NGW = G * NWAVES;
#ifndef PH_ONLY
#define PH_ONLY -1
#endif
#define IN(k) ((PH_ONLY < 0 || PH_ONLY == ((k) >= 12 && (k) <= 14 ? (k) - 8 : (k))) && lo <= (k) && (k) < hi)
#ifndef TS_K1
#define TS_K1 -1
#define TS_K2 -1
#endif
#define TS_STAMP(k) do { if (TS_K1 >= 0 && bx == 0 && tid == 0) ((unsigned long long*)(ws + WS_TS))[k] = __builtin_amdgcn_s_memrealtime(); } while (0)
#define SEAM(k) do { if ((k) + 1 < hi) { xcd_arrive(bar, wid); xcd_wait(bar, wid); } TS_STAMP((k) + 1); } while (0)
#define SEAMX(k, ...) do { if ((k) + 1 < hi) xcd_arrive(bar, wid); { __VA_ARGS__; } if ((k) + 1 < hi) xcd_wait(bar, wid); TS_STAMP((k) + 1); } while (0)
#define SEAMXL(k, ...) do { if ((k) + 1 < hi) xcd_arrive(bar, wid, true); { __VA_ARGS__; } if ((k) + 1 < hi) xcd_wait(bar, wid, true); TS_STAMP((k) + 1); } while (0)
#define STEAL0(first, last) do { TrSrc S_ = mk_trsrc(args.in[4], args.in[5], args.in[15], args.in[20], args.in[21], args.in[22], args.in[2], ws, 3072, (first), (last)); tr_stream(S_, SCR, gw, NGW, lane); } while (0)
#define STEAL1(first) do { TrSrc S_ = mk_trsrc(nullptr, nullptr, nullptr, args.in[20] + EW, args.in[21] + EW, args.in[22] + EW, args.in[2] + D, ws, 0, (first), (first) + NGW); tr_stream(S_, SCR, gw, NGW, lane); } while (0)
#define SCR ((LAS float*)(lds + wid * 16384))
#define ROUTER_PREFILL(layer) do { const u32x4* rw_ = (const u32x4*)(ws + WS_RWT + (size_t)(layer) * RW_LAYER_BYTES); for (int i_ = tid; i_ < RW_LAYER_BYTES / 16; i_ += NTHR) ((LAS u32x4*)lds)[i_] = rw_[i_]; } while (0)
    TS_STAMP(0);
    if (IN(0)) {
        { TrSrc S{args.in[4], args.in[5], args.in[15], args.in[20], args.in[21], args.in[22], args.in[2], ws, 3072, 0, 1536}; tr_stream(S, SCR, gw, NGW, lane); }
        { const float* x = args.in[0]; const float* norm_mix = args.in[1]; bf16* XN = (bf16*)(ws + WS_XN);
          for (int m0 = 2 * gw; m0 < M; m0 += 2 * NGW) { float4 v[2][4];
#pragma unroll
            for (int rr = 0; rr < 2; ++rr) { const float4* xr = (const float4*)(x + (size_t)(m0 + rr) * D);
#pragma unroll
                for (int j = 0; j < 4; ++j) { const f32x4 t_ = __builtin_nontemporal_load((const f32x4*)xr + lane + 64 * j); v[rr][j].x = t_[0]; v[rr][j].y = t_[1]; v[rr][j].z = t_[2]; v[rr][j].w = t_[3]; } }
#pragma unroll
            for (int rr = 0; rr < 2; ++rr) { float ss = 0.f;
#pragma unroll
                for (int j = 0; j < 4; ++j) ss += v[rr][j].x * v[rr][j].x + v[rr][j].y * v[rr][j].y + v[rr][j].z * v[rr][j].z + v[rr][j].w * v[rr][j].w;
                ss = wave_sum(ss); const float s = rsqrtf(ss * (1.f / D) + RMS_EPS);
#pragma unroll
                for (int j = 0; j < 4; ++j) { const int c = 4 * (lane + 64 * j); const float4 gg = *(const float4*)(norm_mix + c); u32x2 w; w.x = pk2(v[rr][j].x * s * gg.x, v[rr][j].y * s * gg.y); w.y = pk2(v[rr][j].z * s * gg.z, v[rr][j].w * s * gg.w);
                    *(u32x2*)(XN + (size_t)(m0 + rr) * D + c) = w; } } } }
        SEAMX(0, STEAL0(1536, 5632));
    }
#define SIDE1() do { \
        { bf16* rwt = (bf16*)(ws + WS_RWT); const float* norm_ffn = args.in[2]; \
          for (int o = bx * NTHR + tid; o < 2 * 36 * 1024; o += G * NTHR) { const int layer = o / (36 * 1024), r = o % (36 * 1024), col = r >> 10, k = r & 1023; \
            const float gnk = norm_ffn[layer * D + k]; \
            const float w = gnk * (col < 4 ? args.in[16][(size_t)layer * 4096 + k * 4 + col] : args.in[18][(size_t)layer * 32768 + ((size_t)((col - 4) >> 3) * 1024 + k) * 8 + ((col - 4) & 7)]); \
            const bf16 hi_ = f2bf(w); const bf16 lo_ = f2bf(w - bf2f(hi_)); \
            rwt[(size_t)layer * 2 * RW_PLANE + col * RW_PITCH + k] = hi_; rwt[(size_t)layer * 2 * RW_PLANE + RW_PLANE + col * RW_PITCH + k] = lo_; } } \
        __syncthreads(); \
        for (int gq = vcu; gq < 256; gq += G) ssm_mats(gq >> 2, gq & 3, args.in[7], args.in[8], args.in[9], args.in[10], args.in[11], args.in[12], args.in[13], args.in[14], ws + WS_SSM, (float*)(ws + WS_A16), (LAS float*)lds, tid); \
        __syncthreads(); } while (0)
    if (IN(1)) { if (vcu & 1) SIDE1(); { PhQKV P{ws, (const char*)(ws + WS_XN), G, bx}; gm::gemm_phase(lds, P, wid); } if (!(vcu & 1)) SIDE1(); SEAMX(1, STEAL0(5632, 9728)); }
#undef SIDE1

    if (IN(2)) {
        const int per = 512 / G;
        { const int uid = vcu * per; at2::attn_stream<8>(uid >> 8, (uid >> 5) & 7, uid & 31, per, (const bf16*)(ws + WS_Q), (const bf16*)(ws + WS_K), (const bf16*)(ws + WS_V), (bf16*)(ws + (args.pad ? WS_XN : WS_Q)), args.in[6], lds, wid); }
        SEAMX(2, STEAL0(9728, 13824));
    }
    if (IN(3)) {
        { PhWo P{ws, (const char*)(ws + WS_Q), args.in[0], args.out, G, bx}; gm::gemm_phase(lds, P, wid); }
        SEAMX(3, STEAL0(13824, 15360); __syncthreads(); if (4 < hi) ROUTER_PREFILL(0)); }

#define TAIL_JOBS(GUF, XB) do { const LAS int* mt = (const LAS int*)(lds + MT_OFF); const int nsm_ = mt[MT_NS], NJ_ = mt[MT_NJ]; \
        for (int j = G - 1 - vcu; j < NJ_; j += G) { const int l_ = lane_now(); const bool hit_ = l_ < nsm_ && mt[MT_JP + l_] <= j && j < mt[MT_JP + l_ + 1]; \
            const int i_ = __builtin_amdgcn_readfirstlane((int)__builtin_ctzll(__ballot(hit_))); const int code_ = __builtin_amdgcn_readfirstlane(mt[MT_SLIST + i_]); \
            Unit u; u.pn = (code_ >> 7) & 1; moe_decode(lds, code_, u); tail_job<GUF>(ws, XB, u, j - __builtin_amdgcn_readfirstlane(mt[MT_JP + i_]), wid, lds, ((code_ >> 6) & 1) != 0); } } while (0)
#define MOE_LAYER(layer, pr) \
    if (IN(pr)) { router_phase((layer) ? (const bf16*)(ws + WS_XN) : (const bf16*)args.out, (const u32x4*)(ws + WS_RWT + (size_t)(layer) * RW_LAYER_BYTES), args.in[17] + (layer) * 4, args.in[19] + (layer) * 32, (unsigned*)ws + CW_CNT + (layer) * 32 * 64, \
                               (int*)(ws + WS_PDST), (float*)(ws + WS_PW), (float*)(ws + WS_PS), (float*)(ws + WS_SROW), lds, vcu, G, wid, (pr) > lo); SEAMXL(pr, if (layer) STEAL1(10240)); } \
    if (IN((pr) + 1) || IN((pr) + 2)) { \
        if (IN((pr) + 1)) { moe_tables(lds, (const unsigned*)ws + CW_CNT + (layer) * 32 * 64, tid); const bf16* hbp = (layer) ? (const bf16*)(ws + WS_XN) : (const bf16*)args.out; \
            { PhGateUp P{ws, (const char*)hbp, lds, G, vcu, __builtin_amdgcn_readfirstlane(((const LAS int*)(lds + MT_OFF))[MT_NN])}; gm::gemm_phase(lds, P, wid); } \
            TAIL_JOBS(true, hbp); \
            SEAM((pr) + 1); } \
        if (IN((pr) + 2)) { if (!IN((pr) + 1)) moe_tables(lds, (const unsigned*)ws + CW_CNT + (layer) * 32 * 64, tid); \
            { PhDown P{ws, (const char*)(ws + WS_H), lds, G, vcu, __builtin_amdgcn_readfirstlane(((const LAS int*)(lds + MT_OFF))[MT_NN])}; gm::gemm_phase(lds, P, wid); } \
            TAIL_JOBS(false, (const bf16*)(ws + WS_H)); \
            SEAMX((pr) + 2, if (!(layer)) STEAL1(0)); } \
    }
    MOE_LAYER(0, 4)
    if (IN(7)) {
        combine_phase<false>((const bf16*)args.out, (const bf16*)(ws + WS_Y2), args.in[1] + D, (bf16*)args.out + (size_t)M * D, (bf16*)(ws + WS_XN), nullptr, vcu, G, wid, lane);
        SEAMX(7, STEAL1(2048); STEAL1(4096)); }
    if (IN(8)) { PhSloc P{ws, (const char*)(ws + WS_XN), lds, G, vcu}; gm::gemm_phase(lds, P, wid); asm volatile("s_waitcnt vmcnt(0)" ::: "memory"); __syncthreads(); }
    if (IN(10)) {
        for (int idx = vcu; idx < 256; idx += G) scan_unit(idx >> 2, idx & 3, (const float*)(ws + WS_SLOC), (const float*)(ws + WS_A16), (bf16*)(ws + WS_XN), (unsigned*)ws, lds, wid);
        asm volatile("s_waitcnt vmcnt(0)" ::: "memory"); __syncthreads();
        PhY P{ws, (const char*)(ws + WS_XN), G, vcu}; gm::gemm_phase(lds, P, wid); SEAMX(10, STEAL1(6144)); }
    if (IN(11)) {
        { PhWout P{ws, (const char*)(ws + WS_G), args.out, G, bx}; gm::gemm_phase(lds, P, wid); }
        SEAMX(11, STEAL1(8192); __syncthreads(); if (12 < hi) ROUTER_PREFILL(1)); }

    MOE_LAYER(1, 12)
#undef MOE_LAYER
    if (IN(15)) { combine_phase<true>((const bf16*)(ws + WS_XN), (const bf16*)(ws + WS_Y2), args.in[3], nullptr, nullptr, args.out, vcu, G, wid, lane);
#if TS_K1 >= 0
        { const unsigned long long* ts = (const unsigned long long*)(ws + WS_TS); const float dtus = (float)(ts[TS_K1 + 1] - ts[TS_K1]) * 1e-2f; const float e = exp2f(rintf(log2f(dtus) * 6.f) / 6.f) * 1e-2f;
          __syncthreads();
          for (int base = vcu * 16; base < M; base += G * 16) for (int i = tid; i < 16 * D; i += NTHR) args.out[(size_t)base * D + i] *= (1.f + e);
          if (TS_K2 >= 0 && bx == 0) { __syncthreads(); if (tid == 0) args.out[0] = exp2f(rintf(log2f((float)(ts[TS_K2 + 1] - ts[TS_K2]) * 1e-2f) * 6.f) / 6.f); } }
#endif
    }
#undef IN
#undef SEAM
#undef SCR
#undef lane
#undef tid
}

#ifndef FUSED
#define FUSED 1
#endif
#ifndef DUP_PH
#define DUP_PH -1
#endif
extern "C" void kernel_launch(void* const* d_in, const int* in_sizes, int n_in, void* d_out, int out_size, void* d_ws, size_t ws_size, hipStream_t stream) {
    static int grid = 0;
    if (grid == 0) {
        if (n_in != 23 || out_size != M * D || ws_size < WS_END) { fprintf(stderr, "kernel_launch: unexpected shapes (n_in %d out %d ws %zu)\n", n_in, out_size, ws_size); grid = -1; return; }
        int dev = 0, cus = 0;
        if (hipGetDevice(&dev) != hipSuccess || hipDeviceGetAttribute(&cus, hipDeviceAttributeMultiprocessorCount, dev) != hipSuccess) { grid = -1; return; }
        if (hipFuncSetAttribute((const void*)mk_fwd, hipFuncAttributeMaxDynamicSharedMemorySize, LDS_BYTES) != hipSuccess) { fprintf(stderr, "kernel_launch: hipFuncSetAttribute failed\n"); grid = -1; return; }
        (void)hipGetLastError();
        grid = cus;
        if (grid != 256) fprintf(stderr, "kernel_launch: %d CUs (built for 256)\n", grid);
    }
    if (grid < 0) return;
    unsigned char* ws = (unsigned char*)d_ws;
    (void)hipMemsetAsync(ws + WS_CTL, 0, CTL_ZERO_BYTES, stream);
    Args a{}; for (int i = 0; i < 23; ++i) a.in[i] = (const float*)d_in[i];
    a.out = (float*)d_out; a.ws = ws;
    int li = 0;
    auto run = [&](int lo, int hi) { a.ph_lo = lo; a.ph_hi = hi; a.li = li++; hipLaunchKernelGGL(mk_fwd, dim3(grid), dim3(NTHR), LDS_BYTES, stream, a); };
    if (FUSED) { run(0, N_PHASES); return; }
    for (int ph = 0; ph < N_PHASES; ++ph) { if (ph == 9) continue;
        if (DUP_PH == ph) { if (ph == 2) { a.pad = 1; run(2, 3); a.pad = 0; } else run(ph, ph + 1); }
        run(ph, ph + 1); }
}
```
